# Optimizing an MI355X kernel written in HIP

```python
import jax, jax.numpy as jnp
from jax import lax
import numpy as np

D_MODEL = 1024
BATCH = 8
SEQ = 2048
DEPTH = 2
DEC_BATCH = 128
DEC_SEQ = 8
PAST_LEN = 16384
PAGE_SIZE = 128

N_AB = (DEPTH + 1) // 2
N_C = DEPTH // 2
N_SUB = 3
D_MIX = D_MODEL
MLSTM_WIDTH = D_MIX // 2
MLSTM_HEADS = 4
MLSTM_HD = MLSTM_WIDTH // MLSTM_HEADS
MLSTM_CHUNK = 128
RG_WIDTH = D_MIX - MLSTM_WIDTH
RG_BLOCKS = 8
RG_BD = RG_WIDTH // RG_BLOCKS
RG_CONV = 4
RG_C = 8.0
D_IN_AB = 4 * MLSTM_WIDTH + 2 * MLSTM_HEADS + 2 * RG_WIDTH
AB_SPLITS = (MLSTM_WIDTH, 2 * MLSTM_WIDTH, 3 * MLSTM_WIDTH, 4 * MLSTM_WIDTH,
             4 * MLSTM_WIDTH + MLSTM_HEADS, 4 * MLSTM_WIDTH + 2 * MLSTM_HEADS,
             4 * MLSTM_WIDTH + 2 * MLSTM_HEADS + RG_WIDTH)
RWKV_HS = 64
RWKV_HEADS = D_MODEL // RWKV_HS
RWKV_DECAY_LORA = 64
RWKV_A_LORA = 64
RWKV_GATE_LORA = 128
RWKV_LN_EPS = 64e-5
D_FF = ((8 * D_MODEL // 3 + 127) // 128) * 128
ALPHA = (2.0 * DEPTH) ** 0.25
BETA = (8.0 * DEPTH) ** -0.25
LN_EPS = 1e-5
HEAD_NORM_EPS = 1e-6

kernel_name = 'hybrid_mlstm_rglru_rwkv7_decoder_step'


def layer_norm(x, g, b):
    xf = x.astype(jnp.float32)
    mu = jnp.mean(xf, axis=-1, keepdims=True)
    var = jnp.mean(jnp.square(xf - mu), axis=-1, keepdims=True)
    return ((xf - mu) * lax.rsqrt(var + LN_EPS) * g + b).astype(x.dtype)


def modulate(x, shift, scale):
    return x * (1.0 + scale[:, None, :]) + shift[:, None, :]


def post_norm_residual(x, y, gate, res_w, g, b):
    return layer_norm(ALPHA * x + res_w * (1.0 + gate[:, None, :]) * y, g, b)


def swiglu(h, w1, w3, w2):
    return (jax.nn.silu(h @ w1) * (h @ w3)) @ w2


def mlstm_chunk(carry, inp):
    C0, n0, m0 = carry
    q, k, v, ig, lf = inp
    L = q.shape[2]
    b = jnp.cumsum(lf, axis=-1)
    causal = jnp.tril(jnp.ones((L, L), dtype=bool))
    dmat = jnp.where(causal, b[..., :, None] - b[..., None, :] + ig[..., None, :], -jnp.inf)
    m_inter = b + m0[..., None]
    m = jnp.maximum(m_inter, jnp.max(dmat, axis=-1))
    w_inter = jnp.exp(m_inter - m)
    scores = jnp.einsum('bhtd,bhsd->bhts', q, k) * jnp.exp(dmat - m[..., None])
    num = jnp.einsum('bhts,bhsd->bhtd', scores, v) + w_inter[..., None] * jnp.einsum('bhvk,bhtk->bhtv', C0, q)
    den = jnp.sum(scores, axis=-1) + w_inter * jnp.einsum('bhk,bhtk->bht', n0, q)
    h = num / jnp.maximum(jnp.abs(den), jnp.exp(-m))[..., None]
    m_end = m[..., -1]
    w_state = jnp.exp(b[..., -1] + m0 - m_end)
    w_rows = jnp.exp(b[..., -1:] - b + ig - m_end[..., None])
    C_new = w_state[..., None, None] * C0 + jnp.einsum('bhs,bhsv,bhsk->bhvk', w_rows, v, k)
    n_new = w_state[..., None] * n0 + jnp.einsum('bhs,bhsk->bhk', w_rows, k)
    return (C_new, n_new, m_end), h


def mlstm(q, k, v, ig, lf, C0, n0, m0):
    B, S = q.shape[0], q.shape[1]
    L = MLSTM_CHUNK if S % MLSTM_CHUNK == 0 else S
    nc = S // L

    def chunks(t):
        t = t.astype(jnp.float32).reshape((B, nc, L) + t.shape[2:])
        return jnp.moveaxis(jnp.moveaxis(t, 3, 2), 1, 0)

    carry0 = (C0.astype(jnp.float32), n0.astype(jnp.float32), m0.astype(jnp.float32))
    (C1, n1, m1), h = lax.scan(mlstm_chunk, carry0,
                               (chunks(q), chunks(k), chunks(v), chunks(ig), chunks(lf)))
    h = jnp.swapaxes(jnp.moveaxis(h, 0, 1), 2, 3).reshape(B, S, MLSTM_HEADS, MLSTM_HD)
    return h, C1, n1, m1


def head_norm(h, g):
    mu = jnp.mean(h, axis=-1, keepdims=True)
    var = jnp.mean(jnp.square(h - mu), axis=-1, keepdims=True)
    hn = (h - mu) * lax.rsqrt(var + HEAD_NORM_EPS)
    return hn.reshape(h.shape[0], h.shape[1], -1) * g


def causal_dwconv(xr, buf, w, b):
    S = xr.shape[1]
    xp = jnp.concatenate([buf.astype(xr.dtype), xr], axis=1)
    out = sum(w[j] * xp[:, j:j + S] for j in range(RG_CONV)) + b
    return out, xp[:, S:].astype(jnp.float32)


def lin_combine(left, right):
    a1, b1 = left
    a2, b2 = right
    return a1 * a2, a2 * b1 + b2


def rg_lru(xc, h0, w_a, b_a, w_x, b_x, lam):
    B, S, W = xc.shape
    xb = xc.reshape(B, S, RG_BLOCKS, RG_BD)
    r = jax.nn.sigmoid(jnp.einsum('bsgi,gij->bsgj', xb, w_a).reshape(B, S, W) + b_a).astype(jnp.float32)
    i = jax.nn.sigmoid(jnp.einsum('bsgi,gij->bsgj', xb, w_x).reshape(B, S, W) + b_x).astype(jnp.float32)
    log_a = -RG_C * jax.nn.softplus(-lam.astype(jnp.float32)) * r
    a = jnp.exp(log_a)
    u = jnp.sqrt(-jnp.expm1(2.0 * log_a)) * i * xc.astype(jnp.float32)
    u = u.at[:, 0].add(a[:, 0] * h0.astype(jnp.float32))
    _, h = lax.associative_scan(lin_combine, (a, u), axis=1)
    return h, h[:, -1]


def ab_mixer(h, C0, n0, m0, rh0, buf0, w_in, b_gates, mnorm_g, conv_w, conv_b,
             w_a, b_a, w_x, b_x, lam, w_out):
    B, S, _ = h.shape
    z = h @ w_in
    q, k, v, o, ig, fg, xr, gr = jnp.split(z, AB_SPLITS, axis=-1)
    heads = lambda t: t.reshape(B, S, MLSTM_HEADS, MLSTM_HD)
    ig = ig.astype(jnp.float32) + b_gates[0]
    lf = jax.nn.log_sigmoid(fg.astype(jnp.float32) + b_gates[1])
    hm, C1, n1, m1 = mlstm(heads(q), heads(k) * (MLSTM_HD ** -0.5), heads(v), ig, lf, C0, n0, m0)
    hm = head_norm(hm, mnorm_g) * jax.nn.sigmoid(o.astype(jnp.float32))
    xc, buf1 = causal_dwconv(xr, buf0, conv_w, conv_b)
    hr, rh1 = rg_lru(xc, rh0, w_a, b_a, w_x, b_x, lam)
    hr = hr.astype(h.dtype) * jax.nn.gelu(gr)
    y = jnp.concatenate([hm.astype(h.dtype), hr], axis=-1) @ w_out
    return y, (C1, n1, m1, rh1, buf1)


def rwkv7_step(S_, inp):
    r_t, dec_t, k_t, v_t, kk_t, a_t = inp
    sa = jnp.einsum('bhvk,bhk->bhv', S_, -kk_t)
    S_ = (S_ * dec_t[:, :, None, :] + sa[..., None] * (kk_t * a_t)[:, :, None, :]
          + v_t[..., None] * k_t[:, :, None, :])
    return S_, jnp.einsum('bhvk,bhk->bhv', S_, r_t)


def rwkv7_mixer(h, wkv0, prev0, mu, wr, wk, wv, w0, w1, w2, a0, a1, a2, g1, g2,
                k_k, k_a, r_k, lnx_g, lnx_b, wo):
    B, S, D = h.shape
    f32 = jnp.float32
    h_prev = jnp.concatenate([prev0[:, None].astype(h.dtype), h[:, :-1]], axis=1)
    dx = h_prev - h
    xr, xw, xk, xv, xa, xg = [h + dx * mu[j] for j in range(6)]
    heads = lambda t: t.astype(f32).reshape(B, S, RWKV_HEADS, RWKV_HS)
    r = heads(xr @ wr)
    k = heads(xk @ wk)
    v = heads(xv @ wv)
    w_log = -jax.nn.softplus(-(w0 + jnp.tanh(xw @ w1) @ w2).astype(f32)) - 0.5
    decay = heads(jnp.exp(-jnp.exp(w_log)))
    a = heads(jax.nn.sigmoid(a0 + (xa @ a1) @ a2))
    g = jax.nn.sigmoid(xg @ g1) @ g2
    kk = k * k_k.astype(f32).reshape(RWKV_HEADS, RWKV_HS)
    kk = kk / jnp.maximum(jnp.sqrt(jnp.sum(kk * kk, axis=-1, keepdims=True)), 1e-12)
    k = k * (1.0 + (a - 1.0) * k_a.astype(f32).reshape(RWKV_HEADS, RWKV_HS))
    tm = lambda t: jnp.moveaxis(t, 1, 0)
    wkv1, y = lax.scan(rwkv7_step, wkv0.astype(f32), (tm(r), tm(decay), tm(k), tm(v), tm(kk), tm(a)))
    y = jnp.moveaxis(y, 0, 1)
    ym = jnp.mean(y, axis=-1, keepdims=True)
    yv = jnp.mean(jnp.square(y - ym), axis=-1, keepdims=True)
    y = ((y - ym) * lax.rsqrt(yv + RWKV_LN_EPS)).reshape(B, S, D) * lnx_g + lnx_b
    bonus = jnp.sum(r * k * r_k.astype(f32), axis=-1, keepdims=True) * v
    y = y + bonus.reshape(B, S, D)
    out = (y.astype(h.dtype) * g) @ wo
    return out, (wkv1, h[:, -1].astype(f32))


def run_trunk(x, c, states, p):
    mC, mn, mm, rh, rconv, wkv, shift = states
    B = x.shape[0]
    new_ab, new_c = [], []
    for layer in range(DEPTH):
        mod = (jax.nn.silu(c) @ p['ada_w'][layer] + p['ada_b'][layer]).reshape(B, 3 * N_SUB, D_MODEL)
        lg, lb = p['ln_g'][layer], p['ln_b'][layer]
        y = swiglu(modulate(x, mod[:, 0], mod[:, 1]),
                   p['ffn_w1'][layer, 0], p['ffn_w3'][layer, 0], p['ffn_w2'][layer, 0])
        x = post_norm_residual(x, y, mod[:, 2], 0.5, lg[0], lb[0])
        hin = modulate(x, mod[:, 3], mod[:, 4])
        j = layer // 2
        if layer % 2 == 0:
            y, st = ab_mixer(hin, mC[j], mn[j], mm[j], rh[j], rconv[j],
                             p['ab_w_in'][j], p['mlstm_b_gates'][j], p['mlstm_norm_g'][j],
                             p['rg_conv_w'][j], p['rg_conv_b'][j], p['rg_w_a'][j], p['rg_b_a'][j],
                             p['rg_w_x'][j], p['rg_b_x'][j], p['rg_lambda'][j], p['ab_w_out'][j])
            new_ab.append(st)
        else:
            y, st = rwkv7_mixer(hin, wkv[j], shift[j], p['rw_mu'][j], p['rw_wr'][j], p['rw_wk'][j],
                                p['rw_wv'][j], p['rw_w0'][j], p['rw_w1'][j], p['rw_w2'][j],
                                p['rw_a0'][j], p['rw_a1'][j], p['rw_a2'][j], p['rw_g1'][j], p['rw_g2'][j],
                                p['rw_k_k'][j], p['rw_k_a'][j], p['rw_r_k'][j],
                                p['rw_lnx_g'][j], p['rw_lnx_b'][j], p['rw_wo'][j])
            new_c.append(st)
        x = post_norm_residual(x, y, mod[:, 5], 1.0, lg[1], lb[1])
        y = swiglu(modulate(x, mod[:, 6], mod[:, 7]),
                   p['ffn_w1'][layer, 1], p['ffn_w3'][layer, 1], p['ffn_w2'][layer, 1])
        x = post_norm_residual(x, y, mod[:, 8], 0.5, lg[2], lb[2])
    stk = lambda sts, i: jnp.stack([s[i] for s in sts], axis=0)
    return x, (stk(new_ab, 0), stk(new_ab, 1), stk(new_ab, 2), stk(new_ab, 3), stk(new_ab, 4),
               stk(new_c, 0), stk(new_c, 1))


def zero_states(B):
    f = jnp.float32
    return (jnp.zeros((N_AB, B, MLSTM_HEADS, MLSTM_HD, MLSTM_HD), f),
            jnp.zeros((N_AB, B, MLSTM_HEADS, MLSTM_HD), f),
            jnp.zeros((N_AB, B, MLSTM_HEADS), f),
            jnp.zeros((N_AB, B, RG_WIDTH), f),
            jnp.zeros((N_AB, B, RG_CONV - 1, RG_WIDTH), f),
            jnp.zeros((N_C, B, RWKV_HEADS, RWKV_HS, RWKV_HS), f),
            jnp.zeros((N_C, B, D_MODEL), f))


def setup_inputs(seed: int = 0) -> dict:
    key = jax.random.key(seed)
    it = iter(jax.random.split(key, 64))
    f32 = jnp.float32

    def nrm(shape, scale):
        return jax.random.normal(next(it), shape, f32) * scale

    def unif(shape, lo, hi):
        return jax.random.uniform(next(it), shape, f32, lo, hi)

    D = D_MODEL
    inv = D ** -0.5
    d = {}
    d['x_prompt'] = nrm((BATCH, SEQ, D), 1.0)
    d['x_sample'] = nrm((DEC_BATCH, DEC_SEQ, D), 1.0)
    d['c_prompt'] = nrm((BATCH, D), 1.0)
    d['c_sample'] = nrm((DEC_BATCH, D), 1.0)
    d['state_mlstm_C'] = nrm((N_AB, DEC_BATCH, MLSTM_HEADS, MLSTM_HD, MLSTM_HD), 0.1)
    d['state_mlstm_n'] = nrm((N_AB, DEC_BATCH, MLSTM_HEADS, MLSTM_HD), 0.1)
    d['state_mlstm_m'] = unif((N_AB, DEC_BATCH, MLSTM_HEADS), 0.0, 3.0)
    d['state_rglru_h'] = nrm((N_AB, DEC_BATCH, RG_WIDTH), 0.5)
    d['state_rglru_conv'] = nrm((N_AB, DEC_BATCH, RG_CONV - 1, RG_WIDTH), 0.5)
    d['state_rwkv_wkv'] = nrm((N_C, DEC_BATCH, RWKV_HEADS, RWKV_HS, RWKV_HS), 0.1)
    d['state_rwkv_shift'] = nrm((N_C, DEC_BATCH, D), 1.0)
    d['ada_w'] = nrm((DEPTH, D, 3 * N_SUB * D), 0.5 * inv)
    d['ada_b'] = nrm((DEPTH, 3 * N_SUB * D), 0.02)
    d['ln_g'] = 1.0 + nrm((DEPTH, N_SUB, D), 0.05)
    d['ln_b'] = nrm((DEPTH, N_SUB, D), 0.02)
    d['ffn_w1'] = nrm((DEPTH, 2, D, D_FF), inv)
    d['ffn_w3'] = nrm((DEPTH, 2, D, D_FF), inv)
    d['ffn_w2'] = nrm((DEPTH, 2, D_FF, D), BETA * D_FF ** -0.5)
    d['ab_w_in'] = nrm((N_AB, D, D_IN_AB), inv)
    d['mlstm_b_gates'] = jnp.stack([nrm((N_AB, MLSTM_HEADS), 0.1),
                                    unif((N_AB, MLSTM_HEADS), 3.0, 6.0)], axis=1)
    d['mlstm_norm_g'] = 1.0 + nrm((N_AB, MLSTM_WIDTH), 0.05)
    d['rg_conv_w'] = nrm((N_AB, RG_CONV, RG_WIDTH), RG_CONV ** -0.5)
    d['rg_conv_b'] = nrm((N_AB, RG_WIDTH), 0.02)
    d['rg_w_a'] = nrm((N_AB, RG_BLOCKS, RG_BD, RG_BD), RG_BD ** -0.5)
    d['rg_b_a'] = nrm((N_AB, RG_WIDTH), 0.02)
    d['rg_w_x'] = nrm((N_AB, RG_BLOCKS, RG_BD, RG_BD), RG_BD ** -0.5)
    d['rg_b_x'] = nrm((N_AB, RG_WIDTH), 0.02)
    a_base = unif((N_AB, RG_WIDTH), 0.9, 0.999) ** (1.0 / RG_C)
    d['rg_lambda'] = jnp.log(a_base) - jnp.log1p(-a_base)
    d['ab_w_out'] = nrm((N_AB, D_MIX, D), BETA * D_MIX ** -0.5)
    d['rw_mu'] = unif((N_C, 6, D), 0.0, 1.0)
    d['rw_wr'] = nrm((N_C, D, D), inv)
    d['rw_wk'] = nrm((N_C, D, D), inv)
    d['rw_wv'] = nrm((N_C, D, D), inv)
    d['rw_w0'] = unif((N_C, D), -5.0, 1.0)
    d['rw_w1'] = nrm((N_C, D, RWKV_DECAY_LORA), inv)
    d['rw_w2'] = nrm((N_C, RWKV_DECAY_LORA, D), 0.1)
    d['rw_a0'] = nrm((N_C, D), 0.1)
    d['rw_a1'] = nrm((N_C, D, RWKV_A_LORA), inv)
    d['rw_a2'] = nrm((N_C, RWKV_A_LORA, D), 0.1)
    d['rw_g1'] = nrm((N_C, D, RWKV_GATE_LORA), inv)
    d['rw_g2'] = nrm((N_C, RWKV_GATE_LORA, D), RWKV_GATE_LORA ** -0.5)
    d['rw_k_k'] = 0.85 + nrm((N_C, D), 0.05)
    d['rw_k_a'] = 1.0 + nrm((N_C, D), 0.05)
    d['rw_r_k'] = nrm((N_C, RWKV_HEADS, RWKV_HS), 0.1)
    d['rw_lnx_g'] = 1.0 + nrm((N_C, D), 0.05)
    d['rw_lnx_b'] = nrm((N_C, D), 0.02)
    d['rw_wo'] = nrm((N_C, D, D), BETA * inv)
    return d


def reference(x_prompt, x_sample, c_prompt, c_sample,
              state_mlstm_C, state_mlstm_n, state_mlstm_m, state_rglru_h, state_rglru_conv,
              state_rwkv_wkv, state_rwkv_shift,
              ada_w, ada_b, ln_g, ln_b, ffn_w1, ffn_w3, ffn_w2,
              ab_w_in, mlstm_b_gates, mlstm_norm_g, rg_conv_w, rg_conv_b, rg_w_a, rg_b_a,
              rg_w_x, rg_b_x, rg_lambda, ab_w_out,
              rw_mu, rw_wr, rw_wk, rw_wv, rw_w0, rw_w1, rw_w2, rw_a0, rw_a1, rw_a2,
              rw_g1, rw_g2, rw_k_k, rw_k_a, rw_r_k, rw_lnx_g, rw_lnx_b, rw_wo):
    p = dict(ada_w=ada_w, ada_b=ada_b, ln_g=ln_g, ln_b=ln_b, ffn_w1=ffn_w1, ffn_w3=ffn_w3,
             ffn_w2=ffn_w2, ab_w_in=ab_w_in, mlstm_b_gates=mlstm_b_gates, mlstm_norm_g=mlstm_norm_g,
             rg_conv_w=rg_conv_w, rg_conv_b=rg_conv_b, rg_w_a=rg_w_a, rg_b_a=rg_b_a, rg_w_x=rg_w_x,
             rg_b_x=rg_b_x, rg_lambda=rg_lambda, ab_w_out=ab_w_out, rw_mu=rw_mu, rw_wr=rw_wr,
             rw_wk=rw_wk, rw_wv=rw_wv, rw_w0=rw_w0, rw_w1=rw_w1, rw_w2=rw_w2, rw_a0=rw_a0,
             rw_a1=rw_a1, rw_a2=rw_a2, rw_g1=rw_g1, rw_g2=rw_g2, rw_k_k=rw_k_k, rw_k_a=rw_k_a,
             rw_r_k=rw_r_k, rw_lnx_g=rw_lnx_g, rw_lnx_b=rw_lnx_b, rw_wo=rw_wo)
    y_prompt, sp = run_trunk(x_prompt, c_prompt, zero_states(x_prompt.shape[0]), p)
    y_sample, ss = run_trunk(x_sample, c_sample,
                             (state_mlstm_C, state_mlstm_n, state_mlstm_m, state_rglru_h,
                              state_rglru_conv, state_rwkv_wkv, state_rwkv_shift), p)
    p_mC, p_mn, p_mm, p_rh, p_rconv, p_wkv, p_shift = sp
    s_mC, s_mn, s_mm, s_rh, s_rconv, s_wkv, s_shift = ss
    return (y_prompt, y_sample,
            p_mC, p_mn, p_mm, p_rh, p_rconv, p_wkv, p_shift,
            s_mC, s_mn, s_mm, s_rh, s_rconv, s_wkv, s_shift)
```

```cpp
#define MK_N_LAUNCHES 25
#include <hip/hip_runtime.h>
#include <cstdio>
#include <cstdint>
#include <cmath>
namespace pg8 {
#define PG8_LAS __attribute__((address_space(3)))
typedef unsigned short bf16_t;
typedef short bf16x8 __attribute__((ext_vector_type(8)));
typedef float f32x4 __attribute__((ext_vector_type(4)));
typedef unsigned u32x4 __attribute__((ext_vector_type(4)));
constexpr int BM = 256, BK = 64, HALF = 128, HTB = HALF * BK * 2  , STAGE_BYTES = 8 * HTB, NXCD = 8, WGM = 8;

__host__ __device__ __forceinline__ int lds_byte(int r, int c) { const int st = (r >> 4) * 2 + (c >> 5), rr = r & 15, cc = c & 31, ob = rr * 64 + cc * 2; return st * 1024 + (ob ^ (((ob >> 9) & 1) << 5)); }
__host__ __device__ __forceinline__ void stage_rc(int b, int& R, int& C) { const int st = b / 1024, sb = b % 1024, swz = sb ^ (((sb >> 9) & 1) << 5); R = (st >> 1) * 16 + swz / 64; C = (st & 1) * 32 + (swz % 64) / 2; }
__host__ __device__ __forceinline__ int perm32(int rho) { const int n = rho >> 4, i = rho & 15; return 8 * (i >> 2) + 4 * n + (i & 3); }

struct Unit { int pm, pn; };
struct Gemm { const bf16_t* A; const bf16_t* Bt; int M, N, K; };

struct StaticOrder {
    int nM, nN, nwg, G, c;
    __host__ __device__ void init(int M, int N, int G_, int c_) { nM = M / BM; nN = N / BM; nwg = nM * nN; G = G_; c = c_; }
    __host__ __device__ bool next(int i, Unit& u) const {
        const long L = (long)i * G + c; if (L >= nwg) return false;
        int wgid = (int)L; { const int q = nwg / NXCD, r = nwg % NXCD, xcd = wgid % NXCD, off = wgid / NXCD; wgid = (xcd < r ? xcd * (q + 1) : r * (q + 1) + (xcd - r) * q) + off; }
        const int nig = WGM * nN, gid = wgid / nig, fm = gid * WGM, gsz = (nM - fm) < WGM ? (nM - fm) : WGM;
        u.pm = fm + ((wgid % nig) % gsz); u.pn = (wgid % nig) / gsz; return true;
    }
    __device__ __forceinline__ void a_ready(const Unit&) const {}
    __device__ __forceinline__ void done(const Unit&) const {}
};

__device__ __forceinline__ unsigned cvt_pk_bf16(float lo, float hi) { unsigned r; asm volatile("v_cvt_pk_bf16_f32 %0, %1, %2" : "=v"(r) : "v"(lo), "v"(hi)); return r; }
typedef float f32x2 __attribute__((ext_vector_type(2)));
constexpr int MPROWS = 16384;
__device__ __forceinline__ int mod_row(int r) { return r < MPROWS ? (r >> 11) : 8 + ((r - MPROWS) >> 3); }
__device__ __forceinline__ float fsig(float x) { return __builtin_amdgcn_rcpf(1.0f + __builtin_amdgcn_exp2f(-1.44269504f * x)); }
__device__ __forceinline__ float ftanh(float x) { return 1.0f - 2.0f * __builtin_amdgcn_rcpf(1.0f + __builtin_amdgcn_exp2f(2.88539008f * x)); }

struct EpiSwiglu {
    static constexpr bool PERM = true, AFTER_DRAIN = false;
    bf16_t* O; int ldc;
    __device__ __forceinline__ void operator()(const f32x4 (&acc)[2][2][4][2], const Unit& u, int wr, int wc, int fr, int fq) const {
        const int row0 = u.pm * BM + wr * 64 + fr, col0 = u.pn * HALF + wc * 32 + 8 * fq;
#pragma unroll
        for (int ai = 0; ai < 2; ++ai)
#pragma unroll
            for (int m = 0; m < 4; ++m) { bf16_t* rowp = O + (size_t)(row0 + ai * HALF + m * 16) * ldc + col0;
                const f32x4 a0 = acc[ai][0][m][0], a1 = acc[ai][0][m][1], b0 = acc[ai][1][m][0], b1 = acc[ai][1][m][1];
                f32x4 v0, v1;
#pragma unroll
                for (int j = 0; j < 4; ++j) { v0[j] = a0[j] * fsig(a0[j]) * b0[j]; v1[j] = a1[j] * fsig(a1[j]) * b1[j]; }
                u32x4 w; w.x = cvt_pk_bf16(v0[0], v0[1]); w.y = cvt_pk_bf16(v0[2], v0[3]); w.z = cvt_pk_bf16(v1[0], v1[1]); w.w = cvt_pk_bf16(v1[2], v1[3]);
                *(u32x4*)rowp = w; asm volatile("" ::: "memory"); }
    }
};
struct EpiStore {
    static constexpr bool PERM = true, AFTER_DRAIN = false;
    bf16_t* O; int ldc; int ntile_main; bf16_t* O2; int ldc2;
    __device__ __forceinline__ void operator()(const f32x4 (&acc)[2][2][4][2], const Unit& u, int wr, int wc, int fr, int fq) const {
        const int row0 = u.pm * BM + wr * 64 + fr;
        const bool main = u.pn < ntile_main;
        bf16_t* base = main ? O + (size_t)u.pn * BM : O2; const int ld = main ? ldc : ldc2;
        const int col0 = wc * 32 + 8 * fq;
#pragma unroll
        for (int ai = 0; ai < 2; ++ai)
#pragma unroll
            for (int m = 0; m < 4; ++m) { bf16_t* rowp = base + (size_t)(row0 + ai * HALF + m * 16) * ld + col0;
#pragma unroll
                for (int bj = 0; bj < 2; ++bj) { f32x4 v0 = acc[ai][bj][m][0], v1 = acc[ai][bj][m][1];
                    if (!main) {
                        if (bj == 1) {
#pragma unroll
                            for (int j = 0; j < 4; ++j) { v0[j] = fsig(v0[j]); v1[j] = fsig(v1[j]); }
                        } else if (wc < 2) {
#pragma unroll
                            for (int j = 0; j < 4; ++j) { v0[j] = ftanh(v0[j]); v1[j] = ftanh(v1[j]); }
                        }
                    }
                    u32x4 w; w.x = cvt_pk_bf16(v0[0], v0[1]); w.y = cvt_pk_bf16(v0[2], v0[3]); w.z = cvt_pk_bf16(v1[0], v1[1]); w.w = cvt_pk_bf16(v1[2], v1[3]);
                    *(u32x4*)(rowp + bj * HALF) = w; asm volatile("" ::: "memory"); } }
    }
};
struct EpiLora2 {
    static constexpr bool PERM = true, AFTER_DRAIN = false;
    bf16_t* O; int ldc; const float* w0; const float* a0;
    __device__ __forceinline__ void operator()(const f32x4 (&acc)[2][2][4][2], const Unit& u, int wr, int wc, int fr, int fq) const {
        const int row0 = u.pm * BM + wr * 64 + fr, col0 = u.pn * BM + wc * 32 + 8 * fq, kind = u.pn >> 2;
        const float* bp = (kind == 0 ? w0 : a0) + (col0 & 1023); const float bsc = kind == 2 ? 0.f : 1.f, mul = kind == 0 ? -0.87504229f : 1.0f;
#pragma unroll
        for (int bj = 0; bj < 2; ++bj)
#pragma unroll
            for (int ai = 0; ai < 2; ++ai)
#pragma unroll
                for (int m = 0; m < 4; ++m) { bf16_t* rowp = O + (size_t)(row0 + ai * HALF + m * 16) * ldc + col0;
                    f32x4 v0 = acc[ai][bj][m][0] + *(const f32x4*)(bp + bj * HALF) * bsc, v1 = acc[ai][bj][m][1] + *(const f32x4*)(bp + bj * HALF + 4) * bsc;
                    if (kind != 2) {
#pragma unroll
                        for (int j = 0; j < 4; ++j) { v0[j] = mul * fsig(v0[j]); v1[j] = mul * fsig(v1[j]); }
                    }
                    u32x4 w; w.x = cvt_pk_bf16(v0[0], v0[1]); w.y = cvt_pk_bf16(v0[2], v0[3]); w.z = cvt_pk_bf16(v1[0], v1[1]); w.w = cvt_pk_bf16(v1[2], v1[3]);
                    *(u32x4*)(rowp + bj * HALF) = w; asm volatile("" ::: "memory"); }
    }
};
struct EpiResid {
    static constexpr bool PERM = false, AFTER_DRAIN = false;
    const float* xp; const float* xs; float* X; const float* gate; float alpha, rw;
    __device__ __forceinline__ void operator()(const f32x4 (&acc)[2][2][4][2], const Unit& u, int wr, int wc, int fr, int fq) const {
        const int row0 = u.pm * BM + wr * 64 + fr, col0 = u.pn * BM + wc * 32 + 4 * fq;
#pragma unroll
        for (int ai = 0; ai < 2; ++ai)
#pragma unroll
            for (int m = 0; m < 4; ++m) { const int row = row0 + ai * HALF + m * 16;
                const float* xr = (row < MPROWS ? xp + (size_t)row * 1024 : xs + (size_t)(row - MPROWS) * 1024) + col0;
                const float* gr = gate + (size_t)mod_row(row) * 9216 + col0; float* o = X + (size_t)row * 1024 + col0;
#pragma unroll
                for (int bj = 0; bj < 2; ++bj)
#pragma unroll
                    for (int n = 0; n < 2; ++n) { const int c = bj * HALF + n * 16; const f32x4 xv = *(const f32x4*)(xr + c), gv = *(const f32x4*)(gr + c);
                        *(f32x4*)(o + c) = xv * alpha + (gv + 1.0f) * rw * acc[ai][bj][m][n]; } }
    }
};

template <class Epi, class Sched, bool ALIGN_EPI = false, bool SP2 = false>
__device__ __forceinline__ void gemm_phase(PG8_LAS unsigned char* lds, const Gemm g, const Sched& S, const Epi& E) {
    int tid_ = threadIdx.x; asm volatile("" : "+v"(tid_));
    const int tid = tid_, wid = __builtin_amdgcn_readfirstlane(tid >> 6), lane = tid & 63, wr = wid >> 2, wc = wid & 3, fr = lane & 15, fq = lane >> 4;
    int K_ = g.K; asm volatile("" : "+s"(K_));
    const int K = K_, nt = K / BK;
    unsigned voffA[2], voffB[2];
#pragma unroll
    for (int i = 0; i < 2; ++i) { int R, C; stage_rc(tid * 16 + i * 8192, R, C); const int Rb = Epi::PERM ? ((R & ~31) + perm32(R & 31)) : R;
        voffA[i] = (unsigned)(R * K + C) * 2u; voffB[i] = (unsigned)(Rb * K + C) * 2u; }
    const size_t kstep = (size_t)(BK * 2);
    const size_t hstep = (size_t)HALF * K * 2;
    const size_t tstep = 2 * hstep;
    const unsigned ldsw = (unsigned)wid * 1024u;
    const int aoff = lds_byte(wr * 64 + fr, fq * 8), boff = lds_byte(wc * 32 + fr, fq * 8);
#define PG8_SA(b, h) (((b) * 2 + (h)) * HTB)
#define PG8_SB(b, h) ((4 + (b) * 2 + (h)) * HTB)
#define PG8_STAGE(bufoff, gbase, voff) do { _Pragma("unroll") for (int _i = 0; _i < 2; ++_i) \
        __builtin_amdgcn_global_load_lds((const unsigned*)((const char*)(gbase) + (voff)[_i]), (PG8_LAS unsigned*)(lds + (bufoff) + ldsw + _i * 8192), 16, 0, 0); } while (0)
#define PG8_LDA(dst, b, h) do { _Pragma("unroll") for (int m = 0; m < 4; ++m) _Pragma("unroll") for (int k = 0; k < 2; ++k) dst[m][k] = *(const PG8_LAS bf16x8*)(lds + PG8_SA(b, h) + aoff + m * 2048 + k * 1024); } while (0)
#define PG8_LDB(dst, b, h) do { _Pragma("unroll") for (int n = 0; n < 2; ++n) _Pragma("unroll") for (int k = 0; k < 2; ++k) dst[n][k] = *(const PG8_LAS bf16x8*)(lds + PG8_SB(b, h) + boff + n * 2048 + k * 1024); } while (0)
#define PG8_MMA(ai, bj, At, Bt) do { __builtin_amdgcn_s_setprio(1); _Pragma("unroll") for (int m = 0; m < 4; ++m) _Pragma("unroll") for (int n = 0; n < 2; ++n) _Pragma("unroll") for (int k = 0; k < 2; ++k) \
        acc[ai][bj][m][n] = __builtin_amdgcn_mfma_f32_16x16x32_bf16(Bt[n][k], At[m][k], acc[ai][bj][m][n], 0, 0, 0); __builtin_amdgcn_s_setprio(0); } while (0)
#define PG8_WAIT_V(n) asm volatile("s_waitcnt vmcnt(" #n ")" ::: "memory")
#define PG8_WAIT_L(n) asm volatile("s_waitcnt lgkmcnt(" #n ")" ::: "memory")
#define PG8_BAR __builtin_amdgcn_s_barrier()
#define PG8_SCHED __builtin_amdgcn_sched_barrier(0)
    Unit cur, nxt; int ui = 0;
    if (!S.next(0, cur)) return;
    f32x4 acc[2][2][4][2];
#pragma unroll
    for (int a = 0; a < 2; ++a)
#pragma unroll
        for (int b = 0; b < 2; ++b)
#pragma unroll
            for (int m = 0; m < 4; ++m)
#pragma unroll
                for (int n = 0; n < 2; ++n) acc[a][b][m][n] = (f32x4){0.f, 0.f, 0.f, 0.f};
    bf16x8 At[4][2], B0[2][2], B1[2][2];
    const char* cA = (const char*)g.A + (size_t)cur.pm * tstep; const char* cB = (const char*)g.Bt + (size_t)cur.pn * tstep;
    S.a_ready(cur);
    if constexpr (SP2) {
        PG8_STAGE(PG8_SB(0, 0), cB, voffB); PG8_STAGE(PG8_SB(0, 1), cB + hstep, voffB); PG8_STAGE(PG8_SA(0, 0), cA, voffA); PG8_STAGE(PG8_SA(0, 1), cA + hstep, voffA);
        if (wr == 1) PG8_BAR;
        PG8_WAIT_V(2); PG8_BAR;
        PG8_STAGE(PG8_SB(1, 0), cB + kstep, voffB); PG8_STAGE(PG8_SA(1, 0), cA + kstep, voffA); PG8_STAGE(PG8_SB(1, 1), cB + hstep + kstep, voffB);
        PG8_WAIT_V(6); PG8_BAR;
    } else {
        PG8_STAGE(PG8_SB(0, 0), cB, voffB); PG8_STAGE(PG8_SA(0, 0), cA, voffA); PG8_STAGE(PG8_SB(0, 1), cB + hstep, voffB); PG8_STAGE(PG8_SA(0, 1), cA + hstep, voffA);
        if (wr == 1) PG8_BAR;
        PG8_WAIT_V(4); PG8_BAR;
        PG8_STAGE(PG8_SB(1, 0), cB + kstep, voffB); PG8_STAGE(PG8_SA(1, 0), cA + kstep, voffA); PG8_STAGE(PG8_SB(1, 1), cB + hstep + kstep, voffB);
        PG8_WAIT_V(6); PG8_BAR;
    }
    for (;;) {
        const bool has_next = S.next(ui + 1, nxt);
        const char* nA = has_next ? (const char*)g.A + (size_t)nxt.pm * tstep : cA; const char* nB = has_next ? (const char*)g.Bt + (size_t)nxt.pn * tstep : cB;
        for (int t = 0; t < nt; t += 2) {
            const bool last = (t == nt - 2);
            const char* a1 = cA + (size_t)(t + 1) * kstep;
            const char* a2 = last ? nA : cA + (size_t)(t + 2) * kstep; const char* b2 = last ? nB : cB + (size_t)(t + 2) * kstep;
            const char* a3 = a2 + kstep; const char* b3 = b2 + kstep;
            if (last && has_next) S.a_ready(nxt);
            if constexpr (SP2) {
            PG8_LDB(B0, 0, 0); PG8_LDB(B1, 0, 1); PG8_SCHED; PG8_LDA(At, 0, 0); PG8_STAGE(PG8_SA(1, 1), a1 + hstep, voffA);
            PG8_WAIT_V(8); PG8_WAIT_L(0); PG8_BAR; PG8_MMA(0, 0, At, B0); PG8_MMA(0, 1, At, B1); PG8_BAR; PG8_SCHED;
            PG8_LDA(At, 0, 1); PG8_STAGE(PG8_SB(0, 0), b2, voffB); PG8_STAGE(PG8_SB(0, 1), b2 + hstep, voffB); PG8_STAGE(PG8_SA(0, 0), a2, voffA);
            PG8_WAIT_V(8); PG8_WAIT_L(0); PG8_BAR; PG8_MMA(1, 0, At, B0); PG8_MMA(1, 1, At, B1); PG8_BAR; PG8_SCHED;
            PG8_LDB(B0, 1, 0); PG8_LDB(B1, 1, 1); PG8_SCHED; PG8_LDA(At, 1, 0); PG8_STAGE(PG8_SA(0, 1), a2 + hstep, voffA);
            PG8_WAIT_V(8); PG8_WAIT_L(0); PG8_BAR; PG8_MMA(0, 0, At, B0); PG8_MMA(0, 1, At, B1); PG8_BAR; PG8_SCHED;
            PG8_LDA(At, 1, 1); PG8_STAGE(PG8_SB(1, 0), b3, voffB); PG8_STAGE(PG8_SB(1, 1), b3 + hstep, voffB); PG8_STAGE(PG8_SA(1, 0), a3, voffA);
            PG8_WAIT_V(8); PG8_WAIT_L(0); PG8_BAR; PG8_MMA(1, 0, At, B0); PG8_MMA(1, 1, At, B1); PG8_BAR; PG8_SCHED;
            } else {
            PG8_LDB(B0, 0, 0); PG8_SCHED; PG8_LDA(At, 0, 0); PG8_STAGE(PG8_SA(1, 1), a1 + hstep, voffA);
            PG8_WAIT_L(8); PG8_BAR; PG8_WAIT_L(0); PG8_MMA(0, 0, At, B0); PG8_BAR; PG8_SCHED;
            PG8_LDB(B1, 0, 1); PG8_STAGE(PG8_SB(0, 0), b2, voffB);
            PG8_BAR; PG8_WAIT_L(0); PG8_MMA(0, 1, At, B1); PG8_BAR;
            PG8_LDA(At, 0, 1); PG8_STAGE(PG8_SA(0, 0), a2, voffA);
            PG8_BAR; PG8_WAIT_L(0); PG8_MMA(1, 0, At, B0); PG8_BAR; PG8_SCHED;
            PG8_STAGE(PG8_SB(0, 1), b2 + hstep, voffB);
            PG8_WAIT_V(6); PG8_BAR; PG8_MMA(1, 1, At, B1); PG8_BAR;
            PG8_LDB(B0, 1, 0); PG8_SCHED; PG8_LDA(At, 1, 0); PG8_STAGE(PG8_SA(0, 1), a2 + hstep, voffA);
            PG8_WAIT_L(8); PG8_BAR; PG8_WAIT_L(0); PG8_MMA(0, 0, At, B0); PG8_BAR; PG8_SCHED;
            PG8_LDB(B1, 1, 1); PG8_STAGE(PG8_SB(1, 0), b3, voffB);
            PG8_BAR; PG8_WAIT_L(0); PG8_MMA(0, 1, At, B1); PG8_BAR;
            PG8_LDA(At, 1, 1); PG8_STAGE(PG8_SA(1, 0), a3, voffA);
            PG8_BAR; PG8_WAIT_L(0); PG8_MMA(1, 0, At, B0); PG8_BAR; PG8_SCHED;
            PG8_STAGE(PG8_SB(1, 1), b3 + hstep, voffB);
            PG8_WAIT_V(6); PG8_BAR; PG8_MMA(1, 1, At, B1); PG8_BAR;
            }
        }
        if constexpr (ALIGN_EPI) { if (wr == 0) PG8_BAR; }
        if constexpr (!Epi::AFTER_DRAIN) { E(acc, cur, wr, wc, fr, fq); S.done(cur); }
        if (!has_next) break;
#pragma unroll
        for (int a = 0; a < 2; ++a)
#pragma unroll
            for (int b = 0; b < 2; ++b)
#pragma unroll
                for (int m = 0; m < 4; ++m)
#pragma unroll
                    for (int n = 0; n < 2; ++n) acc[a][b][m][n] = (f32x4){0.f, 0.f, 0.f, 0.f};
        cur = nxt; cA = nA; cB = nB; ++ui;
        if constexpr (ALIGN_EPI) { if (wr == 1) PG8_BAR; }
    }
    PG8_WAIT_V(0);
    if constexpr (!ALIGN_EPI) { if (wr == 0) PG8_BAR; }
    PG8_BAR;
    if constexpr (Epi::AFTER_DRAIN) { E.fused(acc, cur, wr, wc, fr, fq, lds, wid, lane); S.done(cur); }
#undef PG8_SA
#undef PG8_SB
#undef PG8_STAGE
#undef PG8_LDA
#undef PG8_LDB
#undef PG8_MMA
#undef PG8_WAIT_V
#undef PG8_WAIT_L
#undef PG8_BAR
#undef PG8_SCHED
}
}
constexpr int NWAVES = 8, NTHREADS = 512;
constexpr int D = 1024, MP = 16384, MS = 1024, M = MP + MS, NSEQ = 136, FF = 2816;
constexpr int PSEQ = 2048, SSEQ = 8, NPB = 8, NSB = 128;
constexpr int ZW = 3328;
constexpr int ZQ = 0, ZK = 512, ZV = 1024, ZO = 1536, ZXR = 2048, ZGR = 2560, ZIG = 3072, ZFG = 3076;
constexpr int RKW = 3072, WAGW = 3072;
constexpr float ALPHA = 1.41421356237f;
constexpr float LN_EPS = 1e-5f, HEAD_EPS = 1e-6f, RW_EPS = 64e-5f;
constexpr float MSCALE = 0.08838834764831845f;

constexpr size_t O_Y = 0, O_PMC = 17825792, O_PMN = 18350080, O_PMM = 18354176, O_PRH = 18354208, O_PRC = 18358304, O_PWKV = 18370592, O_PSH = 18894880,
                 O_SMC = 18903072, O_SMN = 27291680, O_SMM = 27357216, O_SRH = 27357728, O_SRC = 27423264, O_SWKV = 27619872, O_SSH = 36008480, O_END = 36139552;

constexpr size_t MiB = 1u << 20;
constexpr size_t WS_CTL = 0, CTL_ZERO_BYTES = 1 * MiB;
constexpr size_t WS_W13 = 1 * MiB;
constexpr size_t WS_W2 = 45 * MiB;
constexpr size_t WS_WIN = 67 * MiB;
constexpr size_t WS_WOUT = WS_WIN + 6815744;
constexpr size_t WS_WRK = WS_WOUT + 2 * MiB;
constexpr size_t WS_WL2 = WS_WRK + 13 * MiB;
constexpr size_t WS_WO = WS_WL2 + 1572864;
constexpr size_t WS_MOD = 92 * MiB;
constexpr size_t WS_H = 102 * MiB;
constexpr size_t WS_BIG = 136 * MiB;
constexpr size_t WS_HID = WS_BIG;
constexpr size_t WS_Z = WS_BIG;
constexpr size_t WS_CST = WS_BIG + 111 * MiB;
constexpr size_t WS_RGH = WS_BIG + 143 * MiB;
constexpr size_t WS_RGP = WS_BIG + 175 * MiB;
constexpr size_t WS_NST = WS_BIG + 207 * MiB;
constexpr size_t WS_MST = WS_NST + 262144;
constexpr size_t WS_CARRY = WS_MST + 8192;
constexpr size_t WS_RK = WS_BIG;
constexpr size_t WS_A3 = WS_BIG + 102 * MiB;
constexpr size_t WS_A2 = WS_BIG + 111 * MiB;
constexpr size_t WS_WAG = WS_BIG + 111 * MiB;
constexpr size_t WS_END = WS_BIG + 213 * MiB;
static_assert(WS_WO + 2 * MiB <= WS_MOD && WS_MOD + (size_t)2 * 136 * 9216 * 4 <= WS_H && WS_H + (size_t)M * D * 2 <= WS_BIG, "ws map");
static_assert(WS_CARRY + 8 * 64 * 512 * 4 <= WS_END && WS_WAG + (size_t)M * WAGW * 2 <= WS_END && WS_A3 + (size_t)M * 256 * 2 <= WS_A2, "ws map 2");
constexpr int CW_BAR = 4096;

constexpr int LDS_BYTES = 147456;
constexpr int LDSCTL_OFF = LDS_BYTES - 512;
constexpr int MISC_OFF = LDSCTL_OFF;

#define GAS __attribute__((address_space(1)))
#define LAS __attribute__((address_space(3)))
typedef unsigned short bf16;
typedef unsigned v4u __attribute__((ext_vector_type(4)));
typedef unsigned v2u __attribute__((ext_vector_type(2)));
typedef float f32x4 __attribute__((ext_vector_type(4)));
typedef float f32x2 __attribute__((ext_vector_type(2)));
typedef float f32x16 __attribute__((ext_vector_type(16)));
typedef short bf16x8 __attribute__((ext_vector_type(8)));
typedef GAS unsigned gu32;
#define RLX_AGENT __ATOMIC_RELAXED, __HIP_MEMORY_SCOPE_AGENT
#define LDS_WAIT() asm volatile("s_waitcnt lgkmcnt(0)" ::: "memory")
#define DI __device__ __forceinline__
#define MFMA32(a, b, c) __builtin_amdgcn_mfma_f32_32x32x16_bf16((a), (b), (c), 0, 0, 0)
DI unsigned f2bf(float f) { unsigned u = __builtin_bit_cast(unsigned, f); return (u + 0x7fffu + ((u >> 16) & 1u)) >> 16; }
DI unsigned pk2(float lo, float hi) { return pg8::cvt_pk_bf16(lo, hi); }
DI float bf2f(unsigned b) { return __builtin_bit_cast(float, b << 16); }
DI float bflo(unsigned w) { return __builtin_bit_cast(float, w << 16); }
DI float bfhi(unsigned w) { return __builtin_bit_cast(float, w & 0xffff0000u); }
DI int crow(int reg, int h) { return (reg & 3) + 8 * (reg >> 2) + 4 * h; }
DI float fexp(float x) { return __builtin_amdgcn_exp2f(1.44269504f * x); }
DI float fsig(float x) { return pg8::fsig(x); }
DI bf16x8 mk_frag(unsigned a, unsigned b, unsigned c, unsigned d) { v4u p; p.x = a; p.y = b; p.z = c; p.w = d; return __builtin_bit_cast(bf16x8, p); }
DI bf16x8 pack8(const float (&v)[8]) { return mk_frag(pk2(v[0], v[1]), pk2(v[2], v[3]), pk2(v[4], v[5]), pk2(v[6], v[7])); }
DI float wave_sum(float v) {
#pragma unroll
    for (int o = 1; o < 64; o <<= 1) v += __shfl_xor(v, o);
    return v;
}

#define XB_TMO      128
#define XB_XCNT(j)  (256  + 64 * (j))
#define XB_XSUB(j)  (1280 + 64 * (j))
#define XB_XGEN(j)  (2304 + 64 * (j))
#define XB_TOP      3328
#define XB_TOPGEN   3392
#define XCD_BAR_WORDS 3456
#define XB_SPIN_CAP (1u << 18)

__device__ __forceinline__ unsigned xb_ld(unsigned* p)              { return __hip_atomic_load(p, __ATOMIC_RELAXED, __HIP_MEMORY_SCOPE_AGENT); }
__device__ __forceinline__ unsigned xb_add(unsigned* p, unsigned v) { return __hip_atomic_fetch_add(p, v, __ATOMIC_RELAXED, __HIP_MEMORY_SCOPE_AGENT); }
__device__ __forceinline__ unsigned xb_xcc_id() { return (unsigned)__builtin_amdgcn_s_getreg((3 << 11) | 20) & 0xFu; }
#define XB_SPIN(cond, bar) do { unsigned _sp = 0; while (cond) { __builtin_amdgcn_s_sleep(1); \
    if ((++_sp & 255u) == 0u) { if (xb_ld(&(bar)[XB_TMO])) break; if (_sp > XB_SPIN_CAP) { atomicAdd(&(bar)[XB_TMO], 1u); break; } } } } while (0)

struct XcdBarrier {
    unsigned* bar; unsigned x;
    volatile LAS unsigned* st;
};

__device__ __forceinline__ XcdBarrier xcd_barrier_post(unsigned* bar, volatile LAS unsigned* st) {
    XcdBarrier b; b.bar = bar; b.x = xb_xcc_id(); b.st = st;
    if (threadIdx.x == 0) (void)xb_add(&bar[XB_XCNT(b.x)], 1u);
    return b;
}
__device__ __forceinline__ void xcd_barrier_complete(unsigned* bar, unsigned x, unsigned& nloc, unsigned& nx) {
    const unsigned G = gridDim.x * gridDim.y * gridDim.z;
    unsigned sum, cnt, mine, sp = 0u;
    for (;;) {
        sum = 0u; cnt = 0u; mine = 0u;
#pragma unroll
        for (unsigned j = 0; j < 16; ++j) { const unsigned c = xb_ld(&bar[XB_XCNT(j)]); sum += c; cnt += (c > 0u) ? 1u : 0u; mine = (j == x) ? c : mine; }
        if (sum == G) break;
        __builtin_amdgcn_s_sleep(1);
        if ((++sp & 255u) == 0u) { if (xb_ld(&bar[XB_TMO])) break; if (sp > XB_SPIN_CAP) { atomicAdd(&bar[XB_TMO], 1u); break; } }
    }
    nloc = mine > 0u ? mine : 1u; nx = cnt > 0u ? cnt : 1u;
}

__device__ __forceinline__ void xcd_barrier(const XcdBarrier& b) {
    asm volatile("s_waitcnt vmcnt(0)" ::: "memory");
    __syncthreads();
    if (threadIdx.x == 0) {
        unsigned* bar = b.bar;
        __builtin_amdgcn_s_waitcnt(0);
        unsigned nloc = b.st[0], nx = b.st[1];
        if (nloc == 0u) { xcd_barrier_complete(bar, b.x, nloc, nx); b.st[0] = nloc; b.st[1] = nx; }
        const unsigned old = xb_add(&bar[XB_XSUB(b.x)], 1u);
        const unsigned gen = old / nloc;
        if (old + 1u == (gen + 1u) * nloc) {
            __builtin_amdgcn_fence(__ATOMIC_RELEASE, "agent");
            asm volatile("s_waitcnt vmcnt(0)" ::: "memory");
            const unsigned og = xb_add(&bar[XB_TOP], 1u);
            const unsigned tg = og / nx;
            if (og + 1u == (tg + 1u) * nx) xb_add(&bar[XB_TOPGEN], 1u);
            else XB_SPIN(xb_ld(&bar[XB_TOPGEN]) == tg, bar);
            __builtin_amdgcn_fence(__ATOMIC_ACQUIRE, "agent");
            xb_add(&bar[XB_XGEN(b.x)], 1u);
            asm volatile("s_waitcnt vmcnt(0)" ::: "memory");
        } else {
            XB_SPIN(xb_ld(&bar[XB_XGEN(b.x)]) == gen, bar);
            __builtin_amdgcn_fence(__ATOMIC_ACQUIRE, "agent");
            asm volatile("s_waitcnt vmcnt(0)" ::: "memory");
        }
    }
    __syncthreads();
}
struct Args { const float* in[47]; float* out; unsigned char* ws; int ph_lo, ph_hi; };
struct Frame {
    LAS unsigned char* lds;
    volatile LAS unsigned* MISC;
    gu32* ctl;
    int tid, lane, wave;
    int vcu, G;
    float* out;
    unsigned char* ws;
};
enum { I_XP = 0, I_XS, I_CP, I_CS, I_SMC, I_SMN, I_SMM, I_SRH, I_SRC, I_SWKV, I_SSH, I_ADAW, I_ADAB, I_LNG, I_LNB, I_W1, I_W3, I_W2, I_WIN, I_BG, I_MNG,
       I_CW, I_CB, I_WA, I_BA, I_WX, I_BX, I_LAM, I_WOUT, I_MU, I_WR, I_WK, I_WV, I_W0, I_LW1, I_LW2, I_A0, I_A1, I_A2, I_G1, I_G2, I_KK, I_KA, I_RK, I_LXG, I_LXB, I_WO };

DI void p0_mod(Frame& F, const Args& AR) {
    LAS float* T = (LAS float*)F.lds;
    const int r = F.lane & 31, hh = F.lane >> 5;
    const float* adaw = AR.in[I_ADAW]; const float* adab = AR.in[I_ADAB];
    float* mod = (float*)(F.ws + WS_MOD);
    for (int nb = F.vcu; nb < 576; nb += F.G) {
        for (int i = F.tid; i < 160 * 33; i += NTHREADS) T[i] = 0.f;
        __syncthreads();
        const int n0 = nb * 32, l = n0 / 9216, nc0 = n0 - l * 9216;
        const float* W = adaw + (size_t)l * 1024 * 9216 + nc0 + r;
        f32x16 acc[5];
#pragma unroll
        for (int mb = 0; mb < 5; ++mb)
#pragma unroll
            for (int i = 0; i < 16; ++i) acc[mb][i] = 0.f;
#pragma unroll 2
        for (int ks = 0; ks < 8; ++ks) {
            const int k0 = F.wave * 128 + ks * 16 + 8 * hh;
            float a[8];
#pragma unroll
            for (int j = 0; j < 8; ++j) a[j] = W[(size_t)(k0 + j) * 9216];
            const bf16x8 A = pack8(a);
#pragma unroll
            for (int mb = 0; mb < 5; ++mb) {
                const int m = mb * 32 + r;
                float c[8];
                if (m < NSEQ) {
                    const float* cp = (m < NPB ? AR.in[I_CP] + (size_t)m * D : AR.in[I_CS] + (size_t)(m - NPB) * D) + k0;
                    const f32x4 c0 = *(const f32x4*)cp, c1 = *(const f32x4*)(cp + 4);
                    c[0] = c0[0]; c[1] = c0[1]; c[2] = c0[2]; c[3] = c0[3]; c[4] = c1[0]; c[5] = c1[1]; c[6] = c1[2]; c[7] = c1[3];
#pragma unroll
                    for (int j = 0; j < 8; ++j) c[j] = c[j] * fsig(c[j]);
                } else {
#pragma unroll
                    for (int j = 0; j < 8; ++j) c[j] = 0.f;
                }
                acc[mb] = MFMA32(A, pack8(c), acc[mb]);
            }
        }
#pragma unroll
        for (int mb = 0; mb < 5; ++mb)
#pragma unroll
            for (int i = 0; i < 16; ++i) __hip_atomic_fetch_add(&T[(mb * 32 + r) * 33 + crow(i, hh)], acc[mb][i], __ATOMIC_RELAXED, __HIP_MEMORY_SCOPE_WORKGROUP);
        __syncthreads();
        for (int m = F.tid >> 5; m < NSEQ; m += 16) { const int n = F.tid & 31; mod[(size_t)(l * NSEQ + m) * 9216 + nc0 + n] = T[m * 33 + n] + adab[l * 9216 + nc0 + n]; }
        __syncthreads();
    }
}

DI void tr_item(const float* src, int ld, int nvalid, const float* sc, int scmode, bf16* dst, int dld, LAS float* scr, int lane) {
#pragma unroll 8
    for (int i = 0; i < 32; ++i) { const int kk = 2 * i + (lane >> 5), n = lane & 31; float v = 0.f;
        if (src != nullptr && n < nvalid) { v = src[(size_t)kk * ld + n]; if (scmode == 1) v *= sc[kk]; else if (scmode == 2) v *= (1.0f - sc[kk]); }
        scr[kk * 33 + n] = v; }
    LDS_WAIT(); asm volatile("" ::: "memory");
    const int c = lane & 7;
#pragma unroll
    for (int j = 0; j < 4; ++j) { const int n = (lane >> 3) + 8 * j; const LAS float* s = scr + (8 * c) * 33 + n;
        v4u o; o.x = pk2(s[0 * 33], s[1 * 33]); o.y = pk2(s[2 * 33], s[3 * 33]); o.z = pk2(s[4 * 33], s[5 * 33]); o.w = pk2(s[6 * 33], s[7 * 33]);
        *(GAS v4u*)(dst + (size_t)n * dld + 8 * c) = o; }
    LDS_WAIT(); asm volatile("" ::: "memory");
}
DI void p0_weights(Frame& F, const Args& AR) {
    LAS float* scr = (LAS float*)(F.lds + 32768 + F.wave * 8704);
    const int gw = F.vcu * NWAVES + F.wave, NGW = F.G * NWAVES;
    constexpr int I_13 = 16 * 176, I_2 = 44 * 32, I_IN = 16 * 104, I_SQ = 16 * 32, I_RKI = 32 * 104, I_L2 = 4 * 96;
    constexpr int NITEMS = 4 * I_13 + 4 * I_2 + I_IN + 2 * I_SQ + I_RKI + I_L2;
    bf16* W13 = (bf16*)(F.ws + WS_W13); bf16* W2 = (bf16*)(F.ws + WS_W2); bf16* WIN = (bf16*)(F.ws + WS_WIN); bf16* WOUT = (bf16*)(F.ws + WS_WOUT);
    bf16* WRK = (bf16*)(F.ws + WS_WRK); bf16* WL2 = (bf16*)(F.ws + WS_WL2); bf16* WO = (bf16*)(F.ws + WS_WO);
    for (int it = gw; it < NITEMS; it += NGW) {
        int r = it;
        if (r < 4 * I_13) { const int f = r / I_13; r -= f * I_13; const int kt = r / 176, tn = r % 176, j = tn >> 3, i = tn & 7;
            const float* src = (i < 4 ? AR.in[I_W1] : AR.in[I_W3]) + (size_t)f * 1024 * FF + (size_t)(64 * kt) * FF + 128 * j + 32 * (i & 3);
            tr_item(src, FF, 32, nullptr, 0, W13 + (size_t)f * 5632 * 1024 + (size_t)(32 * tn) * 1024 + 64 * kt, 1024, scr, F.lane); continue; }
        r -= 4 * I_13;
        if (r < 4 * I_2) { const int f = r / I_2; r -= f * I_2; const int kt = r / 32, tn = r % 32;
            const float* src = AR.in[I_W2] + (size_t)f * FF * 1024 + (size_t)(64 * kt) * 1024 + 32 * tn;
            tr_item(src, 1024, 32, nullptr, 0, W2 + (size_t)f * 1024 * FF + (size_t)(32 * tn) * FF + 64 * kt, FF, scr, F.lane); continue; }
        r -= 4 * I_2;
        if (r < I_IN) { const int kt = r / 104, tn = r % 104, nd = 32 * tn; int sc0 = 0, nv = 32; bool has = true;
            if (nd < 2048) sc0 = nd; else if (nd < 3072) sc0 = nd + 8; else if (nd == 3072) { sc0 = 2048; nv = 8; } else has = false;
            const float* src = has ? AR.in[I_WIN] + (size_t)(64 * kt) * 3080 + sc0 : nullptr;
            tr_item(src, 3080, nv, nullptr, 0, WIN + (size_t)nd * 1024 + 64 * kt, 1024, scr, F.lane); continue; }
        r -= I_IN;
        if (r < 2 * I_SQ) { const int w = r / I_SQ; r -= w * I_SQ; const int kt = r / 32, tn = r % 32;
            const float* src = (w == 0 ? AR.in[I_WOUT] : AR.in[I_WO]) + (size_t)(64 * kt) * 1024 + 32 * tn;
            tr_item(src, 1024, 32, nullptr, 0, (w == 0 ? WOUT : WO) + (size_t)(32 * tn) * 1024 + 64 * kt, 1024, scr, F.lane); continue; }
        r -= 2 * I_SQ;
        if (r < I_RKI) { const int kt = r / 104, tn = r % 104, nd = 32 * tn, kd = 64 * kt, half = kd >= 1024, ks = kd & 1023;
            const float* base; int ld, col, mi;
            if (nd < 1024) { base = AR.in[I_WR]; ld = 1024; col = nd; mi = 0; }
            else if (nd < 2048) { base = AR.in[I_WK]; ld = 1024; col = nd - 1024; mi = 2; }
            else if (nd < 3072) { base = AR.in[I_WV]; ld = 1024; col = nd - 2048; mi = 3; }
            else if (nd < 3136) { base = AR.in[I_LW1]; ld = 64; col = nd - 3072; mi = 1; }
            else if (nd < 3200) { base = AR.in[I_A1]; ld = 64; col = nd - 3136; mi = 4; }
            else { base = AR.in[I_G1]; ld = 128; col = nd - 3200; mi = 5; }
            tr_item(base + (size_t)ks * ld + col, ld, 32, AR.in[I_MU] + mi * 1024 + ks, half ? 1 : 2, WRK + (size_t)nd * 2048 + kd, 2048, scr, F.lane); continue; }
        r -= I_RKI;
        { const int kt = r / 96, tn = r % 96, nd = 32 * tn; const float* src = nullptr;
            if (nd < 1024) { if (kt == 0) src = AR.in[I_LW2] + nd; }
            else if (nd < 2048) { if (kt == 1) src = AR.in[I_A2] + (nd - 1024); }
            else { if (kt >= 2) src = AR.in[I_G2] + (size_t)(64 * (kt - 2)) * 1024 + (nd - 2048); }
            tr_item(src, 1024, 32, nullptr, 0, WL2 + (size_t)nd * 256 + 64 * kt, 256, scr, F.lane); }
    }
}

DI void ln_pass(Frame& F, const Args& AR, int first, int do_ln, int l, int sub, int lm, int js, int mode) {
    const int gw = F.vcu * NWAVES + F.wave, NGW = F.G * NWAVES, lane = F.lane;
    float* X = F.out + O_Y;
    const float* lg = AR.in[I_LNG] + (l * 3 + sub) * 1024; const float* lb = AR.in[I_LNB] + (l * 3 + sub) * 1024;
    const float* mod = (const float*)(F.ws + WS_MOD);
    bf16* H = (bf16*)(F.ws + WS_H); bf16* A2 = (bf16*)(F.ws + WS_A2);
    for (int r = gw; r < M; r += NGW) {
        const float* src = first ? (r < MP ? AR.in[I_XP] + (size_t)r * D : AR.in[I_XS] + (size_t)(r - MP) * D) : X + (size_t)r * D;
        f32x4 v[4];
#pragma unroll
        for (int j = 0; j < 4; ++j) v[j] = ((const f32x4*)src)[lane + 64 * j];
        if (do_ln) {
            float s = 0.f;
#pragma unroll
            for (int j = 0; j < 4; ++j) s += (v[j].x + v[j].y) + (v[j].z + v[j].w);
            const float mean = wave_sum(s) * (1.f / D); float s2 = 0.f;
#pragma unroll
            for (int j = 0; j < 4; ++j) { v[j] = v[j] - mean; s2 += (v[j].x * v[j].x + v[j].y * v[j].y) + (v[j].z * v[j].z + v[j].w * v[j].w); }
            const float rstd = 1.f / sqrtf(wave_sum(s2) * (1.f / D) + LN_EPS);
#pragma unroll
            for (int j = 0; j < 4; ++j) { const f32x4 g4 = ((const f32x4*)lg)[lane + 64 * j], b4 = ((const f32x4*)lb)[lane + 64 * j]; v[j] = v[j] * rstd * g4 + b4;
                ((f32x4*)(X + (size_t)r * D))[lane + 64 * j] = v[j]; }
        }
        if (mode != 2) {
            const int mr = pg8::mod_row(r);
            const float* sh = mod + ((size_t)(lm * NSEQ + mr) * 9 + js) * 1024; const float* sc = sh + 1024;
            int t, len, b; if (r < MP) { t = r & (PSEQ - 1); len = PSEQ; b = r >> 11; } else { t = (r - MP) & (SSEQ - 1); len = SSEQ; b = (r - MP) >> 3; }
#pragma unroll
            for (int j = 0; j < 4; ++j) { const f32x4 s4 = ((const f32x4*)sc)[lane + 64 * j], h4 = ((const f32x4*)sh)[lane + 64 * j];
                const f32x4 h = v[j] * (s4 + 1.0f) + h4; v2u w; w.x = pk2(h.x, h.y); w.y = pk2(h.z, h.w); const int col = 4 * (lane + 64 * j);
                if (mode == 0) *(v2u*)(H + (size_t)r * D + col) = w;
                else {
                    *(v2u*)(A2 + (size_t)r * 2048 + col) = w;
                    if (t + 1 < len) *(v2u*)(A2 + (size_t)(r + 1) * 2048 + 1024 + col) = w;
                    if (t == 0) { v2u p; p.x = 0u; p.y = 0u;
                        if (r >= MP) { const f32x4 q = *(const f32x4*)(AR.in[I_SSH] + (size_t)b * D + col); p.x = pk2(q.x, q.y); p.y = pk2(q.z, q.w); }
                        *(v2u*)(A2 + (size_t)r * 2048 + 1024 + col) = p; }
                    if (t == len - 1) *(f32x4*)(F.out + (r < MP ? O_PSH : O_SSH) + (size_t)b * D + col) = h;
                } }
        }
    }
}

DI float log_sigmoid(float x) { return -(fmaxf(-x, 0.f) + log1pf(__expf(-fabsf(x)))); }
DI float gelu_tanh(float x) { const float u = 0.7978845608f * (x + 0.044715f * x * x * x); return 0.5f * x * (1.0f + pg8::ftanh(u)); }

DI void ml1_prompt(Frame& F, const Args& AR) {
    const bf16* Z = (const bf16*)(F.ws + WS_Z);
    float* CST = (float*)(F.ws + WS_CST); float* NST = (float*)(F.ws + WS_NST); float* MST = (float*)(F.ws + WS_MST);
    LAS bf16* Ks = (LAS bf16*)F.lds;
    LAS bf16* Vs = (LAS bf16*)(F.lds + 32768);
    LAS float* LF = (LAS float*)(F.lds + 65536);
    LAS float* GS = (LAS float*)(F.lds + 65536 + 512);
    LAS float* RED = (LAS float*)(F.lds + 65536 + 1024);
    const int tid = F.tid, lane = F.lane, wave = F.wave, r = lane & 31, hh = lane >> 5;
    for (int item = F.vcu; item < 512; item += F.G) {
        const int b = item >> 6, h = (item >> 4) & 3, c = item & 15; const size_t row0 = (size_t)b * PSEQ + c * 128;
#pragma unroll
        for (int i = 0; i < 4; ++i) { const int e = tid + i * NTHREADS, s = e >> 4, c8 = (e & 15) * 8;
            *(LAS v4u*)(Ks + s * 128 + c8) = *(const v4u*)(Z + (row0 + s) * ZW + ZK + h * 128 + c8);
            *(LAS v4u*)(Vs + s * 128 + c8) = *(const v4u*)(Z + (row0 + s) * ZW + ZV + h * 128 + c8); }
        if (tid < 128) { const float fg = bf2f(Z[(row0 + tid) * ZW + ZFG + h]); LF[tid] = log_sigmoid(fg + AR.in[I_BG][4 + h]); }
        __syncthreads();
        if (tid < 128) { float bs = 0.f; for (int s = 0; s <= tid; ++s) bs += LF[s];
            const float ig = bf2f(Z[(row0 + tid) * ZW + ZIG + h]) + AR.in[I_BG][h];
            GS[tid] = ig - bs; if (tid == 127) RED[0] = bs; }
        __syncthreads();
        float gmax = -INFINITY; for (int s = 0; s < 128; ++s) gmax = fmaxf(gmax, GS[s]);
        const float bL = RED[0];
        __syncthreads();
        if (tid < 128) GS[tid] = fexp(GS[tid] - gmax);
        __syncthreads();
        const int vb = wave >> 1, kb0 = 2 * (wave & 1);
        f32x16 acc[2];
#pragma unroll
        for (int i = 0; i < 16; ++i) { acc[0][i] = 0.f; acc[1][i] = 0.f; }
#pragma unroll 2
        for (int ks = 0; ks < 8; ++ks) { const int s0 = 16 * ks + 8 * hh;
            float a[8];
#pragma unroll
            for (int j = 0; j < 8; ++j) a[j] = bf2f(Vs[(s0 + j) * 128 + vb * 32 + r]) * GS[s0 + j];
            const bf16x8 A = pack8(a);
#pragma unroll
            for (int q = 0; q < 2; ++q) { unsigned kw[8];
#pragma unroll
                for (int j = 0; j < 8; ++j) kw[j] = Ks[(s0 + j) * 128 + (kb0 + q) * 32 + r];
                const bf16x8 B = mk_frag(kw[0] | (kw[1] << 16), kw[2] | (kw[3] << 16), kw[4] | (kw[5] << 16), kw[6] | (kw[7] << 16));
                acc[q] = MFMA32(A, B, acc[q]); } }
        float* Co = CST + (size_t)item * 16384;
#pragma unroll
        for (int q = 0; q < 2; ++q)
#pragma unroll
            for (int i = 0; i < 16; ++i) Co[(vb * 32 + crow(i, hh)) * 128 + (kb0 + q) * 32 + r] = acc[q][i] * MSCALE;
        if (tid < 128) { float n = 0.f; for (int s = 0; s < 128; ++s) n += GS[s] * bf2f(Ks[s * 128 + tid]); NST[item * 128 + tid] = n * MSCALE; }
        if (tid == 0) { MST[item * 4 + 0] = bL + gmax; MST[item * 4 + 1] = bL; }
        __syncthreads();
    }
}

DI void ml_sample(Frame& F, const Args& AR) {
    const bf16* Z = (const bf16*)(F.ws + WS_Z); bf16* G = (bf16*)(F.ws + WS_H);
    LAS float* Qs = (LAS float*)F.lds;
    LAS float* Ks = Qs + 1024; LAS float* Vs = Ks + 1024;
    LAS float* HT = Vs + 1024;
    LAS float* P = HT + 1024;
    LAS float* GT = P + 64;
    LAS float* SC = GT + 64;
    const int tid = F.tid, lane = F.lane, wave = F.wave;
    const float* C0g = AR.in[I_SMC]; const float* n0g = AR.in[I_SMN]; const float* m0g = AR.in[I_SMM];
    for (int item = F.vcu; item < 512; item += F.G) {
        const int b = item >> 2, h = item & 3; const size_t row0 = (size_t)MP + (size_t)b * SSEQ;
        for (int e = tid; e < 3 * 512; e += NTHREADS) { const int w = e >> 9, t = (e >> 6) & 7, c2 = (e & 63) * 2;
            const unsigned u = *(const unsigned*)(Z + (row0 + t) * ZW + (w == 0 ? ZQ : (w == 1 ? ZK : ZV)) + h * 128 + c2);
            LAS float* dst = (w == 0 ? Qs : (w == 1 ? Ks : Vs)) + t * 128 + c2; dst[0] = bflo(u); dst[1] = bfhi(u); }
        const float m0 = m0g[b * 4 + h];
        if (tid < 8) { float bs = 0.f, bsl = 0.f;
            for (int s = 0; s < 8; ++s) { const float lf = log_sigmoid(bf2f(Z[(row0 + s) * ZW + ZFG + h]) + AR.in[I_BG][4 + h]); bs += lf; if (s <= tid) bsl = bs; }
            float mx = m0, gme = 0.f;
            for (int s = 0; s < 8; ++s) { float bq = 0.f; for (int q = 0; q <= s; ++q) bq += log_sigmoid(bf2f(Z[(row0 + q) * ZW + ZFG + h]) + AR.in[I_BG][4 + h]);
                const float g = bf2f(Z[(row0 + s) * ZW + ZIG + h]) + AR.in[I_BG][h] - bq; if (s <= tid) mx = fmaxf(mx, g); if (s == tid) gme = g; }
            GT[0 * 8 + tid] = bsl; GT[1 * 8 + tid] = gme; GT[2 * 8 + tid] = mx; GT[3 * 8 + tid] = fexp(m0 - mx);
            if (tid == 7) { const float mend = bsl + mx; SC[0] = mend; SC[1] = fexp(bsl + m0 - mend); } }
        __syncthreads();
        if (tid < 8) { const float mend = SC[0]; GT[5 * 8 + tid] = fexp(GT[0 * 8 + 7] + GT[1 * 8 + tid] - mend); }
        if (tid < 64) { const int t = tid >> 3, s = tid & 7; float d = 0.f;
            if (s <= t) { for (int k = 0; k < 128; ++k) d += Qs[t * 128 + k] * Ks[s * 128 + k]; d = d * MSCALE * fexp(GT[1 * 8 + s] - GT[2 * 8 + t]); }
            P[t * 8 + s] = d; }
        else if (tid < 72) { const int t = tid - 64; float d = 0.f; for (int k = 0; k < 128; ++k) d += Qs[t * 128 + k] * n0g[(size_t)(b * 4 + h) * 128 + k]; GT[6 * 8 + t] = d; }
        __syncthreads();
        if (tid < 8) { float d = 0.f; for (int s = 0; s < 8; ++s) d += P[tid * 8 + s]; d += GT[3 * 8 + tid] * GT[6 * 8 + tid];
            const float mt = GT[0 * 8 + tid] + GT[2 * 8 + tid]; GT[4 * 8 + tid] = fmaxf(fabsf(d), fexp(-mt)); }
        const int v = tid >> 2, seg = tid & 3;
        const float* C0p = C0g + ((size_t)(b * 4 + h) * 128 + v) * 128 + seg * 32;
        float c0[32];
#pragma unroll
        for (int i = 0; i < 8; ++i) { const f32x4 q = *(const f32x4*)(C0p + 4 * i); c0[4 * i] = q.x; c0[4 * i + 1] = q.y; c0[4 * i + 2] = q.z; c0[4 * i + 3] = q.w; }
        __syncthreads();
        float inter[8];
#pragma unroll
        for (int t = 0; t < 8; ++t) { float d = 0.f;
#pragma unroll
            for (int i = 0; i < 32; ++i) d += c0[i] * Qs[t * 128 + seg * 32 + i];
            d += __shfl_xor(d, 1); d += __shfl_xor(d, 2); inter[t] = d; }
        if (seg == 0) {
#pragma unroll
            for (int t = 0; t < 8; ++t) { float num = GT[3 * 8 + t] * inter[t];
                for (int s = 0; s <= t; ++s) num += P[t * 8 + s] * Vs[s * 128 + v];
                HT[t * 128 + v] = num / GT[4 * 8 + t]; } }
        { const float wst = SC[1]; float* Cout = F.out + O_SMC + ((size_t)(b * 4 + h) * 128 + v) * 128 + seg * 32;
#pragma unroll
            for (int i = 0; i < 32; ++i) c0[i] *= wst;
#pragma unroll
            for (int s = 0; s < 8; ++s) { const float wv = GT[5 * 8 + s] * Vs[s * 128 + v] * MSCALE;
#pragma unroll
                for (int i = 0; i < 32; ++i) c0[i] += wv * Ks[s * 128 + seg * 32 + i]; }
#pragma unroll
            for (int i = 0; i < 8; ++i) { f32x4 q; q.x = c0[4 * i]; q.y = c0[4 * i + 1]; q.z = c0[4 * i + 2]; q.w = c0[4 * i + 3]; *(f32x4*)(Cout + 4 * i) = q; } }
        if (tid < 128) { float n = SC[1] * n0g[(size_t)(b * 4 + h) * 128 + tid];
            for (int s = 0; s < 8; ++s) n += GT[5 * 8 + s] * Ks[s * 128 + tid] * MSCALE;
            F.out[O_SMN + (size_t)(b * 4 + h) * 128 + tid] = n; }
        if (tid == 0) F.out[O_SMM + b * 4 + h] = SC[0];
        __syncthreads();
        { const int t = wave; const float x0 = HT[t * 128 + lane], x1 = HT[t * 128 + 64 + lane];
            const float mean = wave_sum(x0 + x1) * (1.f / 128.f); const float d0 = x0 - mean, d1 = x1 - mean;
            const float rstd = 1.f / sqrtf(wave_sum(d0 * d0 + d1 * d1) * (1.f / 128.f) + HEAD_EPS);
            const size_t row = row0 + t;
            const float o0 = bf2f(Z[row * ZW + ZO + h * 128 + lane]), o1 = bf2f(Z[row * ZW + ZO + h * 128 + 64 + lane]);
            const float g0 = AR.in[I_MNG][h * 128 + lane], g1 = AR.in[I_MNG][h * 128 + 64 + lane];
            G[row * D + h * 128 + lane] = (bf16)f2bf(d0 * rstd * g0 * fsig(o0)); G[row * D + h * 128 + 64 + lane] = (bf16)f2bf(d1 * rstd * g1 * fsig(o1)); }
        __syncthreads();
    }
}

DI void rg1(Frame& F, const Args& AR) {
    const bf16* Z = (const bf16*)(F.ws + WS_Z); bf16* G = (bf16*)(F.ws + WS_H);
    float* RGH = (float*)(F.ws + WS_RGH); float* RGP = (float*)(F.ws + WS_RGP);
    const int lane = F.lane, g = F.wave, r = lane & 31, hh = lane >> 5;
    LAS float* XT = (LAS float*)(F.lds + g * 17408);
    LAS float* AT = XT + 32 * 68;
    const float* wa = AR.in[I_WA] + (size_t)g * 4096; const float* wx = AR.in[I_WX] + (size_t)g * 4096;
    float spl[2], ba[2], bx[2];
#pragma unroll
    for (int cb = 0; cb < 2; ++cb) { const int c = 64 * g + cb * 32 + r; spl[cb] = -8.0f * log1pf(__expf(-AR.in[I_LAM][c])); ba[cb] = AR.in[I_BA][c]; bx[cb] = AR.in[I_BX][c]; }
    const float* cw = AR.in[I_CW]; const float* cbias = AR.in[I_CB];
    for (int tt = F.vcu; tt < M / 32; tt += F.G) {
        const int R0 = tt * 32, row = R0 + r; const bool samp = R0 >= MP;
        int t, b; if (!samp) { t = row & (PSEQ - 1); b = row >> 11; } else { t = (row - MP) & 7; b = (row - MP) >> 3; }
        bf16x8 Af[4];
#pragma unroll
        for (int ks = 0; ks < 4; ++ks) { const int c0 = 64 * g + 16 * ks + 8 * hh; float xc[8];
            { const f32x4 q0 = *(const f32x4*)(cbias + c0), q1 = *(const f32x4*)(cbias + c0 + 4); xc[0] = q0.x; xc[1] = q0.y; xc[2] = q0.z; xc[3] = q0.w; xc[4] = q1.x; xc[5] = q1.y; xc[6] = q1.z; xc[7] = q1.w; }
#pragma unroll
            for (int tap = 0; tap < 4; ++tap) { const int tp = t + tap - 3; float xv[8];
                if (tp >= 0) { const v4u q = *(const v4u*)(Z + (size_t)(row + tap - 3) * ZW + ZXR + c0);
                    xv[0] = bflo(q.x); xv[1] = bfhi(q.x); xv[2] = bflo(q.y); xv[3] = bfhi(q.y); xv[4] = bflo(q.z); xv[5] = bfhi(q.z); xv[6] = bflo(q.w); xv[7] = bfhi(q.w); }
                else if (samp) { const float* sp = AR.in[I_SRC] + ((size_t)b * 3 + (t + tap)) * 512 + c0; const f32x4 q0 = *(const f32x4*)sp, q1 = *(const f32x4*)(sp + 4);
                    xv[0] = q0.x; xv[1] = q0.y; xv[2] = q0.z; xv[3] = q0.w; xv[4] = q1.x; xv[5] = q1.y; xv[6] = q1.z; xv[7] = q1.w; }
                else {
#pragma unroll
                    for (int j = 0; j < 8; ++j) xv[j] = 0.f; }
                const f32x4 w0 = *(const f32x4*)(cw + tap * 512 + c0), w1 = *(const f32x4*)(cw + tap * 512 + c0 + 4);
                xc[0] += w0.x * xv[0]; xc[1] += w0.y * xv[1]; xc[2] += w0.z * xv[2]; xc[3] += w0.w * xv[3]; xc[4] += w1.x * xv[4]; xc[5] += w1.y * xv[5]; xc[6] += w1.z * xv[6]; xc[7] += w1.w * xv[7]; }
            Af[ks] = pack8(xc);
            LAS float* xp = XT + r * 68 + 16 * ks + 8 * hh;
            *(LAS f32x4*)xp = (f32x4){xc[0], xc[1], xc[2], xc[3]}; *(LAS f32x4*)(xp + 4) = (f32x4){xc[4], xc[5], xc[6], xc[7]};
            asm volatile("" ::: "memory"); }
        LDS_WAIT(); asm volatile("" ::: "memory");
        const GAS float* wab = (const GAS float*)(wa + 8 * hh * 64 + r); const GAS float* wxb = (const GAS float*)(wx + 8 * hh * 64 + r);
        asm volatile("" : "+v"(wab), "+v"(wxb));
#pragma unroll
        for (int cb = 0; cb < 2; ++cb) { f32x16 da, dx;
#pragma unroll
            for (int i = 0; i < 16; ++i) { da[i] = 0.f; dx[i] = 0.f; }
#pragma unroll
            for (int ks = 0; ks < 4; ++ks) { float a[8], x[8];
#pragma unroll
                for (int j = 0; j < 8; ++j) { const int i = 16 * ks + j; a[j] = wab[i * 64 + cb * 32]; x[j] = wxb[i * 64 + cb * 32]; }
                da = MFMA32(Af[ks], pack8(a), da); dx = MFMA32(Af[ks], pack8(x), dx); asm volatile("" ::: "memory"); }
#pragma unroll
            for (int i = 0; i < 16; ++i) { const int tr = crow(i, hh), j = cb * 32 + r;
                const float rg = fsig(da[i] + ba[cb]), ig = fsig(dx[i] + bx[cb]);
                const float la = spl[cb] * rg, a = fexp(la), xcv = XT[tr * 68 + j];
                const float u = sqrtf(fmaxf(1.0f - a * a, 0.f)) * ig * xcv;
                AT[tr * 68 + j] = a; XT[tr * 68 + j] = u; } }
        LDS_WAIT(); asm volatile("" ::: "memory");
        { const int c = 64 * g + lane;
            if (!samp) { float h = 0.f, P = 1.f;
#pragma unroll 8
                for (int tr = 0; tr < 32; ++tr) { const float a = AT[tr * 68 + lane], u = XT[tr * 68 + lane]; h = a * h + u; P *= a;
                    RGH[(size_t)(R0 + tr) * 512 + c] = h; RGP[(size_t)(R0 + tr) * 512 + c] = P; } }
            else { float h = 0.f; const int b0 = (R0 - MP) >> 3;
#pragma unroll 8
                for (int tr = 0; tr < 32; ++tr) { const int bb = b0 + (tr >> 3);
                    if ((tr & 7) == 0) h = AR.in[I_SRH][(size_t)bb * 512 + c];
                    const float a = AT[tr * 68 + lane], u = XT[tr * 68 + lane]; h = a * h + u;
                    const float gr = bf2f(Z[(size_t)(R0 + tr) * ZW + ZGR + c]);
                    G[(size_t)(R0 + tr) * D + 512 + c] = (bf16)f2bf(h * gelu_tanh(gr));
                    if ((tr & 7) == 7) F.out[O_SRH + (size_t)bb * 512 + c] = h; } } }
        LDS_WAIT(); asm volatile("" ::: "memory");
    }
    { const int gt = F.vcu * NTHREADS + F.tid, NT = F.G * NTHREADS;
        for (int e = gt; e < NSEQ * 3 * 512; e += NT) { const int c = e & 511, j = (e >> 9) % 3, s = e / 1536;
            if (s < NPB) F.out[O_PRC + ((size_t)s * 3 + j) * 512 + c] = bf2f(Z[((size_t)s * PSEQ + PSEQ - 3 + j) * ZW + ZXR + c]);
            else { const int b = s - NPB; F.out[O_SRC + ((size_t)b * 3 + j) * 512 + c] = bf2f(Z[((size_t)MP + (size_t)b * SSEQ + SSEQ - 3 + j) * ZW + ZXR + c]); } } }
}

DI void ml2_scan(Frame& F, const Args& AR) {
    float* CST = (float*)(F.ws + WS_CST); float* NST = (float*)(F.ws + WS_NST); float* MST = (float*)(F.ws + WS_MST);
    for (int vb = F.vcu; vb < 256; vb += F.G) {
        const int bh = vb >> 3, e0 = ((vb & 7) * NTHREADS + F.tid) * 4;
        float m = 0.f; f32x4 C = (f32x4){0.f, 0.f, 0.f, 0.f};
        const bool nthr = (vb & 7) == 0 && F.tid < 128; float n = 0.f;
        for (int c = 0; c < 16; ++c) { const int item = bh * 16 + c; const float mloc = MST[item * 4 + 0], bL = MST[item * 4 + 1];
            float* cp = CST + (size_t)item * 16384 + e0; const f32x4 cl = *(const f32x4*)cp; *(f32x4*)cp = C;
            const float mn = fmaxf(bL + m, mloc), w0 = fexp(bL + m - mn), w1 = fexp(mloc - mn);
            C = C * w0 + cl * w1;
            if (nthr) { float* np = NST + item * 128 + F.tid; const float nl = *np; *np = n; n = n * w0 + nl * w1; if (F.tid == 0) MST[item * 4 + 2] = m; }
            m = mn; }
        *(f32x4*)(F.out + O_PMC + (size_t)bh * 16384 + e0) = C;
        if (nthr) { F.out[O_PMN + bh * 128 + F.tid] = n; if (F.tid == 0) F.out[O_PMM + bh] = m; }
    }
}
DI void rg2_carry(Frame& F, const Args& AR) {
    const float* RGH = (const float*)(F.ws + WS_RGH); const float* RGP = (const float*)(F.ws + WS_RGP); float* CARRY = (float*)(F.ws + WS_CARRY);
    const int gt = F.vcu * NTHREADS + F.tid, NT = F.G * NTHREADS;
    for (int e = gt; e < NPB * 512; e += NT) { const int b = e >> 9, c = e & 511; float H = 0.f;
        for (int k0 = 0; k0 < 64; k0 += 16) { float pe[16], he[16];
#pragma unroll
            for (int k = 0; k < 16; ++k) { const size_t row = (size_t)b * PSEQ + 32 * (k0 + k) + 31; pe[k] = RGP[row * 512 + c]; he[k] = RGH[row * 512 + c]; }
#pragma unroll
            for (int k = 0; k < 16; ++k) { CARRY[((size_t)b * 64 + k0 + k) * 512 + c] = H; H = pe[k] * H + he[k]; } }
        F.out[O_PRH + (size_t)b * 512 + c] = H; }
}
DI void rg2_apply(Frame& F, const Args& AR) {
    const bf16* Z = (const bf16*)(F.ws + WS_Z); bf16* G = (bf16*)(F.ws + WS_H);
    const float* RGH = (const float*)(F.ws + WS_RGH); const float* RGP = (const float*)(F.ws + WS_RGP); const float* CARRY = (const float*)(F.ws + WS_CARRY);
    const int gt = F.vcu * NTHREADS + F.tid, NT = F.G * NTHREADS;
    for (int e = gt; e < MP * 64; e += NT) { const int row = e >> 6, c0 = (e & 63) * 8, b = row >> 11, tile = (row & (PSEQ - 1)) >> 5;
        const v4u gq = *(const v4u*)(Z + (size_t)row * ZW + ZGR + c0);
        const float gr[8] = {bflo(gq.x), bfhi(gq.x), bflo(gq.y), bfhi(gq.y), bflo(gq.z), bfhi(gq.z), bflo(gq.w), bfhi(gq.w)};
        const float* hp = RGH + (size_t)row * 512 + c0; const float* pp = RGP + (size_t)row * 512 + c0; const float* cp = CARRY + ((size_t)b * 64 + tile) * 512 + c0;
        float o[8];
#pragma unroll
        for (int q = 0; q < 2; ++q) { const f32x4 h4 = *(const f32x4*)(hp + 4 * q), p4 = *(const f32x4*)(pp + 4 * q), c4 = *(const f32x4*)(cp + 4 * q);
            const f32x4 hv = h4 + p4 * c4; o[4 * q] = hv.x * gelu_tanh(gr[4 * q]); o[4 * q + 1] = hv.y * gelu_tanh(gr[4 * q + 1]); o[4 * q + 2] = hv.z * gelu_tanh(gr[4 * q + 2]); o[4 * q + 3] = hv.w * gelu_tanh(gr[4 * q + 3]); }
        v4u w; w.x = pk2(o[0], o[1]); w.y = pk2(o[2], o[3]); w.z = pk2(o[4], o[5]); w.w = pk2(o[6], o[7]);
        *(v4u*)(G + (size_t)row * D + 512 + c0) = w; }
}

DI void ml3_prompt(Frame& F, const Args& AR) {
    const bf16* Z = (const bf16*)(F.ws + WS_Z); bf16* G = (bf16*)(F.ws + WS_H);
    const float* CST = (const float*)(F.ws + WS_CST); const float* NST = (const float*)(F.ws + WS_NST); const float* MST = (const float*)(F.ws + WS_MST);
    LAS bf16* Qs = (LAS bf16*)F.lds;
    LAS bf16* Ks = (LAS bf16*)(F.lds + 34816);
    LAS bf16* Vs = (LAS bf16*)(F.lds + 69632);
    LAS float* LF = (LAS float*)(F.lds + 102400);
    LAS float* BC = LF + 128;
    LAS float* GS = BC + 128;
    LAS float* MX = GS + 128;
    LAS float* N0 = MX + 128;
    LAS float* RA = N0 + 128;
    LAS float* RB = RA + 256;
    LAS float* OT = (LAS float*)F.lds;
    const int tid = F.tid, lane = F.lane, wave = F.wave, r = lane & 31, hh = lane >> 5;
    const int tb = wave >> 1, vh = wave & 1, t = tb * 32 + r;
    for (int item = F.vcu; item < 512; item += F.G) {
        const int b = item >> 6, h = (item >> 4) & 3, c = item & 15; const size_t row0 = (size_t)b * PSEQ + c * 128;
        const float m0 = MST[item * 4 + 2]; const float* C0 = CST + (size_t)item * 16384;
#pragma unroll
        for (int i = 0; i < 4; ++i) { const int e = tid + i * NTHREADS, s = e >> 4, c8 = (e & 15) * 8; const bf16* zr = Z + (row0 + s) * ZW + h * 128 + c8;
            *(LAS v4u*)(Qs + s * 136 + c8) = *(const v4u*)(zr + ZQ); *(LAS v4u*)(Ks + s * 136 + c8) = *(const v4u*)(zr + ZK); *(LAS v4u*)(Vs + s * 128 + c8) = *(const v4u*)(zr + ZV); }
        if (tid < 128) { LF[tid] = log_sigmoid(bf2f(Z[(row0 + tid) * ZW + ZFG + h]) + AR.in[I_BG][4 + h]); N0[tid] = NST[item * 128 + tid]; }
        __syncthreads();
        if (tid < 128) { float bs = 0.f; for (int s = 0; s <= tid; ++s) bs += LF[s];
            BC[tid] = bs; GS[tid] = bf2f(Z[(row0 + tid) * ZW + ZIG + h]) + AR.in[I_BG][h] - bs; }
        __syncthreads();
        if (tid < 128) { float mx = m0; for (int s = 0; s <= tid; ++s) mx = fmaxf(mx, GS[s]); MX[tid] = mx; }
        __syncthreads();
        const float mxt = MX[t], winter = fexp(m0 - mxt);
        bf16x8 bq[8];
#pragma unroll
        for (int ks = 0; ks < 8; ++ks) bq[ks] = *(const LAS bf16x8*)(Qs + t * 136 + 16 * ks + 8 * hh);
        bf16x8 pp[4][2]; float den = 0.f;
#pragma unroll
        for (int sb = 0; sb < 4; ++sb) {
            if (sb <= tb) { f32x16 sa;
#pragma unroll
                for (int i = 0; i < 16; ++i) sa[i] = 0.f;
#pragma unroll
                for (int ks = 0; ks < 8; ++ks) sa = MFMA32(*(const LAS bf16x8*)(Ks + (sb * 32 + r) * 136 + 16 * ks + 8 * hh), bq[ks], sa);
                float pv[16];
#pragma unroll
                for (int i = 0; i < 16; ++i) { const int s = sb * 32 + crow(i, hh); float v = sa[i] * MSCALE * fexp(GS[s] - mxt); if (s > t) v = 0.f; pv[i] = v; den += v; }
                pp[sb][0] = mk_frag(pk2(pv[0], pv[1]), pk2(pv[2], pv[3]), pk2(pv[4], pv[5]), pk2(pv[6], pv[7]));
                pp[sb][1] = mk_frag(pk2(pv[8], pv[9]), pk2(pv[10], pv[11]), pk2(pv[12], pv[13]), pk2(pv[14], pv[15]));
            } else { pp[sb][0] = mk_frag(0u, 0u, 0u, 0u); pp[sb][1] = mk_frag(0u, 0u, 0u, 0u); } }
        den += __shfl_xor(den, 32);
        float qn = 0.f;
#pragma unroll 8
        for (int k = 0; k < 64; ++k) qn += N0[hh * 64 + k] * bf2f(Qs[t * 136 + hh * 64 + k]);
        qn += __shfl_xor(qn, 32);
        const float dtot = den + winter * qn, denom = fmaxf(fabsf(dtot), fexp(-(BC[t] + mxt))), rden = 1.0f / denom;
        float hv[2][16];
#pragma unroll
        for (int q = 0; q < 2; ++q) { const int vb = vh * 2 + q; f32x16 an, ai;
#pragma unroll
            for (int i = 0; i < 16; ++i) { an[i] = 0.f; ai[i] = 0.f; }
#pragma unroll
            for (int sb = 0; sb < 4; ++sb) if (sb <= tb) {
#pragma unroll
                for (int s2 = 0; s2 < 2; ++s2) { unsigned vw[8];
#pragma unroll
                    for (int j = 0; j < 8; ++j) vw[j] = Vs[(sb * 32 + 16 * s2 + 8 * (j >> 2) + 4 * hh + (j & 3)) * 128 + vb * 32 + r];
                    an = MFMA32(mk_frag(vw[0] | (vw[1] << 16), vw[2] | (vw[3] << 16), vw[4] | (vw[5] << 16), vw[6] | (vw[7] << 16)), pp[sb][s2], an); } }
#pragma unroll
            for (int ks = 0; ks < 8; ++ks) { const float* cp = C0 + (size_t)(vb * 32 + r) * 128 + 16 * ks + 8 * hh; const f32x4 c0 = *(const f32x4*)cp, c1 = *(const f32x4*)(cp + 4);
                ai = MFMA32(mk_frag(pk2(c0.x, c0.y), pk2(c0.z, c0.w), pk2(c1.x, c1.y), pk2(c1.z, c1.w)), bq[ks], ai); }
#pragma unroll
            for (int i = 0; i < 16; ++i) hv[q][i] = (an[i] + winter * ai[i]) * rden; }
        float s1 = 0.f;
#pragma unroll
        for (int q = 0; q < 2; ++q)
#pragma unroll
            for (int i = 0; i < 16; ++i) s1 += hv[q][i];
        s1 += __shfl_xor(s1, 32);
        if (hh == 0) RA[vh * 128 + t] = s1;
        __syncthreads();
        const float mean = (RA[t] + RA[128 + t]) * (1.f / 128.f); float s2 = 0.f;
#pragma unroll
        for (int q = 0; q < 2; ++q)
#pragma unroll
            for (int i = 0; i < 16; ++i) { hv[q][i] -= mean; s2 += hv[q][i] * hv[q][i]; }
        s2 += __shfl_xor(s2, 32);
        if (hh == 0) RB[vh * 128 + t] = s2;
        __syncthreads();
        const float rstd = 1.f / sqrtf((RB[t] + RB[128 + t]) * (1.f / 128.f) + HEAD_EPS);
#pragma unroll
        for (int q = 0; q < 2; ++q)
#pragma unroll
            for (int i = 0; i < 16; ++i) OT[t * 132 + (vh * 2 + q) * 32 + crow(i, hh)] = hv[q][i] * rstd;
        __syncthreads();
        { const int tt = tid >> 2, v0 = (tid & 3) * 32; const size_t row = row0 + tt;
#pragma unroll
            for (int q = 0; q < 4; ++q) { const int v = v0 + 8 * q; const v4u oq = *(const v4u*)(Z + row * ZW + ZO + h * 128 + v);
                const float og[8] = {bflo(oq.x), bfhi(oq.x), bflo(oq.y), bfhi(oq.y), bflo(oq.z), bfhi(oq.z), bflo(oq.w), bfhi(oq.w)};
                const f32x4 g0 = *(const f32x4*)(AR.in[I_MNG] + h * 128 + v), g1 = *(const f32x4*)(AR.in[I_MNG] + h * 128 + v + 4);
                const f32x4 x0 = *(const LAS f32x4*)(OT + tt * 132 + v), x1 = *(const LAS f32x4*)(OT + tt * 132 + v + 4);
                v4u w; w.x = pk2(x0.x * g0.x * fsig(og[0]), x0.y * g0.y * fsig(og[1])); w.y = pk2(x0.z * g0.z * fsig(og[2]), x0.w * g0.w * fsig(og[3]));
                w.z = pk2(x1.x * g1.x * fsig(og[4]), x1.y * g1.y * fsig(og[5])); w.w = pk2(x1.z * g1.z * fsig(og[6]), x1.w * g1.w * fsig(og[7]));
                *(v4u*)(G + row * D + h * 128 + v) = w; } }
        __syncthreads();
    }
}

constexpr int TC = 32;
constexpr int RW_ARR = TC * 64;
constexpr int RW_BUF_FLOATS = 7 * RW_ARR + TC;
struct RwRaw { v2u r, k, v, w, a, g; };
DI void rw_load(RwRaw& x, const bf16* RK, const bf16* WAG, size_t row, int h, int k4, bool valid) {
    if (valid) { const bf16* p = RK + row * RKW + h * 64 + k4; const bf16* q = WAG + row * WAGW + h * 64 + k4;
        x.r = *(const v2u*)p; x.k = *(const v2u*)(p + 1024); x.v = *(const v2u*)(p + 2048); x.w = *(const v2u*)q; x.a = *(const v2u*)(q + 1024); x.g = *(const v2u*)(q + 2048); }
    else { x.r = (v2u){0u, 0u}; x.k = x.r; x.v = x.r; x.w = x.r; x.a = x.r; x.g = x.r; }
}
DI void un4(const v2u u, float (&f)[4]) { f[0] = bflo(u.x); f[1] = bfhi(u.x); f[2] = bflo(u.y); f[3] = bfhi(u.y); }
DI void rw_prep(const RwRaw& x, LAS float* buf, int tok, int k4, const float (&kkw)[4], const float (&kaw)[4], const float (&rkw)[4]) {
    float r[4], k[4], v[4], w[4], a[4], g[4]; un4(x.r, r); un4(x.k, k); un4(x.v, v); un4(x.w, w); un4(x.a, a); un4(x.g, g);
    float kk[4], ss = 0.f, bs = 0.f, km[4];
#pragma unroll
    for (int j = 0; j < 4; ++j) { kk[j] = k[j] * kkw[j]; ss += kk[j] * kk[j]; km[j] = k[j] * (1.0f + (a[j] - 1.0f) * kaw[j]); bs += r[j] * km[j] * rkw[j]; }
#pragma unroll
    for (int o = 1; o < 16; o <<= 1) { ss += __shfl_xor(ss, o); bs += __shfl_xor(bs, o); }
    const float inv = 1.0f / fmaxf(sqrtf(ss), 1e-12f);
    f32x4 o0, o1, o2, o3, o4, o5, o6;
#pragma unroll
    for (int j = 0; j < 4; ++j) { const float kn = kk[j] * inv; o0[j] = kn; o1[j] = kn * a[j]; o2[j] = km[j]; o3[j] = __builtin_amdgcn_exp2f(w[j]); o4[j] = r[j]; o5[j] = v[j]; o6[j] = g[j]; }
    LAS float* p = buf + tok * 64 + k4;
    *(LAS f32x4*)p = o0; *(LAS f32x4*)(p + RW_ARR) = o1; *(LAS f32x4*)(p + 2 * RW_ARR) = o2; *(LAS f32x4*)(p + 3 * RW_ARR) = o3;
    *(LAS f32x4*)(p + 4 * RW_ARR) = o4; *(LAS f32x4*)(p + 5 * RW_ARR) = o5; *(LAS f32x4*)(p + 6 * RW_ARR) = o6;
    if ((k4 & 63) == 0) buf[7 * RW_ARR + tok] = bs;
}
DI void rw_seq(Frame& F, const Args& AR, size_t row0, int len, int h, const float* S0, float* Sout) {
    const bf16* RK = (const bf16*)(F.ws + WS_RK); const bf16* WAG = (const bf16*)(F.ws + WS_WAG); bf16* G = (bf16*)(F.ws + WS_H);
    LAS float* B0 = (LAS float*)F.lds; LAS float* B1 = B0 + RW_BUF_FLOATS; LAS float* YB = B1 + RW_BUF_FLOATS;
    const int tid = F.tid, vrow = tid >> 3, p = tid & 7, tok = tid >> 4, k4 = (tid & 15) * 4;
    float kkw[4], kaw[4], rkw[4], lg[4], lb[4];
#pragma unroll
    for (int j = 0; j < 4; ++j) { const int c = h * 64 + k4 + j; kkw[j] = AR.in[I_KK][c]; kaw[j] = AR.in[I_KA][c]; rkw[j] = AR.in[I_RK][c]; lg[j] = AR.in[I_LXG][c]; lb[j] = AR.in[I_LXB][c]; }
    float S[8];
    if (S0) { const f32x4 a = *(const f32x4*)(S0 + vrow * 64 + 8 * p), b = *(const f32x4*)(S0 + vrow * 64 + 8 * p + 4); S[0] = a.x; S[1] = a.y; S[2] = a.z; S[3] = a.w; S[4] = b.x; S[5] = b.y; S[6] = b.z; S[7] = b.w; }
    else {
#pragma unroll
        for (int j = 0; j < 8; ++j) S[j] = 0.f; }
    const int nch = (len + TC - 1) / TC;
    RwRaw raw; rw_load(raw, RK, WAG, row0 + tok, h, k4, tok < len);
    rw_prep(raw, B0, tok, k4, kkw, kaw, rkw);
    __syncthreads();
    for (int ch = 0; ch < nch; ++ch) {
        LAS float* cur = (ch & 1) ? B1 : B0; LAS float* nxt = (ch & 1) ? B0 : B1;
        const int base = ch * TC, nt = (len - base) < TC ? (len - base) : TC;
        const bool more = ch + 1 < nch;
        if (more) rw_load(raw, RK, WAG, row0 + base + TC + tok, h, k4, base + TC + tok < len);
        for (int tk = 0; tk < nt; ++tk) {
            const LAS float* q = cur + tk * 64 + 8 * p;
            const f32x4 ka = *(const LAS f32x4*)q, kb = *(const LAS f32x4*)(q + 4);
            const f32x4 ba = *(const LAS f32x4*)(q + RW_ARR), bb = *(const LAS f32x4*)(q + RW_ARR + 4);
            const f32x4 ma = *(const LAS f32x4*)(q + 2 * RW_ARR), mb = *(const LAS f32x4*)(q + 2 * RW_ARR + 4);
            const f32x4 da = *(const LAS f32x4*)(q + 3 * RW_ARR), db = *(const LAS f32x4*)(q + 3 * RW_ARR + 4);
            const f32x4 ra = *(const LAS f32x4*)(q + 4 * RW_ARR), rb = *(const LAS f32x4*)(q + 4 * RW_ARR + 4);
            const float vv = cur[5 * RW_ARR + tk * 64 + vrow];
            float sa = (S[0] * ka.x + S[1] * ka.y) + (S[2] * ka.z + S[3] * ka.w) + (S[4] * kb.x + S[5] * kb.y) + (S[6] * kb.z + S[7] * kb.w);
            sa += __shfl_xor(sa, 1); sa += __shfl_xor(sa, 2); sa += __shfl_xor(sa, 4);
            sa = -sa;
            S[0] = S[0] * da.x + sa * ba.x + vv * ma.x; S[1] = S[1] * da.y + sa * ba.y + vv * ma.y; S[2] = S[2] * da.z + sa * ba.z + vv * ma.z; S[3] = S[3] * da.w + sa * ba.w + vv * ma.w;
            S[4] = S[4] * db.x + sa * bb.x + vv * mb.x; S[5] = S[5] * db.y + sa * bb.y + vv * mb.y; S[6] = S[6] * db.z + sa * bb.z + vv * mb.z; S[7] = S[7] * db.w + sa * bb.w + vv * mb.w;
            float y = (S[0] * ra.x + S[1] * ra.y) + (S[2] * ra.z + S[3] * ra.w) + (S[4] * rb.x + S[5] * rb.y) + (S[6] * rb.z + S[7] * rb.w);
            y += __shfl_xor(y, 1); y += __shfl_xor(y, 2); y += __shfl_xor(y, 4);
            if (p == 0) YB[tk * 64 + vrow] = y;
        }
        __syncthreads();
        if (tok < nt) { const f32x4 y4 = *(const LAS f32x4*)(YB + tok * 64 + k4);
            float s = (y4.x + y4.y) + (y4.z + y4.w);
#pragma unroll
            for (int o = 1; o < 16; o <<= 1) s += __shfl_xor(s, o);
            const float mean = s * (1.f / 64.f); const f32x4 d = y4 - mean; float s2 = (d.x * d.x + d.y * d.y) + (d.z * d.z + d.w * d.w);
#pragma unroll
            for (int o = 1; o < 16; o <<= 1) s2 += __shfl_xor(s2, o);
            const float rstd = 1.f / sqrtf(s2 * (1.f / 64.f) + RW_EPS); const float bn = cur[7 * RW_ARR + tok];
            const f32x4 v4 = *(const LAS f32x4*)(cur + 5 * RW_ARR + tok * 64 + k4), g4 = *(const LAS f32x4*)(cur + 6 * RW_ARR + tok * 64 + k4);
            const float o0 = (d.x * rstd * lg[0] + lb[0] + bn * v4.x) * g4.x, o1 = (d.y * rstd * lg[1] + lb[1] + bn * v4.y) * g4.y;
            const float o2 = (d.z * rstd * lg[2] + lb[2] + bn * v4.z) * g4.z, o3 = (d.w * rstd * lg[3] + lb[3] + bn * v4.w) * g4.w;
            v2u w; w.x = pk2(o0, o1); w.y = pk2(o2, o3);
            *(v2u*)(G + (row0 + base + tok) * D + h * 64 + k4) = w; }
        else {
        }
        if (more) rw_prep(raw, nxt, tok, k4, kkw, kaw, rkw);
        __syncthreads();
    }
#pragma unroll
    for (int j = 0; j < 8; j += 4) *(f32x4*)(Sout + vrow * 64 + 8 * p + j) = (f32x4){S[j], S[j + 1], S[j + 2], S[j + 3]};
}
DI void rwkv_scan(Frame& F, const Args& AR) {
    const int G = F.G, np = G >= 256 ? 128 : (G / 2 > 0 ? G / 2 : 1);
    if (F.vcu < np) {
        for (int item = F.vcu; item < NPB * 16; item += np) { const int b = item >> 4, h = item & 15;
            rw_seq(F, AR, (size_t)b * PSEQ, PSEQ, h, nullptr, F.out + O_PWKV + (size_t)item * 4096); }
    }
    const int ns = G - np > 0 ? G - np : G, s0 = G - np > 0 ? F.vcu - np : F.vcu;
    if (G - np <= 0 || F.vcu >= np) {
        for (int item = s0; item < NSB * 16; item += ns) { const int b = item >> 4, h = item & 15;
            rw_seq(F, AR, (size_t)MP + (size_t)b * SSEQ, SSEQ, h, AR.in[I_SWKV] + (size_t)item * 4096, F.out + O_SWKV + (size_t)item * 4096); }
    }
}

#ifndef MK_N_LAUNCHES
#define MK_N_LAUNCHES 1
#endif
constexpr int NPHASES = 25;
enum { K_P0 = 0, K_MODX, K_UP, K_RESID, K_LN, K_WIN, K_MIXA, K_MIXB, K_MIXC, K_R1, K_R2, K_R3 };

__global__ void __launch_bounds__(NTHREADS, 2) mega_fwd(Args AR) {
    extern __shared__ __attribute__((aligned(16))) unsigned char lds[];
    Frame F;
    F.lds = (LAS unsigned char*)lds;
    F.MISC = (volatile LAS unsigned*)(F.lds + MISC_OFF);
    F.tid = threadIdx.x; F.lane = F.tid & 63; F.wave = __builtin_amdgcn_readfirstlane(F.tid >> 6);
    F.G = gridDim.x; { const int bx = blockIdx.x; F.vcu = (F.G % 8 == 0) ? (bx % 8) * (F.G / 8) + bx / 8 : bx; }
    F.ws = AR.ws; F.out = AR.out; F.ctl = (gu32*)(AR.ws + WS_CTL);
    for (int u = F.tid; u < (LDS_BYTES - LDSCTL_OFF) / 4; u += NTHREADS) ((LAS unsigned*)(F.lds + LDSCTL_OFF))[u] = 0u;
    __syncthreads();
    const int lo = AR.ph_lo, hi = AR.ph_hi;
    XcdBarrier bar; bar.bar = (unsigned*)(F.ctl + CW_BAR); bar.x = 0; bar.st = nullptr;
    if (hi - lo > 1) bar = xcd_barrier_post((unsigned*)(F.ctl + CW_BAR), F.MISC + 8);

    for (int ph = lo; ph < hi; ++ph) {
        { int t_ = F.tid; asm volatile("" : "+v"(t_)); F.tid = t_; F.lane = t_ & 63; F.wave = __builtin_amdgcn_readfirstlane(t_ >> 6);

          int v_ = F.vcu; asm volatile("" : "+s"(v_)); F.vcu = v_; int g_ = F.G; asm volatile("" : "+s"(g_)); F.G = g_; }
        float* X = F.out + O_Y; const float* mod = (const float*)(F.ws + WS_MOD); bf16* H = (bf16*)(F.ws + WS_H);
        int kind = K_LN, f = 0, l = 0, sub = 0, js = 0, first = 0, mode = 0, lm = 0, which = 0;
        switch (ph) {
            case 0: kind = K_P0; break;
            case 1: kind = K_MODX; break;
            case 2: kind = K_UP; f = 0; break;
            case 3: kind = K_RESID; which = 0; f = 0; l = 0; js = 0; first = 1; break;
            case 4: kind = K_LN; l = 0; sub = 0; lm = 0; js = 3; mode = 0; break;
            case 5: kind = K_WIN; break;
            case 6: kind = K_MIXA; break;
            case 7: kind = K_MIXB; break;
            case 8: kind = K_MIXC; break;
            case 9: kind = K_RESID; which = 1; l = 0; js = 3; break;
            case 10: kind = K_LN; l = 0; sub = 1; lm = 0; js = 6; mode = 0; break;
            case 11: kind = K_UP; f = 1; break;
            case 12: kind = K_RESID; which = 0; f = 1; l = 0; js = 6; break;
            case 13: kind = K_LN; l = 0; sub = 2; lm = 1; js = 0; mode = 0; break;
            case 14: kind = K_UP; f = 2; break;
            case 15: kind = K_RESID; which = 0; f = 2; l = 1; js = 0; break;
            case 16: kind = K_LN; l = 1; sub = 0; lm = 1; js = 3; mode = 1; break;
            case 17: kind = K_R1; break;
            case 18: kind = K_R2; break;
            case 19: kind = K_R3; break;
            case 20: kind = K_RESID; which = 2; l = 1; js = 3; break;
            case 21: kind = K_LN; l = 1; sub = 1; lm = 1; js = 6; mode = 0; break;
            case 22: kind = K_UP; f = 3; break;
            case 23: kind = K_RESID; which = 0; f = 3; l = 1; js = 6; break;
            default: kind = K_LN; l = 1; sub = 2; lm = 1; js = 0; mode = 2; break;
        }
#ifndef PHMASK
#define PHMASK 0xFFFFF
#endif
        switch (kind) {
            case K_P0: if ((PHMASK >> K_P0) & 1) p0_mod(F, AR); __syncthreads(); if ((PHMASK >> 12) & 1) p0_weights(F, AR); break;
            case K_MODX: if ((PHMASK >> K_MODX) & 1) ln_pass(F, AR, 1, 0, 0, 0, 0, 0, 0); break;
            case K_UP: if ((PHMASK >> K_UP) & 1) {
                pg8::Gemm g{H, (const bf16*)(F.ws + WS_W13) + (size_t)f * 5632 * 1024, M, 5632, 1024}; pg8::StaticOrder S; S.init(M, 5632, F.G, (int)blockIdx.x);
                pg8::EpiSwiglu E{(bf16*)(F.ws + WS_HID), FF};
                pg8::gemm_phase<pg8::EpiSwiglu, pg8::StaticOrder, true, true>(F.lds, g, S, E);
            } break;
            case K_RESID: if ((PHMASK >> K_RESID) & 1) {
                const bf16* A = which == 0 ? (const bf16*)(F.ws + WS_HID) : H; const int K = which == 0 ? FF : 1024;
                const bf16* Bt = which == 0 ? (const bf16*)(F.ws + WS_W2) + (size_t)f * 1024 * FF : (which == 1 ? (const bf16*)(F.ws + WS_WOUT) : (const bf16*)(F.ws + WS_WO));
                pg8::Gemm g{A, Bt, M, 1024, K}; pg8::StaticOrder S; S.init(M, 1024, F.G, (int)blockIdx.x);
                pg8::EpiResid E{first ? AR.in[I_XP] : X, first ? AR.in[I_XS] : X + (size_t)MP * D, X, mod + ((size_t)l * NSEQ * 9 + (js + 2)) * 1024, ALPHA, which == 0 ? 0.5f : 1.0f};
                pg8::gemm_phase<pg8::EpiResid, pg8::StaticOrder, true, true>(F.lds, g, S, E);
            } break;
            case K_LN: if ((PHMASK >> K_LN) & 1) ln_pass(F, AR, 0, 1, l, sub, lm, js, mode); break;
            case K_WIN: if ((PHMASK >> K_WIN) & 1) {
                pg8::Gemm g{H, (const bf16*)(F.ws + WS_WIN), M, ZW, 1024}; pg8::StaticOrder S; S.init(M, ZW, F.G, (int)blockIdx.x);
                pg8::EpiStore E{(bf16*)(F.ws + WS_Z), ZW, 1000, nullptr, 0};
                pg8::gemm_phase<pg8::EpiStore, pg8::StaticOrder, true, true>(F.lds, g, S, E);
            } break;
            case K_R1: if ((PHMASK >> K_R1) & 1) {
                pg8::Gemm g{(const bf16*)(F.ws + WS_A2), (const bf16*)(F.ws + WS_WRK), M, 3328, 2048}; pg8::StaticOrder S; S.init(M, 3328, F.G, (int)blockIdx.x);
                pg8::EpiStore E{(bf16*)(F.ws + WS_RK), RKW, 12, (bf16*)(F.ws + WS_A3), 256};
                pg8::gemm_phase<pg8::EpiStore, pg8::StaticOrder, true, true>(F.lds, g, S, E);
            } break;
            case K_R2: if ((PHMASK >> K_R2) & 1) {
                pg8::Gemm g{(const bf16*)(F.ws + WS_A3), (const bf16*)(F.ws + WS_WL2), M, 3072, 256}; pg8::StaticOrder S; S.init(M, 3072, F.G, (int)blockIdx.x);
                pg8::EpiLora2 E{(bf16*)(F.ws + WS_WAG), WAGW, AR.in[I_W0], AR.in[I_A0]};
                pg8::gemm_phase<pg8::EpiLora2, pg8::StaticOrder, true, true>(F.lds, g, S, E);
            } break;
            case K_MIXA: if ((PHMASK >> K_MIXA) & 1) ml1_prompt(F, AR); __syncthreads(); if ((PHMASK >> 13) & 1) ml_sample(F, AR); __syncthreads(); if ((PHMASK >> 14) & 1) rg1(F, AR); break;
            case K_MIXB: if ((PHMASK >> K_MIXB) & 1) ml2_scan(F, AR); if ((PHMASK >> 15) & 1) rg2_carry(F, AR); break;
            case K_MIXC: if ((PHMASK >> K_MIXC) & 1) ml3_prompt(F, AR); __syncthreads(); if ((PHMASK >> 16) & 1) rg2_apply(F, AR); break;
            case K_R3: if ((PHMASK >> K_R3) & 1) rwkv_scan(F, AR); break;
        }
        if (ph + 1 < hi) xcd_barrier(bar);
    }
}

extern "C" void kernel_launch(void* const* d_in, const int* in_sizes, int n_in, void* d_out, int out_size, void* d_ws, size_t ws_size, hipStream_t stream) {
    static int grid = 0;
    if (grid == 0) {
        if (n_in != 47 || out_size != (int)O_END || ws_size < WS_END) { fprintf(stderr, "kernel_launch: unexpected sizes n_in %d out %d ws %zu\n", n_in, out_size, ws_size); grid = -1; return; }
        int dev = 0, cus = 0, per_cu = 0;
        if (hipGetDevice(&dev) != hipSuccess || hipDeviceGetAttribute(&cus, hipDeviceAttributeMultiprocessorCount, dev) != hipSuccess) { grid = -1; return; }
        if (hipFuncSetAttribute((const void*)mega_fwd, hipFuncAttributeMaxDynamicSharedMemorySize, LDS_BYTES) != hipSuccess) { fprintf(stderr, "kernel_launch: hipFuncSetAttribute failed\n"); grid = -1; return; }
        if (hipOccupancyMaxActiveBlocksPerMultiprocessor(&per_cu, (const void*)mega_fwd, NTHREADS, LDS_BYTES) != hipSuccess || per_cu < 1) { fprintf(stderr, "kernel_launch: occupancy query says %d blocks per CU\n", per_cu); (void)hipGetLastError(); grid = -1; return; }
        grid = cus;
    }
    if (grid < 0) return;
    (void)hipMemsetAsync((char*)d_ws + WS_CTL, 0, CTL_ZERO_BYTES, stream);
    Args a{};
    for (int i = 0; i < 47; ++i) a.in[i] = (const float*)d_in[i];
    a.out = (float*)d_out; a.ws = (unsigned char*)d_ws;
#if MK_N_LAUNCHES == 1
    a.ph_lo = 0; a.ph_hi = NPHASES;
    hipLaunchKernelGGL(mega_fwd, dim3(grid), dim3(NTHREADS), LDS_BYTES, stream, a);
#else
    for (int p = 0; p < NPHASES; ++p) { a.ph_lo = p; a.ph_hi = p + 1; hipLaunchKernelGGL(mega_fwd, dim3(grid), dim3(NTHREADS), LDS_BYTES, stream, a); }
#endif
}
```

```cpp
#include <hip/hip_runtime.h>
#include <cstdio>
#include <cstdint>
#include <cmath>
namespace pg8 {
#define PG8_LAS __attribute__((address_space(3)))
typedef unsigned short bf16_t;
typedef short bf16x8 __attribute__((ext_vector_type(8)));
typedef float f32x4 __attribute__((ext_vector_type(4)));
typedef unsigned u32x4 __attribute__((ext_vector_type(4)));
constexpr int BM = 256, BK = 64, HALF = 128, HTB = HALF * BK * 2  , STAGE_BYTES = 8 * HTB, NXCD = 8, WGM = 8;

__host__ __device__ __forceinline__ int lds_byte(int r, int c) { const int st = (r >> 4) * 2 + (c >> 5), rr = r & 15, cc = c & 31, ob = rr * 64 + cc * 2; return st * 1024 + (ob ^ (((ob >> 9) & 1) << 5)); }
__host__ __device__ __forceinline__ void stage_rc(int b, int& R, int& C) { const int st = b / 1024, sb = b % 1024, swz = sb ^ (((sb >> 9) & 1) << 5); R = (st >> 1) * 16 + swz / 64; C = (st & 1) * 32 + (swz % 64) / 2; }
__host__ __device__ __forceinline__ int perm32(int rho) { const int n = rho >> 4, i = rho & 15; return 8 * (i >> 2) + 4 * n + (i & 3); }

struct Unit { int pm, pn; };
struct Gemm { const bf16_t* A; const bf16_t* Bt; int M, N, K; };

struct StaticOrder {
    int nM, nN, nwg, G, c;
    __host__ __device__ void init(int M, int N, int G_, int c_) { nM = M / BM; nN = N / BM; nwg = nM * nN; G = G_; c = c_; }
    __host__ __device__ bool next(int i, Unit& u) const {
        const long L = (long)i * G + c; if (L >= nwg) return false;
        int wgid = (int)L; { const int q = nwg / NXCD, r = nwg % NXCD, xcd = wgid % NXCD, off = wgid / NXCD; wgid = (xcd < r ? xcd * (q + 1) : r * (q + 1) + (xcd - r) * q) + off; }
        const int nig = WGM * nN, gid = wgid / nig, fm = gid * WGM, gsz = (nM - fm) < WGM ? (nM - fm) : WGM;
        u.pm = fm + ((wgid % nig) % gsz); u.pn = (wgid % nig) / gsz; return true;
    }
    __device__ __forceinline__ void a_ready(const Unit&) const {}
    __device__ __forceinline__ void done(const Unit&) const {}
};

__device__ __forceinline__ unsigned cvt_pk_bf16(float lo, float hi) { unsigned r; asm volatile("v_cvt_pk_bf16_f32 %0, %1, %2" : "=v"(r) : "v"(lo), "v"(hi)); return r; }
typedef float f32x2 __attribute__((ext_vector_type(2)));
constexpr int MPROWS = 16384;
__device__ __forceinline__ int mod_row(int r) { return r < MPROWS ? (r >> 11) : 8 + ((r - MPROWS) >> 3); }
__device__ __forceinline__ float fsig(float x) { return __builtin_amdgcn_rcpf(1.0f + __builtin_amdgcn_exp2f(-1.44269504f * x)); }
__device__ __forceinline__ float ftanh(float x) { return 1.0f - 2.0f * __builtin_amdgcn_rcpf(1.0f + __builtin_amdgcn_exp2f(2.88539008f * x)); }

struct EpiSwiglu {
    static constexpr bool PERM = true, AFTER_DRAIN = false;
    bf16_t* O; int ldc;
    __device__ __forceinline__ void operator()(const f32x4 (&acc)[2][2][4][2], const Unit& u, int wr, int wc, int fr, int fq) const {
        const int row0 = u.pm * BM + wr * 64 + fr, col0 = u.pn * HALF + wc * 32 + 8 * fq;
#pragma unroll
        for (int ai = 0; ai < 2; ++ai)
#pragma unroll
            for (int m = 0; m < 4; ++m) { bf16_t* rowp = O + (size_t)(row0 + ai * HALF + m * 16) * ldc + col0;
                const f32x4 a0 = acc[ai][0][m][0], a1 = acc[ai][0][m][1], b0 = acc[ai][1][m][0], b1 = acc[ai][1][m][1];
                f32x4 v0, v1;
#pragma unroll
                for (int j = 0; j < 4; ++j) { v0[j] = a0[j] * fsig(a0[j]) * b0[j]; v1[j] = a1[j] * fsig(a1[j]) * b1[j]; }
                u32x4 w; w.x = cvt_pk_bf16(v0[0], v0[1]); w.y = cvt_pk_bf16(v0[2], v0[3]); w.z = cvt_pk_bf16(v1[0], v1[1]); w.w = cvt_pk_bf16(v1[2], v1[3]);
                *(u32x4*)rowp = w; asm volatile("" ::: "memory"); }
    }
};
struct EpiStore {
    static constexpr bool PERM = true, AFTER_DRAIN = false;
    bf16_t* O; int ldc; int ntile_main; bf16_t* O2; int ldc2;
    __device__ __forceinline__ void operator()(const f32x4 (&acc)[2][2][4][2], const Unit& u, int wr, int wc, int fr, int fq) const {
        const int row0 = u.pm * BM + wr * 64 + fr;
        const bool main = u.pn < ntile_main;
        bf16_t* base = main ? O + (size_t)u.pn * BM : O2; const int ld = main ? ldc : ldc2;
        const int col0 = wc * 32 + 8 * fq;
#pragma unroll
        for (int ai = 0; ai < 2; ++ai)
#pragma unroll
            for (int m = 0; m < 4; ++m) { bf16_t* rowp = base + (size_t)(row0 + ai * HALF + m * 16) * ld + col0;
#pragma unroll
                for (int bj = 0; bj < 2; ++bj) { f32x4 v0 = acc[ai][bj][m][0], v1 = acc[ai][bj][m][1];
                    if (!main) {
                        if (bj == 1) {
#pragma unroll
                            for (int j = 0; j < 4; ++j) { v0[j] = fsig(v0[j]); v1[j] = fsig(v1[j]); }
                        } else if (wc < 2) {
#pragma unroll
                            for (int j = 0; j < 4; ++j) { v0[j] = ftanh(v0[j]); v1[j] = ftanh(v1[j]); }
                        }
                    }
                    u32x4 w; w.x = cvt_pk_bf16(v0[0], v0[1]); w.y = cvt_pk_bf16(v0[2], v0[3]); w.z = cvt_pk_bf16(v1[0], v1[1]); w.w = cvt_pk_bf16(v1[2], v1[3]);
                    *(u32x4*)(rowp + bj * HALF) = w; asm volatile("" ::: "memory"); } }
    }
};
struct EpiLora2 {
    static constexpr bool PERM = true, AFTER_DRAIN = false;
    bf16_t* O; int ldc; const float* w0; const float* a0;
    __device__ __forceinline__ void operator()(const f32x4 (&acc)[2][2][4][2], const Unit& u, int wr, int wc, int fr, int fq) const {
        const int row0 = u.pm * BM + wr * 64 + fr, col0 = u.pn * BM + wc * 32 + 8 * fq, kind = u.pn >> 2;
        const float* bp = (kind == 0 ? w0 : a0) + (col0 & 1023); const float bsc = kind == 2 ? 0.f : 1.f, mul = kind == 0 ? -0.87504229f : 1.0f;
#pragma unroll
        for (int bj = 0; bj < 2; ++bj)
#pragma unroll
            for (int ai = 0; ai < 2; ++ai)
#pragma unroll
                for (int m = 0; m < 4; ++m) { bf16_t* rowp = O + (size_t)(row0 + ai * HALF + m * 16) * ldc + col0;
                    f32x4 v0 = acc[ai][bj][m][0] + *(const f32x4*)(bp + bj * HALF) * bsc, v1 = acc[ai][bj][m][1] + *(const f32x4*)(bp + bj * HALF + 4) * bsc;
                    if (kind != 2) {
#pragma unroll
                        for (int j = 0; j < 4; ++j) { v0[j] = mul * fsig(v0[j]); v1[j] = mul * fsig(v1[j]); }
                    }
                    u32x4 w; w.x = cvt_pk_bf16(v0[0], v0[1]); w.y = cvt_pk_bf16(v0[2], v0[3]); w.z = cvt_pk_bf16(v1[0], v1[1]); w.w = cvt_pk_bf16(v1[2], v1[3]);
                    *(u32x4*)(rowp + bj * HALF) = w; asm volatile("" ::: "memory"); }
    }
};
struct EpiResid {
    static constexpr bool PERM = false, AFTER_DRAIN = false;
    const float* xp; const float* xs; float* X; const float* gate; float alpha, rw;
    __device__ __forceinline__ void operator()(const f32x4 (&acc)[2][2][4][2], const Unit& u, int wr, int wc, int fr, int fq) const {
        const int row0 = u.pm * BM + wr * 64 + fr, col0 = u.pn * BM + wc * 32 + 4 * fq;
#pragma unroll
        for (int ai = 0; ai < 2; ++ai)
#pragma unroll
            for (int m = 0; m < 4; ++m) { const int row = row0 + ai * HALF + m * 16;
                const float* xr = (row < MPROWS ? xp + (size_t)row * 1024 : xs + (size_t)(row - MPROWS) * 1024) + col0;
                const float* gr = gate + (size_t)mod_row(row) * 9216 + col0; float* o = X + (size_t)row * 1024 + col0;
#pragma unroll
                for (int bj = 0; bj < 2; ++bj)
#pragma unroll
                    for (int n = 0; n < 2; ++n) { const int c = bj * HALF + n * 16; const f32x4 xv = *(const f32x4*)(xr + c), gv = *(const f32x4*)(gr + c);
                        *(f32x4*)(o + c) = xv * alpha + (gv + 1.0f) * rw * acc[ai][bj][m][n]; } }
    }
};

template <class Epi, class Sched, bool ALIGN_EPI = false, bool SP2 = false>
__device__ __forceinline__ void gemm_phase(PG8_LAS unsigned char* lds, const Gemm g, const Sched& S, const Epi& E) {
    int tid_ = threadIdx.x; asm volatile("" : "+v"(tid_));
    const int tid = tid_, wid = __builtin_amdgcn_readfirstlane(tid >> 6), lane = tid & 63, wr = wid >> 2, wc = wid & 3, fr = lane & 15, fq = lane >> 4;
    int K_ = g.K; asm volatile("" : "+s"(K_));
    const int K = K_, nt = K / BK;
    unsigned voffA[2], voffB[2];
#pragma unroll
    for (int i = 0; i < 2; ++i) { int R, C; stage_rc(tid * 16 + i * 8192, R, C); const int Rb = Epi::PERM ? ((R & ~31) + perm32(R & 31)) : R;
        voffA[i] = (unsigned)(R * K + C) * 2u; voffB[i] = (unsigned)(Rb * K + C) * 2u; }
    const size_t kstep = (size_t)(BK * 2);
    const size_t hstep = (size_t)HALF * K * 2;
    const size_t tstep = 2 * hstep;
    const unsigned ldsw = (unsigned)wid * 1024u;
    const int aoff = lds_byte(wr * 64 + fr, fq * 8), boff = lds_byte(wc * 32 + fr, fq * 8);
#define PG8_SA(b, h) (((b) * 2 + (h)) * HTB)
#define PG8_SB(b, h) ((4 + (b) * 2 + (h)) * HTB)
#define PG8_STAGE(bufoff, gbase, voff) do { _Pragma("unroll") for (int _i = 0; _i < 2; ++_i) \
        __builtin_amdgcn_global_load_lds((const unsigned*)((const char*)(gbase) + (voff)[_i]), (PG8_LAS unsigned*)(lds + (bufoff) + ldsw + _i * 8192), 16, 0, 0); } while (0)
#define PG8_LDA(dst, b, h) do { _Pragma("unroll") for (int m = 0; m < 4; ++m) _Pragma("unroll") for (int k = 0; k < 2; ++k) dst[m][k] = *(const PG8_LAS bf16x8*)(lds + PG8_SA(b, h) + aoff + m * 2048 + k * 1024); } while (0)
#define PG8_LDB(dst, b, h) do { _Pragma("unroll") for (int n = 0; n < 2; ++n) _Pragma("unroll") for (int k = 0; k < 2; ++k) dst[n][k] = *(const PG8_LAS bf16x8*)(lds + PG8_SB(b, h) + boff + n * 2048 + k * 1024); } while (0)
#define PG8_MMA(ai, bj, At, Bt) do { __builtin_amdgcn_s_setprio(1); _Pragma("unroll") for (int m = 0; m < 4; ++m) _Pragma("unroll") for (int n = 0; n < 2; ++n) _Pragma("unroll") for (int k = 0; k < 2; ++k) \
        acc[ai][bj][m][n] = __builtin_amdgcn_mfma_f32_16x16x32_bf16(Bt[n][k], At[m][k], acc[ai][bj][m][n], 0, 0, 0); __builtin_amdgcn_s_setprio(0); } while (0)
#define PG8_WAIT_V(n) asm volatile("s_waitcnt vmcnt(" #n ")" ::: "memory")
#define PG8_WAIT_L(n) asm volatile("s_waitcnt lgkmcnt(" #n ")" ::: "memory")
#define PG8_BAR __builtin_amdgcn_s_barrier()
#define PG8_SCHED __builtin_amdgcn_sched_barrier(0)
    Unit cur, nxt; int ui = 0;
    if (!S.next(0, cur)) return;
    f32x4 acc[2][2][4][2];
#pragma unroll
    for (int a = 0; a < 2; ++a)
#pragma unroll
        for (int b = 0; b < 2; ++b)
#pragma unroll
            for (int m = 0; m < 4; ++m)
#pragma unroll
                for (int n = 0; n < 2; ++n) acc[a][b][m][n] = (f32x4){0.f, 0.f, 0.f, 0.f};
    bf16x8 At[4][2], B0[2][2], B1[2][2];
    const char* cA = (const char*)g.A + (size_t)cur.pm * tstep; const char* cB = (const char*)g.Bt + (size_t)cur.pn * tstep;
    S.a_ready(cur);
    if constexpr (SP2) {
        PG8_STAGE(PG8_SB(0, 0), cB, voffB); PG8_STAGE(PG8_SB(0, 1), cB + hstep, voffB); PG8_STAGE(PG8_SA(0, 0), cA, voffA); PG8_STAGE(PG8_SA(0, 1), cA + hstep, voffA);
        if (wr == 1) PG8_BAR;
        PG8_WAIT_V(2); PG8_BAR;
        PG8_STAGE(PG8_SB(1, 0), cB + kstep, voffB); PG8_STAGE(PG8_SA(1, 0), cA + kstep, voffA); PG8_STAGE(PG8_SB(1, 1), cB + hstep + kstep, voffB);
        PG8_WAIT_V(6); PG8_BAR;
    } else {
        PG8_STAGE(PG8_SB(0, 0), cB, voffB); PG8_STAGE(PG8_SA(0, 0), cA, voffA); PG8_STAGE(PG8_SB(0, 1), cB + hstep, voffB); PG8_STAGE(PG8_SA(0, 1), cA + hstep, voffA);
        if (wr == 1) PG8_BAR;
        PG8_WAIT_V(4); PG8_BAR;
        PG8_STAGE(PG8_SB(1, 0), cB + kstep, voffB); PG8_STAGE(PG8_SA(1, 0), cA + kstep, voffA); PG8_STAGE(PG8_SB(1, 1), cB + hstep + kstep, voffB);
        PG8_WAIT_V(6); PG8_BAR;
    }
    for (;;) {
        const bool has_next = S.next(ui + 1, nxt);
        const char* nA = has_next ? (const char*)g.A + (size_t)nxt.pm * tstep : cA; const char* nB = has_next ? (const char*)g.Bt + (size_t)nxt.pn * tstep : cB;
        for (int t = 0; t < nt; t += 2) {
            const bool last = (t == nt - 2);
            const char* a1 = cA + (size_t)(t + 1) * kstep;
            const char* a2 = last ? nA : cA + (size_t)(t + 2) * kstep; const char* b2 = last ? nB : cB + (size_t)(t + 2) * kstep;
            const char* a3 = a2 + kstep; const char* b3 = b2 + kstep;
            if (last && has_next) S.a_ready(nxt);
            if constexpr (SP2) {
            PG8_LDB(B0, 0, 0); PG8_LDB(B1, 0, 1); PG8_SCHED; PG8_LDA(At, 0, 0); PG8_STAGE(PG8_SA(1, 1), a1 + hstep, voffA);
            PG8_WAIT_V(8); PG8_WAIT_L(0); PG8_BAR; PG8_MMA(0, 0, At, B0); PG8_MMA(0, 1, At, B1); PG8_BAR; PG8_SCHED;
            PG8_LDA(At, 0, 1); PG8_STAGE(PG8_SB(0, 0), b2, voffB); PG8_STAGE(PG8_SB(0, 1), b2 + hstep, voffB); PG8_STAGE(PG8_SA(0, 0), a2, voffA);
            PG8_WAIT_V(8); PG8_WAIT_L(0); PG8_BAR; PG8_MMA(1, 0, At, B0); PG8_MMA(1, 1, At, B1); PG8_BAR; PG8_SCHED;
            PG8_LDB(B0, 1, 0); PG8_LDB(B1, 1, 1); PG8_SCHED; PG8_LDA(At, 1, 0); PG8_STAGE(PG8_SA(0, 1), a2 + hstep, voffA);
            PG8_WAIT_V(8); PG8_WAIT_L(0); PG8_BAR; PG8_MMA(0, 0, At, B0); PG8_MMA(0, 1, At, B1); PG8_BAR; PG8_SCHED;
            PG8_LDA(At, 1, 1); PG8_STAGE(PG8_SB(1, 0), b3, voffB); PG8_STAGE(PG8_SB(1, 1), b3 + hstep, voffB); PG8_STAGE(PG8_SA(1, 0), a3, voffA);
            PG8_WAIT_V(8); PG8_WAIT_L(0); PG8_BAR; PG8_MMA(1, 0, At, B0); PG8_MMA(1, 1, At, B1); PG8_BAR; PG8_SCHED;
            } else {
            PG8_LDB(B0, 0, 0); PG8_SCHED; PG8_LDA(At, 0, 0); PG8_STAGE(PG8_SA(1, 1), a1 + hstep, voffA);
            PG8_WAIT_L(8); PG8_BAR; PG8_WAIT_L(0); PG8_MMA(0, 0, At, B0); PG8_BAR; PG8_SCHED;
            PG8_LDB(B1, 0, 1); PG8_STAGE(PG8_SB(0, 0), b2, voffB);
            PG8_BAR; PG8_WAIT_L(0); PG8_MMA(0, 1, At, B1); PG8_BAR;
            PG8_LDA(At, 0, 1); PG8_STAGE(PG8_SA(0, 0), a2, voffA);
            PG8_BAR; PG8_WAIT_L(0); PG8_MMA(1, 0, At, B0); PG8_BAR; PG8_SCHED;
            PG8_STAGE(PG8_SB(0, 1), b2 + hstep, voffB);
            PG8_WAIT_V(6); PG8_BAR; PG8_MMA(1, 1, At, B1); PG8_BAR;
            PG8_LDB(B0, 1, 0); PG8_SCHED; PG8_LDA(At, 1, 0); PG8_STAGE(PG8_SA(0, 1), a2 + hstep, voffA);
            PG8_WAIT_L(8); PG8_BAR; PG8_WAIT_L(0); PG8_MMA(0, 0, At, B0); PG8_BAR; PG8_SCHED;
            PG8_LDB(B1, 1, 1); PG8_STAGE(PG8_SB(1, 0), b3, voffB);
            PG8_BAR; PG8_WAIT_L(0); PG8_MMA(0, 1, At, B1); PG8_BAR;
            PG8_LDA(At, 1, 1); PG8_STAGE(PG8_SA(1, 0), a3, voffA);
            PG8_BAR; PG8_WAIT_L(0); PG8_MMA(1, 0, At, B0); PG8_BAR; PG8_SCHED;
            PG8_STAGE(PG8_SB(1, 1), b3 + hstep, voffB);
            PG8_WAIT_V(6); PG8_BAR; PG8_MMA(1, 1, At, B1); PG8_BAR;
            }
        }
        if constexpr (ALIGN_EPI) { if (wr == 0) PG8_BAR; }
        if constexpr (!Epi::AFTER_DRAIN) { E(acc, cur, wr, wc, fr, fq); S.done(cur); }
        if (!has_next) break;
#pragma unroll
        for (int a = 0; a < 2; ++a)
#pragma unroll
            for (int b = 0; b < 2; ++b)
#pragma unroll
                for (int m = 0; m < 4; ++m)
#pragma unroll
                    for (int n = 0; n < 2; ++n) acc[a][b][m][n] = (f32x4){0.f, 0.f, 0.f, 0.f};
        cur = nxt; cA = nA; cB = nB; ++ui;
        if constexpr (ALIGN_EPI) { if (wr == 1) PG8_BAR; }
    }
    PG8_WAIT_V(0);
    if constexpr (!ALIGN_EPI) { if (wr == 0) PG8_BAR; }
    PG8_BAR;
    if constexpr (Epi::AFTER_DRAIN) { E.fused(acc, cur, wr, wc, fr, fq, lds, wid, lane); S.done(cur); }
#undef PG8_SA
#undef PG8_SB
#undef PG8_STAGE
#undef PG8_LDA
#undef PG8_LDB
#undef PG8_MMA
#undef PG8_WAIT_V
#undef PG8_WAIT_L
#undef PG8_BAR
#undef PG8_SCHED
}
}
constexpr int NWAVES = 8, NTHREADS = 512;
constexpr int D = 1024, MP = 16384, MS = 1024, M = MP + MS, NSEQ = 136, FF = 2816;
constexpr int PSEQ = 2048, SSEQ = 8, NPB = 8, NSB = 128;
constexpr int ZW = 3328;
constexpr int ZQ = 0, ZK = 512, ZV = 1024, ZO = 1536, ZXR = 2048, ZGR = 2560, ZIG = 3072, ZFG = 3076;
constexpr int RKW = 3072, WAGW = 3072;
constexpr float ALPHA = 1.41421356237f;
constexpr float LN_EPS = 1e-5f, HEAD_EPS = 1e-6f, RW_EPS = 64e-5f;
constexpr float MSCALE = 0.08838834764831845f;

constexpr size_t O_Y = 0, O_PMC = 17825792, O_PMN = 18350080, O_PMM = 18354176, O_PRH = 18354208, O_PRC = 18358304, O_PWKV = 18370592, O_PSH = 18894880,
                 O_SMC = 18903072, O_SMN = 27291680, O_SMM = 27357216, O_SRH = 27357728, O_SRC = 27423264, O_SWKV = 27619872, O_SSH = 36008480, O_END = 36139552;

constexpr size_t MiB = 1u << 20;
constexpr size_t WS_CTL = 0, CTL_ZERO_BYTES = 1 * MiB;
constexpr size_t WS_W13 = 1 * MiB;
constexpr size_t WS_W2 = 45 * MiB;
constexpr size_t WS_WIN = 67 * MiB;
constexpr size_t WS_WOUT = WS_WIN + 6815744;
constexpr size_t WS_WRK = WS_WOUT + 2 * MiB;
constexpr size_t WS_WL2 = WS_WRK + 13 * MiB;
constexpr size_t WS_WO = WS_WL2 + 1572864;
constexpr size_t WS_MOD = 92 * MiB;
constexpr size_t WS_H = 102 * MiB;
constexpr size_t WS_BIG = 136 * MiB;
constexpr size_t WS_HID = WS_BIG;
constexpr size_t WS_Z = WS_BIG;
constexpr size_t WS_CST = WS_BIG + 111 * MiB;
constexpr size_t WS_RGH = WS_BIG + 143 * MiB;
constexpr size_t WS_RGP = WS_BIG + 175 * MiB;
constexpr size_t WS_NST = WS_BIG + 207 * MiB;
constexpr size_t WS_MST = WS_NST + 262144;
constexpr size_t WS_CARRY = WS_MST + 8192;
constexpr size_t WS_RK = WS_BIG;
constexpr size_t WS_A3 = WS_BIG + 102 * MiB;
constexpr size_t WS_A2 = WS_BIG + 111 * MiB;
constexpr size_t WS_WAG = WS_BIG + 111 * MiB;
constexpr size_t WS_END = WS_BIG + 213 * MiB;
static_assert(WS_WO + 2 * MiB <= WS_MOD && WS_MOD + (size_t)2 * 136 * 9216 * 4 <= WS_H && WS_H + (size_t)M * D * 2 <= WS_BIG, "ws map");
static_assert(WS_CARRY + 8 * 64 * 512 * 4 <= WS_END && WS_WAG + (size_t)M * WAGW * 2 <= WS_END && WS_A3 + (size_t)M * 256 * 2 <= WS_A2, "ws map 2");
constexpr int CW_BAR = 4096;

constexpr int LDS_BYTES = 147456;
constexpr int LDSCTL_OFF = LDS_BYTES - 512;
constexpr int MISC_OFF = LDSCTL_OFF;

#define GAS __attribute__((address_space(1)))
#define LAS __attribute__((address_space(3)))
typedef unsigned short bf16;
typedef unsigned v4u __attribute__((ext_vector_type(4)));
typedef unsigned v2u __attribute__((ext_vector_type(2)));
typedef float f32x4 __attribute__((ext_vector_type(4)));
typedef float f32x2 __attribute__((ext_vector_type(2)));
typedef float f32x16 __attribute__((ext_vector_type(16)));
typedef short bf16x8 __attribute__((ext_vector_type(8)));
typedef GAS unsigned gu32;
#define RLX_AGENT __ATOMIC_RELAXED, __HIP_MEMORY_SCOPE_AGENT
#define LDS_WAIT() asm volatile("s_waitcnt lgkmcnt(0)" ::: "memory")
#define DI __device__ __forceinline__
#define MFMA32(a, b, c) __builtin_amdgcn_mfma_f32_32x32x16_bf16((a), (b), (c), 0, 0, 0)
DI unsigned f2bf(float f) { unsigned u = __builtin_bit_cast(unsigned, f); return (u + 0x7fffu + ((u >> 16) & 1u)) >> 16; }
DI unsigned pk2(float lo, float hi) { return pg8::cvt_pk_bf16(lo, hi); }
DI float bf2f(unsigned b) { return __builtin_bit_cast(float, b << 16); }
DI float bflo(unsigned w) { return __builtin_bit_cast(float, w << 16); }
DI float bfhi(unsigned w) { return __builtin_bit_cast(float, w & 0xffff0000u); }
DI int crow(int reg, int h) { return (reg & 3) + 8 * (reg >> 2) + 4 * h; }
DI float fexp(float x) { return __builtin_amdgcn_exp2f(1.44269504f * x); }
DI float fsig(float x) { return pg8::fsig(x); }
DI bf16x8 mk_frag(unsigned a, unsigned b, unsigned c, unsigned d) { v4u p; p.x = a; p.y = b; p.z = c; p.w = d; return __builtin_bit_cast(bf16x8, p); }
DI bf16x8 pack8(const float (&v)[8]) { return mk_frag(pk2(v[0], v[1]), pk2(v[2], v[3]), pk2(v[4], v[5]), pk2(v[6], v[7])); }
DI float wave_sum(float v) {
#pragma unroll
    for (int o = 1; o < 64; o <<= 1) v += __shfl_xor(v, o);
    return v;
}

#define XB_TMO      128
#define XB_XCNT(j)  (256  + 64 * (j))
#define XB_XSUB(j)  (1280 + 64 * (j))
#define XB_XGEN(j)  (2304 + 64 * (j))
#define XB_TOP      3328
#define XB_TOPGEN   3392
#define XCD_BAR_WORDS 3456
#define XB_SPIN_CAP (1u << 18)

__device__ __forceinline__ unsigned xb_ld(unsigned* p)              { return __hip_atomic_load(p, __ATOMIC_RELAXED, __HIP_MEMORY_SCOPE_AGENT); }
__device__ __forceinline__ unsigned xb_add(unsigned* p, unsigned v) { return __hip_atomic_fetch_add(p, v, __ATOMIC_RELAXED, __HIP_MEMORY_SCOPE_AGENT); }
__device__ __forceinline__ unsigned xb_xcc_id() { return (unsigned)__builtin_amdgcn_s_getreg((3 << 11) | 20) & 0xFu; }
#define XB_SPIN(cond, bar) do { unsigned _sp = 0; while (cond) { __builtin_amdgcn_s_sleep(1); \
    if ((++_sp & 255u) == 0u) { if (xb_ld(&(bar)[XB_TMO])) break; if (_sp > XB_SPIN_CAP) { atomicAdd(&(bar)[XB_TMO], 1u); break; } } } } while (0)

struct XcdBarrier {
    unsigned* bar; unsigned x;
    volatile LAS unsigned* st;
};

__device__ __forceinline__ XcdBarrier xcd_barrier_post(unsigned* bar, volatile LAS unsigned* st) {
    XcdBarrier b; b.bar = bar; b.x = xb_xcc_id(); b.st = st;
    if (threadIdx.x == 0) (void)xb_add(&bar[XB_XCNT(b.x)], 1u);
    return b;
}
__device__ __forceinline__ void xcd_barrier_complete(unsigned* bar, unsigned x, unsigned& nloc, unsigned& nx) {
    const unsigned G = gridDim.x * gridDim.y * gridDim.z;
    unsigned sum, cnt, mine, sp = 0u;
    for (;;) {
        sum = 0u; cnt = 0u; mine = 0u;
#pragma unroll
        for (unsigned j = 0; j < 16; ++j) { const unsigned c = xb_ld(&bar[XB_XCNT(j)]); sum += c; cnt += (c > 0u) ? 1u : 0u; mine = (j == x) ? c : mine; }
        if (sum == G) break;
        __builtin_amdgcn_s_sleep(1);
        if ((++sp & 255u) == 0u) { if (xb_ld(&bar[XB_TMO])) break; if (sp > XB_SPIN_CAP) { atomicAdd(&bar[XB_TMO], 1u); break; } }
    }
    nloc = mine > 0u ? mine : 1u; nx = cnt > 0u ? cnt : 1u;
}

__device__ __forceinline__ void xcd_barrier(const XcdBarrier& b) {
    asm volatile("s_waitcnt vmcnt(0)" ::: "memory");
    __syncthreads();
    if (threadIdx.x == 0) {
        unsigned* bar = b.bar;
        __builtin_amdgcn_s_waitcnt(0);
        unsigned nloc = b.st[0], nx = b.st[1];
        if (nloc == 0u) { xcd_barrier_complete(bar, b.x, nloc, nx); b.st[0] = nloc; b.st[1] = nx; }
        const unsigned old = xb_add(&bar[XB_XSUB(b.x)], 1u);
        const unsigned gen = old / nloc;
        if (old + 1u == (gen + 1u) * nloc) {
            __builtin_amdgcn_fence(__ATOMIC_RELEASE, "agent");
            asm volatile("s_waitcnt vmcnt(0)" ::: "memory");
            const unsigned og = xb_add(&bar[XB_TOP], 1u);
            const unsigned tg = og / nx;
            if (og + 1u == (tg + 1u) * nx) xb_add(&bar[XB_TOPGEN], 1u);
            else XB_SPIN(xb_ld(&bar[XB_TOPGEN]) == tg, bar);
            __builtin_amdgcn_fence(__ATOMIC_ACQUIRE, "agent");
            xb_add(&bar[XB_XGEN(b.x)], 1u);
            asm volatile("s_waitcnt vmcnt(0)" ::: "memory");
        } else {
            XB_SPIN(xb_ld(&bar[XB_XGEN(b.x)]) == gen, bar);
            __builtin_amdgcn_fence(__ATOMIC_ACQUIRE, "agent");
            asm volatile("s_waitcnt vmcnt(0)" ::: "memory");
        }
    }
    __syncthreads();
}
struct Args { const float* in[47]; float* out; unsigned char* ws; int ph_lo, ph_hi; };
struct Frame {
    LAS unsigned char* lds;
    volatile LAS unsigned* MISC;
    gu32* ctl;
    int tid, lane, wave;
    int vcu, G;
    float* out;
    unsigned char* ws;
};
enum { I_XP = 0, I_XS, I_CP, I_CS, I_SMC, I_SMN, I_SMM, I_SRH, I_SRC, I_SWKV, I_SSH, I_ADAW, I_ADAB, I_LNG, I_LNB, I_W1, I_W3, I_W2, I_WIN, I_BG, I_MNG,
       I_CW, I_CB, I_WA, I_BA, I_WX, I_BX, I_LAM, I_WOUT, I_MU, I_WR, I_WK, I_WV, I_W0, I_LW1, I_LW2, I_A0, I_A1, I_A2, I_G1, I_G2, I_KK, I_KA, I_RK, I_LXG, I_LXB, I_WO };

DI void p0_mod(Frame& F, const Args& AR) {
    LAS float* T = (LAS float*)F.lds;
    const int r = F.lane & 31, hh = F.lane >> 5;
    const float* adaw = AR.in[I_ADAW]; const float* adab = AR.in[I_ADAB];
    float* mod = (float*)(F.ws + WS_MOD);
    for (int nb = F.vcu; nb < 576; nb += F.G) {
        for (int i = F.tid; i < 160 * 33; i += NTHREADS) T[i] = 0.f;
        __syncthreads();
        const int n0 = nb * 32, l = n0 / 9216, nc0 = n0 - l * 9216;
        const float* W = adaw + (size_t)l * 1024 * 9216 + nc0 + r;
        f32x16 acc[5];
#pragma unroll
        for (int mb = 0; mb < 5; ++mb)
#pragma unroll
            for (int i = 0; i < 16; ++i) acc[mb][i] = 0.f;
#pragma unroll 2
        for (int ks = 0; ks < 8; ++ks) {
            const int k0 = F.wave * 128 + ks * 16 + 8 * hh;
            float a[8];
#pragma unroll
            for (int j = 0; j < 8; ++j) a[j] = W[(size_t)(k0 + j) * 9216];
            const bf16x8 A = pack8(a);
#pragma unroll
            for (int mb = 0; mb < 5; ++mb) {
                const int m = mb * 32 + r;
                float c[8];
                if (m < NSEQ) {
                    const float* cp = (m < NPB ? AR.in[I_CP] + (size_t)m * D : AR.in[I_CS] + (size_t)(m - NPB) * D) + k0;
                    const f32x4 c0 = *(const f32x4*)cp, c1 = *(const f32x4*)(cp + 4);
                    c[0] = c0[0]; c[1] = c0[1]; c[2] = c0[2]; c[3] = c0[3]; c[4] = c1[0]; c[5] = c1[1]; c[6] = c1[2]; c[7] = c1[3];
#pragma unroll
                    for (int j = 0; j < 8; ++j) c[j] = c[j] * fsig(c[j]);
                } else {
#pragma unroll
                    for (int j = 0; j < 8; ++j) c[j] = 0.f;
                }
                acc[mb] = MFMA32(A, pack8(c), acc[mb]);
            }
        }
#pragma unroll
        for (int mb = 0; mb < 5; ++mb)
#pragma unroll
            for (int i = 0; i < 16; ++i) __hip_atomic_fetch_add(&T[(mb * 32 + r) * 33 + crow(i, hh)], acc[mb][i], __ATOMIC_RELAXED, __HIP_MEMORY_SCOPE_WORKGROUP);
        __syncthreads();
        for (int m = F.tid >> 5; m < NSEQ; m += 16) { const int n = F.tid & 31; mod[(size_t)(l * NSEQ + m) * 9216 + nc0 + n] = T[m * 33 + n] + adab[l * 9216 + nc0 + n]; }
        __syncthreads();
    }
}

DI void tr_item(const float* src, int ld, int nvalid, const float* sc, int scmode, bf16* dst, int dld, LAS float* scr, int lane) {
#pragma unroll 8
    for (int i = 0; i < 32; ++i) { const int kk = 2 * i + (lane >> 5), n = lane & 31; float v = 0.f;
        if (src != nullptr && n < nvalid) { v = src[(size_t)kk * ld + n]; if (scmode == 1) v *= sc[kk]; else if (scmode == 2) v *= (1.0f - sc[kk]); }
        scr[kk * 33 + n] = v; }
    LDS_WAIT(); asm volatile("" ::: "memory");
    const int c = lane & 7;
#pragma unroll
    for (int j = 0; j < 4; ++j) { const int n = (lane >> 3) + 8 * j; const LAS float* s = scr + (8 * c) * 33 + n;
        v4u o; o.x = pk2(s[0 * 33], s[1 * 33]); o.y = pk2(s[2 * 33], s[3 * 33]); o.z = pk2(s[4 * 33], s[5 * 33]); o.w = pk2(s[6 * 33], s[7 * 33]);
        *(GAS v4u*)(dst + (size_t)n * dld + 8 * c) = o; }
    LDS_WAIT(); asm volatile("" ::: "memory");
}
DI void p0_weights(Frame& F, const Args& AR) {
    LAS float* scr = (LAS float*)(F.lds + 32768 + F.wave * 8704);
    const int gw = F.vcu * NWAVES + F.wave, NGW = F.G * NWAVES;
    constexpr int I_13 = 16 * 176, I_2 = 44 * 32, I_IN = 16 * 104, I_SQ = 16 * 32, I_RKI = 32 * 104, I_L2 = 4 * 96;
    constexpr int NITEMS = 4 * I_13 + 4 * I_2 + I_IN + 2 * I_SQ + I_RKI + I_L2;
    bf16* W13 = (bf16*)(F.ws + WS_W13); bf16* W2 = (bf16*)(F.ws + WS_W2); bf16* WIN = (bf16*)(F.ws + WS_WIN); bf16* WOUT = (bf16*)(F.ws + WS_WOUT);
    bf16* WRK = (bf16*)(F.ws + WS_WRK); bf16* WL2 = (bf16*)(F.ws + WS_WL2); bf16* WO = (bf16*)(F.ws + WS_WO);
    for (int it = gw; it < NITEMS; it += NGW) {
        int r = it;
        if (r < 4 * I_13) { const int f = r / I_13; r -= f * I_13; const int kt = r / 176, tn = r % 176, j = tn >> 3, i = tn & 7;
            const float* src = (i < 4 ? AR.in[I_W1] : AR.in[I_W3]) + (size_t)f * 1024 * FF + (size_t)(64 * kt) * FF + 128 * j + 32 * (i & 3);
            tr_item(src, FF, 32, nullptr, 0, W13 + (size_t)f * 5632 * 1024 + (size_t)(32 * tn) * 1024 + 64 * kt, 1024, scr, F.lane); continue; }
        r -= 4 * I_13;
        if (r < 4 * I_2) { const int f = r / I_2; r -= f * I_2; const int kt = r / 32, tn = r % 32;
            const float* src = AR.in[I_W2] + (size_t)f * FF * 1024 + (size_t)(64 * kt) * 1024 + 32 * tn;
            tr_item(src, 1024, 32, nullptr, 0, W2 + (size_t)f * 1024 * FF + (size_t)(32 * tn) * FF + 64 * kt, FF, scr, F.lane); continue; }
        r -= 4 * I_2;
        if (r < I_IN) { const int kt = r / 104, tn = r % 104, nd = 32 * tn; int sc0 = 0, nv = 32; bool has = true;
            if (nd < 2048) sc0 = nd; else if (nd < 3072) sc0 = nd + 8; else if (nd == 3072) { sc0 = 2048; nv = 8; } else has = false;
            const float* src = has ? AR.in[I_WIN] + (size_t)(64 * kt) * 3080 + sc0 : nullptr;
            tr_item(src, 3080, nv, nullptr, 0, WIN + (size_t)nd * 1024 + 64 * kt, 1024, scr, F.lane); continue; }
        r -= I_IN;
        if (r < 2 * I_SQ) { const int w = r / I_SQ; r -= w * I_SQ; const int kt = r / 32, tn = r % 32;
            const float* src = (w == 0 ? AR.in[I_WOUT] : AR.in[I_WO]) + (size_t)(64 * kt) * 1024 + 32 * tn;
            tr_item(src, 1024, 32, nullptr, 0, (w == 0 ? WOUT : WO) + (size_t)(32 * tn) * 1024 + 64 * kt, 1024, scr, F.lane); continue; }
        r -= 2 * I_SQ;
        if (r < I_RKI) { const int kt = r / 104, tn = r % 104, nd = 32 * tn, kd = 64 * kt, half = kd >= 1024, ks = kd & 1023;
            const float* base; int ld, col, mi;
            if (nd < 1024) { base = AR.in[I_WR]; ld = 1024; col = nd; mi = 0; }
            else if (nd < 2048) { base = AR.in[I_WK]; ld = 1024; col = nd - 1024; mi = 2; }
            else if (nd < 3072) { base = AR.in[I_WV]; ld = 1024; col = nd - 2048; mi = 3; }
            else if (nd < 3136) { base = AR.in[I_LW1]; ld = 64; col = nd - 3072; mi = 1; }
            else if (nd < 3200) { base = AR.in[I_A1]; ld = 64; col = nd - 3136; mi = 4; }
            else { base = AR.in[I_G1]; ld = 128; col = nd - 3200; mi = 5; }
            tr_item(base + (size_t)ks * ld + col, ld, 32, AR.in[I_MU] + mi * 1024 + ks, half ? 1 : 2, WRK + (size_t)nd * 2048 + kd, 2048, scr, F.lane); continue; }
        r -= I_RKI;
        { const int kt = r / 96, tn = r % 96, nd = 32 * tn; const float* src = nullptr;
            if (nd < 1024) { if (kt == 0) src = AR.in[I_LW2] + nd; }
            else if (nd < 2048) { if (kt == 1) src = AR.in[I_A2] + (nd - 1024); }
            else { if (kt >= 2) src = AR.in[I_G2] + (size_t)(64 * (kt - 2)) * 1024 + (nd - 2048); }
            tr_item(src, 1024, 32, nullptr, 0, WL2 + (size_t)nd * 256 + 64 * kt, 256, scr, F.lane); }
    }
}

DI void ln_pass(Frame& F, const Args& AR, int first, int do_ln, int l, int sub, int lm, int js, int mode) {
    const int gw = F.vcu * NWAVES + F.wave, NGW = F.G * NWAVES, lane = F.lane;
    float* X = F.out + O_Y;
    const float* lg = AR.in[I_LNG] + (l * 3 + sub) * 1024; const float* lb = AR.in[I_LNB] + (l * 3 + sub) * 1024;
    const float* mod = (const float*)(F.ws + WS_MOD);
    bf16* H = (bf16*)(F.ws + WS_H); bf16* A2 = (bf16*)(F.ws + WS_A2);
    for (int r = gw; r < M; r += NGW) {
        const float* src = first ? (r < MP ? AR.in[I_XP] + (size_t)r * D : AR.in[I_XS] + (size_t)(r - MP) * D) : X + (size_t)r * D;
        f32x4 v[4];
#pragma unroll
        for (int j = 0; j < 4; ++j) v[j] = ((const f32x4*)src)[lane + 64 * j];
        if (do_ln) {
            float s = 0.f;
#pragma unroll
            for (int j = 0; j < 4; ++j) s += (v[j].x + v[j].y) + (v[j].z + v[j].w);
            const float mean = wave_sum(s) * (1.f / D); float s2 = 0.f;
#pragma unroll
            for (int j = 0; j < 4; ++j) { v[j] = v[j] - mean; s2 += (v[j].x * v[j].x + v[j].y * v[j].y) + (v[j].z * v[j].z + v[j].w * v[j].w); }
            const float rstd = 1.f / sqrtf(wave_sum(s2) * (1.f / D) + LN_EPS);
#pragma unroll
            for (int j = 0; j < 4; ++j) { const f32x4 g4 = ((const f32x4*)lg)[lane + 64 * j], b4 = ((const f32x4*)lb)[lane + 64 * j]; v[j] = v[j] * rstd * g4 + b4;
                ((f32x4*)(X + (size_t)r * D))[lane + 64 * j] = v[j]; }
        }
        if (mode != 2) {
            const int mr = pg8::mod_row(r);
            const float* sh = mod + ((size_t)(lm * NSEQ + mr) * 9 + js) * 1024; const float* sc = sh + 1024;
            int t, len, b; if (r < MP) { t = r & (PSEQ - 1); len = PSEQ; b = r >> 11; } else { t = (r - MP) & (SSEQ - 1); len = SSEQ; b = (r - MP) >> 3; }
#pragma unroll
            for (int j = 0; j < 4; ++j) { const f32x4 s4 = ((const f32x4*)sc)[lane + 64 * j], h4 = ((const f32x4*)sh)[lane + 64 * j];
                const f32x4 h = v[j] * (s4 + 1.0f) + h4; v2u w; w.x = pk2(h.x, h.y); w.y = pk2(h.z, h.w); const int col = 4 * (lane + 64 * j);
                if (mode == 0) *(v2u*)(H + (size_t)r * D + col) = w;
                else {
                    *(v2u*)(A2 + (size_t)r * 2048 + col) = w;
                    if (t + 1 < len) *(v2u*)(A2 + (size_t)(r + 1) * 2048 + 1024 + col) = w;
                    if (t == 0) { v2u p; p.x = 0u; p.y = 0u;
                        if (r >= MP) { const f32x4 q = *(const f32x4*)(AR.in[I_SSH] + (size_t)b * D + col); p.x = pk2(q.x, q.y); p.y = pk2(q.z, q.w); }
                        *(v2u*)(A2 + (size_t)r * 2048 + 1024 + col) = p; }
                    if (t == len - 1) *(f32x4*)(F.out + (r < MP ? O_PSH : O_SSH) + (size_t)b * D + col) = h;
                } }
        }
    }
}

DI float log_sigmoid(float x) { return -(fmaxf(-x, 0.f) + log1pf(__expf(-fabsf(x)))); }
DI float gelu_tanh(float x) { const float u = 0.7978845608f * (x + 0.044715f * x * x * x); return 0.5f * x * (1.0f + pg8::ftanh(u)); }

DI void ml1_prompt(Frame& F, const Args& AR) {
    const bf16* Z = (const bf16*)(F.ws + WS_Z);
    float* CST = (float*)(F.ws + WS_CST); float* NST = (float*)(F.ws + WS_NST); float* MST = (float*)(F.ws + WS_MST);
    LAS bf16* Ks = (LAS bf16*)F.lds;
    LAS bf16* Vs = (LAS bf16*)(F.lds + 32768);
    LAS float* LF = (LAS float*)(F.lds + 65536);
    LAS float* GS = (LAS float*)(F.lds + 65536 + 512);
    LAS float* RED = (LAS float*)(F.lds + 65536 + 1024);
    const int tid = F.tid, lane = F.lane, wave = F.wave, r = lane & 31, hh = lane >> 5;
    for (int item = F.vcu; item < 512; item += F.G) {
        const int b = item >> 6, h = (item >> 4) & 3, c = item & 15; const size_t row0 = (size_t)b * PSEQ + c * 128;
#pragma unroll
        for (int i = 0; i < 4; ++i) { const int e = tid + i * NTHREADS, s = e >> 4, c8 = (e & 15) * 8;
            *(LAS v4u*)(Ks + s * 128 + c8) = *(const v4u*)(Z + (row0 + s) * ZW + ZK + h * 128 + c8);
            *(LAS v4u*)(Vs + s * 128 + c8) = *(const v4u*)(Z + (row0 + s) * ZW + ZV + h * 128 + c8); }
        if (tid < 128) { const float fg = bf2f(Z[(row0 + tid) * ZW + ZFG + h]); LF[tid] = log_sigmoid(fg + AR.in[I_BG][4 + h]); }
        __syncthreads();
        if (tid < 128) { float bs = 0.f; for (int s = 0; s <= tid; ++s) bs += LF[s];
            const float ig = bf2f(Z[(row0 + tid) * ZW + ZIG + h]) + AR.in[I_BG][h];
            GS[tid] = ig - bs; if (tid == 127) RED[0] = bs; }
        __syncthreads();
        float gmax = -INFINITY; for (int s = 0; s < 128; ++s) gmax = fmaxf(gmax, GS[s]);
        const float bL = RED[0];
        __syncthreads();
        if (tid < 128) GS[tid] = fexp(GS[tid] - gmax);
        __syncthreads();
        const int vb = wave >> 1, kb0 = 2 * (wave & 1);
        f32x16 acc[2];
#pragma unroll
        for (int i = 0; i < 16; ++i) { acc[0][i] = 0.f; acc[1][i] = 0.f; }
#pragma unroll 2
        for (int ks = 0; ks < 8; ++ks) { const int s0 = 16 * ks + 8 * hh;
            float a[8];
#pragma unroll
            for (int j = 0; j < 8; ++j) a[j] = bf2f(Vs[(s0 + j) * 128 + vb * 32 + r]) * GS[s0 + j];
            const bf16x8 A = pack8(a);
#pragma unroll
            for (int q = 0; q < 2; ++q) { unsigned kw[8];
#pragma unroll
                for (int j = 0; j < 8; ++j) kw[j] = Ks[(s0 + j) * 128 + (kb0 + q) * 32 + r];
                const bf16x8 B = mk_frag(kw[0] | (kw[1] << 16), kw[2] | (kw[3] << 16), kw[4] | (kw[5] << 16), kw[6] | (kw[7] << 16));
                acc[q] = MFMA32(A, B, acc[q]); } }
        float* Co = CST + (size_t)item * 16384;
#pragma unroll
        for (int q = 0; q < 2; ++q)
#pragma unroll
            for (int i = 0; i < 16; ++i) Co[(vb * 32 + crow(i, hh)) * 128 + (kb0 + q) * 32 + r] = acc[q][i] * MSCALE;
        if (tid < 128) { float n = 0.f; for (int s = 0; s < 128; ++s) n += GS[s] * bf2f(Ks[s * 128 + tid]); NST[item * 128 + tid] = n * MSCALE; }
        if (tid == 0) { MST[item * 4 + 0] = bL + gmax; MST[item * 4 + 1] = bL; }
        __syncthreads();
    }
}

DI void ml_sample(Frame& F, const Args& AR) {
    const bf16* Z = (const bf16*)(F.ws + WS_Z); bf16* G = (bf16*)(F.ws + WS_H);
    LAS float* Qs = (LAS float*)F.lds;
    LAS float* Ks = Qs + 1024; LAS float* Vs = Ks + 1024;
    LAS float* HT = Vs + 1024;
    LAS float* P = HT + 1024;
    LAS float* GT = P + 64;
    LAS float* SC = GT + 64;
    const int tid = F.tid, lane = F.lane, wave = F.wave;
    const float* C0g = AR.in[I_SMC]; const float* n0g = AR.in[I_SMN]; const float* m0g = AR.in[I_SMM];
    for (int item = F.vcu; item < 512; item += F.G) {
        const int b = item >> 2, h = item & 3; const size_t row0 = (size_t)MP + (size_t)b * SSEQ;
        for (int e = tid; e < 3 * 512; e += NTHREADS) { const int w = e >> 9, t = (e >> 6) & 7, c2 = (e & 63) * 2;
            const unsigned u = *(const unsigned*)(Z + (row0 + t) * ZW + (w == 0 ? ZQ : (w == 1 ? ZK : ZV)) + h * 128 + c2);
            LAS float* dst = (w == 0 ? Qs : (w == 1 ? Ks : Vs)) + t * 128 + c2; dst[0] = bflo(u); dst[1] = bfhi(u); }
        const float m0 = m0g[b * 4 + h];
        if (tid < 8) { float bs = 0.f, bsl = 0.f;
            for (int s = 0; s < 8; ++s) { const float lf = log_sigmoid(bf2f(Z[(row0 + s) * ZW + ZFG + h]) + AR.in[I_BG][4 + h]); bs += lf; if (s <= tid) bsl = bs; }
            float mx = m0, gme = 0.f;
            for (int s = 0; s < 8; ++s) { float bq = 0.f; for (int q = 0; q <= s; ++q) bq += log_sigmoid(bf2f(Z[(row0 + q) * ZW + ZFG + h]) + AR.in[I_BG][4 + h]);
                const float g = bf2f(Z[(row0 + s) * ZW + ZIG + h]) + AR.in[I_BG][h] - bq; if (s <= tid) mx = fmaxf(mx, g); if (s == tid) gme = g; }
            GT[0 * 8 + tid] = bsl; GT[1 * 8 + tid] = gme; GT[2 * 8 + tid] = mx; GT[3 * 8 + tid] = fexp(m0 - mx);
            if (tid == 7) { const float mend = bsl + mx; SC[0] = mend; SC[1] = fexp(bsl + m0 - mend); } }
        __syncthreads();
        if (tid < 8) { const float mend = SC[0]; GT[5 * 8 + tid] = fexp(GT[0 * 8 + 7] + GT[1 * 8 + tid] - mend); }
        if (tid < 64) { const int t = tid >> 3, s = tid & 7; float d = 0.f;
            if (s <= t) { for (int k = 0; k < 128; ++k) d += Qs[t * 128 + k] * Ks[s * 128 + k]; d = d * MSCALE * fexp(GT[1 * 8 + s] - GT[2 * 8 + t]); }
            P[t * 8 + s] = d; }
        else if (tid < 72) { const int t = tid - 64; float d = 0.f; for (int k = 0; k < 128; ++k) d += Qs[t * 128 + k] * n0g[(size_t)(b * 4 + h) * 128 + k]; GT[6 * 8 + t] = d; }
        __syncthreads();
        if (tid < 8) { float d = 0.f; for (int s = 0; s < 8; ++s) d += P[tid * 8 + s]; d += GT[3 * 8 + tid] * GT[6 * 8 + tid];
            const float mt = GT[0 * 8 + tid] + GT[2 * 8 + tid]; GT[4 * 8 + tid] = fmaxf(fabsf(d), fexp(-mt)); }
        const int v = tid >> 2, seg = tid & 3;
        const float* C0p = C0g + ((size_t)(b * 4 + h) * 128 + v) * 128 + seg * 32;
        float c0[32];
#pragma unroll
        for (int i = 0; i < 8; ++i) { const f32x4 q = *(const f32x4*)(C0p + 4 * i); c0[4 * i] = q.x; c0[4 * i + 1] = q.y; c0[4 * i + 2] = q.z; c0[4 * i + 3] = q.w; }
        __syncthreads();
        float inter[8];
#pragma unroll
        for (int t = 0; t < 8; ++t) { float d = 0.f;
#pragma unroll
            for (int i = 0; i < 32; ++i) d += c0[i] * Qs[t * 128 + seg * 32 + i];
            d += __shfl_xor(d, 1); d += __shfl_xor(d, 2); inter[t] = d; }
        if (seg == 0) {
#pragma unroll
            for (int t = 0; t < 8; ++t) { float num = GT[3 * 8 + t] * inter[t];
                for (int s = 0; s <= t; ++s) num += P[t * 8 + s] * Vs[s * 128 + v];
                HT[t * 128 + v] = num / GT[4 * 8 + t]; } }
        { const float wst = SC[1]; float* Cout = F.out + O_SMC + ((size_t)(b * 4 + h) * 128 + v) * 128 + seg * 32;
#pragma unroll
            for (int i = 0; i < 32; ++i) c0[i] *= wst;
#pragma unroll
            for (int s = 0; s < 8; ++s) { const float wv = GT[5 * 8 + s] * Vs[s * 128 + v] * MSCALE;
#pragma unroll
                for (int i = 0; i < 32; ++i) c0[i] += wv * Ks[s * 128 + seg * 32 + i]; }
#pragma unroll
            for (int i = 0; i < 8; ++i) { f32x4 q; q.x = c0[4 * i]; q.y = c0[4 * i + 1]; q.z = c0[4 * i + 2]; q.w = c0[4 * i + 3]; *(f32x4*)(Cout + 4 * i) = q; } }
        if (tid < 128) { float n = SC[1] * n0g[(size_t)(b * 4 + h) * 128 + tid];
            for (int s = 0; s < 8; ++s) n += GT[5 * 8 + s] * Ks[s * 128 + tid] * MSCALE;
            F.out[O_SMN + (size_t)(b * 4 + h) * 128 + tid] = n; }
        if (tid == 0) F.out[O_SMM + b * 4 + h] = SC[0];
        __syncthreads();
        { const int t = wave; const float x0 = HT[t * 128 + lane], x1 = HT[t * 128 + 64 + lane];
            const float mean = wave_sum(x0 + x1) * (1.f / 128.f); const float d0 = x0 - mean, d1 = x1 - mean;
            const float rstd = 1.f / sqrtf(wave_sum(d0 * d0 + d1 * d1) * (1.f / 128.f) + HEAD_EPS);
            const size_t row = row0 + t;
            const float o0 = bf2f(Z[row * ZW + ZO + h * 128 + lane]), o1 = bf2f(Z[row * ZW + ZO + h * 128 + 64 + lane]);
            const float g0 = AR.in[I_MNG][h * 128 + lane], g1 = AR.in[I_MNG][h * 128 + 64 + lane];
            G[row * D + h * 128 + lane] = (bf16)f2bf(d0 * rstd * g0 * fsig(o0)); G[row * D + h * 128 + 64 + lane] = (bf16)f2bf(d1 * rstd * g1 * fsig(o1)); }
        __syncthreads();
    }
}

DI void rg1(Frame& F, const Args& AR) {
    const bf16* Z = (const bf16*)(F.ws + WS_Z); bf16* G = (bf16*)(F.ws + WS_H);
    float* RGH = (float*)(F.ws + WS_RGH); float* RGP = (float*)(F.ws + WS_RGP);
    const int lane = F.lane, g = F.wave, r = lane & 31, hh = lane >> 5;
    LAS float* XT = (LAS float*)(F.lds + g * 17408);
    LAS float* AT = XT + 32 * 68;
    const float* wa = AR.in[I_WA] + (size_t)g * 4096; const float* wx = AR.in[I_WX] + (size_t)g * 4096;
    float spl[2], ba[2], bx[2];
#pragma unroll
    for (int cb = 0; cb < 2; ++cb) { const int c = 64 * g + cb * 32 + r; spl[cb] = -8.0f * log1pf(__expf(-AR.in[I_LAM][c])); ba[cb] = AR.in[I_BA][c]; bx[cb] = AR.in[I_BX][c]; }
    const float* cw = AR.in[I_CW]; const float* cbias = AR.in[I_CB];
    for (int tt = F.vcu; tt < M / 32; tt += F.G) {
        const int R0 = tt * 32, row = R0 + r; const bool samp = R0 >= MP;
        int t, b; if (!samp) { t = row & (PSEQ - 1); b = row >> 11; } else { t = (row - MP) & 7; b = (row - MP) >> 3; }
        bf16x8 Af[4];
#pragma unroll
        for (int ks = 0; ks < 4; ++ks) { const int c0 = 64 * g + 16 * ks + 8 * hh; float xc[8];
            { const f32x4 q0 = *(const f32x4*)(cbias + c0), q1 = *(const f32x4*)(cbias + c0 + 4); xc[0] = q0.x; xc[1] = q0.y; xc[2] = q0.z; xc[3] = q0.w; xc[4] = q1.x; xc[5] = q1.y; xc[6] = q1.z; xc[7] = q1.w; }
#pragma unroll
            for (int tap = 0; tap < 4; ++tap) { const int tp = t + tap - 3; float xv[8];
                if (tp >= 0) { const v4u q = *(const v4u*)(Z + (size_t)(row + tap - 3) * ZW + ZXR + c0);
                    xv[0] = bflo(q.x); xv[1] = bfhi(q.x); xv[2] = bflo(q.y); xv[3] = bfhi(q.y); xv[4] = bflo(q.z); xv[5] = bfhi(q.z); xv[6] = bflo(q.w); xv[7] = bfhi(q.w); }
                else if (samp) { const float* sp = AR.in[I_SRC] + ((size_t)b * 3 + (t + tap)) * 512 + c0; const f32x4 q0 = *(const f32x4*)sp, q1 = *(const f32x4*)(sp + 4);
                    xv[0] = q0.x; xv[1] = q0.y; xv[2] = q0.z; xv[3] = q0.w; xv[4] = q1.x; xv[5] = q1.y; xv[6] = q1.z; xv[7] = q1.w; }
                else {
#pragma unroll
                    for (int j = 0; j < 8; ++j) xv[j] = 0.f; }
                const f32x4 w0 = *(const f32x4*)(cw + tap * 512 + c0), w1 = *(const f32x4*)(cw + tap * 512 + c0 + 4);
                xc[0] += w0.x * xv[0]; xc[1] += w0.y * xv[1]; xc[2] += w0.z * xv[2]; xc[3] += w0.w * xv[3]; xc[4] += w1.x * xv[4]; xc[5] += w1.y * xv[5]; xc[6] += w1.z * xv[6]; xc[7] += w1.w * xv[7]; }
            Af[ks] = pack8(xc);
            LAS float* xp = XT + r * 68 + 16 * ks + 8 * hh;
            *(LAS f32x4*)xp = (f32x4){xc[0], xc[1], xc[2], xc[3]}; *(LAS f32x4*)(xp + 4) = (f32x4){xc[4], xc[5], xc[6], xc[7]};
            asm volatile("" ::: "memory"); }
        LDS_WAIT(); asm volatile("" ::: "memory");
        const GAS float* wab = (const GAS float*)(wa + 8 * hh * 64 + r); const GAS float* wxb = (const GAS float*)(wx + 8 * hh * 64 + r);
        asm volatile("" : "+v"(wab), "+v"(wxb));
#pragma unroll
        for (int cb = 0; cb < 2; ++cb) { f32x16 da, dx;
#pragma unroll
            for (int i = 0; i < 16; ++i) { da[i] = 0.f; dx[i] = 0.f; }
#pragma unroll
            for (int ks = 0; ks < 4; ++ks) { float a[8], x[8];
#pragma unroll
                for (int j = 0; j < 8; ++j) { const int i = 16 * ks + j; a[j] = wab[i * 64 + cb * 32]; x[j] = wxb[i * 64 + cb * 32]; }
                da = MFMA32(Af[ks], pack8(a), da); dx = MFMA32(Af[ks], pack8(x), dx); asm volatile("" ::: "memory"); }
#pragma unroll
            for (int i = 0; i < 16; ++i) { const int tr = crow(i, hh), j = cb * 32 + r;
                const float rg = fsig(da[i] + ba[cb]), ig = fsig(dx[i] + bx[cb]);
                const float la = spl[cb] * rg, a = fexp(la), xcv = XT[tr * 68 + j];
                const float u = sqrtf(fmaxf(1.0f - a * a, 0.f)) * ig * xcv;
                AT[tr * 68 + j] = a; XT[tr * 68 + j] = u; } }
        LDS_WAIT(); asm volatile("" ::: "memory");
        { const int c = 64 * g + lane;
            if (!samp) { float h = 0.f, P = 1.f;
#pragma unroll 8
                for (int tr = 0; tr < 32; ++tr) { const float a = AT[tr * 68 + lane], u = XT[tr * 68 + lane]; h = a * h + u; P *= a;
                    RGH[(size_t)(R0 + tr) * 512 + c] = h; RGP[(size_t)(R0 + tr) * 512 + c] = P; } }
            else { float h = 0.f; const int b0 = (R0 - MP) >> 3;
#pragma unroll 8
                for (int tr = 0; tr < 32; ++tr) { const int bb = b0 + (tr >> 3);
                    if ((tr & 7) == 0) h = AR.in[I_SRH][(size_t)bb * 512 + c];
                    const float a = AT[tr * 68 + lane], u = XT[tr * 68 + lane]; h = a * h + u;
                    const float gr = bf2f(Z[(size_t)(R0 + tr) * ZW + ZGR + c]);
                    G[(size_t)(R0 + tr) * D + 512 + c] = (bf16)f2bf(h * gelu_tanh(gr));
                    if ((tr & 7) == 7) F.out[O_SRH + (size_t)bb * 512 + c] = h; } } }
        LDS_WAIT(); asm volatile("" ::: "memory");
    }
    { const int gt = F.vcu * NTHREADS + F.tid, NT = F.G * NTHREADS;
        for (int e = gt; e < NSEQ * 3 * 512; e += NT) { const int c = e & 511, j = (e >> 9) % 3, s = e / 1536;
            if (s < NPB) F.out[O_PRC + ((size_t)s * 3 + j) * 512 + c] = bf2f(Z[((size_t)s * PSEQ + PSEQ - 3 + j) * ZW + ZXR + c]);
            else { const int b = s - NPB; F.out[O_SRC + ((size_t)b * 3 + j) * 512 + c] = bf2f(Z[((size_t)MP + (size_t)b * SSEQ + SSEQ - 3 + j) * ZW + ZXR + c]); } } }
}

DI void ml2_scan(Frame& F, const Args& AR) {
    float* CST = (float*)(F.ws + WS_CST); float* NST = (float*)(F.ws + WS_NST); float* MST = (float*)(F.ws + WS_MST);
    for (int vb = F.vcu; vb < 256; vb += F.G) {
        const int bh = vb >> 3, e0 = ((vb & 7) * NTHREADS + F.tid) * 4;
        float m = 0.f; f32x4 C = (f32x4){0.f, 0.f, 0.f, 0.f};
        const bool nthr = (vb & 7) == 0 && F.tid < 128; float n = 0.f;
        for (int c = 0; c < 16; ++c) { const int item = bh * 16 + c; const float mloc = MST[item * 4 + 0], bL = MST[item * 4 + 1];
            float* cp = CST + (size_t)item * 16384 + e0; const f32x4 cl = *(const f32x4*)cp; *(f32x4*)cp = C;
            const float mn = fmaxf(bL + m, mloc), w0 = fexp(bL + m - mn), w1 = fexp(mloc - mn);
            C = C * w0 + cl * w1;
            if (nthr) { float* np = NST + item * 128 + F.tid; const float nl = *np; *np = n; n = n * w0 + nl * w1; if (F.tid == 0) MST[item * 4 + 2] = m; }
            m = mn; }
        *(f32x4*)(F.out + O_PMC + (size_t)bh * 16384 + e0) = C;
        if (nthr) { F.out[O_PMN + bh * 128 + F.tid] = n; if (F.tid == 0) F.out[O_PMM + bh] = m; }
    }
}
DI void rg2_carry(Frame& F, const Args& AR) {
    const float* RGH = (const float*)(F.ws + WS_RGH); const float* RGP = (const float*)(F.ws + WS_RGP); float* CARRY = (float*)(F.ws + WS_CARRY);
    const int gt = F.vcu * NTHREADS + F.tid, NT = F.G * NTHREADS;
    for (int e = gt; e < NPB * 512; e += NT) { const int b = e >> 9, c = e & 511; float H = 0.f;
        for (int k0 = 0; k0 < 64; k0 += 16) { float pe[16], he[16];
#pragma unroll
            for (int k = 0; k < 16; ++k) { const size_t row = (size_t)b * PSEQ + 32 * (k0 + k) + 31; pe[k] = RGP[row * 512 + c]; he[k] = RGH[row * 512 + c]; }
#pragma unroll
            for (int k = 0; k < 16; ++k) { CARRY[((size_t)b * 64 + k0 + k) * 512 + c] = H; H = pe[k] * H + he[k]; } }
        F.out[O_PRH + (size_t)b * 512 + c] = H; }
}
DI void rg2_apply(Frame& F, const Args& AR) {
    const bf16* Z = (const bf16*)(F.ws + WS_Z); bf16* G = (bf16*)(F.ws + WS_H);
    const float* RGH = (const float*)(F.ws + WS_RGH); const float* RGP = (const float*)(F.ws + WS_RGP); const float* CARRY = (const float*)(F.ws + WS_CARRY);
    const int gt = F.vcu * NTHREADS + F.tid, NT = F.G * NTHREADS;
    for (int e = gt; e < MP * 64; e += NT) { const int row = e >> 6, c0 = (e & 63) * 8, b = row >> 11, tile = (row & (PSEQ - 1)) >> 5;
        const v4u gq = *(const v4u*)(Z + (size_t)row * ZW + ZGR + c0);
        const float gr[8] = {bflo(gq.x), bfhi(gq.x), bflo(gq.y), bfhi(gq.y), bflo(gq.z), bfhi(gq.z), bflo(gq.w), bfhi(gq.w)};
        const float* hp = RGH + (size_t)row * 512 + c0; const float* pp = RGP + (size_t)row * 512 + c0; const float* cp = CARRY + ((size_t)b * 64 + tile) * 512 + c0;
        float o[8];
#pragma unroll
        for (int q = 0; q < 2; ++q) { const f32x4 h4 = *(const f32x4*)(hp + 4 * q), p4 = *(const f32x4*)(pp + 4 * q), c4 = *(const f32x4*)(cp + 4 * q);
            const f32x4 hv = h4 + p4 * c4; o[4 * q] = hv.x * gelu_tanh(gr[4 * q]); o[4 * q + 1] = hv.y * gelu_tanh(gr[4 * q + 1]); o[4 * q + 2] = hv.z * gelu_tanh(gr[4 * q + 2]); o[4 * q + 3] = hv.w * gelu_tanh(gr[4 * q + 3]); }
        v4u w; w.x = pk2(o[0], o[1]); w.y = pk2(o[2], o[3]); w.z = pk2(o[4], o[5]); w.w = pk2(o[6], o[7]);
        *(v4u*)(G + (size_t)row * D + 512 + c0) = w; }
}

DI void ml3_prompt(Frame& F, const Args& AR) {
    const bf16* Z = (const bf16*)(F.ws + WS_Z); bf16* G = (bf16*)(F.ws + WS_H);
    const float* CST = (const float*)(F.ws + WS_CST); const float* NST = (const float*)(F.ws + WS_NST); const float* MST = (const float*)(F.ws + WS_MST);
    LAS bf16* Qs = (LAS bf16*)F.lds;
    LAS bf16* Ks = (LAS bf16*)(F.lds + 34816);
    LAS bf16* Vs = (LAS bf16*)(F.lds + 69632);
    LAS float* LF = (LAS float*)(F.lds + 102400);
    LAS float* BC = LF + 128;
    LAS float* GS = BC + 128;
    LAS float* MX = GS + 128;
    LAS float* N0 = MX + 128;
    LAS float* RA = N0 + 128;
    LAS float* RB = RA + 256;
    LAS float* OT = (LAS float*)F.lds;
    const int tid = F.tid, lane = F.lane, wave = F.wave, r = lane & 31, hh = lane >> 5;
    const int tb = wave >> 1, vh = wave & 1, t = tb * 32 + r;
    for (int item = F.vcu; item < 512; item += F.G) {
        const int b = item >> 6, h = (item >> 4) & 3, c = item & 15; const size_t row0 = (size_t)b * PSEQ + c * 128;
        const float m0 = MST[item * 4 + 2]; const float* C0 = CST + (size_t)item * 16384;
#pragma unroll
        for (int i = 0; i < 4; ++i) { const int e = tid + i * NTHREADS, s = e >> 4, c8 = (e & 15) * 8; const bf16* zr = Z + (row0 + s) * ZW + h * 128 + c8;
            *(LAS v4u*)(Qs + s * 136 + c8) = *(const v4u*)(zr + ZQ); *(LAS v4u*)(Ks + s * 136 + c8) = *(const v4u*)(zr + ZK); *(LAS v4u*)(Vs + s * 128 + c8) = *(const v4u*)(zr + ZV); }
        if (tid < 128) { LF[tid] = log_sigmoid(bf2f(Z[(row0 + tid) * ZW + ZFG + h]) + AR.in[I_BG][4 + h]); N0[tid] = NST[item * 128 + tid]; }
        __syncthreads();
        if (tid < 128) { float bs = 0.f; for (int s = 0; s <= tid; ++s) bs += LF[s];
            BC[tid] = bs; GS[tid] = bf2f(Z[(row0 + tid) * ZW + ZIG + h]) + AR.in[I_BG][h] - bs; }
        __syncthreads();
        if (tid < 128) { float mx = m0; for (int s = 0; s <= tid; ++s) mx = fmaxf(mx, GS[s]); MX[tid] = mx; }
        __syncthreads();
        const float mxt = MX[t], winter = fexp(m0 - mxt);
        bf16x8 bq[8];
#pragma unroll
        for (int ks = 0; ks < 8; ++ks) bq[ks] = *(const LAS bf16x8*)(Qs + t * 136 + 16 * ks + 8 * hh);
        bf16x8 pp[4][2]; float den = 0.f;
#pragma unroll
        for (int sb = 0; sb < 4; ++sb) {
            if (sb <= tb) { f32x16 sa;
#pragma unroll
                for (int i = 0; i < 16; ++i) sa[i] = 0.f;
#pragma unroll
                for (int ks = 0; ks < 8; ++ks) sa = MFMA32(*(const LAS bf16x8*)(Ks + (sb * 32 + r) * 136 + 16 * ks + 8 * hh), bq[ks], sa);
                float pv[16];
#pragma unroll
                for (int i = 0; i < 16; ++i) { const int s = sb * 32 + crow(i, hh); float v = sa[i] * MSCALE * fexp(GS[s] - mxt); if (s > t) v = 0.f; pv[i] = v; den += v; }
                pp[sb][0] = mk_frag(pk2(pv[0], pv[1]), pk2(pv[2], pv[3]), pk2(pv[4], pv[5]), pk2(pv[6], pv[7]));
                pp[sb][1] = mk_frag(pk2(pv[8], pv[9]), pk2(pv[10], pv[11]), pk2(pv[12], pv[13]), pk2(pv[14], pv[15]));
            } else { pp[sb][0] = mk_frag(0u, 0u, 0u, 0u); pp[sb][1] = mk_frag(0u, 0u, 0u, 0u); } }
        den += __shfl_xor(den, 32);
        float qn = 0.f;
#pragma unroll 8
        for (int k = 0; k < 64; ++k) qn += N0[hh * 64 + k] * bf2f(Qs[t * 136 + hh * 64 + k]);
        qn += __shfl_xor(qn, 32);
        const float dtot = den + winter * qn, denom = fmaxf(fabsf(dtot), fexp(-(BC[t] + mxt))), rden = 1.0f / denom;
        float hv[2][16];
#pragma unroll
        for (int q = 0; q < 2; ++q) { const int vb = vh * 2 + q; f32x16 an, ai;
#pragma unroll
            for (int i = 0; i < 16; ++i) { an[i] = 0.f; ai[i] = 0.f; }
#pragma unroll
            for (int sb = 0; sb < 4; ++sb) if (sb <= tb) {
#pragma unroll
                for (int s2 = 0; s2 < 2; ++s2) { unsigned vw[8];
#pragma unroll
                    for (int j = 0; j < 8; ++j) vw[j] = Vs[(sb * 32 + 16 * s2 + 8 * (j >> 2) + 4 * hh + (j & 3)) * 128 + vb * 32 + r];
                    an = MFMA32(mk_frag(vw[0] | (vw[1] << 16), vw[2] | (vw[3] << 16), vw[4] | (vw[5] << 16), vw[6] | (vw[7] << 16)), pp[sb][s2], an); } }
#pragma unroll
            for (int ks = 0; ks < 8; ++ks) { const float* cp = C0 + (size_t)(vb * 32 + r) * 128 + 16 * ks + 8 * hh; const f32x4 c0 = *(const f32x4*)cp, c1 = *(const f32x4*)(cp + 4);
                ai = MFMA32(mk_frag(pk2(c0.x, c0.y), pk2(c0.z, c0.w), pk2(c1.x, c1.y), pk2(c1.z, c1.w)), bq[ks], ai); }
#pragma unroll
            for (int i = 0; i < 16; ++i) hv[q][i] = (an[i] + winter * ai[i]) * rden; }
        float s1 = 0.f;
#pragma unroll
        for (int q = 0; q < 2; ++q)
#pragma unroll
            for (int i = 0; i < 16; ++i) s1 += hv[q][i];
        s1 += __shfl_xor(s1, 32);
        if (hh == 0) RA[vh * 128 + t] = s1;
        __syncthreads();
        const float mean = (RA[t] + RA[128 + t]) * (1.f / 128.f); float s2 = 0.f;
#pragma unroll
        for (int q = 0; q < 2; ++q)
#pragma unroll
            for (int i = 0; i < 16; ++i) { hv[q][i] -= mean; s2 += hv[q][i] * hv[q][i]; }
        s2 += __shfl_xor(s2, 32);
        if (hh == 0) RB[vh * 128 + t] = s2;
        __syncthreads();
        const float rstd = 1.f / sqrtf((RB[t] + RB[128 + t]) * (1.f / 128.f) + HEAD_EPS);
#pragma unroll
        for (int q = 0; q < 2; ++q)
#pragma unroll
            for (int i = 0; i < 16; ++i) OT[t * 132 + (vh * 2 + q) * 32 + crow(i, hh)] = hv[q][i] * rstd;
        __syncthreads();
        { const int tt = tid >> 2, v0 = (tid & 3) * 32; const size_t row = row0 + tt;
#pragma unroll
            for (int q = 0; q < 4; ++q) { const int v = v0 + 8 * q; const v4u oq = *(const v4u*)(Z + row * ZW + ZO + h * 128 + v);
                const float og[8] = {bflo(oq.x), bfhi(oq.x), bflo(oq.y), bfhi(oq.y), bflo(oq.z), bfhi(oq.z), bflo(oq.w), bfhi(oq.w)};
                const f32x4 g0 = *(const f32x4*)(AR.in[I_MNG] + h * 128 + v), g1 = *(const f32x4*)(AR.in[I_MNG] + h * 128 + v + 4);
                const f32x4 x0 = *(const LAS f32x4*)(OT + tt * 132 + v), x1 = *(const LAS f32x4*)(OT + tt * 132 + v + 4);
                v4u w; w.x = pk2(x0.x * g0.x * fsig(og[0]), x0.y * g0.y * fsig(og[1])); w.y = pk2(x0.z * g0.z * fsig(og[2]), x0.w * g0.w * fsig(og[3]));
                w.z = pk2(x1.x * g1.x * fsig(og[4]), x1.y * g1.y * fsig(og[5])); w.w = pk2(x1.z * g1.z * fsig(og[6]), x1.w * g1.w * fsig(og[7]));
                *(v4u*)(G + row * D + h * 128 + v) = w; } }
        __syncthreads();
    }
}

constexpr int TC = 32;
constexpr int RW_ARR = TC * 64;
constexpr int RW_BUF_FLOATS = 7 * RW_ARR + TC;
struct RwRaw { v2u r, k, v, w, a, g; };
DI void rw_load(RwRaw& x, const bf16* RK, const bf16* WAG, size_t row, int h, int k4, bool valid) {
    if (valid) { const bf16* p = RK + row * RKW + h * 64 + k4; const bf16* q = WAG + row * WAGW + h * 64 + k4;
        x.r = *(const v2u*)p; x.k = *(const v2u*)(p + 1024); x.v = *(const v2u*)(p + 2048); x.w = *(const v2u*)q; x.a = *(const v2u*)(q + 1024); x.g = *(const v2u*)(q + 2048); }
    else { x.r = (v2u){0u, 0u}; x.k = x.r; x.v = x.r; x.w = x.r; x.a = x.r; x.g = x.r; }
}
DI void un4(const v2u u, float (&f)[4]) { f[0] = bflo(u.x); f[1] = bfhi(u.x); f[2] = bflo(u.y); f[3] = bfhi(u.y); }
DI void rw_prep(const RwRaw& x, LAS float* buf, int tok, int k4, const float (&kkw)[4], const float (&kaw)[4], const float (&rkw)[4]) {
    float r[4], k[4], v[4], w[4], a[4], g[4]; un4(x.r, r); un4(x.k, k); un4(x.v, v); un4(x.w, w); un4(x.a, a); un4(x.g, g);
    float kk[4], ss = 0.f, bs = 0.f, km[4];
#pragma unroll
    for (int j = 0; j < 4; ++j) { kk[j] = k[j] * kkw[j]; ss += kk[j] * kk[j]; km[j] = k[j] * (1.0f + (a[j] - 1.0f) * kaw[j]); bs += r[j] * km[j] * rkw[j]; }
#pragma unroll
    for (int o = 1; o < 16; o <<= 1) { ss += __shfl_xor(ss, o); bs += __shfl_xor(bs, o); }
    const float inv = 1.0f / fmaxf(sqrtf(ss), 1e-12f);
    f32x4 o0, o1, o2, o3, o4, o5, o6;
#pragma unroll
    for (int j = 0; j < 4; ++j) { const float kn = kk[j] * inv; o0[j] = kn; o1[j] = kn * a[j]; o2[j] = km[j]; o3[j] = __builtin_amdgcn_exp2f(w[j]); o4[j] = r[j]; o5[j] = v[j]; o6[j] = g[j]; }
    LAS float* p = buf + tok * 64 + k4;
    *(LAS f32x4*)p = o0; *(LAS f32x4*)(p + RW_ARR) = o1; *(LAS f32x4*)(p + 2 * RW_ARR) = o2; *(LAS f32x4*)(p + 3 * RW_ARR) = o3;
    *(LAS f32x4*)(p + 4 * RW_ARR) = o4; *(LAS f32x4*)(p + 5 * RW_ARR) = o5; *(LAS f32x4*)(p + 6 * RW_ARR) = o6;
    if ((k4 & 63) == 0) buf[7 * RW_ARR + tok] = bs;
}
DI void rw_seq(Frame& F, const Args& AR, size_t row0, int len, int h, const float* S0, float* Sout) {
    const bf16* RK = (const bf16*)(F.ws + WS_RK); const bf16* WAG = (const bf16*)(F.ws + WS_WAG); bf16* G = (bf16*)(F.ws + WS_H);
    LAS float* B0 = (LAS float*)F.lds; LAS float* B1 = B0 + RW_BUF_FLOATS; LAS float* YB = B1 + RW_BUF_FLOATS;
    const int tid = F.tid, vrow = tid >> 3, p = tid & 7, tok = tid >> 4, k4 = (tid & 15) * 4;
    float kkw[4], kaw[4], rkw[4], lg[4], lb[4];
#pragma unroll
    for (int j = 0; j < 4; ++j) { const int c = h * 64 + k4 + j; kkw[j] = AR.in[I_KK][c]; kaw[j] = AR.in[I_KA][c]; rkw[j] = AR.in[I_RK][c]; lg[j] = AR.in[I_LXG][c]; lb[j] = AR.in[I_LXB][c]; }
    float S[8];
    if (S0) { const f32x4 a = *(const f32x4*)(S0 + vrow * 64 + 8 * p), b = *(const f32x4*)(S0 + vrow * 64 + 8 * p + 4); S[0] = a.x; S[1] = a.y; S[2] = a.z; S[3] = a.w; S[4] = b.x; S[5] = b.y; S[6] = b.z; S[7] = b.w; }
    else {
#pragma unroll
        for (int j = 0; j < 8; ++j) S[j] = 0.f; }
    const int nch = (len + TC - 1) / TC;
    RwRaw raw; rw_load(raw, RK, WAG, row0 + tok, h, k4, tok < len);
    rw_prep(raw, B0, tok, k4, kkw, kaw, rkw);
    __syncthreads();
    for (int ch = 0; ch < nch; ++ch) {
        LAS float* cur = (ch & 1) ? B1 : B0; LAS float* nxt = (ch & 1) ? B0 : B1;
        const int base = ch * TC, nt = (len - base) < TC ? (len - base) : TC;
        const bool more = ch + 1 < nch;
        if (more) rw_load(raw, RK, WAG, row0 + base + TC + tok, h, k4, base + TC + tok < len);
        for (int tk = 0; tk < nt; ++tk) {
            const LAS float* q = cur + tk * 64 + 8 * p;
            const f32x4 ka = *(const LAS f32x4*)q, kb = *(const LAS f32x4*)(q + 4);
            const f32x4 ba = *(const LAS f32x4*)(q + RW_ARR), bb = *(const LAS f32x4*)(q + RW_ARR + 4);
            const f32x4 ma = *(const LAS f32x4*)(q + 2 * RW_ARR), mb = *(const LAS f32x4*)(q + 2 * RW_ARR + 4);
            const f32x4 da = *(const LAS f32x4*)(q + 3 * RW_ARR), db = *(const LAS f32x4*)(q + 3 * RW_ARR + 4);
            const f32x4 ra = *(const LAS f32x4*)(q + 4 * RW_ARR), rb = *(const LAS f32x4*)(q + 4 * RW_ARR + 4);
            const float vv = cur[5 * RW_ARR + tk * 64 + vrow];
            float sa = (S[0] * ka.x + S[1] * ka.y) + (S[2] * ka.z + S[3] * ka.w) + (S[4] * kb.x + S[5] * kb.y) + (S[6] * kb.z + S[7] * kb.w);
            sa += __shfl_xor(sa, 1); sa += __shfl_xor(sa, 2); sa += __shfl_xor(sa, 4);
            sa = -sa;
            S[0] = S[0] * da.x + sa * ba.x + vv * ma.x; S[1] = S[1] * da.y + sa * ba.y + vv * ma.y; S[2] = S[2] * da.z + sa * ba.z + vv * ma.z; S[3] = S[3] * da.w + sa * ba.w + vv * ma.w;
            S[4] = S[4] * db.x + sa * bb.x + vv * mb.x; S[5] = S[5] * db.y + sa * bb.y + vv * mb.y; S[6] = S[6] * db.z + sa * bb.z + vv * mb.z; S[7] = S[7] * db.w + sa * bb.w + vv * mb.w;
            float y = (S[0] * ra.x + S[1] * ra.y) + (S[2] * ra.z + S[3] * ra.w) + (S[4] * rb.x + S[5] * rb.y) + (S[6] * rb.z + S[7] * rb.w);
            y += __shfl_xor(y, 1); y += __shfl_xor(y, 2); y += __shfl_xor(y, 4);
            if (p == 0) YB[tk * 64 + vrow] = y;
        }
        __syncthreads();
        if (tok < nt) { const f32x4 y4 = *(const LAS f32x4*)(YB + tok * 64 + k4);
            float s = (y4.x + y4.y) + (y4.z + y4.w);
#pragma unroll
            for (int o = 1; o < 16; o <<= 1) s += __shfl_xor(s, o);
            const float mean = s * (1.f / 64.f); const f32x4 d = y4 - mean; float s2 = (d.x * d.x + d.y * d.y) + (d.z * d.z + d.w * d.w);
#pragma unroll
            for (int o = 1; o < 16; o <<= 1) s2 += __shfl_xor(s2, o);
            const float rstd = 1.f / sqrtf(s2 * (1.f / 64.f) + RW_EPS); const float bn = cur[7 * RW_ARR + tok];
            const f32x4 v4 = *(const LAS f32x4*)(cur + 5 * RW_ARR + tok * 64 + k4), g4 = *(const LAS f32x4*)(cur + 6 * RW_ARR + tok * 64 + k4);
            const float o0 = (d.x * rstd * lg[0] + lb[0] + bn * v4.x) * g4.x, o1 = (d.y * rstd * lg[1] + lb[1] + bn * v4.y) * g4.y;
            const float o2 = (d.z * rstd * lg[2] + lb[2] + bn * v4.z) * g4.z, o3 = (d.w * rstd * lg[3] + lb[3] + bn * v4.w) * g4.w;
            v2u w; w.x = pk2(o0, o1); w.y = pk2(o2, o3);
            *(v2u*)(G + (row0 + base + tok) * D + h * 64 + k4) = w; }
        else {
        }
        if (more) rw_prep(raw, nxt, tok, k4, kkw, kaw, rkw);
        __syncthreads();
    }
#pragma unroll
    for (int j = 0; j < 8; j += 4) *(f32x4*)(Sout + vrow * 64 + 8 * p + j) = (f32x4){S[j], S[j + 1], S[j + 2], S[j + 3]};
}
DI void rwkv_scan(Frame& F, const Args& AR) {
    const int G = F.G, np = G >= 256 ? 128 : (G / 2 > 0 ? G / 2 : 1);
    if (F.vcu < np) {
        for (int item = F.vcu; item < NPB * 16; item += np) { const int b = item >> 4, h = item & 15;
            rw_seq(F, AR, (size_t)b * PSEQ, PSEQ, h, nullptr, F.out + O_PWKV + (size_t)item * 4096); }
    }
    const int ns = G - np > 0 ? G - np : G, s0 = G - np > 0 ? F.vcu - np : F.vcu;
    if (G - np <= 0 || F.vcu >= np) {
        for (int item = s0; item < NSB * 16; item += ns) { const int b = item >> 4, h = item & 15;
            rw_seq(F, AR, (size_t)MP + (size_t)b * SSEQ, SSEQ, h, AR.in[I_SWKV] + (size_t)item * 4096, F.out + O_SWKV + (size_t)item * 4096); }
    }
}

#ifndef MK_N_LAUNCHES
#define MK_N_LAUNCHES 1
#endif
constexpr int NPHASES = 25;
enum { K_P0 = 0, K_MODX, K_UP, K_RESID, K_LN, K_WIN, K_MIXA, K_MIXB, K_MIXC, K_R1, K_R2, K_R3 };

__global__ void __launch_bounds__(NTHREADS, 2) mega_fwd(Args AR) {
    extern __shared__ __attribute__((aligned(16))) unsigned char lds[];
    Frame F;
    F.lds = (LAS unsigned char*)lds;
    F.MISC = (volatile LAS unsigned*)(F.lds + MISC_OFF);
    F.tid = threadIdx.x; F.lane = F.tid & 63; F.wave = __builtin_amdgcn_readfirstlane(F.tid >> 6);
    F.G = gridDim.x; { const int bx = blockIdx.x; F.vcu = (F.G % 8 == 0) ? (bx % 8) * (F.G / 8) + bx / 8 : bx; }
    F.ws = AR.ws; F.out = AR.out; F.ctl = (gu32*)(AR.ws + WS_CTL);
    for (int u = F.tid; u < (LDS_BYTES - LDSCTL_OFF) / 4; u += NTHREADS) ((LAS unsigned*)(F.lds + LDSCTL_OFF))[u] = 0u;
    __syncthreads();
    const int lo = AR.ph_lo, hi = AR.ph_hi;
    XcdBarrier bar; bar.bar = (unsigned*)(F.ctl + CW_BAR); bar.x = 0; bar.st = nullptr;
    if (hi - lo > 1) bar = xcd_barrier_post((unsigned*)(F.ctl + CW_BAR), F.MISC + 8);

    for (int ph = lo; ph < hi; ++ph) {
        { int t_ = F.tid; asm volatile("" : "+v"(t_)); F.tid = t_; F.lane = t_ & 63; F.wave = __builtin_amdgcn_readfirstlane(t_ >> 6);

          int v_ = F.vcu; asm volatile("" : "+s"(v_)); F.vcu = v_; int g_ = F.G; asm volatile("" : "+s"(g_)); F.G = g_; }
        float* X = F.out + O_Y; const float* mod = (const float*)(F.ws + WS_MOD); bf16* H = (bf16*)(F.ws + WS_H);
        int kind = K_LN, f = 0, l = 0, sub = 0, js = 0, first = 0, mode = 0, lm = 0, which = 0;
        switch (ph) {
            case 0: kind = K_P0; break;
            case 1: kind = K_MODX; break;
            case 2: kind = K_UP; f = 0; break;
            case 3: kind = K_RESID; which = 0; f = 0; l = 0; js = 0; first = 1; break;
            case 4: kind = K_LN; l = 0; sub = 0; lm = 0; js = 3; mode = 0; break;
            case 5: kind = K_WIN; break;
            case 6: kind = K_MIXA; break;
            case 7: kind = K_MIXB; break;
            case 8: kind = K_MIXC; break;
            case 9: kind = K_RESID; which = 1; l = 0; js = 3; break;
            case 10: kind = K_LN; l = 0; sub = 1; lm = 0; js = 6; mode = 0; break;
            case 11: kind = K_UP; f = 1; break;
            case 12: kind = K_RESID; which = 0; f = 1; l = 0; js = 6; break;
            case 13: kind = K_LN; l = 0; sub = 2; lm = 1; js = 0; mode = 0; break;
            case 14: kind = K_UP; f = 2; break;
            case 15: kind = K_RESID; which = 0; f = 2; l = 1; js = 0; break;
            case 16: kind = K_LN; l = 1; sub = 0; lm = 1; js = 3; mode = 1; break;
            case 17: kind = K_R1; break;
            case 18: kind = K_R2; break;
            case 19: kind = K_R3; break;
            case 20: kind = K_RESID; which = 2; l = 1; js = 3; break;
            case 21: kind = K_LN; l = 1; sub = 1; lm = 1; js = 6; mode = 0; break;
            case 22: kind = K_UP; f = 3; break;
            case 23: kind = K_RESID; which = 0; f = 3; l = 1; js = 6; break;
            default: kind = K_LN; l = 1; sub = 2; lm = 1; js = 0; mode = 2; break;
        }
#ifndef PHMASK
#define PHMASK 0xFFFFF
#endif
        switch (kind) {
            case K_P0: if ((PHMASK >> K_P0) & 1) p0_mod(F, AR); __syncthreads(); if ((PHMASK >> 12) & 1) p0_weights(F, AR); break;
            case K_MODX: if ((PHMASK >> K_MODX) & 1) ln_pass(F, AR, 1, 0, 0, 0, 0, 0, 0); break;
            case K_UP: if ((PHMASK >> K_UP) & 1) {
                pg8::Gemm g{H, (const bf16*)(F.ws + WS_W13) + (size_t)f * 5632 * 1024, M, 5632, 1024}; pg8::StaticOrder S; S.init(M, 5632, F.G, (int)blockIdx.x);
                pg8::EpiSwiglu E{(bf16*)(F.ws + WS_HID), FF};
                pg8::gemm_phase<pg8::EpiSwiglu, pg8::StaticOrder, true, true>(F.lds, g, S, E);
            } break;
            case K_RESID: if ((PHMASK >> K_RESID) & 1) {
                const bf16* A = which == 0 ? (const bf16*)(F.ws + WS_HID) : H; const int K = which == 0 ? FF : 1024;
                const bf16* Bt = which == 0 ? (const bf16*)(F.ws + WS_W2) + (size_t)f * 1024 * FF : (which == 1 ? (const bf16*)(F.ws + WS_WOUT) : (const bf16*)(F.ws + WS_WO));
                pg8::Gemm g{A, Bt, M, 1024, K}; pg8::StaticOrder S; S.init(M, 1024, F.G, (int)blockIdx.x);
                pg8::EpiResid E{first ? AR.in[I_XP] : X, first ? AR.in[I_XS] : X + (size_t)MP * D, X, mod + ((size_t)l * NSEQ * 9 + (js + 2)) * 1024, ALPHA, which == 0 ? 0.5f : 1.0f};
                pg8::gemm_phase<pg8::EpiResid, pg8::StaticOrder, true, true>(F.lds, g, S, E);
            } break;
            case K_LN: if ((PHMASK >> K_LN) & 1) ln_pass(F, AR, 0, 1, l, sub, lm, js, mode); break;
            case K_WIN: if ((PHMASK >> K_WIN) & 1) {
                pg8::Gemm g{H, (const bf16*)(F.ws + WS_WIN), M, ZW, 1024}; pg8::StaticOrder S; S.init(M, ZW, F.G, (int)blockIdx.x);
                pg8::EpiStore E{(bf16*)(F.ws + WS_Z), ZW, 1000, nullptr, 0};
                pg8::gemm_phase<pg8::EpiStore, pg8::StaticOrder, true, true>(F.lds, g, S, E);
            } break;
            case K_R1: if ((PHMASK >> K_R1) & 1) {
                pg8::Gemm g{(const bf16*)(F.ws + WS_A2), (const bf16*)(F.ws + WS_WRK), M, 3328, 2048}; pg8::StaticOrder S; S.init(M, 3328, F.G, (int)blockIdx.x);
                pg8::EpiStore E{(bf16*)(F.ws + WS_RK), RKW, 12, (bf16*)(F.ws + WS_A3), 256};
                pg8::gemm_phase<pg8::EpiStore, pg8::StaticOrder, true, true>(F.lds, g, S, E);
            } break;
            case K_R2: if ((PHMASK >> K_R2) & 1) {
                pg8::Gemm g{(const bf16*)(F.ws + WS_A3), (const bf16*)(F.ws + WS_WL2), M, 3072, 256}; pg8::StaticOrder S; S.init(M, 3072, F.G, (int)blockIdx.x);
                pg8::EpiLora2 E{(bf16*)(F.ws + WS_WAG), WAGW, AR.in[I_W0], AR.in[I_A0]};
                pg8::gemm_phase<pg8::EpiLora2, pg8::StaticOrder, true, true>(F.lds, g, S, E);
            } break;
            case K_MIXA: if ((PHMASK >> K_MIXA) & 1) ml1_prompt(F, AR); __syncthreads(); if ((PHMASK >> 13) & 1) ml_sample(F, AR); __syncthreads(); if ((PHMASK >> 14) & 1) rg1(F, AR); break;
            case K_MIXB: if ((PHMASK >> K_MIXB) & 1) ml2_scan(F, AR); if ((PHMASK >> 15) & 1) rg2_carry(F, AR); break;
            case K_MIXC: if ((PHMASK >> K_MIXC) & 1) ml3_prompt(F, AR); __syncthreads(); if ((PHMASK >> 16) & 1) rg2_apply(F, AR); break;
            case K_R3: if ((PHMASK >> K_R3) & 1) rwkv_scan(F, AR); break;
        }
        if (ph + 1 < hi) xcd_barrier(bar);
    }
}

extern "C" void kernel_launch(void* const* d_in, const int* in_sizes, int n_in, void* d_out, int out_size, void* d_ws, size_t ws_size, hipStream_t stream) {
    static int grid = 0;
    if (grid == 0) {
        if (n_in != 47 || out_size != (int)O_END || ws_size < WS_END) { fprintf(stderr, "kernel_launch: unexpected sizes n_in %d out %d ws %zu\n", n_in, out_size, ws_size); grid = -1; return; }
        int dev = 0, cus = 0, per_cu = 0;
        if (hipGetDevice(&dev) != hipSuccess || hipDeviceGetAttribute(&cus, hipDeviceAttributeMultiprocessorCount, dev) != hipSuccess) { grid = -1; return; }
        if (hipFuncSetAttribute((const void*)mega_fwd, hipFuncAttributeMaxDynamicSharedMemorySize, LDS_BYTES) != hipSuccess) { fprintf(stderr, "kernel_launch: hipFuncSetAttribute failed\n"); grid = -1; return; }
        if (hipOccupancyMaxActiveBlocksPerMultiprocessor(&per_cu, (const void*)mega_fwd, NTHREADS, LDS_BYTES) != hipSuccess || per_cu < 1) { fprintf(stderr, "kernel_launch: occupancy query says %d blocks per CU\n", per_cu); (void)hipGetLastError(); grid = -1; return; }
        grid = cus;
    }
    if (grid < 0) return;
    (void)hipMemsetAsync((char*)d_ws + WS_CTL, 0, CTL_ZERO_BYTES, stream);
    Args a{};
    for (int i = 0; i < 47; ++i) a.in[i] = (const float*)d_in[i];
    a.out = (float*)d_out; a.ws = (unsigned char*)d_ws;
#if MK_N_LAUNCHES == 1
    a.ph_lo = 0; a.ph_hi = NPHASES;
    hipLaunchKernelGGL(mega_fwd, dim3(grid), dim3(NTHREADS), LDS_BYTES, stream, a);
#else
    for (int p = 0; p < NPHASES; ++p) { a.ph_lo = p; a.ph_hi = p + 1; hipLaunchKernelGGL(mega_fwd, dim3(grid), dim3(NTHREADS), LDS_BYTES, stream, a); }
#endif
}
```

```cpp
#include <hip/hip_runtime.h>
#include <cstdio>
#include <cstdint>
#include <cmath>
namespace pg8 {
#define PG8_LAS __attribute__((address_space(3)))
typedef unsigned short bf16_t;
typedef short bf16x8 __attribute__((ext_vector_type(8)));
typedef float f32x4 __attribute__((ext_vector_type(4)));
typedef unsigned u32x4 __attribute__((ext_vector_type(4)));
constexpr int BM = 256, BK = 64, HALF = 128, HTB = HALF * BK * 2  , STAGE_BYTES = 8 * HTB, NXCD = 8, WGM = 8;

__host__ __device__ __forceinline__ int lds_byte(int r, int c) { const int st = (r >> 4) * 2 + (c >> 5), rr = r & 15, cc = c & 31, ob = rr * 64 + cc * 2; return st * 1024 + (ob ^ (((ob >> 9) & 1) << 5)); }
__host__ __device__ __forceinline__ void stage_rc(int b, int& R, int& C) { const int st = b / 1024, sb = b % 1024, swz = sb ^ (((sb >> 9) & 1) << 5); R = (st >> 1) * 16 + swz / 64; C = (st & 1) * 32 + (swz % 64) / 2; }
__host__ __device__ __forceinline__ int perm32(int rho) { const int n = rho >> 4, i = rho & 15; return 8 * (i >> 2) + 4 * n + (i & 3); }

struct Unit { int pm, pn, k0, nt, sub; };
struct Gemm { const bf16_t* A; const bf16_t* Bt; int M, N, K; };

struct StaticOrder {
    int nM, nN, nwg, G, c, ntk;
    __host__ __device__ void init(int M, int N, int G_, int c_) { nM = M / BM; nN = N / BM; nwg = nM * nN; G = G_; c = c_; }
    __host__ __device__ bool next(int i, Unit& u) const {
        const long L = (long)i * G + c; if (L >= nwg) return false;
        int wgid = (int)L; { const int q = nwg / NXCD, r = nwg % NXCD, xcd = wgid % NXCD, off = wgid / NXCD; wgid = (xcd < r ? xcd * (q + 1) : r * (q + 1) + (xcd - r) * q) + off; }
        const int nig = WGM * nN, gid = wgid / nig, fm = gid * WGM, gsz = (nM - fm) < WGM ? (nM - fm) : WGM;
        u.pm = fm + ((wgid % nig) % gsz); u.pn = (wgid % nig) / gsz; u.k0 = 0; u.nt = ntk; u.sub = 0; return true;
    }
    __device__ __forceinline__ void a_ready(const Unit&) const {}
    __device__ __forceinline__ void done(const Unit&) const {}
};

__device__ __forceinline__ unsigned cvt_pk_bf16(float lo, float hi) { unsigned r; asm volatile("v_cvt_pk_bf16_f32 %0, %1, %2" : "=v"(r) : "v"(lo), "v"(hi)); return r; }
typedef float f32x2 __attribute__((ext_vector_type(2)));
constexpr int MPROWS = 16384;
__device__ __forceinline__ int mod_row(int r) { return r < MPROWS ? (r >> 11) : 8 + ((r - MPROWS) >> 3); }
__device__ __forceinline__ float fsig(float x) { return __builtin_amdgcn_rcpf(1.0f + __builtin_amdgcn_exp2f(-1.44269504f * x)); }
__device__ __forceinline__ float ftanh(float x) { return 1.0f - 2.0f * __builtin_amdgcn_rcpf(1.0f + __builtin_amdgcn_exp2f(2.88539008f * x)); }

struct EpiSwiglu {
    static constexpr bool PERM = true, AFTER_DRAIN = false;
    bf16_t* O; int ldc;
    __device__ __forceinline__ void operator()(const f32x4 (&acc)[2][2][4][2], const Unit& u, int wr, int wc, int fr, int fq) const {
        const int row0 = u.pm * BM + wr * 64 + fr, col0 = u.pn * HALF + wc * 32 + 8 * fq;
#pragma unroll
        for (int ai = 0; ai < 2; ++ai)
#pragma unroll
            for (int m = 0; m < 4; ++m) { bf16_t* rowp = O + (size_t)(row0 + ai * HALF + m * 16) * ldc + col0;
                const f32x4 a0 = acc[ai][0][m][0], a1 = acc[ai][0][m][1], b0 = acc[ai][1][m][0], b1 = acc[ai][1][m][1];
                f32x4 v0, v1;
#pragma unroll
                for (int j = 0; j < 4; ++j) { v0[j] = a0[j] * fsig(a0[j]) * b0[j]; v1[j] = a1[j] * fsig(a1[j]) * b1[j]; }
                u32x4 w; w.x = cvt_pk_bf16(v0[0], v0[1]); w.y = cvt_pk_bf16(v0[2], v0[3]); w.z = cvt_pk_bf16(v1[0], v1[1]); w.w = cvt_pk_bf16(v1[2], v1[3]);
                *(u32x4*)rowp = w; asm volatile("" ::: "memory"); }
    }
};
struct EpiStore {
    static constexpr bool PERM = true, AFTER_DRAIN = false;
    bf16_t* O; int ldc; int ntile_main; bf16_t* O2; int ldc2;
    __device__ __forceinline__ void operator()(const f32x4 (&acc)[2][2][4][2], const Unit& u, int wr, int wc, int fr, int fq) const {
        const int row0 = u.pm * BM + wr * 64 + fr;
        const bool main = u.pn < ntile_main;
        bf16_t* base = main ? O + (size_t)u.pn * BM : O2; const int ld = main ? ldc : ldc2;
        const int col0 = wc * 32 + 8 * fq;
#pragma unroll
        for (int ai = 0; ai < 2; ++ai)
#pragma unroll
            for (int m = 0; m < 4; ++m) { bf16_t* rowp = base + (size_t)(row0 + ai * HALF + m * 16) * ld + col0;
#pragma unroll
                for (int bj = 0; bj < 2; ++bj) { f32x4 v0 = acc[ai][bj][m][0], v1 = acc[ai][bj][m][1];
                    if (!main) {
                        if (bj == 1) {
#pragma unroll
                            for (int j = 0; j < 4; ++j) { v0[j] = fsig(v0[j]); v1[j] = fsig(v1[j]); }
                        } else if (wc < 2) {
#pragma unroll
                            for (int j = 0; j < 4; ++j) { v0[j] = ftanh(v0[j]); v1[j] = ftanh(v1[j]); }
                        }
                    }
                    u32x4 w; w.x = cvt_pk_bf16(v0[0], v0[1]); w.y = cvt_pk_bf16(v0[2], v0[3]); w.z = cvt_pk_bf16(v1[0], v1[1]); w.w = cvt_pk_bf16(v1[2], v1[3]);
                    *(u32x4*)(rowp + bj * HALF) = w; asm volatile("" ::: "memory"); } }
    }
};
struct EpiLora2 {
    static constexpr bool PERM = true, AFTER_DRAIN = false;
    bf16_t* O; int ldc; const float* w0; const float* a0;
    __device__ __forceinline__ void operator()(const f32x4 (&acc)[2][2][4][2], const Unit& u, int wr, int wc, int fr, int fq) const {
        const int row0 = u.pm * BM + wr * 64 + fr, col0 = u.pn * BM + wc * 32 + 8 * fq, kind = u.pn >> 2;
        const float* bp = (kind == 0 ? w0 : a0) + (col0 & 1023); const float bsc = kind == 2 ? 0.f : 1.f, mul = kind == 0 ? -0.87504229f : 1.0f;
#pragma unroll
        for (int bj = 0; bj < 2; ++bj)
#pragma unroll
            for (int ai = 0; ai < 2; ++ai)
#pragma unroll
                for (int m = 0; m < 4; ++m) { bf16_t* rowp = O + (size_t)(row0 + ai * HALF + m * 16) * ldc + col0;
                    f32x4 v0 = acc[ai][bj][m][0] + *(const f32x4*)(bp + bj * HALF) * bsc, v1 = acc[ai][bj][m][1] + *(const f32x4*)(bp + bj * HALF + 4) * bsc;
                    if (kind != 2) {
#pragma unroll
                        for (int j = 0; j < 4; ++j) { v0[j] = mul * fsig(v0[j]); v1[j] = mul * fsig(v1[j]); }
                    }
                    u32x4 w; w.x = cvt_pk_bf16(v0[0], v0[1]); w.y = cvt_pk_bf16(v0[2], v0[3]); w.z = cvt_pk_bf16(v1[0], v1[1]); w.w = cvt_pk_bf16(v1[2], v1[3]);
                    *(u32x4*)(rowp + bj * HALF) = w; asm volatile("" ::: "memory"); }
    }
};

template <class Epi, class Sched, bool ALIGN_EPI = false, bool SP2 = false>
__device__ __forceinline__ void gemm_phase(PG8_LAS unsigned char* lds, const Gemm g, const Sched& S, const Epi& E, int tid_in) {
    int tid_ = tid_in; asm volatile("" : "+v"(tid_));
    const int tid = tid_, wid = __builtin_amdgcn_readfirstlane(tid >> 6), lane = tid & 63, wr = wid >> 2, wc = wid & 3, fr = lane & 15, fq = lane >> 4;
    int K_ = g.K; asm volatile("" : "+s"(K_));
    const int K = K_;
    unsigned voffA[2], voffB[2];
#pragma unroll
    for (int i = 0; i < 2; ++i) { int R, C; stage_rc(tid * 16 + i * 8192, R, C); const int Rb = Epi::PERM ? ((R & ~31) + perm32(R & 31)) : R;
        voffA[i] = (unsigned)(R * K + C) * 2u; voffB[i] = (unsigned)(Rb * K + C) * 2u; }
    const size_t kstep = (size_t)(BK * 2);
    const size_t hstep = (size_t)HALF * K * 2;
    const size_t tstep = 2 * hstep;
    const unsigned ldsw = (unsigned)wid * 1024u;
    const int aoff = lds_byte(wr * 64 + fr, fq * 8), boff = lds_byte(wc * 32 + fr, fq * 8);
#define PG8_SA(b, h) (((b) * 2 + (h)) * HTB)
#define PG8_SB(b, h) ((4 + (b) * 2 + (h)) * HTB)
#define PG8_STAGE(bufoff, gbase, voff) do { _Pragma("unroll") for (int _i = 0; _i < 2; ++_i) \
        __builtin_amdgcn_global_load_lds((const unsigned*)((const char*)(gbase) + (voff)[_i]), (PG8_LAS unsigned*)(lds + (bufoff) + ldsw + _i * 8192), 16, 0, 0); } while (0)
#define PG8_LDA(dst, b, h) do { _Pragma("unroll") for (int m = 0; m < 4; ++m) _Pragma("unroll") for (int k = 0; k < 2; ++k) dst[m][k] = *(const PG8_LAS bf16x8*)(lds + PG8_SA(b, h) + aoff + m * 2048 + k * 1024); } while (0)
#define PG8_LDB(dst, b, h) do { _Pragma("unroll") for (int n = 0; n < 2; ++n) _Pragma("unroll") for (int k = 0; k < 2; ++k) dst[n][k] = *(const PG8_LAS bf16x8*)(lds + PG8_SB(b, h) + boff + n * 2048 + k * 1024); } while (0)
#define PG8_MMA(ai, bj, At, Bt) do { __builtin_amdgcn_s_setprio(1); _Pragma("unroll") for (int m = 0; m < 4; ++m) _Pragma("unroll") for (int n = 0; n < 2; ++n) _Pragma("unroll") for (int k = 0; k < 2; ++k) \
        acc[ai][bj][m][n] = __builtin_amdgcn_mfma_f32_16x16x32_bf16(Bt[n][k], At[m][k], acc[ai][bj][m][n], 0, 0, 0); __builtin_amdgcn_s_setprio(0); } while (0)
#define PG8_WAIT_V(n) asm volatile("s_waitcnt vmcnt(" #n ")" ::: "memory")
#define PG8_WAIT_L(n) asm volatile("s_waitcnt lgkmcnt(" #n ")" ::: "memory")
#define PG8_BAR __builtin_amdgcn_s_barrier()
#define PG8_SCHED __builtin_amdgcn_sched_barrier(0)
    Unit cur, nxt; int ui = 0;
    if (!S.next(0, cur)) return;
    f32x4 acc[2][2][4][2];
#pragma unroll
    for (int a = 0; a < 2; ++a)
#pragma unroll
        for (int b = 0; b < 2; ++b)
#pragma unroll
            for (int m = 0; m < 4; ++m)
#pragma unroll
                for (int n = 0; n < 2; ++n) acc[a][b][m][n] = (f32x4){0.f, 0.f, 0.f, 0.f};
    bf16x8 At[4][2], B0[2][2], B1[2][2];
    const char* cA = (const char*)g.A + (size_t)cur.pm * tstep + (size_t)cur.k0 * 2; const char* cB = (const char*)g.Bt + (size_t)cur.pn * tstep + (size_t)cur.k0 * 2;
    S.a_ready(cur);
    if constexpr (SP2) {
        PG8_STAGE(PG8_SB(0, 0), cB, voffB); PG8_STAGE(PG8_SB(0, 1), cB + hstep, voffB); PG8_STAGE(PG8_SA(0, 0), cA, voffA); PG8_STAGE(PG8_SA(0, 1), cA + hstep, voffA);
        if (wr == 1) PG8_BAR;
        PG8_WAIT_V(2); PG8_BAR;
        PG8_STAGE(PG8_SB(1, 0), cB + kstep, voffB); PG8_STAGE(PG8_SA(1, 0), cA + kstep, voffA); PG8_STAGE(PG8_SB(1, 1), cB + hstep + kstep, voffB);
        PG8_WAIT_V(6); PG8_BAR;
    } else {
        PG8_STAGE(PG8_SB(0, 0), cB, voffB); PG8_STAGE(PG8_SA(0, 0), cA, voffA); PG8_STAGE(PG8_SB(0, 1), cB + hstep, voffB); PG8_STAGE(PG8_SA(0, 1), cA + hstep, voffA);
        if (wr == 1) PG8_BAR;
        PG8_WAIT_V(4); PG8_BAR;
        PG8_STAGE(PG8_SB(1, 0), cB + kstep, voffB); PG8_STAGE(PG8_SA(1, 0), cA + kstep, voffA); PG8_STAGE(PG8_SB(1, 1), cB + hstep + kstep, voffB);
        PG8_WAIT_V(6); PG8_BAR;
    }
    for (;;) {
        const bool has_next = S.next(ui + 1, nxt);
        const char* nA = has_next ? (const char*)g.A + (size_t)nxt.pm * tstep + (size_t)nxt.k0 * 2 : cA; const char* nB = has_next ? (const char*)g.Bt + (size_t)nxt.pn * tstep + (size_t)nxt.k0 * 2 : cB;
        const int nt = cur.nt;
        for (int t = 0; t < nt; t += 2) {
            const bool last = (t == nt - 2);
            const char* a1 = cA + (size_t)(t + 1) * kstep;
            const char* a2 = last ? nA : cA + (size_t)(t + 2) * kstep; const char* b2 = last ? nB : cB + (size_t)(t + 2) * kstep;
            const char* a3 = a2 + kstep; const char* b3 = b2 + kstep;
            if (last && has_next) S.a_ready(nxt);
            if constexpr (SP2) {
            PG8_LDB(B0, 0, 0); PG8_LDB(B1, 0, 1); PG8_SCHED; PG8_LDA(At, 0, 0); PG8_STAGE(PG8_SA(1, 1), a1 + hstep, voffA);
            PG8_WAIT_V(8); PG8_WAIT_L(0); PG8_BAR; PG8_MMA(0, 0, At, B0); PG8_MMA(0, 1, At, B1); PG8_BAR; PG8_SCHED;
            PG8_LDA(At, 0, 1); PG8_STAGE(PG8_SB(0, 0), b2, voffB); PG8_STAGE(PG8_SB(0, 1), b2 + hstep, voffB); PG8_STAGE(PG8_SA(0, 0), a2, voffA);
            PG8_WAIT_V(8); PG8_WAIT_L(0); PG8_BAR; PG8_MMA(1, 0, At, B0); PG8_MMA(1, 1, At, B1); PG8_BAR; PG8_SCHED;
            PG8_LDB(B0, 1, 0); PG8_LDB(B1, 1, 1); PG8_SCHED; PG8_LDA(At, 1, 0); PG8_STAGE(PG8_SA(0, 1), a2 + hstep, voffA);
            PG8_WAIT_V(8); PG8_WAIT_L(0); PG8_BAR; PG8_MMA(0, 0, At, B0); PG8_MMA(0, 1, At, B1); PG8_BAR; PG8_SCHED;
            PG8_LDA(At, 1, 1); PG8_STAGE(PG8_SB(1, 0), b3, voffB); PG8_STAGE(PG8_SB(1, 1), b3 + hstep, voffB); PG8_STAGE(PG8_SA(1, 0), a3, voffA);
            PG8_WAIT_V(8); PG8_WAIT_L(0); PG8_BAR; PG8_MMA(1, 0, At, B0); PG8_MMA(1, 1, At, B1); PG8_BAR; PG8_SCHED;
            } else {
            PG8_LDB(B0, 0, 0); PG8_SCHED; PG8_LDA(At, 0, 0); PG8_STAGE(PG8_SA(1, 1), a1 + hstep, voffA);
            PG8_WAIT_L(8); PG8_BAR; PG8_WAIT_L(0); PG8_MMA(0, 0, At, B0); PG8_BAR; PG8_SCHED;
            PG8_LDB(B1, 0, 1); PG8_STAGE(PG8_SB(0, 0), b2, voffB);
            PG8_BAR; PG8_WAIT_L(0); PG8_MMA(0, 1, At, B1); PG8_BAR;
            PG8_LDA(At, 0, 1); PG8_STAGE(PG8_SA(0, 0), a2, voffA);
            PG8_BAR; PG8_WAIT_L(0); PG8_MMA(1, 0, At, B0); PG8_BAR; PG8_SCHED;
            PG8_STAGE(PG8_SB(0, 1), b2 + hstep, voffB);
            PG8_WAIT_V(6); PG8_BAR; PG8_MMA(1, 1, At, B1); PG8_BAR;
            PG8_LDB(B0, 1, 0); PG8_SCHED; PG8_LDA(At, 1, 0); PG8_STAGE(PG8_SA(0, 1), a2 + hstep, voffA);
            PG8_WAIT_L(8); PG8_BAR; PG8_WAIT_L(0); PG8_MMA(0, 0, At, B0); PG8_BAR; PG8_SCHED;
            PG8_LDB(B1, 1, 1); PG8_STAGE(PG8_SB(1, 0), b3, voffB);
            PG8_BAR; PG8_WAIT_L(0); PG8_MMA(0, 1, At, B1); PG8_BAR;
            PG8_LDA(At, 1, 1); PG8_STAGE(PG8_SA(1, 0), a3, voffA);
            PG8_BAR; PG8_WAIT_L(0); PG8_MMA(1, 0, At, B0); PG8_BAR; PG8_SCHED;
            PG8_STAGE(PG8_SB(1, 1), b3 + hstep, voffB);
            PG8_WAIT_V(6); PG8_BAR; PG8_MMA(1, 1, At, B1); PG8_BAR;
            }
        }
        if constexpr (ALIGN_EPI) { if (wr == 0) PG8_BAR; }
        if constexpr (!Epi::AFTER_DRAIN) { E(acc, cur, wr, wc, fr, fq); S.done(cur); }
        if (!has_next) break;
#pragma unroll
        for (int a = 0; a < 2; ++a)
#pragma unroll
            for (int b = 0; b < 2; ++b)
#pragma unroll
                for (int m = 0; m < 4; ++m)
#pragma unroll
                    for (int n = 0; n < 2; ++n) acc[a][b][m][n] = (f32x4){0.f, 0.f, 0.f, 0.f};
        cur = nxt; cA = nA; cB = nB; ++ui;
        if constexpr (ALIGN_EPI) { if (wr == 1) PG8_BAR; }
    }
    PG8_WAIT_V(0);
    if constexpr (!ALIGN_EPI) { if (wr == 0) PG8_BAR; }
    PG8_BAR;
    if constexpr (Epi::AFTER_DRAIN) { E.fused(acc, cur, wr, wc, fr, fq, lds, wid, lane); S.done(cur); }
#undef PG8_SA
#undef PG8_SB
#undef PG8_STAGE
#undef PG8_LDA
#undef PG8_LDB
#undef PG8_MMA
#undef PG8_WAIT_V
#undef PG8_WAIT_L
#undef PG8_BAR
#undef PG8_SCHED
}
}
constexpr int NWAVES = 8, NTHREADS = 512;
constexpr int D = 1024, MP = 16384, MS = 1024, M = MP + MS, NSEQ = 136, FF = 2816;
constexpr int PSEQ = 2048, SSEQ = 8, NPB = 8, NSB = 128;
constexpr int ZW = 3328;
constexpr int ZQ = 0, ZK = 512, ZV = 1024, ZO = 1536, ZXR = 2048, ZGR = 2560, ZIG = 3072, ZFG = 3076;
constexpr int RKW = 3072, WAGW = 3072;
constexpr float ALPHA = 1.41421356237f;
constexpr float LN_EPS = 1e-5f, HEAD_EPS = 1e-6f, RW_EPS = 64e-5f;
constexpr float MSCALE = 0.08838834764831845f;

constexpr size_t O_Y = 0, O_PMC = 17825792, O_PMN = 18350080, O_PMM = 18354176, O_PRH = 18354208, O_PRC = 18358304, O_PWKV = 18370592, O_PSH = 18894880,
                 O_SMC = 18903072, O_SMN = 27291680, O_SMM = 27357216, O_SRH = 27357728, O_SRC = 27423264, O_SWKV = 27619872, O_SSH = 36008480, O_END = 36139552;

constexpr size_t MiB = 1u << 20;
constexpr size_t WS_CTL = 0, CTL_ZERO_BYTES = 1 * MiB;
constexpr size_t WS_W13 = 1 * MiB;
constexpr size_t WS_W2 = 45 * MiB;
constexpr size_t WS_WIN = 67 * MiB;
constexpr size_t WS_WOUT = WS_WIN + 6815744;
constexpr size_t WS_WRK = WS_WOUT + 2 * MiB;
constexpr size_t WS_WL2 = WS_WRK + 13 * MiB;
constexpr size_t WS_WO = WS_WL2 + 1572864;
constexpr size_t WS_MOD = 92 * MiB;
constexpr size_t WS_SC = 101 * MiB + 640 * 1024;
constexpr size_t WS_H = 102 * MiB;
constexpr size_t WS_BIG = 136 * MiB;
constexpr size_t WS_HID = WS_BIG;
constexpr size_t WS_Z = WS_BIG;
constexpr size_t WS_CST = WS_BIG + 111 * MiB;
constexpr size_t WS_SLAB = WS_BIG + 180 * MiB;
constexpr size_t WS_RGH = WS_BIG + 143 * MiB;
constexpr size_t WS_RGP = WS_BIG + 175 * MiB;
constexpr size_t WS_NST = WS_BIG + 207 * MiB;
constexpr size_t WS_MST = WS_NST + 262144;
constexpr size_t WS_CARRY = WS_MST + 8192;
constexpr size_t WS_RK = WS_BIG;
constexpr size_t WS_A3 = WS_BIG + 102 * MiB;
constexpr size_t WS_A2 = WS_BIG + 111 * MiB;
constexpr size_t WS_WAG = WS_BIG + 111 * MiB;
constexpr size_t WS_END = WS_BIG + 224 * MiB;
static_assert(WS_WO + 2 * MiB <= WS_MOD && WS_MOD + (size_t)2 * 136 * 9216 * 4 <= WS_SC && WS_SC + 160 * 1024 * 2 <= WS_H && WS_H + (size_t)M * D * 2 <= WS_BIG, "ws map");
static_assert(WS_SLAB + (size_t)11 * 4 * MiB <= WS_END && WS_A2 + (size_t)M * 2048 * 2 <= WS_SLAB && WS_CARRY + 8 * 64 * 512 * 4 <= WS_END && WS_WAG + (size_t)M * WAGW * 2 <= WS_END && WS_A3 + (size_t)M * 256 * 2 <= WS_A2, "ws map 2");
constexpr int CW_BAR = 4096;

constexpr int LDS_BYTES = 147456;
constexpr int LDSCTL_OFF = LDS_BYTES - 512;
constexpr int MISC_OFF = LDSCTL_OFF;

#define GAS __attribute__((address_space(1)))
#define LAS __attribute__((address_space(3)))
typedef unsigned short bf16;
typedef unsigned v4u __attribute__((ext_vector_type(4)));
typedef unsigned v2u __attribute__((ext_vector_type(2)));
typedef float f32x4 __attribute__((ext_vector_type(4)));
typedef float f32x2 __attribute__((ext_vector_type(2)));
typedef float f32x16 __attribute__((ext_vector_type(16)));
typedef short bf16x8 __attribute__((ext_vector_type(8)));
typedef GAS unsigned gu32;
#define RLX_AGENT __ATOMIC_RELAXED, __HIP_MEMORY_SCOPE_AGENT
#define LDS_WAIT() asm volatile("s_waitcnt lgkmcnt(0)" ::: "memory")
#define DI __device__ __forceinline__
#define MFMA32(a, b, c) __builtin_amdgcn_mfma_f32_32x32x16_bf16((a), (b), (c), 0, 0, 0)
DI unsigned f2bf(float f) { unsigned u = __builtin_bit_cast(unsigned, f); return (u + 0x7fffu + ((u >> 16) & 1u)) >> 16; }
DI unsigned pk2(float lo, float hi) { return pg8::cvt_pk_bf16(lo, hi); }
DI float bf2f(unsigned b) { return __builtin_bit_cast(float, b << 16); }
DI float bflo(unsigned w) { return __builtin_bit_cast(float, w << 16); }
DI float bfhi(unsigned w) { return __builtin_bit_cast(float, w & 0xffff0000u); }
DI int crow(int reg, int h) { return (reg & 3) + 8 * (reg >> 2) + 4 * h; }
DI float fexp(float x) { return __builtin_amdgcn_exp2f(1.44269504f * x); }
DI float fsig(float x) { return pg8::fsig(x); }
DI bf16x8 mk_frag(unsigned a, unsigned b, unsigned c, unsigned d) { v4u p; p.x = a; p.y = b; p.z = c; p.w = d; return __builtin_bit_cast(bf16x8, p); }
DI bf16x8 pack8(const float (&v)[8]) { return mk_frag(pk2(v[0], v[1]), pk2(v[2], v[3]), pk2(v[4], v[5]), pk2(v[6], v[7])); }
DI float wave_sum(float v) {
#pragma unroll
    for (int o = 1; o < 64; o <<= 1) v += __shfl_xor(v, o);
    return v;
}

#define XB_TMO      128
#define XB_XCNT(j)  (256  + 64 * (j))
#define XB_XSUB(j)  (1280 + 64 * (j))
#define XB_XGEN(j)  (2304 + 64 * (j))
#define XB_TOP      3328
#define XB_TOPGEN   3392
#define XCD_BAR_WORDS 3456
#define XB_SPIN_CAP (1u << 18)

__device__ __forceinline__ unsigned xb_ld(unsigned* p)              { return __hip_atomic_load(p, __ATOMIC_RELAXED, __HIP_MEMORY_SCOPE_AGENT); }
__device__ __forceinline__ unsigned xb_add(unsigned* p, unsigned v) { return __hip_atomic_fetch_add(p, v, __ATOMIC_RELAXED, __HIP_MEMORY_SCOPE_AGENT); }
__device__ __forceinline__ unsigned xb_xcc_id() { return (unsigned)__builtin_amdgcn_s_getreg((3 << 11) | 20) & 0xFu; }
#define XB_SPIN(cond, bar) do { unsigned _sp = 0; while (cond) { __builtin_amdgcn_s_sleep(1); \
    if ((++_sp & 255u) == 0u) { if (xb_ld(&(bar)[XB_TMO])) break; if (_sp > XB_SPIN_CAP) { atomicAdd(&(bar)[XB_TMO], 1u); break; } } } } while (0)

struct XcdBarrier {
    unsigned* bar; unsigned x;
    volatile LAS unsigned* st;
};

__device__ __forceinline__ XcdBarrier xcd_barrier_post(unsigned* bar, volatile LAS unsigned* st) {
    XcdBarrier b; b.bar = bar; b.x = xb_xcc_id(); b.st = st;
    if (threadIdx.x == 0) (void)xb_add(&bar[XB_XCNT(b.x)], 1u);
    return b;
}
__device__ __forceinline__ void xcd_barrier_complete(unsigned* bar, unsigned x, unsigned& nloc, unsigned& nx) {
    const unsigned G = gridDim.x * gridDim.y * gridDim.z;
    unsigned sum, cnt, mine, sp = 0u;
    for (;;) {
        sum = 0u; cnt = 0u; mine = 0u;
#pragma unroll
        for (unsigned j = 0; j < 16; ++j) { const unsigned c = xb_ld(&bar[XB_XCNT(j)]); sum += c; cnt += (c > 0u) ? 1u : 0u; mine = (j == x) ? c : mine; }
        if (sum == G) break;
        __builtin_amdgcn_s_sleep(1);
        if ((++sp & 255u) == 0u) { if (xb_ld(&bar[XB_TMO])) break; if (sp > XB_SPIN_CAP) { atomicAdd(&bar[XB_TMO], 1u); break; } }
    }
    nloc = mine > 0u ? mine : 1u; nx = cnt > 0u ? cnt : 1u;
}

__device__ __forceinline__ void xcd_barrier(const XcdBarrier& b) {
    asm volatile("s_waitcnt vmcnt(0)" ::: "memory");
    __syncthreads();
    if (threadIdx.x == 0) {
        unsigned* bar = b.bar;
        __builtin_amdgcn_s_waitcnt(0);
        unsigned nloc = b.st[0], nx = b.st[1];
        if (nloc == 0u) { xcd_barrier_complete(bar, b.x, nloc, nx); b.st[0] = nloc; b.st[1] = nx; }
        const unsigned old = xb_add(&bar[XB_XSUB(b.x)], 1u);
        const unsigned gen = old / nloc;
        if (old + 1u == (gen + 1u) * nloc) {
            __builtin_amdgcn_fence(__ATOMIC_RELEASE, "agent");
            asm volatile("s_waitcnt vmcnt(0)" ::: "memory");
            const unsigned og = xb_add(&bar[XB_TOP], 1u);
            const unsigned tg = og / nx;
            if (og + 1u == (tg + 1u) * nx) xb_add(&bar[XB_TOPGEN], 1u);
            else XB_SPIN(xb_ld(&bar[XB_TOPGEN]) == tg, bar);
            __builtin_amdgcn_fence(__ATOMIC_ACQUIRE, "agent");
            xb_add(&bar[XB_XGEN(b.x)], 1u);
            asm volatile("s_waitcnt vmcnt(0)" ::: "memory");
        } else {
            XB_SPIN(xb_ld(&bar[XB_XGEN(b.x)]) == gen, bar);
            __builtin_amdgcn_fence(__ATOMIC_ACQUIRE, "agent");
            asm volatile("s_waitcnt vmcnt(0)" ::: "memory");
        }
    }
    __syncthreads();
}
struct Args { const float* in[47]; float* out; unsigned char* ws; int ph_lo, ph_hi; };
struct Frame {
    LAS unsigned char* lds;
    volatile LAS unsigned* MISC;
    gu32* ctl;
    int tid, lane, wave;
    int vcu, G;
    float* out;
    unsigned char* ws;
};
enum { I_XP = 0, I_XS, I_CP, I_CS, I_SMC, I_SMN, I_SMM, I_SRH, I_SRC, I_SWKV, I_SSH, I_ADAW, I_ADAB, I_LNG, I_LNB, I_W1, I_W3, I_W2, I_WIN, I_BG, I_MNG,
       I_CW, I_CB, I_WA, I_BA, I_WX, I_BX, I_LAM, I_WOUT, I_MU, I_WR, I_WK, I_WV, I_W0, I_LW1, I_LW2, I_A0, I_A1, I_A2, I_G1, I_G2, I_KK, I_KA, I_RK, I_LXG, I_LXB, I_WO };

struct EpiResid {
    static constexpr bool PERM = false, AFTER_DRAIN = false;
    const Args& ar; float* out; unsigned char* ws; int cfg;
    __device__ __forceinline__ void operator()(const pg8::f32x4 (&acc)[2][2][4][2], const pg8::Unit& u, int wr, int wc, int fr, int fq) const {
        using pg8::BM; using pg8::HALF;
        const int row0 = u.pm * BM + wr * 64 + fr, col0 = u.pn * BM + wc * 32 + 4 * fq;
        if (u.sub) {
            float* sb = (float*)(ws + WS_SLAB) + (size_t)(u.k0 / (64 * u.nt)) * (1024 * 1024) + col0;
#pragma unroll
            for (int ai = 0; ai < 2; ++ai)
#pragma unroll
                for (int m = 0; m < 4; ++m) { float* o = sb + (size_t)(row0 + ai * HALF + m * 16 - MP) * 1024;
#pragma unroll
                    for (int bj = 0; bj < 2; ++bj)
#pragma unroll
                        for (int n = 0; n < 2; ++n) *(f32x4*)(o + bj * HALF + n * 16) = acc[ai][bj][m][n]; }
            return;
        }
        const bool first = cfg & 1; const int l = (cfg >> 1) & 1, jg = (cfg >> 2) & 15; const float rw = (cfg & 64) ? 1.0f : 0.5f;
        float* X = out + O_Y; const float* xp = first ? ar.in[I_XP] : X; const float* xs = first ? ar.in[I_XS] : X + (size_t)MP * D;
        float* Xo = (cfg & 128) ? (float*)(ws + WS_BIG + 111 * MiB) : X;
        const float* gate = (const float*)(ws + WS_MOD) + ((size_t)l * NSEQ * 9 + jg) * 1024;
#pragma unroll
        for (int ai = 0; ai < 2; ++ai)
#pragma unroll
            for (int m = 0; m < 4; ++m) { const int row = row0 + ai * HALF + m * 16;
                const float* xr = (row < MP ? xp + (size_t)row * 1024 : xs + (size_t)(row - MP) * 1024) + col0;
                const float* gr = gate + (size_t)pg8::mod_row(row) * 9216 + col0; float* o = Xo + (size_t)row * 1024 + col0;
#pragma unroll
                for (int bj = 0; bj < 2; ++bj)
#pragma unroll
                    for (int n = 0; n < 2; ++n) { const int c = bj * HALF + n * 16; const f32x4 xv = *(const f32x4*)(xr + c), gv = *(const f32x4*)(gr + c);
                        *(f32x4*)(o + c) = xv * ALPHA + (gv + 1.0f) * rw * acc[ai][bj][m][n]; } }
    }
};
struct SplitOrder {
    pg8::StaticOrder base; int S;
    __device__ __forceinline__ bool next(int i, pg8::Unit& u) const {
        if (S == 0) return base.next(i, u);
        if (i == 0) return base.next(0, u);
        if (i == 1 && base.c < 16 * S) { const int su = base.c / S, ks = base.c - su * S; u.pm = 64 + (su >> 2); u.pn = su & 3; u.k0 = ks * 256; u.nt = 4; u.sub = 1; return true; }
        return false;
    }
    __device__ __forceinline__ void a_ready(const pg8::Unit&) const {}
    __device__ __forceinline__ void done(const pg8::Unit&) const {}
};

DI void p0_sctab(Frame& F, const Args& AR) {
    bf16* sc = (bf16*)(F.ws + WS_SC);
    const int gt = F.vcu * NTHREADS + F.tid, NT = F.G * NTHREADS;
    for (int e = gt; e < 160 * 256; e += NT) { const int m = e >> 8, k4 = (e & 255) * 4; v2u w; w.x = 0u; w.y = 0u;
        if (m < NSEQ) { const f32x4 c = *(const f32x4*)((m < NPB ? AR.in[I_CP] + (size_t)m * D : AR.in[I_CS] + (size_t)(m - NPB) * D) + k4);
            w.x = pk2(c.x * fsig(c.x), c.y * fsig(c.y)); w.y = pk2(c.z * fsig(c.z), c.w * fsig(c.w)); }
        *(v2u*)(sc + (size_t)m * 1024 + k4) = w; }
}
DI void p0_mod(Frame& F, const Args& AR) {
    LAS float* SL = (LAS float*)F.lds;
    LAS float* T = (LAS float*)(F.lds + 81920);
    const int lane = F.lane, wave = F.wave, r = lane & 31, hh = lane >> 5;
    const float* adaw = AR.in[I_ADAW]; const float* adab = AR.in[I_ADAB];
    const bf16* sc = (const bf16*)(F.ws + WS_SC);
    float* mod = (float*)(F.ws + WS_MOD);
    for (int nb = F.vcu; nb < 576; nb += F.G) {
        const int n0 = nb * 32, l = n0 / 9216, nc0 = n0 - l * 9216;
        const float* W = adaw + (size_t)l * 1024 * 9216 + nc0 + r + (size_t)(wave * 128 + 8 * hh) * 9216;
        float a[8][8];
#pragma unroll
        for (int ks = 0; ks < 8; ++ks)
#pragma unroll
            for (int j = 0; j < 8; ++j) a[ks][j] = W[(size_t)(ks * 16 + j) * 9216];
        f32x16 acc[5];
#pragma unroll
        for (int mb = 0; mb < 5; ++mb)
#pragma unroll
            for (int i = 0; i < 16; ++i) acc[mb][i] = 0.f;
#pragma unroll
        for (int ks = 0; ks < 8; ++ks) { const bf16x8 A = pack8(a[ks]); const int k0 = wave * 128 + ks * 16 + 8 * hh;
#pragma unroll
            for (int mb = 0; mb < 5; ++mb) acc[mb] = MFMA32(A, *(const bf16x8*)(sc + (size_t)(mb * 32 + r) * 1024 + k0), acc[mb]); }
#pragma unroll
        for (int half = 4; half >= 1; half >>= 1) {
            if (wave >= half && wave < 2 * half) { LAS float* p = SL + (wave - half) * 5120 + lane;
#pragma unroll
                for (int mb = 0; mb < 5; ++mb)
#pragma unroll
                    for (int i = 0; i < 16; ++i) p[(mb * 16 + i) * 64] = acc[mb][i]; }
            __syncthreads();
            if (wave < half) { const LAS float* p = SL + wave * 5120 + lane;
#pragma unroll
                for (int mb = 0; mb < 5; ++mb)
#pragma unroll
                    for (int i = 0; i < 16; ++i) acc[mb][i] += p[(mb * 16 + i) * 64]; }
            __syncthreads();
        }
        if (wave == 0) {
#pragma unroll
            for (int mb = 0; mb < 5; ++mb)
#pragma unroll
                for (int i = 0; i < 16; ++i) T[(mb * 32 + r) * 33 + crow(i, hh)] = acc[mb][i]; }
        __syncthreads();
        for (int m = F.tid >> 5; m < NSEQ; m += 16) { const int n = F.tid & 31; mod[(size_t)(l * NSEQ + m) * 9216 + nc0 + n] = T[m * 33 + n] + adab[l * 9216 + nc0 + n]; }
        __syncthreads();
    }
}

DI void tr_item(const float* src, int ld, int nvalid, float keep, const float* sc, float sa, float sb, bf16* dst, int dld, LAS float* scr, int lane) {
    const int n4 = (lane & 7) * 4, kr = lane >> 3; const float kz = (n4 < nvalid) ? keep : 0.f;
    f32x4 v[8]; float m[8];
#pragma unroll
    for (int i = 0; i < 8; ++i) { v[i] = *(const f32x4*)(src + (size_t)(kr + 8 * i) * ld + n4); m[i] = sc[kr + 8 * i]; }
#pragma unroll
    for (int i = 0; i < 8; ++i) { const float f = (sa + sb * m[i]) * kz; LAS float* p = scr + (kr + 8 * i) * 33 + n4;
        p[0] = kz == 0.f ? 0.f : v[i].x * f; p[1] = kz == 0.f ? 0.f : v[i].y * f; p[2] = kz == 0.f ? 0.f : v[i].z * f; p[3] = kz == 0.f ? 0.f : v[i].w * f; }
    LDS_WAIT(); asm volatile("" ::: "memory");
    const int c = lane & 7;
#pragma unroll
    for (int j = 0; j < 4; ++j) { const int n = (lane >> 3) + 8 * j; const LAS float* s = scr + (8 * c) * 33 + n;
        v4u o; o.x = pk2(s[0 * 33], s[1 * 33]); o.y = pk2(s[2 * 33], s[3 * 33]); o.z = pk2(s[4 * 33], s[5 * 33]); o.w = pk2(s[6 * 33], s[7 * 33]);
        *(GAS v4u*)(dst + (size_t)n * dld + 8 * c) = o; }
    LDS_WAIT(); asm volatile("" ::: "memory");
}
DI void p0_weights(Frame& F, const Args& AR) {
    LAS float* scr = (LAS float*)(F.lds + 32768 + F.wave * 8704);
    const int gw = F.vcu * NWAVES + F.wave, NGW = F.G * NWAVES;
    constexpr int I_13 = 16 * 176, I_2 = 44 * 32, I_IN = 16 * 104, I_SQ = 16 * 32, I_RKI = 32 * 104, I_L2 = 4 * 96;
    constexpr int NITEMS = 4 * I_13 + 4 * I_2 + I_IN + 2 * I_SQ + I_RKI + I_L2;
    bf16* W13 = (bf16*)(F.ws + WS_W13); bf16* W2 = (bf16*)(F.ws + WS_W2); bf16* WIN = (bf16*)(F.ws + WS_WIN); bf16* WOUT = (bf16*)(F.ws + WS_WOUT);
    bf16* WRK = (bf16*)(F.ws + WS_WRK); bf16* WL2 = (bf16*)(F.ws + WS_WL2); bf16* WO = (bf16*)(F.ws + WS_WO);
    for (int it = gw; it < NITEMS; it += NGW) {
        int r = it;
        if (r < 4 * I_13) { const int f = r / I_13; r -= f * I_13; const int kt = r / 176, tn = r % 176, j = tn >> 3, i = tn & 7;
            const float* src = (i < 4 ? AR.in[I_W1] : AR.in[I_W3]) + (size_t)f * 1024 * FF + (size_t)(64 * kt) * FF + 128 * j + 32 * (i & 3);
            tr_item(src, FF, 32, 1.f, src, 1.f, 0.f, W13 + (size_t)f * 5632 * 1024 + (size_t)(32 * tn) * 1024 + 64 * kt, 1024, scr, F.lane); continue; }
        r -= 4 * I_13;
        if (r < 4 * I_2) { const int f = r / I_2; r -= f * I_2; const int kt = r / 32, tn = r % 32;
            const float* src = AR.in[I_W2] + (size_t)f * FF * 1024 + (size_t)(64 * kt) * 1024 + 32 * tn;
            tr_item(src, 1024, 32, 1.f, src, 1.f, 0.f, W2 + (size_t)f * 1024 * FF + (size_t)(32 * tn) * FF + 64 * kt, FF, scr, F.lane); continue; }
        r -= 4 * I_2;
        if (r < I_IN) { const int kt = r / 104, tn = r % 104, nd = 32 * tn; int sc0 = 0, nv = 32; bool has = true;
            if (nd < 2048) sc0 = nd; else if (nd < 3072) sc0 = nd + 8; else if (nd == 3072) { sc0 = 2048; nv = 8; } else has = false;
            const float* src = AR.in[I_WIN] + (size_t)(64 * kt) * 3080 + sc0;
            tr_item(src, 3080, nv, has ? 1.f : 0.f, src, 1.f, 0.f, WIN + (size_t)nd * 1024 + 64 * kt, 1024, scr, F.lane); continue; }
        r -= I_IN;
        if (r < 2 * I_SQ) { const int w = r / I_SQ; r -= w * I_SQ; const int kt = r / 32, tn = r % 32;
            const float* src = (w == 0 ? AR.in[I_WOUT] : AR.in[I_WO]) + (size_t)(64 * kt) * 1024 + 32 * tn;
            tr_item(src, 1024, 32, 1.f, src, 1.f, 0.f, (w == 0 ? WOUT : WO) + (size_t)(32 * tn) * 1024 + 64 * kt, 1024, scr, F.lane); continue; }
        r -= 2 * I_SQ;
        if (r < I_RKI) { const int kt = r / 104, tn = r % 104, nd = 32 * tn, kd = 64 * kt, half = kd >= 1024, ks = kd & 1023;
            const float* base; int ld, col, mi;
            if (nd < 1024) { base = AR.in[I_WR]; ld = 1024; col = nd; mi = 0; }
            else if (nd < 2048) { base = AR.in[I_WK]; ld = 1024; col = nd - 1024; mi = 2; }
            else if (nd < 3072) { base = AR.in[I_WV]; ld = 1024; col = nd - 2048; mi = 3; }
            else if (nd < 3136) { base = AR.in[I_LW1]; ld = 64; col = nd - 3072; mi = 1; }
            else if (nd < 3200) { base = AR.in[I_A1]; ld = 64; col = nd - 3136; mi = 4; }
            else { base = AR.in[I_G1]; ld = 128; col = nd - 3200; mi = 5; }
            tr_item(base + (size_t)ks * ld + col, ld, 32, 1.f, AR.in[I_MU] + mi * 1024 + ks, half ? 0.f : 1.f, half ? 1.f : -1.f, WRK + (size_t)nd * 2048 + kd, 2048, scr, F.lane); continue; }
        r -= I_RKI;
        { const int kt = r / 96, tn = r % 96, nd = 32 * tn; const float* src = AR.in[I_LW2]; float keep = 0.f;
            if (nd < 1024) { if (kt == 0) { src = AR.in[I_LW2] + nd; keep = 1.f; } }
            else if (nd < 2048) { if (kt == 1) { src = AR.in[I_A2] + (nd - 1024); keep = 1.f; } }
            else { if (kt >= 2) { src = AR.in[I_G2] + (size_t)(64 * (kt - 2)) * 1024 + (nd - 2048); keep = 1.f; } }
            tr_item(src, 1024, 32, keep, AR.in[I_LW2], 1.f, 0.f, WL2 + (size_t)nd * 256 + 64 * kt, 256, scr, F.lane); }
    }
}

DI void ln_pass(Frame& F, const Args& AR, int first, int do_ln, int l, int sub, int lm, int js, int mode, int nsplit, int xfirst) {
    const int gw = F.vcu * NWAVES + F.wave, NGW = F.G * NWAVES, lane = F.lane;
    float* X = F.out + O_Y;
    const float* lg = AR.in[I_LNG] + (l * 3 + sub) * 1024; const float* lb = AR.in[I_LNB] + (l * 3 + sub) * 1024;
    const float* mod = (const float*)(F.ws + WS_MOD);
    bf16* H = (bf16*)(F.ws + WS_H); bf16* A2 = (bf16*)(F.ws + WS_A2);
    for (int r = gw; r < M; r += NGW) {
        const float* src = first ? (r < MP ? AR.in[I_XP] + (size_t)r * D : AR.in[I_XS] + (size_t)(r - MP) * D) : X + (size_t)r * D;
        f32x4 v[4];
#pragma unroll
        for (int j = 0; j < 4; ++j) v[j] = ((const f32x4*)src)[lane + 64 * j];
        if (nsplit > 0 && r >= MP) {
            const float* xo = xfirst ? AR.in[I_XS] + (size_t)(r - MP) * D : src;
            const float* gp = mod + ((size_t)(l * NSEQ + pg8::mod_row(r)) * 9 + 3 * sub + 2) * 1024; const float rw = sub == 1 ? 1.0f : 0.5f;
            const float* sl = (const float*)(F.ws + WS_SLAB) + (size_t)(r - MP) * 1024;
#pragma unroll
            for (int j = 0; j < 4; ++j) { f32x4 a = ((const f32x4*)sl)[lane + 64 * j];
                for (int s = 1; s < nsplit; ++s) a += ((const f32x4*)(sl + (size_t)s * 1024 * 1024))[lane + 64 * j];
                const f32x4 g4 = ((const f32x4*)gp)[lane + 64 * j], x4 = ((const f32x4*)xo)[lane + 64 * j];
                v[j] = x4 * ALPHA + (g4 + 1.0f) * rw * a; }
        }
        if (do_ln) {
            float s = 0.f;
#pragma unroll
            for (int j = 0; j < 4; ++j) s += (v[j].x + v[j].y) + (v[j].z + v[j].w);
            const float mean = wave_sum(s) * (1.f / D); float s2 = 0.f;
#pragma unroll
            for (int j = 0; j < 4; ++j) { v[j] = v[j] - mean; s2 += (v[j].x * v[j].x + v[j].y * v[j].y) + (v[j].z * v[j].z + v[j].w * v[j].w); }
            const float rstd = 1.f / sqrtf(wave_sum(s2) * (1.f / D) + LN_EPS);
#pragma unroll
            for (int j = 0; j < 4; ++j) { const f32x4 g4 = ((const f32x4*)lg)[lane + 64 * j], b4 = ((const f32x4*)lb)[lane + 64 * j]; v[j] = v[j] * rstd * g4 + b4;
                ((f32x4*)(X + (size_t)r * D))[lane + 64 * j] = v[j]; }
        }
        if (mode != 2) {
            const int mr = pg8::mod_row(r);
            const float* sh = mod + ((size_t)(lm * NSEQ + mr) * 9 + js) * 1024; const float* sc = sh + 1024;
            int t, len, b; if (r < MP) { t = r & (PSEQ - 1); len = PSEQ; b = r >> 11; } else { t = (r - MP) & (SSEQ - 1); len = SSEQ; b = (r - MP) >> 3; }
#pragma unroll
            for (int j = 0; j < 4; ++j) { const f32x4 s4 = ((const f32x4*)sc)[lane + 64 * j], h4 = ((const f32x4*)sh)[lane + 64 * j];
                const f32x4 h = v[j] * (s4 + 1.0f) + h4; v2u w; w.x = pk2(h.x, h.y); w.y = pk2(h.z, h.w); const int col = 4 * (lane + 64 * j);
                if (mode == 0) *(v2u*)(H + (size_t)r * D + col) = w;
                else {
                    *(v2u*)(A2 + (size_t)r * 2048 + col) = w;
                    if (t + 1 < len) *(v2u*)(A2 + (size_t)(r + 1) * 2048 + 1024 + col) = w;
                    if (t == 0) { v2u p; p.x = 0u; p.y = 0u;
                        if (r >= MP) { const f32x4 q = *(const f32x4*)(AR.in[I_SSH] + (size_t)b * D + col); p.x = pk2(q.x, q.y); p.y = pk2(q.z, q.w); }
                        *(v2u*)(A2 + (size_t)r * 2048 + 1024 + col) = p; }
                    if (t == len - 1) *(f32x4*)(F.out + (r < MP ? O_PSH : O_SSH) + (size_t)b * D + col) = h;
                } }
        }
    }
}

DI float log_sigmoid(float x) { return -(fmaxf(-x, 0.f) + log1pf(__expf(-fabsf(x)))); }
DI float gelu_tanh(float x) { const float u = 0.7978845608f * (x + 0.044715f * x * x * x); return 0.5f * x * (1.0f + pg8::ftanh(u)); }

DI void ml1_prompt(Frame& F, const Args& AR) {
    const bf16* Z = (const bf16*)(F.ws + WS_Z);
    float* CST = (float*)(F.ws + WS_CST); float* NST = (float*)(F.ws + WS_NST); float* MST = (float*)(F.ws + WS_MST);
    LAS bf16* Ks = (LAS bf16*)F.lds;
    LAS bf16* Vs = (LAS bf16*)(F.lds + 32768);
    LAS float* LF = (LAS float*)(F.lds + 65536);
    LAS float* GS = (LAS float*)(F.lds + 65536 + 512);
    LAS float* RED = (LAS float*)(F.lds + 65536 + 1024);
    const int tid = F.tid, lane = F.lane, wave = F.wave, r = lane & 31, hh = lane >> 5;
    for (int item = F.vcu; item < 512; item += F.G) {
        const int b = item >> 6, h = (item >> 4) & 3, c = item & 15; const size_t row0 = (size_t)b * PSEQ + c * 128;
#pragma unroll
        for (int i = 0; i < 4; ++i) { const int e = tid + i * NTHREADS, s = e >> 4, c8 = (e & 15) * 8;
            *(LAS v4u*)(Ks + s * 128 + c8) = *(const v4u*)(Z + (row0 + s) * ZW + ZK + h * 128 + c8);
            *(LAS v4u*)(Vs + s * 128 + c8) = *(const v4u*)(Z + (row0 + s) * ZW + ZV + h * 128 + c8); }
        if (tid < 128) { const float fg = bf2f(Z[(row0 + tid) * ZW + ZFG + h]); LF[tid] = log_sigmoid(fg + AR.in[I_BG][4 + h]); }
        __syncthreads();
        if (tid < 128) { float bs = 0.f; for (int s = 0; s <= tid; ++s) bs += LF[s];
            const float ig = bf2f(Z[(row0 + tid) * ZW + ZIG + h]) + AR.in[I_BG][h];
            GS[tid] = ig - bs; if (tid == 127) RED[0] = bs; }
        __syncthreads();
        float gmax = -INFINITY; for (int s = 0; s < 128; ++s) gmax = fmaxf(gmax, GS[s]);
        const float bL = RED[0];
        __syncthreads();
        if (tid < 128) GS[tid] = fexp(GS[tid] - gmax);
        __syncthreads();
        const int vb = wave >> 1, kb0 = 2 * (wave & 1);
        f32x16 acc[2];
#pragma unroll
        for (int i = 0; i < 16; ++i) { acc[0][i] = 0.f; acc[1][i] = 0.f; }
#pragma unroll 2
        for (int ks = 0; ks < 8; ++ks) { const int s0 = 16 * ks + 8 * hh;
            float a[8];
#pragma unroll
            for (int j = 0; j < 8; ++j) a[j] = bf2f(Vs[(s0 + j) * 128 + vb * 32 + r]) * GS[s0 + j];
            const bf16x8 A = pack8(a);
#pragma unroll
            for (int q = 0; q < 2; ++q) { unsigned kw[8];
#pragma unroll
                for (int j = 0; j < 8; ++j) kw[j] = Ks[(s0 + j) * 128 + (kb0 + q) * 32 + r];
                const bf16x8 B = mk_frag(kw[0] | (kw[1] << 16), kw[2] | (kw[3] << 16), kw[4] | (kw[5] << 16), kw[6] | (kw[7] << 16));
                acc[q] = MFMA32(A, B, acc[q]); } }
        float* Co = CST + (size_t)item * 16384;
#pragma unroll
        for (int q = 0; q < 2; ++q)
#pragma unroll
            for (int i = 0; i < 16; ++i) Co[(vb * 32 + crow(i, hh)) * 128 + (kb0 + q) * 32 + r] = acc[q][i] * MSCALE;
        if (tid < 128) { float n = 0.f; for (int s = 0; s < 128; ++s) n += GS[s] * bf2f(Ks[s * 128 + tid]); NST[item * 128 + tid] = n * MSCALE; }
        if (tid == 0) { MST[item * 4 + 0] = bL + gmax; MST[item * 4 + 1] = bL; }
        __syncthreads();
    }
}

DI void ml_sample(Frame& F, const Args& AR) {
    const bf16* Z = (const bf16*)(F.ws + WS_Z); bf16* G = (bf16*)(F.ws + WS_H);
    LAS float* Qs = (LAS float*)F.lds;
    LAS float* Ks = Qs + 1024; LAS float* Vs = Ks + 1024;
    LAS float* HT = Vs + 1024;
    LAS float* P = HT + 1024;
    LAS float* GT = P + 64;
    LAS float* SC = GT + 64;
    const int tid = F.tid, lane = F.lane, wave = F.wave;
    const float* C0g = AR.in[I_SMC]; const float* n0g = AR.in[I_SMN]; const float* m0g = AR.in[I_SMM];
    for (int item = F.vcu; item < 512; item += F.G) {
        const int b = item >> 2, h = item & 3; const size_t row0 = (size_t)MP + (size_t)b * SSEQ;
        for (int e = tid; e < 3 * 512; e += NTHREADS) { const int w = e >> 9, t = (e >> 6) & 7, c2 = (e & 63) * 2;
            const unsigned u = *(const unsigned*)(Z + (row0 + t) * ZW + (w == 0 ? ZQ : (w == 1 ? ZK : ZV)) + h * 128 + c2);
            LAS float* dst = (w == 0 ? Qs : (w == 1 ? Ks : Vs)) + t * 128 + c2; dst[0] = bflo(u); dst[1] = bfhi(u); }
        const float m0 = m0g[b * 4 + h];
        if (tid < 16) { const int t = tid & 7; const float zv = bf2f(Z[(row0 + t) * ZW + (tid < 8 ? ZIG : ZFG) + h]);
            if (tid < 8) P[t] = zv + AR.in[I_BG][h]; else GT[7 * 8 + t] = log_sigmoid(zv + AR.in[I_BG][4 + h]); }
        __syncthreads();
        if (tid < 8) { float bs = 0.f, mx = m0, bsl = 0.f, gme = 0.f;
            for (int s = 0; s < 8; ++s) { bs += GT[7 * 8 + s]; const float g = P[s] - bs; if (s <= tid) { mx = fmaxf(mx, g); bsl = bs; } if (s == tid) gme = g; }
            GT[0 * 8 + tid] = bsl; GT[1 * 8 + tid] = gme; GT[2 * 8 + tid] = mx; GT[3 * 8 + tid] = fexp(m0 - mx);
            if (tid == 7) { const float mend = bsl + mx; SC[0] = mend; SC[1] = fexp(bsl + m0 - mend); } }
        __syncthreads();
        if (tid < 8) { const float mend = SC[0]; GT[5 * 8 + tid] = fexp(GT[0 * 8 + 7] + GT[1 * 8 + tid] - mend); }
        if (tid < 64) { const int t = tid >> 3, s = tid & 7; float d = 0.f;
            if (s <= t) { for (int k = 0; k < 128; ++k) d += Qs[t * 128 + k] * Ks[s * 128 + k]; d = d * MSCALE * fexp(GT[1 * 8 + s] - GT[2 * 8 + t]); }
            P[t * 8 + s] = d; }
        else if (tid < 72) { const int t = tid - 64; float d = 0.f; for (int k = 0; k < 128; ++k) d += Qs[t * 128 + k] * n0g[(size_t)(b * 4 + h) * 128 + k]; GT[6 * 8 + t] = d; }
        __syncthreads();
        if (tid < 8) { float d = 0.f; for (int s = 0; s < 8; ++s) d += P[tid * 8 + s]; d += GT[3 * 8 + tid] * GT[6 * 8 + tid];
            const float mt = GT[0 * 8 + tid] + GT[2 * 8 + tid]; GT[4 * 8 + tid] = fmaxf(fabsf(d), fexp(-mt)); }
        const int v = tid >> 2, seg = tid & 3;
        const float* C0p = C0g + ((size_t)(b * 4 + h) * 128 + v) * 128 + seg * 32;
        float c0[32];
#pragma unroll
        for (int i = 0; i < 8; ++i) { const f32x4 q = *(const f32x4*)(C0p + 4 * i); c0[4 * i] = q.x; c0[4 * i + 1] = q.y; c0[4 * i + 2] = q.z; c0[4 * i + 3] = q.w; }
        __syncthreads();
        float inter[8];
#pragma unroll
        for (int t = 0; t < 8; ++t) { float d = 0.f;
#pragma unroll
            for (int i = 0; i < 32; ++i) d += c0[i] * Qs[t * 128 + seg * 32 + i];
            d += __shfl_xor(d, 1); d += __shfl_xor(d, 2); inter[t] = d; }
        if (seg == 0) {
#pragma unroll
            for (int t = 0; t < 8; ++t) { float num = GT[3 * 8 + t] * inter[t];
                for (int s = 0; s <= t; ++s) num += P[t * 8 + s] * Vs[s * 128 + v];
                HT[t * 128 + v] = num / GT[4 * 8 + t]; } }
        { const float wst = SC[1]; float* Cout = F.out + O_SMC + ((size_t)(b * 4 + h) * 128 + v) * 128 + seg * 32;
#pragma unroll
            for (int i = 0; i < 32; ++i) c0[i] *= wst;
#pragma unroll
            for (int s = 0; s < 8; ++s) { const float wv = GT[5 * 8 + s] * Vs[s * 128 + v] * MSCALE;
#pragma unroll
                for (int i = 0; i < 32; ++i) c0[i] += wv * Ks[s * 128 + seg * 32 + i]; }
#pragma unroll
            for (int i = 0; i < 8; ++i) { f32x4 q; q.x = c0[4 * i]; q.y = c0[4 * i + 1]; q.z = c0[4 * i + 2]; q.w = c0[4 * i + 3]; *(f32x4*)(Cout + 4 * i) = q; } }
        if (tid < 128) { float n = SC[1] * n0g[(size_t)(b * 4 + h) * 128 + tid];
            for (int s = 0; s < 8; ++s) n += GT[5 * 8 + s] * Ks[s * 128 + tid] * MSCALE;
            F.out[O_SMN + (size_t)(b * 4 + h) * 128 + tid] = n; }
        if (tid == 0) F.out[O_SMM + b * 4 + h] = SC[0];
        __syncthreads();
        { const int t = wave; const float x0 = HT[t * 128 + lane], x1 = HT[t * 128 + 64 + lane];
            const float mean = wave_sum(x0 + x1) * (1.f / 128.f); const float d0 = x0 - mean, d1 = x1 - mean;
            const float rstd = 1.f / sqrtf(wave_sum(d0 * d0 + d1 * d1) * (1.f / 128.f) + HEAD_EPS);
            const size_t row = row0 + t;
            const float o0 = bf2f(Z[row * ZW + ZO + h * 128 + lane]), o1 = bf2f(Z[row * ZW + ZO + h * 128 + 64 + lane]);
            const float g0 = AR.in[I_MNG][h * 128 + lane], g1 = AR.in[I_MNG][h * 128 + 64 + lane];
            G[row * D + h * 128 + lane] = (bf16)f2bf(d0 * rstd * g0 * fsig(o0)); G[row * D + h * 128 + 64 + lane] = (bf16)f2bf(d1 * rstd * g1 * fsig(o1)); }
        __syncthreads();
    }
}

DI void rg1(Frame& F, const Args& AR) {
    const bf16* Z = (const bf16*)(F.ws + WS_Z); bf16* G = (bf16*)(F.ws + WS_H);
    float* RGH = (float*)(F.ws + WS_RGH); float* RGP = (float*)(F.ws + WS_RGP);
    const int lane = F.lane, g = F.wave, r = lane & 31, hh = lane >> 5;
    LAS float* XT = (LAS float*)(F.lds + g * 17408);
    LAS float* AT = XT + 32 * 68;
    const float* wa = AR.in[I_WA] + (size_t)g * 4096; const float* wx = AR.in[I_WX] + (size_t)g * 4096;
    float spl[2], ba[2], bx[2];
#pragma unroll
    for (int cb = 0; cb < 2; ++cb) { const int c = 64 * g + cb * 32 + r; spl[cb] = -8.0f * log1pf(__expf(-AR.in[I_LAM][c])); ba[cb] = AR.in[I_BA][c]; bx[cb] = AR.in[I_BX][c]; }
    const float* cw = AR.in[I_CW]; const float* cbias = AR.in[I_CB];
    for (int tt = F.vcu; tt < M / 32; tt += F.G) {
        const int R0 = tt * 32, row = R0 + r; const bool samp = R0 >= MP;
        int t, b; if (!samp) { t = row & (PSEQ - 1); b = row >> 11; } else { t = (row - MP) & 7; b = (row - MP) >> 3; }
        bf16x8 Af[4];
#pragma unroll
        for (int ks = 0; ks < 4; ++ks) { const int c0 = 64 * g + 16 * ks + 8 * hh; float xc[8];
            { const f32x4 q0 = *(const f32x4*)(cbias + c0), q1 = *(const f32x4*)(cbias + c0 + 4); xc[0] = q0.x; xc[1] = q0.y; xc[2] = q0.z; xc[3] = q0.w; xc[4] = q1.x; xc[5] = q1.y; xc[6] = q1.z; xc[7] = q1.w; }
#pragma unroll
            for (int tap = 0; tap < 4; ++tap) { const int tp = t + tap - 3; float xv[8];
                if (tp >= 0) { const v4u q = *(const v4u*)(Z + (size_t)(row + tap - 3) * ZW + ZXR + c0);
                    xv[0] = bflo(q.x); xv[1] = bfhi(q.x); xv[2] = bflo(q.y); xv[3] = bfhi(q.y); xv[4] = bflo(q.z); xv[5] = bfhi(q.z); xv[6] = bflo(q.w); xv[7] = bfhi(q.w); }
                else if (samp) { const float* sp = AR.in[I_SRC] + ((size_t)b * 3 + (t + tap)) * 512 + c0; const f32x4 q0 = *(const f32x4*)sp, q1 = *(const f32x4*)(sp + 4);
                    xv[0] = q0.x; xv[1] = q0.y; xv[2] = q0.z; xv[3] = q0.w; xv[4] = q1.x; xv[5] = q1.y; xv[6] = q1.z; xv[7] = q1.w; }
                else {
#pragma unroll
                    for (int j = 0; j < 8; ++j) xv[j] = 0.f; }
                const f32x4 w0 = *(const f32x4*)(cw + tap * 512 + c0), w1 = *(const f32x4*)(cw + tap * 512 + c0 + 4);
                xc[0] += w0.x * xv[0]; xc[1] += w0.y * xv[1]; xc[2] += w0.z * xv[2]; xc[3] += w0.w * xv[3]; xc[4] += w1.x * xv[4]; xc[5] += w1.y * xv[5]; xc[6] += w1.z * xv[6]; xc[7] += w1.w * xv[7]; }
            Af[ks] = pack8(xc);
            LAS float* xp = XT + r * 68 + 16 * ks + 8 * hh;
            *(LAS f32x4*)xp = (f32x4){xc[0], xc[1], xc[2], xc[3]}; *(LAS f32x4*)(xp + 4) = (f32x4){xc[4], xc[5], xc[6], xc[7]};
            asm volatile("" ::: "memory"); }
        LDS_WAIT(); asm volatile("" ::: "memory");
        const GAS float* wab = (const GAS float*)(wa + 8 * hh * 64 + r); const GAS float* wxb = (const GAS float*)(wx + 8 * hh * 64 + r);
        asm volatile("" : "+v"(wab), "+v"(wxb));
#pragma unroll
        for (int cb = 0; cb < 2; ++cb) { f32x16 da, dx;
#pragma unroll
            for (int i = 0; i < 16; ++i) { da[i] = 0.f; dx[i] = 0.f; }
#pragma unroll
            for (int ks = 0; ks < 4; ++ks) { float a[8], x[8];
#pragma unroll
                for (int j = 0; j < 8; ++j) { const int i = 16 * ks + j; a[j] = wab[i * 64 + cb * 32]; x[j] = wxb[i * 64 + cb * 32]; }
                da = MFMA32(Af[ks], pack8(a), da); dx = MFMA32(Af[ks], pack8(x), dx); asm volatile("" ::: "memory"); }
#pragma unroll
            for (int i = 0; i < 16; ++i) { const int tr = crow(i, hh), j = cb * 32 + r;
                const float rg = fsig(da[i] + ba[cb]), ig = fsig(dx[i] + bx[cb]);
                const float la = spl[cb] * rg, a = fexp(la), xcv = XT[tr * 68 + j];
                const float u = sqrtf(fmaxf(1.0f - a * a, 0.f)) * ig * xcv;
                AT[tr * 68 + j] = a; XT[tr * 68 + j] = u; } }
        LDS_WAIT(); asm volatile("" ::: "memory");
        { const int c = 64 * g + lane;
            if (!samp) { float h = 0.f, P = 1.f;
#pragma unroll 8
                for (int tr = 0; tr < 32; ++tr) { const float a = AT[tr * 68 + lane], u = XT[tr * 68 + lane]; h = a * h + u; P *= a;
                    RGH[(size_t)(R0 + tr) * 512 + c] = h; RGP[(size_t)(R0 + tr) * 512 + c] = P; } }
            else { float h = 0.f; const int b0 = (R0 - MP) >> 3;
#pragma unroll 8
                for (int tr = 0; tr < 32; ++tr) { const int bb = b0 + (tr >> 3);
                    if ((tr & 7) == 0) h = AR.in[I_SRH][(size_t)bb * 512 + c];
                    const float a = AT[tr * 68 + lane], u = XT[tr * 68 + lane]; h = a * h + u;
                    const float gr = bf2f(Z[(size_t)(R0 + tr) * ZW + ZGR + c]);
                    G[(size_t)(R0 + tr) * D + 512 + c] = (bf16)f2bf(h * gelu_tanh(gr));
                    if ((tr & 7) == 7) F.out[O_SRH + (size_t)bb * 512 + c] = h; } } }
        LDS_WAIT(); asm volatile("" ::: "memory");
    }
    { const int gt = F.vcu * NTHREADS + F.tid, NT = F.G * NTHREADS;
        for (int e = gt; e < NSEQ * 3 * 512; e += NT) { const int c = e & 511, j = (e >> 9) % 3, s = e / 1536;
            if (s < NPB) F.out[O_PRC + ((size_t)s * 3 + j) * 512 + c] = bf2f(Z[((size_t)s * PSEQ + PSEQ - 3 + j) * ZW + ZXR + c]);
            else { const int b = s - NPB; F.out[O_SRC + ((size_t)b * 3 + j) * 512 + c] = bf2f(Z[((size_t)MP + (size_t)b * SSEQ + SSEQ - 3 + j) * ZW + ZXR + c]); } } }
}

DI void ml2_scan(Frame& F, const Args& AR) {
    float* CST = (float*)(F.ws + WS_CST); float* NST = (float*)(F.ws + WS_NST); float* MST = (float*)(F.ws + WS_MST);
    for (int vb = F.vcu; vb < 256; vb += F.G) {
        const int bh = vb >> 3, e0 = ((vb & 7) * NTHREADS + F.tid) * 4;
        float m = 0.f; f32x4 C = (f32x4){0.f, 0.f, 0.f, 0.f};
        const bool nthr = (vb & 7) == 0 && F.tid < 128; float n = 0.f;
        for (int c = 0; c < 16; ++c) { const int item = bh * 16 + c; const float mloc = MST[item * 4 + 0], bL = MST[item * 4 + 1];
            float* cp = CST + (size_t)item * 16384 + e0; const f32x4 cl = *(const f32x4*)cp; *(f32x4*)cp = C;
            const float mn = fmaxf(bL + m, mloc), w0 = fexp(bL + m - mn), w1 = fexp(mloc - mn);
            C = C * w0 + cl * w1;
            if (nthr) { float* np = NST + item * 128 + F.tid; const float nl = *np; *np = n; n = n * w0 + nl * w1; if (F.tid == 0) MST[item * 4 + 2] = m; }
            m = mn; }
        *(f32x4*)(F.out + O_PMC + (size_t)bh * 16384 + e0) = C;
        if (nthr) { F.out[O_PMN + bh * 128 + F.tid] = n; if (F.tid == 0) F.out[O_PMM + bh] = m; }
    }
}
DI void rg2_carry(Frame& F, const Args& AR) {
    const float* RGH = (const float*)(F.ws + WS_RGH); const float* RGP = (const float*)(F.ws + WS_RGP); float* CARRY = (float*)(F.ws + WS_CARRY);
    const int gt = F.vcu * NTHREADS + F.tid, NT = F.G * NTHREADS;
    for (int e = gt; e < NPB * 512; e += NT) { const int b = e >> 9, c = e & 511; float H = 0.f;
        for (int k0 = 0; k0 < 64; k0 += 16) { float pe[16], he[16];
#pragma unroll
            for (int k = 0; k < 16; ++k) { const size_t row = (size_t)b * PSEQ + 32 * (k0 + k) + 31; pe[k] = RGP[row * 512 + c]; he[k] = RGH[row * 512 + c]; }
#pragma unroll
            for (int k = 0; k < 16; ++k) { CARRY[((size_t)b * 64 + k0 + k) * 512 + c] = H; H = pe[k] * H + he[k]; } }
        F.out[O_PRH + (size_t)b * 512 + c] = H; }
}
DI void rg2_apply(Frame& F, const Args& AR) {
    const bf16* Z = (const bf16*)(F.ws + WS_Z); bf16* G = (bf16*)(F.ws + WS_H);
    const float* RGH = (const float*)(F.ws + WS_RGH); const float* RGP = (const float*)(F.ws + WS_RGP); const float* CARRY = (const float*)(F.ws + WS_CARRY);
    const int gt = F.vcu * NTHREADS + F.tid, NT = F.G * NTHREADS;
    for (int e = gt; e < MP * 64; e += NT) { const int row = e >> 6, c0 = (e & 63) * 8, b = row >> 11, tile = (row & (PSEQ - 1)) >> 5;
        const v4u gq = *(const v4u*)(Z + (size_t)row * ZW + ZGR + c0);
        const float gr[8] = {bflo(gq.x), bfhi(gq.x), bflo(gq.y), bfhi(gq.y), bflo(gq.z), bfhi(gq.z), bflo(gq.w), bfhi(gq.w)};
        const float* hp = RGH + (size_t)row * 512 + c0; const float* pp = RGP + (size_t)row * 512 + c0; const float* cp = CARRY + ((size_t)b * 64 + tile) * 512 + c0;
        float o[8];
#pragma unroll
        for (int q = 0; q < 2; ++q) { const f32x4 h4 = *(const f32x4*)(hp + 4 * q), p4 = *(const f32x4*)(pp + 4 * q), c4 = *(const f32x4*)(cp + 4 * q);
            const f32x4 hv = h4 + p4 * c4; o[4 * q] = hv.x * gelu_tanh(gr[4 * q]); o[4 * q + 1] = hv.y * gelu_tanh(gr[4 * q + 1]); o[4 * q + 2] = hv.z * gelu_tanh(gr[4 * q + 2]); o[4 * q + 3] = hv.w * gelu_tanh(gr[4 * q + 3]); }
        v4u w; w.x = pk2(o[0], o[1]); w.y = pk2(o[2], o[3]); w.z = pk2(o[4], o[5]); w.w = pk2(o[6], o[7]);
        *(v4u*)(G + (size_t)row * D + 512 + c0) = w; }
}

DI void ml3_prompt(Frame& F, const Args& AR) {
    const bf16* Z = (const bf16*)(F.ws + WS_Z); bf16* G = (bf16*)(F.ws + WS_H);
    const float* CST = (const float*)(F.ws + WS_CST); const float* NST = (const float*)(F.ws + WS_NST); const float* MST = (const float*)(F.ws + WS_MST);
    LAS bf16* Qs = (LAS bf16*)F.lds;
    LAS bf16* Ks = (LAS bf16*)(F.lds + 34816);
    LAS bf16* Vs = (LAS bf16*)(F.lds + 69632);
    LAS float* LF = (LAS float*)(F.lds + 102400);
    LAS float* BC = LF + 128;
    LAS float* GS = BC + 128;
    LAS float* MX = GS + 128;
    LAS float* N0 = MX + 128;
    LAS float* RA = N0 + 128;
    LAS float* RB = RA + 256;
    LAS float* OT = (LAS float*)F.lds;
    const int tid = F.tid, lane = F.lane, wave = F.wave, r = lane & 31, hh = lane >> 5;
    const int tb = wave >> 1, vh = wave & 1, t = tb * 32 + r;
    for (int item = F.vcu; item < 512; item += F.G) {
        const int b = item >> 6, h = (item >> 4) & 3, c = item & 15; const size_t row0 = (size_t)b * PSEQ + c * 128;
        const float m0 = MST[item * 4 + 2]; const float* C0 = CST + (size_t)item * 16384;
#pragma unroll
        for (int i = 0; i < 4; ++i) { const int e = tid + i * NTHREADS, s = e >> 4, c8 = (e & 15) * 8; const bf16* zr = Z + (row0 + s) * ZW + h * 128 + c8;
            *(LAS v4u*)(Qs + s * 136 + c8) = *(const v4u*)(zr + ZQ); *(LAS v4u*)(Ks + s * 136 + c8) = *(const v4u*)(zr + ZK); *(LAS v4u*)(Vs + s * 128 + c8) = *(const v4u*)(zr + ZV); }
        if (tid < 128) { LF[tid] = log_sigmoid(bf2f(Z[(row0 + tid) * ZW + ZFG + h]) + AR.in[I_BG][4 + h]); N0[tid] = NST[item * 128 + tid]; }
        __syncthreads();
        if (tid < 128) { float bs = 0.f; for (int s = 0; s <= tid; ++s) bs += LF[s];
            BC[tid] = bs; GS[tid] = bf2f(Z[(row0 + tid) * ZW + ZIG + h]) + AR.in[I_BG][h] - bs; }
        __syncthreads();
        if (tid < 128) { float mx = m0; for (int s = 0; s <= tid; ++s) mx = fmaxf(mx, GS[s]); MX[tid] = mx; }
        __syncthreads();
        const float mxt = MX[t], winter = fexp(m0 - mxt);
        bf16x8 bq[8];
#pragma unroll
        for (int ks = 0; ks < 8; ++ks) bq[ks] = *(const LAS bf16x8*)(Qs + t * 136 + 16 * ks + 8 * hh);
        bf16x8 pp[4][2]; float den = 0.f;
#pragma unroll
        for (int sb = 0; sb < 4; ++sb) {
            if (sb <= tb) { f32x16 sa;
#pragma unroll
                for (int i = 0; i < 16; ++i) sa[i] = 0.f;
#pragma unroll
                for (int ks = 0; ks < 8; ++ks) sa = MFMA32(*(const LAS bf16x8*)(Ks + (sb * 32 + r) * 136 + 16 * ks + 8 * hh), bq[ks], sa);
                float pv[16];
#pragma unroll
                for (int i = 0; i < 16; ++i) { const int s = sb * 32 + crow(i, hh); float v = sa[i] * MSCALE * fexp(GS[s] - mxt); if (s > t) v = 0.f; pv[i] = v; den += v; }
                pp[sb][0] = mk_frag(pk2(pv[0], pv[1]), pk2(pv[2], pv[3]), pk2(pv[4], pv[5]), pk2(pv[6], pv[7]));
                pp[sb][1] = mk_frag(pk2(pv[8], pv[9]), pk2(pv[10], pv[11]), pk2(pv[12], pv[13]), pk2(pv[14], pv[15]));
            } else { pp[sb][0] = mk_frag(0u, 0u, 0u, 0u); pp[sb][1] = mk_frag(0u, 0u, 0u, 0u); } }
        den += __shfl_xor(den, 32);
        float qn = 0.f;
#pragma unroll 8
        for (int k = 0; k < 64; ++k) qn += N0[hh * 64 + k] * bf2f(Qs[t * 136 + hh * 64 + k]);
        qn += __shfl_xor(qn, 32);
        const float dtot = den + winter * qn, denom = fmaxf(fabsf(dtot), fexp(-(BC[t] + mxt))), rden = 1.0f / denom;
        float hv[2][16];
#pragma unroll
        for (int q = 0; q < 2; ++q) { const int vb = vh * 2 + q; f32x16 an, ai;
#pragma unroll
            for (int i = 0; i < 16; ++i) { an[i] = 0.f; ai[i] = 0.f; }
#pragma unroll
            for (int sb = 0; sb < 4; ++sb) if (sb <= tb) {
#pragma unroll
                for (int s2 = 0; s2 < 2; ++s2) { unsigned vw[8];
#pragma unroll
                    for (int j = 0; j < 8; ++j) vw[j] = Vs[(sb * 32 + 16 * s2 + 8 * (j >> 2) + 4 * hh + (j & 3)) * 128 + vb * 32 + r];
                    an = MFMA32(mk_frag(vw[0] | (vw[1] << 16), vw[2] | (vw[3] << 16), vw[4] | (vw[5] << 16), vw[6] | (vw[7] << 16)), pp[sb][s2], an); } }
#pragma unroll
            for (int ks = 0; ks < 8; ++ks) { const float* cp = C0 + (size_t)(vb * 32 + r) * 128 + 16 * ks + 8 * hh; const f32x4 c0 = *(const f32x4*)cp, c1 = *(const f32x4*)(cp + 4);
                ai = MFMA32(mk_frag(pk2(c0.x, c0.y), pk2(c0.z, c0.w), pk2(c1.x, c1.y), pk2(c1.z, c1.w)), bq[ks], ai); }
#pragma unroll
            for (int i = 0; i < 16; ++i) hv[q][i] = (an[i] + winter * ai[i]) * rden; }
        float s1 = 0.f;
#pragma unroll
        for (int q = 0; q < 2; ++q)
#pragma unroll
            for (int i = 0; i < 16; ++i) s1 += hv[q][i];
        s1 += __shfl_xor(s1, 32);
        if (hh == 0) RA[vh * 128 + t] = s1;
        __syncthreads();
        const float mean = (RA[t] + RA[128 + t]) * (1.f / 128.f); float s2 = 0.f;
#pragma unroll
        for (int q = 0; q < 2; ++q)
#pragma unroll
            for (int i = 0; i < 16; ++i) { hv[q][i] -= mean; s2 += hv[q][i] * hv[q][i]; }
        s2 += __shfl_xor(s2, 32);
        if (hh == 0) RB[vh * 128 + t] = s2;
        __syncthreads();
        const float rstd = 1.f / sqrtf((RB[t] + RB[128 + t]) * (1.f / 128.f) + HEAD_EPS);
#pragma unroll
        for (int q = 0; q < 2; ++q)
#pragma unroll
            for (int i = 0; i < 16; ++i) OT[t * 132 + (vh * 2 + q) * 32 + crow(i, hh)] = hv[q][i] * rstd;
        __syncthreads();
        { const int tt = tid >> 2, v0 = (tid & 3) * 32; const size_t row = row0 + tt;
#pragma unroll
            for (int q = 0; q < 4; ++q) { const int v = v0 + 8 * q; const v4u oq = *(const v4u*)(Z + row * ZW + ZO + h * 128 + v);
                const float og[8] = {bflo(oq.x), bfhi(oq.x), bflo(oq.y), bfhi(oq.y), bflo(oq.z), bfhi(oq.z), bflo(oq.w), bfhi(oq.w)};
                const f32x4 g0 = *(const f32x4*)(AR.in[I_MNG] + h * 128 + v), g1 = *(const f32x4*)(AR.in[I_MNG] + h * 128 + v + 4);
                const f32x4 x0 = *(const LAS f32x4*)(OT + tt * 132 + v), x1 = *(const LAS f32x4*)(OT + tt * 132 + v + 4);
                v4u w; w.x = pk2(x0.x * g0.x * fsig(og[0]), x0.y * g0.y * fsig(og[1])); w.y = pk2(x0.z * g0.z * fsig(og[2]), x0.w * g0.w * fsig(og[3]));
                w.z = pk2(x1.x * g1.x * fsig(og[4]), x1.y * g1.y * fsig(og[5])); w.w = pk2(x1.z * g1.z * fsig(og[6]), x1.w * g1.w * fsig(og[7]));
                *(v4u*)(G + row * D + h * 128 + v) = w; } }
        __syncthreads();
    }
}

constexpr int TC = 32;
constexpr int RW_ARR = TC * 64;
constexpr int RW_BUF_FLOATS = 6 * RW_ARR + 2 * TC;
template <int CTRL> DI float dpp_add(float x) {
    const int xi = __builtin_bit_cast(int, x);
    const int yi = __builtin_amdgcn_update_dpp(xi, xi, CTRL, 0xF, 0xF, false);
    return x + __builtin_bit_cast(float, yi);
}
DI float sum8(float x) { x = dpp_add<0xB1>(x); x = dpp_add<0x4E>(x); x = dpp_add<0x141>(x); return x; }
DI float sum16(float x) { x = sum8(x); x = dpp_add<0x140>(x); return x; }
struct RwRaw { v2u r, k, v, w, a, g; };
DI void rw_load(RwRaw& x, const bf16* RK, const bf16* WAG, size_t row, size_t row_safe, int h, int k4, bool valid) {
    const size_t rr = valid ? row : row_safe;
    const bf16* p = RK + rr * RKW + h * 64 + k4; const bf16* q = WAG + rr * WAGW + h * 64 + k4;
    x.r = *(const v2u*)p; x.k = *(const v2u*)(p + 1024); x.v = *(const v2u*)(p + 2048); x.w = *(const v2u*)q; x.a = *(const v2u*)(q + 1024); x.g = *(const v2u*)(q + 2048);
}
DI void un4(const v2u u, float (&f)[4]) { f[0] = bflo(u.x); f[1] = bfhi(u.x); f[2] = bflo(u.y); f[3] = bfhi(u.y); }
DI float rw_prep(const RwRaw& x, LAS float* buf, int tok, int k4, const float (&kkw)[4], const float (&kaw)[4], const float (&rkw)[4]) {
    float r[4], k[4], v[4], w[4], a[4]; un4(x.r, r); un4(x.k, k); un4(x.v, v); un4(x.w, w); un4(x.a, a);
    float kk[4], ss = 0.f, bs = 0.f, km[4];
#pragma unroll
    for (int j = 0; j < 4; ++j) { kk[j] = k[j] * kkw[j]; ss += kk[j] * kk[j]; km[j] = k[j] * (1.0f + (a[j] - 1.0f) * kaw[j]); bs += r[j] * km[j] * rkw[j]; }
    ss = sum16(ss); bs = sum16(bs);
    const float inv = 1.0f / fmaxf(sqrtf(ss), 1e-12f);
    f32x4 o0, o1, o2, o3, o4, o5; float br = 0.f, kr = 0.f;
#pragma unroll
    for (int j = 0; j < 4; ++j) { const float kn = kk[j] * inv, dc = __builtin_amdgcn_exp2f(w[j]); o0[j] = kn; o1[j] = kn * a[j]; o2[j] = km[j]; o3[j] = dc; o4[j] = dc * r[j]; o5[j] = v[j];
        br += kn * a[j] * r[j]; kr += km[j] * r[j]; }
    br = sum16(br); kr = sum16(kr);
    LAS float* p = buf + tok * 64 + k4;
    *(LAS f32x4*)p = o0; *(LAS f32x4*)(p + RW_ARR) = o1; *(LAS f32x4*)(p + 2 * RW_ARR) = o2; *(LAS f32x4*)(p + 3 * RW_ARR) = o3;
    *(LAS f32x4*)(p + 4 * RW_ARR) = o4; *(LAS f32x4*)(p + 5 * RW_ARR) = o5;
    if (k4 == 0) *(LAS f32x2*)(buf + 6 * RW_ARR + 2 * tok) = (f32x2){br, kr};
    return bs;
}
DI void rw_post(const LAS float* YB, int tok, int k4, float bn, const v2u vraw, const v2u graw, const float (&lg)[4], const float (&lb)[4], bf16* gout) {
    const f32x4 y4 = *(const LAS f32x4*)(YB + tok * 64 + k4);
    const float s = sum16((y4.x + y4.y) + (y4.z + y4.w));
    const float mean = s * (1.f / 64.f); const f32x4 d = y4 - mean;
    const float s2 = sum16((d.x * d.x + d.y * d.y) + (d.z * d.z + d.w * d.w));
    const float rstd = 1.f / sqrtf(s2 * (1.f / 64.f) + RW_EPS);
    float v[4], g[4]; un4(vraw, v); un4(graw, g);
    const float o0 = (d.x * rstd * lg[0] + lb[0] + bn * v[0]) * g[0], o1 = (d.y * rstd * lg[1] + lb[1] + bn * v[1]) * g[1];
    const float o2 = (d.z * rstd * lg[2] + lb[2] + bn * v[2]) * g[2], o3 = (d.w * rstd * lg[3] + lb[3] + bn * v[3]) * g[3];
    v2u w; w.x = pk2(o0, o1); w.y = pk2(o2, o3);
    *(v2u*)gout = w;
}
struct StepV { f32x4 ka, kb, ba, bb, ma, mb, da, db, ea, eb; f32x2 vv, sc; };
DI void ld_step(StepV& s, const LAS float* cur, int tk, int p, int rp) {
    const LAS float* q = cur + tk * 64 + 8 * p;
    s.ka = *(const LAS f32x4*)q; s.kb = *(const LAS f32x4*)(q + 4); s.ba = *(const LAS f32x4*)(q + RW_ARR); s.bb = *(const LAS f32x4*)(q + RW_ARR + 4);
    s.ma = *(const LAS f32x4*)(q + 2 * RW_ARR); s.mb = *(const LAS f32x4*)(q + 2 * RW_ARR + 4); s.da = *(const LAS f32x4*)(q + 3 * RW_ARR); s.db = *(const LAS f32x4*)(q + 3 * RW_ARR + 4);
    s.ea = *(const LAS f32x4*)(q + 4 * RW_ARR); s.eb = *(const LAS f32x4*)(q + 4 * RW_ARR + 4);
    s.vv = *(const LAS f32x2*)(cur + 5 * RW_ARR + tk * 64 + 2 * rp); s.sc = *(const LAS f32x2*)(cur + 6 * RW_ARR + 2 * tk);
}
DI void sum8x4(float& a, float& b, float& c, float& d) {
    asm volatile("s_nop 1\n\t"
                 "v_add_f32_dpp %0, %0, %0 quad_perm:[1,0,3,2] row_mask:0xf bank_mask:0xf\n\tv_add_f32_dpp %1, %1, %1 quad_perm:[1,0,3,2] row_mask:0xf bank_mask:0xf\n\t"
                 "v_add_f32_dpp %2, %2, %2 quad_perm:[1,0,3,2] row_mask:0xf bank_mask:0xf\n\tv_add_f32_dpp %3, %3, %3 quad_perm:[1,0,3,2] row_mask:0xf bank_mask:0xf\n\t"
                 "v_add_f32_dpp %0, %0, %0 quad_perm:[2,3,0,1] row_mask:0xf bank_mask:0xf\n\tv_add_f32_dpp %1, %1, %1 quad_perm:[2,3,0,1] row_mask:0xf bank_mask:0xf\n\t"
                 "v_add_f32_dpp %2, %2, %2 quad_perm:[2,3,0,1] row_mask:0xf bank_mask:0xf\n\tv_add_f32_dpp %3, %3, %3 quad_perm:[2,3,0,1] row_mask:0xf bank_mask:0xf\n\t"
                 "v_add_f32_dpp %0, %0, %0 row_half_mirror row_mask:0xf bank_mask:0xf\n\tv_add_f32_dpp %1, %1, %1 row_half_mirror row_mask:0xf bank_mask:0xf\n\t"
                 "v_add_f32_dpp %2, %2, %2 row_half_mirror row_mask:0xf bank_mask:0xf\n\tv_add_f32_dpp %3, %3, %3 row_half_mirror row_mask:0xf bank_mask:0xf\n\ts_nop 0"
                 : "+v"(a), "+v"(b), "+v"(c), "+v"(d));
}
DI void rw_seq(Frame& F, const Args& AR, size_t row0, int len, int h, const float* S0, float* Sout) {
    const bf16* RK = (const bf16*)(F.ws + WS_RK); const bf16* WAG = (const bf16*)(F.ws + WS_WAG); bf16* G = (bf16*)(F.ws + WS_H);
    LAS float* BUF = (LAS float*)F.lds;
    LAS float* YB = BUF + 2 * RW_BUF_FLOATS;
    const int tid = F.tid; const bool scan = tid < 256;
    const int nch = (len + TC - 1) / TC;
    if (scan) {
        const int rp = tid >> 3, p = tid & 7;
        f32x4 Sa[2], Sb[2];
#pragma unroll
        for (int i = 0; i < 2; ++i) {
            if (S0) { Sa[i] = *(const f32x4*)(S0 + (2 * rp + i) * 64 + 8 * p); Sb[i] = *(const f32x4*)(S0 + (2 * rp + i) * 64 + 8 * p + 4); }
            else { Sa[i] = (f32x4){0.f, 0.f, 0.f, 0.f}; Sb[i] = Sa[i]; } }
        __syncthreads();
        for (int ch = 0; ch < nch; ++ch) {
            const LAS float* cur = BUF + (ch & 1) * RW_BUF_FLOATS; LAS float* yb = YB + (ch & 1) * RW_ARR;
            const int base = ch * TC, nt = (len - base) < TC ? (len - base) : TC;
            StepV nx; ld_step(nx, cur, 0, p, rp);
#pragma unroll 2
            for (int tk = 0; tk < nt; ++tk) {
                const StepV c = nx; ld_step(nx, cur, tk + 1 < nt ? tk + 1 : tk, p, rp);
                const f32x4 t0 = Sa[0] * c.ka + Sb[0] * c.kb, t1 = Sa[1] * c.ka + Sb[1] * c.kb, u0 = Sa[0] * c.ea + Sb[0] * c.eb, u1 = Sa[1] * c.ea + Sb[1] * c.eb;
                float r0 = (t0.x + t0.y) + (t0.z + t0.w), r1 = (t1.x + t1.y) + (t1.z + t1.w), r2 = (u0.x + u0.y) + (u0.z + u0.w), r3 = (u1.x + u1.y) + (u1.z + u1.w);
                sum8x4(r0, r1, r2, r3);
                const float sa0 = -r0, sa1 = -r1;
                Sa[0] = Sa[0] * c.da + c.ma * c.vv.x + c.ba * sa0; Sb[0] = Sb[0] * c.db + c.mb * c.vv.x + c.bb * sa0;
                Sa[1] = Sa[1] * c.da + c.ma * c.vv.y + c.ba * sa1; Sb[1] = Sb[1] * c.db + c.mb * c.vv.y + c.bb * sa1;
                if (p == 0) *(LAS f32x2*)(yb + tk * 64 + 2 * rp) = (f32x2){r2 + sa0 * c.sc.x + c.vv.x * c.sc.y, r3 + sa1 * c.sc.x + c.vv.y * c.sc.y};
            }
            __syncthreads();
        }
#pragma unroll
        for (int i = 0; i < 2; ++i) { *(f32x4*)(Sout + (2 * rp + i) * 64 + 8 * p) = Sa[i]; *(f32x4*)(Sout + (2 * rp + i) * 64 + 8 * p + 4) = Sb[i]; }
        __syncthreads();
    } else {
        const int ht = tid - 256, tk0 = ht >> 4, k4 = (ht & 15) * 4;
        float kkw[4], kaw[4], rkw[4], lg[4], lb[4];
#pragma unroll
        for (int j = 0; j < 4; ++j) { const int c = h * 64 + k4 + j; kkw[j] = AR.in[I_KK][c]; kaw[j] = AR.in[I_KA][c]; rkw[j] = AR.in[I_RK][c]; lg[j] = AR.in[I_LXG][c]; lb[j] = AR.in[I_LXB][c]; }
        RwRaw raw[2];
        v2u vP[2], gP[2], vC[2], gC[2]; float bnP[2], bnC[2];
#pragma unroll
        for (int i = 0; i < 2; ++i) { rw_load(raw[i], RK, WAG, row0 + tk0 + 16 * i, row0, h, k4, tk0 + 16 * i < len);
            bnC[i] = rw_prep(raw[i], BUF, tk0 + 16 * i, k4, kkw, kaw, rkw); vC[i] = raw[i].v; gC[i] = raw[i].g; vP[i] = vC[i]; gP[i] = gC[i]; bnP[i] = 0.f; }
#pragma unroll
        for (int i = 0; i < 2; ++i) rw_load(raw[i], RK, WAG, row0 + TC + tk0 + 16 * i, row0, h, k4, TC + tk0 + 16 * i < len);
        __syncthreads();
        for (int ch = 0; ch < nch; ++ch) {
            const int base = ch * TC;
            if (ch > 0) {
#pragma unroll
                for (int i = 0; i < 2; ++i) { const int tok = tk0 + 16 * i;
                    rw_post(YB + ((ch - 1) & 1) * RW_ARR, tok, k4, bnP[i], vP[i], gP[i], lg, lb, G + (row0 + base - TC + tok) * D + h * 64 + k4); } }
#pragma unroll
            for (int i = 0; i < 2; ++i) { vP[i] = vC[i]; gP[i] = gC[i]; bnP[i] = bnC[i]; }
            if (ch + 1 < nch) {
#pragma unroll
                for (int i = 0; i < 2; ++i) { bnC[i] = rw_prep(raw[i], BUF + ((ch + 1) & 1) * RW_BUF_FLOATS, tk0 + 16 * i, k4, kkw, kaw, rkw); vC[i] = raw[i].v; gC[i] = raw[i].g; }
#pragma unroll
                for (int i = 0; i < 2; ++i) rw_load(raw[i], RK, WAG, row0 + base + 2 * TC + tk0 + 16 * i, row0, h, k4, base + 2 * TC + tk0 + 16 * i < len);
            }
            __syncthreads();
        }
        { const int base = nch * TC;
#pragma unroll
            for (int i = 0; i < 2; ++i) { const int tok = tk0 + 16 * i;
                if (base - TC + tok < len) rw_post(YB + ((nch - 1) & 1) * RW_ARR, tok, k4, bnP[i], vP[i], gP[i], lg, lb, G + (row0 + base - TC + tok) * D + h * 64 + k4); } }
        __syncthreads();
    }
}
DI void rwkv_scan(Frame& F, const Args& AR) {
    const int G = F.G, np = G >= 256 ? 128 : (G / 2 > 0 ? G / 2 : 1);
#ifndef PROBE_RW
#define PROBE_RW 0
#endif
    if (F.vcu < np) {
        for (int rep = 0; rep < (PROBE_RW == 1 ? 2 : 1); ++rep)
        for (int item = F.vcu; item < NPB * 16; item += np) { const int b = item >> 4, h = item & 15;
            rw_seq(F, AR, (size_t)b * PSEQ, PSEQ, h, nullptr, F.out + O_PWKV + (size_t)item * 4096); }
    }
    const int ns = G - np > 0 ? G - np : G, s0 = G - np > 0 ? F.vcu - np : F.vcu;
    if (G - np <= 0 || F.vcu >= np) {
        for (int rep = 0; rep < (PROBE_RW == 2 ? 2 : 1); ++rep)
        for (int item = s0; item < NSB * 16; item += ns) { const int b = item >> 4, h = item & 15;
            rw_seq(F, AR, (size_t)MP + (size_t)b * SSEQ, SSEQ, h, AR.in[I_SWKV] + (size_t)item * 4096, F.out + O_SWKV + (size_t)item * 4096); }
    }
}

#ifndef MK_N_LAUNCHES
#define MK_N_LAUNCHES 1
#endif
#ifdef PROBE_DUP_PH
constexpr int NPHASES = 27;
#else
constexpr int NPHASES = 26;
#endif
enum { K_P0 = 0, K_MODX, K_UP, K_RESID, K_LN, K_WIN, K_MIXA, K_MIXB, K_MIXC, K_R1, K_R2, K_R3, K_MOD };

__global__ void __launch_bounds__(NTHREADS, 2) mega_fwd(Args AR) {
    extern __shared__ __attribute__((aligned(16))) unsigned char lds[];
    Frame F;
    F.lds = (LAS unsigned char*)lds;
    F.MISC = (volatile LAS unsigned*)(F.lds + MISC_OFF);
    F.tid = threadIdx.x; F.lane = F.tid & 63; F.wave = __builtin_amdgcn_readfirstlane(F.tid >> 6);
    F.G = gridDim.x; { const int bx = blockIdx.x; F.vcu = (F.G % 8 == 0) ? (bx % 8) * (F.G / 8) + bx / 8 : bx; }
    F.ws = AR.ws; F.out = AR.out; F.ctl = (gu32*)(AR.ws + WS_CTL);
    for (int u = F.tid; u < (LDS_BYTES - LDSCTL_OFF) / 4; u += NTHREADS) ((LAS unsigned*)(F.lds + LDSCTL_OFF))[u] = 0u;
    __syncthreads();
    const int lo = AR.ph_lo, hi = AR.ph_hi;
    XcdBarrier bar; bar.bar = (unsigned*)(F.ctl + CW_BAR); bar.x = 0; bar.st = nullptr;
    if (hi - lo > 1) bar = xcd_barrier_post((unsigned*)(F.ctl + CW_BAR), F.MISC + 8);

#ifndef PROBE_DUP_PH
#define PROBE_DUP_PH 1000
#endif
    for (int phs = lo; phs < hi; ++phs) {
        const int ph = phs > PROBE_DUP_PH ? phs - 1 : phs; const bool dupfirst = (phs == PROBE_DUP_PH);
        float* X = F.out + O_Y; const float* mod = (const float*)(F.ws + WS_MOD); bf16* H = (bf16*)(F.ws + WS_H);
        int kind = K_LN, f = 0, l = 0, sub = 0, js = 0, first = 0, mode = 0, lm = 0, which = 0;
        switch (ph == 0 ? 0 : (ph == 1 ? 100 : ph - 1)) {
            case 0: kind = K_P0; break;
            case 100: kind = K_MOD; break;
            case 1: kind = K_MODX; break;
            case 2: kind = K_UP; f = 0; break;
            case 3: kind = K_RESID; which = 0; f = 0; l = 0; js = 0; first = 1; break;
            case 4: kind = K_LN; l = 0; sub = 0; lm = 0; js = 3; mode = 0; break;
            case 5: kind = K_WIN; break;
            case 6: kind = K_MIXA; break;
            case 7: kind = K_MIXB; break;
            case 8: kind = K_MIXC; break;
            case 9: kind = K_RESID; which = 1; l = 0; js = 3; break;
            case 10: kind = K_LN; l = 0; sub = 1; lm = 0; js = 6; mode = 0; break;
            case 11: kind = K_UP; f = 1; break;
            case 12: kind = K_RESID; which = 0; f = 1; l = 0; js = 6; break;
            case 13: kind = K_LN; l = 0; sub = 2; lm = 1; js = 0; mode = 0; break;
            case 14: kind = K_UP; f = 2; break;
            case 15: kind = K_RESID; which = 0; f = 2; l = 1; js = 0; break;
            case 16: kind = K_LN; l = 1; sub = 0; lm = 1; js = 3; mode = 1; break;
            case 17: kind = K_R1; break;
            case 18: kind = K_R2; break;
            case 19: kind = K_R3; break;
            case 20: kind = K_RESID; which = 2; l = 1; js = 3; break;
            case 21: kind = K_LN; l = 1; sub = 1; lm = 1; js = 6; mode = 0; break;
            case 22: kind = K_UP; f = 3; break;
            case 23: kind = K_RESID; which = 0; f = 3; l = 1; js = 6; break;
            default: kind = K_LN; l = 1; sub = 2; lm = 1; js = 0; mode = 2; break;
        }
#ifndef PHMASK
#define PHMASK 0xFFFFF
#endif
        { int t_ = F.tid; asm volatile("" : "+v"(t_)); F.tid = t_; F.lane = t_ & 63; F.wave = __builtin_amdgcn_readfirstlane(t_ >> 6);

          int v_ = F.vcu; asm volatile("" : "+s"(v_)); F.vcu = v_; int g_ = F.G; asm volatile("" : "+s"(g_)); F.G = g_;
          unsigned l_ = (unsigned)(size_t)F.lds; asm volatile("" : "+s"(l_)); F.lds = (LAS unsigned char*)(size_t)l_; }
        switch (kind) {
            case K_P0: p0_sctab(F, AR); p0_weights(F, AR); break;
            case K_MOD: p0_mod(F, AR); break;
            case K_MODX: if ((PHMASK >> K_MODX) & 1) ln_pass(F, AR, 1, 0, 0, 0, 0, 0, 0, 0, 0); break;
            case K_UP: if ((PHMASK >> K_UP) & 1) {
                pg8::Gemm g{H, (const bf16*)(F.ws + WS_W13) + (size_t)f * 5632 * 1024, M, 5632, 1024}; pg8::StaticOrder S; S.init(M, 5632, F.G, (int)blockIdx.x); S.ntk = 16;
                pg8::EpiSwiglu E{(bf16*)(F.ws + WS_HID), FF};
                pg8::gemm_phase<pg8::EpiSwiglu, pg8::StaticOrder, true, true>(F.lds, g, S, E, F.tid);
            } break;
            case K_RESID: if ((PHMASK >> K_RESID) & 1) {
                const bf16* A = which == 0 ? (const bf16*)(F.ws + WS_HID) : H; const int K = which == 0 ? FF : 1024;
                const bf16* Bt = which == 0 ? (const bf16*)(F.ws + WS_W2) + (size_t)f * 1024 * FF : (which == 1 ? (const bf16*)(F.ws + WS_WOUT) : (const bf16*)(F.ws + WS_WO));
                const int nsp = (F.G == 256) ? (which == 0 ? 11 : 4) : 0;
                pg8::Gemm g{A, Bt, M, 1024, K}; SplitOrder S; S.base.init(nsp ? MP : M, 1024, F.G, (int)blockIdx.x); S.base.ntk = K / 64; S.S = nsp;
                EpiResid E{AR, F.out, F.ws, (first ? 1 : 0) | (l << 1) | ((js + 2) << 2) | (which == 0 ? 0 : 64) | (dupfirst ? 128 : 0)};
                pg8::gemm_phase<EpiResid, SplitOrder, true, true>(F.lds, g, S, E, F.tid);
            } break;
            case K_LN: if ((PHMASK >> K_LN) & 1) ln_pass(F, AR, 0, 1, l, sub, lm, js, mode, (F.G == 256) ? (sub == 1 ? 4 : 11) : 0, ph == 5); break;
            case K_WIN: if ((PHMASK >> K_WIN) & 1) {
                pg8::Gemm g{H, (const bf16*)(F.ws + WS_WIN), M, ZW, 1024}; pg8::StaticOrder S; S.init(M, ZW, F.G, (int)blockIdx.x); S.ntk = 16;
                pg8::EpiStore E{(bf16*)(F.ws + WS_Z), ZW, 1000, nullptr, 0};
                pg8::gemm_phase<pg8::EpiStore, pg8::StaticOrder, true, true>(F.lds, g, S, E, F.tid);
            } break;
            case K_R1: if ((PHMASK >> K_R1) & 1) {
                pg8::Gemm g{(const bf16*)(F.ws + WS_A2), (const bf16*)(F.ws + WS_WRK), M, 3328, 2048}; pg8::StaticOrder S; S.init(M, 3328, F.G, (int)blockIdx.x); S.ntk = 32;
                pg8::EpiStore E{(bf16*)(F.ws + WS_RK), RKW, 12, (bf16*)(F.ws + WS_A3), 256};
                pg8::gemm_phase<pg8::EpiStore, pg8::StaticOrder, true, true>(F.lds, g, S, E, F.tid);
            } break;
            case K_R2: if ((PHMASK >> K_R2) & 1) {
                pg8::Gemm g{(const bf16*)(F.ws + WS_A3), (const bf16*)(F.ws + WS_WL2), M, 3072, 256}; pg8::StaticOrder S; S.init(M, 3072, F.G, (int)blockIdx.x); S.ntk = 4;
                pg8::EpiLora2 E{(bf16*)(F.ws + WS_WAG), WAGW, AR.in[I_W0], AR.in[I_A0]};
                pg8::gemm_phase<pg8::EpiLora2, pg8::StaticOrder, true, true>(F.lds, g, S, E, F.tid);
            } break;
            case K_MIXA: if ((PHMASK >> K_MIXA) & 1) ml1_prompt(F, AR); __syncthreads(); if ((PHMASK >> 13) & 1) ml_sample(F, AR); __syncthreads(); if ((PHMASK >> 14) & 1) rg1(F, AR); break;
            case K_MIXB: if ((PHMASK >> K_MIXB) & 1) ml2_scan(F, AR); if ((PHMASK >> 15) & 1) rg2_carry(F, AR); break;
            case K_MIXC: if ((PHMASK >> K_MIXC) & 1) ml3_prompt(F, AR); __syncthreads(); if ((PHMASK >> 16) & 1) rg2_apply(F, AR); break;
            case K_R3: if ((PHMASK >> K_R3) & 1) rwkv_scan(F, AR); break;
        }
        if (phs + 1 < hi) xcd_barrier(bar);
    }
}

extern "C" void kernel_launch(void* const* d_in, const int* in_sizes, int n_in, void* d_out, int out_size, void* d_ws, size_t ws_size, hipStream_t stream) {
    static int grid = 0;
    if (grid == 0) {
        if (n_in != 47 || out_size != (int)O_END || ws_size < WS_END) { fprintf(stderr, "kernel_launch: unexpected sizes n_in %d out %d ws %zu\n", n_in, out_size, ws_size); grid = -1; return; }
        int dev = 0, cus = 0, per_cu = 0;
        if (hipGetDevice(&dev) != hipSuccess || hipDeviceGetAttribute(&cus, hipDeviceAttributeMultiprocessorCount, dev) != hipSuccess) { grid = -1; return; }
        if (hipFuncSetAttribute((const void*)mega_fwd, hipFuncAttributeMaxDynamicSharedMemorySize, LDS_BYTES) != hipSuccess) { fprintf(stderr, "kernel_launch: hipFuncSetAttribute failed\n"); grid = -1; return; }
        if (hipOccupancyMaxActiveBlocksPerMultiprocessor(&per_cu, (const void*)mega_fwd, NTHREADS, LDS_BYTES) != hipSuccess || per_cu < 1) { fprintf(stderr, "kernel_launch: occupancy query says %d blocks per CU\n", per_cu); (void)hipGetLastError(); grid = -1; return; }
        grid = cus;
    }
    if (grid < 0) return;
    (void)hipMemsetAsync((char*)d_ws + WS_CTL, 0, CTL_ZERO_BYTES, stream);
    Args a{};
    for (int i = 0; i < 47; ++i) a.in[i] = (const float*)d_in[i];
    a.out = (float*)d_out; a.ws = (unsigned char*)d_ws;
#if MK_N_LAUNCHES == 1
    a.ph_lo = 0; a.ph_hi = NPHASES;
    hipLaunchKernelGGL(mega_fwd, dim3(grid), dim3(NTHREADS), LDS_BYTES, stream, a);
#else
    for (int p = 0; p < NPHASES; ++p) { a.ph_lo = p; a.ph_hi = p + 1; hipLaunchKernelGGL(mega_fwd, dim3(grid), dim3(NTHREADS), LDS_BYTES, stream, a); }
#endif
}
```

```cpp
#include <hip/hip_runtime.h>
#include <cstdio>
#include <cstdint>
#include <cmath>
namespace pg8 {
#define PG8_LAS __attribute__((address_space(3)))
typedef unsigned short bf16_t;
typedef short bf16x8 __attribute__((ext_vector_type(8)));
typedef float f32x4 __attribute__((ext_vector_type(4)));
typedef unsigned u32x4 __attribute__((ext_vector_type(4)));
constexpr int BM = 256, BK = 64, HALF = 128, HTB = HALF * BK * 2  , STAGE_BYTES = 8 * HTB, NXCD = 8, WGM = 8;

__host__ __device__ __forceinline__ int lds_byte(int r, int c) { const int st = (r >> 4) * 2 + (c >> 5), rr = r & 15, cc = c & 31, ob = rr * 64 + cc * 2; return st * 1024 + (ob ^ (((ob >> 9) & 1) << 5)); }
__host__ __device__ __forceinline__ void stage_rc(int b, int& R, int& C) { const int st = b / 1024, sb = b % 1024, swz = sb ^ (((sb >> 9) & 1) << 5); R = (st >> 1) * 16 + swz / 64; C = (st & 1) * 32 + (swz % 64) / 2; }
__host__ __device__ __forceinline__ int perm32(int rho) { const int n = rho >> 4, i = rho & 15; return 8 * (i >> 2) + 4 * n + (i & 3); }

struct Unit { int pm, pn, k0, nt, sub; };
struct Gemm { const bf16_t* A; const bf16_t* Bt; int M, N, K; };

struct StaticOrder {
    int nM, nN, nwg, G, c, ntk;
    __host__ __device__ void init(int M, int N, int G_, int c_) { nM = M / BM; nN = N / BM; nwg = nM * nN; G = G_; c = c_; }
    __host__ __device__ bool next(int i, Unit& u) const {
        const long L = (long)i * G + c; if (L >= nwg) return false;
        int wgid = (int)L; { const int q = nwg / NXCD, r = nwg % NXCD, xcd = wgid % NXCD, off = wgid / NXCD; wgid = (xcd < r ? xcd * (q + 1) : r * (q + 1) + (xcd - r) * q) + off; }
        const int nig = WGM * nN, gid = wgid / nig, fm = gid * WGM, gsz = (nM - fm) < WGM ? (nM - fm) : WGM;
        u.pm = fm + ((wgid % nig) % gsz); u.pn = (wgid % nig) / gsz; u.k0 = 0; u.nt = ntk; u.sub = 0; return true;
    }
    __device__ __forceinline__ void a_ready(const Unit&) const {}
    __device__ __forceinline__ void done(const Unit&) const {}
};

__device__ __forceinline__ unsigned cvt_pk_bf16(float lo, float hi) { unsigned r; asm volatile("v_cvt_pk_bf16_f32 %0, %1, %2" : "=v"(r) : "v"(lo), "v"(hi)); return r; }
typedef float f32x2 __attribute__((ext_vector_type(2)));
constexpr int MPROWS = 16384;
__device__ __forceinline__ int mod_row(int r) { return r < MPROWS ? (r >> 11) : 8 + ((r - MPROWS) >> 3); }
__device__ __forceinline__ float fsig(float x) { return __builtin_amdgcn_rcpf(1.0f + __builtin_amdgcn_exp2f(-1.44269504f * x)); }
__device__ __forceinline__ float ftanh(float x) { return 1.0f - 2.0f * __builtin_amdgcn_rcpf(1.0f + __builtin_amdgcn_exp2f(2.88539008f * x)); }

struct EpiSwiglu {
    static constexpr bool PERM = true, AFTER_DRAIN = false;
    bf16_t* O; int ldc;
    __device__ __forceinline__ void operator()(const f32x4 (&acc)[2][2][4][2], const Unit& u, int wr, int wc, int fr, int fq) const {
        const int row0 = u.pm * BM + wr * 64 + fr, col0 = u.pn * HALF + wc * 32 + 8 * fq;
#pragma unroll
        for (int ai = 0; ai < 2; ++ai)
#pragma unroll
            for (int m = 0; m < 4; ++m) { bf16_t* rowp = O + (size_t)(row0 + ai * HALF + m * 16) * ldc + col0;
                const f32x4 a0 = acc[ai][0][m][0], a1 = acc[ai][0][m][1], b0 = acc[ai][1][m][0], b1 = acc[ai][1][m][1];
                f32x4 v0, v1;
#pragma unroll
                for (int j = 0; j < 4; ++j) { v0[j] = a0[j] * fsig(a0[j]) * b0[j]; v1[j] = a1[j] * fsig(a1[j]) * b1[j]; }
                u32x4 w; w.x = cvt_pk_bf16(v0[0], v0[1]); w.y = cvt_pk_bf16(v0[2], v0[3]); w.z = cvt_pk_bf16(v1[0], v1[1]); w.w = cvt_pk_bf16(v1[2], v1[3]);
                *(u32x4*)rowp = w; asm volatile("" ::: "memory"); }
    }
};
struct EpiStore {
    static constexpr bool PERM = true, AFTER_DRAIN = false;
    bf16_t* O; int ldc; int ntile_main; bf16_t* O2; int ldc2;
    __device__ __forceinline__ void operator()(const f32x4 (&acc)[2][2][4][2], const Unit& u, int wr, int wc, int fr, int fq) const {
        const int row0 = u.pm * BM + wr * 64 + fr;
        const bool main = u.pn < ntile_main;
        bf16_t* base = main ? O + (size_t)u.pn * BM : O2; const int ld = main ? ldc : ldc2;
        const int col0 = wc * 32 + 8 * fq;
#pragma unroll
        for (int ai = 0; ai < 2; ++ai)
#pragma unroll
            for (int m = 0; m < 4; ++m) { bf16_t* rowp = base + (size_t)(row0 + ai * HALF + m * 16) * ld + col0;
#pragma unroll
                for (int bj = 0; bj < 2; ++bj) { f32x4 v0 = acc[ai][bj][m][0], v1 = acc[ai][bj][m][1];
                    if (!main) {
                        if (bj == 1) {
#pragma unroll
                            for (int j = 0; j < 4; ++j) { v0[j] = fsig(v0[j]); v1[j] = fsig(v1[j]); }
                        } else if (wc < 2) {
#pragma unroll
                            for (int j = 0; j < 4; ++j) { v0[j] = ftanh(v0[j]); v1[j] = ftanh(v1[j]); }
                        }
                    }
                    u32x4 w; w.x = cvt_pk_bf16(v0[0], v0[1]); w.y = cvt_pk_bf16(v0[2], v0[3]); w.z = cvt_pk_bf16(v1[0], v1[1]); w.w = cvt_pk_bf16(v1[2], v1[3]);
                    *(u32x4*)(rowp + bj * HALF) = w; asm volatile("" ::: "memory"); } }
    }
};
struct EpiLora2 {
    static constexpr bool PERM = true, AFTER_DRAIN = false;
    bf16_t* O; int ldc; const float* w0; const float* a0;
    __device__ __forceinline__ void operator()(const f32x4 (&acc)[2][2][4][2], const Unit& u, int wr, int wc, int fr, int fq) const {
        const int row0 = u.pm * BM + wr * 64 + fr, col0 = u.pn * BM + wc * 32 + 8 * fq, kind = u.pn >> 2;
        const float* bp = (kind == 0 ? w0 : a0) + (col0 & 1023); const float bsc = kind == 2 ? 0.f : 1.f, mul = kind == 0 ? -0.87504229f : 1.0f;
#pragma unroll
        for (int bj = 0; bj < 2; ++bj)
#pragma unroll
            for (int ai = 0; ai < 2; ++ai)
#pragma unroll
                for (int m = 0; m < 4; ++m) { bf16_t* rowp = O + (size_t)(row0 + ai * HALF + m * 16) * ldc + col0;
                    f32x4 v0 = acc[ai][bj][m][0] + *(const f32x4*)(bp + bj * HALF) * bsc, v1 = acc[ai][bj][m][1] + *(const f32x4*)(bp + bj * HALF + 4) * bsc;
                    if (kind != 2) {
#pragma unroll
                        for (int j = 0; j < 4; ++j) { v0[j] = mul * fsig(v0[j]); v1[j] = mul * fsig(v1[j]); }
                    }
                    u32x4 w; w.x = cvt_pk_bf16(v0[0], v0[1]); w.y = cvt_pk_bf16(v0[2], v0[3]); w.z = cvt_pk_bf16(v1[0], v1[1]); w.w = cvt_pk_bf16(v1[2], v1[3]);
                    *(u32x4*)(rowp + bj * HALF) = w; asm volatile("" ::: "memory"); }
    }
};

template <class Epi, class Sched, bool ALIGN_EPI = false, bool SP2 = false>
__device__ __forceinline__ void gemm_phase(PG8_LAS unsigned char* lds, const Gemm g, const Sched& S, const Epi& E, int tid_in) {
    int tid_ = tid_in; asm volatile("" : "+v"(tid_));
    const int tid = tid_, wid = __builtin_amdgcn_readfirstlane(tid >> 6), lane = tid & 63, wr = wid >> 2, wc = wid & 3, fr = lane & 15, fq = lane >> 4;
    int K_ = g.K; asm volatile("" : "+s"(K_));
    const int K = K_;
    unsigned voffA[2], voffB[2];
#pragma unroll
    for (int i = 0; i < 2; ++i) { int R, C; stage_rc(tid * 16 + i * 8192, R, C); const int Rb = Epi::PERM ? ((R & ~31) + perm32(R & 31)) : R;
        voffA[i] = (unsigned)(R * K + C) * 2u; voffB[i] = (unsigned)(Rb * K + C) * 2u; }
    const size_t kstep = (size_t)(BK * 2);
    const size_t hstep = (size_t)HALF * K * 2;
    const size_t tstep = 2 * hstep;
    const unsigned ldsw = (unsigned)wid * 1024u;
    const int aoff = lds_byte(wr * 64 + fr, fq * 8), boff = lds_byte(wc * 32 + fr, fq * 8);
#define PG8_SA(b, h) (((b) * 2 + (h)) * HTB)
#define PG8_SB(b, h) ((4 + (b) * 2 + (h)) * HTB)
#define PG8_STAGE(bufoff, gbase, voff) do { _Pragma("unroll") for (int _i = 0; _i < 2; ++_i) \
        __builtin_amdgcn_global_load_lds((const unsigned*)((const char*)(gbase) + (voff)[_i]), (PG8_LAS unsigned*)(lds + (bufoff) + ldsw + _i * 8192), 16, 0, 0); } while (0)
#define PG8_LDA(dst, b, h) do { _Pragma("unroll") for (int m = 0; m < 4; ++m) _Pragma("unroll") for (int k = 0; k < 2; ++k) dst[m][k] = *(const PG8_LAS bf16x8*)(lds + PG8_SA(b, h) + aoff + m * 2048 + k * 1024); } while (0)
#define PG8_LDB(dst, b, h) do { _Pragma("unroll") for (int n = 0; n < 2; ++n) _Pragma("unroll") for (int k = 0; k < 2; ++k) dst[n][k] = *(const PG8_LAS bf16x8*)(lds + PG8_SB(b, h) + boff + n * 2048 + k * 1024); } while (0)
#define PG8_MMA(ai, bj, At, Bt) do { __builtin_amdgcn_s_setprio(1); _Pragma("unroll") for (int m = 0; m < 4; ++m) _Pragma("unroll") for (int n = 0; n < 2; ++n) _Pragma("unroll") for (int k = 0; k < 2; ++k) \
        acc[ai][bj][m][n] = __builtin_amdgcn_mfma_f32_16x16x32_bf16(Bt[n][k], At[m][k], acc[ai][bj][m][n], 0, 0, 0); __builtin_amdgcn_s_setprio(0); } while (0)
#define PG8_WAIT_V(n) asm volatile("s_waitcnt vmcnt(" #n ")" ::: "memory")
#define PG8_WAIT_L(n) asm volatile("s_waitcnt lgkmcnt(" #n ")" ::: "memory")
#define PG8_BAR __builtin_amdgcn_s_barrier()
#define PG8_SCHED __builtin_amdgcn_sched_barrier(0)
    Unit cur, nxt; int ui = 0;
    if (!S.next(0, cur)) return;
    f32x4 acc[2][2][4][2];
#pragma unroll
    for (int a = 0; a < 2; ++a)
#pragma unroll
        for (int b = 0; b < 2; ++b)
#pragma unroll
            for (int m = 0; m < 4; ++m)
#pragma unroll
                for (int n = 0; n < 2; ++n) acc[a][b][m][n] = (f32x4){0.f, 0.f, 0.f, 0.f};
    bf16x8 At[4][2], B0[2][2], B1[2][2];
    const char* cA = (const char*)g.A + (size_t)cur.pm * tstep + (size_t)cur.k0 * 2; const char* cB = (const char*)g.Bt + (size_t)cur.pn * tstep + (size_t)cur.k0 * 2;
    S.a_ready(cur);
    if constexpr (SP2) {
        PG8_STAGE(PG8_SB(0, 0), cB, voffB); PG8_STAGE(PG8_SB(0, 1), cB + hstep, voffB); PG8_STAGE(PG8_SA(0, 0), cA, voffA); PG8_STAGE(PG8_SA(0, 1), cA + hstep, voffA);
        if (wr == 1) PG8_BAR;
        PG8_WAIT_V(2); PG8_BAR;
        PG8_STAGE(PG8_SB(1, 0), cB + kstep, voffB); PG8_STAGE(PG8_SA(1, 0), cA + kstep, voffA); PG8_STAGE(PG8_SB(1, 1), cB + hstep + kstep, voffB);
        PG8_WAIT_V(6); PG8_BAR;
    } else {
        PG8_STAGE(PG8_SB(0, 0), cB, voffB); PG8_STAGE(PG8_SA(0, 0), cA, voffA); PG8_STAGE(PG8_SB(0, 1), cB + hstep, voffB); PG8_STAGE(PG8_SA(0, 1), cA + hstep, voffA);
        if (wr == 1) PG8_BAR;
        PG8_WAIT_V(4); PG8_BAR;
        PG8_STAGE(PG8_SB(1, 0), cB + kstep, voffB); PG8_STAGE(PG8_SA(1, 0), cA + kstep, voffA); PG8_STAGE(PG8_SB(1, 1), cB + hstep + kstep, voffB);
        PG8_WAIT_V(6); PG8_BAR;
    }
    for (;;) {
        const bool has_next = S.next(ui + 1, nxt);
        const char* nA = has_next ? (const char*)g.A + (size_t)nxt.pm * tstep + (size_t)nxt.k0 * 2 : cA; const char* nB = has_next ? (const char*)g.Bt + (size_t)nxt.pn * tstep + (size_t)nxt.k0 * 2 : cB;
        const int nt = cur.nt;
        for (int t = 0; t < nt; t += 2) {
            const bool last = (t == nt - 2);
            const char* a1 = cA + (size_t)(t + 1) * kstep;
            const char* a2 = last ? nA : cA + (size_t)(t + 2) * kstep; const char* b2 = last ? nB : cB + (size_t)(t + 2) * kstep;
            const char* a3 = a2 + kstep; const char* b3 = b2 + kstep;
            if (last && has_next) S.a_ready(nxt);
            if constexpr (SP2) {
            PG8_LDB(B0, 0, 0); PG8_LDB(B1, 0, 1); PG8_SCHED; PG8_LDA(At, 0, 0); PG8_STAGE(PG8_SA(1, 1), a1 + hstep, voffA);
            PG8_WAIT_V(8); PG8_WAIT_L(0); PG8_BAR; PG8_MMA(0, 0, At, B0); PG8_MMA(0, 1, At, B1); PG8_BAR; PG8_SCHED;
            PG8_LDA(At, 0, 1); PG8_STAGE(PG8_SB(0, 0), b2, voffB); PG8_STAGE(PG8_SB(0, 1), b2 + hstep, voffB); PG8_STAGE(PG8_SA(0, 0), a2, voffA);
            PG8_WAIT_V(8); PG8_WAIT_L(0); PG8_BAR; PG8_MMA(1, 0, At, B0); PG8_MMA(1, 1, At, B1); PG8_BAR; PG8_SCHED;
            PG8_LDB(B0, 1, 0); PG8_LDB(B1, 1, 1); PG8_SCHED; PG8_LDA(At, 1, 0); PG8_STAGE(PG8_SA(0, 1), a2 + hstep, voffA);
            PG8_WAIT_V(8); PG8_WAIT_L(0); PG8_BAR; PG8_MMA(0, 0, At, B0); PG8_MMA(0, 1, At, B1); PG8_BAR; PG8_SCHED;
            PG8_LDA(At, 1, 1); PG8_STAGE(PG8_SB(1, 0), b3, voffB); PG8_STAGE(PG8_SB(1, 1), b3 + hstep, voffB); PG8_STAGE(PG8_SA(1, 0), a3, voffA);
            PG8_WAIT_V(8); PG8_WAIT_L(0); PG8_BAR; PG8_MMA(1, 0, At, B0); PG8_MMA(1, 1, At, B1); PG8_BAR; PG8_SCHED;
            } else {
            PG8_LDB(B0, 0, 0); PG8_SCHED; PG8_LDA(At, 0, 0); PG8_STAGE(PG8_SA(1, 1), a1 + hstep, voffA);
            PG8_WAIT_L(8); PG8_BAR; PG8_WAIT_L(0); PG8_MMA(0, 0, At, B0); PG8_BAR; PG8_SCHED;
            PG8_LDB(B1, 0, 1); PG8_STAGE(PG8_SB(0, 0), b2, voffB);
            PG8_BAR; PG8_WAIT_L(0); PG8_MMA(0, 1, At, B1); PG8_BAR;
            PG8_LDA(At, 0, 1); PG8_STAGE(PG8_SA(0, 0), a2, voffA);
            PG8_BAR; PG8_WAIT_L(0); PG8_MMA(1, 0, At, B0); PG8_BAR; PG8_SCHED;
            PG8_STAGE(PG8_SB(0, 1), b2 + hstep, voffB);
            PG8_WAIT_V(6); PG8_BAR; PG8_MMA(1, 1, At, B1); PG8_BAR;
            PG8_LDB(B0, 1, 0); PG8_SCHED; PG8_LDA(At, 1, 0); PG8_STAGE(PG8_SA(0, 1), a2 + hstep, voffA);
            PG8_WAIT_L(8); PG8_BAR; PG8_WAIT_L(0); PG8_MMA(0, 0, At, B0); PG8_BAR; PG8_SCHED;
            PG8_LDB(B1, 1, 1); PG8_STAGE(PG8_SB(1, 0), b3, voffB);
            PG8_BAR; PG8_WAIT_L(0); PG8_MMA(0, 1, At, B1); PG8_BAR;
            PG8_LDA(At, 1, 1); PG8_STAGE(PG8_SA(1, 0), a3, voffA);
            PG8_BAR; PG8_WAIT_L(0); PG8_MMA(1, 0, At, B0); PG8_BAR; PG8_SCHED;
            PG8_STAGE(PG8_SB(1, 1), b3 + hstep, voffB);
            PG8_WAIT_V(6); PG8_BAR; PG8_MMA(1, 1, At, B1); PG8_BAR;
            }
        }
        if constexpr (ALIGN_EPI) { if (wr == 0) PG8_BAR; }
        if constexpr (!Epi::AFTER_DRAIN) { E(acc, cur, wr, wc, fr, fq); S.done(cur); }
        if (!has_next) break;
#pragma unroll
        for (int a = 0; a < 2; ++a)
#pragma unroll
            for (int b = 0; b < 2; ++b)
#pragma unroll
                for (int m = 0; m < 4; ++m)
#pragma unroll
                    for (int n = 0; n < 2; ++n) acc[a][b][m][n] = (f32x4){0.f, 0.f, 0.f, 0.f};
        cur = nxt; cA = nA; cB = nB; ++ui;
        if constexpr (ALIGN_EPI) { if (wr == 1) PG8_BAR; }
    }
    PG8_WAIT_V(0);
    if constexpr (!ALIGN_EPI) { if (wr == 0) PG8_BAR; }
    PG8_BAR;
    if constexpr (Epi::AFTER_DRAIN) { E.fused(acc, cur, wr, wc, fr, fq, lds, wid, lane); S.done(cur); }
#undef PG8_SA
#undef PG8_SB
#undef PG8_STAGE
#undef PG8_LDA
#undef PG8_LDB
#undef PG8_MMA
#undef PG8_WAIT_V
#undef PG8_WAIT_L
#undef PG8_BAR
#undef PG8_SCHED
}
}
constexpr int NWAVES = 8, NTHREADS = 512;
constexpr int D = 1024, MP = 16384, MS = 1024, M = MP + MS, NSEQ = 136, FF = 2816;
constexpr int PSEQ = 2048, SSEQ = 8, NPB = 8, NSB = 128;
constexpr int ZW = 3328;
constexpr int ZQ = 0, ZK = 512, ZV = 1024, ZO = 1536, ZXR = 2048, ZGR = 2560, ZIG = 3072, ZFG = 3076;
constexpr int RKW = 3072, WAGW = 3072;
constexpr float ALPHA = 1.41421356237f;
constexpr float LN_EPS = 1e-5f, HEAD_EPS = 1e-6f, RW_EPS = 64e-5f;
constexpr float MSCALE = 0.08838834764831845f;

constexpr size_t O_Y = 0, O_PMC = 17825792, O_PMN = 18350080, O_PMM = 18354176, O_PRH = 18354208, O_PRC = 18358304, O_PWKV = 18370592, O_PSH = 18894880,
                 O_SMC = 18903072, O_SMN = 27291680, O_SMM = 27357216, O_SRH = 27357728, O_SRC = 27423264, O_SWKV = 27619872, O_SSH = 36008480, O_END = 36139552;

constexpr size_t MiB = 1u << 20;
constexpr size_t WS_CTL = 0, CTL_ZERO_BYTES = 1 * MiB;
constexpr size_t WS_W13 = 1 * MiB;
constexpr size_t WS_W2 = 45 * MiB;
constexpr size_t WS_WIN = 67 * MiB;
constexpr size_t WS_WOUT = WS_WIN + 6815744;
constexpr size_t WS_WRK = WS_WOUT + 2 * MiB;
constexpr size_t WS_WL2 = WS_WRK + 13 * MiB;
constexpr size_t WS_WO = WS_WL2 + 1572864;
constexpr size_t WS_MOD = 92 * MiB;
constexpr size_t WS_SC = 101 * MiB + 640 * 1024;
constexpr size_t WS_H = 102 * MiB;
constexpr size_t WS_BIG = 136 * MiB;
constexpr size_t WS_HID = WS_BIG;
constexpr size_t WS_Z = WS_BIG;
constexpr size_t WS_CST = WS_BIG + 111 * MiB;
constexpr size_t WS_SLAB = WS_BIG + 180 * MiB;
constexpr size_t WS_RGH = WS_BIG + 143 * MiB;
constexpr size_t WS_RGP = WS_BIG + 175 * MiB;
constexpr size_t WS_NST = WS_BIG + 207 * MiB;
constexpr size_t WS_MST = WS_NST + 262144;
constexpr size_t WS_CARRY = WS_MST + 8192;
constexpr size_t WS_RK = WS_BIG;
constexpr size_t WS_A3 = WS_BIG + 102 * MiB;
constexpr size_t WS_A2 = WS_BIG + 111 * MiB;
constexpr size_t WS_WAG = WS_BIG + 111 * MiB;
constexpr size_t WS_END = WS_BIG + 224 * MiB;
static_assert(WS_WO + 2 * MiB <= WS_MOD && WS_MOD + (size_t)2 * 136 * 9216 * 4 <= WS_SC && WS_SC + 160 * 1024 * 2 <= WS_H && WS_H + (size_t)M * D * 2 <= WS_BIG, "ws map");
static_assert(WS_SLAB + (size_t)11 * 4 * MiB <= WS_END && WS_A2 + (size_t)M * 2048 * 2 <= WS_SLAB && WS_CARRY + 8 * 64 * 512 * 4 <= WS_END && WS_WAG + (size_t)M * WAGW * 2 <= WS_END && WS_A3 + (size_t)M * 256 * 2 <= WS_A2, "ws map 2");
constexpr size_t WS_BN = WS_BIG + 213 * MiB;
constexpr size_t XB_OFF = (size_t)M * 1024 * 2;
constexpr size_t WS_ZF = WS_BIG + 111 * MiB;
constexpr int CW_BAR = 4096;

constexpr int LDS_BYTES = 147456;
constexpr int LDSCTL_OFF = LDS_BYTES - 512;
constexpr int MISC_OFF = LDSCTL_OFF;

#define GAS __attribute__((address_space(1)))
#define LAS __attribute__((address_space(3)))
typedef unsigned short bf16;
typedef unsigned v4u __attribute__((ext_vector_type(4)));
typedef unsigned v2u __attribute__((ext_vector_type(2)));
typedef float f32x4 __attribute__((ext_vector_type(4)));
typedef float f32x2 __attribute__((ext_vector_type(2)));
typedef float f32x16 __attribute__((ext_vector_type(16)));
typedef short bf16x8 __attribute__((ext_vector_type(8)));
typedef GAS unsigned gu32;
#define RLX_AGENT __ATOMIC_RELAXED, __HIP_MEMORY_SCOPE_AGENT
#define LDS_WAIT() asm volatile("s_waitcnt lgkmcnt(0)" ::: "memory")
#define DI __device__ __forceinline__
#define MFMA32(a, b, c) __builtin_amdgcn_mfma_f32_32x32x16_bf16((a), (b), (c), 0, 0, 0)
DI unsigned f2bf(float f) { unsigned u = __builtin_bit_cast(unsigned, f); return (u + 0x7fffu + ((u >> 16) & 1u)) >> 16; }
DI unsigned pk2(float lo, float hi) { return pg8::cvt_pk_bf16(lo, hi); }
DI float bf2f(unsigned b) { return __builtin_bit_cast(float, b << 16); }
DI float bflo(unsigned w) { return __builtin_bit_cast(float, w << 16); }
DI float bfhi(unsigned w) { return __builtin_bit_cast(float, w & 0xffff0000u); }
DI int crow(int reg, int h) { return (reg & 3) + 8 * (reg >> 2) + 4 * h; }
DI float fexp(float x) { return __builtin_amdgcn_exp2f(1.44269504f * x); }
DI float fsig(float x) { return pg8::fsig(x); }
DI bf16x8 mk_frag(unsigned a, unsigned b, unsigned c, unsigned d) { v4u p; p.x = a; p.y = b; p.z = c; p.w = d; return __builtin_bit_cast(bf16x8, p); }
DI bf16x8 pack8(const float (&v)[8]) { return mk_frag(pk2(v[0], v[1]), pk2(v[2], v[3]), pk2(v[4], v[5]), pk2(v[6], v[7])); }
DI float wave_sum(float v) {
#pragma unroll
    for (int o = 1; o < 64; o <<= 1) v += __shfl_xor(v, o);
    return v;
}

#define XB_TMO      128
#define XB_XCNT(j)  (256  + 64 * (j))
#define XB_XSUB(j)  (1280 + 64 * (j))
#define XB_XGEN(j)  (2304 + 64 * (j))
#define XB_TOP      3328
#define XB_TOPGEN   3392
#define XCD_BAR_WORDS 3456
#define XB_SPIN_CAP (1u << 18)

__device__ __forceinline__ unsigned xb_ld(unsigned* p)              { return __hip_atomic_load(p, __ATOMIC_RELAXED, __HIP_MEMORY_SCOPE_AGENT); }
__device__ __forceinline__ unsigned xb_add(unsigned* p, unsigned v) { return __hip_atomic_fetch_add(p, v, __ATOMIC_RELAXED, __HIP_MEMORY_SCOPE_AGENT); }
__device__ __forceinline__ unsigned xb_xcc_id() { return (unsigned)__builtin_amdgcn_s_getreg((3 << 11) | 20) & 0xFu; }
#define XB_SPIN(cond, bar) do { unsigned _sp = 0; while (cond) { __builtin_amdgcn_s_sleep(1); \
    if ((++_sp & 255u) == 0u) { if (xb_ld(&(bar)[XB_TMO])) break; if (_sp > XB_SPIN_CAP) { atomicAdd(&(bar)[XB_TMO], 1u); break; } } } } while (0)

struct XcdBarrier {
    unsigned* bar; unsigned x;
    volatile LAS unsigned* st;
};

__device__ __forceinline__ XcdBarrier xcd_barrier_post(unsigned* bar, volatile LAS unsigned* st) {
    XcdBarrier b; b.bar = bar; b.x = xb_xcc_id(); b.st = st;
    if (threadIdx.x == 0) (void)xb_add(&bar[XB_XCNT(b.x)], 1u);
    return b;
}
__device__ __forceinline__ void xcd_barrier_complete(unsigned* bar, unsigned x, unsigned& nloc, unsigned& nx) {
    const unsigned G = gridDim.x * gridDim.y * gridDim.z;
    unsigned sum, cnt, mine, sp = 0u;
    for (;;) {
        sum = 0u; cnt = 0u; mine = 0u;
#pragma unroll
        for (unsigned j = 0; j < 16; ++j) { const unsigned c = xb_ld(&bar[XB_XCNT(j)]); sum += c; cnt += (c > 0u) ? 1u : 0u; mine = (j == x) ? c : mine; }
        if (sum == G) break;
        __builtin_amdgcn_s_sleep(1);
        if ((++sp & 255u) == 0u) { if (xb_ld(&bar[XB_TMO])) break; if (sp > XB_SPIN_CAP) { atomicAdd(&bar[XB_TMO], 1u); break; } }
    }
    nloc = mine > 0u ? mine : 1u; nx = cnt > 0u ? cnt : 1u;
}

__device__ __forceinline__ void xcd_barrier(const XcdBarrier& b) {
    asm volatile("s_waitcnt vmcnt(0)" ::: "memory");
    __syncthreads();
    if (threadIdx.x == 0) {
        unsigned* bar = b.bar;
        __builtin_amdgcn_s_waitcnt(0);
        unsigned nloc = b.st[0], nx = b.st[1];
        if (nloc == 0u) { xcd_barrier_complete(bar, b.x, nloc, nx); b.st[0] = nloc; b.st[1] = nx; }
        const unsigned old = xb_add(&bar[XB_XSUB(b.x)], 1u);
        const unsigned gen = old / nloc;
        if (old + 1u == (gen + 1u) * nloc) {
            __builtin_amdgcn_fence(__ATOMIC_RELEASE, "agent");
            asm volatile("s_waitcnt vmcnt(0)" ::: "memory");
            const unsigned og = xb_add(&bar[XB_TOP], 1u);
            const unsigned tg = og / nx;
            if (og + 1u == (tg + 1u) * nx) xb_add(&bar[XB_TOPGEN], 1u);
            else XB_SPIN(xb_ld(&bar[XB_TOPGEN]) == tg, bar);
            __builtin_amdgcn_fence(__ATOMIC_ACQUIRE, "agent");
            xb_add(&bar[XB_XGEN(b.x)], 1u);
            asm volatile("s_waitcnt vmcnt(0)" ::: "memory");
        } else {
            XB_SPIN(xb_ld(&bar[XB_XGEN(b.x)]) == gen, bar);
            __builtin_amdgcn_fence(__ATOMIC_ACQUIRE, "agent");
            asm volatile("s_waitcnt vmcnt(0)" ::: "memory");
        }
    }
    __syncthreads();
}
struct Args { const float* in[47]; float* out; unsigned char* ws; int ph_lo, ph_hi; };
struct Frame {
    LAS unsigned char* lds;
    volatile LAS unsigned* MISC;
    gu32* ctl;
    int tid, lane, wave;
    int vcu, G;
    float* out;
    unsigned char* ws;
};
enum { I_XP = 0, I_XS, I_CP, I_CS, I_SMC, I_SMN, I_SMM, I_SRH, I_SRC, I_SWKV, I_SSH, I_ADAW, I_ADAB, I_LNG, I_LNB, I_W1, I_W3, I_W2, I_WIN, I_BG, I_MNG,
       I_CW, I_CB, I_WA, I_BA, I_WX, I_BX, I_LAM, I_WOUT, I_MU, I_WR, I_WK, I_WV, I_W0, I_LW1, I_LW2, I_A0, I_A1, I_A2, I_G1, I_G2, I_KK, I_KA, I_RK, I_LXG, I_LXB, I_WO };

struct EpiResid {
    static constexpr bool PERM = true, AFTER_DRAIN = false;
    const Args& ar; float* out; unsigned char* ws; int cfg;
    __device__ __forceinline__ void operator()(const pg8::f32x4 (&acc)[2][2][4][2], const pg8::Unit& u, int wr, int wc, int fr, int fq) const {
        using pg8::BM; using pg8::HALF;
        if (u.sub) {
            const int row0 = u.pm * BM + wr * 64 + fr - MP, col0 = u.pn * BM + wc * 32 + 8 * fq;
            float* sb = (float*)(ws + WS_SLAB) + (size_t)(u.k0 / (64 * u.nt)) * (1024 * 1024) + col0;
#pragma unroll
            for (int ai = 0; ai < 2; ++ai)
#pragma unroll
                for (int m = 0; m < 4; ++m) { float* o = sb + (size_t)(row0 + ai * HALF + m * 16) * 1024;
#pragma unroll
                    for (int bj = 0; bj < 2; ++bj) { *(f32x4*)(o + bj * HALF) = acc[ai][bj][m][0]; *(f32x4*)(o + bj * HALF + 4) = acc[ai][bj][m][1]; } }
            return;
        }
        const int row0 = u.pm * BM + wr * 64 + fr, col0 = u.pn * BM + wc * 32 + 8 * fq;
        const bool first = cfg & 1; const int l = (cfg >> 1) & 1, jg = (cfg >> 2) & 15; const float rw = (cfg & 64) ? 1.0f : 0.5f;
        bf16* XB = (bf16*)((unsigned char*)out + XB_OFF);
        bf16* Zo = (cfg & 128) ? (bf16*)(ws + WS_BIG + 145 * MiB) : ((cfg & 256) ? (bf16*)(ws + WS_ZF) : XB);
        const float* gate = (const float*)(ws + WS_MOD) + ((size_t)l * NSEQ * 9 + jg) * 1024;
#pragma unroll
        for (int ai = 0; ai < 2; ++ai)
#pragma unroll
            for (int m = 0; m < 4; ++m) { const int row = row0 + ai * HALF + m * 16;
                const float* gr = gate + (size_t)pg8::mod_row(row) * 9216 + col0;
#pragma unroll
                for (int bj = 0; bj < 2; ++bj) { const int c = bj * HALF; f32x4 x0, x1;
                    if (first) { const float* xr = (row < MP ? ar.in[I_XP] + (size_t)row * 1024 : ar.in[I_XS] + (size_t)(row - MP) * 1024) + col0 + c; x0 = *(const f32x4*)xr; x1 = *(const f32x4*)(xr + 4); }
                    else { const v4u q = *(const v4u*)(XB + (size_t)row * 1024 + col0 + c); x0 = (f32x4){bflo(q.x), bfhi(q.x), bflo(q.y), bfhi(q.y)}; x1 = (f32x4){bflo(q.z), bfhi(q.z), bflo(q.w), bfhi(q.w)}; }
                    const f32x4 g0 = *(const f32x4*)(gr + c), g1 = *(const f32x4*)(gr + c + 4);
                    const f32x4 z0 = x0 * ALPHA + (g0 + 1.0f) * rw * acc[ai][bj][m][0], z1 = x1 * ALPHA + (g1 + 1.0f) * rw * acc[ai][bj][m][1];
                    v4u w; w.x = pk2(z0.x, z0.y); w.y = pk2(z0.z, z0.w); w.z = pk2(z1.x, z1.y); w.w = pk2(z1.z, z1.w);
                    *(v4u*)(Zo + (size_t)row * 1024 + col0 + c) = w; }
                asm volatile("" ::: "memory"); }
    }
};
struct SplitOrder {
    pg8::StaticOrder base; int S;
    __device__ __forceinline__ bool next(int i, pg8::Unit& u) const {
        if (S == 0) return base.next(i, u);
        if (i == 0) return base.next(0, u);
        if (i == 1 && base.c < 16 * S) { const int su = base.c / S, ks = base.c - su * S; u.pm = 64 + (su >> 2); u.pn = su & 3; u.k0 = ks * 256; u.nt = 4; u.sub = 1; return true; }
        return false;
    }
    __device__ __forceinline__ void a_ready(const pg8::Unit&) const {}
    __device__ __forceinline__ void done(const pg8::Unit&) const {}
};

DI void p0_sctab(Frame& F, const Args& AR) {
    bf16* sc = (bf16*)(F.ws + WS_SC);
    const int gt = F.vcu * NTHREADS + F.tid, NT = F.G * NTHREADS;
    for (int e = gt; e < 160 * 256; e += NT) { const int m = e >> 8, k4 = (e & 255) * 4; v2u w; w.x = 0u; w.y = 0u;
        if (m < NSEQ) { const f32x4 c = *(const f32x4*)((m < NPB ? AR.in[I_CP] + (size_t)m * D : AR.in[I_CS] + (size_t)(m - NPB) * D) + k4);
            w.x = pk2(c.x * fsig(c.x), c.y * fsig(c.y)); w.y = pk2(c.z * fsig(c.z), c.w * fsig(c.w)); }
        *(v2u*)(sc + (size_t)m * 1024 + k4) = w; }
}
DI void p0_mod(Frame& F, const Args& AR) {
    LAS float* SL = (LAS float*)F.lds;
    LAS float* T = (LAS float*)(F.lds + 81920);
    const int lane = F.lane, wave = F.wave, r = lane & 31, hh = lane >> 5;
    const float* adaw = AR.in[I_ADAW]; const float* adab = AR.in[I_ADAB];
    const bf16* sc = (const bf16*)(F.ws + WS_SC);
    float* mod = (float*)(F.ws + WS_MOD);
    for (int nb = F.vcu; nb < 576; nb += F.G) {
        const int n0 = nb * 32, l = n0 / 9216, nc0 = n0 - l * 9216;
        const float* W = adaw + (size_t)l * 1024 * 9216 + nc0 + r + (size_t)(wave * 128 + 8 * hh) * 9216;
        float a[8][8];
#pragma unroll
        for (int ks = 0; ks < 8; ++ks)
#pragma unroll
            for (int j = 0; j < 8; ++j) a[ks][j] = W[(size_t)(ks * 16 + j) * 9216];
        f32x16 acc[5];
#pragma unroll
        for (int mb = 0; mb < 5; ++mb)
#pragma unroll
            for (int i = 0; i < 16; ++i) acc[mb][i] = 0.f;
#pragma unroll
        for (int ks = 0; ks < 8; ++ks) { const bf16x8 A = pack8(a[ks]); const int k0 = wave * 128 + ks * 16 + 8 * hh;
#pragma unroll
            for (int mb = 0; mb < 5; ++mb) acc[mb] = MFMA32(A, *(const bf16x8*)(sc + (size_t)(mb * 32 + r) * 1024 + k0), acc[mb]); }
#pragma unroll
        for (int half = 4; half >= 1; half >>= 1) {
            if (wave >= half && wave < 2 * half) { LAS float* p = SL + (wave - half) * 5120 + lane;
#pragma unroll
                for (int mb = 0; mb < 5; ++mb)
#pragma unroll
                    for (int i = 0; i < 16; ++i) p[(mb * 16 + i) * 64] = acc[mb][i]; }
            __syncthreads();
            if (wave < half) { const LAS float* p = SL + wave * 5120 + lane;
#pragma unroll
                for (int mb = 0; mb < 5; ++mb)
#pragma unroll
                    for (int i = 0; i < 16; ++i) acc[mb][i] += p[(mb * 16 + i) * 64]; }
            __syncthreads();
        }
        if (wave == 0) {
#pragma unroll
            for (int mb = 0; mb < 5; ++mb)
#pragma unroll
                for (int i = 0; i < 16; ++i) T[(mb * 32 + r) * 33 + crow(i, hh)] = acc[mb][i]; }
        __syncthreads();
        for (int m = F.tid >> 5; m < NSEQ; m += 16) { const int n = F.tid & 31; mod[(size_t)(l * NSEQ + m) * 9216 + nc0 + n] = T[m * 33 + n] + adab[l * 9216 + nc0 + n]; }
        __syncthreads();
    }
}

DI void tr_item(const float* src, int ld, int nvalid, float keep, const float* sc, float sa, float sb, bf16* dst, int dld, LAS float* scr, int lane) {
    const int n4 = (lane & 7) * 4, kr = lane >> 3; const float kz = (n4 < nvalid) ? keep : 0.f;
    f32x4 v[8]; float m[8];
#pragma unroll
    for (int i = 0; i < 8; ++i) { v[i] = *(const f32x4*)(src + (size_t)(kr + 8 * i) * ld + n4); m[i] = sc[kr + 8 * i]; }
#pragma unroll
    for (int i = 0; i < 8; ++i) { const float f = (sa + sb * m[i]) * kz; LAS float* p = scr + (kr + 8 * i) * 33 + n4;
        p[0] = kz == 0.f ? 0.f : v[i].x * f; p[1] = kz == 0.f ? 0.f : v[i].y * f; p[2] = kz == 0.f ? 0.f : v[i].z * f; p[3] = kz == 0.f ? 0.f : v[i].w * f; }
    LDS_WAIT(); asm volatile("" ::: "memory");
    const int c = lane & 7;
#pragma unroll
    for (int j = 0; j < 4; ++j) { const int n = (lane >> 3) + 8 * j; const LAS float* s = scr + (8 * c) * 33 + n;
        v4u o; o.x = pk2(s[0 * 33], s[1 * 33]); o.y = pk2(s[2 * 33], s[3 * 33]); o.z = pk2(s[4 * 33], s[5 * 33]); o.w = pk2(s[6 * 33], s[7 * 33]);
        *(GAS v4u*)(dst + (size_t)n * dld + 8 * c) = o; }
    LDS_WAIT(); asm volatile("" ::: "memory");
}
DI void p0_weights(Frame& F, const Args& AR) {
    LAS float* scr = (LAS float*)(F.lds + 32768 + F.wave * 8704);
    const int gw = F.vcu * NWAVES + F.wave, NGW = F.G * NWAVES;
    constexpr int I_13 = 16 * 176, I_2 = 44 * 32, I_IN = 16 * 104, I_SQ = 16 * 32, I_RKI = 32 * 104, I_L2 = 4 * 96;
    constexpr int NITEMS = 4 * I_13 + 4 * I_2 + I_IN + 2 * I_SQ + I_RKI + I_L2;
    bf16* W13 = (bf16*)(F.ws + WS_W13); bf16* W2 = (bf16*)(F.ws + WS_W2); bf16* WIN = (bf16*)(F.ws + WS_WIN); bf16* WOUT = (bf16*)(F.ws + WS_WOUT);
    bf16* WRK = (bf16*)(F.ws + WS_WRK); bf16* WL2 = (bf16*)(F.ws + WS_WL2); bf16* WO = (bf16*)(F.ws + WS_WO);
    for (int it = gw; it < NITEMS; it += NGW) {
        int r = it;
        if (r < 4 * I_13) { const int f = r / I_13; r -= f * I_13; const int kt = r / 176, tn = r % 176, j = tn >> 3, i = tn & 7;
            const float* src = (i < 4 ? AR.in[I_W1] : AR.in[I_W3]) + (size_t)f * 1024 * FF + (size_t)(64 * kt) * FF + 128 * j + 32 * (i & 3);
            tr_item(src, FF, 32, 1.f, src, 1.f, 0.f, W13 + (size_t)f * 5632 * 1024 + (size_t)(32 * tn) * 1024 + 64 * kt, 1024, scr, F.lane); continue; }
        r -= 4 * I_13;
        if (r < 4 * I_2) { const int f = r / I_2; r -= f * I_2; const int kt = r / 32, tn = r % 32;
            const float* src = AR.in[I_W2] + (size_t)f * FF * 1024 + (size_t)(64 * kt) * 1024 + 32 * tn;
            tr_item(src, 1024, 32, 1.f, src, 1.f, 0.f, W2 + (size_t)f * 1024 * FF + (size_t)(32 * tn) * FF + 64 * kt, FF, scr, F.lane); continue; }
        r -= 4 * I_2;
        if (r < I_IN) { const int kt = r / 104, tn = r % 104, nd = 32 * tn; int sc0 = 0, nv = 32; bool has = true;
            if (nd < 2048) sc0 = nd; else if (nd < 3072) sc0 = nd + 8; else if (nd == 3072) { sc0 = 2048; nv = 8; } else has = false;
            const float* src = AR.in[I_WIN] + (size_t)(64 * kt) * 3080 + sc0;
            tr_item(src, 3080, nv, has ? 1.f : 0.f, src, 1.f, 0.f, WIN + (size_t)nd * 1024 + 64 * kt, 1024, scr, F.lane); continue; }
        r -= I_IN;
        if (r < 2 * I_SQ) { const int w = r / I_SQ; r -= w * I_SQ; const int kt = r / 32, tn = r % 32;
            const float* src = (w == 0 ? AR.in[I_WOUT] : AR.in[I_WO]) + (size_t)(64 * kt) * 1024 + 32 * tn;
            tr_item(src, 1024, 32, 1.f, src, 1.f, 0.f, (w == 0 ? WOUT : WO) + (size_t)(32 * tn) * 1024 + 64 * kt, 1024, scr, F.lane); continue; }
        r -= 2 * I_SQ;
        if (r < I_RKI) { const int kt = r / 104, tn = r % 104, nd = 32 * tn, kd = 64 * kt, half = kd >= 1024, ks = kd & 1023;
            const float* base; int ld, col, mi;
            if (nd < 1024) { base = AR.in[I_WR]; ld = 1024; col = nd; mi = 0; }
            else if (nd < 2048) { base = AR.in[I_WK]; ld = 1024; col = nd - 1024; mi = 2; }
            else if (nd < 3072) { base = AR.in[I_WV]; ld = 1024; col = nd - 2048; mi = 3; }
            else if (nd < 3136) { base = AR.in[I_LW1]; ld = 64; col = nd - 3072; mi = 1; }
            else if (nd < 3200) { base = AR.in[I_A1]; ld = 64; col = nd - 3136; mi = 4; }
            else { base = AR.in[I_G1]; ld = 128; col = nd - 3200; mi = 5; }
            tr_item(base + (size_t)ks * ld + col, ld, 32, 1.f, AR.in[I_MU] + mi * 1024 + ks, half ? 0.f : 1.f, half ? 1.f : -1.f, WRK + (size_t)nd * 2048 + kd, 2048, scr, F.lane); continue; }
        r -= I_RKI;
        { const int kt = r / 96, tn = r % 96, nd = 32 * tn; const float* src = AR.in[I_LW2]; float keep = 0.f;
            if (nd < 1024) { if (kt == 0) { src = AR.in[I_LW2] + nd; keep = 1.f; } }
            else if (nd < 2048) { if (kt == 1) { src = AR.in[I_A2] + (nd - 1024); keep = 1.f; } }
            else { if (kt >= 2) { src = AR.in[I_G2] + (size_t)(64 * (kt - 2)) * 1024 + (nd - 2048); keep = 1.f; } }
            tr_item(src, 1024, 32, keep, AR.in[I_LW2], 1.f, 0.f, WL2 + (size_t)nd * 256 + 64 * kt, 256, scr, F.lane); }
    }
}

DI void ld8(float (&v)[8], const bf16* p) { const v4u q = *(const v4u*)p; v[0] = bflo(q.x); v[1] = bfhi(q.x); v[2] = bflo(q.y); v[3] = bfhi(q.y); v[4] = bflo(q.z); v[5] = bfhi(q.z); v[6] = bflo(q.w); v[7] = bfhi(q.w); }
DI void ld8(float (&v)[8], const float* p) { const f32x4 a = *(const f32x4*)p, b = *(const f32x4*)(p + 4); v[0] = a.x; v[1] = a.y; v[2] = a.z; v[3] = a.w; v[4] = b.x; v[5] = b.y; v[6] = b.z; v[7] = b.w; }
DI v4u pk8(const float (&v)[8]) { v4u w; w.x = pk2(v[0], v[1]); w.y = pk2(v[2], v[3]); w.z = pk2(v[4], v[5]); w.w = pk2(v[6], v[7]); return w; }
DI void ln_pass(Frame& F, const Args& AR, int first, int do_ln, int l, int sub, int lm, int js, int mode, int nsplit, int xfirst, int fin) {
    const int gw = F.vcu * NWAVES + F.wave, NGW = F.G * NWAVES, lane = F.lane;
    bf16* XB = (bf16*)((unsigned char*)F.out + XB_OFF); const bf16* ZS = fin ? (const bf16*)(F.ws + WS_ZF) : XB;
    const float* lg = AR.in[I_LNG] + (l * 3 + sub) * 1024; const float* lb = AR.in[I_LNB] + (l * 3 + sub) * 1024;
    const float* mod = (const float*)(F.ws + WS_MOD);
    bf16* H = (bf16*)(F.ws + WS_H); bf16* A2 = (bf16*)(F.ws + WS_A2);
    for (int r = gw; r < M; r += NGW) {
        float v[2][8];
#pragma unroll
        for (int j = 0; j < 2; ++j) { const int c0 = 8 * (lane + 64 * j);
            if (first || (xfirst && r >= MP)) ld8(v[j], (r < MP ? AR.in[I_XP] + (size_t)r * D : AR.in[I_XS] + (size_t)(r - MP) * D) + c0);
            else ld8(v[j], ZS + (size_t)r * D + c0); }
        if (nsplit > 0 && r >= MP) {
            const float* gp = mod + ((size_t)(l * NSEQ + pg8::mod_row(r)) * 9 + 3 * sub + 2) * 1024; const float rw = sub == 1 ? 1.0f : 0.5f;
            const float* sl = (const float*)(F.ws + WS_SLAB) + (size_t)(r - MP) * 1024;
#pragma unroll
            for (int j = 0; j < 2; ++j) { const int c0 = 8 * (lane + 64 * j); float a[8], g[8]; ld8(a, sl + c0); ld8(g, gp + c0);
                for (int s = 1; s < nsplit; ++s) { float t[8]; ld8(t, sl + (size_t)s * 1024 * 1024 + c0);
#pragma unroll
                    for (int e = 0; e < 8; ++e) a[e] += t[e]; }
#pragma unroll
                for (int e = 0; e < 8; ++e) v[j][e] = v[j][e] * ALPHA + (g[e] + 1.0f) * rw * a[e]; }
        }
        if (do_ln) {
            float s = 0.f;
#pragma unroll
            for (int j = 0; j < 2; ++j)
#pragma unroll
                for (int e = 0; e < 8; ++e) s += v[j][e];
            const float mean = wave_sum(s) * (1.f / D); float s2 = 0.f;
#pragma unroll
            for (int j = 0; j < 2; ++j)
#pragma unroll
                for (int e = 0; e < 8; ++e) { v[j][e] -= mean; s2 += v[j][e] * v[j][e]; }
            const float rstd = 1.f / sqrtf(wave_sum(s2) * (1.f / D) + LN_EPS);
#pragma unroll
            for (int j = 0; j < 2; ++j) { const int c0 = 8 * (lane + 64 * j); float g[8], b[8]; ld8(g, lg + c0); ld8(b, lb + c0);
#pragma unroll
                for (int e = 0; e < 8; ++e) v[j][e] = v[j][e] * rstd * g[e] + b[e];
                if (fin) { float* o = F.out + O_Y + (size_t)r * D + c0; *(f32x4*)o = (f32x4){v[j][0], v[j][1], v[j][2], v[j][3]}; *(f32x4*)(o + 4) = (f32x4){v[j][4], v[j][5], v[j][6], v[j][7]}; }
                else *(v4u*)(XB + (size_t)r * D + c0) = pk8(v[j]); }
        }
        if (mode != 2) {
            const int mr = pg8::mod_row(r);
            const float* sh = mod + ((size_t)(lm * NSEQ + mr) * 9 + js) * 1024; const float* sc = sh + 1024;
            int t, len, b; if (r < MP) { t = r & (PSEQ - 1); len = PSEQ; b = r >> 11; } else { t = (r - MP) & (SSEQ - 1); len = SSEQ; b = (r - MP) >> 3; }
#pragma unroll
            for (int j = 0; j < 2; ++j) { const int c0 = 8 * (lane + 64 * j); float s8[8], h8[8], h[8]; ld8(s8, sc + c0); ld8(h8, sh + c0);
#pragma unroll
                for (int e = 0; e < 8; ++e) h[e] = v[j][e] * (s8[e] + 1.0f) + h8[e];
                const v4u w = pk8(h);
                if (mode == 0) *(v4u*)(H + (size_t)r * D + c0) = w;
                else {
                    *(v4u*)(A2 + (size_t)r * 2048 + c0) = w;
                    if (t + 1 < len) *(v4u*)(A2 + (size_t)(r + 1) * 2048 + 1024 + c0) = w;
                    if (t == 0) { v4u p; p.x = 0u; p.y = 0u; p.z = 0u; p.w = 0u;
                        if (r >= MP) { float q[8]; ld8(q, AR.in[I_SSH] + (size_t)b * D + c0); p = pk8(q); }
                        *(v4u*)(A2 + (size_t)r * 2048 + 1024 + c0) = p; }
                    if (t == len - 1) { float* o = F.out + (r < MP ? O_PSH : O_SSH) + (size_t)b * D + c0; *(f32x4*)o = (f32x4){h[0], h[1], h[2], h[3]}; *(f32x4*)(o + 4) = (f32x4){h[4], h[5], h[6], h[7]}; }
                } }
        }
    }
}

DI float log_sigmoid(float x) { return -(fmaxf(-x, 0.f) + log1pf(__expf(-fabsf(x)))); }
DI float gelu_tanh(float x) { const float u = 0.7978845608f * (x + 0.044715f * x * x * x); return 0.5f * x * (1.0f + pg8::ftanh(u)); }

DI void ml1_prompt(Frame& F, const Args& AR) {
    const bf16* Z = (const bf16*)(F.ws + WS_Z);
    float* CST = (float*)(F.ws + WS_CST); float* NST = (float*)(F.ws + WS_NST); float* MST = (float*)(F.ws + WS_MST);
    LAS bf16* Ks = (LAS bf16*)F.lds;
    LAS bf16* Vs = (LAS bf16*)(F.lds + 32768);
    LAS float* LF = (LAS float*)(F.lds + 65536);
    LAS float* GS = (LAS float*)(F.lds + 65536 + 512);
    LAS float* RED = (LAS float*)(F.lds + 65536 + 1024);
    const int tid = F.tid, lane = F.lane, wave = F.wave, r = lane & 31, hh = lane >> 5;
    for (int item = F.vcu; item < 512; item += F.G) {
        const int b = item >> 6, h = (item >> 4) & 3, c = item & 15; const size_t row0 = (size_t)b * PSEQ + c * 128;
#pragma unroll
        for (int i = 0; i < 4; ++i) { const int e = tid + i * NTHREADS, s = e >> 4, c8 = (e & 15) * 8;
            *(LAS v4u*)(Ks + s * 128 + c8) = *(const v4u*)(Z + (row0 + s) * ZW + ZK + h * 128 + c8);
            *(LAS v4u*)(Vs + s * 128 + c8) = *(const v4u*)(Z + (row0 + s) * ZW + ZV + h * 128 + c8); }
        if (tid < 128) { const float fg = bf2f(Z[(row0 + tid) * ZW + ZFG + h]); LF[tid] = log_sigmoid(fg + AR.in[I_BG][4 + h]); }
        __syncthreads();
        if (tid < 128) { float bs = 0.f; for (int s = 0; s <= tid; ++s) bs += LF[s];
            const float ig = bf2f(Z[(row0 + tid) * ZW + ZIG + h]) + AR.in[I_BG][h];
            GS[tid] = ig - bs; if (tid == 127) RED[0] = bs; }
        __syncthreads();
        float gmax = -INFINITY; for (int s = 0; s < 128; ++s) gmax = fmaxf(gmax, GS[s]);
        const float bL = RED[0];
        __syncthreads();
        if (tid < 128) GS[tid] = fexp(GS[tid] - gmax);
        __syncthreads();
        const int vb = wave >> 1, kb0 = 2 * (wave & 1);
        f32x16 acc[2];
#pragma unroll
        for (int i = 0; i < 16; ++i) { acc[0][i] = 0.f; acc[1][i] = 0.f; }
#pragma unroll 2
        for (int ks = 0; ks < 8; ++ks) { const int s0 = 16 * ks + 8 * hh;
            float a[8];
#pragma unroll
            for (int j = 0; j < 8; ++j) a[j] = bf2f(Vs[(s0 + j) * 128 + vb * 32 + r]) * GS[s0 + j];
            const bf16x8 A = pack8(a);
#pragma unroll
            for (int q = 0; q < 2; ++q) { unsigned kw[8];
#pragma unroll
                for (int j = 0; j < 8; ++j) kw[j] = Ks[(s0 + j) * 128 + (kb0 + q) * 32 + r];
                const bf16x8 B = mk_frag(kw[0] | (kw[1] << 16), kw[2] | (kw[3] << 16), kw[4] | (kw[5] << 16), kw[6] | (kw[7] << 16));
                acc[q] = MFMA32(A, B, acc[q]); } }
        float* Co = CST + (size_t)item * 16384;
#pragma unroll
        for (int q = 0; q < 2; ++q)
#pragma unroll
            for (int i = 0; i < 16; ++i) Co[(vb * 32 + crow(i, hh)) * 128 + (kb0 + q) * 32 + r] = acc[q][i] * MSCALE;
        if (tid < 128) { float n = 0.f; for (int s = 0; s < 128; ++s) n += GS[s] * bf2f(Ks[s * 128 + tid]); NST[item * 128 + tid] = n * MSCALE; }
        if (tid == 0) { MST[item * 4 + 0] = bL + gmax; MST[item * 4 + 1] = bL; }
        __syncthreads();
    }
}

DI void ml_sample(Frame& F, const Args& AR) {
    const bf16* Z = (const bf16*)(F.ws + WS_Z); bf16* G = (bf16*)(F.ws + WS_H);
    LAS float* Qs = (LAS float*)F.lds;
    LAS float* Ks = Qs + 1024; LAS float* Vs = Ks + 1024;
    LAS float* HT = Vs + 1024;
    LAS float* P = HT + 1024;
    LAS float* GT = P + 64;
    LAS float* SC = GT + 64;
    const int tid = F.tid, lane = F.lane, wave = F.wave;
    const float* C0g = AR.in[I_SMC]; const float* n0g = AR.in[I_SMN]; const float* m0g = AR.in[I_SMM];
    for (int item = F.vcu; item < 512; item += F.G) {
        const int b = item >> 2, h = item & 3; const size_t row0 = (size_t)MP + (size_t)b * SSEQ;
        for (int e = tid; e < 3 * 512; e += NTHREADS) { const int w = e >> 9, t = (e >> 6) & 7, c2 = (e & 63) * 2;
            const unsigned u = *(const unsigned*)(Z + (row0 + t) * ZW + (w == 0 ? ZQ : (w == 1 ? ZK : ZV)) + h * 128 + c2);
            LAS float* dst = (w == 0 ? Qs : (w == 1 ? Ks : Vs)) + t * 128 + c2; dst[0] = bflo(u); dst[1] = bfhi(u); }
        const float m0 = m0g[b * 4 + h];
        if (tid < 16) { const int t = tid & 7; const float zv = bf2f(Z[(row0 + t) * ZW + (tid < 8 ? ZIG : ZFG) + h]);
            if (tid < 8) P[t] = zv + AR.in[I_BG][h]; else GT[7 * 8 + t] = log_sigmoid(zv + AR.in[I_BG][4 + h]); }
        __syncthreads();
        if (tid < 8) { float bs = 0.f, mx = m0, bsl = 0.f, gme = 0.f;
            for (int s = 0; s < 8; ++s) { bs += GT[7 * 8 + s]; const float g = P[s] - bs; if (s <= tid) { mx = fmaxf(mx, g); bsl = bs; } if (s == tid) gme = g; }
            GT[0 * 8 + tid] = bsl; GT[1 * 8 + tid] = gme; GT[2 * 8 + tid] = mx; GT[3 * 8 + tid] = fexp(m0 - mx);
            if (tid == 7) { const float mend = bsl + mx; SC[0] = mend; SC[1] = fexp(bsl + m0 - mend); } }
        __syncthreads();
        if (tid < 8) { const float mend = SC[0]; GT[5 * 8 + tid] = fexp(GT[0 * 8 + 7] + GT[1 * 8 + tid] - mend); }
        if (tid < 64) { const int t = tid >> 3, s = tid & 7; float d = 0.f;
            if (s <= t) { for (int k = 0; k < 128; ++k) d += Qs[t * 128 + k] * Ks[s * 128 + k]; d = d * MSCALE * fexp(GT[1 * 8 + s] - GT[2 * 8 + t]); }
            P[t * 8 + s] = d; }
        else if (tid < 72) { const int t = tid - 64; float d = 0.f; for (int k = 0; k < 128; ++k) d += Qs[t * 128 + k] * n0g[(size_t)(b * 4 + h) * 128 + k]; GT[6 * 8 + t] = d; }
        __syncthreads();
        if (tid < 8) { float d = 0.f; for (int s = 0; s < 8; ++s) d += P[tid * 8 + s]; d += GT[3 * 8 + tid] * GT[6 * 8 + tid];
            const float mt = GT[0 * 8 + tid] + GT[2 * 8 + tid]; GT[4 * 8 + tid] = fmaxf(fabsf(d), fexp(-mt)); }
        const int v = tid >> 2, seg = tid & 3;
        const float* C0p = C0g + ((size_t)(b * 4 + h) * 128 + v) * 128 + seg * 32;
        float c0[32];
#pragma unroll
        for (int i = 0; i < 8; ++i) { const f32x4 q = *(const f32x4*)(C0p + 4 * i); c0[4 * i] = q.x; c0[4 * i + 1] = q.y; c0[4 * i + 2] = q.z; c0[4 * i + 3] = q.w; }
        __syncthreads();
        float inter[8];
#pragma unroll
        for (int t = 0; t < 8; ++t) { float d = 0.f;
#pragma unroll
            for (int i = 0; i < 32; ++i) d += c0[i] * Qs[t * 128 + seg * 32 + i];
            d += __shfl_xor(d, 1); d += __shfl_xor(d, 2); inter[t] = d; }
        if (seg == 0) {
#pragma unroll
            for (int t = 0; t < 8; ++t) { float num = GT[3 * 8 + t] * inter[t];
                for (int s = 0; s <= t; ++s) num += P[t * 8 + s] * Vs[s * 128 + v];
                HT[t * 128 + v] = num / GT[4 * 8 + t]; } }
        { const float wst = SC[1]; float* Cout = F.out + O_SMC + ((size_t)(b * 4 + h) * 128 + v) * 128 + seg * 32;
#pragma unroll
            for (int i = 0; i < 32; ++i) c0[i] *= wst;
#pragma unroll
            for (int s = 0; s < 8; ++s) { const float wv = GT[5 * 8 + s] * Vs[s * 128 + v] * MSCALE;
#pragma unroll
                for (int i = 0; i < 32; ++i) c0[i] += wv * Ks[s * 128 + seg * 32 + i]; }
#pragma unroll
            for (int i = 0; i < 8; ++i) { f32x4 q; q.x = c0[4 * i]; q.y = c0[4 * i + 1]; q.z = c0[4 * i + 2]; q.w = c0[4 * i + 3]; *(f32x4*)(Cout + 4 * i) = q; } }
        if (tid < 128) { float n = SC[1] * n0g[(size_t)(b * 4 + h) * 128 + tid];
            for (int s = 0; s < 8; ++s) n += GT[5 * 8 + s] * Ks[s * 128 + tid] * MSCALE;
            F.out[O_SMN + (size_t)(b * 4 + h) * 128 + tid] = n; }
        if (tid == 0) F.out[O_SMM + b * 4 + h] = SC[0];
        __syncthreads();
        { const int t = wave; const float x0 = HT[t * 128 + lane], x1 = HT[t * 128 + 64 + lane];
            const float mean = wave_sum(x0 + x1) * (1.f / 128.f); const float d0 = x0 - mean, d1 = x1 - mean;
            const float rstd = 1.f / sqrtf(wave_sum(d0 * d0 + d1 * d1) * (1.f / 128.f) + HEAD_EPS);
            const size_t row = row0 + t;
            const float o0 = bf2f(Z[row * ZW + ZO + h * 128 + lane]), o1 = bf2f(Z[row * ZW + ZO + h * 128 + 64 + lane]);
            const float g0 = AR.in[I_MNG][h * 128 + lane], g1 = AR.in[I_MNG][h * 128 + 64 + lane];
            G[row * D + h * 128 + lane] = (bf16)f2bf(d0 * rstd * g0 * fsig(o0)); G[row * D + h * 128 + 64 + lane] = (bf16)f2bf(d1 * rstd * g1 * fsig(o1)); }
        __syncthreads();
    }
}

DI void rg1(Frame& F, const Args& AR) {
    const bf16* Z = (const bf16*)(F.ws + WS_Z); bf16* G = (bf16*)(F.ws + WS_H);
    float* RGH = (float*)(F.ws + WS_RGH); float* RGP = (float*)(F.ws + WS_RGP);
    const int lane = F.lane, g = F.wave, r = lane & 31, hh = lane >> 5;
    LAS float* XT = (LAS float*)(F.lds + g * 17408);
    LAS float* AT = XT + 32 * 68;
    const float* wa = AR.in[I_WA] + (size_t)g * 4096; const float* wx = AR.in[I_WX] + (size_t)g * 4096;
    bf16x8 Ba[4][2], Bx[4][2];
    { const GAS float* wab = (const GAS float*)(wa + 8 * hh * 64 + r); const GAS float* wxb = (const GAS float*)(wx + 8 * hh * 64 + r);
#pragma unroll
        for (int ks = 0; ks < 4; ++ks)
#pragma unroll
            for (int cb = 0; cb < 2; ++cb) { float a[8], x[8];
#pragma unroll
                for (int j = 0; j < 8; ++j) { const int i = 16 * ks + j; a[j] = wab[i * 64 + cb * 32]; x[j] = wxb[i * 64 + cb * 32]; }
                Ba[ks][cb] = pack8(a); Bx[ks][cb] = pack8(x); } }
    float spl[2], ba[2], bx[2];
#pragma unroll
    for (int cb = 0; cb < 2; ++cb) { const int c = 64 * g + cb * 32 + r; spl[cb] = -8.0f * log1pf(__expf(-AR.in[I_LAM][c])); ba[cb] = AR.in[I_BA][c]; bx[cb] = AR.in[I_BX][c]; }
    const float* cw = AR.in[I_CW]; const float* cbias = AR.in[I_CB];
    for (int tt = F.vcu; tt < M / 32; tt += F.G) {
        const int R0 = tt * 32, row = R0 + r; const bool samp = R0 >= MP;
        int t, b; if (!samp) { t = row & (PSEQ - 1); b = row >> 11; } else { t = (row - MP) & 7; b = (row - MP) >> 3; }
        bf16x8 Af[4];
#pragma unroll
        for (int ks = 0; ks < 4; ++ks) { const int c0 = 64 * g + 16 * ks + 8 * hh; float xc[8];
            { const f32x4 q0 = *(const f32x4*)(cbias + c0), q1 = *(const f32x4*)(cbias + c0 + 4); xc[0] = q0.x; xc[1] = q0.y; xc[2] = q0.z; xc[3] = q0.w; xc[4] = q1.x; xc[5] = q1.y; xc[6] = q1.z; xc[7] = q1.w; }
#pragma unroll
            for (int tap = 0; tap < 4; ++tap) { const int tp = t + tap - 3; const bool ok = tp >= 0; float xv[8];
                { const v4u q = *(const v4u*)(Z + (size_t)(ok ? row + tap - 3 : row) * ZW + ZXR + c0);
                    xv[0] = bflo(q.x); xv[1] = bfhi(q.x); xv[2] = bflo(q.y); xv[3] = bfhi(q.y); xv[4] = bflo(q.z); xv[5] = bfhi(q.z); xv[6] = bflo(q.w); xv[7] = bfhi(q.w); }
                if (samp) { const float* sp = AR.in[I_SRC] + ((size_t)b * 3 + (ok ? 0 : t + tap)) * 512 + c0; const f32x4 q0 = *(const f32x4*)sp, q1 = *(const f32x4*)(sp + 4);
                    if (!ok) { xv[0] = q0.x; xv[1] = q0.y; xv[2] = q0.z; xv[3] = q0.w; xv[4] = q1.x; xv[5] = q1.y; xv[6] = q1.z; xv[7] = q1.w; } }
                else if (!ok) {
#pragma unroll
                    for (int j = 0; j < 8; ++j) xv[j] = 0.f; }
                const f32x4 w0 = *(const f32x4*)(cw + tap * 512 + c0), w1 = *(const f32x4*)(cw + tap * 512 + c0 + 4);
                xc[0] += w0.x * xv[0]; xc[1] += w0.y * xv[1]; xc[2] += w0.z * xv[2]; xc[3] += w0.w * xv[3]; xc[4] += w1.x * xv[4]; xc[5] += w1.y * xv[5]; xc[6] += w1.z * xv[6]; xc[7] += w1.w * xv[7]; }
            Af[ks] = pack8(xc);
            LAS float* xp = XT + r * 68 + 16 * ks + 8 * hh;
            *(LAS f32x4*)xp = (f32x4){xc[0], xc[1], xc[2], xc[3]}; *(LAS f32x4*)(xp + 4) = (f32x4){xc[4], xc[5], xc[6], xc[7]};
            asm volatile("" ::: "memory"); }
        LDS_WAIT(); asm volatile("" ::: "memory");
#pragma unroll
        for (int cb = 0; cb < 2; ++cb) { f32x16 da, dx;
#pragma unroll
            for (int i = 0; i < 16; ++i) { da[i] = 0.f; dx[i] = 0.f; }
#pragma unroll
            for (int ks = 0; ks < 4; ++ks) { da = MFMA32(Af[ks], Ba[ks][cb], da); dx = MFMA32(Af[ks], Bx[ks][cb], dx); }
#pragma unroll
            for (int i = 0; i < 16; ++i) { const int tr = crow(i, hh), j = cb * 32 + r;
                const float rg = fsig(da[i] + ba[cb]), ig = fsig(dx[i] + bx[cb]);
                const float la = spl[cb] * rg, a = fexp(la), xcv = XT[tr * 68 + j];
                const float u = sqrtf(fmaxf(1.0f - a * a, 0.f)) * ig * xcv;
                AT[tr * 68 + j] = a; XT[tr * 68 + j] = u; } }
        LDS_WAIT(); asm volatile("" ::: "memory");
        { const int c = 64 * g + lane;
            if (!samp) { float h = 0.f, P = 1.f;
#pragma unroll 8
                for (int tr = 0; tr < 32; ++tr) { const float a = AT[tr * 68 + lane], u = XT[tr * 68 + lane]; h = a * h + u; P *= a;
                    RGH[(size_t)(R0 + tr) * 512 + c] = h; RGP[(size_t)(R0 + tr) * 512 + c] = P; } }
            else { float h = 0.f; const int b0 = (R0 - MP) >> 3;
#pragma unroll 8
                for (int tr = 0; tr < 32; ++tr) { const int bb = b0 + (tr >> 3);
                    if ((tr & 7) == 0) h = AR.in[I_SRH][(size_t)bb * 512 + c];
                    const float a = AT[tr * 68 + lane], u = XT[tr * 68 + lane]; h = a * h + u;
                    const float gr = bf2f(Z[(size_t)(R0 + tr) * ZW + ZGR + c]);
                    G[(size_t)(R0 + tr) * D + 512 + c] = (bf16)f2bf(h * gelu_tanh(gr));
                    if ((tr & 7) == 7) F.out[O_SRH + (size_t)bb * 512 + c] = h; } } }
        LDS_WAIT(); asm volatile("" ::: "memory");
    }
    { const int gt = F.vcu * NTHREADS + F.tid, NT = F.G * NTHREADS;
        for (int e = gt; e < NSEQ * 3 * 512; e += NT) { const int c = e & 511, j = (e >> 9) % 3, s = e / 1536;
            if (s < NPB) F.out[O_PRC + ((size_t)s * 3 + j) * 512 + c] = bf2f(Z[((size_t)s * PSEQ + PSEQ - 3 + j) * ZW + ZXR + c]);
            else { const int b = s - NPB; F.out[O_SRC + ((size_t)b * 3 + j) * 512 + c] = bf2f(Z[((size_t)MP + (size_t)b * SSEQ + SSEQ - 3 + j) * ZW + ZXR + c]); } } }
}

DI void ml2_scan(Frame& F, const Args& AR) {
    float* CST = (float*)(F.ws + WS_CST); float* NST = (float*)(F.ws + WS_NST); float* MST = (float*)(F.ws + WS_MST);
    for (int vb = F.vcu; vb < 256; vb += F.G) {
        const int bh = vb >> 3, e0 = ((vb & 7) * NTHREADS + F.tid) * 4;
        float m = 0.f; f32x4 C = (f32x4){0.f, 0.f, 0.f, 0.f};
        const bool nthr = (vb & 7) == 0 && F.tid < 128; float n = 0.f;
        for (int c = 0; c < 16; ++c) { const int item = bh * 16 + c; const float mloc = MST[item * 4 + 0], bL = MST[item * 4 + 1];
            float* cp = CST + (size_t)item * 16384 + e0; const f32x4 cl = *(const f32x4*)cp; *(f32x4*)cp = C;
            const float mn = fmaxf(bL + m, mloc), w0 = fexp(bL + m - mn), w1 = fexp(mloc - mn);
            C = C * w0 + cl * w1;
            if (nthr) { float* np = NST + item * 128 + F.tid; const float nl = *np; *np = n; n = n * w0 + nl * w1; if (F.tid == 0) MST[item * 4 + 2] = m; }
            m = mn; }
        *(f32x4*)(F.out + O_PMC + (size_t)bh * 16384 + e0) = C;
        if (nthr) { F.out[O_PMN + bh * 128 + F.tid] = n; if (F.tid == 0) F.out[O_PMM + bh] = m; }
    }
}
DI void rg2_carry(Frame& F, const Args& AR) {
    const float* RGH = (const float*)(F.ws + WS_RGH); const float* RGP = (const float*)(F.ws + WS_RGP); float* CARRY = (float*)(F.ws + WS_CARRY);
    const int gt = F.vcu * NTHREADS + F.tid, NT = F.G * NTHREADS;
    for (int e = gt; e < NPB * 512; e += NT) { const int b = e >> 9, c = e & 511; float H = 0.f;
        for (int k0 = 0; k0 < 64; k0 += 16) { float pe[16], he[16];
#pragma unroll
            for (int k = 0; k < 16; ++k) { const size_t row = (size_t)b * PSEQ + 32 * (k0 + k) + 31; pe[k] = RGP[row * 512 + c]; he[k] = RGH[row * 512 + c]; }
#pragma unroll
            for (int k = 0; k < 16; ++k) { CARRY[((size_t)b * 64 + k0 + k) * 512 + c] = H; H = pe[k] * H + he[k]; } }
        F.out[O_PRH + (size_t)b * 512 + c] = H; }
}
DI void rg2_apply(Frame& F, const Args& AR) {
    const bf16* Z = (const bf16*)(F.ws + WS_Z); bf16* G = (bf16*)(F.ws + WS_H);
    const float* RGH = (const float*)(F.ws + WS_RGH); const float* RGP = (const float*)(F.ws + WS_RGP); const float* CARRY = (const float*)(F.ws + WS_CARRY);
    const int gt = F.vcu * NTHREADS + F.tid, NT = F.G * NTHREADS;
    for (int e = gt; e < MP * 64; e += NT) { const int row = e >> 6, c0 = (e & 63) * 8, b = row >> 11, tile = (row & (PSEQ - 1)) >> 5;
        const v4u gq = *(const v4u*)(Z + (size_t)row * ZW + ZGR + c0);
        const float gr[8] = {bflo(gq.x), bfhi(gq.x), bflo(gq.y), bfhi(gq.y), bflo(gq.z), bfhi(gq.z), bflo(gq.w), bfhi(gq.w)};
        const float* hp = RGH + (size_t)row * 512 + c0; const float* pp = RGP + (size_t)row * 512 + c0; const float* cp = CARRY + ((size_t)b * 64 + tile) * 512 + c0;
        float o[8];
#pragma unroll
        for (int q = 0; q < 2; ++q) { const f32x4 h4 = *(const f32x4*)(hp + 4 * q), p4 = *(const f32x4*)(pp + 4 * q), c4 = *(const f32x4*)(cp + 4 * q);
            const f32x4 hv = h4 + p4 * c4; o[4 * q] = hv.x * gelu_tanh(gr[4 * q]); o[4 * q + 1] = hv.y * gelu_tanh(gr[4 * q + 1]); o[4 * q + 2] = hv.z * gelu_tanh(gr[4 * q + 2]); o[4 * q + 3] = hv.w * gelu_tanh(gr[4 * q + 3]); }
        v4u w; w.x = pk2(o[0], o[1]); w.y = pk2(o[2], o[3]); w.z = pk2(o[4], o[5]); w.w = pk2(o[6], o[7]);
        *(v4u*)(G + (size_t)row * D + 512 + c0) = w; }
}

DI void ml3_prompt(Frame& F, const Args& AR) {
    const bf16* Z = (const bf16*)(F.ws + WS_Z); bf16* G = (bf16*)(F.ws + WS_H);
    const float* CST = (const float*)(F.ws + WS_CST); const float* NST = (const float*)(F.ws + WS_NST); const float* MST = (const float*)(F.ws + WS_MST);
    LAS bf16* Qs = (LAS bf16*)F.lds;
    LAS bf16* Ks = (LAS bf16*)(F.lds + 34816);
    LAS bf16* Vs = (LAS bf16*)(F.lds + 69632);
    LAS float* LF = (LAS float*)(F.lds + 102400);
    LAS float* BC = LF + 128;
    LAS float* GS = BC + 128;
    LAS float* MX = GS + 128;
    LAS float* N0 = MX + 128;
    LAS float* RA = N0 + 128;
    LAS float* RB = RA + 256;
    LAS float* OT = (LAS float*)F.lds;
    const int tid = F.tid, lane = F.lane, wave = F.wave, r = lane & 31, hh = lane >> 5;
    const int tb = wave >> 1, vh = wave & 1, t = tb * 32 + r;
    for (int item = F.vcu; item < 512; item += F.G) {
        const int b = item >> 6, h = (item >> 4) & 3, c = item & 15; const size_t row0 = (size_t)b * PSEQ + c * 128;
        const float m0 = MST[item * 4 + 2]; const float* C0 = CST + (size_t)item * 16384;
#pragma unroll
        for (int i = 0; i < 4; ++i) { const int e = tid + i * NTHREADS, s = e >> 4, c8 = (e & 15) * 8; const bf16* zr = Z + (row0 + s) * ZW + h * 128 + c8;
            *(LAS v4u*)(Qs + s * 136 + c8) = *(const v4u*)(zr + ZQ); *(LAS v4u*)(Ks + s * 136 + c8) = *(const v4u*)(zr + ZK); *(LAS v4u*)(Vs + s * 128 + c8) = *(const v4u*)(zr + ZV); }
        if (tid < 128) { LF[tid] = log_sigmoid(bf2f(Z[(row0 + tid) * ZW + ZFG + h]) + AR.in[I_BG][4 + h]); N0[tid] = NST[item * 128 + tid]; }
        __syncthreads();
        if (tid < 128) { float bs = 0.f; for (int s = 0; s <= tid; ++s) bs += LF[s];
            BC[tid] = bs; GS[tid] = bf2f(Z[(row0 + tid) * ZW + ZIG + h]) + AR.in[I_BG][h] - bs; }
        __syncthreads();
        if (tid < 128) { float mx = m0; for (int s = 0; s <= tid; ++s) mx = fmaxf(mx, GS[s]); MX[tid] = mx; }
        __syncthreads();
        const float mxt = MX[t], winter = fexp(m0 - mxt);
        bf16x8 bq[8];
#pragma unroll
        for (int ks = 0; ks < 8; ++ks) bq[ks] = *(const LAS bf16x8*)(Qs + t * 136 + 16 * ks + 8 * hh);
        bf16x8 pp[4][2]; float den = 0.f;
#pragma unroll
        for (int sb = 0; sb < 4; ++sb) {
            if (sb <= tb) { f32x16 sa;
#pragma unroll
                for (int i = 0; i < 16; ++i) sa[i] = 0.f;
#pragma unroll
                for (int ks = 0; ks < 8; ++ks) sa = MFMA32(*(const LAS bf16x8*)(Ks + (sb * 32 + r) * 136 + 16 * ks + 8 * hh), bq[ks], sa);
                float pv[16];
#pragma unroll
                for (int i = 0; i < 16; ++i) { const int s = sb * 32 + crow(i, hh); float v = sa[i] * MSCALE * fexp(GS[s] - mxt); if (s > t) v = 0.f; pv[i] = v; den += v; }
                pp[sb][0] = mk_frag(pk2(pv[0], pv[1]), pk2(pv[2], pv[3]), pk2(pv[4], pv[5]), pk2(pv[6], pv[7]));
                pp[sb][1] = mk_frag(pk2(pv[8], pv[9]), pk2(pv[10], pv[11]), pk2(pv[12], pv[13]), pk2(pv[14], pv[15]));
            } else { pp[sb][0] = mk_frag(0u, 0u, 0u, 0u); pp[sb][1] = mk_frag(0u, 0u, 0u, 0u); } }
        den += __shfl_xor(den, 32);
        float qn = 0.f;
#pragma unroll 8
        for (int k = 0; k < 64; ++k) qn += N0[hh * 64 + k] * bf2f(Qs[t * 136 + hh * 64 + k]);
        qn += __shfl_xor(qn, 32);
        const float dtot = den + winter * qn, denom = fmaxf(fabsf(dtot), fexp(-(BC[t] + mxt))), rden = 1.0f / denom;
        float hv[2][16];
#pragma unroll
        for (int q = 0; q < 2; ++q) { const int vb = vh * 2 + q; f32x16 an, ai;
#pragma unroll
            for (int i = 0; i < 16; ++i) { an[i] = 0.f; ai[i] = 0.f; }
#pragma unroll
            for (int sb = 0; sb < 4; ++sb) if (sb <= tb) {
#pragma unroll
                for (int s2 = 0; s2 < 2; ++s2) { unsigned vw[8];
#pragma unroll
                    for (int j = 0; j < 8; ++j) vw[j] = Vs[(sb * 32 + 16 * s2 + 8 * (j >> 2) + 4 * hh + (j & 3)) * 128 + vb * 32 + r];
                    an = MFMA32(mk_frag(vw[0] | (vw[1] << 16), vw[2] | (vw[3] << 16), vw[4] | (vw[5] << 16), vw[6] | (vw[7] << 16)), pp[sb][s2], an); } }
#pragma unroll
            for (int ks = 0; ks < 8; ++ks) { const float* cp = C0 + (size_t)(vb * 32 + r) * 128 + 16 * ks + 8 * hh; const f32x4 c0 = *(const f32x4*)cp, c1 = *(const f32x4*)(cp + 4);
                ai = MFMA32(mk_frag(pk2(c0.x, c0.y), pk2(c0.z, c0.w), pk2(c1.x, c1.y), pk2(c1.z, c1.w)), bq[ks], ai); }
#pragma unroll
            for (int i = 0; i < 16; ++i) hv[q][i] = (an[i] + winter * ai[i]) * rden; }
        float s1 = 0.f;
#pragma unroll
        for (int q = 0; q < 2; ++q)
#pragma unroll
            for (int i = 0; i < 16; ++i) s1 += hv[q][i];
        s1 += __shfl_xor(s1, 32);
        if (hh == 0) RA[vh * 128 + t] = s1;
        __syncthreads();
        const float mean = (RA[t] + RA[128 + t]) * (1.f / 128.f); float s2 = 0.f;
#pragma unroll
        for (int q = 0; q < 2; ++q)
#pragma unroll
            for (int i = 0; i < 16; ++i) { hv[q][i] -= mean; s2 += hv[q][i] * hv[q][i]; }
        s2 += __shfl_xor(s2, 32);
        if (hh == 0) RB[vh * 128 + t] = s2;
        __syncthreads();
        const float rstd = 1.f / sqrtf((RB[t] + RB[128 + t]) * (1.f / 128.f) + HEAD_EPS);
#pragma unroll
        for (int q = 0; q < 2; ++q)
#pragma unroll
            for (int i = 0; i < 16; ++i) OT[t * 132 + (vh * 2 + q) * 32 + crow(i, hh)] = hv[q][i] * rstd;
        __syncthreads();
        { const int tt = tid >> 2, v0 = (tid & 3) * 32; const size_t row = row0 + tt;
#pragma unroll
            for (int q = 0; q < 4; ++q) { const int v = v0 + 8 * q; const v4u oq = *(const v4u*)(Z + row * ZW + ZO + h * 128 + v);
                const float og[8] = {bflo(oq.x), bfhi(oq.x), bflo(oq.y), bfhi(oq.y), bflo(oq.z), bfhi(oq.z), bflo(oq.w), bfhi(oq.w)};
                const f32x4 g0 = *(const f32x4*)(AR.in[I_MNG] + h * 128 + v), g1 = *(const f32x4*)(AR.in[I_MNG] + h * 128 + v + 4);
                const f32x4 x0 = *(const LAS f32x4*)(OT + tt * 132 + v), x1 = *(const LAS f32x4*)(OT + tt * 132 + v + 4);
                v4u w; w.x = pk2(x0.x * g0.x * fsig(og[0]), x0.y * g0.y * fsig(og[1])); w.y = pk2(x0.z * g0.z * fsig(og[2]), x0.w * g0.w * fsig(og[3]));
                w.z = pk2(x1.x * g1.x * fsig(og[4]), x1.y * g1.y * fsig(og[5])); w.w = pk2(x1.z * g1.z * fsig(og[6]), x1.w * g1.w * fsig(og[7]));
                *(v4u*)(G + row * D + h * 128 + v) = w; } }
        __syncthreads();
    }
}

constexpr int TC = 32;
constexpr int RW_ARR = TC * 64;
constexpr int RW_BUF_FLOATS = 6 * RW_ARR + 2 * TC;
template <int CTRL> DI float dpp_add(float x) {
    const int xi = __builtin_bit_cast(int, x);
    const int yi = __builtin_amdgcn_update_dpp(xi, xi, CTRL, 0xF, 0xF, false);
    return x + __builtin_bit_cast(float, yi);
}
DI float sum8(float x) { x = dpp_add<0xB1>(x); x = dpp_add<0x4E>(x); x = dpp_add<0x141>(x); return x; }
DI float sum16(float x) { x = sum8(x); x = dpp_add<0x140>(x); return x; }
struct RwRaw { v2u r, k, v, w, a, g; };
DI void rw_load(RwRaw& x, const bf16* RK, const bf16* WAG, size_t row, size_t row_safe, int h, int k4, bool valid) {
    const size_t rr = valid ? row : row_safe;
    const bf16* p = RK + rr * RKW + h * 64 + k4; const bf16* q = WAG + rr * WAGW + h * 64 + k4;
    x.r = *(const v2u*)p; x.k = *(const v2u*)(p + 1024); x.v = *(const v2u*)(p + 2048); x.w = *(const v2u*)q; x.a = *(const v2u*)(q + 1024); x.g = *(const v2u*)(q + 2048);
}
DI void un4(const v2u u, float (&f)[4]) { f[0] = bflo(u.x); f[1] = bfhi(u.x); f[2] = bflo(u.y); f[3] = bfhi(u.y); }
DI float rw_prep(const RwRaw& x, LAS float* buf, int tok, int k4, const float (&kkw)[4], const float (&kaw)[4], const float (&rkw)[4]) {
    float r[4], k[4], v[4], w[4], a[4]; un4(x.r, r); un4(x.k, k); un4(x.v, v); un4(x.w, w); un4(x.a, a);
    float kk[4], ss = 0.f, bs = 0.f, km[4];
#pragma unroll
    for (int j = 0; j < 4; ++j) { kk[j] = k[j] * kkw[j]; ss += kk[j] * kk[j]; km[j] = k[j] * (1.0f + (a[j] - 1.0f) * kaw[j]); bs += r[j] * km[j] * rkw[j]; }
    ss = sum16(ss); bs = sum16(bs);
    const float inv = 1.0f / fmaxf(sqrtf(ss), 1e-12f);
    f32x4 o0, o1, o2, o3, o4, o5; float br = 0.f, kr = 0.f;
#pragma unroll
    for (int j = 0; j < 4; ++j) { const float kn = kk[j] * inv, dc = __builtin_amdgcn_exp2f(w[j]); o0[j] = kn; o1[j] = kn * a[j]; o2[j] = km[j]; o3[j] = dc; o4[j] = dc * r[j]; o5[j] = v[j];
        br += kn * a[j] * r[j]; kr += km[j] * r[j]; }
    br = sum16(br); kr = sum16(kr);
    LAS float* p = buf + tok * 64 + k4;
    *(LAS f32x4*)p = o0; *(LAS f32x4*)(p + RW_ARR) = o1; *(LAS f32x4*)(p + 2 * RW_ARR) = o2; *(LAS f32x4*)(p + 3 * RW_ARR) = o3;
    *(LAS f32x4*)(p + 4 * RW_ARR) = o4; *(LAS f32x4*)(p + 5 * RW_ARR) = o5;
    if (k4 == 0) *(LAS f32x2*)(buf + 6 * RW_ARR + 2 * tok) = (f32x2){br, kr};
    return bs;
}
#define BAR_LDS() do { asm volatile("s_waitcnt lgkmcnt(0)" ::: "memory"); __builtin_amdgcn_s_barrier(); asm volatile("" ::: "memory"); } while (0)
#define NOPK(x) asm volatile("" : "+v"(x))
DI void sum8x2(float& a, float& b) {
    asm volatile("s_nop 1\n\t"
                 "v_add_f32_dpp %0, %0, %0 quad_perm:[1,0,3,2] row_mask:0xf bank_mask:0xf\n\tv_add_f32_dpp %1, %1, %1 quad_perm:[1,0,3,2] row_mask:0xf bank_mask:0xf\n\ts_nop 0\n\t"
                 "v_add_f32_dpp %0, %0, %0 quad_perm:[2,3,0,1] row_mask:0xf bank_mask:0xf\n\tv_add_f32_dpp %1, %1, %1 quad_perm:[2,3,0,1] row_mask:0xf bank_mask:0xf\n\ts_nop 0\n\t"
                 "v_add_f32_dpp %0, %0, %0 row_half_mirror row_mask:0xf bank_mask:0xf\n\tv_add_f32_dpp %1, %1, %1 row_half_mirror row_mask:0xf bank_mask:0xf\n\ts_nop 0"
                 : "+v"(a), "+v"(b));
}
struct StepV { f32x4 ka, kb, ba, bb, ma, mb, da, db, ea, eb; float vv; f32x2 sc; };
DI void ld_step(StepV& s, const LAS float* cur, int tk, int p, int row) {
    const LAS float* q = cur + tk * 64 + 8 * p;
    s.ka = *(const LAS f32x4*)q; s.kb = *(const LAS f32x4*)(q + 4); s.ba = *(const LAS f32x4*)(q + RW_ARR); s.bb = *(const LAS f32x4*)(q + RW_ARR + 4);
    s.ma = *(const LAS f32x4*)(q + 2 * RW_ARR); s.mb = *(const LAS f32x4*)(q + 2 * RW_ARR + 4); s.da = *(const LAS f32x4*)(q + 3 * RW_ARR); s.db = *(const LAS f32x4*)(q + 3 * RW_ARR + 4);
    s.ea = *(const LAS f32x4*)(q + 4 * RW_ARR); s.eb = *(const LAS f32x4*)(q + 4 * RW_ARR + 4);
    s.vv = cur[5 * RW_ARR + tk * 64 + row]; s.sc = *(const LAS f32x2*)(cur + 6 * RW_ARR + 2 * tk);
}
DI void ld_step_asm(StepV& s, unsigned aq, unsigned av, unsigned asc) {
    asm volatile("ds_read_b128 %0, %12\n\tds_read_b128 %1, %12 offset:16\n\tds_read_b128 %2, %12 offset:8192\n\tds_read_b128 %3, %12 offset:8208\n\t"
                 "ds_read_b128 %4, %12 offset:16384\n\tds_read_b128 %5, %12 offset:16400\n\tds_read_b128 %6, %12 offset:24576\n\tds_read_b128 %7, %12 offset:24592\n\t"
                 "ds_read_b128 %8, %12 offset:32768\n\tds_read_b128 %9, %12 offset:32784\n\tds_read_b32 %10, %13\n\tds_read_b64 %11, %14"
                 : "=&v"(s.ka), "=&v"(s.kb), "=&v"(s.ba), "=&v"(s.bb), "=&v"(s.ma), "=&v"(s.mb), "=&v"(s.da), "=&v"(s.db), "=&v"(s.ea), "=&v"(s.eb), "=&v"(s.vv), "=&v"(s.sc)
                 : "v"(aq), "v"(av), "v"(asc) : "memory");
}
DI void wait_step(StepV& s) {
    asm volatile("s_waitcnt lgkmcnt(0)" : "+v"(s.ka), "+v"(s.kb), "+v"(s.ba), "+v"(s.bb), "+v"(s.ma), "+v"(s.mb), "+v"(s.da), "+v"(s.db), "+v"(s.ea), "+v"(s.eb), "+v"(s.vv), "+v"(s.sc) :: "memory");
}
DI void wait_step1(StepV& s) {
    asm volatile("s_waitcnt lgkmcnt(1)" : "+v"(s.ka), "+v"(s.kb), "+v"(s.ba), "+v"(s.bb), "+v"(s.ma), "+v"(s.mb), "+v"(s.da), "+v"(s.db), "+v"(s.ea), "+v"(s.eb), "+v"(s.vv), "+v"(s.sc) :: "memory");
}
DI void rw_step(float (&S)[8], const StepV& c, LAS float* ydst, bool wr) {
    const float kk[8] = {c.ka.x, c.ka.y, c.ka.z, c.ka.w, c.kb.x, c.kb.y, c.kb.z, c.kb.w}, ee[8] = {c.ea.x, c.ea.y, c.ea.z, c.ea.w, c.eb.x, c.eb.y, c.eb.z, c.eb.w};
    const float dd[8] = {c.da.x, c.da.y, c.da.z, c.da.w, c.db.x, c.db.y, c.db.z, c.db.w}, bb[8] = {c.ba.x, c.ba.y, c.ba.z, c.ba.w, c.bb.x, c.bb.y, c.bb.z, c.bb.w};
    const float mm[8] = {c.ma.x, c.ma.y, c.ma.z, c.ma.w, c.mb.x, c.mb.y, c.mb.z, c.mb.w};
    float a0 = S[0] * kk[0], a1 = S[4] * kk[4], y0 = S[0] * ee[0], y1 = S[4] * ee[4];
#pragma unroll
    for (int j = 1; j < 4; ++j) { a0 = fmaf(S[j], kk[j], a0); a1 = fmaf(S[4 + j], kk[4 + j], a1); y0 = fmaf(S[j], ee[j], y0); y1 = fmaf(S[4 + j], ee[4 + j], y1); }
    float a = a0 + a1, y = y0 + y1; NOPK(a); NOPK(y);
    sum8x2(a, y);
    const float sa = -a, v = c.vv;
#pragma unroll
    for (int j = 0; j < 8; ++j) { float t = S[j] * dd[j]; t = fmaf(mm[j], v, t); t = fmaf(bb[j], sa, t); NOPK(t); S[j] = t; }
    if (wr) *ydst = fmaf(v, c.sc.y, fmaf(sa, c.sc.x, y));
    asm volatile("" ::: "memory");
}
DI void rw_prompt_half(Frame& F, const Args& AR, int b, int h, int half, float* Sout) {
    const bf16* RK = (const bf16*)(F.ws + WS_RK); const bf16* WAG = (const bf16*)(F.ws + WS_WAG); bf16* G = (bf16*)(F.ws + WS_H); float* BN = (float*)(F.ws + WS_BN);
    LAS float* BUF = (LAS float*)F.lds;
    LAS float* YB = BUF + 2 * RW_BUF_FLOATS;
    const int tid = F.tid; const size_t row0 = (size_t)b * PSEQ;
    constexpr int nch = PSEQ / TC;
    if (tid < 256) {
        const int rl = tid >> 3, row = 32 * half + rl, p = tid & 7;
        float S[8];
#pragma unroll
        for (int j = 0; j < 8; ++j) S[j] = 0.f;
#ifdef PROBE_SHADOW
        float S2[8];
#pragma unroll
        for (int j = 0; j < 8; ++j) S2[j] = 1.f;
#endif
        BAR_LDS();
        for (int ch = 0; ch < nch; ++ch) {
            const LAS float* cur = BUF + (ch & 1) * RW_BUF_FLOATS; LAS float* yb = YB + (ch & 1) * (TC * 32);
            const unsigned cb = (unsigned)(size_t)cur; unsigned aq = cb + 32u * p, av = cb + 40960u + 4u * row, asc = cb + 49152u;
            StepV A, B; ld_step_asm(A, aq, av, asc); wait_step(A);
#pragma unroll 1
            for (int tk = 0; tk < TC; tk += 2) {
                ld_step_asm(B, aq + 256u, av + 256u, asc + 8u);
                rw_step(S, A, yb + tk * 32 + rl, p == 0);
#ifdef PROBE_SHADOW
                rw_step(S2, A, yb, false);
#endif
                wait_step1(B);
                aq += 512u; av += 512u; asc += 16u;
                const unsigned back = (tk + 2 < TC) ? 0u : 256u;
                ld_step_asm(A, aq - back, av - back, asc - (back >> 5));
                rw_step(S, B, yb + (tk + 1) * 32 + rl, p == 0);
#ifdef PROBE_SHADOW
                rw_step(S2, B, yb, false);
#endif
                wait_step1(A);
            }
            BAR_LDS();
        }
#ifdef PROBE_SHADOW
#pragma unroll
        for (int j = 0; j < 8; ++j) asm volatile("" :: "v"(S2[j]));
#endif
        *(f32x4*)(Sout + row * 64 + 8 * p) = (f32x4){S[0], S[1], S[2], S[3]}; *(f32x4*)(Sout + row * 64 + 8 * p + 4) = (f32x4){S[4], S[5], S[6], S[7]};
        BAR_LDS();
    } else {
        const int ht = tid - 256, tk0 = ht >> 4, k4 = (ht & 15) * 4;
        const int yt = ht >> 3, yv4 = (ht & 7) * 4;
        float kkw[4], kaw[4], rkw[4];
#pragma unroll
        for (int j = 0; j < 4; ++j) { const int c = h * 64 + k4 + j; kkw[j] = AR.in[I_KK][c]; kaw[j] = AR.in[I_KA][c]; rkw[j] = AR.in[I_RK][c]; }
        RwRaw raw[2];
#pragma unroll
        for (int i = 0; i < 2; ++i) { rw_load(raw[i], RK, WAG, row0 + tk0 + 16 * i, row0, h, k4, true);
            const float bn = rw_prep(raw[i], BUF, tk0 + 16 * i, k4, kkw, kaw, rkw); if (half == 0 && k4 == 0) BN[(row0 + tk0 + 16 * i) * 16 + h] = bn; }
#pragma unroll
        for (int i = 0; i < 2; ++i) rw_load(raw[i], RK, WAG, row0 + TC + tk0 + 16 * i, row0, h, k4, true);
        BAR_LDS();
        for (int ch = 0; ch < nch; ++ch) {
            const int base = ch * TC;
            if (ch > 0) { const f32x4 y4 = *(const LAS f32x4*)(YB + ((ch - 1) & 1) * (TC * 32) + yt * 32 + yv4);
                v2u w; w.x = pk2(y4.x, y4.y); w.y = pk2(y4.z, y4.w); *(v2u*)(G + (row0 + base - TC + yt) * D + h * 64 + 32 * half + yv4) = w; }
            if (ch + 1 < nch) {
#pragma unroll
                for (int i = 0; i < 2; ++i) { const float bn = rw_prep(raw[i], BUF + ((ch + 1) & 1) * RW_BUF_FLOATS, tk0 + 16 * i, k4, kkw, kaw, rkw);
                    if (half == 0 && k4 == 0) BN[(row0 + base + TC + tk0 + 16 * i) * 16 + h] = bn; }
#pragma unroll
                for (int i = 0; i < 2; ++i) rw_load(raw[i], RK, WAG, row0 + base + 2 * TC + tk0 + 16 * i, row0, h, k4, base + 2 * TC < PSEQ);
            }
            BAR_LDS();
        }
        { const f32x4 y4 = *(const LAS f32x4*)(YB + ((nch - 1) & 1) * (TC * 32) + yt * 32 + yv4);
            v2u w; w.x = pk2(y4.x, y4.y); w.y = pk2(y4.z, y4.w); *(v2u*)(G + (row0 + PSEQ - TC + yt) * D + h * 64 + 32 * half + yv4) = w; }
        BAR_LDS();
    }
}
DI void rw_gn_pass(Frame& F, const Args& AR) {
    const bf16* RK = (const bf16*)(F.ws + WS_RK); const bf16* WAG = (const bf16*)(F.ws + WS_WAG); bf16* G = (bf16*)(F.ws + WS_H); const float* BN = (const float*)(F.ws + WS_BN);
    const int gt = F.vcu * NTHREADS + F.tid, NT = F.G * NTHREADS;
    for (int e = gt; e < MP * 256; e += NT) { const int row = e >> 8, h = (e >> 4) & 15, k4 = (e & 15) * 4, c = h * 64 + k4;
        bf16* gp = G + (size_t)row * D + c; float y[4], v[4], g[4]; un4(*(const v2u*)gp, y); un4(*(const v2u*)(RK + (size_t)row * RKW + 2048 + c), v); un4(*(const v2u*)(WAG + (size_t)row * WAGW + 2048 + c), g);
        const f32x4 lg = *(const f32x4*)(AR.in[I_LXG] + c), lb = *(const f32x4*)(AR.in[I_LXB] + c); const float bn = BN[row * 16 + h];
        const float mean = sum16((y[0] + y[1]) + (y[2] + y[3])) * (1.f / 64.f);
        const float d0 = y[0] - mean, d1 = y[1] - mean, d2 = y[2] - mean, d3 = y[3] - mean;
        const float rstd = __builtin_amdgcn_rsqf(sum16((d0 * d0 + d1 * d1) + (d2 * d2 + d3 * d3)) * (1.f / 64.f) + RW_EPS);
        v2u w; w.x = pk2((d0 * rstd * lg.x + lb.x + bn * v[0]) * g[0], (d1 * rstd * lg.y + lb.y + bn * v[1]) * g[1]);
        w.y = pk2((d2 * rstd * lg.z + lb.z + bn * v[2]) * g[2], (d3 * rstd * lg.w + lb.w + bn * v[3]) * g[3]);
        *(v2u*)gp = w; }
}
constexpr int RS_WAVE_BYTES = 16640;
DI void ld8b(float (&f)[8], const bf16* p) { const v4u q = *(const v4u*)p; f[0] = bflo(q.x); f[1] = bfhi(q.x); f[2] = bflo(q.y); f[3] = bfhi(q.y); f[4] = bflo(q.z); f[5] = bfhi(q.z); f[6] = bflo(q.w); f[7] = bfhi(q.w); }
DI void st8(LAS float* p, const float (&f)[8]) { *(LAS f32x4*)p = (f32x4){f[0], f[1], f[2], f[3]}; *(LAS f32x4*)(p + 4) = (f32x4){f[4], f[5], f[6], f[7]}; }
DI void rw_sample_wave(Frame& F, const Args& AR, int item) {
    const bf16* RK = (const bf16*)(F.ws + WS_RK); const bf16* WAG = (const bf16*)(F.ws + WS_WAG); bf16* G = (bf16*)(F.ws + WS_H);
    const int lane = F.lane, b = item >> 4, h = item & 15; const size_t row0 = (size_t)MP + (size_t)b * SSEQ;
    LAS float* L = (LAS float*)(F.lds + F.wave * RS_WAVE_BYTES);
    { const int tok = lane >> 3, k8 = (lane & 7) * 8, c = h * 64 + k8;
        float r[8], k[8], v[8], w[8], a[8], g[8];
        { const bf16* p = RK + (row0 + tok) * RKW + c; const bf16* q = WAG + (row0 + tok) * WAGW + c; ld8b(r, p); ld8b(k, p + 1024); ld8b(v, p + 2048); ld8b(w, q); ld8b(a, q + 1024); ld8b(g, q + 2048); }
        float kkw[8], kaw[8], rkw[8]; ld8(kkw, AR.in[I_KK] + c); ld8(kaw, AR.in[I_KA] + c); ld8(rkw, AR.in[I_RK] + c);
        float kk[8], km[8], ss = 0.f, bs = 0.f;
#pragma unroll
        for (int j = 0; j < 8; ++j) { kk[j] = k[j] * kkw[j]; ss += kk[j] * kk[j]; km[j] = k[j] * (1.0f + (a[j] - 1.0f) * kaw[j]); bs += r[j] * km[j] * rkw[j]; }
        ss = sum8(ss); bs = sum8(bs);
        const float inv = 1.0f / fmaxf(sqrtf(ss), 1e-12f);
        float o1[8], o3[8], o4[8], br = 0.f, kr = 0.f;
#pragma unroll
        for (int j = 0; j < 8; ++j) { kk[j] *= inv; o1[j] = kk[j] * a[j]; o3[j] = __builtin_amdgcn_exp2f(w[j]); o4[j] = o3[j] * r[j]; br += o1[j] * r[j]; kr += km[j] * r[j]; }
        br = sum8(br); kr = sum8(kr);
        LAS float* p = L + tok * 64 + k8;
        st8(p, kk); st8(p + 512, o1); st8(p + 1024, km); st8(p + 1536, o3); st8(p + 2048, o4); st8(p + 2560, v); st8(p + 3072, g);
        if (k8 == 0) { L[3584 + 2 * tok] = br; L[3584 + 2 * tok + 1] = kr; L[3600 + tok] = bs; } }
    float S[64];
    { const float* sp = AR.in[I_SWKV] + (size_t)item * 4096 + lane * 64;
#pragma unroll
        for (int j = 0; j < 16; ++j) { const f32x4 q = *(const f32x4*)(sp + 4 * j); S[4 * j] = q.x; S[4 * j + 1] = q.y; S[4 * j + 2] = q.z; S[4 * j + 3] = q.w; } }
    LDS_WAIT(); asm volatile("" ::: "memory");
    LAS float* YS = L + 3616;
#pragma unroll 1
    for (int tk = 0; tk < SSEQ; ++tk) { const LAS float* q = L + tk * 64;
        float a0 = 0.f, a1 = 0.f, y0 = 0.f, y1 = 0.f;
#pragma unroll
        for (int c4 = 0; c4 < 16; ++c4) { const f32x4 kq = *(const LAS f32x4*)(q + 4 * c4), eq = *(const LAS f32x4*)(q + 2048 + 4 * c4);
            a0 = fmaf(S[4 * c4], kq.x, a0); a1 = fmaf(S[4 * c4 + 1], kq.y, a1); a0 = fmaf(S[4 * c4 + 2], kq.z, a0); a1 = fmaf(S[4 * c4 + 3], kq.w, a1);
            y0 = fmaf(S[4 * c4], eq.x, y0); y1 = fmaf(S[4 * c4 + 1], eq.y, y1); y0 = fmaf(S[4 * c4 + 2], eq.z, y0); y1 = fmaf(S[4 * c4 + 3], eq.w, y1); }
        const float sa = -(a0 + a1), v = q[2560 + lane]; const f32x2 sc = *(const LAS f32x2*)(L + 3584 + 2 * tk);
#pragma unroll
        for (int c4 = 0; c4 < 16; ++c4) { const f32x4 dq = *(const LAS f32x4*)(q + 1536 + 4 * c4), bq = *(const LAS f32x4*)(q + 512 + 4 * c4), mq = *(const LAS f32x4*)(q + 1024 + 4 * c4);
            S[4 * c4] = fmaf(bq.x, sa, fmaf(mq.x, v, S[4 * c4] * dq.x)); S[4 * c4 + 1] = fmaf(bq.y, sa, fmaf(mq.y, v, S[4 * c4 + 1] * dq.y));
            S[4 * c4 + 2] = fmaf(bq.z, sa, fmaf(mq.z, v, S[4 * c4 + 2] * dq.z)); S[4 * c4 + 3] = fmaf(bq.w, sa, fmaf(mq.w, v, S[4 * c4 + 3] * dq.w)); }
        YS[tk * 64 + lane] = fmaf(v, sc.y, fmaf(sa, sc.x, y0 + y1)); }
    { float* sp = F.out + O_SWKV + (size_t)item * 4096 + lane * 64;
#pragma unroll
        for (int j = 0; j < 16; ++j) *(f32x4*)(sp + 4 * j) = (f32x4){S[4 * j], S[4 * j + 1], S[4 * j + 2], S[4 * j + 3]}; }
    LDS_WAIT(); asm volatile("" ::: "memory");
    { const float lg = AR.in[I_LXG][h * 64 + lane], lb = AR.in[I_LXB][h * 64 + lane];
#pragma unroll 1
        for (int tk = 0; tk < SSEQ; ++tk) { const float y = YS[tk * 64 + lane];
            const float mean = wave_sum(y) * (1.f / 64.f), d = y - mean, rstd = __builtin_amdgcn_rsqf(wave_sum(d * d) * (1.f / 64.f) + RW_EPS);
            const float o = (d * rstd * lg + lb + L[3600 + tk] * L[2560 + tk * 64 + lane]) * L[3072 + tk * 64 + lane];
            G[(row0 + tk) * D + h * 64 + lane] = (bf16)f2bf(o); } }
    LDS_WAIT(); asm volatile("" ::: "memory");
}
#ifndef PROBE_RW
#define PROBE_RW 0
#endif
DI void rwkv_scan(Frame& F, const Args& AR) {
    for (int rep = 0; rep < (PROBE_RW == 1 ? 2 : 1); ++rep)
    for (int it = F.vcu; it < NPB * 16 * 2; it += F.G) { const int bh = it >> 1, b = bh >> 4, h = bh & 15;
        rw_prompt_half(F, AR, b, h, it & 1, F.out + O_PWKV + (size_t)bh * 4096); }
    __syncthreads();
    for (int rep = 0; rep < (PROBE_RW == 2 ? 2 : 1); ++rep)
    for (int item = F.vcu * NWAVES + F.wave; item < NSB * 16; item += F.G * NWAVES) rw_sample_wave(F, AR, item);
}

#ifndef MK_N_LAUNCHES
#define MK_N_LAUNCHES 1
#endif
#ifdef PROBE_DUP_PH
constexpr int NPHASES = 28;
#else
constexpr int NPHASES = 27;
#endif
enum { K_P0 = 0, K_MODX, K_UP, K_RESID, K_LN, K_WIN, K_MIXA, K_MIXB, K_MIXC, K_R1, K_R2, K_R3, K_MOD, K_R3B };

__global__ void __launch_bounds__(NTHREADS, 2) mega_fwd(Args AR) {
    extern __shared__ __attribute__((aligned(16))) unsigned char lds[];
    Frame F;
    F.lds = (LAS unsigned char*)lds;
    F.MISC = (volatile LAS unsigned*)(F.lds + MISC_OFF);
    F.tid = threadIdx.x; F.lane = F.tid & 63; F.wave = __builtin_amdgcn_readfirstlane(F.tid >> 6);
    F.G = gridDim.x; { const int bx = blockIdx.x; F.vcu = (F.G % 8 == 0) ? (bx % 8) * (F.G / 8) + bx / 8 : bx; }
    F.ws = AR.ws; F.out = AR.out; F.ctl = (gu32*)(AR.ws + WS_CTL);
    for (int u = F.tid; u < (LDS_BYTES - LDSCTL_OFF) / 4; u += NTHREADS) ((LAS unsigned*)(F.lds + LDSCTL_OFF))[u] = 0u;
    __syncthreads();
    const int lo = AR.ph_lo, hi = AR.ph_hi;
    XcdBarrier bar; bar.bar = (unsigned*)(F.ctl + CW_BAR); bar.x = 0; bar.st = nullptr;
    if (hi - lo > 1) bar = xcd_barrier_post((unsigned*)(F.ctl + CW_BAR), F.MISC + 8);

#ifndef PROBE_DUP_PH
#define PROBE_DUP_PH 1000
#endif
    for (int phs = lo; phs < hi; ++phs) {
        const int ph = phs > PROBE_DUP_PH ? phs - 1 : phs; const bool dupfirst = (phs == PROBE_DUP_PH);
        float* X = F.out + O_Y; const float* mod = (const float*)(F.ws + WS_MOD); bf16* H = (bf16*)(F.ws + WS_H);
        int kind = K_LN, f = 0, l = 0, sub = 0, js = 0, first = 0, mode = 0, lm = 0, which = 0, fin = 0;
        switch (ph == 0 ? 0 : (ph == 1 ? 100 : (ph <= 20 ? ph - 1 : (ph == 21 ? 101 : ph - 2)))) {
            case 0: kind = K_P0; break;
            case 100: kind = K_MOD; break;
            case 101: kind = K_R3B; break;
            case 1: kind = K_MODX; break;
            case 2: kind = K_UP; f = 0; break;
            case 3: kind = K_RESID; which = 0; f = 0; l = 0; js = 0; first = 1; break;
            case 4: kind = K_LN; l = 0; sub = 0; lm = 0; js = 3; mode = 0; break;
            case 5: kind = K_WIN; break;
            case 6: kind = K_MIXA; break;
            case 7: kind = K_MIXB; break;
            case 8: kind = K_MIXC; break;
            case 9: kind = K_RESID; which = 1; l = 0; js = 3; break;
            case 10: kind = K_LN; l = 0; sub = 1; lm = 0; js = 6; mode = 0; break;
            case 11: kind = K_UP; f = 1; break;
            case 12: kind = K_RESID; which = 0; f = 1; l = 0; js = 6; break;
            case 13: kind = K_LN; l = 0; sub = 2; lm = 1; js = 0; mode = 0; break;
            case 14: kind = K_UP; f = 2; break;
            case 15: kind = K_RESID; which = 0; f = 2; l = 1; js = 0; break;
            case 16: kind = K_LN; l = 1; sub = 0; lm = 1; js = 3; mode = 1; break;
            case 17: kind = K_R1; break;
            case 18: kind = K_R2; break;
            case 19: kind = K_R3; break;
            case 20: kind = K_RESID; which = 2; l = 1; js = 3; break;
            case 21: kind = K_LN; l = 1; sub = 1; lm = 1; js = 6; mode = 0; break;
            case 22: kind = K_UP; f = 3; break;
            case 23: kind = K_RESID; which = 0; f = 3; l = 1; js = 6; fin = 1; break;
            default: kind = K_LN; l = 1; sub = 2; lm = 1; js = 0; mode = 2; fin = 1; break;
        }
#ifndef PHMASK
#define PHMASK 0xFFFFF
#endif
        { int t_ = F.tid; asm volatile("" : "+v"(t_)); F.tid = t_; F.lane = t_ & 63; F.wave = __builtin_amdgcn_readfirstlane(t_ >> 6);

          int v_ = F.vcu; asm volatile("" : "+s"(v_)); F.vcu = v_; int g_ = F.G; asm volatile("" : "+s"(g_)); F.G = g_;
          unsigned l_ = (unsigned)(size_t)F.lds; asm volatile("" : "+s"(l_)); F.lds = (LAS unsigned char*)(size_t)l_; }
        switch (kind) {
            case K_P0: p0_sctab(F, AR); p0_weights(F, AR); break;
            case K_MOD: p0_mod(F, AR); break;
            case K_MODX: if ((PHMASK >> K_MODX) & 1) ln_pass(F, AR, 1, 0, 0, 0, 0, 0, 0, 0, 0, 0); break;
            case K_UP: if ((PHMASK >> K_UP) & 1) {
                pg8::Gemm g{H, (const bf16*)(F.ws + WS_W13) + (size_t)f * 5632 * 1024, M, 5632, 1024}; pg8::StaticOrder S; S.init(M, 5632, F.G, (int)blockIdx.x); S.ntk = 16;
                pg8::EpiSwiglu E{(bf16*)(F.ws + WS_HID), FF};
                pg8::gemm_phase<pg8::EpiSwiglu, pg8::StaticOrder, true, true>(F.lds, g, S, E, F.tid);
            } break;
            case K_RESID: if ((PHMASK >> K_RESID) & 1) {
                const bf16* A = which == 0 ? (const bf16*)(F.ws + WS_HID) : H; const int K = which == 0 ? FF : 1024;
                const bf16* Bt = which == 0 ? (const bf16*)(F.ws + WS_W2) + (size_t)f * 1024 * FF : (which == 1 ? (const bf16*)(F.ws + WS_WOUT) : (const bf16*)(F.ws + WS_WO));
                const int nsp = (F.G == 256) ? (which == 0 ? 11 : 4) : 0;
                pg8::Gemm g{A, Bt, M, 1024, K}; SplitOrder S; S.base.init(nsp ? MP : M, 1024, F.G, (int)blockIdx.x); S.base.ntk = K / 64; S.S = nsp;
                EpiResid E{AR, F.out, F.ws, (first ? 1 : 0) | (l << 1) | ((js + 2) << 2) | (which == 0 ? 0 : 64) | (dupfirst ? 128 : 0) | (fin ? 256 : 0)};
                pg8::gemm_phase<EpiResid, SplitOrder, true, true>(F.lds, g, S, E, F.tid);
                if (fin && nsp) {
                    const v4u* src = (const v4u*)((unsigned char*)F.out + XB_OFF + (size_t)MP * 2048); v4u* dst = (v4u*)(F.ws + WS_ZF + (size_t)MP * 2048);
                    for (int e = F.vcu * NTHREADS + F.tid; e < MS * 128; e += F.G * NTHREADS) dst[e] = src[e]; }
            } break;
            case K_LN: if ((PHMASK >> K_LN) & 1) ln_pass(F, AR, 0, 1, l, sub, lm, js, mode, (F.G == 256) ? (sub == 1 ? 4 : 11) : 0, ph == 5, fin); break;
            case K_WIN: if ((PHMASK >> K_WIN) & 1) {
                pg8::Gemm g{H, (const bf16*)(F.ws + WS_WIN), M, ZW, 1024}; pg8::StaticOrder S; S.init(M, ZW, F.G, (int)blockIdx.x); S.ntk = 16;
                pg8::EpiStore E{(bf16*)(F.ws + WS_Z), ZW, 1000, nullptr, 0};
                pg8::gemm_phase<pg8::EpiStore, pg8::StaticOrder, true, true>(F.lds, g, S, E, F.tid);
            } break;
            case K_R1: if ((PHMASK >> K_R1) & 1) {
                pg8::Gemm g{(const bf16*)(F.ws + WS_A2), (const bf16*)(F.ws + WS_WRK), M, 3328, 2048}; pg8::StaticOrder S; S.init(M, 3328, F.G, (int)blockIdx.x); S.ntk = 32;
                pg8::EpiStore E{(bf16*)(F.ws + WS_RK), RKW, 12, (bf16*)(F.ws + WS_A3), 256};
                pg8::gemm_phase<pg8::EpiStore, pg8::StaticOrder, true, true>(F.lds, g, S, E, F.tid);
            } break;
            case K_R2: if ((PHMASK >> K_R2) & 1) {
                pg8::Gemm g{(const bf16*)(F.ws + WS_A3), (const bf16*)(F.ws + WS_WL2), M, 3072, 256}; pg8::StaticOrder S; S.init(M, 3072, F.G, (int)blockIdx.x); S.ntk = 4;
                pg8::EpiLora2 E{(bf16*)(F.ws + WS_WAG), WAGW, AR.in[I_W0], AR.in[I_A0]};
                pg8::gemm_phase<pg8::EpiLora2, pg8::StaticOrder, true, true>(F.lds, g, S, E, F.tid);
            } break;
            case K_MIXA: if ((PHMASK >> K_MIXA) & 1) ml1_prompt(F, AR); __syncthreads(); if ((PHMASK >> 13) & 1) ml_sample(F, AR); __syncthreads(); if ((PHMASK >> 14) & 1) rg1(F, AR); break;
            case K_MIXB: if ((PHMASK >> K_MIXB) & 1) ml2_scan(F, AR); if ((PHMASK >> 15) & 1) rg2_carry(F, AR); break;
            case K_MIXC: if ((PHMASK >> K_MIXC) & 1) ml3_prompt(F, AR); __syncthreads(); if ((PHMASK >> 16) & 1) rg2_apply(F, AR); break;
            case K_R3: if ((PHMASK >> K_R3) & 1) rwkv_scan(F, AR); break;
            case K_R3B: rw_gn_pass(F, AR); break;
        }
        if (phs + 1 < hi) xcd_barrier(bar);
    }
}

extern "C" void kernel_launch(void* const* d_in, const int* in_sizes, int n_in, void* d_out, int out_size, void* d_ws, size_t ws_size, hipStream_t stream) {
    static int grid = 0;
    if (grid == 0) {
        if (n_in != 47 || out_size != (int)O_END || ws_size < WS_END) { fprintf(stderr, "kernel_launch: unexpected sizes n_in %d out %d ws %zu\n", n_in, out_size, ws_size); grid = -1; return; }
        int dev = 0, cus = 0, per_cu = 0;
        if (hipGetDevice(&dev) != hipSuccess || hipDeviceGetAttribute(&cus, hipDeviceAttributeMultiprocessorCount, dev) != hipSuccess) { grid = -1; return; }
        if (hipFuncSetAttribute((const void*)mega_fwd, hipFuncAttributeMaxDynamicSharedMemorySize, LDS_BYTES) != hipSuccess) { fprintf(stderr, "kernel_launch: hipFuncSetAttribute failed\n"); grid = -1; return; }
        if (hipOccupancyMaxActiveBlocksPerMultiprocessor(&per_cu, (const void*)mega_fwd, NTHREADS, LDS_BYTES) != hipSuccess || per_cu < 1) { fprintf(stderr, "kernel_launch: occupancy query says %d blocks per CU\n", per_cu); (void)hipGetLastError(); grid = -1; return; }
        grid = cus;
    }
    if (grid < 0) return;
    (void)hipMemsetAsync((char*)d_ws + WS_CTL, 0, CTL_ZERO_BYTES, stream);
    Args a{};
    for (int i = 0; i < 47; ++i) a.in[i] = (const float*)d_in[i];
    a.out = (float*)d_out; a.ws = (unsigned char*)d_ws;
#if MK_N_LAUNCHES == 1
    a.ph_lo = 0; a.ph_hi = NPHASES;
    hipLaunchKernelGGL(mega_fwd, dim3(grid), dim3(NTHREADS), LDS_BYTES, stream, a);
#else
    for (int p = 0; p < NPHASES; ++p) { a.ph_lo = p; a.ph_hi = p + 1; hipLaunchKernelGGL(mega_fwd, dim3(grid), dim3(NTHREADS), LDS_BYTES, stream, a); }
#endif
}
```

```cpp
#include <hip/hip_runtime.h>
#include <cstdio>
#include <cstdint>
#include <cmath>
namespace pg8 {
#define PG8_LAS __attribute__((address_space(3)))
typedef unsigned short bf16_t;
typedef short bf16x8 __attribute__((ext_vector_type(8)));
typedef float f32x4 __attribute__((ext_vector_type(4)));
typedef unsigned u32x4 __attribute__((ext_vector_type(4)));
constexpr int BM = 256, BK = 64, HALF = 128, HTB = HALF * BK * 2  , STAGE_BYTES = 8 * HTB, NXCD = 8, WGM = 8;

__host__ __device__ __forceinline__ int lds_byte(int r, int c) { const int st = (r >> 4) * 2 + (c >> 5), rr = r & 15, cc = c & 31, ob = rr * 64 + cc * 2; return st * 1024 + (ob ^ (((ob >> 9) & 1) << 5)); }
__host__ __device__ __forceinline__ void stage_rc(int b, int& R, int& C) { const int st = b / 1024, sb = b % 1024, swz = sb ^ (((sb >> 9) & 1) << 5); R = (st >> 1) * 16 + swz / 64; C = (st & 1) * 32 + (swz % 64) / 2; }
__host__ __device__ __forceinline__ int perm32(int rho) { const int n = rho >> 4, i = rho & 15; return 8 * (i >> 2) + 4 * n + (i & 3); }

struct Unit { int pm, pn, k0, nt, sub; };
struct Gemm { const bf16_t* A; const bf16_t* Bt; int M, N, K; };

struct StaticOrder {
    int nM, nN, nwg, G, c, ntk;
    __host__ __device__ void init(int M, int N, int G_, int c_) { nM = M / BM; nN = N / BM; nwg = nM * nN; G = G_; c = c_; }
    __host__ __device__ bool next(int i, Unit& u) const {
        const long L = (long)i * G + c; if (L >= nwg) return false;
        int wgid = (int)L; { const int q = nwg / NXCD, r = nwg % NXCD, xcd = wgid % NXCD, off = wgid / NXCD; wgid = (xcd < r ? xcd * (q + 1) : r * (q + 1) + (xcd - r) * q) + off; }
        const int nig = WGM * nN, gid = wgid / nig, fm = gid * WGM, gsz = (nM - fm) < WGM ? (nM - fm) : WGM;
        u.pm = fm + ((wgid % nig) % gsz); u.pn = (wgid % nig) / gsz; u.k0 = 0; u.nt = ntk; u.sub = 0; return true;
    }
    __device__ __forceinline__ void a_ready(const Unit&) const {}
    __device__ __forceinline__ void done(const Unit&) const {}
};

__device__ __forceinline__ unsigned cvt_pk_bf16(float lo, float hi) { unsigned r; asm volatile("v_cvt_pk_bf16_f32 %0, %1, %2" : "=v"(r) : "v"(lo), "v"(hi)); return r; }
typedef float f32x2 __attribute__((ext_vector_type(2)));
constexpr int MPROWS = 16384;
__device__ __forceinline__ int mod_row(int r) { return r < MPROWS ? (r >> 11) : 8 + ((r - MPROWS) >> 3); }
__device__ __forceinline__ float fsig(float x) { return __builtin_amdgcn_rcpf(1.0f + __builtin_amdgcn_exp2f(-1.44269504f * x)); }
__device__ __forceinline__ float ftanh(float x) { return 1.0f - 2.0f * __builtin_amdgcn_rcpf(1.0f + __builtin_amdgcn_exp2f(2.88539008f * x)); }

struct EpiSwiglu {
    static constexpr bool PERM = true, AFTER_DRAIN = false;
    bf16_t* O; int ldc;
    __device__ __forceinline__ void operator()(const f32x4 (&acc)[2][2][4][2], const Unit& u, int wr, int wc, int fr, int fq) const {
        const int row0 = u.pm * BM + wr * 64 + fr, col0 = u.pn * HALF + wc * 32 + 8 * fq;
#pragma unroll
        for (int ai = 0; ai < 2; ++ai)
#pragma unroll
            for (int m = 0; m < 4; ++m) { bf16_t* rowp = O + (size_t)(row0 + ai * HALF + m * 16) * ldc + col0;
                const f32x4 a0 = acc[ai][0][m][0], a1 = acc[ai][0][m][1], b0 = acc[ai][1][m][0], b1 = acc[ai][1][m][1];
                f32x4 v0, v1;
#pragma unroll
                for (int j = 0; j < 4; ++j) { v0[j] = a0[j] * fsig(a0[j]) * b0[j]; v1[j] = a1[j] * fsig(a1[j]) * b1[j]; }
                u32x4 w; w.x = cvt_pk_bf16(v0[0], v0[1]); w.y = cvt_pk_bf16(v0[2], v0[3]); w.z = cvt_pk_bf16(v1[0], v1[1]); w.w = cvt_pk_bf16(v1[2], v1[3]);
                *(u32x4*)rowp = w; asm volatile("" ::: "memory"); }
    }
};
struct EpiStore {
    static constexpr bool PERM = true, AFTER_DRAIN = false;
    bf16_t* O; int ldc; int ntile_main; bf16_t* O2; int ldc2;
    __device__ __forceinline__ void operator()(const f32x4 (&acc)[2][2][4][2], const Unit& u, int wr, int wc, int fr, int fq) const {
        const int row0 = u.pm * BM + wr * 64 + fr;
        const bool main = u.pn < ntile_main;
        bf16_t* base = main ? O + (size_t)u.pn * BM : O2; const int ld = main ? ldc : ldc2;
        const int col0 = wc * 32 + 8 * fq;
#pragma unroll
        for (int ai = 0; ai < 2; ++ai)
#pragma unroll
            for (int m = 0; m < 4; ++m) { bf16_t* rowp = base + (size_t)(row0 + ai * HALF + m * 16) * ld + col0;
#pragma unroll
                for (int bj = 0; bj < 2; ++bj) { f32x4 v0 = acc[ai][bj][m][0], v1 = acc[ai][bj][m][1];
                    if (!main) {
                        if (bj == 1) {
#pragma unroll
                            for (int j = 0; j < 4; ++j) { v0[j] = fsig(v0[j]); v1[j] = fsig(v1[j]); }
                        } else if (wc < 2) {
#pragma unroll
                            for (int j = 0; j < 4; ++j) { v0[j] = ftanh(v0[j]); v1[j] = ftanh(v1[j]); }
                        }
                    }
                    u32x4 w; w.x = cvt_pk_bf16(v0[0], v0[1]); w.y = cvt_pk_bf16(v0[2], v0[3]); w.z = cvt_pk_bf16(v1[0], v1[1]); w.w = cvt_pk_bf16(v1[2], v1[3]);
                    *(u32x4*)(rowp + bj * HALF) = w; asm volatile("" ::: "memory"); } }
    }
};
struct EpiLora2 {
    static constexpr bool PERM = true, AFTER_DRAIN = false;
    bf16_t* O; int ldc; const float* w0; const float* a0;
    __device__ __forceinline__ void operator()(const f32x4 (&acc)[2][2][4][2], const Unit& u, int wr, int wc, int fr, int fq) const {
        const int row0 = u.pm * BM + wr * 64 + fr, col0 = u.pn * BM + wc * 32 + 8 * fq, kind = u.pn >> 2;
        const float* bp = (kind == 0 ? w0 : a0) + (col0 & 1023); const float bsc = kind == 2 ? 0.f : 1.f, mul = kind == 0 ? -0.87504229f : 1.0f;
#pragma unroll
        for (int bj = 0; bj < 2; ++bj)
#pragma unroll
            for (int ai = 0; ai < 2; ++ai)
#pragma unroll
                for (int m = 0; m < 4; ++m) { bf16_t* rowp = O + (size_t)(row0 + ai * HALF + m * 16) * ldc + col0;
                    f32x4 v0 = acc[ai][bj][m][0] + *(const f32x4*)(bp + bj * HALF) * bsc, v1 = acc[ai][bj][m][1] + *(const f32x4*)(bp + bj * HALF + 4) * bsc;
                    if (kind != 2) {
#pragma unroll
                        for (int j = 0; j < 4; ++j) { v0[j] = mul * fsig(v0[j]); v1[j] = mul * fsig(v1[j]); }
                    }
                    u32x4 w; w.x = cvt_pk_bf16(v0[0], v0[1]); w.y = cvt_pk_bf16(v0[2], v0[3]); w.z = cvt_pk_bf16(v1[0], v1[1]); w.w = cvt_pk_bf16(v1[2], v1[3]);
                    *(u32x4*)(rowp + bj * HALF) = w; asm volatile("" ::: "memory"); }
    }
};

template <class Epi, class Sched, bool ALIGN_EPI = false, bool SP2 = false>
__device__ __forceinline__ void gemm_phase(PG8_LAS unsigned char* lds, const Gemm g, const Sched& S, const Epi& E, int tid_in) {
    int tid_ = tid_in; asm volatile("" : "+v"(tid_));
    const int tid = tid_, wid = __builtin_amdgcn_readfirstlane(tid >> 6), lane = tid & 63, wr = wid >> 2, wc = wid & 3, fr = lane & 15, fq = lane >> 4;
    int K_ = g.K; asm volatile("" : "+s"(K_));
    const int K = K_;
    unsigned voffA[2], voffB[2];
#pragma unroll
    for (int i = 0; i < 2; ++i) { int R, C; stage_rc(tid * 16 + i * 8192, R, C); const int Rb = Epi::PERM ? ((R & ~31) + perm32(R & 31)) : R;
        voffA[i] = (unsigned)(R * K + C) * 2u; voffB[i] = (unsigned)(Rb * K + C) * 2u; }
    const size_t kstep = (size_t)(BK * 2);
    const size_t hstep = (size_t)HALF * K * 2;
    const size_t tstep = 2 * hstep;
    const unsigned ldsw = (unsigned)wid * 1024u;
    const int aoff = lds_byte(wr * 64 + fr, fq * 8), boff = lds_byte(wc * 32 + fr, fq * 8);
#define PG8_SA(b, h) (((b) * 2 + (h)) * HTB)
#define PG8_SB(b, h) ((4 + (b) * 2 + (h)) * HTB)
#define PG8_STAGE(bufoff, gbase, voff) do { _Pragma("unroll") for (int _i = 0; _i < 2; ++_i) \
        __builtin_amdgcn_global_load_lds((const unsigned*)((const char*)(gbase) + (voff)[_i]), (PG8_LAS unsigned*)(lds + (bufoff) + ldsw + _i * 8192), 16, 0, 0); } while (0)
#define PG8_LDA(dst, b, h) do { _Pragma("unroll") for (int m = 0; m < 4; ++m) _Pragma("unroll") for (int k = 0; k < 2; ++k) dst[m][k] = *(const PG8_LAS bf16x8*)(lds + PG8_SA(b, h) + aoff + m * 2048 + k * 1024); } while (0)
#define PG8_LDB(dst, b, h) do { _Pragma("unroll") for (int n = 0; n < 2; ++n) _Pragma("unroll") for (int k = 0; k < 2; ++k) dst[n][k] = *(const PG8_LAS bf16x8*)(lds + PG8_SB(b, h) + boff + n * 2048 + k * 1024); } while (0)
#define PG8_MMA(ai, bj, At, Bt) do { __builtin_amdgcn_s_setprio(1); _Pragma("unroll") for (int m = 0; m < 4; ++m) _Pragma("unroll") for (int n = 0; n < 2; ++n) _Pragma("unroll") for (int k = 0; k < 2; ++k) \
        acc[ai][bj][m][n] = __builtin_amdgcn_mfma_f32_16x16x32_bf16(Bt[n][k], At[m][k], acc[ai][bj][m][n], 0, 0, 0); __builtin_amdgcn_s_setprio(0); } while (0)
#define PG8_WAIT_V(n) asm volatile("s_waitcnt vmcnt(" #n ")" ::: "memory")
#define PG8_WAIT_L(n) asm volatile("s_waitcnt lgkmcnt(" #n ")" ::: "memory")
#define PG8_BAR __builtin_amdgcn_s_barrier()
#define PG8_SCHED __builtin_amdgcn_sched_barrier(0)
    Unit cur, nxt; int ui = 0;
    if (!S.next(0, cur)) return;
    f32x4 acc[2][2][4][2];
#pragma unroll
    for (int a = 0; a < 2; ++a)
#pragma unroll
        for (int b = 0; b < 2; ++b)
#pragma unroll
            for (int m = 0; m < 4; ++m)
#pragma unroll
                for (int n = 0; n < 2; ++n) acc[a][b][m][n] = (f32x4){0.f, 0.f, 0.f, 0.f};
    bf16x8 At[4][2], B0[2][2], B1[2][2];
    const char* cA = (const char*)g.A + (size_t)cur.pm * tstep + (size_t)cur.k0 * 2; const char* cB = (const char*)g.Bt + (size_t)cur.pn * tstep + (size_t)cur.k0 * 2;
    S.a_ready(cur);
    if constexpr (SP2) {
        PG8_STAGE(PG8_SB(0, 0), cB, voffB); PG8_STAGE(PG8_SB(0, 1), cB + hstep, voffB); PG8_STAGE(PG8_SA(0, 0), cA, voffA); PG8_STAGE(PG8_SA(0, 1), cA + hstep, voffA);
        if (wr == 1) PG8_BAR;
        PG8_WAIT_V(2); PG8_BAR;
        PG8_STAGE(PG8_SB(1, 0), cB + kstep, voffB); PG8_STAGE(PG8_SA(1, 0), cA + kstep, voffA); PG8_STAGE(PG8_SB(1, 1), cB + hstep + kstep, voffB);
        PG8_WAIT_V(6); PG8_BAR;
    } else {
        PG8_STAGE(PG8_SB(0, 0), cB, voffB); PG8_STAGE(PG8_SA(0, 0), cA, voffA); PG8_STAGE(PG8_SB(0, 1), cB + hstep, voffB); PG8_STAGE(PG8_SA(0, 1), cA + hstep, voffA);
        if (wr == 1) PG8_BAR;
        PG8_WAIT_V(4); PG8_BAR;
        PG8_STAGE(PG8_SB(1, 0), cB + kstep, voffB); PG8_STAGE(PG8_SA(1, 0), cA + kstep, voffA); PG8_STAGE(PG8_SB(1, 1), cB + hstep + kstep, voffB);
        PG8_WAIT_V(6); PG8_BAR;
    }
    for (;;) {
        const bool has_next = S.next(ui + 1, nxt);
        const char* nA = has_next ? (const char*)g.A + (size_t)nxt.pm * tstep + (size_t)nxt.k0 * 2 : cA; const char* nB = has_next ? (const char*)g.Bt + (size_t)nxt.pn * tstep + (size_t)nxt.k0 * 2 : cB;
        const int nt = cur.nt;
        for (int t = 0; t < nt; t += 2) {
            const bool last = (t == nt - 2);
            const char* a1 = cA + (size_t)(t + 1) * kstep;
            const char* a2 = last ? nA : cA + (size_t)(t + 2) * kstep; const char* b2 = last ? nB : cB + (size_t)(t + 2) * kstep;
            const char* a3 = a2 + kstep; const char* b3 = b2 + kstep;
            if (last && has_next) S.a_ready(nxt);
            if constexpr (SP2) {
            PG8_LDB(B0, 0, 0); PG8_LDB(B1, 0, 1); PG8_SCHED; PG8_LDA(At, 0, 0); PG8_STAGE(PG8_SA(1, 1), a1 + hstep, voffA);
            PG8_WAIT_V(8); PG8_WAIT_L(0); PG8_BAR; PG8_MMA(0, 0, At, B0); PG8_MMA(0, 1, At, B1); PG8_BAR; PG8_SCHED;
            PG8_LDA(At, 0, 1); PG8_STAGE(PG8_SB(0, 0), b2, voffB); PG8_STAGE(PG8_SB(0, 1), b2 + hstep, voffB); PG8_STAGE(PG8_SA(0, 0), a2, voffA);
            PG8_WAIT_V(8); PG8_WAIT_L(0); PG8_BAR; PG8_MMA(1, 0, At, B0); PG8_MMA(1, 1, At, B1); PG8_BAR; PG8_SCHED;
            PG8_LDB(B0, 1, 0); PG8_LDB(B1, 1, 1); PG8_SCHED; PG8_LDA(At, 1, 0); PG8_STAGE(PG8_SA(0, 1), a2 + hstep, voffA);
            PG8_WAIT_V(8); PG8_WAIT_L(0); PG8_BAR; PG8_MMA(0, 0, At, B0); PG8_MMA(0, 1, At, B1); PG8_BAR; PG8_SCHED;
            PG8_LDA(At, 1, 1); PG8_STAGE(PG8_SB(1, 0), b3, voffB); PG8_STAGE(PG8_SB(1, 1), b3 + hstep, voffB); PG8_STAGE(PG8_SA(1, 0), a3, voffA);
            PG8_WAIT_V(8); PG8_WAIT_L(0); PG8_BAR; PG8_MMA(1, 0, At, B0); PG8_MMA(1, 1, At, B1); PG8_BAR; PG8_SCHED;
            } else {
            PG8_LDB(B0, 0, 0); PG8_SCHED; PG8_LDA(At, 0, 0); PG8_STAGE(PG8_SA(1, 1), a1 + hstep, voffA);
            PG8_WAIT_L(8); PG8_BAR; PG8_WAIT_L(0); PG8_MMA(0, 0, At, B0); PG8_BAR; PG8_SCHED;
            PG8_LDB(B1, 0, 1); PG8_STAGE(PG8_SB(0, 0), b2, voffB);
            PG8_BAR; PG8_WAIT_L(0); PG8_MMA(0, 1, At, B1); PG8_BAR;
            PG8_LDA(At, 0, 1); PG8_STAGE(PG8_SA(0, 0), a2, voffA);
            PG8_BAR; PG8_WAIT_L(0); PG8_MMA(1, 0, At, B0); PG8_BAR; PG8_SCHED;
            PG8_STAGE(PG8_SB(0, 1), b2 + hstep, voffB);
            PG8_WAIT_V(6); PG8_BAR; PG8_MMA(1, 1, At, B1); PG8_BAR;
            PG8_LDB(B0, 1, 0); PG8_SCHED; PG8_LDA(At, 1, 0); PG8_STAGE(PG8_SA(0, 1), a2 + hstep, voffA);
            PG8_WAIT_L(8); PG8_BAR; PG8_WAIT_L(0); PG8_MMA(0, 0, At, B0); PG8_BAR; PG8_SCHED;
            PG8_LDB(B1, 1, 1); PG8_STAGE(PG8_SB(1, 0), b3, voffB);
            PG8_BAR; PG8_WAIT_L(0); PG8_MMA(0, 1, At, B1); PG8_BAR;
            PG8_LDA(At, 1, 1); PG8_STAGE(PG8_SA(1, 0), a3, voffA);
            PG8_BAR; PG8_WAIT_L(0); PG8_MMA(1, 0, At, B0); PG8_BAR; PG8_SCHED;
            PG8_STAGE(PG8_SB(1, 1), b3 + hstep, voffB);
            PG8_WAIT_V(6); PG8_BAR; PG8_MMA(1, 1, At, B1); PG8_BAR;
            }
        }
        if constexpr (ALIGN_EPI) { if (wr == 0) PG8_BAR; }
        if constexpr (!Epi::AFTER_DRAIN) { E(acc, cur, wr, wc, fr, fq); S.done(cur); }
        if (!has_next) break;
#pragma unroll
        for (int a = 0; a < 2; ++a)
#pragma unroll
            for (int b = 0; b < 2; ++b)
#pragma unroll
                for (int m = 0; m < 4; ++m)
#pragma unroll
                    for (int n = 0; n < 2; ++n) acc[a][b][m][n] = (f32x4){0.f, 0.f, 0.f, 0.f};
        cur = nxt; cA = nA; cB = nB; ++ui;
        if constexpr (ALIGN_EPI) { if (wr == 1) PG8_BAR; }
    }
    PG8_WAIT_V(0);
    if constexpr (!ALIGN_EPI) { if (wr == 0) PG8_BAR; }
    PG8_BAR;
    if constexpr (Epi::AFTER_DRAIN) { E.fused(acc, cur, wr, wc, fr, fq, lds, wid, lane); S.done(cur); }
#undef PG8_SA
#undef PG8_SB
#undef PG8_STAGE
#undef PG8_LDA
#undef PG8_LDB
#undef PG8_MMA
#undef PG8_WAIT_V
#undef PG8_WAIT_L
#undef PG8_BAR
#undef PG8_SCHED
}
}
constexpr int NWAVES = 8, NTHREADS = 512;
constexpr int D = 1024, MP = 16384, MS = 1024, M = MP + MS, NSEQ = 136, FF = 2816;
constexpr int PSEQ = 2048, SSEQ = 8, NPB = 8, NSB = 128;
constexpr int ZW = 3328;
constexpr int ZQ = 0, ZK = 512, ZV = 1024, ZO = 1536, ZXR = 2048, ZGR = 2560, ZIG = 3072, ZFG = 3076;
constexpr int RKW = 3072, WAGW = 3072;
constexpr float ALPHA = 1.41421356237f;
constexpr float LN_EPS = 1e-5f, HEAD_EPS = 1e-6f, RW_EPS = 64e-5f;
constexpr float MSCALE = 0.08838834764831845f;

constexpr size_t O_Y = 0, O_PMC = 17825792, O_PMN = 18350080, O_PMM = 18354176, O_PRH = 18354208, O_PRC = 18358304, O_PWKV = 18370592, O_PSH = 18894880,
                 O_SMC = 18903072, O_SMN = 27291680, O_SMM = 27357216, O_SRH = 27357728, O_SRC = 27423264, O_SWKV = 27619872, O_SSH = 36008480, O_END = 36139552;

constexpr size_t MiB = 1u << 20;
constexpr size_t WS_CTL = 0, CTL_ZERO_BYTES = 1 * MiB;
constexpr size_t WS_W13 = 1 * MiB;
constexpr size_t WS_W2 = 45 * MiB;
constexpr size_t WS_WIN = 67 * MiB;
constexpr size_t WS_WOUT = WS_WIN + 6815744;
constexpr size_t WS_WRK = WS_WOUT + 2 * MiB;
constexpr size_t WS_WL2 = WS_WRK + 13 * MiB;
constexpr size_t WS_WO = WS_WL2 + 1572864;
constexpr size_t WS_MOD = 92 * MiB;
constexpr size_t WS_SC = 101 * MiB + 640 * 1024;
constexpr size_t WS_H = 102 * MiB;
constexpr size_t WS_BIG = 136 * MiB;
constexpr size_t WS_HID = WS_BIG;
constexpr size_t WS_Z = WS_BIG;
constexpr size_t WS_CST = WS_BIG + 111 * MiB;
constexpr size_t WS_SLAB = WS_BIG + 180 * MiB;
constexpr size_t WS_RGH = WS_BIG + 143 * MiB;
constexpr size_t WS_RGP = WS_BIG + 175 * MiB;
constexpr size_t WS_NST = WS_BIG + 207 * MiB;
constexpr size_t WS_MST = WS_NST + 262144;
constexpr size_t WS_CARRY = WS_MST + 8192;
constexpr size_t WS_RK = WS_BIG;
constexpr size_t WS_A3 = WS_BIG + 102 * MiB;
constexpr size_t WS_A2 = WS_BIG + 111 * MiB;
constexpr size_t WS_WAG = WS_BIG + 111 * MiB;
constexpr size_t WS_END = WS_BIG + 224 * MiB;
static_assert(WS_WO + 2 * MiB <= WS_MOD && WS_MOD + (size_t)2 * 136 * 9216 * 4 <= WS_SC && WS_SC + 160 * 1024 * 2 <= WS_H && WS_H + (size_t)M * D * 2 <= WS_BIG, "ws map");
static_assert(WS_SLAB + (size_t)11 * 4 * MiB <= WS_END && WS_A2 + (size_t)M * 2048 * 2 <= WS_SLAB && WS_CARRY + 8 * 64 * 512 * 4 <= WS_END && WS_WAG + (size_t)M * WAGW * 2 <= WS_END && WS_A3 + (size_t)M * 256 * 2 <= WS_A2, "ws map 2");
constexpr size_t WS_BN = WS_BIG + 213 * MiB;
constexpr size_t XB_OFF = (size_t)M * 1024 * 2;
constexpr size_t WS_ZF = WS_BIG + 111 * MiB;
constexpr int CW_BAR = 4096;

constexpr int LDS_BYTES = 147456;
constexpr int LDSCTL_OFF = LDS_BYTES - 512;
constexpr int MISC_OFF = LDSCTL_OFF;

#define GAS __attribute__((address_space(1)))
#define LAS __attribute__((address_space(3)))
typedef unsigned short bf16;
typedef unsigned v4u __attribute__((ext_vector_type(4)));
typedef unsigned v2u __attribute__((ext_vector_type(2)));
typedef float f32x4 __attribute__((ext_vector_type(4)));
typedef float f32x2 __attribute__((ext_vector_type(2)));
typedef float f32x16 __attribute__((ext_vector_type(16)));
typedef short bf16x8 __attribute__((ext_vector_type(8)));
typedef GAS unsigned gu32;
#define RLX_AGENT __ATOMIC_RELAXED, __HIP_MEMORY_SCOPE_AGENT
#define LDS_WAIT() asm volatile("s_waitcnt lgkmcnt(0)" ::: "memory")
#define DI __device__ __forceinline__
#define MFMA32(a, b, c) __builtin_amdgcn_mfma_f32_32x32x16_bf16((a), (b), (c), 0, 0, 0)
DI unsigned f2bf(float f) { unsigned u = __builtin_bit_cast(unsigned, f); return (u + 0x7fffu + ((u >> 16) & 1u)) >> 16; }
DI unsigned pk2(float lo, float hi) { return pg8::cvt_pk_bf16(lo, hi); }
DI float bf2f(unsigned b) { return __builtin_bit_cast(float, b << 16); }
DI float bflo(unsigned w) { return __builtin_bit_cast(float, w << 16); }
DI float bfhi(unsigned w) { return __builtin_bit_cast(float, w & 0xffff0000u); }
DI int crow(int reg, int h) { return (reg & 3) + 8 * (reg >> 2) + 4 * h; }
DI float fexp(float x) { return __builtin_amdgcn_exp2f(1.44269504f * x); }
DI float fsig(float x) { return pg8::fsig(x); }
DI bf16x8 mk_frag(unsigned a, unsigned b, unsigned c, unsigned d) { v4u p; p.x = a; p.y = b; p.z = c; p.w = d; return __builtin_bit_cast(bf16x8, p); }
DI bf16x8 pack8(const float (&v)[8]) { return mk_frag(pk2(v[0], v[1]), pk2(v[2], v[3]), pk2(v[4], v[5]), pk2(v[6], v[7])); }
template <int CTRL> DI float dpp_add(float x) {
    const int xi = __builtin_bit_cast(int, x);
    const int yi = __builtin_amdgcn_update_dpp(xi, xi, CTRL, 0xF, 0xF, false);
    return x + __builtin_bit_cast(float, yi);
}
DI float sum8(float x) { x = dpp_add<0xB1>(x); x = dpp_add<0x4E>(x); x = dpp_add<0x141>(x); return x; }
DI float sum16(float x) { x = sum8(x); x = dpp_add<0x140>(x); return x; }
DI float wave_sum(float v) { v = sum16(v); v += __shfl_xor(v, 16); v += __shfl_xor(v, 32); return v; }

#define XB_TMO      128
#define XB_XCNT(j)  (256  + 64 * (j))
#define XB_XSUB(j)  (1280 + 64 * (j))
#define XB_XGEN(j)  (2304 + 64 * (j))
#define XB_TOP      3328
#define XB_TOPGEN   3392
#define XCD_BAR_WORDS 3456
#define XB_SPIN_CAP (1u << 18)

__device__ __forceinline__ unsigned xb_ld(unsigned* p)              { return __hip_atomic_load(p, __ATOMIC_RELAXED, __HIP_MEMORY_SCOPE_AGENT); }
__device__ __forceinline__ unsigned xb_add(unsigned* p, unsigned v) { return __hip_atomic_fetch_add(p, v, __ATOMIC_RELAXED, __HIP_MEMORY_SCOPE_AGENT); }
__device__ __forceinline__ unsigned xb_xcc_id() { return (unsigned)__builtin_amdgcn_s_getreg((3 << 11) | 20) & 0xFu; }
#define XB_SPIN(cond, bar) do { unsigned _sp = 0; while (cond) { __builtin_amdgcn_s_sleep(1); \
    if ((++_sp & 255u) == 0u) { if (xb_ld(&(bar)[XB_TMO])) break; if (_sp > XB_SPIN_CAP) { atomicAdd(&(bar)[XB_TMO], 1u); break; } } } } while (0)

struct XcdBarrier {
    unsigned* bar; unsigned x;
    volatile LAS unsigned* st;
};

__device__ __forceinline__ XcdBarrier xcd_barrier_post(unsigned* bar, volatile LAS unsigned* st) {
    XcdBarrier b; b.bar = bar; b.x = xb_xcc_id(); b.st = st;
    if (threadIdx.x == 0) (void)xb_add(&bar[XB_XCNT(b.x)], 1u);
    return b;
}
__device__ __forceinline__ void xcd_barrier_complete(unsigned* bar, unsigned x, unsigned& nloc, unsigned& nx) {
    const unsigned G = gridDim.x * gridDim.y * gridDim.z;
    unsigned sum, cnt, mine, sp = 0u;
    for (;;) {
        sum = 0u; cnt = 0u; mine = 0u;
#pragma unroll
        for (unsigned j = 0; j < 16; ++j) { const unsigned c = xb_ld(&bar[XB_XCNT(j)]); sum += c; cnt += (c > 0u) ? 1u : 0u; mine = (j == x) ? c : mine; }
        if (sum == G) break;
        __builtin_amdgcn_s_sleep(1);
        if ((++sp & 255u) == 0u) { if (xb_ld(&bar[XB_TMO])) break; if (sp > XB_SPIN_CAP) { atomicAdd(&bar[XB_TMO], 1u); break; } }
    }
    nloc = mine > 0u ? mine : 1u; nx = cnt > 0u ? cnt : 1u;
}

__device__ __forceinline__ void xcd_barrier(const XcdBarrier& b) {
    asm volatile("s_waitcnt vmcnt(0)" ::: "memory");
    __syncthreads();
    if (threadIdx.x == 0) {
        unsigned* bar = b.bar;
        __builtin_amdgcn_s_waitcnt(0);
        unsigned nloc = b.st[0], nx = b.st[1];
        if (nloc == 0u) { xcd_barrier_complete(bar, b.x, nloc, nx); b.st[0] = nloc; b.st[1] = nx; }
        const unsigned old = xb_add(&bar[XB_XSUB(b.x)], 1u);
        const unsigned gen = old / nloc;
        if (old + 1u == (gen + 1u) * nloc) {
            __builtin_amdgcn_fence(__ATOMIC_RELEASE, "agent");
            asm volatile("s_waitcnt vmcnt(0)" ::: "memory");
            const unsigned og = xb_add(&bar[XB_TOP], 1u);
            const unsigned tg = og / nx;
            if (og + 1u == (tg + 1u) * nx) xb_add(&bar[XB_TOPGEN], 1u);
            else XB_SPIN(xb_ld(&bar[XB_TOPGEN]) == tg, bar);
            __builtin_amdgcn_fence(__ATOMIC_ACQUIRE, "agent");
            xb_add(&bar[XB_XGEN(b.x)], 1u);
            asm volatile("s_waitcnt vmcnt(0)" ::: "memory");
        } else {
            XB_SPIN(xb_ld(&bar[XB_XGEN(b.x)]) == gen, bar);
            __builtin_amdgcn_fence(__ATOMIC_ACQUIRE, "agent");
            asm volatile("s_waitcnt vmcnt(0)" ::: "memory");
        }
    }
    __syncthreads();
}
struct Args { const float* in[47]; float* out; unsigned char* ws; int ph_lo, ph_hi; };
struct Frame {
    LAS unsigned char* lds;
    volatile LAS unsigned* MISC;
    gu32* ctl;
    int tid, lane, wave;
    int vcu, G;
    float* out;
    unsigned char* ws;
};
enum { I_XP = 0, I_XS, I_CP, I_CS, I_SMC, I_SMN, I_SMM, I_SRH, I_SRC, I_SWKV, I_SSH, I_ADAW, I_ADAB, I_LNG, I_LNB, I_W1, I_W3, I_W2, I_WIN, I_BG, I_MNG,
       I_CW, I_CB, I_WA, I_BA, I_WX, I_BX, I_LAM, I_WOUT, I_MU, I_WR, I_WK, I_WV, I_W0, I_LW1, I_LW2, I_A0, I_A1, I_A2, I_G1, I_G2, I_KK, I_KA, I_RK, I_LXG, I_LXB, I_WO };

struct EpiResid {
    static constexpr bool PERM = true, AFTER_DRAIN = false;
    const Args& ar; float* out; unsigned char* ws; int cfg;
    __device__ __forceinline__ void operator()(const pg8::f32x4 (&acc)[2][2][4][2], const pg8::Unit& u, int wr, int wc, int fr, int fq) const {
        using pg8::BM; using pg8::HALF;
        if (u.sub) {
            const int row0 = u.pm * BM + wr * 64 + fr - MP, col0 = u.pn * BM + wc * 32 + 8 * fq;
            float* sb = (float*)(ws + WS_SLAB) + (size_t)(u.k0 / (64 * u.nt)) * (1024 * 1024) + col0;
#pragma unroll
            for (int ai = 0; ai < 2; ++ai)
#pragma unroll
                for (int m = 0; m < 4; ++m) { float* o = sb + (size_t)(row0 + ai * HALF + m * 16) * 1024;
#pragma unroll
                    for (int bj = 0; bj < 2; ++bj) { *(f32x4*)(o + bj * HALF) = acc[ai][bj][m][0]; *(f32x4*)(o + bj * HALF + 4) = acc[ai][bj][m][1]; } }
            return;
        }
        const int row0 = u.pm * BM + wr * 64 + fr, col0 = u.pn * BM + wc * 32 + 8 * fq;
        const bool first = cfg & 1; const int l = (cfg >> 1) & 1, jg = (cfg >> 2) & 15; const float rw = (cfg & 64) ? 1.0f : 0.5f;
        bf16* XB = (bf16*)((unsigned char*)out + XB_OFF);
        bf16* Zo = (cfg & 128) ? (bf16*)(ws + WS_BIG + 145 * MiB) : ((cfg & 256) ? (bf16*)(ws + WS_ZF) : XB);
        const float* gate = (const float*)(ws + WS_MOD) + ((size_t)l * NSEQ * 9 + jg) * 1024;
#pragma unroll
        for (int ai = 0; ai < 2; ++ai)
#pragma unroll
            for (int m = 0; m < 4; ++m) { const int row = row0 + ai * HALF + m * 16;
                const float* gr = gate + (size_t)pg8::mod_row(row) * 9216 + col0;
#pragma unroll
                for (int bj = 0; bj < 2; ++bj) { const int c = bj * HALF; f32x4 x0, x1;
                    if (first) { const float* xr = (row < MP ? ar.in[I_XP] + (size_t)row * 1024 : ar.in[I_XS] + (size_t)(row - MP) * 1024) + col0 + c; x0 = *(const f32x4*)xr; x1 = *(const f32x4*)(xr + 4); }
                    else { const v4u q = *(const v4u*)(XB + (size_t)row * 1024 + col0 + c); x0 = (f32x4){bflo(q.x), bfhi(q.x), bflo(q.y), bfhi(q.y)}; x1 = (f32x4){bflo(q.z), bfhi(q.z), bflo(q.w), bfhi(q.w)}; }
                    const f32x4 g0 = *(const f32x4*)(gr + c), g1 = *(const f32x4*)(gr + c + 4);
                    const f32x4 z0 = x0 * ALPHA + (g0 + 1.0f) * rw * acc[ai][bj][m][0], z1 = x1 * ALPHA + (g1 + 1.0f) * rw * acc[ai][bj][m][1];
                    v4u w; w.x = pk2(z0.x, z0.y); w.y = pk2(z0.z, z0.w); w.z = pk2(z1.x, z1.y); w.w = pk2(z1.z, z1.w);
                    *(v4u*)(Zo + (size_t)row * 1024 + col0 + c) = w; }
                asm volatile("" ::: "memory"); }
    }
};
struct SplitOrder {
    pg8::StaticOrder base; int S;
    __device__ __forceinline__ bool next(int i, pg8::Unit& u) const {
        if (S == 0) return base.next(i, u);
        if (i == 0) return base.next(0, u);
        if (i == 1 && base.c < 16 * S) { const int su = base.c / S, ks = base.c - su * S; u.pm = 64 + (su >> 2); u.pn = su & 3; u.k0 = ks * 256; u.nt = 4; u.sub = 1; return true; }
        return false;
    }
    __device__ __forceinline__ void a_ready(const pg8::Unit&) const {}
    __device__ __forceinline__ void done(const pg8::Unit&) const {}
};

DI void p0_sctab(Frame& F, const Args& AR) {
    bf16* sc = (bf16*)(F.ws + WS_SC);
    const int gt = F.vcu * NTHREADS + F.tid, NT = F.G * NTHREADS;
    for (int e = gt; e < 160 * 256; e += NT) { const int m = e >> 8, k4 = (e & 255) * 4; v2u w; w.x = 0u; w.y = 0u;
        if (m < NSEQ) { const f32x4 c = *(const f32x4*)((m < NPB ? AR.in[I_CP] + (size_t)m * D : AR.in[I_CS] + (size_t)(m - NPB) * D) + k4);
            w.x = pk2(c.x * fsig(c.x), c.y * fsig(c.y)); w.y = pk2(c.z * fsig(c.z), c.w * fsig(c.w)); }
        *(v2u*)(sc + (size_t)m * 1024 + k4) = w; }
}
DI void p0_mod(Frame& F, const Args& AR) {
    LAS float* SL = (LAS float*)F.lds;
    LAS float* T = (LAS float*)(F.lds + 81920);
    const int lane = F.lane, wave = F.wave, r = lane & 31, hh = lane >> 5;
    const float* adaw = AR.in[I_ADAW]; const float* adab = AR.in[I_ADAB];
    const bf16* sc = (const bf16*)(F.ws + WS_SC);
    float* mod = (float*)(F.ws + WS_MOD);
    for (int nb = F.vcu; nb < 576; nb += F.G) {
        const int n0 = nb * 32, l = n0 / 9216, nc0 = n0 - l * 9216;
        const float* W = adaw + (size_t)l * 1024 * 9216 + nc0 + r + (size_t)(wave * 128 + 8 * hh) * 9216;
        float a[8][8];
#pragma unroll
        for (int ks = 0; ks < 8; ++ks)
#pragma unroll
            for (int j = 0; j < 8; ++j) a[ks][j] = W[(size_t)(ks * 16 + j) * 9216];
        f32x16 acc[5];
#pragma unroll
        for (int mb = 0; mb < 5; ++mb)
#pragma unroll
            for (int i = 0; i < 16; ++i) acc[mb][i] = 0.f;
#pragma unroll
        for (int ks = 0; ks < 8; ++ks) { const bf16x8 A = pack8(a[ks]); const int k0 = wave * 128 + ks * 16 + 8 * hh;
#pragma unroll
            for (int mb = 0; mb < 5; ++mb) acc[mb] = MFMA32(A, *(const bf16x8*)(sc + (size_t)(mb * 32 + r) * 1024 + k0), acc[mb]); }
#pragma unroll
        for (int half = 4; half >= 1; half >>= 1) {
            if (wave >= half && wave < 2 * half) { LAS float* p = SL + (wave - half) * 5120 + lane;
#pragma unroll
                for (int mb = 0; mb < 5; ++mb)
#pragma unroll
                    for (int i = 0; i < 16; ++i) p[(mb * 16 + i) * 64] = acc[mb][i]; }
            __syncthreads();
            if (wave < half) { const LAS float* p = SL + wave * 5120 + lane;
#pragma unroll
                for (int mb = 0; mb < 5; ++mb)
#pragma unroll
                    for (int i = 0; i < 16; ++i) acc[mb][i] += p[(mb * 16 + i) * 64]; }
            __syncthreads();
        }
        if (wave == 0) {
#pragma unroll
            for (int mb = 0; mb < 5; ++mb)
#pragma unroll
                for (int i = 0; i < 16; ++i) T[(mb * 32 + r) * 33 + crow(i, hh)] = acc[mb][i]; }
        __syncthreads();
        for (int m = F.tid >> 5; m < NSEQ; m += 16) { const int n = F.tid & 31; mod[(size_t)(l * NSEQ + m) * 9216 + nc0 + n] = T[m * 33 + n] + adab[l * 9216 + nc0 + n]; }
        __syncthreads();
    }
}

DI void tr_item(const float* src, int ld, int nvalid, float keep, const float* sc, float sa, float sb, bf16* dst, int dld, LAS float* scr, int lane) {
    const int n4 = (lane & 7) * 4, kr = lane >> 3; const float kz = (n4 < nvalid) ? keep : 0.f;
    f32x4 v[8]; float m[8];
#pragma unroll
    for (int i = 0; i < 8; ++i) { v[i] = *(const f32x4*)(src + (size_t)(kr + 8 * i) * ld + n4); m[i] = sc[kr + 8 * i]; }
#pragma unroll
    for (int i = 0; i < 8; ++i) { const float f = (sa + sb * m[i]) * kz; LAS float* p = scr + (kr + 8 * i) * 33 + n4;
        p[0] = kz == 0.f ? 0.f : v[i].x * f; p[1] = kz == 0.f ? 0.f : v[i].y * f; p[2] = kz == 0.f ? 0.f : v[i].z * f; p[3] = kz == 0.f ? 0.f : v[i].w * f; }
    LDS_WAIT(); asm volatile("" ::: "memory");
    const int c = lane & 7;
#pragma unroll
    for (int j = 0; j < 4; ++j) { const int n = (lane >> 3) + 8 * j; const LAS float* s = scr + (8 * c) * 33 + n;
        v4u o; o.x = pk2(s[0 * 33], s[1 * 33]); o.y = pk2(s[2 * 33], s[3 * 33]); o.z = pk2(s[4 * 33], s[5 * 33]); o.w = pk2(s[6 * 33], s[7 * 33]);
        *(GAS v4u*)(dst + (size_t)n * dld + 8 * c) = o; }
    LDS_WAIT(); asm volatile("" ::: "memory");
}
DI void p0_weights(Frame& F, const Args& AR) {
    LAS float* scr = (LAS float*)(F.lds + 32768 + F.wave * 8704);
    const int gw = F.vcu * NWAVES + F.wave, NGW = F.G * NWAVES;
    constexpr int I_13 = 16 * 176, I_2 = 44 * 32, I_IN = 16 * 104, I_SQ = 16 * 32, I_RKI = 32 * 104, I_L2 = 4 * 96;
    constexpr int NITEMS = 4 * I_13 + 4 * I_2 + I_IN + 2 * I_SQ + I_RKI + I_L2;
    bf16* W13 = (bf16*)(F.ws + WS_W13); bf16* W2 = (bf16*)(F.ws + WS_W2); bf16* WIN = (bf16*)(F.ws + WS_WIN); bf16* WOUT = (bf16*)(F.ws + WS_WOUT);
    bf16* WRK = (bf16*)(F.ws + WS_WRK); bf16* WL2 = (bf16*)(F.ws + WS_WL2); bf16* WO = (bf16*)(F.ws + WS_WO);
    for (int it = gw; it < NITEMS; it += NGW) {
        int r = it;
        if (r < 4 * I_13) { const int f = r / I_13; r -= f * I_13; const int kt = r / 176, tn = r % 176, j = tn >> 3, i = tn & 7;
            const float* src = (i < 4 ? AR.in[I_W1] : AR.in[I_W3]) + (size_t)f * 1024 * FF + (size_t)(64 * kt) * FF + 128 * j + 32 * (i & 3);
            tr_item(src, FF, 32, 1.f, src, 1.f, 0.f, W13 + (size_t)f * 5632 * 1024 + (size_t)(32 * tn) * 1024 + 64 * kt, 1024, scr, F.lane); continue; }
        r -= 4 * I_13;
        if (r < 4 * I_2) { const int f = r / I_2; r -= f * I_2; const int kt = r / 32, tn = r % 32;
            const float* src = AR.in[I_W2] + (size_t)f * FF * 1024 + (size_t)(64 * kt) * 1024 + 32 * tn;
            tr_item(src, 1024, 32, 1.f, src, 1.f, 0.f, W2 + (size_t)f * 1024 * FF + (size_t)(32 * tn) * FF + 64 * kt, FF, scr, F.lane); continue; }
        r -= 4 * I_2;
        if (r < I_IN) { const int kt = r / 104, tn = r % 104, nd = 32 * tn; int sc0 = 0, nv = 32; bool has = true;
            if (nd < 2048) sc0 = nd; else if (nd < 3072) sc0 = nd + 8; else if (nd == 3072) { sc0 = 2048; nv = 8; } else has = false;
            const float* src = AR.in[I_WIN] + (size_t)(64 * kt) * 3080 + sc0;
            tr_item(src, 3080, nv, has ? 1.f : 0.f, src, 1.f, 0.f, WIN + (size_t)nd * 1024 + 64 * kt, 1024, scr, F.lane); continue; }
        r -= I_IN;
        if (r < 2 * I_SQ) { const int w = r / I_SQ; r -= w * I_SQ; const int kt = r / 32, tn = r % 32;
            const float* src = (w == 0 ? AR.in[I_WOUT] : AR.in[I_WO]) + (size_t)(64 * kt) * 1024 + 32 * tn;
            tr_item(src, 1024, 32, 1.f, src, 1.f, 0.f, (w == 0 ? WOUT : WO) + (size_t)(32 * tn) * 1024 + 64 * kt, 1024, scr, F.lane); continue; }
        r -= 2 * I_SQ;
        if (r < I_RKI) { const int kt = r / 104, tn = r % 104, nd = 32 * tn, kd = 64 * kt, half = kd >= 1024, ks = kd & 1023;
            const float* base; int ld, col, mi;
            if (nd < 1024) { base = AR.in[I_WR]; ld = 1024; col = nd; mi = 0; }
            else if (nd < 2048) { base = AR.in[I_WK]; ld = 1024; col = nd - 1024; mi = 2; }
            else if (nd < 3072) { base = AR.in[I_WV]; ld = 1024; col = nd - 2048; mi = 3; }
            else if (nd < 3136) { base = AR.in[I_LW1]; ld = 64; col = nd - 3072; mi = 1; }
            else if (nd < 3200) { base = AR.in[I_A1]; ld = 64; col = nd - 3136; mi = 4; }
            else { base = AR.in[I_G1]; ld = 128; col = nd - 3200; mi = 5; }
            tr_item(base + (size_t)ks * ld + col, ld, 32, 1.f, AR.in[I_MU] + mi * 1024 + ks, half ? 0.f : 1.f, half ? 1.f : -1.f, WRK + (size_t)nd * 2048 + kd, 2048, scr, F.lane); continue; }
        r -= I_RKI;
        { const int kt = r / 96, tn = r % 96, nd = 32 * tn; const float* src = AR.in[I_LW2]; float keep = 0.f;
            if (nd < 1024) { if (kt == 0) { src = AR.in[I_LW2] + nd; keep = 1.f; } }
            else if (nd < 2048) { if (kt == 1) { src = AR.in[I_A2] + (nd - 1024); keep = 1.f; } }
            else { if (kt >= 2) { src = AR.in[I_G2] + (size_t)(64 * (kt - 2)) * 1024 + (nd - 2048); keep = 1.f; } }
            tr_item(src, 1024, 32, keep, AR.in[I_LW2], 1.f, 0.f, WL2 + (size_t)nd * 256 + 64 * kt, 256, scr, F.lane); }
    }
}

DI void ld8(float (&v)[8], const bf16* p) { const v4u q = *(const v4u*)p; v[0] = bflo(q.x); v[1] = bfhi(q.x); v[2] = bflo(q.y); v[3] = bfhi(q.y); v[4] = bflo(q.z); v[5] = bfhi(q.z); v[6] = bflo(q.w); v[7] = bfhi(q.w); }
DI void ld8(float (&v)[8], const float* p) { const f32x4 a = *(const f32x4*)p, b = *(const f32x4*)(p + 4); v[0] = a.x; v[1] = a.y; v[2] = a.z; v[3] = a.w; v[4] = b.x; v[5] = b.y; v[6] = b.z; v[7] = b.w; }
DI v4u pk8(const float (&v)[8]) { v4u w; w.x = pk2(v[0], v[1]); w.y = pk2(v[2], v[3]); w.z = pk2(v[4], v[5]); w.w = pk2(v[6], v[7]); return w; }
DI void ln_pass(Frame& F, const Args& AR, int first, int do_ln, int l, int sub, int lm, int js, int mode, int nsplit, int xfirst, int fin) {
    const int gw = F.vcu * NWAVES + F.wave, NGW = F.G * NWAVES, lane = F.lane;
    bf16* XB = (bf16*)((unsigned char*)F.out + XB_OFF); const bf16* ZS = fin ? (const bf16*)(F.ws + WS_ZF) : XB;
    const float* lg = AR.in[I_LNG] + (l * 3 + sub) * 1024; const float* lb = AR.in[I_LNB] + (l * 3 + sub) * 1024;
    const float* mod = (const float*)(F.ws + WS_MOD);
    bf16* H = (bf16*)(F.ws + WS_H); bf16* A2 = (bf16*)(F.ws + WS_A2);
    float nv[2][8];
    { const int r = gw < M ? gw : 0;
#pragma unroll
        for (int j = 0; j < 2; ++j) { const int c0 = 8 * (lane + 64 * j);
            if (first || (xfirst && r >= MP)) ld8(nv[j], (r < MP ? AR.in[I_XP] + (size_t)r * D : AR.in[I_XS] + (size_t)(r - MP) * D) + c0);
            else ld8(nv[j], ZS + (size_t)r * D + c0); } }
    for (int r = gw; r < M; r += NGW) {
        float v[2][8];
#pragma unroll
        for (int j = 0; j < 2; ++j)
#pragma unroll
            for (int e = 0; e < 8; ++e) v[j][e] = nv[j][e];
        { const int rn = r + NGW < M ? r + NGW : r;
#pragma unroll
            for (int j = 0; j < 2; ++j) { const int c0 = 8 * (lane + 64 * j);
                if (first || (xfirst && rn >= MP)) ld8(nv[j], (rn < MP ? AR.in[I_XP] + (size_t)rn * D : AR.in[I_XS] + (size_t)(rn - MP) * D) + c0);
                else ld8(nv[j], ZS + (size_t)rn * D + c0); } }
        if (nsplit > 0 && r >= MP) {
            const float* gp = mod + ((size_t)(l * NSEQ + pg8::mod_row(r)) * 9 + 3 * sub + 2) * 1024; const float rw = sub == 1 ? 1.0f : 0.5f;
            const float* sl = (const float*)(F.ws + WS_SLAB) + (size_t)(r - MP) * 1024;
#pragma unroll
            for (int j = 0; j < 2; ++j) { const int c0 = 8 * (lane + 64 * j); float a[8], g[8]; ld8(a, sl + c0); ld8(g, gp + c0);
                for (int s = 1; s < nsplit; ++s) { float t[8]; ld8(t, sl + (size_t)s * 1024 * 1024 + c0);
#pragma unroll
                    for (int e = 0; e < 8; ++e) a[e] += t[e]; }
#pragma unroll
                for (int e = 0; e < 8; ++e) v[j][e] = v[j][e] * ALPHA + (g[e] + 1.0f) * rw * a[e]; }
        }
        if (do_ln) {
            float s = 0.f;
#pragma unroll
            for (int j = 0; j < 2; ++j)
#pragma unroll
                for (int e = 0; e < 8; ++e) s += v[j][e];
            const float mean = wave_sum(s) * (1.f / D); float s2 = 0.f;
#pragma unroll
            for (int j = 0; j < 2; ++j)
#pragma unroll
                for (int e = 0; e < 8; ++e) { v[j][e] -= mean; s2 += v[j][e] * v[j][e]; }
            const float rstd = 1.f / sqrtf(wave_sum(s2) * (1.f / D) + LN_EPS);
#pragma unroll
            for (int j = 0; j < 2; ++j) { const int c0 = 8 * (lane + 64 * j); float g[8], b[8]; ld8(g, lg + c0); ld8(b, lb + c0);
#pragma unroll
                for (int e = 0; e < 8; ++e) v[j][e] = v[j][e] * rstd * g[e] + b[e];
                if (fin) { float* o = F.out + O_Y + (size_t)r * D + c0; *(f32x4*)o = (f32x4){v[j][0], v[j][1], v[j][2], v[j][3]}; *(f32x4*)(o + 4) = (f32x4){v[j][4], v[j][5], v[j][6], v[j][7]}; }
                else *(v4u*)(XB + (size_t)r * D + c0) = pk8(v[j]); }
        }
        if (mode != 2) {
            const int mr = pg8::mod_row(r);
            const float* sh = mod + ((size_t)(lm * NSEQ + mr) * 9 + js) * 1024; const float* sc = sh + 1024;
            int t, len, b; if (r < MP) { t = r & (PSEQ - 1); len = PSEQ; b = r >> 11; } else { t = (r - MP) & (SSEQ - 1); len = SSEQ; b = (r - MP) >> 3; }
#pragma unroll
            for (int j = 0; j < 2; ++j) { const int c0 = 8 * (lane + 64 * j); float s8[8], h8[8], h[8]; ld8(s8, sc + c0); ld8(h8, sh + c0);
#pragma unroll
                for (int e = 0; e < 8; ++e) h[e] = v[j][e] * (s8[e] + 1.0f) + h8[e];
                const v4u w = pk8(h);
                if (mode == 0) *(v4u*)(H + (size_t)r * D + c0) = w;
                else {
                    *(v4u*)(A2 + (size_t)r * 2048 + c0) = w;
                    if (t + 1 < len) *(v4u*)(A2 + (size_t)(r + 1) * 2048 + 1024 + c0) = w;
                    if (t == 0) { v4u p; p.x = 0u; p.y = 0u; p.z = 0u; p.w = 0u;
                        if (r >= MP) { float q[8]; ld8(q, AR.in[I_SSH] + (size_t)b * D + c0); p = pk8(q); }
                        *(v4u*)(A2 + (size_t)r * 2048 + 1024 + c0) = p; }
                    if (t == len - 1) { float* o = F.out + (r < MP ? O_PSH : O_SSH) + (size_t)b * D + c0; *(f32x4*)o = (f32x4){h[0], h[1], h[2], h[3]}; *(f32x4*)(o + 4) = (f32x4){h[4], h[5], h[6], h[7]}; }
                } }
        }
    }
}

DI float log_sigmoid(float x) { return -(fmaxf(-x, 0.f) + log1pf(__expf(-fabsf(x)))); }
DI float gelu_tanh(float x) { const float u = 0.7978845608f * (x + 0.044715f * x * x * x); return 0.5f * x * (1.0f + pg8::ftanh(u)); }

DI void ml1_prompt(Frame& F, const Args& AR) {
    const bf16* Z = (const bf16*)(F.ws + WS_Z);
    float* CST = (float*)(F.ws + WS_CST); float* NST = (float*)(F.ws + WS_NST); float* MST = (float*)(F.ws + WS_MST);
    LAS bf16* Ks = (LAS bf16*)F.lds;
    LAS bf16* Vs = (LAS bf16*)(F.lds + 32768);
    LAS float* LF = (LAS float*)(F.lds + 65536);
    LAS float* GS = (LAS float*)(F.lds + 65536 + 512);
    LAS float* RED = (LAS float*)(F.lds + 65536 + 1024);
    const int tid = F.tid, lane = F.lane, wave = F.wave, r = lane & 31, hh = lane >> 5;
    for (int item = F.vcu; item < 512; item += F.G) {
        const int b = item >> 6, h = (item >> 4) & 3, c = item & 15; const size_t row0 = (size_t)b * PSEQ + c * 128;
#pragma unroll
        for (int i = 0; i < 4; ++i) { const int e = tid + i * NTHREADS, s = e >> 4, c8 = (e & 15) * 8;
            *(LAS v4u*)(Ks + s * 128 + c8) = *(const v4u*)(Z + (row0 + s) * ZW + ZK + h * 128 + c8);
            *(LAS v4u*)(Vs + s * 128 + c8) = *(const v4u*)(Z + (row0 + s) * ZW + ZV + h * 128 + c8); }
        if (tid < 128) { const float fg = bf2f(Z[(row0 + tid) * ZW + ZFG + h]); LF[tid] = log_sigmoid(fg + AR.in[I_BG][4 + h]); }
        __syncthreads();
        if (tid < 128) { float bs = 0.f; for (int s = 0; s <= tid; ++s) bs += LF[s];
            const float ig = bf2f(Z[(row0 + tid) * ZW + ZIG + h]) + AR.in[I_BG][h];
            GS[tid] = ig - bs; if (tid == 127) RED[0] = bs; }
        __syncthreads();
        float gmax = -INFINITY; for (int s = 0; s < 128; ++s) gmax = fmaxf(gmax, GS[s]);
        const float bL = RED[0];
        __syncthreads();
        if (tid < 128) GS[tid] = fexp(GS[tid] - gmax);
        __syncthreads();
        const int vb = wave >> 1, kb0 = 2 * (wave & 1);
        f32x16 acc[2];
#pragma unroll
        for (int i = 0; i < 16; ++i) { acc[0][i] = 0.f; acc[1][i] = 0.f; }
#pragma unroll 2
        for (int ks = 0; ks < 8; ++ks) { const int s0 = 16 * ks + 8 * hh;
            float a[8];
#pragma unroll
            for (int j = 0; j < 8; ++j) a[j] = bf2f(Vs[(s0 + j) * 128 + vb * 32 + r]) * GS[s0 + j];
            const bf16x8 A = pack8(a);
#pragma unroll
            for (int q = 0; q < 2; ++q) { unsigned kw[8];
#pragma unroll
                for (int j = 0; j < 8; ++j) kw[j] = Ks[(s0 + j) * 128 + (kb0 + q) * 32 + r];
                const bf16x8 B = mk_frag(kw[0] | (kw[1] << 16), kw[2] | (kw[3] << 16), kw[4] | (kw[5] << 16), kw[6] | (kw[7] << 16));
                acc[q] = MFMA32(A, B, acc[q]); } }
        float* Co = CST + (size_t)item * 16384;
#pragma unroll
        for (int q = 0; q < 2; ++q)
#pragma unroll
            for (int i = 0; i < 16; ++i) Co[(vb * 32 + crow(i, hh)) * 128 + (kb0 + q) * 32 + r] = acc[q][i] * MSCALE;
        if (tid < 128) { float n = 0.f; for (int s = 0; s < 128; ++s) n += GS[s] * bf2f(Ks[s * 128 + tid]); NST[item * 128 + tid] = n * MSCALE; }
        if (tid == 0) { MST[item * 4 + 0] = bL + gmax; MST[item * 4 + 1] = bL; }
        __syncthreads();
    }
}

DI void ml_sample(Frame& F, const Args& AR) {
    const bf16* Z = (const bf16*)(F.ws + WS_Z); bf16* G = (bf16*)(F.ws + WS_H);
    LAS float* Qs = (LAS float*)F.lds;
    LAS float* Ks = Qs + 1024; LAS float* Vs = Ks + 1024;
    LAS float* HT = Vs + 1024;
    LAS float* P = HT + 1024;
    LAS float* GT = P + 64;
    LAS float* SC = GT + 64;
    const int tid = F.tid, lane = F.lane, wave = F.wave;
    const float* C0g = AR.in[I_SMC]; const float* n0g = AR.in[I_SMN]; const float* m0g = AR.in[I_SMM];
    for (int item = F.vcu; item < 512; item += F.G) {
        const int b = item >> 2, h = item & 3; const size_t row0 = (size_t)MP + (size_t)b * SSEQ;
        for (int e = tid; e < 3 * 512; e += NTHREADS) { const int w = e >> 9, t = (e >> 6) & 7, c2 = (e & 63) * 2;
            const unsigned u = *(const unsigned*)(Z + (row0 + t) * ZW + (w == 0 ? ZQ : (w == 1 ? ZK : ZV)) + h * 128 + c2);
            LAS float* dst = (w == 0 ? Qs : (w == 1 ? Ks : Vs)) + t * 128 + c2; dst[0] = bflo(u); dst[1] = bfhi(u); }
        const float m0 = m0g[b * 4 + h];
        if (tid < 16) { const int t = tid & 7; const float zv = bf2f(Z[(row0 + t) * ZW + (tid < 8 ? ZIG : ZFG) + h]);
            if (tid < 8) P[t] = zv + AR.in[I_BG][h]; else GT[7 * 8 + t] = log_sigmoid(zv + AR.in[I_BG][4 + h]); }
        __syncthreads();
        if (tid < 8) { float bs = 0.f, mx = m0, bsl = 0.f, gme = 0.f;
            for (int s = 0; s < 8; ++s) { bs += GT[7 * 8 + s]; const float g = P[s] - bs; if (s <= tid) { mx = fmaxf(mx, g); bsl = bs; } if (s == tid) gme = g; }
            GT[0 * 8 + tid] = bsl; GT[1 * 8 + tid] = gme; GT[2 * 8 + tid] = mx; GT[3 * 8 + tid] = fexp(m0 - mx);
            if (tid == 7) { const float mend = bsl + mx; SC[0] = mend; SC[1] = fexp(bsl + m0 - mend); } }
        __syncthreads();
        if (tid < 8) { const float mend = SC[0]; GT[5 * 8 + tid] = fexp(GT[0 * 8 + 7] + GT[1 * 8 + tid] - mend); }
        if (tid < 64) { const int t = tid >> 3, s = tid & 7; float d = 0.f;
            if (s <= t) { for (int k = 0; k < 128; ++k) d += Qs[t * 128 + k] * Ks[s * 128 + k]; d = d * MSCALE * fexp(GT[1 * 8 + s] - GT[2 * 8 + t]); }
            P[t * 8 + s] = d; }
        else if (tid < 72) { const int t = tid - 64; float d = 0.f; for (int k = 0; k < 128; ++k) d += Qs[t * 128 + k] * n0g[(size_t)(b * 4 + h) * 128 + k]; GT[6 * 8 + t] = d; }
        __syncthreads();
        if (tid < 8) { float d = 0.f; for (int s = 0; s < 8; ++s) d += P[tid * 8 + s]; d += GT[3 * 8 + tid] * GT[6 * 8 + tid];
            const float mt = GT[0 * 8 + tid] + GT[2 * 8 + tid]; GT[4 * 8 + tid] = fmaxf(fabsf(d), fexp(-mt)); }
        const int v = tid >> 2, seg = tid & 3;
        const float* C0p = C0g + ((size_t)(b * 4 + h) * 128 + v) * 128 + seg * 32;
        float c0[32];
#pragma unroll
        for (int i = 0; i < 8; ++i) { const f32x4 q = *(const f32x4*)(C0p + 4 * i); c0[4 * i] = q.x; c0[4 * i + 1] = q.y; c0[4 * i + 2] = q.z; c0[4 * i + 3] = q.w; }
        __syncthreads();
        float inter[8];
#pragma unroll
        for (int t = 0; t < 8; ++t) { float d = 0.f;
#pragma unroll
            for (int i = 0; i < 32; ++i) d += c0[i] * Qs[t * 128 + seg * 32 + i];
            d += __shfl_xor(d, 1); d += __shfl_xor(d, 2); inter[t] = d; }
        if (seg == 0) {
#pragma unroll
            for (int t = 0; t < 8; ++t) { float num = GT[3 * 8 + t] * inter[t];
                for (int s = 0; s <= t; ++s) num += P[t * 8 + s] * Vs[s * 128 + v];
                HT[t * 128 + v] = num / GT[4 * 8 + t]; } }
        { const float wst = SC[1]; float* Cout = F.out + O_SMC + ((size_t)(b * 4 + h) * 128 + v) * 128 + seg * 32;
#pragma unroll
            for (int i = 0; i < 32; ++i) c0[i] *= wst;
#pragma unroll
            for (int s = 0; s < 8; ++s) { const float wv = GT[5 * 8 + s] * Vs[s * 128 + v] * MSCALE;
#pragma unroll
                for (int i = 0; i < 32; ++i) c0[i] += wv * Ks[s * 128 + seg * 32 + i]; }
#pragma unroll
            for (int i = 0; i < 8; ++i) { f32x4 q; q.x = c0[4 * i]; q.y = c0[4 * i + 1]; q.z = c0[4 * i + 2]; q.w = c0[4 * i + 3]; *(f32x4*)(Cout + 4 * i) = q; } }
        if (tid < 128) { float n = SC[1] * n0g[(size_t)(b * 4 + h) * 128 + tid];
            for (int s = 0; s < 8; ++s) n += GT[5 * 8 + s] * Ks[s * 128 + tid] * MSCALE;
            F.out[O_SMN + (size_t)(b * 4 + h) * 128 + tid] = n; }
        if (tid == 0) F.out[O_SMM + b * 4 + h] = SC[0];
        __syncthreads();
        { const int t = wave; const float x0 = HT[t * 128 + lane], x1 = HT[t * 128 + 64 + lane];
            const float mean = wave_sum(x0 + x1) * (1.f / 128.f); const float d0 = x0 - mean, d1 = x1 - mean;
            const float rstd = 1.f / sqrtf(wave_sum(d0 * d0 + d1 * d1) * (1.f / 128.f) + HEAD_EPS);
            const size_t row = row0 + t;
            const float o0 = bf2f(Z[row * ZW + ZO + h * 128 + lane]), o1 = bf2f(Z[row * ZW + ZO + h * 128 + 64 + lane]);
            const float g0 = AR.in[I_MNG][h * 128 + lane], g1 = AR.in[I_MNG][h * 128 + 64 + lane];
            G[row * D + h * 128 + lane] = (bf16)f2bf(d0 * rstd * g0 * fsig(o0)); G[row * D + h * 128 + 64 + lane] = (bf16)f2bf(d1 * rstd * g1 * fsig(o1)); }
        __syncthreads();
    }
}

DI void rg1(Frame& F, const Args& AR) {
    const bf16* Z = (const bf16*)(F.ws + WS_Z); bf16* G = (bf16*)(F.ws + WS_H);
    float* RGH = (float*)(F.ws + WS_RGH); float* RGP = (float*)(F.ws + WS_RGP);
    const int lane = F.lane, g = F.wave, r = lane & 31, hh = lane >> 5;
    LAS float* XT = (LAS float*)(F.lds + g * 17408);
    LAS float* AT = XT + 32 * 68;
    const float* wa = AR.in[I_WA] + (size_t)g * 4096; const float* wx = AR.in[I_WX] + (size_t)g * 4096;
    bf16x8 Ba[4][2], Bx[4][2];
    { const GAS float* wab = (const GAS float*)(wa + 8 * hh * 64 + r); const GAS float* wxb = (const GAS float*)(wx + 8 * hh * 64 + r);
#pragma unroll
        for (int ks = 0; ks < 4; ++ks)
#pragma unroll
            for (int cb = 0; cb < 2; ++cb) { float a[8], x[8];
#pragma unroll
                for (int j = 0; j < 8; ++j) { const int i = 16 * ks + j; a[j] = wab[i * 64 + cb * 32]; x[j] = wxb[i * 64 + cb * 32]; }
                Ba[ks][cb] = pack8(a); Bx[ks][cb] = pack8(x); } }
    float spl[2], ba[2], bx[2];
#pragma unroll
    for (int cb = 0; cb < 2; ++cb) { const int c = 64 * g + cb * 32 + r; spl[cb] = -8.0f * log1pf(__expf(-AR.in[I_LAM][c])); ba[cb] = AR.in[I_BA][c]; bx[cb] = AR.in[I_BX][c]; }
    const float* cw = AR.in[I_CW]; const float* cbias = AR.in[I_CB];
    for (int tt = F.vcu; tt < M / 32; tt += F.G) {
        const int R0 = tt * 32, row = R0 + r; const bool samp = R0 >= MP;
        int t, b; if (!samp) { t = row & (PSEQ - 1); b = row >> 11; } else { t = (row - MP) & 7; b = (row - MP) >> 3; }
        bf16x8 Af[4];
#pragma unroll
        for (int ks = 0; ks < 4; ++ks) { const int c0 = 64 * g + 16 * ks + 8 * hh; float xc[8];
            { const f32x4 q0 = *(const f32x4*)(cbias + c0), q1 = *(const f32x4*)(cbias + c0 + 4); xc[0] = q0.x; xc[1] = q0.y; xc[2] = q0.z; xc[3] = q0.w; xc[4] = q1.x; xc[5] = q1.y; xc[6] = q1.z; xc[7] = q1.w; }
#pragma unroll
            for (int tap = 0; tap < 4; ++tap) { const int tp = t + tap - 3; const bool ok = tp >= 0; float xv[8];
                { const v4u q = *(const v4u*)(Z + (size_t)(ok ? row + tap - 3 : row) * ZW + ZXR + c0);
                    xv[0] = bflo(q.x); xv[1] = bfhi(q.x); xv[2] = bflo(q.y); xv[3] = bfhi(q.y); xv[4] = bflo(q.z); xv[5] = bfhi(q.z); xv[6] = bflo(q.w); xv[7] = bfhi(q.w); }
                if (samp) { const float* sp = AR.in[I_SRC] + ((size_t)b * 3 + (ok ? 0 : t + tap)) * 512 + c0; const f32x4 q0 = *(const f32x4*)sp, q1 = *(const f32x4*)(sp + 4);
                    if (!ok) { xv[0] = q0.x; xv[1] = q0.y; xv[2] = q0.z; xv[3] = q0.w; xv[4] = q1.x; xv[5] = q1.y; xv[6] = q1.z; xv[7] = q1.w; } }
                else if (!ok) {
#pragma unroll
                    for (int j = 0; j < 8; ++j) xv[j] = 0.f; }
                const f32x4 w0 = *(const f32x4*)(cw + tap * 512 + c0), w1 = *(const f32x4*)(cw + tap * 512 + c0 + 4);
                xc[0] += w0.x * xv[0]; xc[1] += w0.y * xv[1]; xc[2] += w0.z * xv[2]; xc[3] += w0.w * xv[3]; xc[4] += w1.x * xv[4]; xc[5] += w1.y * xv[5]; xc[6] += w1.z * xv[6]; xc[7] += w1.w * xv[7]; }
            Af[ks] = pack8(xc);
            LAS float* xp = XT + r * 68 + 16 * ks + 8 * hh;
            *(LAS f32x4*)xp = (f32x4){xc[0], xc[1], xc[2], xc[3]}; *(LAS f32x4*)(xp + 4) = (f32x4){xc[4], xc[5], xc[6], xc[7]};
            asm volatile("" ::: "memory"); }
        LDS_WAIT(); asm volatile("" ::: "memory");
#pragma unroll
        for (int cb = 0; cb < 2; ++cb) { f32x16 da, dx;
#pragma unroll
            for (int i = 0; i < 16; ++i) { da[i] = 0.f; dx[i] = 0.f; }
#pragma unroll
            for (int ks = 0; ks < 4; ++ks) { da = MFMA32(Af[ks], Ba[ks][cb], da); dx = MFMA32(Af[ks], Bx[ks][cb], dx); }
#pragma unroll
            for (int i = 0; i < 16; ++i) { const int tr = crow(i, hh), j = cb * 32 + r;
                const float rg = fsig(da[i] + ba[cb]), ig = fsig(dx[i] + bx[cb]);
                const float la = spl[cb] * rg, a = fexp(la), xcv = XT[tr * 68 + j];
                const float u = sqrtf(fmaxf(1.0f - a * a, 0.f)) * ig * xcv;
                AT[tr * 68 + j] = a; XT[tr * 68 + j] = u; } }
        LDS_WAIT(); asm volatile("" ::: "memory");
        { const int c = 64 * g + lane;
            if (!samp) { float h = 0.f, P = 1.f;
#pragma unroll 8
                for (int tr = 0; tr < 32; ++tr) { const float a = AT[tr * 68 + lane], u = XT[tr * 68 + lane]; h = a * h + u; P *= a;
                    RGH[(size_t)(R0 + tr) * 512 + c] = h; RGP[(size_t)(R0 + tr) * 512 + c] = P; } }
            else { float h = 0.f; const int b0 = (R0 - MP) >> 3;
#pragma unroll 8
                for (int tr = 0; tr < 32; ++tr) { const int bb = b0 + (tr >> 3);
                    if ((tr & 7) == 0) h = AR.in[I_SRH][(size_t)bb * 512 + c];
                    const float a = AT[tr * 68 + lane], u = XT[tr * 68 + lane]; h = a * h + u;
                    const float gr = bf2f(Z[(size_t)(R0 + tr) * ZW + ZGR + c]);
                    G[(size_t)(R0 + tr) * D + 512 + c] = (bf16)f2bf(h * gelu_tanh(gr));
                    if ((tr & 7) == 7) F.out[O_SRH + (size_t)bb * 512 + c] = h; } } }
        LDS_WAIT(); asm volatile("" ::: "memory");
    }
    { const int gt = F.vcu * NTHREADS + F.tid, NT = F.G * NTHREADS;
        for (int e = gt; e < NSEQ * 3 * 512; e += NT) { const int c = e & 511, j = (e >> 9) % 3, s = e / 1536;
            if (s < NPB) F.out[O_PRC + ((size_t)s * 3 + j) * 512 + c] = bf2f(Z[((size_t)s * PSEQ + PSEQ - 3 + j) * ZW + ZXR + c]);
            else { const int b = s - NPB; F.out[O_SRC + ((size_t)b * 3 + j) * 512 + c] = bf2f(Z[((size_t)MP + (size_t)b * SSEQ + SSEQ - 3 + j) * ZW + ZXR + c]); } } }
}

DI void ml2_scan(Frame& F, const Args& AR) {
    float* CST = (float*)(F.ws + WS_CST); float* NST = (float*)(F.ws + WS_NST); float* MST = (float*)(F.ws + WS_MST);
    for (int vb = F.vcu; vb < 256; vb += F.G) {
        const int bh = vb >> 3, e0 = ((vb & 7) * NTHREADS + F.tid) * 4;
        float m = 0.f; f32x4 C = (f32x4){0.f, 0.f, 0.f, 0.f};
        const bool nthr = (vb & 7) == 0 && F.tid < 128; float n = 0.f;
        for (int c = 0; c < 16; ++c) { const int item = bh * 16 + c; const float mloc = MST[item * 4 + 0], bL = MST[item * 4 + 1];
            float* cp = CST + (size_t)item * 16384 + e0; const f32x4 cl = *(const f32x4*)cp; *(f32x4*)cp = C;
            const float mn = fmaxf(bL + m, mloc), w0 = fexp(bL + m - mn), w1 = fexp(mloc - mn);
            C = C * w0 + cl * w1;
            if (nthr) { float* np = NST + item * 128 + F.tid; const float nl = *np; *np = n; n = n * w0 + nl * w1; if (F.tid == 0) MST[item * 4 + 2] = m; }
            m = mn; }
        *(f32x4*)(F.out + O_PMC + (size_t)bh * 16384 + e0) = C;
        if (nthr) { F.out[O_PMN + bh * 128 + F.tid] = n; if (F.tid == 0) F.out[O_PMM + bh] = m; }
    }
}
DI void rg2_carry(Frame& F, const Args& AR) {
    const float* RGH = (const float*)(F.ws + WS_RGH); const float* RGP = (const float*)(F.ws + WS_RGP); float* CARRY = (float*)(F.ws + WS_CARRY);
    const int gt = F.vcu * NTHREADS + F.tid, NT = F.G * NTHREADS;
    for (int e = gt; e < NPB * 512; e += NT) { const int b = e >> 9, c = e & 511; float H = 0.f;
        for (int k0 = 0; k0 < 64; k0 += 16) { float pe[16], he[16];
#pragma unroll
            for (int k = 0; k < 16; ++k) { const size_t row = (size_t)b * PSEQ + 32 * (k0 + k) + 31; pe[k] = RGP[row * 512 + c]; he[k] = RGH[row * 512 + c]; }
#pragma unroll
            for (int k = 0; k < 16; ++k) { CARRY[((size_t)b * 64 + k0 + k) * 512 + c] = H; H = pe[k] * H + he[k]; } }
        F.out[O_PRH + (size_t)b * 512 + c] = H; }
}
DI void rg2_apply(Frame& F, const Args& AR) {
    const bf16* Z = (const bf16*)(F.ws + WS_Z); bf16* G = (bf16*)(F.ws + WS_H);
    const float* RGH = (const float*)(F.ws + WS_RGH); const float* RGP = (const float*)(F.ws + WS_RGP); const float* CARRY = (const float*)(F.ws + WS_CARRY);
    const int gt = F.vcu * NTHREADS + F.tid, NT = F.G * NTHREADS;
    for (int e = gt; e < MP * 64; e += NT) { const int row = e >> 6, c0 = (e & 63) * 8, b = row >> 11, tile = (row & (PSEQ - 1)) >> 5;
        const v4u gq = *(const v4u*)(Z + (size_t)row * ZW + ZGR + c0);
        const float gr[8] = {bflo(gq.x), bfhi(gq.x), bflo(gq.y), bfhi(gq.y), bflo(gq.z), bfhi(gq.z), bflo(gq.w), bfhi(gq.w)};
        const float* hp = RGH + (size_t)row * 512 + c0; const float* pp = RGP + (size_t)row * 512 + c0; const float* cp = CARRY + ((size_t)b * 64 + tile) * 512 + c0;
        float o[8];
#pragma unroll
        for (int q = 0; q < 2; ++q) { const f32x4 h4 = *(const f32x4*)(hp + 4 * q), p4 = *(const f32x4*)(pp + 4 * q), c4 = *(const f32x4*)(cp + 4 * q);
            const f32x4 hv = h4 + p4 * c4; o[4 * q] = hv.x * gelu_tanh(gr[4 * q]); o[4 * q + 1] = hv.y * gelu_tanh(gr[4 * q + 1]); o[4 * q + 2] = hv.z * gelu_tanh(gr[4 * q + 2]); o[4 * q + 3] = hv.w * gelu_tanh(gr[4 * q + 3]); }
        v4u w; w.x = pk2(o[0], o[1]); w.y = pk2(o[2], o[3]); w.z = pk2(o[4], o[5]); w.w = pk2(o[6], o[7]);
        *(v4u*)(G + (size_t)row * D + 512 + c0) = w; }
}

DI void ml3_prompt(Frame& F, const Args& AR) {
    const bf16* Z = (const bf16*)(F.ws + WS_Z); bf16* G = (bf16*)(F.ws + WS_H);
    const float* CST = (const float*)(F.ws + WS_CST); const float* NST = (const float*)(F.ws + WS_NST); const float* MST = (const float*)(F.ws + WS_MST);
    LAS bf16* Qs = (LAS bf16*)F.lds;
    LAS bf16* Ks = (LAS bf16*)(F.lds + 34816);
    LAS bf16* Vs = (LAS bf16*)(F.lds + 69632);
    LAS float* LF = (LAS float*)(F.lds + 102400);
    LAS float* BC = LF + 128;
    LAS float* GS = BC + 128;
    LAS float* MX = GS + 128;
    LAS float* N0 = MX + 128;
    LAS float* RA = N0 + 128;
    LAS float* RB = RA + 256;
    LAS float* OT = (LAS float*)F.lds;
    const int tid = F.tid, lane = F.lane, wave = F.wave, r = lane & 31, hh = lane >> 5;
    const int tb = wave >> 1, vh = wave & 1, t = tb * 32 + r;
    for (int item = F.vcu; item < 512; item += F.G) {
        const int b = item >> 6, h = (item >> 4) & 3, c = item & 15; const size_t row0 = (size_t)b * PSEQ + c * 128;
        const float m0 = MST[item * 4 + 2]; const float* C0 = CST + (size_t)item * 16384;
#pragma unroll
        for (int i = 0; i < 4; ++i) { const int e = tid + i * NTHREADS, s = e >> 4, c8 = (e & 15) * 8; const bf16* zr = Z + (row0 + s) * ZW + h * 128 + c8;
            *(LAS v4u*)(Qs + s * 136 + c8) = *(const v4u*)(zr + ZQ); *(LAS v4u*)(Ks + s * 136 + c8) = *(const v4u*)(zr + ZK); *(LAS v4u*)(Vs + s * 128 + c8) = *(const v4u*)(zr + ZV); }
        if (tid < 128) { LF[tid] = log_sigmoid(bf2f(Z[(row0 + tid) * ZW + ZFG + h]) + AR.in[I_BG][4 + h]); N0[tid] = NST[item * 128 + tid]; }
        __syncthreads();
        if (tid < 128) { float bs = 0.f; for (int s = 0; s <= tid; ++s) bs += LF[s];
            BC[tid] = bs; GS[tid] = bf2f(Z[(row0 + tid) * ZW + ZIG + h]) + AR.in[I_BG][h] - bs; }
        __syncthreads();
        if (tid < 128) { float mx = m0; for (int s = 0; s <= tid; ++s) mx = fmaxf(mx, GS[s]); MX[tid] = mx; }
        __syncthreads();
        const float mxt = MX[t], winter = fexp(m0 - mxt);
        bf16x8 bq[8];
#pragma unroll
        for (int ks = 0; ks < 8; ++ks) bq[ks] = *(const LAS bf16x8*)(Qs + t * 136 + 16 * ks + 8 * hh);
        bf16x8 pp[4][2]; float den = 0.f;
#pragma unroll
        for (int sb = 0; sb < 4; ++sb) {
            if (sb <= tb) { f32x16 sa;
#pragma unroll
                for (int i = 0; i < 16; ++i) sa[i] = 0.f;
#pragma unroll
                for (int ks = 0; ks < 8; ++ks) sa = MFMA32(*(const LAS bf16x8*)(Ks + (sb * 32 + r) * 136 + 16 * ks + 8 * hh), bq[ks], sa);
                float pv[16];
#pragma unroll
                for (int i = 0; i < 16; ++i) { const int s = sb * 32 + crow(i, hh); float v = sa[i] * MSCALE * fexp(GS[s] - mxt); if (s > t) v = 0.f; pv[i] = v; den += v; }
                pp[sb][0] = mk_frag(pk2(pv[0], pv[1]), pk2(pv[2], pv[3]), pk2(pv[4], pv[5]), pk2(pv[6], pv[7]));
                pp[sb][1] = mk_frag(pk2(pv[8], pv[9]), pk2(pv[10], pv[11]), pk2(pv[12], pv[13]), pk2(pv[14], pv[15]));
            } else { pp[sb][0] = mk_frag(0u, 0u, 0u, 0u); pp[sb][1] = mk_frag(0u, 0u, 0u, 0u); } }
        den += __shfl_xor(den, 32);
        float qn = 0.f;
#pragma unroll 8
        for (int k = 0; k < 64; ++k) qn += N0[hh * 64 + k] * bf2f(Qs[t * 136 + hh * 64 + k]);
        qn += __shfl_xor(qn, 32);
        const float dtot = den + winter * qn, denom = fmaxf(fabsf(dtot), fexp(-(BC[t] + mxt))), rden = 1.0f / denom;
        float hv[2][16];
#pragma unroll
        for (int q = 0; q < 2; ++q) { const int vb = vh * 2 + q; f32x16 an, ai;
#pragma unroll
            for (int i = 0; i < 16; ++i) { an[i] = 0.f; ai[i] = 0.f; }
#pragma unroll
            for (int sb = 0; sb < 4; ++sb) if (sb <= tb) {
#pragma unroll
                for (int s2 = 0; s2 < 2; ++s2) { unsigned vw[8];
#pragma unroll
                    for (int j = 0; j < 8; ++j) vw[j] = Vs[(sb * 32 + 16 * s2 + 8 * (j >> 2) + 4 * hh + (j & 3)) * 128 + vb * 32 + r];
                    an = MFMA32(mk_frag(vw[0] | (vw[1] << 16), vw[2] | (vw[3] << 16), vw[4] | (vw[5] << 16), vw[6] | (vw[7] << 16)), pp[sb][s2], an); } }
#pragma unroll
            for (int ks = 0; ks < 8; ++ks) { const float* cp = C0 + (size_t)(vb * 32 + r) * 128 + 16 * ks + 8 * hh; const f32x4 c0 = *(const f32x4*)cp, c1 = *(const f32x4*)(cp + 4);
                ai = MFMA32(mk_frag(pk2(c0.x, c0.y), pk2(c0.z, c0.w), pk2(c1.x, c1.y), pk2(c1.z, c1.w)), bq[ks], ai); }
#pragma unroll
            for (int i = 0; i < 16; ++i) hv[q][i] = (an[i] + winter * ai[i]) * rden; }
        float s1 = 0.f;
#pragma unroll
        for (int q = 0; q < 2; ++q)
#pragma unroll
            for (int i = 0; i < 16; ++i) s1 += hv[q][i];
        s1 += __shfl_xor(s1, 32);
        if (hh == 0) RA[vh * 128 + t] = s1;
        __syncthreads();
        const float mean = (RA[t] + RA[128 + t]) * (1.f / 128.f); float s2 = 0.f;
#pragma unroll
        for (int q = 0; q < 2; ++q)
#pragma unroll
            for (int i = 0; i < 16; ++i) { hv[q][i] -= mean; s2 += hv[q][i] * hv[q][i]; }
        s2 += __shfl_xor(s2, 32);
        if (hh == 0) RB[vh * 128 + t] = s2;
        __syncthreads();
        const float rstd = 1.f / sqrtf((RB[t] + RB[128 + t]) * (1.f / 128.f) + HEAD_EPS);
#pragma unroll
        for (int q = 0; q < 2; ++q)
#pragma unroll
            for (int i = 0; i < 16; ++i) OT[t * 132 + (vh * 2 + q) * 32 + crow(i, hh)] = hv[q][i] * rstd;
        __syncthreads();
        { const int tt = tid >> 2, v0 = (tid & 3) * 32; const size_t row = row0 + tt;
#pragma unroll
            for (int q = 0; q < 4; ++q) { const int v = v0 + 8 * q; const v4u oq = *(const v4u*)(Z + row * ZW + ZO + h * 128 + v);
                const float og[8] = {bflo(oq.x), bfhi(oq.x), bflo(oq.y), bfhi(oq.y), bflo(oq.z), bfhi(oq.z), bflo(oq.w), bfhi(oq.w)};
                const f32x4 g0 = *(const f32x4*)(AR.in[I_MNG] + h * 128 + v), g1 = *(const f32x4*)(AR.in[I_MNG] + h * 128 + v + 4);
                const f32x4 x0 = *(const LAS f32x4*)(OT + tt * 132 + v), x1 = *(const LAS f32x4*)(OT + tt * 132 + v + 4);
                v4u w; w.x = pk2(x0.x * g0.x * fsig(og[0]), x0.y * g0.y * fsig(og[1])); w.y = pk2(x0.z * g0.z * fsig(og[2]), x0.w * g0.w * fsig(og[3]));
                w.z = pk2(x1.x * g1.x * fsig(og[4]), x1.y * g1.y * fsig(og[5])); w.w = pk2(x1.z * g1.z * fsig(og[6]), x1.w * g1.w * fsig(og[7]));
                *(v4u*)(G + row * D + h * 128 + v) = w; } }
        __syncthreads();
    }
}

constexpr int TC = 32;
constexpr int RW_ARR = TC * 64;
constexpr int RW_BUF_FLOATS = 6 * RW_ARR + 2 * TC;
struct RwRaw { v2u r, k, v, w, a, g; };
DI void rw_load(RwRaw& x, const bf16* RK, const bf16* WAG, size_t row, size_t row_safe, int h, int k4, bool valid) {
    const size_t rr = valid ? row : row_safe;
    const bf16* p = RK + rr * RKW + h * 64 + k4; const bf16* q = WAG + rr * WAGW + h * 64 + k4;
    x.r = *(const v2u*)p; x.k = *(const v2u*)(p + 1024); x.v = *(const v2u*)(p + 2048); x.w = *(const v2u*)q; x.a = *(const v2u*)(q + 1024); x.g = *(const v2u*)(q + 2048);
}
DI void un4(const v2u u, float (&f)[4]) { f[0] = bflo(u.x); f[1] = bfhi(u.x); f[2] = bflo(u.y); f[3] = bfhi(u.y); }
DI float rw_prep(const RwRaw& x, LAS float* buf, int tok, int k4, const float (&kkw)[4], const float (&kaw)[4], const float (&rkw)[4]) {
    float r[4], k[4], v[4], w[4], a[4]; un4(x.r, r); un4(x.k, k); un4(x.v, v); un4(x.w, w); un4(x.a, a);
    float kk[4], ss = 0.f, bs = 0.f, km[4];
#pragma unroll
    for (int j = 0; j < 4; ++j) { kk[j] = k[j] * kkw[j]; ss += kk[j] * kk[j]; km[j] = k[j] * (1.0f + (a[j] - 1.0f) * kaw[j]); bs += r[j] * km[j] * rkw[j]; }
    ss = sum16(ss); bs = sum16(bs);
    const float inv = 1.0f / fmaxf(sqrtf(ss), 1e-12f);
    f32x4 o0, o1, o2, o3, o4, o5; float br = 0.f, kr = 0.f;
#pragma unroll
    for (int j = 0; j < 4; ++j) { const float kn = kk[j] * inv, dc = __builtin_amdgcn_exp2f(w[j]); o0[j] = kn; o1[j] = kn * a[j]; o2[j] = km[j]; o3[j] = dc; o4[j] = dc * r[j]; o5[j] = v[j];
        br += kn * a[j] * r[j]; kr += km[j] * r[j]; }
    br = sum16(br); kr = sum16(kr);
    LAS float* p = buf + tok * 64 + k4;
    *(LAS f32x4*)p = o0; *(LAS f32x4*)(p + RW_ARR) = o1; *(LAS f32x4*)(p + 2 * RW_ARR) = o2; *(LAS f32x4*)(p + 3 * RW_ARR) = o3;
    *(LAS f32x4*)(p + 4 * RW_ARR) = o4; *(LAS f32x4*)(p + 5 * RW_ARR) = o5;
    if (k4 == 0) *(LAS f32x2*)(buf + 6 * RW_ARR + 2 * tok) = (f32x2){br, kr};
    return bs;
}
#define BAR_LDS() do { asm volatile("s_waitcnt lgkmcnt(0)" ::: "memory"); __builtin_amdgcn_s_barrier(); asm volatile("" ::: "memory"); } while (0)
#define NOPK(x) asm volatile("" : "+v"(x))
DI void sum8x2(float& a, float& b) {
    asm volatile("s_nop 1\n\t"
                 "v_add_f32_dpp %0, %0, %0 quad_perm:[1,0,3,2] row_mask:0xf bank_mask:0xf\n\tv_add_f32_dpp %1, %1, %1 quad_perm:[1,0,3,2] row_mask:0xf bank_mask:0xf\n\ts_nop 0\n\t"
                 "v_add_f32_dpp %0, %0, %0 quad_perm:[2,3,0,1] row_mask:0xf bank_mask:0xf\n\tv_add_f32_dpp %1, %1, %1 quad_perm:[2,3,0,1] row_mask:0xf bank_mask:0xf\n\ts_nop 0\n\t"
                 "v_add_f32_dpp %0, %0, %0 row_half_mirror row_mask:0xf bank_mask:0xf\n\tv_add_f32_dpp %1, %1, %1 row_half_mirror row_mask:0xf bank_mask:0xf\n\ts_nop 0"
                 : "+v"(a), "+v"(b));
}
struct StepV { f32x4 ka, kb, ba, bb, ma, mb, da, db, ea, eb; float vv; f32x2 sc; };
DI void ld_step(StepV& s, const LAS float* cur, int tk, int p, int row) {
    const LAS float* q = cur + tk * 64 + 8 * p;
    s.ka = *(const LAS f32x4*)q; s.kb = *(const LAS f32x4*)(q + 4); s.ba = *(const LAS f32x4*)(q + RW_ARR); s.bb = *(const LAS f32x4*)(q + RW_ARR + 4);
    s.ma = *(const LAS f32x4*)(q + 2 * RW_ARR); s.mb = *(const LAS f32x4*)(q + 2 * RW_ARR + 4); s.da = *(const LAS f32x4*)(q + 3 * RW_ARR); s.db = *(const LAS f32x4*)(q + 3 * RW_ARR + 4);
    s.ea = *(const LAS f32x4*)(q + 4 * RW_ARR); s.eb = *(const LAS f32x4*)(q + 4 * RW_ARR + 4);
    s.vv = cur[5 * RW_ARR + tk * 64 + row]; s.sc = *(const LAS f32x2*)(cur + 6 * RW_ARR + 2 * tk);
}
DI void ld_step_asm(StepV& s, unsigned aq, unsigned av, unsigned asc) {
    asm volatile("ds_read_b128 %0, %12\n\tds_read_b128 %1, %12 offset:16\n\tds_read_b128 %2, %12 offset:8192\n\tds_read_b128 %3, %12 offset:8208\n\t"
                 "ds_read_b128 %4, %12 offset:16384\n\tds_read_b128 %5, %12 offset:16400\n\tds_read_b128 %6, %12 offset:24576\n\tds_read_b128 %7, %12 offset:24592\n\t"
                 "ds_read_b128 %8, %12 offset:32768\n\tds_read_b128 %9, %12 offset:32784\n\tds_read_b32 %10, %13\n\tds_read_b64 %11, %14"
                 : "=&v"(s.ka), "=&v"(s.kb), "=&v"(s.ba), "=&v"(s.bb), "=&v"(s.ma), "=&v"(s.mb), "=&v"(s.da), "=&v"(s.db), "=&v"(s.ea), "=&v"(s.eb), "=&v"(s.vv), "=&v"(s.sc)
                 : "v"(aq), "v"(av), "v"(asc) : "memory");
}
DI void wait_step(StepV& s) {
    asm volatile("s_waitcnt lgkmcnt(0)" : "+v"(s.ka), "+v"(s.kb), "+v"(s.ba), "+v"(s.bb), "+v"(s.ma), "+v"(s.mb), "+v"(s.da), "+v"(s.db), "+v"(s.ea), "+v"(s.eb), "+v"(s.vv), "+v"(s.sc) :: "memory");
}
DI void wait_step1(StepV& s) {
    asm volatile("s_waitcnt lgkmcnt(1)" : "+v"(s.ka), "+v"(s.kb), "+v"(s.ba), "+v"(s.bb), "+v"(s.ma), "+v"(s.mb), "+v"(s.da), "+v"(s.db), "+v"(s.ea), "+v"(s.eb), "+v"(s.vv), "+v"(s.sc) :: "memory");
}
DI void rw_step(float (&S)[8], const StepV& c, LAS float* ydst, bool wr) {
    const float kk[8] = {c.ka.x, c.ka.y, c.ka.z, c.ka.w, c.kb.x, c.kb.y, c.kb.z, c.kb.w}, ee[8] = {c.ea.x, c.ea.y, c.ea.z, c.ea.w, c.eb.x, c.eb.y, c.eb.z, c.eb.w};
    const float dd[8] = {c.da.x, c.da.y, c.da.z, c.da.w, c.db.x, c.db.y, c.db.z, c.db.w}, bb[8] = {c.ba.x, c.ba.y, c.ba.z, c.ba.w, c.bb.x, c.bb.y, c.bb.z, c.bb.w};
    const float mm[8] = {c.ma.x, c.ma.y, c.ma.z, c.ma.w, c.mb.x, c.mb.y, c.mb.z, c.mb.w};
    float a0 = S[0] * kk[0], a1 = S[4] * kk[4], y0 = S[0] * ee[0], y1 = S[4] * ee[4];
#pragma unroll
    for (int j = 1; j < 4; ++j) { a0 = fmaf(S[j], kk[j], a0); a1 = fmaf(S[4 + j], kk[4 + j], a1); y0 = fmaf(S[j], ee[j], y0); y1 = fmaf(S[4 + j], ee[4 + j], y1); }
    float a = a0 + a1, y = y0 + y1; NOPK(a); NOPK(y);
    sum8x2(a, y);
    const float sa = -a, v = c.vv;
#pragma unroll
    for (int j = 0; j < 8; ++j) { float t = S[j] * dd[j]; t = fmaf(mm[j], v, t); t = fmaf(bb[j], sa, t); NOPK(t); S[j] = t; }
    if (wr) *ydst = fmaf(v, c.sc.y, fmaf(sa, c.sc.x, y));
    asm volatile("" ::: "memory");
}
DI void rw_prompt_half(Frame& F, const Args& AR, int b, int h, int half, float* Sout) {
    const bf16* RK = (const bf16*)(F.ws + WS_RK); const bf16* WAG = (const bf16*)(F.ws + WS_WAG); bf16* G = (bf16*)(F.ws + WS_H); float* BN = (float*)(F.ws + WS_BN);
    LAS float* BUF = (LAS float*)F.lds;
    LAS float* YB = BUF + 2 * RW_BUF_FLOATS;
    const int tid = F.tid; const size_t row0 = (size_t)b * PSEQ;
    constexpr int nch = PSEQ / TC;
    if (tid < 256) {
        const int rl = tid >> 3, row = 32 * half + rl, p = tid & 7;
        float S[8];
#pragma unroll
        for (int j = 0; j < 8; ++j) S[j] = 0.f;
#ifdef PROBE_SHADOW
        float S2[8];
#pragma unroll
        for (int j = 0; j < 8; ++j) S2[j] = 1.f;
#endif
        BAR_LDS();
        for (int ch = 0; ch < nch; ++ch) {
            const LAS float* cur = BUF + (ch & 1) * RW_BUF_FLOATS; LAS float* yb = YB + (ch & 1) * (TC * 32);
            const unsigned cb = (unsigned)(size_t)cur; unsigned aq = cb + 32u * p, av = cb + 40960u + 4u * row, asc = cb + 49152u;
            StepV A, B; ld_step_asm(A, aq, av, asc); wait_step(A);
#pragma unroll 1
            for (int tk = 0; tk < TC; tk += 2) {
                ld_step_asm(B, aq + 256u, av + 256u, asc + 8u);
                rw_step(S, A, yb + tk * 32 + rl, p == 0);
#ifdef PROBE_SHADOW
                rw_step(S2, A, yb, false);
#endif
                wait_step1(B);
                aq += 512u; av += 512u; asc += 16u;
                const unsigned back = (tk + 2 < TC) ? 0u : 256u;
                ld_step_asm(A, aq - back, av - back, asc - (back >> 5));
                rw_step(S, B, yb + (tk + 1) * 32 + rl, p == 0);
#ifdef PROBE_SHADOW
                rw_step(S2, B, yb, false);
#endif
                wait_step1(A);
            }
            BAR_LDS();
        }
#ifdef PROBE_SHADOW
#pragma unroll
        for (int j = 0; j < 8; ++j) asm volatile("" :: "v"(S2[j]));
#endif
        *(f32x4*)(Sout + row * 64 + 8 * p) = (f32x4){S[0], S[1], S[2], S[3]}; *(f32x4*)(Sout + row * 64 + 8 * p + 4) = (f32x4){S[4], S[5], S[6], S[7]};
        BAR_LDS();
    } else {
        const int ht = tid - 256, tk0 = ht >> 4, k4 = (ht & 15) * 4;
        const int yt = ht >> 3, yv4 = (ht & 7) * 4;
        float kkw[4], kaw[4], rkw[4];
#pragma unroll
        for (int j = 0; j < 4; ++j) { const int c = h * 64 + k4 + j; kkw[j] = AR.in[I_KK][c]; kaw[j] = AR.in[I_KA][c]; rkw[j] = AR.in[I_RK][c]; }
        RwRaw raw[2];
#pragma unroll
        for (int i = 0; i < 2; ++i) { rw_load(raw[i], RK, WAG, row0 + tk0 + 16 * i, row0, h, k4, true);
            const float bn = rw_prep(raw[i], BUF, tk0 + 16 * i, k4, kkw, kaw, rkw); if (half == 0 && k4 == 0) BN[(row0 + tk0 + 16 * i) * 16 + h] = bn; }
#pragma unroll
        for (int i = 0; i < 2; ++i) rw_load(raw[i], RK, WAG, row0 + TC + tk0 + 16 * i, row0, h, k4, true);
        BAR_LDS();
        for (int ch = 0; ch < nch; ++ch) {
            const int base = ch * TC;
            if (ch > 0) { const f32x4 y4 = *(const LAS f32x4*)(YB + ((ch - 1) & 1) * (TC * 32) + yt * 32 + yv4);
                v2u w; w.x = pk2(y4.x, y4.y); w.y = pk2(y4.z, y4.w); *(v2u*)(G + (row0 + base - TC + yt) * D + h * 64 + 32 * half + yv4) = w; }
            if (ch + 1 < nch) {
#pragma unroll
                for (int i = 0; i < 2; ++i) { const float bn = rw_prep(raw[i], BUF + ((ch + 1) & 1) * RW_BUF_FLOATS, tk0 + 16 * i, k4, kkw, kaw, rkw);
                    if (half == 0 && k4 == 0) BN[(row0 + base + TC + tk0 + 16 * i) * 16 + h] = bn; }
#pragma unroll
                for (int i = 0; i < 2; ++i) rw_load(raw[i], RK, WAG, row0 + base + 2 * TC + tk0 + 16 * i, row0, h, k4, base + 2 * TC < PSEQ);
            }
            BAR_LDS();
        }
        { const f32x4 y4 = *(const LAS f32x4*)(YB + ((nch - 1) & 1) * (TC * 32) + yt * 32 + yv4);
            v2u w; w.x = pk2(y4.x, y4.y); w.y = pk2(y4.z, y4.w); *(v2u*)(G + (row0 + PSEQ - TC + yt) * D + h * 64 + 32 * half + yv4) = w; }
        BAR_LDS();
    }
}
DI void rw_gn_pass(Frame& F, const Args& AR) {
    const bf16* RK = (const bf16*)(F.ws + WS_RK); const bf16* WAG = (const bf16*)(F.ws + WS_WAG); bf16* G = (bf16*)(F.ws + WS_H); const float* BN = (const float*)(F.ws + WS_BN);
    const int gt = F.vcu * NTHREADS + F.tid, NT = F.G * NTHREADS;
    for (int e = gt; e < MP * 256; e += NT) { const int row = e >> 8, h = (e >> 4) & 15, k4 = (e & 15) * 4, c = h * 64 + k4;
        bf16* gp = G + (size_t)row * D + c; float y[4], v[4], g[4]; un4(*(const v2u*)gp, y); un4(*(const v2u*)(RK + (size_t)row * RKW + 2048 + c), v); un4(*(const v2u*)(WAG + (size_t)row * WAGW + 2048 + c), g);
        const f32x4 lg = *(const f32x4*)(AR.in[I_LXG] + c), lb = *(const f32x4*)(AR.in[I_LXB] + c); const float bn = BN[row * 16 + h];
        const float mean = sum16((y[0] + y[1]) + (y[2] + y[3])) * (1.f / 64.f);
        const float d0 = y[0] - mean, d1 = y[1] - mean, d2 = y[2] - mean, d3 = y[3] - mean;
        const float rstd = __builtin_amdgcn_rsqf(sum16((d0 * d0 + d1 * d1) + (d2 * d2 + d3 * d3)) * (1.f / 64.f) + RW_EPS);
        v2u w; w.x = pk2((d0 * rstd * lg.x + lb.x + bn * v[0]) * g[0], (d1 * rstd * lg.y + lb.y + bn * v[1]) * g[1]);
        w.y = pk2((d2 * rstd * lg.z + lb.z + bn * v[2]) * g[2], (d3 * rstd * lg.w + lb.w + bn * v[3]) * g[3]);
        *(v2u*)gp = w; }
}
constexpr int RS_WAVE_BYTES = 16640;
DI void ld8b(float (&f)[8], const bf16* p) { const v4u q = *(const v4u*)p; f[0] = bflo(q.x); f[1] = bfhi(q.x); f[2] = bflo(q.y); f[3] = bfhi(q.y); f[4] = bflo(q.z); f[5] = bfhi(q.z); f[6] = bflo(q.w); f[7] = bfhi(q.w); }
DI void st8(LAS float* p, const float (&f)[8]) { *(LAS f32x4*)p = (f32x4){f[0], f[1], f[2], f[3]}; *(LAS f32x4*)(p + 4) = (f32x4){f[4], f[5], f[6], f[7]}; }
DI void rw_sample_wave(Frame& F, const Args& AR, int item) {
    const bf16* RK = (const bf16*)(F.ws + WS_RK); const bf16* WAG = (const bf16*)(F.ws + WS_WAG); bf16* G = (bf16*)(F.ws + WS_H);
    const int lane = F.lane, b = item >> 4, h = item & 15; const size_t row0 = (size_t)MP + (size_t)b * SSEQ;
    LAS float* L = (LAS float*)(F.lds + F.wave * RS_WAVE_BYTES);
    { const int tok = lane >> 3, k8 = (lane & 7) * 8, c = h * 64 + k8;
        float r[8], k[8], v[8], w[8], a[8], g[8];
        { const bf16* p = RK + (row0 + tok) * RKW + c; const bf16* q = WAG + (row0 + tok) * WAGW + c; ld8b(r, p); ld8b(k, p + 1024); ld8b(v, p + 2048); ld8b(w, q); ld8b(a, q + 1024); ld8b(g, q + 2048); }
        float kkw[8], kaw[8], rkw[8]; ld8(kkw, AR.in[I_KK] + c); ld8(kaw, AR.in[I_KA] + c); ld8(rkw, AR.in[I_RK] + c);
        float kk[8], km[8], ss = 0.f, bs = 0.f;
#pragma unroll
        for (int j = 0; j < 8; ++j) { kk[j] = k[j] * kkw[j]; ss += kk[j] * kk[j]; km[j] = k[j] * (1.0f + (a[j] - 1.0f) * kaw[j]); bs += r[j] * km[j] * rkw[j]; }
        ss = sum8(ss); bs = sum8(bs);
        const float inv = 1.0f / fmaxf(sqrtf(ss), 1e-12f);
        float o1[8], o3[8], o4[8], br = 0.f, kr = 0.f;
#pragma unroll
        for (int j = 0; j < 8; ++j) { kk[j] *= inv; o1[j] = kk[j] * a[j]; o3[j] = __builtin_amdgcn_exp2f(w[j]); o4[j] = o3[j] * r[j]; br += o1[j] * r[j]; kr += km[j] * r[j]; }
        br = sum8(br); kr = sum8(kr);
        LAS float* p = L + tok * 64 + k8;
        st8(p, kk); st8(p + 512, o1); st8(p + 1024, km); st8(p + 1536, o3); st8(p + 2048, o4); st8(p + 2560, v); st8(p + 3072, g);
        if (k8 == 0) { L[3584 + 2 * tok] = br; L[3584 + 2 * tok + 1] = kr; L[3600 + tok] = bs; } }
    float S[64];
    { const float* sp = AR.in[I_SWKV] + (size_t)item * 4096 + lane * 64;
#pragma unroll
        for (int j = 0; j < 16; ++j) { const f32x4 q = *(const f32x4*)(sp + 4 * j); S[4 * j] = q.x; S[4 * j + 1] = q.y; S[4 * j + 2] = q.z; S[4 * j + 3] = q.w; } }
    LDS_WAIT(); asm volatile("" ::: "memory");
    LAS float* YS = L + 3616;
#pragma unroll 1
    for (int tk = 0; tk < SSEQ; ++tk) { const LAS float* q = L + tk * 64;
        float a0 = 0.f, a1 = 0.f, y0 = 0.f, y1 = 0.f;
#pragma unroll
        for (int c4 = 0; c4 < 16; ++c4) { const f32x4 kq = *(const LAS f32x4*)(q + 4 * c4), eq = *(const LAS f32x4*)(q + 2048 + 4 * c4);
            a0 = fmaf(S[4 * c4], kq.x, a0); a1 = fmaf(S[4 * c4 + 1], kq.y, a1); a0 = fmaf(S[4 * c4 + 2], kq.z, a0); a1 = fmaf(S[4 * c4 + 3], kq.w, a1);
            y0 = fmaf(S[4 * c4], eq.x, y0); y1 = fmaf(S[4 * c4 + 1], eq.y, y1); y0 = fmaf(S[4 * c4 + 2], eq.z, y0); y1 = fmaf(S[4 * c4 + 3], eq.w, y1); }
        const float sa = -(a0 + a1), v = q[2560 + lane]; const f32x2 sc = *(const LAS f32x2*)(L + 3584 + 2 * tk);
#pragma unroll
        for (int c4 = 0; c4 < 16; ++c4) { const f32x4 dq = *(const LAS f32x4*)(q + 1536 + 4 * c4), bq = *(const LAS f32x4*)(q + 512 + 4 * c4), mq = *(const LAS f32x4*)(q + 1024 + 4 * c4);
            S[4 * c4] = fmaf(bq.x, sa, fmaf(mq.x, v, S[4 * c4] * dq.x)); S[4 * c4 + 1] = fmaf(bq.y, sa, fmaf(mq.y, v, S[4 * c4 + 1] * dq.y));
            S[4 * c4 + 2] = fmaf(bq.z, sa, fmaf(mq.z, v, S[4 * c4 + 2] * dq.z)); S[4 * c4 + 3] = fmaf(bq.w, sa, fmaf(mq.w, v, S[4 * c4 + 3] * dq.w)); }
        YS[tk * 64 + lane] = fmaf(v, sc.y, fmaf(sa, sc.x, y0 + y1)); }
    { float* sp = F.out + O_SWKV + (size_t)item * 4096 + lane * 64;
#pragma unroll
        for (int j = 0; j < 16; ++j) *(f32x4*)(sp + 4 * j) = (f32x4){S[4 * j], S[4 * j + 1], S[4 * j + 2], S[4 * j + 3]}; }
    LDS_WAIT(); asm volatile("" ::: "memory");
    { const float lg = AR.in[I_LXG][h * 64 + lane], lb = AR.in[I_LXB][h * 64 + lane];
#pragma unroll 1
        for (int tk = 0; tk < SSEQ; ++tk) { const float y = YS[tk * 64 + lane];
            const float mean = wave_sum(y) * (1.f / 64.f), d = y - mean, rstd = __builtin_amdgcn_rsqf(wave_sum(d * d) * (1.f / 64.f) + RW_EPS);
            const float o = (d * rstd * lg + lb + L[3600 + tk] * L[2560 + tk * 64 + lane]) * L[3072 + tk * 64 + lane];
            G[(row0 + tk) * D + h * 64 + lane] = (bf16)f2bf(o); } }
    LDS_WAIT(); asm volatile("" ::: "memory");
}
#ifndef PROBE_RW
#define PROBE_RW 0
#endif
DI void rwkv_scan(Frame& F, const Args& AR) {
    for (int rep = 0; rep < (PROBE_RW == 1 ? 2 : 1); ++rep)
    for (int it = F.vcu; it < NPB * 16 * 2; it += F.G) { const int bh = it >> 1, b = bh >> 4, h = bh & 15;
        rw_prompt_half(F, AR, b, h, it & 1, F.out + O_PWKV + (size_t)bh * 4096); }
    __syncthreads();
    for (int rep = 0; rep < (PROBE_RW == 2 ? 2 : 1); ++rep)
    for (int item = F.vcu * NWAVES + F.wave; item < NSB * 16; item += F.G * NWAVES) rw_sample_wave(F, AR, item);
}

#ifndef MK_N_LAUNCHES
#define MK_N_LAUNCHES 1
#endif
#ifdef PROBE_DUP_PH
constexpr int NPHASES = 28;
#else
constexpr int NPHASES = 27;
#endif
enum { K_P0 = 0, K_MODX, K_UP, K_RESID, K_LN, K_WIN, K_MIXA, K_MIXB, K_MIXC, K_R1, K_R2, K_R3, K_MOD, K_R3B };

__global__ void __launch_bounds__(NTHREADS, 2) mega_fwd(Args AR) {
    extern __shared__ __attribute__((aligned(16))) unsigned char lds[];
    Frame F;
    F.lds = (LAS unsigned char*)lds;
    F.MISC = (volatile LAS unsigned*)(F.lds + MISC_OFF);
    F.tid = threadIdx.x; F.lane = F.tid & 63; F.wave = __builtin_amdgcn_readfirstlane(F.tid >> 6);
    F.G = gridDim.x; { const int bx = blockIdx.x; F.vcu = (F.G % 8 == 0) ? (bx % 8) * (F.G / 8) + bx / 8 : bx; }
    F.ws = AR.ws; F.out = AR.out; F.ctl = (gu32*)(AR.ws + WS_CTL);
    for (int u = F.tid; u < (LDS_BYTES - LDSCTL_OFF) / 4; u += NTHREADS) ((LAS unsigned*)(F.lds + LDSCTL_OFF))[u] = 0u;
    __syncthreads();
    const int lo = AR.ph_lo, hi = AR.ph_hi;
    XcdBarrier bar; bar.bar = (unsigned*)(F.ctl + CW_BAR); bar.x = 0; bar.st = nullptr;
    if (hi - lo > 1) bar = xcd_barrier_post((unsigned*)(F.ctl + CW_BAR), F.MISC + 8);

#ifndef PROBE_DUP_PH
#define PROBE_DUP_PH 1000
#endif
    for (int phs = lo; phs < hi; ++phs) {
        const int ph = phs > PROBE_DUP_PH ? phs - 1 : phs; const bool dupfirst = (phs == PROBE_DUP_PH);
        float* X = F.out + O_Y; const float* mod = (const float*)(F.ws + WS_MOD); bf16* H = (bf16*)(F.ws + WS_H);
        int kind = K_LN, f = 0, l = 0, sub = 0, js = 0, first = 0, mode = 0, lm = 0, which = 0, fin = 0;
        switch (ph == 0 ? 0 : (ph == 1 ? 100 : (ph <= 20 ? ph - 1 : (ph == 21 ? 101 : ph - 2)))) {
            case 0: kind = K_P0; break;
            case 100: kind = K_MOD; break;
            case 101: kind = K_R3B; break;
            case 1: kind = K_MODX; break;
            case 2: kind = K_UP; f = 0; break;
            case 3: kind = K_RESID; which = 0; f = 0; l = 0; js = 0; first = 1; break;
            case 4: kind = K_LN; l = 0; sub = 0; lm = 0; js = 3; mode = 0; break;
            case 5: kind = K_WIN; break;
            case 6: kind = K_MIXA; break;
            case 7: kind = K_MIXB; break;
            case 8: kind = K_MIXC; break;
            case 9: kind = K_RESID; which = 1; l = 0; js = 3; break;
            case 10: kind = K_LN; l = 0; sub = 1; lm = 0; js = 6; mode = 0; break;
            case 11: kind = K_UP; f = 1; break;
            case 12: kind = K_RESID; which = 0; f = 1; l = 0; js = 6; break;
            case 13: kind = K_LN; l = 0; sub = 2; lm = 1; js = 0; mode = 0; break;
            case 14: kind = K_UP; f = 2; break;
            case 15: kind = K_RESID; which = 0; f = 2; l = 1; js = 0; break;
            case 16: kind = K_LN; l = 1; sub = 0; lm = 1; js = 3; mode = 1; break;
            case 17: kind = K_R1; break;
            case 18: kind = K_R2; break;
            case 19: kind = K_R3; break;
            case 20: kind = K_RESID; which = 2; l = 1; js = 3; break;
            case 21: kind = K_LN; l = 1; sub = 1; lm = 1; js = 6; mode = 0; break;
            case 22: kind = K_UP; f = 3; break;
            case 23: kind = K_RESID; which = 0; f = 3; l = 1; js = 6; fin = 1; break;
            default: kind = K_LN; l = 1; sub = 2; lm = 1; js = 0; mode = 2; fin = 1; break;
        }
#ifndef PHMASK
#define PHMASK 0xFFFFF
#endif
        { int t_ = F.tid; asm volatile("" : "+v"(t_)); F.tid = t_; F.lane = t_ & 63; F.wave = __builtin_amdgcn_readfirstlane(t_ >> 6);

          int v_ = F.vcu; asm volatile("" : "+s"(v_)); F.vcu = v_; int g_ = F.G; asm volatile("" : "+s"(g_)); F.G = g_;
          unsigned l_ = (unsigned)(size_t)F.lds; asm volatile("" : "+s"(l_)); F.lds = (LAS unsigned char*)(size_t)l_; }
        switch (kind) {
            case K_P0: p0_sctab(F, AR); p0_weights(F, AR); break;
            case K_MOD: p0_mod(F, AR); break;
            case K_MODX: if ((PHMASK >> K_MODX) & 1) ln_pass(F, AR, 1, 0, 0, 0, 0, 0, 0, 0, 0, 0); break;
            case K_UP: if ((PHMASK >> K_UP) & 1) {
                pg8::Gemm g{H, (const bf16*)(F.ws + WS_W13) + (size_t)f * 5632 * 1024, M, 5632, 1024}; pg8::StaticOrder S; S.init(M, 5632, F.G, (int)blockIdx.x); S.ntk = 16;
                pg8::EpiSwiglu E{(bf16*)(F.ws + WS_HID), FF};
                pg8::gemm_phase<pg8::EpiSwiglu, pg8::StaticOrder, true, true>(F.lds, g, S, E, F.tid);
            } break;
            case K_RESID: if ((PHMASK >> K_RESID) & 1) {
                const bf16* A = which == 0 ? (const bf16*)(F.ws + WS_HID) : H; const int K = which == 0 ? FF : 1024;
                const bf16* Bt = which == 0 ? (const bf16*)(F.ws + WS_W2) + (size_t)f * 1024 * FF : (which == 1 ? (const bf16*)(F.ws + WS_WOUT) : (const bf16*)(F.ws + WS_WO));
                const int nsp = (F.G == 256) ? (which == 0 ? 11 : 4) : 0;
                pg8::Gemm g{A, Bt, M, 1024, K}; SplitOrder S; S.base.init(nsp ? MP : M, 1024, F.G, (int)blockIdx.x); S.base.ntk = K / 64; S.S = nsp;
                EpiResid E{AR, F.out, F.ws, (first ? 1 : 0) | (l << 1) | ((js + 2) << 2) | (which == 0 ? 0 : 64) | (dupfirst ? 128 : 0) | (fin ? 256 : 0)};
                pg8::gemm_phase<EpiResid, SplitOrder, true, true>(F.lds, g, S, E, F.tid);
                if (fin && nsp) {
                    const v4u* src = (const v4u*)((unsigned char*)F.out + XB_OFF + (size_t)MP * 2048); v4u* dst = (v4u*)(F.ws + WS_ZF + (size_t)MP * 2048);
                    for (int e = F.vcu * NTHREADS + F.tid; e < MS * 128; e += F.G * NTHREADS) dst[e] = src[e]; }
            } break;
            case K_LN: if ((PHMASK >> K_LN) & 1) ln_pass(F, AR, 0, 1, l, sub, lm, js, mode, (F.G == 256) ? (sub == 1 ? 4 : 11) : 0, ph == 5, fin); break;
            case K_WIN: if ((PHMASK >> K_WIN) & 1) {
                pg8::Gemm g{H, (const bf16*)(F.ws + WS_WIN), M, ZW, 1024}; pg8::StaticOrder S; S.init(M, ZW, F.G, (int)blockIdx.x); S.ntk = 16;
                pg8::EpiStore E{(bf16*)(F.ws + WS_Z), ZW, 1000, nullptr, 0};
                pg8::gemm_phase<pg8::EpiStore, pg8::StaticOrder, true, true>(F.lds, g, S, E, F.tid);
            } break;
            case K_R1: if ((PHMASK >> K_R1) & 1) {
                pg8::Gemm g{(const bf16*)(F.ws + WS_A2), (const bf16*)(F.ws + WS_WRK), M, 3328, 2048}; pg8::StaticOrder S; S.init(M, 3328, F.G, (int)blockIdx.x); S.ntk = 32;
                pg8::EpiStore E{(bf16*)(F.ws + WS_RK), RKW, 12, (bf16*)(F.ws + WS_A3), 256};
                pg8::gemm_phase<pg8::EpiStore, pg8::StaticOrder, true, true>(F.lds, g, S, E, F.tid);
            } break;
            case K_R2: if ((PHMASK >> K_R2) & 1) {
                pg8::Gemm g{(const bf16*)(F.ws + WS_A3), (const bf16*)(F.ws + WS_WL2), M, 3072, 256}; pg8::StaticOrder S; S.init(M, 3072, F.G, (int)blockIdx.x); S.ntk = 4;
                pg8::EpiLora2 E{(bf16*)(F.ws + WS_WAG), WAGW, AR.in[I_W0], AR.in[I_A0]};
                pg8::gemm_phase<pg8::EpiLora2, pg8::StaticOrder, true, true>(F.lds, g, S, E, F.tid);
            } break;
            case K_MIXA: if ((PHMASK >> K_MIXA) & 1) ml1_prompt(F, AR); __syncthreads(); if ((PHMASK >> 13) & 1) ml_sample(F, AR); __syncthreads(); if ((PHMASK >> 14) & 1) rg1(F, AR); break;
            case K_MIXB: if ((PHMASK >> K_MIXB) & 1) ml2_scan(F, AR); if ((PHMASK >> 15) & 1) rg2_carry(F, AR); break;
            case K_MIXC: if ((PHMASK >> K_MIXC) & 1) ml3_prompt(F, AR); __syncthreads(); if ((PHMASK >> 16) & 1) rg2_apply(F, AR); break;
            case K_R3: if ((PHMASK >> K_R3) & 1) rwkv_scan(F, AR); break;
            case K_R3B: rw_gn_pass(F, AR); break;
        }
        if (phs + 1 < hi) xcd_barrier(bar);
    }
}

extern "C" void kernel_launch(void* const* d_in, const int* in_sizes, int n_in, void* d_out, int out_size, void* d_ws, size_t ws_size, hipStream_t stream) {
    static int grid = 0;
    if (grid == 0) {
        if (n_in != 47 || out_size != (int)O_END || ws_size < WS_END) { fprintf(stderr, "kernel_launch: unexpected sizes n_in %d out %d ws %zu\n", n_in, out_size, ws_size); grid = -1; return; }
        int dev = 0, cus = 0, per_cu = 0;
        if (hipGetDevice(&dev) != hipSuccess || hipDeviceGetAttribute(&cus, hipDeviceAttributeMultiprocessorCount, dev) != hipSuccess) { grid = -1; return; }
        if (hipFuncSetAttribute((const void*)mega_fwd, hipFuncAttributeMaxDynamicSharedMemorySize, LDS_BYTES) != hipSuccess) { fprintf(stderr, "kernel_launch: hipFuncSetAttribute failed\n"); grid = -1; return; }
        if (hipOccupancyMaxActiveBlocksPerMultiprocessor(&per_cu, (const void*)mega_fwd, NTHREADS, LDS_BYTES) != hipSuccess || per_cu < 1) { fprintf(stderr, "kernel_launch: occupancy query says %d blocks per CU\n", per_cu); (void)hipGetLastError(); grid = -1; return; }
        grid = cus;
    }
    if (grid < 0) return;
    (void)hipMemsetAsync((char*)d_ws + WS_CTL, 0, CTL_ZERO_BYTES, stream);
    Args a{};
    for (int i = 0; i < 47; ++i) a.in[i] = (const float*)d_in[i];
    a.out = (float*)d_out; a.ws = (unsigned char*)d_ws;
#if MK_N_LAUNCHES == 1
    a.ph_lo = 0; a.ph_hi = NPHASES;
    hipLaunchKernelGGL(mega_fwd, dim3(grid), dim3(NTHREADS), LDS_BYTES, stream, a);
#else
    for (int p = 0; p < NPHASES; ++p) { a.ph_lo = p; a.ph_hi = p + 1; hipLaunchKernelGGL(mega_fwd, dim3(grid), dim3(NTHREADS), LDS_BYTES, stream, a); }
#endif
}
```

```cpp
#include <hip/hip_runtime.h>
#include <cstdio>
#include <cstdint>
#include <cmath>
namespace pg8 {
#define PG8_LAS __attribute__((address_space(3)))
typedef unsigned short bf16_t;
typedef short bf16x8 __attribute__((ext_vector_type(8)));
typedef float f32x4 __attribute__((ext_vector_type(4)));
typedef unsigned u32x4 __attribute__((ext_vector_type(4)));
constexpr int BM = 256, BK = 64, HALF = 128, HTB = HALF * BK * 2  , STAGE_BYTES = 8 * HTB, NXCD = 8, WGM = 8;

__host__ __device__ __forceinline__ int lds_byte(int r, int c) { const int st = (r >> 4) * 2 + (c >> 5), rr = r & 15, cc = c & 31, ob = rr * 64 + cc * 2; return st * 1024 + (ob ^ (((ob >> 9) & 1) << 5)); }
__host__ __device__ __forceinline__ void stage_rc(int b, int& R, int& C) { const int st = b / 1024, sb = b % 1024, swz = sb ^ (((sb >> 9) & 1) << 5); R = (st >> 1) * 16 + swz / 64; C = (st & 1) * 32 + (swz % 64) / 2; }
__host__ __device__ __forceinline__ int perm32(int rho) { const int n = rho >> 4, i = rho & 15; return 8 * (i >> 2) + 4 * n + (i & 3); }

struct Unit { int pm, pn, k0, nt, sub; };
struct Gemm { const bf16_t* A; const bf16_t* Bt; int M, N, K; };

struct StaticOrder {
    int nM, nN, nwg, G, c, ntk;
    __host__ __device__ void init(int M, int N, int G_, int c_) { nM = M / BM; nN = N / BM; nwg = nM * nN; G = G_; c = c_; }
    __host__ __device__ bool next(int i, Unit& u) const {
        const long L = (long)i * G + c; if (L >= nwg) return false;
        int wgid = (int)L; { const int q = nwg / NXCD, r = nwg % NXCD, xcd = wgid % NXCD, off = wgid / NXCD; wgid = (xcd < r ? xcd * (q + 1) : r * (q + 1) + (xcd - r) * q) + off; }
        const int nig = WGM * nN, gid = wgid / nig, fm = gid * WGM, gsz = (nM - fm) < WGM ? (nM - fm) : WGM;
        u.pm = fm + ((wgid % nig) % gsz); u.pn = (wgid % nig) / gsz; u.k0 = 0; u.nt = ntk; u.sub = 0; return true;
    }
    __device__ __forceinline__ void a_ready(const Unit&) const {}
    __device__ __forceinline__ void done(const Unit&) const {}
};

__device__ __forceinline__ unsigned cvt_pk_bf16(float lo, float hi) { unsigned r; asm volatile("v_cvt_pk_bf16_f32 %0, %1, %2" : "=v"(r) : "v"(lo), "v"(hi)); return r; }
typedef float f32x2 __attribute__((ext_vector_type(2)));
constexpr int MPROWS = 16384;
__device__ __forceinline__ int mod_row(int r) { return r < MPROWS ? (r >> 11) : 8 + ((r - MPROWS) >> 3); }
__device__ __forceinline__ float fsig(float x) { return __builtin_amdgcn_rcpf(1.0f + __builtin_amdgcn_exp2f(-1.44269504f * x)); }
__device__ __forceinline__ float ftanh(float x) { return 1.0f - 2.0f * __builtin_amdgcn_rcpf(1.0f + __builtin_amdgcn_exp2f(2.88539008f * x)); }

struct EpiSwiglu {
    static constexpr bool PERM = true, AFTER_DRAIN = false;
    bf16_t* O; int ldc;
    __device__ __forceinline__ void operator()(const f32x4 (&acc)[2][2][4][2], const Unit& u, int wr, int wc, int fr, int fq) const {
        const int row0 = u.pm * BM + wr * 64 + fr, col0 = u.pn * HALF + wc * 32 + 8 * fq;
#pragma unroll
        for (int ai = 0; ai < 2; ++ai)
#pragma unroll
            for (int m = 0; m < 4; ++m) { bf16_t* rowp = O + (size_t)(row0 + ai * HALF + m * 16) * ldc + col0;
                const f32x4 a0 = acc[ai][0][m][0], a1 = acc[ai][0][m][1], b0 = acc[ai][1][m][0], b1 = acc[ai][1][m][1];
                f32x4 v0, v1;
#pragma unroll
                for (int j = 0; j < 4; ++j) { v0[j] = a0[j] * fsig(a0[j]) * b0[j]; v1[j] = a1[j] * fsig(a1[j]) * b1[j]; }
                u32x4 w; w.x = cvt_pk_bf16(v0[0], v0[1]); w.y = cvt_pk_bf16(v0[2], v0[3]); w.z = cvt_pk_bf16(v1[0], v1[1]); w.w = cvt_pk_bf16(v1[2], v1[3]);
                *(u32x4*)rowp = w; asm volatile("" ::: "memory"); }
    }
};
struct EpiStore {
    static constexpr bool PERM = true, AFTER_DRAIN = false;
    bf16_t* O; int ldc; int ntile_main; bf16_t* O2; int ldc2;
    __device__ __forceinline__ void operator()(const f32x4 (&acc)[2][2][4][2], const Unit& u, int wr, int wc, int fr, int fq) const {
        const int row0 = u.pm * BM + wr * 64 + fr;
        const bool main = u.pn < ntile_main;
        bf16_t* base = main ? O + (size_t)u.pn * BM : O2; const int ld = main ? ldc : ldc2;
        const int col0 = wc * 32 + 8 * fq;
#pragma unroll
        for (int ai = 0; ai < 2; ++ai)
#pragma unroll
            for (int m = 0; m < 4; ++m) { bf16_t* rowp = base + (size_t)(row0 + ai * HALF + m * 16) * ld + col0;
#pragma unroll
                for (int bj = 0; bj < 2; ++bj) { f32x4 v0 = acc[ai][bj][m][0], v1 = acc[ai][bj][m][1];
                    if (!main) {
                        if (bj == 1) {
#pragma unroll
                            for (int j = 0; j < 4; ++j) { v0[j] = fsig(v0[j]); v1[j] = fsig(v1[j]); }
                        } else if (wc < 2) {
#pragma unroll
                            for (int j = 0; j < 4; ++j) { v0[j] = ftanh(v0[j]); v1[j] = ftanh(v1[j]); }
                        }
                    }
                    u32x4 w; w.x = cvt_pk_bf16(v0[0], v0[1]); w.y = cvt_pk_bf16(v0[2], v0[3]); w.z = cvt_pk_bf16(v1[0], v1[1]); w.w = cvt_pk_bf16(v1[2], v1[3]);
                    *(u32x4*)(rowp + bj * HALF) = w; asm volatile("" ::: "memory"); } }
    }
};
struct EpiLora2 {
    static constexpr bool PERM = true, AFTER_DRAIN = false;
    bf16_t* O; int ldc; const float* w0; const float* a0;
    __device__ __forceinline__ void operator()(const f32x4 (&acc)[2][2][4][2], const Unit& u, int wr, int wc, int fr, int fq) const {
        const int row0 = u.pm * BM + wr * 64 + fr, col0 = u.pn * BM + wc * 32 + 8 * fq, kind = u.pn >> 2;
        const float* bp = (kind == 0 ? w0 : a0) + (col0 & 1023); const float bsc = kind == 2 ? 0.f : 1.f, mul = kind == 0 ? -0.87504229f : 1.0f;
#pragma unroll
        for (int bj = 0; bj < 2; ++bj)
#pragma unroll
            for (int ai = 0; ai < 2; ++ai)
#pragma unroll
                for (int m = 0; m < 4; ++m) { bf16_t* rowp = O + (size_t)(row0 + ai * HALF + m * 16) * ldc + col0;
                    f32x4 v0 = acc[ai][bj][m][0] + *(const f32x4*)(bp + bj * HALF) * bsc, v1 = acc[ai][bj][m][1] + *(const f32x4*)(bp + bj * HALF + 4) * bsc;
                    if (kind != 2) {
#pragma unroll
                        for (int j = 0; j < 4; ++j) { v0[j] = mul * fsig(v0[j]); v1[j] = mul * fsig(v1[j]); }
                    }
                    u32x4 w; w.x = cvt_pk_bf16(v0[0], v0[1]); w.y = cvt_pk_bf16(v0[2], v0[3]); w.z = cvt_pk_bf16(v1[0], v1[1]); w.w = cvt_pk_bf16(v1[2], v1[3]);
                    *(u32x4*)(rowp + bj * HALF) = w; asm volatile("" ::: "memory"); }
    }
};

template <class Epi, class Sched, bool ALIGN_EPI = false, bool SP2 = false>
__device__ __forceinline__ void gemm_phase(PG8_LAS unsigned char* lds, const Gemm g, const Sched& S, const Epi& E, int tid_in) {
    int tid_ = tid_in; asm volatile("" : "+v"(tid_));
    const int tid = tid_, wid = __builtin_amdgcn_readfirstlane(tid >> 6), lane = tid & 63, wr = wid >> 2, wc = wid & 3, fr = lane & 15, fq = lane >> 4;
    int K_ = g.K; asm volatile("" : "+s"(K_));
    const int K = K_;
    unsigned voffA[2], voffB[2];
#pragma unroll
    for (int i = 0; i < 2; ++i) { int R, C; stage_rc(tid * 16 + i * 8192, R, C); const int Rb = Epi::PERM ? ((R & ~31) + perm32(R & 31)) : R;
        voffA[i] = (unsigned)(R * K + C) * 2u; voffB[i] = (unsigned)(Rb * K + C) * 2u; }
    const size_t kstep = (size_t)(BK * 2);
    const size_t hstep = (size_t)HALF * K * 2;
    const size_t tstep = 2 * hstep;
    const unsigned ldsw = (unsigned)wid * 1024u;
    const int aoff = lds_byte(wr * 64 + fr, fq * 8), boff = lds_byte(wc * 32 + fr, fq * 8);
#define PG8_SA(b, h) (((b) * 2 + (h)) * HTB)
#define PG8_SB(b, h) ((4 + (b) * 2 + (h)) * HTB)
#define PG8_STAGE(bufoff, gbase, voff) do { _Pragma("unroll") for (int _i = 0; _i < 2; ++_i) \
        __builtin_amdgcn_global_load_lds((const unsigned*)((const char*)(gbase) + (voff)[_i]), (PG8_LAS unsigned*)(lds + (bufoff) + ldsw + _i * 8192), 16, 0, 0); } while (0)
#define PG8_LDA(dst, b, h) do { _Pragma("unroll") for (int m = 0; m < 4; ++m) _Pragma("unroll") for (int k = 0; k < 2; ++k) dst[m][k] = *(const PG8_LAS bf16x8*)(lds + PG8_SA(b, h) + aoff + m * 2048 + k * 1024); } while (0)
#define PG8_LDB(dst, b, h) do { _Pragma("unroll") for (int n = 0; n < 2; ++n) _Pragma("unroll") for (int k = 0; k < 2; ++k) dst[n][k] = *(const PG8_LAS bf16x8*)(lds + PG8_SB(b, h) + boff + n * 2048 + k * 1024); } while (0)
#define PG8_MMA(ai, bj, At, Bt) do { __builtin_amdgcn_s_setprio(1); _Pragma("unroll") for (int m = 0; m < 4; ++m) _Pragma("unroll") for (int n = 0; n < 2; ++n) _Pragma("unroll") for (int k = 0; k < 2; ++k) \
        acc[ai][bj][m][n] = __builtin_amdgcn_mfma_f32_16x16x32_bf16(Bt[n][k], At[m][k], acc[ai][bj][m][n], 0, 0, 0); __builtin_amdgcn_s_setprio(0); } while (0)
#define PG8_WAIT_V(n) asm volatile("s_waitcnt vmcnt(" #n ")" ::: "memory")
#define PG8_WAIT_L(n) asm volatile("s_waitcnt lgkmcnt(" #n ")" ::: "memory")
#define PG8_BAR __builtin_amdgcn_s_barrier()
#define PG8_SCHED __builtin_amdgcn_sched_barrier(0)
    Unit cur, nxt; int ui = 0;
    if (!S.next(0, cur)) return;
    f32x4 acc[2][2][4][2];
#pragma unroll
    for (int a = 0; a < 2; ++a)
#pragma unroll
        for (int b = 0; b < 2; ++b)
#pragma unroll
            for (int m = 0; m < 4; ++m)
#pragma unroll
                for (int n = 0; n < 2; ++n) acc[a][b][m][n] = (f32x4){0.f, 0.f, 0.f, 0.f};
    bf16x8 At[4][2], B0[2][2], B1[2][2];
    const char* cA = (const char*)g.A + (size_t)cur.pm * tstep + (size_t)cur.k0 * 2; const char* cB = (const char*)g.Bt + (size_t)cur.pn * tstep + (size_t)cur.k0 * 2;
    S.a_ready(cur);
    if constexpr (SP2) {
        PG8_STAGE(PG8_SB(0, 0), cB, voffB); PG8_STAGE(PG8_SB(0, 1), cB + hstep, voffB); PG8_STAGE(PG8_SA(0, 0), cA, voffA); PG8_STAGE(PG8_SA(0, 1), cA + hstep, voffA);
        if (wr == 1) PG8_BAR;
        PG8_WAIT_V(2); PG8_BAR;
        PG8_STAGE(PG8_SB(1, 0), cB + kstep, voffB); PG8_STAGE(PG8_SA(1, 0), cA + kstep, voffA); PG8_STAGE(PG8_SB(1, 1), cB + hstep + kstep, voffB);
        PG8_WAIT_V(6); PG8_BAR;
    } else {
        PG8_STAGE(PG8_SB(0, 0), cB, voffB); PG8_STAGE(PG8_SA(0, 0), cA, voffA); PG8_STAGE(PG8_SB(0, 1), cB + hstep, voffB); PG8_STAGE(PG8_SA(0, 1), cA + hstep, voffA);
        if (wr == 1) PG8_BAR;
        PG8_WAIT_V(4); PG8_BAR;
        PG8_STAGE(PG8_SB(1, 0), cB + kstep, voffB); PG8_STAGE(PG8_SA(1, 0), cA + kstep, voffA); PG8_STAGE(PG8_SB(1, 1), cB + hstep + kstep, voffB);
        PG8_WAIT_V(6); PG8_BAR;
    }
    for (;;) {
        const bool has_next = S.next(ui + 1, nxt);
        const char* nA = has_next ? (const char*)g.A + (size_t)nxt.pm * tstep + (size_t)nxt.k0 * 2 : cA; const char* nB = has_next ? (const char*)g.Bt + (size_t)nxt.pn * tstep + (size_t)nxt.k0 * 2 : cB;
        const int nt = cur.nt;
        for (int t = 0; t < nt; t += 2) {
            const bool last = (t == nt - 2);
            const char* a1 = cA + (size_t)(t + 1) * kstep;
            const char* a2 = last ? nA : cA + (size_t)(t + 2) * kstep; const char* b2 = last ? nB : cB + (size_t)(t + 2) * kstep;
            const char* a3 = a2 + kstep; const char* b3 = b2 + kstep;
            if (last && has_next) S.a_ready(nxt);
            if constexpr (SP2) {
            PG8_LDB(B0, 0, 0); PG8_LDB(B1, 0, 1); PG8_SCHED; PG8_LDA(At, 0, 0); PG8_STAGE(PG8_SA(1, 1), a1 + hstep, voffA);
            PG8_WAIT_V(8); PG8_WAIT_L(0); PG8_BAR; PG8_MMA(0, 0, At, B0); PG8_MMA(0, 1, At, B1); PG8_BAR; PG8_SCHED;
            PG8_LDA(At, 0, 1); PG8_STAGE(PG8_SB(0, 0), b2, voffB); PG8_STAGE(PG8_SB(0, 1), b2 + hstep, voffB); PG8_STAGE(PG8_SA(0, 0), a2, voffA);
            PG8_WAIT_V(8); PG8_WAIT_L(0); PG8_BAR; PG8_MMA(1, 0, At, B0); PG8_MMA(1, 1, At, B1); PG8_BAR; PG8_SCHED;
            PG8_LDB(B0, 1, 0); PG8_LDB(B1, 1, 1); PG8_SCHED; PG8_LDA(At, 1, 0); PG8_STAGE(PG8_SA(0, 1), a2 + hstep, voffA);
            PG8_WAIT_V(8); PG8_WAIT_L(0); PG8_BAR; PG8_MMA(0, 0, At, B0); PG8_MMA(0, 1, At, B1); PG8_BAR; PG8_SCHED;
            PG8_LDA(At, 1, 1); PG8_STAGE(PG8_SB(1, 0), b3, voffB); PG8_STAGE(PG8_SB(1, 1), b3 + hstep, voffB); PG8_STAGE(PG8_SA(1, 0), a3, voffA);
            PG8_WAIT_V(8); PG8_WAIT_L(0); PG8_BAR; PG8_MMA(1, 0, At, B0); PG8_MMA(1, 1, At, B1); PG8_BAR; PG8_SCHED;
            } else {
            PG8_LDB(B0, 0, 0); PG8_SCHED; PG8_LDA(At, 0, 0); PG8_STAGE(PG8_SA(1, 1), a1 + hstep, voffA);
            PG8_WAIT_L(8); PG8_BAR; PG8_WAIT_L(0); PG8_MMA(0, 0, At, B0); PG8_BAR; PG8_SCHED;
            PG8_LDB(B1, 0, 1); PG8_STAGE(PG8_SB(0, 0), b2, voffB);
            PG8_BAR; PG8_WAIT_L(0); PG8_MMA(0, 1, At, B1); PG8_BAR;
            PG8_LDA(At, 0, 1); PG8_STAGE(PG8_SA(0, 0), a2, voffA);
            PG8_BAR; PG8_WAIT_L(0); PG8_MMA(1, 0, At, B0); PG8_BAR; PG8_SCHED;
            PG8_STAGE(PG8_SB(0, 1), b2 + hstep, voffB);
            PG8_WAIT_V(6); PG8_BAR; PG8_MMA(1, 1, At, B1); PG8_BAR;
            PG8_LDB(B0, 1, 0); PG8_SCHED; PG8_LDA(At, 1, 0); PG8_STAGE(PG8_SA(0, 1), a2 + hstep, voffA);
            PG8_WAIT_L(8); PG8_BAR; PG8_WAIT_L(0); PG8_MMA(0, 0, At, B0); PG8_BAR; PG8_SCHED;
            PG8_LDB(B1, 1, 1); PG8_STAGE(PG8_SB(1, 0), b3, voffB);
            PG8_BAR; PG8_WAIT_L(0); PG8_MMA(0, 1, At, B1); PG8_BAR;
            PG8_LDA(At, 1, 1); PG8_STAGE(PG8_SA(1, 0), a3, voffA);
            PG8_BAR; PG8_WAIT_L(0); PG8_MMA(1, 0, At, B0); PG8_BAR; PG8_SCHED;
            PG8_STAGE(PG8_SB(1, 1), b3 + hstep, voffB);
            PG8_WAIT_V(6); PG8_BAR; PG8_MMA(1, 1, At, B1); PG8_BAR;
            }
        }
        if constexpr (ALIGN_EPI) { if (wr == 0) PG8_BAR; }
        if constexpr (!Epi::AFTER_DRAIN) { E(acc, cur, wr, wc, fr, fq); S.done(cur); }
        if (!has_next) break;
#pragma unroll
        for (int a = 0; a < 2; ++a)
#pragma unroll
            for (int b = 0; b < 2; ++b)
#pragma unroll
                for (int m = 0; m < 4; ++m)
#pragma unroll
                    for (int n = 0; n < 2; ++n) acc[a][b][m][n] = (f32x4){0.f, 0.f, 0.f, 0.f};
        cur = nxt; cA = nA; cB = nB; ++ui;
        if constexpr (ALIGN_EPI) { if (wr == 1) PG8_BAR; }
    }
    PG8_WAIT_V(0);
    if constexpr (!ALIGN_EPI) { if (wr == 0) PG8_BAR; }
    PG8_BAR;
    if constexpr (Epi::AFTER_DRAIN) { E.fused(acc, cur, wr, wc, fr, fq, lds, wid, lane); S.done(cur); }
#undef PG8_SA
#undef PG8_SB
#undef PG8_STAGE
#undef PG8_LDA
#undef PG8_LDB
#undef PG8_MMA
#undef PG8_WAIT_V
#undef PG8_WAIT_L
#undef PG8_BAR
#undef PG8_SCHED
}
}
constexpr int NWAVES = 8, NTHREADS = 512;
constexpr int D = 1024, MP = 16384, MS = 1024, M = MP + MS, NSEQ = 136, FF = 2816;
constexpr int PSEQ = 2048, SSEQ = 8, NPB = 8, NSB = 128;
constexpr int ZW = 3328;
constexpr int ZQ = 0, ZK = 512, ZV = 1024, ZO = 1536, ZXR = 2048, ZGR = 2560, ZIG = 3072, ZFG = 3076;
constexpr int RKW = 3072, WAGW = 3072;
constexpr float ALPHA = 1.41421356237f;
constexpr float LN_EPS = 1e-5f, HEAD_EPS = 1e-6f, RW_EPS = 64e-5f;
constexpr float MSCALE = 0.08838834764831845f;

constexpr size_t O_Y = 0, O_PMC = 17825792, O_PMN = 18350080, O_PMM = 18354176, O_PRH = 18354208, O_PRC = 18358304, O_PWKV = 18370592, O_PSH = 18894880,
                 O_SMC = 18903072, O_SMN = 27291680, O_SMM = 27357216, O_SRH = 27357728, O_SRC = 27423264, O_SWKV = 27619872, O_SSH = 36008480, O_END = 36139552;

constexpr size_t MiB = 1u << 20;
constexpr size_t WS_CTL = 0, CTL_ZERO_BYTES = 1 * MiB;
constexpr size_t WS_W13 = 1 * MiB;
constexpr size_t WS_W2 = 45 * MiB;
constexpr size_t WS_WIN = 67 * MiB;
constexpr size_t WS_WOUT = WS_WIN + 6815744;
constexpr size_t WS_WRK = WS_WOUT + 2 * MiB;
constexpr size_t WS_WL2 = WS_WRK + 13 * MiB;
constexpr size_t WS_WO = WS_WL2 + 1572864;
constexpr size_t WS_MOD = 92 * MiB;
constexpr size_t WS_SC = 101 * MiB + 640 * 1024;
constexpr size_t WS_H = 102 * MiB;
constexpr size_t WS_BIG = 136 * MiB;
constexpr size_t WS_HID = WS_BIG;
constexpr size_t WS_Z = WS_BIG;
constexpr size_t WS_CST = WS_BIG + 111 * MiB;
constexpr size_t WS_SLAB = WS_BIG + 180 * MiB;
constexpr size_t WS_RGH = WS_BIG + 143 * MiB;
constexpr size_t WS_RGP = WS_BIG + 175 * MiB;
constexpr size_t WS_NST = WS_BIG + 207 * MiB;
constexpr size_t WS_MST = WS_NST + 262144;
constexpr size_t WS_CARRY = WS_MST + 8192;
constexpr size_t WS_RK = WS_BIG;
constexpr size_t WS_A3 = WS_BIG + 102 * MiB;
constexpr size_t WS_A2 = WS_BIG + 111 * MiB;
constexpr size_t WS_WAG = WS_BIG + 111 * MiB;
constexpr size_t WS_END = WS_BIG + 224 * MiB;
static_assert(WS_WO + 2 * MiB <= WS_MOD && WS_MOD + (size_t)2 * 136 * 9216 * 4 <= WS_SC && WS_SC + 160 * 1024 * 2 <= WS_H && WS_H + (size_t)M * D * 2 <= WS_BIG, "ws map");
static_assert(WS_SLAB + (size_t)11 * 4 * MiB <= WS_END && WS_A2 + (size_t)M * 2048 * 2 <= WS_SLAB && WS_CARRY + 8 * 64 * 512 * 4 <= WS_END && WS_WAG + (size_t)M * WAGW * 2 <= WS_END && WS_A3 + (size_t)M * 256 * 2 <= WS_A2, "ws map 2");
constexpr size_t WS_BN = WS_BIG + 213 * MiB;
constexpr size_t XB_OFF = (size_t)M * 1024 * 2;
constexpr size_t WS_ZF = WS_BIG + 111 * MiB;
constexpr int CW_BAR = 4096;

constexpr int LDS_BYTES = 147456;
constexpr int LDSCTL_OFF = LDS_BYTES - 512;
constexpr int MISC_OFF = LDSCTL_OFF;

#define GAS __attribute__((address_space(1)))
#define LAS __attribute__((address_space(3)))
typedef unsigned short bf16;
typedef unsigned v4u __attribute__((ext_vector_type(4)));
typedef unsigned v2u __attribute__((ext_vector_type(2)));
typedef float f32x4 __attribute__((ext_vector_type(4)));
typedef float f32x2 __attribute__((ext_vector_type(2)));
typedef float f32x16 __attribute__((ext_vector_type(16)));
typedef short bf16x8 __attribute__((ext_vector_type(8)));
typedef GAS unsigned gu32;
#define RLX_AGENT __ATOMIC_RELAXED, __HIP_MEMORY_SCOPE_AGENT
#define LDS_WAIT() asm volatile("s_waitcnt lgkmcnt(0)" ::: "memory")
#define DI __device__ __forceinline__
#define MFMA32(a, b, c) __builtin_amdgcn_mfma_f32_32x32x16_bf16((a), (b), (c), 0, 0, 0)
DI unsigned f2bf(float f) { unsigned u = __builtin_bit_cast(unsigned, f); return (u + 0x7fffu + ((u >> 16) & 1u)) >> 16; }
DI unsigned pk2(float lo, float hi) { return pg8::cvt_pk_bf16(lo, hi); }
DI float bf2f(unsigned b) { return __builtin_bit_cast(float, b << 16); }
DI float bflo(unsigned w) { return __builtin_bit_cast(float, w << 16); }
DI float bfhi(unsigned w) { return __builtin_bit_cast(float, w & 0xffff0000u); }
DI int crow(int reg, int h) { return (reg & 3) + 8 * (reg >> 2) + 4 * h; }
DI float fexp(float x) { return __builtin_amdgcn_exp2f(1.44269504f * x); }
DI float fsig(float x) { return pg8::fsig(x); }
DI bf16x8 mk_frag(unsigned a, unsigned b, unsigned c, unsigned d) { v4u p; p.x = a; p.y = b; p.z = c; p.w = d; return __builtin_bit_cast(bf16x8, p); }
DI bf16x8 pack8(const float (&v)[8]) { return mk_frag(pk2(v[0], v[1]), pk2(v[2], v[3]), pk2(v[4], v[5]), pk2(v[6], v[7])); }
template <int CTRL> DI float dpp_add(float x) {
    const int xi = __builtin_bit_cast(int, x);
    const int yi = __builtin_amdgcn_update_dpp(xi, xi, CTRL, 0xF, 0xF, false);
    return x + __builtin_bit_cast(float, yi);
}
DI float sum8(float x) { x = dpp_add<0xB1>(x); x = dpp_add<0x4E>(x); x = dpp_add<0x141>(x); return x; }
DI float sum16(float x) { x = sum8(x); x = dpp_add<0x140>(x); return x; }
DI float wave_sum(float v) { v = sum16(v); v += __shfl_xor(v, 16); v += __shfl_xor(v, 32); return v; }

#define XB_TMO      128
#define XB_XCNT(j)  (256  + 64 * (j))
#define XB_XSUB(j)  (1280 + 64 * (j))
#define XB_XGEN(j)  (2304 + 64 * (j))
#define XB_TOP      3328
#define XB_TOPGEN   3392
#define XCD_BAR_WORDS 3456
#define XB_SPIN_CAP (1u << 18)

__device__ __forceinline__ unsigned xb_ld(unsigned* p)              { return __hip_atomic_load(p, __ATOMIC_RELAXED, __HIP_MEMORY_SCOPE_AGENT); }
__device__ __forceinline__ unsigned xb_add(unsigned* p, unsigned v) { return __hip_atomic_fetch_add(p, v, __ATOMIC_RELAXED, __HIP_MEMORY_SCOPE_AGENT); }
__device__ __forceinline__ unsigned xb_xcc_id() { return (unsigned)__builtin_amdgcn_s_getreg((3 << 11) | 20) & 0xFu; }
#define XB_SPIN(cond, bar) do { unsigned _sp = 0; while (cond) { __builtin_amdgcn_s_sleep(1); \
    if ((++_sp & 255u) == 0u) { if (xb_ld(&(bar)[XB_TMO])) break; if (_sp > XB_SPIN_CAP) { atomicAdd(&(bar)[XB_TMO], 1u); break; } } } } while (0)

struct XcdBarrier {
    unsigned* bar; unsigned x;
    volatile LAS unsigned* st;
};

__device__ __forceinline__ XcdBarrier xcd_barrier_post(unsigned* bar, volatile LAS unsigned* st) {
    XcdBarrier b; b.bar = bar; b.x = xb_xcc_id(); b.st = st;
    if (threadIdx.x == 0) (void)xb_add(&bar[XB_XCNT(b.x)], 1u);
    return b;
}
__device__ __forceinline__ void xcd_barrier_complete(unsigned* bar, unsigned x, unsigned& nloc, unsigned& nx) {
    const unsigned G = gridDim.x * gridDim.y * gridDim.z;
    unsigned sum, cnt, mine, sp = 0u;
    for (;;) {
        sum = 0u; cnt = 0u; mine = 0u;
#pragma unroll
        for (unsigned j = 0; j < 16; ++j) { const unsigned c = xb_ld(&bar[XB_XCNT(j)]); sum += c; cnt += (c > 0u) ? 1u : 0u; mine = (j == x) ? c : mine; }
        if (sum == G) break;
        __builtin_amdgcn_s_sleep(1);
        if ((++sp & 255u) == 0u) { if (xb_ld(&bar[XB_TMO])) break; if (sp > XB_SPIN_CAP) { atomicAdd(&bar[XB_TMO], 1u); break; } }
    }
    nloc = mine > 0u ? mine : 1u; nx = cnt > 0u ? cnt : 1u;
}

__device__ __forceinline__ void xcd_barrier(const XcdBarrier& b) {
    asm volatile("s_waitcnt vmcnt(0)" ::: "memory");
    __syncthreads();
    if (threadIdx.x == 0) {
        unsigned* bar = b.bar;
        __builtin_amdgcn_s_waitcnt(0);
        unsigned nloc = b.st[0], nx = b.st[1];
        if (nloc == 0u) { xcd_barrier_complete(bar, b.x, nloc, nx); b.st[0] = nloc; b.st[1] = nx; }
        const unsigned old = xb_add(&bar[XB_XSUB(b.x)], 1u);
        const unsigned gen = old / nloc;
        if (old + 1u == (gen + 1u) * nloc) {
            __builtin_amdgcn_fence(__ATOMIC_RELEASE, "agent");
            asm volatile("s_waitcnt vmcnt(0)" ::: "memory");
            const unsigned og = xb_add(&bar[XB_TOP], 1u);
            const unsigned tg = og / nx;
            if (og + 1u == (tg + 1u) * nx) xb_add(&bar[XB_TOPGEN], 1u);
            else XB_SPIN(xb_ld(&bar[XB_TOPGEN]) == tg, bar);
            __builtin_amdgcn_fence(__ATOMIC_ACQUIRE, "agent");
            xb_add(&bar[XB_XGEN(b.x)], 1u);
            asm volatile("s_waitcnt vmcnt(0)" ::: "memory");
        } else {
            XB_SPIN(xb_ld(&bar[XB_XGEN(b.x)]) == gen, bar);
            __builtin_amdgcn_fence(__ATOMIC_ACQUIRE, "agent");
            asm volatile("s_waitcnt vmcnt(0)" ::: "memory");
        }
    }
    __syncthreads();
}
struct Args { const float* in[47]; float* out; unsigned char* ws; int ph_lo, ph_hi; };
struct Frame {
    LAS unsigned char* lds;
    volatile LAS unsigned* MISC;
    gu32* ctl;
    int tid, lane, wave;
    int vcu, G;
    float* out;
    unsigned char* ws;
};
enum { I_XP = 0, I_XS, I_CP, I_CS, I_SMC, I_SMN, I_SMM, I_SRH, I_SRC, I_SWKV, I_SSH, I_ADAW, I_ADAB, I_LNG, I_LNB, I_W1, I_W3, I_W2, I_WIN, I_BG, I_MNG,
       I_CW, I_CB, I_WA, I_BA, I_WX, I_BX, I_LAM, I_WOUT, I_MU, I_WR, I_WK, I_WV, I_W0, I_LW1, I_LW2, I_A0, I_A1, I_A2, I_G1, I_G2, I_KK, I_KA, I_RK, I_LXG, I_LXB, I_WO };

struct EpiResid {
    static constexpr bool PERM = true, AFTER_DRAIN = false;
    const Args& ar; float* out; unsigned char* ws; int cfg;
    __device__ __forceinline__ void operator()(const pg8::f32x4 (&acc)[2][2][4][2], const pg8::Unit& u, int wr, int wc, int fr, int fq) const {
        using pg8::BM; using pg8::HALF;
        if (u.sub) {
            const int row0 = u.pm * BM + wr * 64 + fr - MP, col0 = u.pn * BM + wc * 32 + 8 * fq;
            float* sb = (float*)(ws + WS_SLAB) + (size_t)(u.k0 / (64 * u.nt)) * (1024 * 1024) + col0;
#pragma unroll
            for (int ai = 0; ai < 2; ++ai)
#pragma unroll
                for (int m = 0; m < 4; ++m) { float* o = sb + (size_t)(row0 + ai * HALF + m * 16) * 1024;
#pragma unroll
                    for (int bj = 0; bj < 2; ++bj) { *(f32x4*)(o + bj * HALF) = acc[ai][bj][m][0]; *(f32x4*)(o + bj * HALF + 4) = acc[ai][bj][m][1]; } }
            return;
        }
        const int row0 = u.pm * BM + wr * 64 + fr, col0 = u.pn * BM + wc * 32 + 8 * fq;
        const bool first = cfg & 1; const int l = (cfg >> 1) & 1, jg = (cfg >> 2) & 15; const float rw = (cfg & 64) ? 1.0f : 0.5f;
        bf16* XB = (bf16*)((unsigned char*)out + XB_OFF);
        bf16* Zo = (cfg & 128) ? (bf16*)(ws + WS_BIG + 145 * MiB) : ((cfg & 256) ? (bf16*)(ws + WS_ZF) : XB);
        const float* gate = (const float*)(ws + WS_MOD) + ((size_t)l * NSEQ * 9 + jg) * 1024;
#pragma unroll
        for (int ai = 0; ai < 2; ++ai)
#pragma unroll
            for (int m = 0; m < 4; ++m) { const int row = row0 + ai * HALF + m * 16;
                const float* gr = gate + (size_t)pg8::mod_row(row) * 9216 + col0;
#pragma unroll
                for (int bj = 0; bj < 2; ++bj) { const int c = bj * HALF; f32x4 x0, x1;
                    if (first) { const float* xr = (row < MP ? ar.in[I_XP] + (size_t)row * 1024 : ar.in[I_XS] + (size_t)(row - MP) * 1024) + col0 + c; x0 = *(const f32x4*)xr; x1 = *(const f32x4*)(xr + 4); }
                    else { const v4u q = *(const v4u*)(XB + (size_t)row * 1024 + col0 + c); x0 = (f32x4){bflo(q.x), bfhi(q.x), bflo(q.y), bfhi(q.y)}; x1 = (f32x4){bflo(q.z), bfhi(q.z), bflo(q.w), bfhi(q.w)}; }
                    const f32x4 g0 = *(const f32x4*)(gr + c), g1 = *(const f32x4*)(gr + c + 4);
                    const f32x4 z0 = x0 * ALPHA + (g0 + 1.0f) * rw * acc[ai][bj][m][0], z1 = x1 * ALPHA + (g1 + 1.0f) * rw * acc[ai][bj][m][1];
                    v4u w; w.x = pk2(z0.x, z0.y); w.y = pk2(z0.z, z0.w); w.z = pk2(z1.x, z1.y); w.w = pk2(z1.z, z1.w);
                    *(v4u*)(Zo + (size_t)row * 1024 + col0 + c) = w; }
                asm volatile("" ::: "memory"); }
    }
};
struct SplitOrder {
    pg8::StaticOrder base; int S;
    __device__ __forceinline__ bool next(int i, pg8::Unit& u) const {
        if (S == 0) return base.next(i, u);
        if (i == 0) return base.next(0, u);
        if (i == 1 && base.c < 16 * S) { const int su = base.c / S, ks = base.c - su * S; u.pm = 64 + (su >> 2); u.pn = su & 3; u.k0 = ks * 256; u.nt = 4; u.sub = 1; return true; }
        return false;
    }
    __device__ __forceinline__ void a_ready(const pg8::Unit&) const {}
    __device__ __forceinline__ void done(const pg8::Unit&) const {}
};

DI void p0_sctab(Frame& F, const Args& AR) {
    bf16* sc = (bf16*)(F.ws + WS_SC);
    const int gt = F.vcu * NTHREADS + F.tid, NT = F.G * NTHREADS;
    for (int e = gt; e < 160 * 256; e += NT) { const int m = e >> 8, k4 = (e & 255) * 4; v2u w; w.x = 0u; w.y = 0u;
        if (m < NSEQ) { const f32x4 c = *(const f32x4*)((m < NPB ? AR.in[I_CP] + (size_t)m * D : AR.in[I_CS] + (size_t)(m - NPB) * D) + k4);
            w.x = pk2(c.x * fsig(c.x), c.y * fsig(c.y)); w.y = pk2(c.z * fsig(c.z), c.w * fsig(c.w)); }
        *(v2u*)(sc + (size_t)m * 1024 + k4) = w; }
}
DI void p0_mod(Frame& F, const Args& AR) {
    LAS float* SL = (LAS float*)F.lds;
    LAS float* T = (LAS float*)(F.lds + 81920);
    const int lane = F.lane, wave = F.wave, r = lane & 31, hh = lane >> 5;
    const float* adaw = AR.in[I_ADAW]; const float* adab = AR.in[I_ADAB];
    const bf16* sc = (const bf16*)(F.ws + WS_SC);
    float* mod = (float*)(F.ws + WS_MOD);
    for (int nb = F.vcu; nb < 576; nb += F.G) {
        const int n0 = nb * 32, l = n0 / 9216, nc0 = n0 - l * 9216;
        const float* W = adaw + (size_t)l * 1024 * 9216 + nc0 + r + (size_t)(wave * 128 + 8 * hh) * 9216;
        float a[8][8];
#pragma unroll
        for (int ks = 0; ks < 8; ++ks)
#pragma unroll
            for (int j = 0; j < 8; ++j) a[ks][j] = W[(size_t)(ks * 16 + j) * 9216];
        f32x16 acc[5];
#pragma unroll
        for (int mb = 0; mb < 5; ++mb)
#pragma unroll
            for (int i = 0; i < 16; ++i) acc[mb][i] = 0.f;
#pragma unroll
        for (int ks = 0; ks < 8; ++ks) { const bf16x8 A = pack8(a[ks]); const int k0 = wave * 128 + ks * 16 + 8 * hh;
#pragma unroll
            for (int mb = 0; mb < 5; ++mb) acc[mb] = MFMA32(A, *(const bf16x8*)(sc + (size_t)(mb * 32 + r) * 1024 + k0), acc[mb]); }
#pragma unroll
        for (int half = 4; half >= 1; half >>= 1) {
            if (wave >= half && wave < 2 * half) { LAS float* p = SL + (wave - half) * 5120 + lane;
#pragma unroll
                for (int mb = 0; mb < 5; ++mb)
#pragma unroll
                    for (int i = 0; i < 16; ++i) p[(mb * 16 + i) * 64] = acc[mb][i]; }
            __syncthreads();
            if (wave < half) { const LAS float* p = SL + wave * 5120 + lane;
#pragma unroll
                for (int mb = 0; mb < 5; ++mb)
#pragma unroll
                    for (int i = 0; i < 16; ++i) acc[mb][i] += p[(mb * 16 + i) * 64]; }
            __syncthreads();
        }
        if (wave == 0) {
#pragma unroll
            for (int mb = 0; mb < 5; ++mb)
#pragma unroll
                for (int i = 0; i < 16; ++i) T[(mb * 32 + r) * 33 + crow(i, hh)] = acc[mb][i]; }
        __syncthreads();
        for (int m = F.tid >> 5; m < NSEQ; m += 16) { const int n = F.tid & 31; mod[(size_t)(l * NSEQ + m) * 9216 + nc0 + n] = T[m * 33 + n] + adab[l * 9216 + nc0 + n]; }
        __syncthreads();
    }
}

DI void tr_item(const float* src, int ld, int nvalid, float keep, const float* sc, float sa, float sb, bf16* dst, int dld, LAS float* scr, int lane) {
    const int n4 = (lane & 7) * 4, kr = lane >> 3; const float kz = (n4 < nvalid) ? keep : 0.f;
    f32x4 v[8]; float m[8];
#pragma unroll
    for (int i = 0; i < 8; ++i) { v[i] = *(const f32x4*)(src + (size_t)(kr + 8 * i) * ld + n4); m[i] = sc[kr + 8 * i]; }
#pragma unroll
    for (int i = 0; i < 8; ++i) { const float f = (sa + sb * m[i]) * kz; LAS float* p = scr + (kr + 8 * i) * 33 + n4;
        p[0] = kz == 0.f ? 0.f : v[i].x * f; p[1] = kz == 0.f ? 0.f : v[i].y * f; p[2] = kz == 0.f ? 0.f : v[i].z * f; p[3] = kz == 0.f ? 0.f : v[i].w * f; }
    LDS_WAIT(); asm volatile("" ::: "memory");
    const int c = lane & 7;
#pragma unroll
    for (int j = 0; j < 4; ++j) { const int n = (lane >> 3) + 8 * j; const LAS float* s = scr + (8 * c) * 33 + n;
        v4u o; o.x = pk2(s[0 * 33], s[1 * 33]); o.y = pk2(s[2 * 33], s[3 * 33]); o.z = pk2(s[4 * 33], s[5 * 33]); o.w = pk2(s[6 * 33], s[7 * 33]);
        *(GAS v4u*)(dst + (size_t)n * dld + 8 * c) = o; }
    LDS_WAIT(); asm volatile("" ::: "memory");
}
DI void p0_weights(Frame& F, const Args& AR) {
    LAS float* scr = (LAS float*)(F.lds + 32768 + F.wave * 8704);
    const int gw = F.vcu * NWAVES + F.wave, NGW = F.G * NWAVES;
    constexpr int I_13 = 16 * 176, I_2 = 44 * 32, I_IN = 16 * 104, I_SQ = 16 * 32, I_RKI = 32 * 104, I_L2 = 4 * 96;
    constexpr int NITEMS = 4 * I_13 + 4 * I_2 + I_IN + 2 * I_SQ + I_RKI + I_L2;
    bf16* W13 = (bf16*)(F.ws + WS_W13); bf16* W2 = (bf16*)(F.ws + WS_W2); bf16* WIN = (bf16*)(F.ws + WS_WIN); bf16* WOUT = (bf16*)(F.ws + WS_WOUT);
    bf16* WRK = (bf16*)(F.ws + WS_WRK); bf16* WL2 = (bf16*)(F.ws + WS_WL2); bf16* WO = (bf16*)(F.ws + WS_WO);
    for (int it = gw; it < NITEMS; it += NGW) {
        int r = it;
        if (r < 4 * I_13) { const int f = r / I_13; r -= f * I_13; const int kt = r / 176, tn = r % 176, j = tn >> 3, i = tn & 7;
            const float* src = (i < 4 ? AR.in[I_W1] : AR.in[I_W3]) + (size_t)f * 1024 * FF + (size_t)(64 * kt) * FF + 128 * j + 32 * (i & 3);
            tr_item(src, FF, 32, 1.f, src, 1.f, 0.f, W13 + (size_t)f * 5632 * 1024 + (size_t)(32 * tn) * 1024 + 64 * kt, 1024, scr, F.lane); continue; }
        r -= 4 * I_13;
        if (r < 4 * I_2) { const int f = r / I_2; r -= f * I_2; const int kt = r / 32, tn = r % 32;
            const float* src = AR.in[I_W2] + (size_t)f * FF * 1024 + (size_t)(64 * kt) * 1024 + 32 * tn;
            tr_item(src, 1024, 32, 1.f, src, 1.f, 0.f, W2 + (size_t)f * 1024 * FF + (size_t)(32 * tn) * FF + 64 * kt, FF, scr, F.lane); continue; }
        r -= 4 * I_2;
        if (r < I_IN) { const int kt = r / 104, tn = r % 104, nd = 32 * tn; int sc0 = 0, nv = 32; bool has = true;
            if (nd < 2048) sc0 = nd; else if (nd < 3072) sc0 = nd + 8; else if (nd == 3072) { sc0 = 2048; nv = 8; } else has = false;
            const float* src = AR.in[I_WIN] + (size_t)(64 * kt) * 3080 + sc0;
            tr_item(src, 3080, nv, has ? 1.f : 0.f, src, 1.f, 0.f, WIN + (size_t)nd * 1024 + 64 * kt, 1024, scr, F.lane); continue; }
        r -= I_IN;
        if (r < 2 * I_SQ) { const int w = r / I_SQ; r -= w * I_SQ; const int kt = r / 32, tn = r % 32;
            const float* src = (w == 0 ? AR.in[I_WOUT] : AR.in[I_WO]) + (size_t)(64 * kt) * 1024 + 32 * tn;
            tr_item(src, 1024, 32, 1.f, src, 1.f, 0.f, (w == 0 ? WOUT : WO) + (size_t)(32 * tn) * 1024 + 64 * kt, 1024, scr, F.lane); continue; }
        r -= 2 * I_SQ;
        if (r < I_RKI) { const int kt = r / 104, tn = r % 104, nd = 32 * tn, kd = 64 * kt, half = kd >= 1024, ks = kd & 1023;
            const float* base; int ld, col, mi;
            if (nd < 1024) { base = AR.in[I_WR]; ld = 1024; col = nd; mi = 0; }
            else if (nd < 2048) { base = AR.in[I_WK]; ld = 1024; col = nd - 1024; mi = 2; }
            else if (nd < 3072) { base = AR.in[I_WV]; ld = 1024; col = nd - 2048; mi = 3; }
            else if (nd < 3136) { base = AR.in[I_LW1]; ld = 64; col = nd - 3072; mi = 1; }
            else if (nd < 3200) { base = AR.in[I_A1]; ld = 64; col = nd - 3136; mi = 4; }
            else { base = AR.in[I_G1]; ld = 128; col = nd - 3200; mi = 5; }
            tr_item(base + (size_t)ks * ld + col, ld, 32, 1.f, AR.in[I_MU] + mi * 1024 + ks, half ? 0.f : 1.f, half ? 1.f : -1.f, WRK + (size_t)nd * 2048 + kd, 2048, scr, F.lane); continue; }
        r -= I_RKI;
        { const int kt = r / 96, tn = r % 96, nd = 32 * tn; const float* src = AR.in[I_LW2]; float keep = 0.f;
            if (nd < 1024) { if (kt == 0) { src = AR.in[I_LW2] + nd; keep = 1.f; } }
            else if (nd < 2048) { if (kt == 1) { src = AR.in[I_A2] + (nd - 1024); keep = 1.f; } }
            else { if (kt >= 2) { src = AR.in[I_G2] + (size_t)(64 * (kt - 2)) * 1024 + (nd - 2048); keep = 1.f; } }
            tr_item(src, 1024, 32, keep, AR.in[I_LW2], 1.f, 0.f, WL2 + (size_t)nd * 256 + 64 * kt, 256, scr, F.lane); }
    }
}

DI void ld8(float (&v)[8], const bf16* p) { const v4u q = *(const v4u*)p; v[0] = bflo(q.x); v[1] = bfhi(q.x); v[2] = bflo(q.y); v[3] = bfhi(q.y); v[4] = bflo(q.z); v[5] = bfhi(q.z); v[6] = bflo(q.w); v[7] = bfhi(q.w); }
DI void ld8(float (&v)[8], const float* p) { const f32x4 a = *(const f32x4*)p, b = *(const f32x4*)(p + 4); v[0] = a.x; v[1] = a.y; v[2] = a.z; v[3] = a.w; v[4] = b.x; v[5] = b.y; v[6] = b.z; v[7] = b.w; }
DI v4u pk8(const float (&v)[8]) { v4u w; w.x = pk2(v[0], v[1]); w.y = pk2(v[2], v[3]); w.z = pk2(v[4], v[5]); w.w = pk2(v[6], v[7]); return w; }
DI void ln_pass(Frame& F, const Args& AR, int first, int do_ln, int l, int sub, int lm, int js, int mode, int nsplit, int xfirst, int fin) {
    const int gw = F.vcu * NWAVES + F.wave, NGW = F.G * NWAVES, lane = F.lane;
    bf16* XB = (bf16*)((unsigned char*)F.out + XB_OFF); const bf16* ZS = fin ? (const bf16*)(F.ws + WS_ZF) : XB;
    const float* lg = AR.in[I_LNG] + (l * 3 + sub) * 1024; const float* lb = AR.in[I_LNB] + (l * 3 + sub) * 1024;
    const float* mod = (const float*)(F.ws + WS_MOD);
    bf16* H = (bf16*)(F.ws + WS_H); bf16* A2 = (bf16*)(F.ws + WS_A2);
    float nv[2][8];
    { const int r = gw < M ? gw : 0;
#pragma unroll
        for (int j = 0; j < 2; ++j) { const int c0 = 8 * (lane + 64 * j);
            if (first || (xfirst && r >= MP)) ld8(nv[j], (r < MP ? AR.in[I_XP] + (size_t)r * D : AR.in[I_XS] + (size_t)(r - MP) * D) + c0);
            else ld8(nv[j], ZS + (size_t)r * D + c0); } }
    for (int r = gw; r < M; r += NGW) {
        float v[2][8];
#pragma unroll
        for (int j = 0; j < 2; ++j)
#pragma unroll
            for (int e = 0; e < 8; ++e) v[j][e] = nv[j][e];
        { const int rn = r + NGW < M ? r + NGW : r;
#pragma unroll
            for (int j = 0; j < 2; ++j) { const int c0 = 8 * (lane + 64 * j);
                if (first || (xfirst && rn >= MP)) ld8(nv[j], (rn < MP ? AR.in[I_XP] + (size_t)rn * D : AR.in[I_XS] + (size_t)(rn - MP) * D) + c0);
                else ld8(nv[j], ZS + (size_t)rn * D + c0); } }
        if (nsplit > 0 && r >= MP) {
            const float* gp = mod + ((size_t)(l * NSEQ + pg8::mod_row(r)) * 9 + 3 * sub + 2) * 1024; const float rw = sub == 1 ? 1.0f : 0.5f;
            const float* sl = (const float*)(F.ws + WS_SLAB) + (size_t)(r - MP) * 1024;
#pragma unroll
            for (int j = 0; j < 2; ++j) { const int c0 = 8 * (lane + 64 * j); float a[8], g[8]; ld8(a, sl + c0); ld8(g, gp + c0);
                for (int s = 1; s < nsplit; ++s) { float t[8]; ld8(t, sl + (size_t)s * 1024 * 1024 + c0);
#pragma unroll
                    for (int e = 0; e < 8; ++e) a[e] += t[e]; }
#pragma unroll
                for (int e = 0; e < 8; ++e) v[j][e] = v[j][e] * ALPHA + (g[e] + 1.0f) * rw * a[e]; }
        }
        if (do_ln) {
            float s = 0.f;
#pragma unroll
            for (int j = 0; j < 2; ++j)
#pragma unroll
                for (int e = 0; e < 8; ++e) s += v[j][e];
            const float mean = wave_sum(s) * (1.f / D); float s2 = 0.f;
#pragma unroll
            for (int j = 0; j < 2; ++j)
#pragma unroll
                for (int e = 0; e < 8; ++e) { v[j][e] -= mean; s2 += v[j][e] * v[j][e]; }
            const float rstd = 1.f / sqrtf(wave_sum(s2) * (1.f / D) + LN_EPS);
#pragma unroll
            for (int j = 0; j < 2; ++j) { const int c0 = 8 * (lane + 64 * j); float g[8], b[8]; ld8(g, lg + c0); ld8(b, lb + c0);
#pragma unroll
                for (int e = 0; e < 8; ++e) v[j][e] = v[j][e] * rstd * g[e] + b[e];
                if (fin) { float* o = F.out + O_Y + (size_t)r * D + c0; *(f32x4*)o = (f32x4){v[j][0], v[j][1], v[j][2], v[j][3]}; *(f32x4*)(o + 4) = (f32x4){v[j][4], v[j][5], v[j][6], v[j][7]}; }
                else *(v4u*)(XB + (size_t)r * D + c0) = pk8(v[j]); }
        }
        if (mode != 2) {
            const int mr = pg8::mod_row(r);
            const float* sh = mod + ((size_t)(lm * NSEQ + mr) * 9 + js) * 1024; const float* sc = sh + 1024;
            int t, len, b; if (r < MP) { t = r & (PSEQ - 1); len = PSEQ; b = r >> 11; } else { t = (r - MP) & (SSEQ - 1); len = SSEQ; b = (r - MP) >> 3; }
#pragma unroll
            for (int j = 0; j < 2; ++j) { const int c0 = 8 * (lane + 64 * j); float s8[8], h8[8], h[8]; ld8(s8, sc + c0); ld8(h8, sh + c0);
#pragma unroll
                for (int e = 0; e < 8; ++e) h[e] = v[j][e] * (s8[e] + 1.0f) + h8[e];
                const v4u w = pk8(h);
                if (mode == 0) *(v4u*)(H + (size_t)r * D + c0) = w;
                else {
                    *(v4u*)(A2 + (size_t)r * 2048 + c0) = w;
                    if (t + 1 < len) *(v4u*)(A2 + (size_t)(r + 1) * 2048 + 1024 + c0) = w;
                    if (t == 0) { v4u p; p.x = 0u; p.y = 0u; p.z = 0u; p.w = 0u;
                        if (r >= MP) { float q[8]; ld8(q, AR.in[I_SSH] + (size_t)b * D + c0); p = pk8(q); }
                        *(v4u*)(A2 + (size_t)r * 2048 + 1024 + c0) = p; }
                    if (t == len - 1) { float* o = F.out + (r < MP ? O_PSH : O_SSH) + (size_t)b * D + c0; *(f32x4*)o = (f32x4){h[0], h[1], h[2], h[3]}; *(f32x4*)(o + 4) = (f32x4){h[4], h[5], h[6], h[7]}; }
                } }
        }
    }
}

DI float log_sigmoid(float x) { return -(fmaxf(-x, 0.f) + log1pf(__expf(-fabsf(x)))); }
DI float gelu_tanh(float x) { const float u = 0.7978845608f * (x + 0.044715f * x * x * x); return 0.5f * x * (1.0f + pg8::ftanh(u)); }

DI void ml1_prompt(Frame& F, const Args& AR) {
    const bf16* Z = (const bf16*)(F.ws + WS_Z);
    float* CST = (float*)(F.ws + WS_CST); float* NST = (float*)(F.ws + WS_NST); float* MST = (float*)(F.ws + WS_MST);
    LAS bf16* Ks = (LAS bf16*)F.lds;
    LAS bf16* Vs = (LAS bf16*)(F.lds + 32768);
    LAS float* LF = (LAS float*)(F.lds + 65536);
    LAS float* GS = (LAS float*)(F.lds + 65536 + 512);
    LAS float* RED = (LAS float*)(F.lds + 65536 + 1024);
    const int tid = F.tid, lane = F.lane, wave = F.wave, r = lane & 31, hh = lane >> 5;
    for (int item = F.vcu; item < 512; item += F.G) {
        const int b = item >> 6, h = (item >> 4) & 3, c = item & 15; const size_t row0 = (size_t)b * PSEQ + c * 128;
#pragma unroll
        for (int i = 0; i < 4; ++i) { const int e = tid + i * NTHREADS, s = e >> 4, c8 = (e & 15) * 8;
            *(LAS v4u*)(Ks + s * 128 + c8) = *(const v4u*)(Z + (row0 + s) * ZW + ZK + h * 128 + c8);
            *(LAS v4u*)(Vs + s * 128 + c8) = *(const v4u*)(Z + (row0 + s) * ZW + ZV + h * 128 + c8); }
        if (tid < 128) { const float fg = bf2f(Z[(row0 + tid) * ZW + ZFG + h]); LF[tid] = log_sigmoid(fg + AR.in[I_BG][4 + h]); }
        __syncthreads();
        if (tid < 128) { float bs = 0.f; for (int s = 0; s <= tid; ++s) bs += LF[s];
            const float ig = bf2f(Z[(row0 + tid) * ZW + ZIG + h]) + AR.in[I_BG][h];
            GS[tid] = ig - bs; if (tid == 127) RED[0] = bs; }
        __syncthreads();
        float gmax = -INFINITY; for (int s = 0; s < 128; ++s) gmax = fmaxf(gmax, GS[s]);
        const float bL = RED[0];
        __syncthreads();
        if (tid < 128) GS[tid] = fexp(GS[tid] - gmax);
        __syncthreads();
        const int vb = wave >> 1, kb0 = 2 * (wave & 1);
        f32x16 acc[2];
#pragma unroll
        for (int i = 0; i < 16; ++i) { acc[0][i] = 0.f; acc[1][i] = 0.f; }
#pragma unroll 2
        for (int ks = 0; ks < 8; ++ks) { const int s0 = 16 * ks + 8 * hh;
            float a[8];
#pragma unroll
            for (int j = 0; j < 8; ++j) a[j] = bf2f(Vs[(s0 + j) * 128 + vb * 32 + r]) * GS[s0 + j];
            const bf16x8 A = pack8(a);
#pragma unroll
            for (int q = 0; q < 2; ++q) { unsigned kw[8];
#pragma unroll
                for (int j = 0; j < 8; ++j) kw[j] = Ks[(s0 + j) * 128 + (kb0 + q) * 32 + r];
                const bf16x8 B = mk_frag(kw[0] | (kw[1] << 16), kw[2] | (kw[3] << 16), kw[4] | (kw[5] << 16), kw[6] | (kw[7] << 16));
                acc[q] = MFMA32(A, B, acc[q]); } }
        float* Co = CST + (size_t)item * 16384;
#pragma unroll
        for (int q = 0; q < 2; ++q)
#pragma unroll
            for (int i = 0; i < 16; ++i) Co[(vb * 32 + crow(i, hh)) * 128 + (kb0 + q) * 32 + r] = acc[q][i] * MSCALE;
        if (tid < 128) { float n = 0.f; for (int s = 0; s < 128; ++s) n += GS[s] * bf2f(Ks[s * 128 + tid]); NST[item * 128 + tid] = n * MSCALE; }
        if (tid == 0) { MST[item * 4 + 0] = bL + gmax; MST[item * 4 + 1] = bL; }
        __syncthreads();
    }
}

DI void ml_sample(Frame& F, const Args& AR) {
    const bf16* Z = (const bf16*)(F.ws + WS_Z); bf16* G = (bf16*)(F.ws + WS_H);
    LAS float* Qs = (LAS float*)F.lds;
    LAS float* Ks = Qs + 1024; LAS float* Vs = Ks + 1024;
    LAS float* HT = Vs + 1024;
    LAS float* P = HT + 1024;
    LAS float* GT = P + 64;
    LAS float* SC = GT + 64;
    const int tid = F.tid, lane = F.lane, wave = F.wave;
    const float* C0g = AR.in[I_SMC]; const float* n0g = AR.in[I_SMN]; const float* m0g = AR.in[I_SMM];
    for (int item = F.vcu; item < 512; item += F.G) {
        const int b = item >> 2, h = item & 3; const size_t row0 = (size_t)MP + (size_t)b * SSEQ;
        for (int e = tid; e < 3 * 512; e += NTHREADS) { const int w = e >> 9, t = (e >> 6) & 7, c2 = (e & 63) * 2;
            const unsigned u = *(const unsigned*)(Z + (row0 + t) * ZW + (w == 0 ? ZQ : (w == 1 ? ZK : ZV)) + h * 128 + c2);
            LAS float* dst = (w == 0 ? Qs : (w == 1 ? Ks : Vs)) + t * 128 + c2; dst[0] = bflo(u); dst[1] = bfhi(u); }
        const float m0 = m0g[b * 4 + h];
        if (tid < 16) { const int t = tid & 7; const float zv = bf2f(Z[(row0 + t) * ZW + (tid < 8 ? ZIG : ZFG) + h]);
            if (tid < 8) P[t] = zv + AR.in[I_BG][h]; else GT[7 * 8 + t] = log_sigmoid(zv + AR.in[I_BG][4 + h]); }
        __syncthreads();
        if (tid < 8) { float bs = 0.f, mx = m0, bsl = 0.f, gme = 0.f;
            for (int s = 0; s < 8; ++s) { bs += GT[7 * 8 + s]; const float g = P[s] - bs; if (s <= tid) { mx = fmaxf(mx, g); bsl = bs; } if (s == tid) gme = g; }
            GT[0 * 8 + tid] = bsl; GT[1 * 8 + tid] = gme; GT[2 * 8 + tid] = mx; GT[3 * 8 + tid] = fexp(m0 - mx);
            if (tid == 7) { const float mend = bsl + mx; SC[0] = mend; SC[1] = fexp(bsl + m0 - mend); } }
        __syncthreads();
        if (tid < 8) { const float mend = SC[0]; GT[5 * 8 + tid] = fexp(GT[0 * 8 + 7] + GT[1 * 8 + tid] - mend); }
        if (tid < 64) { const int t = tid >> 3, s = tid & 7; float d = 0.f;
            if (s <= t) { for (int k = 0; k < 128; ++k) d += Qs[t * 128 + k] * Ks[s * 128 + k]; d = d * MSCALE * fexp(GT[1 * 8 + s] - GT[2 * 8 + t]); }
            P[t * 8 + s] = d; }
        else if (tid < 72) { const int t = tid - 64; float d = 0.f; for (int k = 0; k < 128; ++k) d += Qs[t * 128 + k] * n0g[(size_t)(b * 4 + h) * 128 + k]; GT[6 * 8 + t] = d; }
        __syncthreads();
        if (tid < 8) { float d = 0.f; for (int s = 0; s < 8; ++s) d += P[tid * 8 + s]; d += GT[3 * 8 + tid] * GT[6 * 8 + tid];
            const float mt = GT[0 * 8 + tid] + GT[2 * 8 + tid]; GT[4 * 8 + tid] = fmaxf(fabsf(d), fexp(-mt)); }
        const int v = tid >> 2, seg = tid & 3;
        const float* C0p = C0g + ((size_t)(b * 4 + h) * 128 + v) * 128 + seg * 32;
        float c0[32];
#pragma unroll
        for (int i = 0; i < 8; ++i) { const f32x4 q = *(const f32x4*)(C0p + 4 * i); c0[4 * i] = q.x; c0[4 * i + 1] = q.y; c0[4 * i + 2] = q.z; c0[4 * i + 3] = q.w; }
        __syncthreads();
        float inter[8];
#pragma unroll
        for (int t = 0; t < 8; ++t) { float d = 0.f;
#pragma unroll
            for (int i = 0; i < 32; ++i) d += c0[i] * Qs[t * 128 + seg * 32 + i];
            d += __shfl_xor(d, 1); d += __shfl_xor(d, 2); inter[t] = d; }
        if (seg == 0) {
#pragma unroll
            for (int t = 0; t < 8; ++t) { float num = GT[3 * 8 + t] * inter[t];
                for (int s = 0; s <= t; ++s) num += P[t * 8 + s] * Vs[s * 128 + v];
                HT[t * 128 + v] = num / GT[4 * 8 + t]; } }
        { const float wst = SC[1]; float* Cout = F.out + O_SMC + ((size_t)(b * 4 + h) * 128 + v) * 128 + seg * 32;
#pragma unroll
            for (int i = 0; i < 32; ++i) c0[i] *= wst;
#pragma unroll
            for (int s = 0; s < 8; ++s) { const float wv = GT[5 * 8 + s] * Vs[s * 128 + v] * MSCALE;
#pragma unroll
                for (int i = 0; i < 32; ++i) c0[i] += wv * Ks[s * 128 + seg * 32 + i]; }
#pragma unroll
            for (int i = 0; i < 8; ++i) { f32x4 q; q.x = c0[4 * i]; q.y = c0[4 * i + 1]; q.z = c0[4 * i + 2]; q.w = c0[4 * i + 3]; *(f32x4*)(Cout + 4 * i) = q; } }
        if (tid < 128) { float n = SC[1] * n0g[(size_t)(b * 4 + h) * 128 + tid];
            for (int s = 0; s < 8; ++s) n += GT[5 * 8 + s] * Ks[s * 128 + tid] * MSCALE;
            F.out[O_SMN + (size_t)(b * 4 + h) * 128 + tid] = n; }
        if (tid == 0) F.out[O_SMM + b * 4 + h] = SC[0];
        __syncthreads();
        { const int t = wave; const float x0 = HT[t * 128 + lane], x1 = HT[t * 128 + 64 + lane];
            const float mean = wave_sum(x0 + x1) * (1.f / 128.f); const float d0 = x0 - mean, d1 = x1 - mean;
            const float rstd = 1.f / sqrtf(wave_sum(d0 * d0 + d1 * d1) * (1.f / 128.f) + HEAD_EPS);
            const size_t row = row0 + t;
            const float o0 = bf2f(Z[row * ZW + ZO + h * 128 + lane]), o1 = bf2f(Z[row * ZW + ZO + h * 128 + 64 + lane]);
            const float g0 = AR.in[I_MNG][h * 128 + lane], g1 = AR.in[I_MNG][h * 128 + 64 + lane];
            G[row * D + h * 128 + lane] = (bf16)f2bf(d0 * rstd * g0 * fsig(o0)); G[row * D + h * 128 + 64 + lane] = (bf16)f2bf(d1 * rstd * g1 * fsig(o1)); }
        __syncthreads();
    }
}

DI void rg1(Frame& F, const Args& AR) {
    const bf16* Z = (const bf16*)(F.ws + WS_Z); bf16* G = (bf16*)(F.ws + WS_H);
    float* RGH = (float*)(F.ws + WS_RGH); float* RGP = (float*)(F.ws + WS_RGP);
    const int lane = F.lane, g = F.wave, r = lane & 31, hh = lane >> 5;
    LAS float* XT = (LAS float*)(F.lds + g * 17408);
    LAS float* AT = XT + 32 * 68;
    const float* wa = AR.in[I_WA] + (size_t)g * 4096; const float* wx = AR.in[I_WX] + (size_t)g * 4096;
    bf16x8 Ba[4][2], Bx[4][2];
    { const GAS float* wab = (const GAS float*)(wa + 8 * hh * 64 + r); const GAS float* wxb = (const GAS float*)(wx + 8 * hh * 64 + r);
#pragma unroll
        for (int ks = 0; ks < 4; ++ks)
#pragma unroll
            for (int cb = 0; cb < 2; ++cb) { float a[8], x[8];
#pragma unroll
                for (int j = 0; j < 8; ++j) { const int i = 16 * ks + j; a[j] = wab[i * 64 + cb * 32]; x[j] = wxb[i * 64 + cb * 32]; }
                Ba[ks][cb] = pack8(a); Bx[ks][cb] = pack8(x); } }
    float spl[2], ba[2], bx[2];
#pragma unroll
    for (int cb = 0; cb < 2; ++cb) { const int c = 64 * g + cb * 32 + r; spl[cb] = -8.0f * log1pf(__expf(-AR.in[I_LAM][c])); ba[cb] = AR.in[I_BA][c]; bx[cb] = AR.in[I_BX][c]; }
    const float* cw = AR.in[I_CW]; const float* cbias = AR.in[I_CB];
    for (int tt = F.vcu; tt < M / 32; tt += F.G) {
        const int R0 = tt * 32, row = R0 + r; const bool samp = R0 >= MP;
        int t, b; if (!samp) { t = row & (PSEQ - 1); b = row >> 11; } else { t = (row - MP) & 7; b = (row - MP) >> 3; }
        bf16x8 Af[4];
#pragma unroll
        for (int ks = 0; ks < 4; ++ks) { const int c0 = 64 * g + 16 * ks + 8 * hh; float xc[8];
            { const f32x4 q0 = *(const f32x4*)(cbias + c0), q1 = *(const f32x4*)(cbias + c0 + 4); xc[0] = q0.x; xc[1] = q0.y; xc[2] = q0.z; xc[3] = q0.w; xc[4] = q1.x; xc[5] = q1.y; xc[6] = q1.z; xc[7] = q1.w; }
#pragma unroll
            for (int tap = 0; tap < 4; ++tap) { const int tp = t + tap - 3; const bool ok = tp >= 0; float xv[8];
                { const v4u q = *(const v4u*)(Z + (size_t)(ok ? row + tap - 3 : row) * ZW + ZXR + c0);
                    xv[0] = bflo(q.x); xv[1] = bfhi(q.x); xv[2] = bflo(q.y); xv[3] = bfhi(q.y); xv[4] = bflo(q.z); xv[5] = bfhi(q.z); xv[6] = bflo(q.w); xv[7] = bfhi(q.w); }
                if (samp) { const float* sp = AR.in[I_SRC] + ((size_t)b * 3 + (ok ? 0 : t + tap)) * 512 + c0; const f32x4 q0 = *(const f32x4*)sp, q1 = *(const f32x4*)(sp + 4);
                    if (!ok) { xv[0] = q0.x; xv[1] = q0.y; xv[2] = q0.z; xv[3] = q0.w; xv[4] = q1.x; xv[5] = q1.y; xv[6] = q1.z; xv[7] = q1.w; } }
                else if (!ok) {
#pragma unroll
                    for (int j = 0; j < 8; ++j) xv[j] = 0.f; }
                const f32x4 w0 = *(const f32x4*)(cw + tap * 512 + c0), w1 = *(const f32x4*)(cw + tap * 512 + c0 + 4);
                xc[0] += w0.x * xv[0]; xc[1] += w0.y * xv[1]; xc[2] += w0.z * xv[2]; xc[3] += w0.w * xv[3]; xc[4] += w1.x * xv[4]; xc[5] += w1.y * xv[5]; xc[6] += w1.z * xv[6]; xc[7] += w1.w * xv[7]; }
            Af[ks] = pack8(xc);
            LAS float* xp = XT + r * 68 + 16 * ks + 8 * hh;
            *(LAS f32x4*)xp = (f32x4){xc[0], xc[1], xc[2], xc[3]}; *(LAS f32x4*)(xp + 4) = (f32x4){xc[4], xc[5], xc[6], xc[7]};
            asm volatile("" ::: "memory"); }
        LDS_WAIT(); asm volatile("" ::: "memory");
#pragma unroll
        for (int cb = 0; cb < 2; ++cb) { f32x16 da, dx;
#pragma unroll
            for (int i = 0; i < 16; ++i) { da[i] = 0.f; dx[i] = 0.f; }
#pragma unroll
            for (int ks = 0; ks < 4; ++ks) { da = MFMA32(Af[ks], Ba[ks][cb], da); dx = MFMA32(Af[ks], Bx[ks][cb], dx); }
#pragma unroll
            for (int i = 0; i < 16; ++i) { const int tr = crow(i, hh), j = cb * 32 + r;
                const float rg = fsig(da[i] + ba[cb]), ig = fsig(dx[i] + bx[cb]);
                const float la = spl[cb] * rg, a = fexp(la), xcv = XT[tr * 68 + j];
                const float u = sqrtf(fmaxf(1.0f - a * a, 0.f)) * ig * xcv;
                AT[tr * 68 + j] = a; XT[tr * 68 + j] = u; } }
        LDS_WAIT(); asm volatile("" ::: "memory");
        { const int c = 64 * g + lane;
            if (!samp) { float h = 0.f, P = 1.f;
#pragma unroll 8
                for (int tr = 0; tr < 32; ++tr) { const float a = AT[tr * 68 + lane], u = XT[tr * 68 + lane]; h = a * h + u; P *= a;
                    RGH[(size_t)(R0 + tr) * 512 + c] = h; RGP[(size_t)(R0 + tr) * 512 + c] = P; } }
            else { float h = 0.f; const int b0 = (R0 - MP) >> 3;
#pragma unroll 8
                for (int tr = 0; tr < 32; ++tr) { const int bb = b0 + (tr >> 3);
                    if ((tr & 7) == 0) h = AR.in[I_SRH][(size_t)bb * 512 + c];
                    const float a = AT[tr * 68 + lane], u = XT[tr * 68 + lane]; h = a * h + u;
                    const float gr = bf2f(Z[(size_t)(R0 + tr) * ZW + ZGR + c]);
                    G[(size_t)(R0 + tr) * D + 512 + c] = (bf16)f2bf(h * gelu_tanh(gr));
                    if ((tr & 7) == 7) F.out[O_SRH + (size_t)bb * 512 + c] = h; } } }
        LDS_WAIT(); asm volatile("" ::: "memory");
    }
    { const int gt = F.vcu * NTHREADS + F.tid, NT = F.G * NTHREADS;
        for (int e = gt; e < NSEQ * 3 * 512; e += NT) { const int c = e & 511, j = (e >> 9) % 3, s = e / 1536;
            if (s < NPB) F.out[O_PRC + ((size_t)s * 3 + j) * 512 + c] = bf2f(Z[((size_t)s * PSEQ + PSEQ - 3 + j) * ZW + ZXR + c]);
            else { const int b = s - NPB; F.out[O_SRC + ((size_t)b * 3 + j) * 512 + c] = bf2f(Z[((size_t)MP + (size_t)b * SSEQ + SSEQ - 3 + j) * ZW + ZXR + c]); } } }
}

DI void ml2_scan(Frame& F, const Args& AR) {
    float* CST = (float*)(F.ws + WS_CST); float* NST = (float*)(F.ws + WS_NST); float* MST = (float*)(F.ws + WS_MST);
    for (int vb = F.vcu; vb < 256; vb += F.G) {
        const int bh = vb >> 3, e0 = ((vb & 7) * NTHREADS + F.tid) * 4;
        float m = 0.f; f32x4 C = (f32x4){0.f, 0.f, 0.f, 0.f};
        const bool nthr = (vb & 7) == 0 && F.tid < 128; float n = 0.f;
        f32x4 cl[16]; float ml[16], bl[16], nl[16];
#pragma unroll
        for (int c = 0; c < 16; ++c) { const int item = bh * 16 + c; cl[c] = *(const f32x4*)(CST + (size_t)item * 16384 + e0); ml[c] = MST[item * 4 + 0]; bl[c] = MST[item * 4 + 1];
            nl[c] = nthr ? NST[item * 128 + F.tid] : 0.f; }
#pragma unroll
        for (int c = 0; c < 16; ++c) { const int item = bh * 16 + c;
            *(f32x4*)(CST + (size_t)item * 16384 + e0) = C;
            const float mn = fmaxf(bl[c] + m, ml[c]), w0 = fexp(bl[c] + m - mn), w1 = fexp(ml[c] - mn);
            C = C * w0 + cl[c] * w1;
            if (nthr) { NST[item * 128 + F.tid] = n; n = n * w0 + nl[c] * w1; if (F.tid == 0) MST[item * 4 + 2] = m; }
            m = mn; }
        *(f32x4*)(F.out + O_PMC + (size_t)bh * 16384 + e0) = C;
        if (nthr) { F.out[O_PMN + bh * 128 + F.tid] = n; if (F.tid == 0) F.out[O_PMM + bh] = m; }
    }
}
DI void rg2_carry(Frame& F, const Args& AR) {
    const float* RGH = (const float*)(F.ws + WS_RGH); const float* RGP = (const float*)(F.ws + WS_RGP); float* CARRY = (float*)(F.ws + WS_CARRY);
    const int gt = F.vcu * NTHREADS + F.tid, NT = F.G * NTHREADS;
    for (int e = gt; e < NPB * 512; e += NT) { const int b = e >> 9, c = e & 511; float H = 0.f;
        for (int k0 = 0; k0 < 64; k0 += 16) { float pe[16], he[16];
#pragma unroll
            for (int k = 0; k < 16; ++k) { const size_t row = (size_t)b * PSEQ + 32 * (k0 + k) + 31; pe[k] = RGP[row * 512 + c]; he[k] = RGH[row * 512 + c]; }
#pragma unroll
            for (int k = 0; k < 16; ++k) { CARRY[((size_t)b * 64 + k0 + k) * 512 + c] = H; H = pe[k] * H + he[k]; } }
        F.out[O_PRH + (size_t)b * 512 + c] = H; }
}
DI void rg2_apply(Frame& F, const Args& AR) {
    const bf16* Z = (const bf16*)(F.ws + WS_Z); bf16* G = (bf16*)(F.ws + WS_H);
    const float* RGH = (const float*)(F.ws + WS_RGH); const float* RGP = (const float*)(F.ws + WS_RGP); const float* CARRY = (const float*)(F.ws + WS_CARRY);
    const int gt = F.vcu * NTHREADS + F.tid, NT = F.G * NTHREADS;
    for (int e = gt; e < MP * 64; e += NT) { const int row = e >> 6, c0 = (e & 63) * 8, b = row >> 11, tile = (row & (PSEQ - 1)) >> 5;
        const v4u gq = *(const v4u*)(Z + (size_t)row * ZW + ZGR + c0);
        const float gr[8] = {bflo(gq.x), bfhi(gq.x), bflo(gq.y), bfhi(gq.y), bflo(gq.z), bfhi(gq.z), bflo(gq.w), bfhi(gq.w)};
        const float* hp = RGH + (size_t)row * 512 + c0; const float* pp = RGP + (size_t)row * 512 + c0; const float* cp = CARRY + ((size_t)b * 64 + tile) * 512 + c0;
        float o[8];
#pragma unroll
        for (int q = 0; q < 2; ++q) { const f32x4 h4 = *(const f32x4*)(hp + 4 * q), p4 = *(const f32x4*)(pp + 4 * q), c4 = *(const f32x4*)(cp + 4 * q);
            const f32x4 hv = h4 + p4 * c4; o[4 * q] = hv.x * gelu_tanh(gr[4 * q]); o[4 * q + 1] = hv.y * gelu_tanh(gr[4 * q + 1]); o[4 * q + 2] = hv.z * gelu_tanh(gr[4 * q + 2]); o[4 * q + 3] = hv.w * gelu_tanh(gr[4 * q + 3]); }
        v4u w; w.x = pk2(o[0], o[1]); w.y = pk2(o[2], o[3]); w.z = pk2(o[4], o[5]); w.w = pk2(o[6], o[7]);
        *(v4u*)(G + (size_t)row * D + 512 + c0) = w; }
}

DI void ml3_prompt(Frame& F, const Args& AR) {
    const bf16* Z = (const bf16*)(F.ws + WS_Z); bf16* G = (bf16*)(F.ws + WS_H);
    const float* CST = (const float*)(F.ws + WS_CST); const float* NST = (const float*)(F.ws + WS_NST); const float* MST = (const float*)(F.ws + WS_MST);
    LAS bf16* Qs = (LAS bf16*)F.lds;
    LAS bf16* Ks = (LAS bf16*)(F.lds + 34816);
    LAS bf16* Vs = (LAS bf16*)(F.lds + 69632);
    LAS float* LF = (LAS float*)(F.lds + 102400);
    LAS float* BC = LF + 128;
    LAS float* GS = BC + 128;
    LAS float* MX = GS + 128;
    LAS float* N0 = MX + 128;
    LAS float* RA = N0 + 128;
    LAS float* RB = RA + 256;
    LAS float* OT = (LAS float*)F.lds;
    const int tid = F.tid, lane = F.lane, wave = F.wave, r = lane & 31, hh = lane >> 5;
    const int tb = wave >> 1, vh = wave & 1, t = tb * 32 + r;
    for (int item = F.vcu; item < 512; item += F.G) {
        const int b = item >> 6, h = (item >> 4) & 3, c = item & 15; const size_t row0 = (size_t)b * PSEQ + c * 128;
        const float m0 = MST[item * 4 + 2]; const float* C0 = CST + (size_t)item * 16384;
#pragma unroll
        for (int i = 0; i < 4; ++i) { const int e = tid + i * NTHREADS, s = e >> 4, c8 = (e & 15) * 8; const bf16* zr = Z + (row0 + s) * ZW + h * 128 + c8;
            *(LAS v4u*)(Qs + s * 136 + c8) = *(const v4u*)(zr + ZQ); *(LAS v4u*)(Ks + s * 136 + c8) = *(const v4u*)(zr + ZK); *(LAS v4u*)(Vs + s * 128 + c8) = *(const v4u*)(zr + ZV); }
        if (tid < 128) { LF[tid] = log_sigmoid(bf2f(Z[(row0 + tid) * ZW + ZFG + h]) + AR.in[I_BG][4 + h]); N0[tid] = NST[item * 128 + tid]; }
        __syncthreads();
        if (tid < 128) { float bs = 0.f; for (int s = 0; s <= tid; ++s) bs += LF[s];
            BC[tid] = bs; GS[tid] = bf2f(Z[(row0 + tid) * ZW + ZIG + h]) + AR.in[I_BG][h] - bs; }
        __syncthreads();
        if (tid < 128) { float mx = m0; for (int s = 0; s <= tid; ++s) mx = fmaxf(mx, GS[s]); MX[tid] = mx; }
        __syncthreads();
        const float mxt = MX[t], winter = fexp(m0 - mxt);
        bf16x8 bq[8];
#pragma unroll
        for (int ks = 0; ks < 8; ++ks) bq[ks] = *(const LAS bf16x8*)(Qs + t * 136 + 16 * ks + 8 * hh);
        bf16x8 pp[4][2]; float den = 0.f;
#pragma unroll
        for (int sb = 0; sb < 4; ++sb) {
            if (sb <= tb) { f32x16 sa;
#pragma unroll
                for (int i = 0; i < 16; ++i) sa[i] = 0.f;
#pragma unroll
                for (int ks = 0; ks < 8; ++ks) sa = MFMA32(*(const LAS bf16x8*)(Ks + (sb * 32 + r) * 136 + 16 * ks + 8 * hh), bq[ks], sa);
                float pv[16];
#pragma unroll
                for (int i = 0; i < 16; ++i) { const int s = sb * 32 + crow(i, hh); float v = sa[i] * MSCALE * fexp(GS[s] - mxt); if (s > t) v = 0.f; pv[i] = v; den += v; }
                pp[sb][0] = mk_frag(pk2(pv[0], pv[1]), pk2(pv[2], pv[3]), pk2(pv[4], pv[5]), pk2(pv[6], pv[7]));
                pp[sb][1] = mk_frag(pk2(pv[8], pv[9]), pk2(pv[10], pv[11]), pk2(pv[12], pv[13]), pk2(pv[14], pv[15]));
            } else { pp[sb][0] = mk_frag(0u, 0u, 0u, 0u); pp[sb][1] = mk_frag(0u, 0u, 0u, 0u); } }
        den += __shfl_xor(den, 32);
        float qn = 0.f;
#pragma unroll 8
        for (int k = 0; k < 64; ++k) qn += N0[hh * 64 + k] * bf2f(Qs[t * 136 + hh * 64 + k]);
        qn += __shfl_xor(qn, 32);
        const float dtot = den + winter * qn, denom = fmaxf(fabsf(dtot), fexp(-(BC[t] + mxt))), rden = 1.0f / denom;
        float hv[2][16];
#pragma unroll
        for (int q = 0; q < 2; ++q) { const int vb = vh * 2 + q; f32x16 an, ai;
#pragma unroll
            for (int i = 0; i < 16; ++i) { an[i] = 0.f; ai[i] = 0.f; }
#pragma unroll
            for (int sb = 0; sb < 4; ++sb) if (sb <= tb) {
#pragma unroll
                for (int s2 = 0; s2 < 2; ++s2) { unsigned vw[8];
#pragma unroll
                    for (int j = 0; j < 8; ++j) vw[j] = Vs[(sb * 32 + 16 * s2 + 8 * (j >> 2) + 4 * hh + (j & 3)) * 128 + vb * 32 + r];
                    an = MFMA32(mk_frag(vw[0] | (vw[1] << 16), vw[2] | (vw[3] << 16), vw[4] | (vw[5] << 16), vw[6] | (vw[7] << 16)), pp[sb][s2], an); } }
#pragma unroll
            for (int ks = 0; ks < 8; ++ks) { const float* cp = C0 + (size_t)(vb * 32 + r) * 128 + 16 * ks + 8 * hh; const f32x4 c0 = *(const f32x4*)cp, c1 = *(const f32x4*)(cp + 4);
                ai = MFMA32(mk_frag(pk2(c0.x, c0.y), pk2(c0.z, c0.w), pk2(c1.x, c1.y), pk2(c1.z, c1.w)), bq[ks], ai); }
#pragma unroll
            for (int i = 0; i < 16; ++i) hv[q][i] = (an[i] + winter * ai[i]) * rden; }
        float s1 = 0.f;
#pragma unroll
        for (int q = 0; q < 2; ++q)
#pragma unroll
            for (int i = 0; i < 16; ++i) s1 += hv[q][i];
        s1 += __shfl_xor(s1, 32);
        if (hh == 0) RA[vh * 128 + t] = s1;
        __syncthreads();
        const float mean = (RA[t] + RA[128 + t]) * (1.f / 128.f); float s2 = 0.f;
#pragma unroll
        for (int q = 0; q < 2; ++q)
#pragma unroll
            for (int i = 0; i < 16; ++i) { hv[q][i] -= mean; s2 += hv[q][i] * hv[q][i]; }
        s2 += __shfl_xor(s2, 32);
        if (hh == 0) RB[vh * 128 + t] = s2;
        __syncthreads();
        const float rstd = 1.f / sqrtf((RB[t] + RB[128 + t]) * (1.f / 128.f) + HEAD_EPS);
#pragma unroll
        for (int q = 0; q < 2; ++q)
#pragma unroll
            for (int i = 0; i < 16; ++i) OT[t * 132 + (vh * 2 + q) * 32 + crow(i, hh)] = hv[q][i] * rstd;
        __syncthreads();
        { const int tt = tid >> 2, v0 = (tid & 3) * 32; const size_t row = row0 + tt;
#pragma unroll
            for (int q = 0; q < 4; ++q) { const int v = v0 + 8 * q; const v4u oq = *(const v4u*)(Z + row * ZW + ZO + h * 128 + v);
                const float og[8] = {bflo(oq.x), bfhi(oq.x), bflo(oq.y), bfhi(oq.y), bflo(oq.z), bfhi(oq.z), bflo(oq.w), bfhi(oq.w)};
                const f32x4 g0 = *(const f32x4*)(AR.in[I_MNG] + h * 128 + v), g1 = *(const f32x4*)(AR.in[I_MNG] + h * 128 + v + 4);
                const f32x4 x0 = *(const LAS f32x4*)(OT + tt * 132 + v), x1 = *(const LAS f32x4*)(OT + tt * 132 + v + 4);
                v4u w; w.x = pk2(x0.x * g0.x * fsig(og[0]), x0.y * g0.y * fsig(og[1])); w.y = pk2(x0.z * g0.z * fsig(og[2]), x0.w * g0.w * fsig(og[3]));
                w.z = pk2(x1.x * g1.x * fsig(og[4]), x1.y * g1.y * fsig(og[5])); w.w = pk2(x1.z * g1.z * fsig(og[6]), x1.w * g1.w * fsig(og[7]));
                *(v4u*)(G + row * D + h * 128 + v) = w; } }
        __syncthreads();
    }
}

constexpr int TC = 32;
constexpr int RW_ARR = TC * 64;
constexpr int RW_BUF_FLOATS = 6 * RW_ARR + 2 * TC;
struct RwRaw { v2u r, k, v, w, a, g; };
DI void rw_load(RwRaw& x, const bf16* RK, const bf16* WAG, size_t row, size_t row_safe, int h, int k4, bool valid) {
    const size_t rr = valid ? row : row_safe;
    const bf16* p = RK + rr * RKW + h * 64 + k4; const bf16* q = WAG + rr * WAGW + h * 64 + k4;
    x.r = *(const v2u*)p; x.k = *(const v2u*)(p + 1024); x.v = *(const v2u*)(p + 2048); x.w = *(const v2u*)q; x.a = *(const v2u*)(q + 1024); x.g = *(const v2u*)(q + 2048);
}
DI void un4(const v2u u, float (&f)[4]) { f[0] = bflo(u.x); f[1] = bfhi(u.x); f[2] = bflo(u.y); f[3] = bfhi(u.y); }
DI float rw_prep(const RwRaw& x, LAS float* buf, int tok, int k4, const float (&kkw)[4], const float (&kaw)[4], const float (&rkw)[4]) {
    float r[4], k[4], v[4], w[4], a[4]; un4(x.r, r); un4(x.k, k); un4(x.v, v); un4(x.w, w); un4(x.a, a);
    float kk[4], ss = 0.f, bs = 0.f, km[4];
#pragma unroll
    for (int j = 0; j < 4; ++j) { kk[j] = k[j] * kkw[j]; ss += kk[j] * kk[j]; km[j] = k[j] * (1.0f + (a[j] - 1.0f) * kaw[j]); bs += r[j] * km[j] * rkw[j]; }
    ss = sum16(ss); bs = sum16(bs);
    const float inv = 1.0f / fmaxf(sqrtf(ss), 1e-12f);
    f32x4 o0, o1, o2, o3, o4, o5; float br = 0.f, kr = 0.f;
#pragma unroll
    for (int j = 0; j < 4; ++j) { const float kn = kk[j] * inv, dc = __builtin_amdgcn_exp2f(w[j]); o0[j] = kn; o1[j] = kn * a[j]; o2[j] = km[j]; o3[j] = dc; o4[j] = dc * r[j]; o5[j] = v[j];
        br += kn * a[j] * r[j]; kr += km[j] * r[j]; }
    br = sum16(br); kr = sum16(kr);
    LAS float* p = buf + tok * 64 + k4;
    *(LAS f32x4*)p = o0; *(LAS f32x4*)(p + RW_ARR) = o1; *(LAS f32x4*)(p + 2 * RW_ARR) = o2; *(LAS f32x4*)(p + 3 * RW_ARR) = o3;
    *(LAS f32x4*)(p + 4 * RW_ARR) = o4; *(LAS f32x4*)(p + 5 * RW_ARR) = o5;
    if (k4 == 0) *(LAS f32x2*)(buf + 6 * RW_ARR + 2 * tok) = (f32x2){br, kr};
    return bs;
}
#define BAR_LDS() do { asm volatile("s_waitcnt lgkmcnt(0)" ::: "memory"); __builtin_amdgcn_s_barrier(); asm volatile("" ::: "memory"); } while (0)
#define NOPK(x) asm volatile("" : "+v"(x))
DI void sum8x2(float& a, float& b) {
    asm volatile("s_nop 1\n\t"
                 "v_add_f32_dpp %0, %0, %0 quad_perm:[1,0,3,2] row_mask:0xf bank_mask:0xf\n\tv_add_f32_dpp %1, %1, %1 quad_perm:[1,0,3,2] row_mask:0xf bank_mask:0xf\n\ts_nop 0\n\t"
                 "v_add_f32_dpp %0, %0, %0 quad_perm:[2,3,0,1] row_mask:0xf bank_mask:0xf\n\tv_add_f32_dpp %1, %1, %1 quad_perm:[2,3,0,1] row_mask:0xf bank_mask:0xf\n\ts_nop 0\n\t"
                 "v_add_f32_dpp %0, %0, %0 row_half_mirror row_mask:0xf bank_mask:0xf\n\tv_add_f32_dpp %1, %1, %1 row_half_mirror row_mask:0xf bank_mask:0xf\n\ts_nop 0"
                 : "+v"(a), "+v"(b));
}
struct StepV { f32x4 ka, kb, ba, bb, ma, mb, da, db, ea, eb; float vv; f32x2 sc; };
DI void ld_step(StepV& s, const LAS float* cur, int tk, int p, int row) {
    const LAS float* q = cur + tk * 64 + 8 * p;
    s.ka = *(const LAS f32x4*)q; s.kb = *(const LAS f32x4*)(q + 4); s.ba = *(const LAS f32x4*)(q + RW_ARR); s.bb = *(const LAS f32x4*)(q + RW_ARR + 4);
    s.ma = *(const LAS f32x4*)(q + 2 * RW_ARR); s.mb = *(const LAS f32x4*)(q + 2 * RW_ARR + 4); s.da = *(const LAS f32x4*)(q + 3 * RW_ARR); s.db = *(const LAS f32x4*)(q + 3 * RW_ARR + 4);
    s.ea = *(const LAS f32x4*)(q + 4 * RW_ARR); s.eb = *(const LAS f32x4*)(q + 4 * RW_ARR + 4);
    s.vv = cur[5 * RW_ARR + tk * 64 + row]; s.sc = *(const LAS f32x2*)(cur + 6 * RW_ARR + 2 * tk);
}
DI void ld_step_asm(StepV& s, unsigned aq, unsigned av, unsigned asc) {
    asm volatile("ds_read_b128 %0, %12\n\tds_read_b128 %1, %12 offset:16\n\tds_read_b128 %2, %12 offset:8192\n\tds_read_b128 %3, %12 offset:8208\n\t"
                 "ds_read_b128 %4, %12 offset:16384\n\tds_read_b128 %5, %12 offset:16400\n\tds_read_b128 %6, %12 offset:24576\n\tds_read_b128 %7, %12 offset:24592\n\t"
                 "ds_read_b128 %8, %12 offset:32768\n\tds_read_b128 %9, %12 offset:32784\n\tds_read_b32 %10, %13\n\tds_read_b64 %11, %14"
                 : "=&v"(s.ka), "=&v"(s.kb), "=&v"(s.ba), "=&v"(s.bb), "=&v"(s.ma), "=&v"(s.mb), "=&v"(s.da), "=&v"(s.db), "=&v"(s.ea), "=&v"(s.eb), "=&v"(s.vv), "=&v"(s.sc)
                 : "v"(aq), "v"(av), "v"(asc) : "memory");
}
DI void wait_step(StepV& s) {
    asm volatile("s_waitcnt lgkmcnt(0)" : "+v"(s.ka), "+v"(s.kb), "+v"(s.ba), "+v"(s.bb), "+v"(s.ma), "+v"(s.mb), "+v"(s.da), "+v"(s.db), "+v"(s.ea), "+v"(s.eb), "+v"(s.vv), "+v"(s.sc) :: "memory");
}
DI void wait_step1(StepV& s) {
    asm volatile("s_waitcnt lgkmcnt(1)" : "+v"(s.ka), "+v"(s.kb), "+v"(s.ba), "+v"(s.bb), "+v"(s.ma), "+v"(s.mb), "+v"(s.da), "+v"(s.db), "+v"(s.ea), "+v"(s.eb), "+v"(s.vv), "+v"(s.sc) :: "memory");
}
DI void rw_step(float (&S)[8], const StepV& c, LAS float* ydst, bool wr) {
    const float kk[8] = {c.ka.x, c.ka.y, c.ka.z, c.ka.w, c.kb.x, c.kb.y, c.kb.z, c.kb.w}, ee[8] = {c.ea.x, c.ea.y, c.ea.z, c.ea.w, c.eb.x, c.eb.y, c.eb.z, c.eb.w};
    const float dd[8] = {c.da.x, c.da.y, c.da.z, c.da.w, c.db.x, c.db.y, c.db.z, c.db.w}, bb[8] = {c.ba.x, c.ba.y, c.ba.z, c.ba.w, c.bb.x, c.bb.y, c.bb.z, c.bb.w};
    const float mm[8] = {c.ma.x, c.ma.y, c.ma.z, c.ma.w, c.mb.x, c.mb.y, c.mb.z, c.mb.w};
    float a0 = S[0] * kk[0], a1 = S[4] * kk[4], y0 = S[0] * ee[0], y1 = S[4] * ee[4];
#pragma unroll
    for (int j = 1; j < 4; ++j) { a0 = fmaf(S[j], kk[j], a0); a1 = fmaf(S[4 + j], kk[4 + j], a1); y0 = fmaf(S[j], ee[j], y0); y1 = fmaf(S[4 + j], ee[4 + j], y1); }
    float a = a0 + a1, y = y0 + y1; NOPK(a); NOPK(y);
    sum8x2(a, y);
    const float sa = -a, v = c.vv;
#pragma unroll
    for (int j = 0; j < 8; ++j) { float t = S[j] * dd[j]; t = fmaf(mm[j], v, t); t = fmaf(bb[j], sa, t); NOPK(t); S[j] = t; }
    if (wr) *ydst = fmaf(v, c.sc.y, fmaf(sa, c.sc.x, y));
    asm volatile("" ::: "memory");
}
DI void rw_prompt_half(Frame& F, const Args& AR, int b, int h, int half, float* Sout) {
    const bf16* RK = (const bf16*)(F.ws + WS_RK); const bf16* WAG = (const bf16*)(F.ws + WS_WAG); bf16* G = (bf16*)(F.ws + WS_H); float* BN = (float*)(F.ws + WS_BN);
    LAS float* BUF = (LAS float*)F.lds;
    LAS float* YB = BUF + 2 * RW_BUF_FLOATS;
    const int tid = F.tid; const size_t row0 = (size_t)b * PSEQ;
    constexpr int nch = PSEQ / TC;
    if (tid < 256) {
        const int rl = tid >> 3, row = 32 * half + rl, p = tid & 7;
        float S[8];
#pragma unroll
        for (int j = 0; j < 8; ++j) S[j] = 0.f;
#ifdef PROBE_SHADOW
        float S2[8];
#pragma unroll
        for (int j = 0; j < 8; ++j) S2[j] = 1.f;
#endif
        BAR_LDS();
        for (int ch = 0; ch < nch; ++ch) {
            const LAS float* cur = BUF + (ch & 1) * RW_BUF_FLOATS; LAS float* yb = YB + (ch & 1) * (TC * 32);
            const unsigned cb = (unsigned)(size_t)cur; unsigned aq = cb + 32u * p, av = cb + 40960u + 4u * row, asc = cb + 49152u;
            StepV A, B; ld_step_asm(A, aq, av, asc); wait_step(A);
#pragma unroll 1
            for (int tk = 0; tk < TC; tk += 2) {
                ld_step_asm(B, aq + 256u, av + 256u, asc + 8u);
                rw_step(S, A, yb + tk * 32 + rl, p == 0);
#ifdef PROBE_SHADOW
                rw_step(S2, A, yb, false);
#endif
                wait_step1(B);
                aq += 512u; av += 512u; asc += 16u;
                const unsigned back = (tk + 2 < TC) ? 0u : 256u;
                ld_step_asm(A, aq - back, av - back, asc - (back >> 5));
                rw_step(S, B, yb + (tk + 1) * 32 + rl, p == 0);
#ifdef PROBE_SHADOW
                rw_step(S2, B, yb, false);
#endif
                wait_step1(A);
            }
            BAR_LDS();
        }
#ifdef PROBE_SHADOW
#pragma unroll
        for (int j = 0; j < 8; ++j) asm volatile("" :: "v"(S2[j]));
#endif
        *(f32x4*)(Sout + row * 64 + 8 * p) = (f32x4){S[0], S[1], S[2], S[3]}; *(f32x4*)(Sout + row * 64 + 8 * p + 4) = (f32x4){S[4], S[5], S[6], S[7]};
        BAR_LDS();
    } else {
        const int ht = tid - 256, tk0 = ht >> 4, k4 = (ht & 15) * 4;
        const int yt = ht >> 3, yv4 = (ht & 7) * 4;
        float kkw[4], kaw[4], rkw[4];
#pragma unroll
        for (int j = 0; j < 4; ++j) { const int c = h * 64 + k4 + j; kkw[j] = AR.in[I_KK][c]; kaw[j] = AR.in[I_KA][c]; rkw[j] = AR.in[I_RK][c]; }
        RwRaw raw[2];
#pragma unroll
        for (int i = 0; i < 2; ++i) { rw_load(raw[i], RK, WAG, row0 + tk0 + 16 * i, row0, h, k4, true);
            const float bn = rw_prep(raw[i], BUF, tk0 + 16 * i, k4, kkw, kaw, rkw); if (half == 0 && k4 == 0) BN[(row0 + tk0 + 16 * i) * 16 + h] = bn; }
#pragma unroll
        for (int i = 0; i < 2; ++i) rw_load(raw[i], RK, WAG, row0 + TC + tk0 + 16 * i, row0, h, k4, true);
        BAR_LDS();
        for (int ch = 0; ch < nch; ++ch) {
            const int base = ch * TC;
            if (ch > 0) { const f32x4 y4 = *(const LAS f32x4*)(YB + ((ch - 1) & 1) * (TC * 32) + yt * 32 + yv4);
                v2u w; w.x = pk2(y4.x, y4.y); w.y = pk2(y4.z, y4.w); *(v2u*)(G + (row0 + base - TC + yt) * D + h * 64 + 32 * half + yv4) = w; }
            if (ch + 1 < nch) {
#pragma unroll
                for (int i = 0; i < 2; ++i) { const float bn = rw_prep(raw[i], BUF + ((ch + 1) & 1) * RW_BUF_FLOATS, tk0 + 16 * i, k4, kkw, kaw, rkw);
                    if (half == 0 && k4 == 0) BN[(row0 + base + TC + tk0 + 16 * i) * 16 + h] = bn; }
#pragma unroll
                for (int i = 0; i < 2; ++i) rw_load(raw[i], RK, WAG, row0 + base + 2 * TC + tk0 + 16 * i, row0, h, k4, base + 2 * TC < PSEQ);
            }
            BAR_LDS();
        }
        { const f32x4 y4 = *(const LAS f32x4*)(YB + ((nch - 1) & 1) * (TC * 32) + yt * 32 + yv4);
            v2u w; w.x = pk2(y4.x, y4.y); w.y = pk2(y4.z, y4.w); *(v2u*)(G + (row0 + PSEQ - TC + yt) * D + h * 64 + 32 * half + yv4) = w; }
        BAR_LDS();
    }
}
DI void rw_gn_pass(Frame& F, const Args& AR) {
    const bf16* RK = (const bf16*)(F.ws + WS_RK); const bf16* WAG = (const bf16*)(F.ws + WS_WAG); bf16* G = (bf16*)(F.ws + WS_H); const float* BN = (const float*)(F.ws + WS_BN);
    const int gt = F.vcu * NTHREADS + F.tid, NT = F.G * NTHREADS;
    for (int e = gt; e < MP * 256; e += NT) { const int row = e >> 8, h = (e >> 4) & 15, k4 = (e & 15) * 4, c = h * 64 + k4;
        bf16* gp = G + (size_t)row * D + c; float y[4], v[4], g[4]; un4(*(const v2u*)gp, y); un4(*(const v2u*)(RK + (size_t)row * RKW + 2048 + c), v); un4(*(const v2u*)(WAG + (size_t)row * WAGW + 2048 + c), g);
        const f32x4 lg = *(const f32x4*)(AR.in[I_LXG] + c), lb = *(const f32x4*)(AR.in[I_LXB] + c); const float bn = BN[row * 16 + h];
        const float mean = sum16((y[0] + y[1]) + (y[2] + y[3])) * (1.f / 64.f);
        const float d0 = y[0] - mean, d1 = y[1] - mean, d2 = y[2] - mean, d3 = y[3] - mean;
        const float rstd = __builtin_amdgcn_rsqf(sum16((d0 * d0 + d1 * d1) + (d2 * d2 + d3 * d3)) * (1.f / 64.f) + RW_EPS);
        v2u w; w.x = pk2((d0 * rstd * lg.x + lb.x + bn * v[0]) * g[0], (d1 * rstd * lg.y + lb.y + bn * v[1]) * g[1]);
        w.y = pk2((d2 * rstd * lg.z + lb.z + bn * v[2]) * g[2], (d3 * rstd * lg.w + lb.w + bn * v[3]) * g[3]);
        *(v2u*)gp = w; }
}
constexpr int RS_WAVE_BYTES = 16640;
DI void ld8b(float (&f)[8], const bf16* p) { const v4u q = *(const v4u*)p; f[0] = bflo(q.x); f[1] = bfhi(q.x); f[2] = bflo(q.y); f[3] = bfhi(q.y); f[4] = bflo(q.z); f[5] = bfhi(q.z); f[6] = bflo(q.w); f[7] = bfhi(q.w); }
DI void st8(LAS float* p, const float (&f)[8]) { *(LAS f32x4*)p = (f32x4){f[0], f[1], f[2], f[3]}; *(LAS f32x4*)(p + 4) = (f32x4){f[4], f[5], f[6], f[7]}; }
DI void rw_sample_wave(Frame& F, const Args& AR, int item) {
    const bf16* RK = (const bf16*)(F.ws + WS_RK); const bf16* WAG = (const bf16*)(F.ws + WS_WAG); bf16* G = (bf16*)(F.ws + WS_H);
    const int lane = F.lane, b = item >> 4, h = item & 15; const size_t row0 = (size_t)MP + (size_t)b * SSEQ;
    LAS float* L = (LAS float*)(F.lds + F.wave * RS_WAVE_BYTES);
    { const int tok = lane >> 3, k8 = (lane & 7) * 8, c = h * 64 + k8;
        float r[8], k[8], v[8], w[8], a[8], g[8];
        { const bf16* p = RK + (row0 + tok) * RKW + c; const bf16* q = WAG + (row0 + tok) * WAGW + c; ld8b(r, p); ld8b(k, p + 1024); ld8b(v, p + 2048); ld8b(w, q); ld8b(a, q + 1024); ld8b(g, q + 2048); }
        float kkw[8], kaw[8], rkw[8]; ld8(kkw, AR.in[I_KK] + c); ld8(kaw, AR.in[I_KA] + c); ld8(rkw, AR.in[I_RK] + c);
        float kk[8], km[8], ss = 0.f, bs = 0.f;
#pragma unroll
        for (int j = 0; j < 8; ++j) { kk[j] = k[j] * kkw[j]; ss += kk[j] * kk[j]; km[j] = k[j] * (1.0f + (a[j] - 1.0f) * kaw[j]); bs += r[j] * km[j] * rkw[j]; }
        ss = sum8(ss); bs = sum8(bs);
        const float inv = 1.0f / fmaxf(sqrtf(ss), 1e-12f);
        float o1[8], o3[8], o4[8], br = 0.f, kr = 0.f;
#pragma unroll
        for (int j = 0; j < 8; ++j) { kk[j] *= inv; o1[j] = kk[j] * a[j]; o3[j] = __builtin_amdgcn_exp2f(w[j]); o4[j] = o3[j] * r[j]; br += o1[j] * r[j]; kr += km[j] * r[j]; }
        br = sum8(br); kr = sum8(kr);
        LAS float* p = L + tok * 64 + k8;
        st8(p, kk); st8(p + 512, o1); st8(p + 1024, km); st8(p + 1536, o3); st8(p + 2048, o4); st8(p + 2560, v); st8(p + 3072, g);
        if (k8 == 0) { L[3584 + 2 * tok] = br; L[3584 + 2 * tok + 1] = kr; L[3600 + tok] = bs; } }
    float S[64];
    { const float* sp = AR.in[I_SWKV] + (size_t)item * 4096 + lane * 64;
#pragma unroll
        for (int j = 0; j < 16; ++j) { const f32x4 q = *(const f32x4*)(sp + 4 * j); S[4 * j] = q.x; S[4 * j + 1] = q.y; S[4 * j + 2] = q.z; S[4 * j + 3] = q.w; } }
    LDS_WAIT(); asm volatile("" ::: "memory");
    LAS float* YS = L + 3616;
#pragma unroll 1
    for (int tk = 0; tk < SSEQ; ++tk) { const LAS float* q = L + tk * 64;
        float a0 = 0.f, a1 = 0.f, y0 = 0.f, y1 = 0.f;
#pragma unroll
        for (int c4 = 0; c4 < 16; ++c4) { const f32x4 kq = *(const LAS f32x4*)(q + 4 * c4), eq = *(const LAS f32x4*)(q + 2048 + 4 * c4);
            a0 = fmaf(S[4 * c4], kq.x, a0); a1 = fmaf(S[4 * c4 + 1], kq.y, a1); a0 = fmaf(S[4 * c4 + 2], kq.z, a0); a1 = fmaf(S[4 * c4 + 3], kq.w, a1);
            y0 = fmaf(S[4 * c4], eq.x, y0); y1 = fmaf(S[4 * c4 + 1], eq.y, y1); y0 = fmaf(S[4 * c4 + 2], eq.z, y0); y1 = fmaf(S[4 * c4 + 3], eq.w, y1); }
        const float sa = -(a0 + a1), v = q[2560 + lane]; const f32x2 sc = *(const LAS f32x2*)(L + 3584 + 2 * tk);
#pragma unroll
        for (int c4 = 0; c4 < 16; ++c4) { const f32x4 dq = *(const LAS f32x4*)(q + 1536 + 4 * c4), bq = *(const LAS f32x4*)(q + 512 + 4 * c4), mq = *(const LAS f32x4*)(q + 1024 + 4 * c4);
            S[4 * c4] = fmaf(bq.x, sa, fmaf(mq.x, v, S[4 * c4] * dq.x)); S[4 * c4 + 1] = fmaf(bq.y, sa, fmaf(mq.y, v, S[4 * c4 + 1] * dq.y));
            S[4 * c4 + 2] = fmaf(bq.z, sa, fmaf(mq.z, v, S[4 * c4 + 2] * dq.z)); S[4 * c4 + 3] = fmaf(bq.w, sa, fmaf(mq.w, v, S[4 * c4 + 3] * dq.w)); }
        YS[tk * 64 + lane] = fmaf(v, sc.y, fmaf(sa, sc.x, y0 + y1)); }
    { float* sp = F.out + O_SWKV + (size_t)item * 4096 + lane * 64;
#pragma unroll
        for (int j = 0; j < 16; ++j) *(f32x4*)(sp + 4 * j) = (f32x4){S[4 * j], S[4 * j + 1], S[4 * j + 2], S[4 * j + 3]}; }
    LDS_WAIT(); asm volatile("" ::: "memory");
    { const float lg = AR.in[I_LXG][h * 64 + lane], lb = AR.in[I_LXB][h * 64 + lane];
#pragma unroll 1
        for (int tk = 0; tk < SSEQ; ++tk) { const float y = YS[tk * 64 + lane];
            const float mean = wave_sum(y) * (1.f / 64.f), d = y - mean, rstd = __builtin_amdgcn_rsqf(wave_sum(d * d) * (1.f / 64.f) + RW_EPS);
            const float o = (d * rstd * lg + lb + L[3600 + tk] * L[2560 + tk * 64 + lane]) * L[3072 + tk * 64 + lane];
            G[(row0 + tk) * D + h * 64 + lane] = (bf16)f2bf(o); } }
    LDS_WAIT(); asm volatile("" ::: "memory");
}
#ifndef PROBE_RW
#define PROBE_RW 0
#endif
DI void rwkv_scan(Frame& F, const Args& AR) {
    for (int rep = 0; rep < (PROBE_RW == 1 ? 2 : 1); ++rep)
    for (int it = F.vcu; it < NPB * 16 * 2; it += F.G) { const int bh = it >> 1, b = bh >> 4, h = bh & 15;
        rw_prompt_half(F, AR, b, h, it & 1, F.out + O_PWKV + (size_t)bh * 4096); }
    __syncthreads();
    for (int rep = 0; rep < (PROBE_RW == 2 ? 2 : 1); ++rep)
    for (int item = F.vcu * NWAVES + F.wave; item < NSB * 16; item += F.G * NWAVES) rw_sample_wave(F, AR, item);
}

#ifndef MK_N_LAUNCHES
#define MK_N_LAUNCHES 1
#endif
#ifdef PROBE_DUP_PH
constexpr int NPHASES = 28;
#else
constexpr int NPHASES = 27;
#endif
enum { K_P0 = 0, K_MODX, K_UP, K_RESID, K_LN, K_WIN, K_MIXA, K_MIXB, K_MIXC, K_R1, K_R2, K_R3, K_MOD, K_R3B };

__global__ void __launch_bounds__(NTHREADS, 2) mega_fwd(Args AR) {
    extern __shared__ __attribute__((aligned(16))) unsigned char lds[];
    Frame F;
    F.lds = (LAS unsigned char*)lds;
    F.MISC = (volatile LAS unsigned*)(F.lds + MISC_OFF);
    F.tid = threadIdx.x; F.lane = F.tid & 63; F.wave = __builtin_amdgcn_readfirstlane(F.tid >> 6);
    F.G = gridDim.x; { const int bx = blockIdx.x; F.vcu = (F.G % 8 == 0) ? (bx % 8) * (F.G / 8) + bx / 8 : bx; }
    F.ws = AR.ws; F.out = AR.out; F.ctl = (gu32*)(AR.ws + WS_CTL);
    for (int u = F.tid; u < (LDS_BYTES - LDSCTL_OFF) / 4; u += NTHREADS) ((LAS unsigned*)(F.lds + LDSCTL_OFF))[u] = 0u;
    __syncthreads();
    const int lo = AR.ph_lo, hi = AR.ph_hi;
    XcdBarrier bar; bar.bar = (unsigned*)(F.ctl + CW_BAR); bar.x = 0; bar.st = nullptr;
    if (hi - lo > 1) bar = xcd_barrier_post((unsigned*)(F.ctl + CW_BAR), F.MISC + 8);

#ifndef PROBE_DUP_PH
#define PROBE_DUP_PH 1000
#endif
    for (int phs = lo; phs < hi; ++phs) {
        const int ph = phs > PROBE_DUP_PH ? phs - 1 : phs; const bool dupfirst = (phs == PROBE_DUP_PH);
        float* X = F.out + O_Y; const float* mod = (const float*)(F.ws + WS_MOD); bf16* H = (bf16*)(F.ws + WS_H);
        int kind = K_LN, f = 0, l = 0, sub = 0, js = 0, first = 0, mode = 0, lm = 0, which = 0, fin = 0;
        switch (ph == 0 ? 0 : (ph == 1 ? 100 : (ph <= 20 ? ph - 1 : (ph == 21 ? 101 : ph - 2)))) {
            case 0: kind = K_P0; break;
            case 100: kind = K_MOD; break;
            case 101: kind = K_R3B; break;
            case 1: kind = K_MODX; break;
            case 2: kind = K_UP; f = 0; break;
            case 3: kind = K_RESID; which = 0; f = 0; l = 0; js = 0; first = 1; break;
            case 4: kind = K_LN; l = 0; sub = 0; lm = 0; js = 3; mode = 0; break;
            case 5: kind = K_WIN; break;
            case 6: kind = K_MIXA; break;
            case 7: kind = K_MIXB; break;
            case 8: kind = K_MIXC; break;
            case 9: kind = K_RESID; which = 1; l = 0; js = 3; break;
            case 10: kind = K_LN; l = 0; sub = 1; lm = 0; js = 6; mode = 0; break;
            case 11: kind = K_UP; f = 1; break;
            case 12: kind = K_RESID; which = 0; f = 1; l = 0; js = 6; break;
            case 13: kind = K_LN; l = 0; sub = 2; lm = 1; js = 0; mode = 0; break;
            case 14: kind = K_UP; f = 2; break;
            case 15: kind = K_RESID; which = 0; f = 2; l = 1; js = 0; break;
            case 16: kind = K_LN; l = 1; sub = 0; lm = 1; js = 3; mode = 1; break;
            case 17: kind = K_R1; break;
            case 18: kind = K_R2; break;
            case 19: kind = K_R3; break;
            case 20: kind = K_RESID; which = 2; l = 1; js = 3; break;
            case 21: kind = K_LN; l = 1; sub = 1; lm = 1; js = 6; mode = 0; break;
            case 22: kind = K_UP; f = 3; break;
            case 23: kind = K_RESID; which = 0; f = 3; l = 1; js = 6; fin = 1; break;
            default: kind = K_LN; l = 1; sub = 2; lm = 1; js = 0; mode = 2; fin = 1; break;
        }
#ifndef PHMASK
#define PHMASK 0xFFFFF
#endif
        { int t_ = F.tid; asm volatile("" : "+v"(t_)); F.tid = t_; F.lane = t_ & 63; F.wave = __builtin_amdgcn_readfirstlane(t_ >> 6);

          int v_ = F.vcu; asm volatile("" : "+s"(v_)); F.vcu = v_; int g_ = F.G; asm volatile("" : "+s"(g_)); F.G = g_;
          unsigned l_ = (unsigned)(size_t)F.lds; asm volatile("" : "+s"(l_)); F.lds = (LAS unsigned char*)(size_t)l_; }
        switch (kind) {
            case K_P0: p0_sctab(F, AR); p0_weights(F, AR); break;
            case K_MOD: p0_mod(F, AR); break;
            case K_MODX: if ((PHMASK >> K_MODX) & 1) ln_pass(F, AR, 1, 0, 0, 0, 0, 0, 0, 0, 0, 0); break;
            case K_UP: if ((PHMASK >> K_UP) & 1) {
                pg8::Gemm g{H, (const bf16*)(F.ws + WS_W13) + (size_t)f * 5632 * 1024, M, 5632, 1024}; pg8::StaticOrder S; S.init(M, 5632, F.G, (int)blockIdx.x); S.ntk = 16;
                pg8::EpiSwiglu E{(bf16*)(F.ws + WS_HID), FF};
                pg8::gemm_phase<pg8::EpiSwiglu, pg8::StaticOrder, true, true>(F.lds, g, S, E, F.tid);
            } break;
            case K_RESID: if ((PHMASK >> K_RESID) & 1) {
                const bf16* A = which == 0 ? (const bf16*)(F.ws + WS_HID) : H; const int K = which == 0 ? FF : 1024;
                const bf16* Bt = which == 0 ? (const bf16*)(F.ws + WS_W2) + (size_t)f * 1024 * FF : (which == 1 ? (const bf16*)(F.ws + WS_WOUT) : (const bf16*)(F.ws + WS_WO));
                const int nsp = (F.G == 256) ? (which == 0 ? 11 : 4) : 0;
                pg8::Gemm g{A, Bt, M, 1024, K}; SplitOrder S; S.base.init(nsp ? MP : M, 1024, F.G, (int)blockIdx.x); S.base.ntk = K / 64; S.S = nsp;
                EpiResid E{AR, F.out, F.ws, (first ? 1 : 0) | (l << 1) | ((js + 2) << 2) | (which == 0 ? 0 : 64) | (dupfirst ? 128 : 0) | (fin ? 256 : 0)};
                pg8::gemm_phase<EpiResid, SplitOrder, true, true>(F.lds, g, S, E, F.tid);
                if (fin && nsp) {
                    const v4u* src = (const v4u*)((unsigned char*)F.out + XB_OFF + (size_t)MP * 2048); v4u* dst = (v4u*)(F.ws + WS_ZF + (size_t)MP * 2048);
                    for (int e = F.vcu * NTHREADS + F.tid; e < MS * 128; e += F.G * NTHREADS) dst[e] = src[e]; }
            } break;
            case K_LN: if ((PHMASK >> K_LN) & 1) ln_pass(F, AR, 0, 1, l, sub, lm, js, mode, (F.G == 256) ? (sub == 1 ? 4 : 11) : 0, ph == 5, fin); break;
            case K_WIN: if ((PHMASK >> K_WIN) & 1) {
                pg8::Gemm g{H, (const bf16*)(F.ws + WS_WIN), M, ZW, 1024}; pg8::StaticOrder S; S.init(M, ZW, F.G, (int)blockIdx.x); S.ntk = 16;
                pg8::EpiStore E{(bf16*)(F.ws + WS_Z), ZW, 1000, nullptr, 0};
                pg8::gemm_phase<pg8::EpiStore, pg8::StaticOrder, true, true>(F.lds, g, S, E, F.tid);
            } break;
            case K_R1: if ((PHMASK >> K_R1) & 1) {
                pg8::Gemm g{(const bf16*)(F.ws + WS_A2), (const bf16*)(F.ws + WS_WRK), M, 3328, 2048}; pg8::StaticOrder S; S.init(M, 3328, F.G, (int)blockIdx.x); S.ntk = 32;
                pg8::EpiStore E{(bf16*)(F.ws + WS_RK), RKW, 12, (bf16*)(F.ws + WS_A3), 256};
                pg8::gemm_phase<pg8::EpiStore, pg8::StaticOrder, true, true>(F.lds, g, S, E, F.tid);
            } break;
            case K_R2: if ((PHMASK >> K_R2) & 1) {
                pg8::Gemm g{(const bf16*)(F.ws + WS_A3), (const bf16*)(F.ws + WS_WL2), M, 3072, 256}; pg8::StaticOrder S; S.init(M, 3072, F.G, (int)blockIdx.x); S.ntk = 4;
                pg8::EpiLora2 E{(bf16*)(F.ws + WS_WAG), WAGW, AR.in[I_W0], AR.in[I_A0]};
                pg8::gemm_phase<pg8::EpiLora2, pg8::StaticOrder, true, true>(F.lds, g, S, E, F.tid);
            } break;
            case K_MIXA: if ((PHMASK >> K_MIXA) & 1) ml1_prompt(F, AR); __syncthreads(); if ((PHMASK >> 13) & 1) ml_sample(F, AR); __syncthreads(); if ((PHMASK >> 14) & 1) rg1(F, AR); break;
            case K_MIXB: if ((PHMASK >> K_MIXB) & 1) ml2_scan(F, AR); if ((PHMASK >> 15) & 1) rg2_carry(F, AR); break;
            case K_MIXC: if ((PHMASK >> K_MIXC) & 1) ml3_prompt(F, AR); __syncthreads(); if ((PHMASK >> 16) & 1) rg2_apply(F, AR); break;
            case K_R3: if ((PHMASK >> K_R3) & 1) rwkv_scan(F, AR); break;
            case K_R3B: rw_gn_pass(F, AR); break;
        }
        if (phs + 1 < hi) xcd_barrier(bar);
    }
}

extern "C" void kernel_launch(void* const* d_in, const int* in_sizes, int n_in, void* d_out, int out_size, void* d_ws, size_t ws_size, hipStream_t stream) {
    static int grid = 0;
    if (grid == 0) {
        if (n_in != 47 || out_size != (int)O_END || ws_size < WS_END) { fprintf(stderr, "kernel_launch: unexpected sizes n_in %d out %d ws %zu\n", n_in, out_size, ws_size); grid = -1; return; }
        int dev = 0, cus = 0, per_cu = 0;
        if (hipGetDevice(&dev) != hipSuccess || hipDeviceGetAttribute(&cus, hipDeviceAttributeMultiprocessorCount, dev) != hipSuccess) { grid = -1; return; }
        if (hipFuncSetAttribute((const void*)mega_fwd, hipFuncAttributeMaxDynamicSharedMemorySize, LDS_BYTES) != hipSuccess) { fprintf(stderr, "kernel_launch: hipFuncSetAttribute failed\n"); grid = -1; return; }
        if (hipOccupancyMaxActiveBlocksPerMultiprocessor(&per_cu, (const void*)mega_fwd, NTHREADS, LDS_BYTES) != hipSuccess || per_cu < 1) { fprintf(stderr, "kernel_launch: occupancy query says %d blocks per CU\n", per_cu); (void)hipGetLastError(); grid = -1; return; }
        grid = cus;
    }
    if (grid < 0) return;
    (void)hipMemsetAsync((char*)d_ws + WS_CTL, 0, CTL_ZERO_BYTES, stream);
    Args a{};
    for (int i = 0; i < 47; ++i) a.in[i] = (const float*)d_in[i];
    a.out = (float*)d_out; a.ws = (unsigned char*)d_ws;
#if MK_N_LAUNCHES == 1
    a.ph_lo = 0; a.ph_hi = NPHASES;
    hipLaunchKernelGGL(mega_fwd, dim3(grid), dim3(NTHREADS), LDS_BYTES, stream, a);
#else
    for (int p = 0; p < NPHASES; ++p) { a.ph_lo = p; a.ph_hi = p + 1; hipLaunchKernelGGL(mega_fwd, dim3(grid), dim3(NTHREADS), LDS_BYTES, stream, a); }
#endif
}
```

```cpp
#include <hip/hip_runtime.h>
#include <cstdio>
#include <cstdint>
#include <cmath>
namespace pg8 {
#define PG8_LAS __attribute__((address_space(3)))
typedef unsigned short bf16_t;
typedef short bf16x8 __attribute__((ext_vector_type(8)));
typedef float f32x4 __attribute__((ext_vector_type(4)));
typedef unsigned u32x4 __attribute__((ext_vector_type(4)));
constexpr int BM = 256, BK = 64, HALF = 128, HTB = HALF * BK * 2  , STAGE_BYTES = 8 * HTB, NXCD = 8, WGM = 8;

__host__ __device__ __forceinline__ int lds_byte(int r, int c) { const int st = (r >> 4) * 2 + (c >> 5), rr = r & 15, cc = c & 31, ob = rr * 64 + cc * 2; return st * 1024 + (ob ^ (((ob >> 9) & 1) << 5)); }
__host__ __device__ __forceinline__ void stage_rc(int b, int& R, int& C) { const int st = b / 1024, sb = b % 1024, swz = sb ^ (((sb >> 9) & 1) << 5); R = (st >> 1) * 16 + swz / 64; C = (st & 1) * 32 + (swz % 64) / 2; }
__host__ __device__ __forceinline__ int perm32(int rho) { const int n = rho >> 4, i = rho & 15; return 8 * (i >> 2) + 4 * n + (i & 3); }

struct Unit { int pm, pn, k0, nt, sub; };
struct Gemm { const bf16_t* A; const bf16_t* Bt; int M, N, K; };

struct StaticOrder {
    int nM, nN, nwg, G, c, ntk;
    __host__ __device__ void init(int M, int N, int G_, int c_) { nM = M / BM; nN = N / BM; nwg = nM * nN; G = G_; c = c_; }
    __host__ __device__ bool next(int i, Unit& u) const {
        const long L = (long)i * G + c; if (L >= nwg) return false;
        int wgid = (int)L; { const int q = nwg / NXCD, r = nwg % NXCD, xcd = wgid % NXCD, off = wgid / NXCD; wgid = (xcd < r ? xcd * (q + 1) : r * (q + 1) + (xcd - r) * q) + off; }
        const int nig = WGM * nN, gid = wgid / nig, fm = gid * WGM, gsz = (nM - fm) < WGM ? (nM - fm) : WGM;
        u.pm = fm + ((wgid % nig) % gsz); u.pn = (wgid % nig) / gsz; u.k0 = 0; u.nt = ntk; u.sub = 0; return true;
    }
    __device__ __forceinline__ void a_ready(const Unit&) const {}
    __device__ __forceinline__ void done(const Unit&) const {}
};

__device__ __forceinline__ unsigned cvt_pk_bf16(float lo, float hi) { unsigned r; asm volatile("v_cvt_pk_bf16_f32 %0, %1, %2" : "=v"(r) : "v"(lo), "v"(hi)); return r; }
typedef float f32x2 __attribute__((ext_vector_type(2)));
constexpr int MPROWS = 16384;
__device__ __forceinline__ int mod_row(int r) { return r < MPROWS ? (r >> 11) : 8 + ((r - MPROWS) >> 3); }
__device__ __forceinline__ float fsig(float x) { return __builtin_amdgcn_rcpf(1.0f + __builtin_amdgcn_exp2f(-1.44269504f * x)); }
__device__ __forceinline__ float ftanh(float x) { return 1.0f - 2.0f * __builtin_amdgcn_rcpf(1.0f + __builtin_amdgcn_exp2f(2.88539008f * x)); }

struct EpiSwiglu {
    static constexpr bool PERM = true, AFTER_DRAIN = false;
    bf16_t* O; int ldc;
    __device__ __forceinline__ void operator()(const f32x4 (&acc)[2][2][4][2], const Unit& u, int wr, int wc, int fr, int fq) const {
        const int row0 = u.pm * BM + wr * 64 + fr, col0 = u.pn * HALF + wc * 32 + 8 * fq;
#pragma unroll
        for (int ai = 0; ai < 2; ++ai)
#pragma unroll
            for (int m = 0; m < 4; ++m) { bf16_t* rowp = O + (size_t)(row0 + ai * HALF + m * 16) * ldc + col0;
                const f32x4 a0 = acc[ai][0][m][0], a1 = acc[ai][0][m][1], b0 = acc[ai][1][m][0], b1 = acc[ai][1][m][1];
                f32x4 v0, v1;
#pragma unroll
                for (int j = 0; j < 4; ++j) { v0[j] = a0[j] * fsig(a0[j]) * b0[j]; v1[j] = a1[j] * fsig(a1[j]) * b1[j]; }
                u32x4 w; w.x = cvt_pk_bf16(v0[0], v0[1]); w.y = cvt_pk_bf16(v0[2], v0[3]); w.z = cvt_pk_bf16(v1[0], v1[1]); w.w = cvt_pk_bf16(v1[2], v1[3]);
                *(u32x4*)rowp = w; asm volatile("" ::: "memory"); }
    }
};
struct EpiStore {
    static constexpr bool PERM = true, AFTER_DRAIN = false;
    bf16_t* O; int ldc; int ntile_main; bf16_t* O2; int ldc2;
    __device__ __forceinline__ void operator()(const f32x4 (&acc)[2][2][4][2], const Unit& u, int wr, int wc, int fr, int fq) const {
        const int row0 = u.pm * BM + wr * 64 + fr;
        const bool main = u.pn < ntile_main;
        bf16_t* base = main ? O + (size_t)u.pn * BM : O2; const int ld = main ? ldc : ldc2;
        const int col0 = wc * 32 + 8 * fq;
#pragma unroll
        for (int ai = 0; ai < 2; ++ai)
#pragma unroll
            for (int m = 0; m < 4; ++m) { bf16_t* rowp = base + (size_t)(row0 + ai * HALF + m * 16) * ld + col0;
#pragma unroll
                for (int bj = 0; bj < 2; ++bj) { f32x4 v0 = acc[ai][bj][m][0], v1 = acc[ai][bj][m][1];
                    if (!main) {
                        if (bj == 1) {
#pragma unroll
                            for (int j = 0; j < 4; ++j) { v0[j] = fsig(v0[j]); v1[j] = fsig(v1[j]); }
                        } else if (wc < 2) {
#pragma unroll
                            for (int j = 0; j < 4; ++j) { v0[j] = ftanh(v0[j]); v1[j] = ftanh(v1[j]); }
                        }
                    }
                    u32x4 w; w.x = cvt_pk_bf16(v0[0], v0[1]); w.y = cvt_pk_bf16(v0[2], v0[3]); w.z = cvt_pk_bf16(v1[0], v1[1]); w.w = cvt_pk_bf16(v1[2], v1[3]);
                    *(u32x4*)(rowp + bj * HALF) = w; asm volatile("" ::: "memory"); } }
    }
};
struct EpiLora2 {
    static constexpr bool PERM = true, AFTER_DRAIN = false;
    bf16_t* O; int ldc; const float* w0; const float* a0;
    __device__ __forceinline__ void operator()(const f32x4 (&acc)[2][2][4][2], const Unit& u, int wr, int wc, int fr, int fq) const {
        const int row0 = u.pm * BM + wr * 64 + fr, col0 = u.pn * BM + wc * 32 + 8 * fq, kind = u.pn >> 2;
        const float* bp = (kind == 0 ? w0 : a0) + (col0 & 1023); const float bsc = kind == 2 ? 0.f : 1.f, mul = kind == 0 ? -0.87504229f : 1.0f;
#pragma unroll
        for (int bj = 0; bj < 2; ++bj)
#pragma unroll
            for (int ai = 0; ai < 2; ++ai)
#pragma unroll
                for (int m = 0; m < 4; ++m) { bf16_t* rowp = O + (size_t)(row0 + ai * HALF + m * 16) * ldc + col0;
                    f32x4 v0 = acc[ai][bj][m][0] + *(const f32x4*)(bp + bj * HALF) * bsc, v1 = acc[ai][bj][m][1] + *(const f32x4*)(bp + bj * HALF + 4) * bsc;
                    if (kind != 2) {
#pragma unroll
                        for (int j = 0; j < 4; ++j) { v0[j] = mul * fsig(v0[j]); v1[j] = mul * fsig(v1[j]); }
                    }
                    u32x4 w; w.x = cvt_pk_bf16(v0[0], v0[1]); w.y = cvt_pk_bf16(v0[2], v0[3]); w.z = cvt_pk_bf16(v1[0], v1[1]); w.w = cvt_pk_bf16(v1[2], v1[3]);
                    *(u32x4*)(rowp + bj * HALF) = w; asm volatile("" ::: "memory"); }
    }
};

template <class Epi, class Sched, bool ALIGN_EPI = false, bool SP2 = false>
__device__ __forceinline__ void gemm_phase(PG8_LAS unsigned char* lds, const Gemm g, const Sched& S, const Epi& E, int tid_in) {
    int tid_ = tid_in; asm volatile("" : "+v"(tid_));
    const int tid = tid_, wid = __builtin_amdgcn_readfirstlane(tid >> 6), lane = tid & 63, wr = wid >> 2, wc = wid & 3, fr = lane & 15, fq = lane >> 4;
    int K_ = g.K; asm volatile("" : "+s"(K_));
    const int K = K_;
    unsigned voffA[2], voffB[2];
#pragma unroll
    for (int i = 0; i < 2; ++i) { int R, C; stage_rc(tid * 16 + i * 8192, R, C); const int Rb = Epi::PERM ? ((R & ~31) + perm32(R & 31)) : R;
        voffA[i] = (unsigned)(R * K + C) * 2u; voffB[i] = (unsigned)(Rb * K + C) * 2u; }
    const size_t kstep = (size_t)(BK * 2);
    const size_t hstep = (size_t)HALF * K * 2;
    const size_t tstep = 2 * hstep;
    const unsigned ldsw = (unsigned)wid * 1024u;
    const int aoff = lds_byte(wr * 64 + fr, fq * 8), boff = lds_byte(wc * 32 + fr, fq * 8);
#define PG8_SA(b, h) (((b) * 2 + (h)) * HTB)
#define PG8_SB(b, h) ((4 + (b) * 2 + (h)) * HTB)
#define PG8_STAGE(bufoff, gbase, voff) do { _Pragma("unroll") for (int _i = 0; _i < 2; ++_i) \
        __builtin_amdgcn_global_load_lds((const unsigned*)((const char*)(gbase) + (voff)[_i]), (PG8_LAS unsigned*)(lds + (bufoff) + ldsw + _i * 8192), 16, 0, 0); } while (0)
#define PG8_LDA(dst, b, h) do { _Pragma("unroll") for (int m = 0; m < 4; ++m) _Pragma("unroll") for (int k = 0; k < 2; ++k) dst[m][k] = *(const PG8_LAS bf16x8*)(lds + PG8_SA(b, h) + aoff + m * 2048 + k * 1024); } while (0)
#define PG8_LDB(dst, b, h) do { _Pragma("unroll") for (int n = 0; n < 2; ++n) _Pragma("unroll") for (int k = 0; k < 2; ++k) dst[n][k] = *(const PG8_LAS bf16x8*)(lds + PG8_SB(b, h) + boff + n * 2048 + k * 1024); } while (0)
#define PG8_MMA(ai, bj, At, Bt) do { __builtin_amdgcn_s_setprio(1); _Pragma("unroll") for (int m = 0; m < 4; ++m) _Pragma("unroll") for (int n = 0; n < 2; ++n) _Pragma("unroll") for (int k = 0; k < 2; ++k) \
        acc[ai][bj][m][n] = __builtin_amdgcn_mfma_f32_16x16x32_bf16(Bt[n][k], At[m][k], acc[ai][bj][m][n], 0, 0, 0); __builtin_amdgcn_s_setprio(0); } while (0)
#define PG8_WAIT_V(n) asm volatile("s_waitcnt vmcnt(" #n ")" ::: "memory")
#define PG8_WAIT_L(n) asm volatile("s_waitcnt lgkmcnt(" #n ")" ::: "memory")
#define PG8_BAR __builtin_amdgcn_s_barrier()
#define PG8_SCHED __builtin_amdgcn_sched_barrier(0)
    Unit cur, nxt; int ui = 0;
    if (!S.next(0, cur)) return;
    f32x4 acc[2][2][4][2];
#pragma unroll
    for (int a = 0; a < 2; ++a)
#pragma unroll
        for (int b = 0; b < 2; ++b)
#pragma unroll
            for (int m = 0; m < 4; ++m)
#pragma unroll
                for (int n = 0; n < 2; ++n) acc[a][b][m][n] = (f32x4){0.f, 0.f, 0.f, 0.f};
    bf16x8 At[4][2], B0[2][2], B1[2][2];
    const char* cA = (const char*)g.A + (size_t)cur.pm * tstep + (size_t)cur.k0 * 2; const char* cB = (const char*)g.Bt + (size_t)cur.pn * tstep + (size_t)cur.k0 * 2;
    S.a_ready(cur);
    if constexpr (SP2) {
        PG8_STAGE(PG8_SB(0, 0), cB, voffB); PG8_STAGE(PG8_SB(0, 1), cB + hstep, voffB); PG8_STAGE(PG8_SA(0, 0), cA, voffA); PG8_STAGE(PG8_SA(0, 1), cA + hstep, voffA);
        if (wr == 1) PG8_BAR;
        PG8_WAIT_V(2); PG8_BAR;
        PG8_STAGE(PG8_SB(1, 0), cB + kstep, voffB); PG8_STAGE(PG8_SA(1, 0), cA + kstep, voffA); PG8_STAGE(PG8_SB(1, 1), cB + hstep + kstep, voffB);
        PG8_WAIT_V(6); PG8_BAR;
    } else {
        PG8_STAGE(PG8_SB(0, 0), cB, voffB); PG8_STAGE(PG8_SA(0, 0), cA, voffA); PG8_STAGE(PG8_SB(0, 1), cB + hstep, voffB); PG8_STAGE(PG8_SA(0, 1), cA + hstep, voffA);
        if (wr == 1) PG8_BAR;
        PG8_WAIT_V(4); PG8_BAR;
        PG8_STAGE(PG8_SB(1, 0), cB + kstep, voffB); PG8_STAGE(PG8_SA(1, 0), cA + kstep, voffA); PG8_STAGE(PG8_SB(1, 1), cB + hstep + kstep, voffB);
        PG8_WAIT_V(6); PG8_BAR;
    }
    for (;;) {
        const bool has_next = S.next(ui + 1, nxt);
        const char* nA = has_next ? (const char*)g.A + (size_t)nxt.pm * tstep + (size_t)nxt.k0 * 2 : cA; const char* nB = has_next ? (const char*)g.Bt + (size_t)nxt.pn * tstep + (size_t)nxt.k0 * 2 : cB;
        const int nt = cur.nt;
        for (int t = 0; t < nt; t += 2) {
            const bool last = (t == nt - 2);
            const char* a1 = cA + (size_t)(t + 1) * kstep;
            const char* a2 = last ? nA : cA + (size_t)(t + 2) * kstep; const char* b2 = last ? nB : cB + (size_t)(t + 2) * kstep;
            const char* a3 = a2 + kstep; const char* b3 = b2 + kstep;
            if (last && has_next) S.a_ready(nxt);
            if constexpr (SP2) {
            PG8_LDB(B0, 0, 0); PG8_LDB(B1, 0, 1); PG8_SCHED; PG8_LDA(At, 0, 0); PG8_STAGE(PG8_SA(1, 1), a1 + hstep, voffA);
            PG8_WAIT_V(8); PG8_WAIT_L(0); PG8_BAR; PG8_MMA(0, 0, At, B0); PG8_MMA(0, 1, At, B1); PG8_BAR; PG8_SCHED;
            PG8_LDA(At, 0, 1); PG8_STAGE(PG8_SB(0, 0), b2, voffB); PG8_STAGE(PG8_SB(0, 1), b2 + hstep, voffB); PG8_STAGE(PG8_SA(0, 0), a2, voffA);
            PG8_WAIT_V(8); PG8_WAIT_L(0); PG8_BAR; PG8_MMA(1, 0, At, B0); PG8_MMA(1, 1, At, B1); PG8_BAR; PG8_SCHED;
            PG8_LDB(B0, 1, 0); PG8_LDB(B1, 1, 1); PG8_SCHED; PG8_LDA(At, 1, 0); PG8_STAGE(PG8_SA(0, 1), a2 + hstep, voffA);
            PG8_WAIT_V(8); PG8_WAIT_L(0); PG8_BAR; PG8_MMA(0, 0, At, B0); PG8_MMA(0, 1, At, B1); PG8_BAR; PG8_SCHED;
            PG8_LDA(At, 1, 1); PG8_STAGE(PG8_SB(1, 0), b3, voffB); PG8_STAGE(PG8_SB(1, 1), b3 + hstep, voffB); PG8_STAGE(PG8_SA(1, 0), a3, voffA);
            PG8_WAIT_V(8); PG8_WAIT_L(0); PG8_BAR; PG8_MMA(1, 0, At, B0); PG8_MMA(1, 1, At, B1); PG8_BAR; PG8_SCHED;
            } else {
            PG8_LDB(B0, 0, 0); PG8_SCHED; PG8_LDA(At, 0, 0); PG8_STAGE(PG8_SA(1, 1), a1 + hstep, voffA);
            PG8_WAIT_L(8); PG8_BAR; PG8_WAIT_L(0); PG8_MMA(0, 0, At, B0); PG8_BAR; PG8_SCHED;
            PG8_LDB(B1, 0, 1); PG8_STAGE(PG8_SB(0, 0), b2, voffB);
            PG8_BAR; PG8_WAIT_L(0); PG8_MMA(0, 1, At, B1); PG8_BAR;
            PG8_LDA(At, 0, 1); PG8_STAGE(PG8_SA(0, 0), a2, voffA);
            PG8_BAR; PG8_WAIT_L(0); PG8_MMA(1, 0, At, B0); PG8_BAR; PG8_SCHED;
            PG8_STAGE(PG8_SB(0, 1), b2 + hstep, voffB);
            PG8_WAIT_V(6); PG8_BAR; PG8_MMA(1, 1, At, B1); PG8_BAR;
            PG8_LDB(B0, 1, 0); PG8_SCHED; PG8_LDA(At, 1, 0); PG8_STAGE(PG8_SA(0, 1), a2 + hstep, voffA);
            PG8_WAIT_L(8); PG8_BAR; PG8_WAIT_L(0); PG8_MMA(0, 0, At, B0); PG8_BAR; PG8_SCHED;
            PG8_LDB(B1, 1, 1); PG8_STAGE(PG8_SB(1, 0), b3, voffB);
            PG8_BAR; PG8_WAIT_L(0); PG8_MMA(0, 1, At, B1); PG8_BAR;
            PG8_LDA(At, 1, 1); PG8_STAGE(PG8_SA(1, 0), a3, voffA);
            PG8_BAR; PG8_WAIT_L(0); PG8_MMA(1, 0, At, B0); PG8_BAR; PG8_SCHED;
            PG8_STAGE(PG8_SB(1, 1), b3 + hstep, voffB);
            PG8_WAIT_V(6); PG8_BAR; PG8_MMA(1, 1, At, B1); PG8_BAR;
            }
        }
        if constexpr (ALIGN_EPI) { if (wr == 0) PG8_BAR; }
        if constexpr (!Epi::AFTER_DRAIN) { E(acc, cur, wr, wc, fr, fq); S.done(cur); }
        if (!has_next) break;
#pragma unroll
        for (int a = 0; a < 2; ++a)
#pragma unroll
            for (int b = 0; b < 2; ++b)
#pragma unroll
                for (int m = 0; m < 4; ++m)
#pragma unroll
                    for (int n = 0; n < 2; ++n) acc[a][b][m][n] = (f32x4){0.f, 0.f, 0.f, 0.f};
        cur = nxt; cA = nA; cB = nB; ++ui;
        if constexpr (ALIGN_EPI) { if (wr == 1) PG8_BAR; }
    }
    PG8_WAIT_V(0);
    if constexpr (!ALIGN_EPI) { if (wr == 0) PG8_BAR; }
    PG8_BAR;
    if constexpr (Epi::AFTER_DRAIN) { E.fused(acc, cur, wr, wc, fr, fq, lds, wid, lane); S.done(cur); }
#undef PG8_SA
#undef PG8_SB
#undef PG8_STAGE
#undef PG8_LDA
#undef PG8_LDB
#undef PG8_MMA
#undef PG8_WAIT_V
#undef PG8_WAIT_L
#undef PG8_BAR
#undef PG8_SCHED
}
}
constexpr int NWAVES = 8, NTHREADS = 512;
constexpr int D = 1024, MP = 16384, MS = 1024, M = MP + MS, NSEQ = 136, FF = 2816;
constexpr int PSEQ = 2048, SSEQ = 8, NPB = 8, NSB = 128;
constexpr int ZW = 3328;
constexpr int ZQ = 0, ZK = 512, ZV = 1024, ZO = 1536, ZXR = 2048, ZGR = 2560, ZIG = 3072, ZFG = 3076;
constexpr int RKW = 3072, WAGW = 3072;
constexpr float ALPHA = 1.41421356237f;
constexpr float LN_EPS = 1e-5f, HEAD_EPS = 1e-6f, RW_EPS = 64e-5f;
constexpr float MSCALE = 0.08838834764831845f;

constexpr size_t O_Y = 0, O_PMC = 17825792, O_PMN = 18350080, O_PMM = 18354176, O_PRH = 18354208, O_PRC = 18358304, O_PWKV = 18370592, O_PSH = 18894880,
                 O_SMC = 18903072, O_SMN = 27291680, O_SMM = 27357216, O_SRH = 27357728, O_SRC = 27423264, O_SWKV = 27619872, O_SSH = 36008480, O_END = 36139552;

constexpr size_t MiB = 1u << 20;
constexpr size_t WS_CTL = 0, CTL_ZERO_BYTES = 1 * MiB;
constexpr size_t WS_W13 = 1 * MiB;
constexpr size_t WS_W2 = 45 * MiB;
constexpr size_t WS_WIN = 67 * MiB;
constexpr size_t WS_WOUT = WS_WIN + 6815744;
constexpr size_t WS_WRK = WS_WOUT + 2 * MiB;
constexpr size_t WS_WL2 = WS_WRK + 13 * MiB;
constexpr size_t WS_WO = WS_WL2 + 1572864;
constexpr size_t WS_MOD = 92 * MiB;
constexpr size_t WS_SC = 101 * MiB + 640 * 1024;
constexpr size_t WS_H = 102 * MiB;
constexpr size_t WS_BIG = 136 * MiB;
constexpr size_t WS_HID = WS_BIG;
constexpr size_t WS_Z = WS_BIG;
constexpr size_t WS_CST = WS_BIG + 111 * MiB;
constexpr size_t WS_SLAB = WS_BIG + 180 * MiB;
constexpr size_t WS_RGH = WS_BIG + 143 * MiB;
constexpr size_t WS_RGP = WS_BIG + 175 * MiB;
constexpr size_t WS_NST = WS_BIG + 207 * MiB;
constexpr size_t WS_MST = WS_NST + 262144;
constexpr size_t WS_CARRY = WS_MST + 8192;
constexpr size_t WS_RK = WS_BIG;
constexpr size_t WS_A3 = WS_BIG + 102 * MiB;
constexpr size_t WS_A2 = WS_BIG + 111 * MiB;
constexpr size_t WS_WAG = WS_BIG + 111 * MiB;
constexpr size_t WS_END = WS_BIG + 224 * MiB;
static_assert(WS_WO + 2 * MiB <= WS_MOD && WS_MOD + (size_t)2 * 136 * 9216 * 4 <= WS_SC && WS_SC + 160 * 1024 * 2 <= WS_H && WS_H + (size_t)M * D * 2 <= WS_BIG, "ws map");
static_assert(WS_SLAB + (size_t)11 * 4 * MiB <= WS_END && WS_A2 + (size_t)M * 2048 * 2 <= WS_SLAB && WS_CARRY + 8 * 64 * 512 * 4 <= WS_END && WS_WAG + (size_t)M * WAGW * 2 <= WS_END && WS_A3 + (size_t)M * 256 * 2 <= WS_A2, "ws map 2");
constexpr size_t WS_BN = WS_BIG + 213 * MiB;
constexpr size_t XB_OFF = (size_t)M * 1024 * 2;
constexpr size_t WS_ZF = WS_BIG + 111 * MiB;
constexpr int CW_BAR = 4096;

constexpr int LDS_BYTES = 147456;
constexpr int LDSCTL_OFF = LDS_BYTES - 512;
constexpr int MISC_OFF = LDSCTL_OFF;

#define GAS __attribute__((address_space(1)))
#define LAS __attribute__((address_space(3)))
typedef unsigned short bf16;
typedef unsigned v4u __attribute__((ext_vector_type(4)));
typedef unsigned v2u __attribute__((ext_vector_type(2)));
typedef float f32x4 __attribute__((ext_vector_type(4)));
typedef float f32x2 __attribute__((ext_vector_type(2)));
typedef float f32x16 __attribute__((ext_vector_type(16)));
typedef short bf16x8 __attribute__((ext_vector_type(8)));
typedef GAS unsigned gu32;
#define RLX_AGENT __ATOMIC_RELAXED, __HIP_MEMORY_SCOPE_AGENT
#define LDS_WAIT() asm volatile("s_waitcnt lgkmcnt(0)" ::: "memory")
#define DI __device__ __forceinline__
#define MFMA32(a, b, c) __builtin_amdgcn_mfma_f32_32x32x16_bf16((a), (b), (c), 0, 0, 0)
DI unsigned f2bf(float f) { unsigned u = __builtin_bit_cast(unsigned, f); return (u + 0x7fffu + ((u >> 16) & 1u)) >> 16; }
DI unsigned pk2(float lo, float hi) { return pg8::cvt_pk_bf16(lo, hi); }
DI float bf2f(unsigned b) { return __builtin_bit_cast(float, b << 16); }
DI float bflo(unsigned w) { return __builtin_bit_cast(float, w << 16); }
DI float bfhi(unsigned w) { return __builtin_bit_cast(float, w & 0xffff0000u); }
DI int crow(int reg, int h) { return (reg & 3) + 8 * (reg >> 2) + 4 * h; }
DI float fexp(float x) { return __builtin_amdgcn_exp2f(1.44269504f * x); }
DI float fsig(float x) { return pg8::fsig(x); }
DI bf16x8 mk_frag(unsigned a, unsigned b, unsigned c, unsigned d) { v4u p; p.x = a; p.y = b; p.z = c; p.w = d; return __builtin_bit_cast(bf16x8, p); }
DI bf16x8 pack8(const float (&v)[8]) { return mk_frag(pk2(v[0], v[1]), pk2(v[2], v[3]), pk2(v[4], v[5]), pk2(v[6], v[7])); }
template <int CTRL> DI float dpp_add(float x) {
    const int xi = __builtin_bit_cast(int, x);
    const int yi = __builtin_amdgcn_update_dpp(xi, xi, CTRL, 0xF, 0xF, false);
    return x + __builtin_bit_cast(float, yi);
}
DI float sum8(float x) { x = dpp_add<0xB1>(x); x = dpp_add<0x4E>(x); x = dpp_add<0x141>(x); return x; }
DI float sum16(float x) { x = sum8(x); x = dpp_add<0x140>(x); return x; }
DI float wave_sum(float v) { v = sum16(v); v += __shfl_xor(v, 16); v += __shfl_xor(v, 32); return v; }

#define XB_TMO      128
#define XB_XCNT(j)  (256  + 64 * (j))
#define XB_XSUB(j)  (1280 + 64 * (j))
#define XB_XGEN(j)  (2304 + 64 * (j))
#define XB_TOP      3328
#define XB_TOPGEN   3392
#define XCD_BAR_WORDS 3456
#define XB_SPIN_CAP (1u << 18)

__device__ __forceinline__ unsigned xb_ld(unsigned* p)              { return __hip_atomic_load(p, __ATOMIC_RELAXED, __HIP_MEMORY_SCOPE_AGENT); }
__device__ __forceinline__ unsigned xb_add(unsigned* p, unsigned v) { return __hip_atomic_fetch_add(p, v, __ATOMIC_RELAXED, __HIP_MEMORY_SCOPE_AGENT); }
__device__ __forceinline__ unsigned xb_xcc_id() { return (unsigned)__builtin_amdgcn_s_getreg((3 << 11) | 20) & 0xFu; }
#define XB_SPIN(cond, bar) do { unsigned _sp = 0; while (cond) { __builtin_amdgcn_s_sleep(1); \
    if ((++_sp & 255u) == 0u) { if (xb_ld(&(bar)[XB_TMO])) break; if (_sp > XB_SPIN_CAP) { atomicAdd(&(bar)[XB_TMO], 1u); break; } } } } while (0)

struct XcdBarrier {
    unsigned* bar; unsigned x;
    volatile LAS unsigned* st;
};

__device__ __forceinline__ XcdBarrier xcd_barrier_post(unsigned* bar, volatile LAS unsigned* st) {
    XcdBarrier b; b.bar = bar; b.x = xb_xcc_id(); b.st = st;
    if (threadIdx.x == 0) (void)xb_add(&bar[XB_XCNT(b.x)], 1u);
    return b;
}
__device__ __forceinline__ void xcd_barrier_complete(unsigned* bar, unsigned x, unsigned& nloc, unsigned& nx) {
    const unsigned G = gridDim.x * gridDim.y * gridDim.z;
    unsigned sum, cnt, mine, sp = 0u;
    for (;;) {
        sum = 0u; cnt = 0u; mine = 0u;
#pragma unroll
        for (unsigned j = 0; j < 16; ++j) { const unsigned c = xb_ld(&bar[XB_XCNT(j)]); sum += c; cnt += (c > 0u) ? 1u : 0u; mine = (j == x) ? c : mine; }
        if (sum == G) break;
        __builtin_amdgcn_s_sleep(1);
        if ((++sp & 255u) == 0u) { if (xb_ld(&bar[XB_TMO])) break; if (sp > XB_SPIN_CAP) { atomicAdd(&bar[XB_TMO], 1u); break; } }
    }
    nloc = mine > 0u ? mine : 1u; nx = cnt > 0u ? cnt : 1u;
}

__device__ __forceinline__ void xcd_barrier(const XcdBarrier& b) {
    asm volatile("s_waitcnt vmcnt(0)" ::: "memory");
    __syncthreads();
    if (threadIdx.x == 0) {
        unsigned* bar = b.bar;
        __builtin_amdgcn_s_waitcnt(0);
        unsigned nloc = b.st[0], nx = b.st[1];
        if (nloc == 0u) { xcd_barrier_complete(bar, b.x, nloc, nx); b.st[0] = nloc; b.st[1] = nx; }
        const unsigned old = xb_add(&bar[XB_XSUB(b.x)], 1u);
        const unsigned gen = old / nloc;
        if (old + 1u == (gen + 1u) * nloc) {
            __builtin_amdgcn_fence(__ATOMIC_RELEASE, "agent");
            asm volatile("s_waitcnt vmcnt(0)" ::: "memory");
            const unsigned og = xb_add(&bar[XB_TOP], 1u);
            const unsigned tg = og / nx;
            if (og + 1u == (tg + 1u) * nx) xb_add(&bar[XB_TOPGEN], 1u);
            else XB_SPIN(xb_ld(&bar[XB_TOPGEN]) == tg, bar);
            __builtin_amdgcn_fence(__ATOMIC_ACQUIRE, "agent");
            xb_add(&bar[XB_XGEN(b.x)], 1u);
            asm volatile("s_waitcnt vmcnt(0)" ::: "memory");
        } else {
            XB_SPIN(xb_ld(&bar[XB_XGEN(b.x)]) == gen, bar);
            __builtin_amdgcn_fence(__ATOMIC_ACQUIRE, "agent");
            asm volatile("s_waitcnt vmcnt(0)" ::: "memory");
        }
    }
    __syncthreads();
}
struct Args { const float* in[47]; float* out; unsigned char* ws; int ph_lo, ph_hi; };
struct Frame {
    LAS unsigned char* lds;
    volatile LAS unsigned* MISC;
    gu32* ctl;
    int tid, lane, wave;
    int vcu, G;
    float* out;
    unsigned char* ws;
};
enum { I_XP = 0, I_XS, I_CP, I_CS, I_SMC, I_SMN, I_SMM, I_SRH, I_SRC, I_SWKV, I_SSH, I_ADAW, I_ADAB, I_LNG, I_LNB, I_W1, I_W3, I_W2, I_WIN, I_BG, I_MNG,
       I_CW, I_CB, I_WA, I_BA, I_WX, I_BX, I_LAM, I_WOUT, I_MU, I_WR, I_WK, I_WV, I_W0, I_LW1, I_LW2, I_A0, I_A1, I_A2, I_G1, I_G2, I_KK, I_KA, I_RK, I_LXG, I_LXB, I_WO };

struct EpiResid {
    static constexpr bool PERM = true, AFTER_DRAIN = false;
    const Args& ar; float* out; unsigned char* ws; int cfg;
    __device__ __forceinline__ void operator()(const pg8::f32x4 (&acc)[2][2][4][2], const pg8::Unit& u, int wr, int wc, int fr, int fq) const {
        using pg8::BM; using pg8::HALF;
        if (u.sub) {
            const int row0 = u.pm * BM + wr * 64 + fr - MP, col0 = u.pn * BM + wc * 32 + 8 * fq;
            float* sb = (float*)(ws + WS_SLAB) + (size_t)(u.k0 / (64 * u.nt)) * (1024 * 1024) + col0;
#pragma unroll
            for (int ai = 0; ai < 2; ++ai)
#pragma unroll
                for (int m = 0; m < 4; ++m) { float* o = sb + (size_t)(row0 + ai * HALF + m * 16) * 1024;
#pragma unroll
                    for (int bj = 0; bj < 2; ++bj) { *(f32x4*)(o + bj * HALF) = acc[ai][bj][m][0]; *(f32x4*)(o + bj * HALF + 4) = acc[ai][bj][m][1]; } }
            return;
        }
        const int row0 = u.pm * BM + wr * 64 + fr, col0 = u.pn * BM + wc * 32 + 8 * fq;
        const bool first = cfg & 1; const int l = (cfg >> 1) & 1, jg = (cfg >> 2) & 15; const float rw = (cfg & 64) ? 1.0f : 0.5f;
        bf16* XB = (bf16*)((unsigned char*)out + XB_OFF);
        bf16* Zo = (cfg & 128) ? (bf16*)(ws + WS_BIG + 145 * MiB) : ((cfg & 256) ? (bf16*)(ws + WS_ZF) : XB);
        const float* gate = (const float*)(ws + WS_MOD) + ((size_t)l * NSEQ * 9 + jg) * 1024;
#pragma unroll
        for (int ai = 0; ai < 2; ++ai)
#pragma unroll
            for (int m = 0; m < 4; ++m) { const int row = row0 + ai * HALF + m * 16;
                const float* gr = gate + (size_t)pg8::mod_row(row) * 9216 + col0;
#pragma unroll
                for (int bj = 0; bj < 2; ++bj) { const int c = bj * HALF; f32x4 x0, x1;
                    if (first) { const float* xr = (row < MP ? ar.in[I_XP] + (size_t)row * 1024 : ar.in[I_XS] + (size_t)(row - MP) * 1024) + col0 + c; x0 = *(const f32x4*)xr; x1 = *(const f32x4*)(xr + 4); }
                    else { const v4u q = *(const v4u*)(XB + (size_t)row * 1024 + col0 + c); x0 = (f32x4){bflo(q.x), bfhi(q.x), bflo(q.y), bfhi(q.y)}; x1 = (f32x4){bflo(q.z), bfhi(q.z), bflo(q.w), bfhi(q.w)}; }
                    const f32x4 g0 = *(const f32x4*)(gr + c), g1 = *(const f32x4*)(gr + c + 4);
                    const f32x4 z0 = x0 * ALPHA + (g0 + 1.0f) * rw * acc[ai][bj][m][0], z1 = x1 * ALPHA + (g1 + 1.0f) * rw * acc[ai][bj][m][1];
                    v4u w; w.x = pk2(z0.x, z0.y); w.y = pk2(z0.z, z0.w); w.z = pk2(z1.x, z1.y); w.w = pk2(z1.z, z1.w);
                    *(v4u*)(Zo + (size_t)row * 1024 + col0 + c) = w; }
                asm volatile("" ::: "memory"); }
    }
};
struct SplitOrder {
    pg8::StaticOrder base; int S;
    __device__ __forceinline__ bool next(int i, pg8::Unit& u) const {
        if (S == 0) return base.next(i, u);
        if (i == 0) return base.next(0, u);
        if (i == 1 && base.c < 16 * S) { const int su = base.c / S, ks = base.c - su * S; u.pm = 64 + (su >> 2); u.pn = su & 3; u.k0 = ks * 256; u.nt = 4; u.sub = 1; return true; }
        return false;
    }
    __device__ __forceinline__ void a_ready(const pg8::Unit&) const {}
    __device__ __forceinline__ void done(const pg8::Unit&) const {}
};

DI void p0_sctab(Frame& F, const Args& AR) {
    bf16* sc = (bf16*)(F.ws + WS_SC);
    const int gt = F.vcu * NTHREADS + F.tid, NT = F.G * NTHREADS;
    for (int e = gt; e < 160 * 256; e += NT) { const int m = e >> 8, k4 = (e & 255) * 4; v2u w; w.x = 0u; w.y = 0u;
        if (m < NSEQ) { const f32x4 c = *(const f32x4*)((m < NPB ? AR.in[I_CP] + (size_t)m * D : AR.in[I_CS] + (size_t)(m - NPB) * D) + k4);
            w.x = pk2(c.x * fsig(c.x), c.y * fsig(c.y)); w.y = pk2(c.z * fsig(c.z), c.w * fsig(c.w)); }
        *(v2u*)(sc + (size_t)m * 1024 + k4) = w; }
}
DI void p0_mod(Frame& F, const Args& AR) {
    LAS float* SL = (LAS float*)F.lds;
    LAS float* T = (LAS float*)(F.lds + 81920);
    const int lane = F.lane, wave = F.wave, r = lane & 31, hh = lane >> 5;
    const float* adaw = AR.in[I_ADAW]; const float* adab = AR.in[I_ADAB];
    const bf16* sc = (const bf16*)(F.ws + WS_SC);
    float* mod = (float*)(F.ws + WS_MOD);
    for (int nb = F.vcu; nb < 576; nb += F.G) {
        const int n0 = nb * 32, l = n0 / 9216, nc0 = n0 - l * 9216;
        const float* W = adaw + (size_t)l * 1024 * 9216 + nc0 + r + (size_t)(wave * 128 + 8 * hh) * 9216;
        float a[8][8];
#pragma unroll
        for (int ks = 0; ks < 8; ++ks)
#pragma unroll
            for (int j = 0; j < 8; ++j) a[ks][j] = W[(size_t)(ks * 16 + j) * 9216];
        f32x16 acc[5];
#pragma unroll
        for (int mb = 0; mb < 5; ++mb)
#pragma unroll
            for (int i = 0; i < 16; ++i) acc[mb][i] = 0.f;
#pragma unroll
        for (int ks = 0; ks < 8; ++ks) { const bf16x8 A = pack8(a[ks]); const int k0 = wave * 128 + ks * 16 + 8 * hh;
#pragma unroll
            for (int mb = 0; mb < 5; ++mb) acc[mb] = MFMA32(A, *(const bf16x8*)(sc + (size_t)(mb * 32 + r) * 1024 + k0), acc[mb]); }
#pragma unroll
        for (int half = 4; half >= 1; half >>= 1) {
            if (wave >= half && wave < 2 * half) { LAS float* p = SL + (wave - half) * 5120 + lane;
#pragma unroll
                for (int mb = 0; mb < 5; ++mb)
#pragma unroll
                    for (int i = 0; i < 16; ++i) p[(mb * 16 + i) * 64] = acc[mb][i]; }
            __syncthreads();
            if (wave < half) { const LAS float* p = SL + wave * 5120 + lane;
#pragma unroll
                for (int mb = 0; mb < 5; ++mb)
#pragma unroll
                    for (int i = 0; i < 16; ++i) acc[mb][i] += p[(mb * 16 + i) * 64]; }
            __syncthreads();
        }
        if (wave == 0) {
#pragma unroll
            for (int mb = 0; mb < 5; ++mb)
#pragma unroll
                for (int i = 0; i < 16; ++i) T[(mb * 32 + r) * 33 + crow(i, hh)] = acc[mb][i]; }
        __syncthreads();
        for (int m = F.tid >> 5; m < NSEQ; m += 16) { const int n = F.tid & 31; mod[(size_t)(l * NSEQ + m) * 9216 + nc0 + n] = T[m * 33 + n] + adab[l * 9216 + nc0 + n]; }
        __syncthreads();
    }
}

DI void tr_item(const float* src, int ld, int nvalid, float keep, const float* sc, float sa, float sb, bf16* dst, int dld, LAS float* scr, int lane) {
    const int n4 = (lane & 7) * 4, kr = lane >> 3; const float kz = (n4 < nvalid) ? keep : 0.f;
    f32x4 v[8]; float m[8];
#pragma unroll
    for (int i = 0; i < 8; ++i) { v[i] = *(const f32x4*)(src + (size_t)(kr + 8 * i) * ld + n4); m[i] = sc[kr + 8 * i]; }
#pragma unroll
    for (int i = 0; i < 8; ++i) { const float f = (sa + sb * m[i]) * kz; LAS float* p = scr + (kr + 8 * i) * 33 + n4;
        p[0] = kz == 0.f ? 0.f : v[i].x * f; p[1] = kz == 0.f ? 0.f : v[i].y * f; p[2] = kz == 0.f ? 0.f : v[i].z * f; p[3] = kz == 0.f ? 0.f : v[i].w * f; }
    LDS_WAIT(); asm volatile("" ::: "memory");
    const int c = lane & 7;
#pragma unroll
    for (int j = 0; j < 4; ++j) { const int n = (lane >> 3) + 8 * j; const LAS float* s = scr + (8 * c) * 33 + n;
        v4u o; o.x = pk2(s[0 * 33], s[1 * 33]); o.y = pk2(s[2 * 33], s[3 * 33]); o.z = pk2(s[4 * 33], s[5 * 33]); o.w = pk2(s[6 * 33], s[7 * 33]);
        *(GAS v4u*)(dst + (size_t)n * dld + 8 * c) = o; }
    LDS_WAIT(); asm volatile("" ::: "memory");
}
DI void p0_weights(Frame& F, const Args& AR) {
    LAS float* scr = (LAS float*)(F.lds + 32768 + F.wave * 8704);
    const int gw = F.vcu * NWAVES + F.wave, NGW = F.G * NWAVES;
    constexpr int I_13 = 16 * 176, I_2 = 44 * 32, I_IN = 16 * 104, I_SQ = 16 * 32, I_RKI = 32 * 104, I_L2 = 4 * 96;
    constexpr int NITEMS = 4 * I_13 + 4 * I_2 + I_IN + 2 * I_SQ + I_RKI + I_L2;
    bf16* W13 = (bf16*)(F.ws + WS_W13); bf16* W2 = (bf16*)(F.ws + WS_W2); bf16* WIN = (bf16*)(F.ws + WS_WIN); bf16* WOUT = (bf16*)(F.ws + WS_WOUT);
    bf16* WRK = (bf16*)(F.ws + WS_WRK); bf16* WL2 = (bf16*)(F.ws + WS_WL2); bf16* WO = (bf16*)(F.ws + WS_WO);
    for (int it = gw; it < NITEMS; it += NGW) {
        int r = it;
        if (r < 4 * I_13) { const int f = r / I_13; r -= f * I_13; const int kt = r / 176, tn = r % 176, j = tn >> 3, i = tn & 7;
            const float* src = (i < 4 ? AR.in[I_W1] : AR.in[I_W3]) + (size_t)f * 1024 * FF + (size_t)(64 * kt) * FF + 128 * j + 32 * (i & 3);
            tr_item(src, FF, 32, 1.f, src, 1.f, 0.f, W13 + (size_t)f * 5632 * 1024 + (size_t)(32 * tn) * 1024 + 64 * kt, 1024, scr, F.lane); continue; }
        r -= 4 * I_13;
        if (r < 4 * I_2) { const int f = r / I_2; r -= f * I_2; const int kt = r / 32, tn = r % 32;
            const float* src = AR.in[I_W2] + (size_t)f * FF * 1024 + (size_t)(64 * kt) * 1024 + 32 * tn;
            tr_item(src, 1024, 32, 1.f, src, 1.f, 0.f, W2 + (size_t)f * 1024 * FF + (size_t)(32 * tn) * FF + 64 * kt, FF, scr, F.lane); continue; }
        r -= 4 * I_2;
        if (r < I_IN) { const int kt = r / 104, tn = r % 104, nd = 32 * tn; int sc0 = 0, nv = 32; bool has = true;
            if (nd < 2048) sc0 = nd; else if (nd < 3072) sc0 = nd + 8; else if (nd == 3072) { sc0 = 2048; nv = 8; } else has = false;
            const float* src = AR.in[I_WIN] + (size_t)(64 * kt) * 3080 + sc0;
            tr_item(src, 3080, nv, has ? 1.f : 0.f, src, 1.f, 0.f, WIN + (size_t)nd * 1024 + 64 * kt, 1024, scr, F.lane); continue; }
        r -= I_IN;
        if (r < 2 * I_SQ) { const int w = r / I_SQ; r -= w * I_SQ; const int kt = r / 32, tn = r % 32;
            const float* src = (w == 0 ? AR.in[I_WOUT] : AR.in[I_WO]) + (size_t)(64 * kt) * 1024 + 32 * tn;
            tr_item(src, 1024, 32, 1.f, src, 1.f, 0.f, (w == 0 ? WOUT : WO) + (size_t)(32 * tn) * 1024 + 64 * kt, 1024, scr, F.lane); continue; }
        r -= 2 * I_SQ;
        if (r < I_RKI) { const int kt = r / 104, tn = r % 104, nd = 32 * tn, kd = 64 * kt, half = kd >= 1024, ks = kd & 1023;
            const float* base; int ld, col, mi;
            if (nd < 1024) { base = AR.in[I_WR]; ld = 1024; col = nd; mi = 0; }
            else if (nd < 2048) { base = AR.in[I_WK]; ld = 1024; col = nd - 1024; mi = 2; }
            else if (nd < 3072) { base = AR.in[I_WV]; ld = 1024; col = nd - 2048; mi = 3; }
            else if (nd < 3136) { base = AR.in[I_LW1]; ld = 64; col = nd - 3072; mi = 1; }
            else if (nd < 3200) { base = AR.in[I_A1]; ld = 64; col = nd - 3136; mi = 4; }
            else { base = AR.in[I_G1]; ld = 128; col = nd - 3200; mi = 5; }
            tr_item(base + (size_t)ks * ld + col, ld, 32, 1.f, AR.in[I_MU] + mi * 1024 + ks, half ? 0.f : 1.f, half ? 1.f : -1.f, WRK + (size_t)nd * 2048 + kd, 2048, scr, F.lane); continue; }
        r -= I_RKI;
        { const int kt = r / 96, tn = r % 96, nd = 32 * tn; const float* src = AR.in[I_LW2]; float keep = 0.f;
            if (nd < 1024) { if (kt == 0) { src = AR.in[I_LW2] + nd; keep = 1.f; } }
            else if (nd < 2048) { if (kt == 1) { src = AR.in[I_A2] + (nd - 1024); keep = 1.f; } }
            else { if (kt >= 2) { src = AR.in[I_G2] + (size_t)(64 * (kt - 2)) * 1024 + (nd - 2048); keep = 1.f; } }
            tr_item(src, 1024, 32, keep, AR.in[I_LW2], 1.f, 0.f, WL2 + (size_t)nd * 256 + 64 * kt, 256, scr, F.lane); }
    }
}

DI void ld8(float (&v)[8], const bf16* p) { const v4u q = *(const v4u*)p; v[0] = bflo(q.x); v[1] = bfhi(q.x); v[2] = bflo(q.y); v[3] = bfhi(q.y); v[4] = bflo(q.z); v[5] = bfhi(q.z); v[6] = bflo(q.w); v[7] = bfhi(q.w); }
DI void ld8(float (&v)[8], const float* p) { const f32x4 a = *(const f32x4*)p, b = *(const f32x4*)(p + 4); v[0] = a.x; v[1] = a.y; v[2] = a.z; v[3] = a.w; v[4] = b.x; v[5] = b.y; v[6] = b.z; v[7] = b.w; }
DI v4u pk8(const float (&v)[8]) { v4u w; w.x = pk2(v[0], v[1]); w.y = pk2(v[2], v[3]); w.z = pk2(v[4], v[5]); w.w = pk2(v[6], v[7]); return w; }
DI void ln_pass(Frame& F, const Args& AR, int first, int do_ln, int l, int sub, int lm, int js, int mode, int nsplit, int xfirst, int fin) {
    const int gw = F.vcu * NWAVES + F.wave, NGW = F.G * NWAVES, lane = F.lane;
    bf16* XB = (bf16*)((unsigned char*)F.out + XB_OFF); const bf16* ZS = fin ? (const bf16*)(F.ws + WS_ZF) : XB;
    const float* lg = AR.in[I_LNG] + (l * 3 + sub) * 1024; const float* lb = AR.in[I_LNB] + (l * 3 + sub) * 1024;
    const float* mod = (const float*)(F.ws + WS_MOD);
    bf16* H = (bf16*)(F.ws + WS_H); bf16* A2 = (bf16*)(F.ws + WS_A2);
    float nv[2][8];
    { const int r = gw < M ? gw : 0;
#pragma unroll
        for (int j = 0; j < 2; ++j) { const int c0 = 8 * (lane + 64 * j);
            if (first || (xfirst && r >= MP)) ld8(nv[j], (r < MP ? AR.in[I_XP] + (size_t)r * D : AR.in[I_XS] + (size_t)(r - MP) * D) + c0);
            else ld8(nv[j], ZS + (size_t)r * D + c0); } }
    for (int r = gw; r < M; r += NGW) {
        float v[2][8];
#pragma unroll
        for (int j = 0; j < 2; ++j)
#pragma unroll
            for (int e = 0; e < 8; ++e) v[j][e] = nv[j][e];
        { const int rn = r + NGW < M ? r + NGW : r;
#pragma unroll
            for (int j = 0; j < 2; ++j) { const int c0 = 8 * (lane + 64 * j);
                if (first || (xfirst && rn >= MP)) ld8(nv[j], (rn < MP ? AR.in[I_XP] + (size_t)rn * D : AR.in[I_XS] + (size_t)(rn - MP) * D) + c0);
                else ld8(nv[j], ZS + (size_t)rn * D + c0); } }
        if (nsplit > 0 && r >= MP) {
            const float* gp = mod + ((size_t)(l * NSEQ + pg8::mod_row(r)) * 9 + 3 * sub + 2) * 1024; const float rw = sub == 1 ? 1.0f : 0.5f;
            const float* sl = (const float*)(F.ws + WS_SLAB) + (size_t)(r - MP) * 1024;
#pragma unroll
            for (int j = 0; j < 2; ++j) { const int c0 = 8 * (lane + 64 * j); float a[8], g[8]; ld8(a, sl + c0); ld8(g, gp + c0);
                for (int s = 1; s < nsplit; ++s) { float t[8]; ld8(t, sl + (size_t)s * 1024 * 1024 + c0);
#pragma unroll
                    for (int e = 0; e < 8; ++e) a[e] += t[e]; }
#pragma unroll
                for (int e = 0; e < 8; ++e) v[j][e] = v[j][e] * ALPHA + (g[e] + 1.0f) * rw * a[e]; }
        }
        if (do_ln) {
            float s = 0.f;
#pragma unroll
            for (int j = 0; j < 2; ++j)
#pragma unroll
                for (int e = 0; e < 8; ++e) s += v[j][e];
            const float mean = wave_sum(s) * (1.f / D); float s2 = 0.f;
#pragma unroll
            for (int j = 0; j < 2; ++j)
#pragma unroll
                for (int e = 0; e < 8; ++e) { v[j][e] -= mean; s2 += v[j][e] * v[j][e]; }
            const float rstd = 1.f / sqrtf(wave_sum(s2) * (1.f / D) + LN_EPS);
#pragma unroll
            for (int j = 0; j < 2; ++j) { const int c0 = 8 * (lane + 64 * j); float g[8], b[8]; ld8(g, lg + c0); ld8(b, lb + c0);
#pragma unroll
                for (int e = 0; e < 8; ++e) v[j][e] = v[j][e] * rstd * g[e] + b[e];
                if (fin) { float* o = F.out + O_Y + (size_t)r * D + c0; *(f32x4*)o = (f32x4){v[j][0], v[j][1], v[j][2], v[j][3]}; *(f32x4*)(o + 4) = (f32x4){v[j][4], v[j][5], v[j][6], v[j][7]}; }
                else *(v4u*)(XB + (size_t)r * D + c0) = pk8(v[j]); }
        }
        if (mode != 2) {
            const int mr = pg8::mod_row(r);
            const float* sh = mod + ((size_t)(lm * NSEQ + mr) * 9 + js) * 1024; const float* sc = sh + 1024;
            int t, len, b; if (r < MP) { t = r & (PSEQ - 1); len = PSEQ; b = r >> 11; } else { t = (r - MP) & (SSEQ - 1); len = SSEQ; b = (r - MP) >> 3; }
#pragma unroll
            for (int j = 0; j < 2; ++j) { const int c0 = 8 * (lane + 64 * j); float s8[8], h8[8], h[8]; ld8(s8, sc + c0); ld8(h8, sh + c0);
#pragma unroll
                for (int e = 0; e < 8; ++e) h[e] = v[j][e] * (s8[e] + 1.0f) + h8[e];
                const v4u w = pk8(h);
                if (mode == 0) *(v4u*)(H + (size_t)r * D + c0) = w;
                else {
                    *(v4u*)(A2 + (size_t)r * 2048 + c0) = w;
                    if (t + 1 < len) *(v4u*)(A2 + (size_t)(r + 1) * 2048 + 1024 + c0) = w;
                    if (t == 0) { v4u p; p.x = 0u; p.y = 0u; p.z = 0u; p.w = 0u;
                        if (r >= MP) { float q[8]; ld8(q, AR.in[I_SSH] + (size_t)b * D + c0); p = pk8(q); }
                        *(v4u*)(A2 + (size_t)r * 2048 + 1024 + c0) = p; }
                    if (t == len - 1) { float* o = F.out + (r < MP ? O_PSH : O_SSH) + (size_t)b * D + c0; *(f32x4*)o = (f32x4){h[0], h[1], h[2], h[3]}; *(f32x4*)(o + 4) = (f32x4){h[4], h[5], h[6], h[7]}; }
                } }
        }
    }
}

DI float log_sigmoid(float x) { return -(fmaxf(-x, 0.f) + log1pf(__expf(-fabsf(x)))); }
DI float gelu_tanh(float x) { const float u = 0.7978845608f * (x + 0.044715f * x * x * x); return 0.5f * x * (1.0f + pg8::ftanh(u)); }

DI void ml1_prompt(Frame& F, const Args& AR) {
    const bf16* Z = (const bf16*)(F.ws + WS_Z);
    float* CST = (float*)(F.ws + WS_CST); float* NST = (float*)(F.ws + WS_NST); float* MST = (float*)(F.ws + WS_MST);
    LAS bf16* Ks = (LAS bf16*)F.lds;
    LAS bf16* Vs = (LAS bf16*)(F.lds + 32768);
    LAS float* LF = (LAS float*)(F.lds + 65536);
    LAS float* GS = (LAS float*)(F.lds + 65536 + 512);
    LAS float* RED = (LAS float*)(F.lds + 65536 + 1024);
    const int tid = F.tid, lane = F.lane, wave = F.wave, r = lane & 31, hh = lane >> 5;
    for (int item = F.vcu; item < 512; item += F.G) {
        const int b = item >> 6, h = (item >> 4) & 3, c = item & 15; const size_t row0 = (size_t)b * PSEQ + c * 128;
#pragma unroll
        for (int i = 0; i < 4; ++i) { const int e = tid + i * NTHREADS, s = e >> 4, c8 = (e & 15) * 8;
            *(LAS v4u*)(Ks + s * 128 + c8) = *(const v4u*)(Z + (row0 + s) * ZW + ZK + h * 128 + c8);
            *(LAS v4u*)(Vs + s * 128 + c8) = *(const v4u*)(Z + (row0 + s) * ZW + ZV + h * 128 + c8); }
        if (tid < 128) { const float fg = bf2f(Z[(row0 + tid) * ZW + ZFG + h]); LF[tid] = log_sigmoid(fg + AR.in[I_BG][4 + h]); }
        __syncthreads();
        if (tid < 128) { float bs = 0.f; for (int s = 0; s <= tid; ++s) bs += LF[s];
            const float ig = bf2f(Z[(row0 + tid) * ZW + ZIG + h]) + AR.in[I_BG][h];
            GS[tid] = ig - bs; if (tid == 127) RED[0] = bs; }
        __syncthreads();
        float gmax = -INFINITY; for (int s = 0; s < 128; ++s) gmax = fmaxf(gmax, GS[s]);
        const float bL = RED[0];
        __syncthreads();
        if (tid < 128) GS[tid] = fexp(GS[tid] - gmax);
        __syncthreads();
        const int vb = wave >> 1, kb0 = 2 * (wave & 1);
        f32x16 acc[2];
#pragma unroll
        for (int i = 0; i < 16; ++i) { acc[0][i] = 0.f; acc[1][i] = 0.f; }
#pragma unroll 2
        for (int ks = 0; ks < 8; ++ks) { const int s0 = 16 * ks + 8 * hh;
            float a[8];
#pragma unroll
            for (int j = 0; j < 8; ++j) a[j] = bf2f(Vs[(s0 + j) * 128 + vb * 32 + r]) * GS[s0 + j];
            const bf16x8 A = pack8(a);
#pragma unroll
            for (int q = 0; q < 2; ++q) { unsigned kw[8];
#pragma unroll
                for (int j = 0; j < 8; ++j) kw[j] = Ks[(s0 + j) * 128 + (kb0 + q) * 32 + r];
                const bf16x8 B = mk_frag(kw[0] | (kw[1] << 16), kw[2] | (kw[3] << 16), kw[4] | (kw[5] << 16), kw[6] | (kw[7] << 16));
                acc[q] = MFMA32(A, B, acc[q]); } }
        float* Co = CST + (size_t)item * 16384;
#pragma unroll
        for (int q = 0; q < 2; ++q)
#pragma unroll
            for (int i = 0; i < 16; ++i) Co[(vb * 32 + crow(i, hh)) * 128 + (kb0 + q) * 32 + r] = acc[q][i] * MSCALE;
        if (tid < 128) { float n = 0.f; for (int s = 0; s < 128; ++s) n += GS[s] * bf2f(Ks[s * 128 + tid]); NST[item * 128 + tid] = n * MSCALE; }
        if (tid == 0) { MST[item * 4 + 0] = bL + gmax; MST[item * 4 + 1] = bL; }
        __syncthreads();
    }
}

DI void ml_sample(Frame& F, const Args& AR) {
    const bf16* Z = (const bf16*)(F.ws + WS_Z); bf16* G = (bf16*)(F.ws + WS_H);
    LAS float* Qs = (LAS float*)F.lds;
    LAS float* Ks = Qs + 1024; LAS float* Vs = Ks + 1024;
    LAS float* HT = Vs + 1024;
    LAS float* P = HT + 1024;
    LAS float* GT = P + 64;
    LAS float* SC = GT + 64;
    const int tid = F.tid, lane = F.lane, wave = F.wave;
    const float* C0g = AR.in[I_SMC]; const float* n0g = AR.in[I_SMN]; const float* m0g = AR.in[I_SMM];
    for (int item = F.vcu; item < 512; item += F.G) {
        const int b = item >> 2, h = item & 3; const size_t row0 = (size_t)MP + (size_t)b * SSEQ;
        for (int e = tid; e < 3 * 512; e += NTHREADS) { const int w = e >> 9, t = (e >> 6) & 7, c2 = (e & 63) * 2;
            const unsigned u = *(const unsigned*)(Z + (row0 + t) * ZW + (w == 0 ? ZQ : (w == 1 ? ZK : ZV)) + h * 128 + c2);
            LAS float* dst = (w == 0 ? Qs : (w == 1 ? Ks : Vs)) + t * 128 + c2; dst[0] = bflo(u); dst[1] = bfhi(u); }
        const float m0 = m0g[b * 4 + h];
        if (tid < 16) { const int t = tid & 7; const float zv = bf2f(Z[(row0 + t) * ZW + (tid < 8 ? ZIG : ZFG) + h]);
            if (tid < 8) P[t] = zv + AR.in[I_BG][h]; else GT[7 * 8 + t] = log_sigmoid(zv + AR.in[I_BG][4 + h]); }
        __syncthreads();
        if (tid < 8) { float bs = 0.f, mx = m0, bsl = 0.f, gme = 0.f;
            for (int s = 0; s < 8; ++s) { bs += GT[7 * 8 + s]; const float g = P[s] - bs; if (s <= tid) { mx = fmaxf(mx, g); bsl = bs; } if (s == tid) gme = g; }
            GT[0 * 8 + tid] = bsl; GT[1 * 8 + tid] = gme; GT[2 * 8 + tid] = mx; GT[3 * 8 + tid] = fexp(m0 - mx);
            if (tid == 7) { const float mend = bsl + mx; SC[0] = mend; SC[1] = fexp(bsl + m0 - mend); } }
        __syncthreads();
        if (tid < 8) { const float mend = SC[0]; GT[5 * 8 + tid] = fexp(GT[0 * 8 + 7] + GT[1 * 8 + tid] - mend); }
        if (tid < 64) { const int t = tid >> 3, s = tid & 7; float d = 0.f;
            if (s <= t) { for (int k = 0; k < 128; ++k) d += Qs[t * 128 + k] * Ks[s * 128 + k]; d = d * MSCALE * fexp(GT[1 * 8 + s] - GT[2 * 8 + t]); }
            P[t * 8 + s] = d; }
        else if (tid < 72) { const int t = tid - 64; float d = 0.f; for (int k = 0; k < 128; ++k) d += Qs[t * 128 + k] * n0g[(size_t)(b * 4 + h) * 128 + k]; GT[6 * 8 + t] = d; }
        __syncthreads();
        if (tid < 8) { float d = 0.f; for (int s = 0; s < 8; ++s) d += P[tid * 8 + s]; d += GT[3 * 8 + tid] * GT[6 * 8 + tid];
            const float mt = GT[0 * 8 + tid] + GT[2 * 8 + tid]; GT[4 * 8 + tid] = fmaxf(fabsf(d), fexp(-mt)); }
        const int v = tid >> 2, seg = tid & 3;
        const float* C0p = C0g + ((size_t)(b * 4 + h) * 128 + v) * 128 + seg * 32;
        float c0[32];
#pragma unroll
        for (int i = 0; i < 8; ++i) { const f32x4 q = *(const f32x4*)(C0p + 4 * i); c0[4 * i] = q.x; c0[4 * i + 1] = q.y; c0[4 * i + 2] = q.z; c0[4 * i + 3] = q.w; }
        __syncthreads();
        float inter[8];
#pragma unroll
        for (int t = 0; t < 8; ++t) { float d = 0.f;
#pragma unroll
            for (int i = 0; i < 32; ++i) d += c0[i] * Qs[t * 128 + seg * 32 + i];
            d += __shfl_xor(d, 1); d += __shfl_xor(d, 2); inter[t] = d; }
        if (seg == 0) {
#pragma unroll
            for (int t = 0; t < 8; ++t) { float num = GT[3 * 8 + t] * inter[t];
                for (int s = 0; s <= t; ++s) num += P[t * 8 + s] * Vs[s * 128 + v];
                HT[t * 128 + v] = num / GT[4 * 8 + t]; } }
        { const float wst = SC[1]; float* Cout = F.out + O_SMC + ((size_t)(b * 4 + h) * 128 + v) * 128 + seg * 32;
#pragma unroll
            for (int i = 0; i < 32; ++i) c0[i] *= wst;
#pragma unroll
            for (int s = 0; s < 8; ++s) { const float wv = GT[5 * 8 + s] * Vs[s * 128 + v] * MSCALE;
#pragma unroll
                for (int i = 0; i < 32; ++i) c0[i] += wv * Ks[s * 128 + seg * 32 + i]; }
#pragma unroll
            for (int i = 0; i < 8; ++i) { f32x4 q; q.x = c0[4 * i]; q.y = c0[4 * i + 1]; q.z = c0[4 * i + 2]; q.w = c0[4 * i + 3]; *(f32x4*)(Cout + 4 * i) = q; } }
        if (tid < 128) { float n = SC[1] * n0g[(size_t)(b * 4 + h) * 128 + tid];
            for (int s = 0; s < 8; ++s) n += GT[5 * 8 + s] * Ks[s * 128 + tid] * MSCALE;
            F.out[O_SMN + (size_t)(b * 4 + h) * 128 + tid] = n; }
        if (tid == 0) F.out[O_SMM + b * 4 + h] = SC[0];
        __syncthreads();
        { const int t = wave; const float x0 = HT[t * 128 + lane], x1 = HT[t * 128 + 64 + lane];
            const float mean = wave_sum(x0 + x1) * (1.f / 128.f); const float d0 = x0 - mean, d1 = x1 - mean;
            const float rstd = 1.f / sqrtf(wave_sum(d0 * d0 + d1 * d1) * (1.f / 128.f) + HEAD_EPS);
            const size_t row = row0 + t;
            const float o0 = bf2f(Z[row * ZW + ZO + h * 128 + lane]), o1 = bf2f(Z[row * ZW + ZO + h * 128 + 64 + lane]);
            const float g0 = AR.in[I_MNG][h * 128 + lane], g1 = AR.in[I_MNG][h * 128 + 64 + lane];
            G[row * D + h * 128 + lane] = (bf16)f2bf(d0 * rstd * g0 * fsig(o0)); G[row * D + h * 128 + 64 + lane] = (bf16)f2bf(d1 * rstd * g1 * fsig(o1)); }
        __syncthreads();
    }
}

DI void rg1(Frame& F, const Args& AR) {
    const bf16* Z = (const bf16*)(F.ws + WS_Z); bf16* G = (bf16*)(F.ws + WS_H);
    float* RGH = (float*)(F.ws + WS_RGH); float* RGP = (float*)(F.ws + WS_RGP);
    const int lane = F.lane, g = F.wave, r = lane & 31, hh = lane >> 5;
    LAS float* XT = (LAS float*)(F.lds + g * 17408);
    LAS float* AT = XT + 32 * 68;
    const float* wa = AR.in[I_WA] + (size_t)g * 4096; const float* wx = AR.in[I_WX] + (size_t)g * 4096;
    bf16x8 Ba[4][2], Bx[4][2];
    { const GAS float* wab = (const GAS float*)(wa + 8 * hh * 64 + r); const GAS float* wxb = (const GAS float*)(wx + 8 * hh * 64 + r);
#pragma unroll
        for (int ks = 0; ks < 4; ++ks)
#pragma unroll
            for (int cb = 0; cb < 2; ++cb) { float a[8], x[8];
#pragma unroll
                for (int j = 0; j < 8; ++j) { const int i = 16 * ks + j; a[j] = wab[i * 64 + cb * 32]; x[j] = wxb[i * 64 + cb * 32]; }
                Ba[ks][cb] = pack8(a); Bx[ks][cb] = pack8(x); } }
    float spl[2], ba[2], bx[2];
#pragma unroll
    for (int cb = 0; cb < 2; ++cb) { const int c = 64 * g + cb * 32 + r; spl[cb] = -8.0f * log1pf(__expf(-AR.in[I_LAM][c])); ba[cb] = AR.in[I_BA][c]; bx[cb] = AR.in[I_BX][c]; }
    const float* cw = AR.in[I_CW]; const float* cbias = AR.in[I_CB];
    for (int tt = F.vcu; tt < M / 32; tt += F.G) {
        const int R0 = tt * 32, row = R0 + r; const bool samp = R0 >= MP;
        int t, b; if (!samp) { t = row & (PSEQ - 1); b = row >> 11; } else { t = (row - MP) & 7; b = (row - MP) >> 3; }
        bf16x8 Af[4];
#pragma unroll
        for (int ks = 0; ks < 4; ++ks) { const int c0 = 64 * g + 16 * ks + 8 * hh; float xc[8];
            { const f32x4 q0 = *(const f32x4*)(cbias + c0), q1 = *(const f32x4*)(cbias + c0 + 4); xc[0] = q0.x; xc[1] = q0.y; xc[2] = q0.z; xc[3] = q0.w; xc[4] = q1.x; xc[5] = q1.y; xc[6] = q1.z; xc[7] = q1.w; }
#pragma unroll
            for (int tap = 0; tap < 4; ++tap) { const int tp = t + tap - 3; const bool ok = tp >= 0; float xv[8];
                { const v4u q = *(const v4u*)(Z + (size_t)(ok ? row + tap - 3 : row) * ZW + ZXR + c0);
                    xv[0] = bflo(q.x); xv[1] = bfhi(q.x); xv[2] = bflo(q.y); xv[3] = bfhi(q.y); xv[4] = bflo(q.z); xv[5] = bfhi(q.z); xv[6] = bflo(q.w); xv[7] = bfhi(q.w); }
                if (samp) { const float* sp = AR.in[I_SRC] + ((size_t)b * 3 + (ok ? 0 : t + tap)) * 512 + c0; const f32x4 q0 = *(const f32x4*)sp, q1 = *(const f32x4*)(sp + 4);
                    if (!ok) { xv[0] = q0.x; xv[1] = q0.y; xv[2] = q0.z; xv[3] = q0.w; xv[4] = q1.x; xv[5] = q1.y; xv[6] = q1.z; xv[7] = q1.w; } }
                else if (!ok) {
#pragma unroll
                    for (int j = 0; j < 8; ++j) xv[j] = 0.f; }
                const f32x4 w0 = *(const f32x4*)(cw + tap * 512 + c0), w1 = *(const f32x4*)(cw + tap * 512 + c0 + 4);
                xc[0] += w0.x * xv[0]; xc[1] += w0.y * xv[1]; xc[2] += w0.z * xv[2]; xc[3] += w0.w * xv[3]; xc[4] += w1.x * xv[4]; xc[5] += w1.y * xv[5]; xc[6] += w1.z * xv[6]; xc[7] += w1.w * xv[7]; }
            Af[ks] = pack8(xc);
            LAS float* xp = XT + r * 68 + 16 * ks + 8 * hh;
            *(LAS f32x4*)xp = (f32x4){xc[0], xc[1], xc[2], xc[3]}; *(LAS f32x4*)(xp + 4) = (f32x4){xc[4], xc[5], xc[6], xc[7]};
            asm volatile("" ::: "memory"); }
        LDS_WAIT(); asm volatile("" ::: "memory");
#pragma unroll
        for (int cb = 0; cb < 2; ++cb) { f32x16 da, dx;
#pragma unroll
            for (int i = 0; i < 16; ++i) { da[i] = 0.f; dx[i] = 0.f; }
#pragma unroll
            for (int ks = 0; ks < 4; ++ks) { da = MFMA32(Af[ks], Ba[ks][cb], da); dx = MFMA32(Af[ks], Bx[ks][cb], dx); }
#pragma unroll
            for (int i = 0; i < 16; ++i) { const int tr = crow(i, hh), j = cb * 32 + r;
                const float rg = fsig(da[i] + ba[cb]), ig = fsig(dx[i] + bx[cb]);
                const float la = spl[cb] * rg, a = fexp(la), xcv = XT[tr * 68 + j];
                const float u = sqrtf(fmaxf(1.0f - a * a, 0.f)) * ig * xcv;
                AT[tr * 68 + j] = a; XT[tr * 68 + j] = u; } }
        LDS_WAIT(); asm volatile("" ::: "memory");
        { const int c = 64 * g + lane;
            if (!samp) { float h = 0.f, P = 1.f;
#pragma unroll 8
                for (int tr = 0; tr < 32; ++tr) { const float a = AT[tr * 68 + lane], u = XT[tr * 68 + lane]; h = a * h + u; P *= a;
                    RGH[(size_t)(R0 + tr) * 512 + c] = h; RGP[(size_t)(R0 + tr) * 512 + c] = P; } }
            else { float h = 0.f; const int b0 = (R0 - MP) >> 3;
#pragma unroll 8
                for (int tr = 0; tr < 32; ++tr) { const int bb = b0 + (tr >> 3);
                    if ((tr & 7) == 0) h = AR.in[I_SRH][(size_t)bb * 512 + c];
                    const float a = AT[tr * 68 + lane], u = XT[tr * 68 + lane]; h = a * h + u;
                    const float gr = bf2f(Z[(size_t)(R0 + tr) * ZW + ZGR + c]);
                    G[(size_t)(R0 + tr) * D + 512 + c] = (bf16)f2bf(h * gelu_tanh(gr));
                    if ((tr & 7) == 7) F.out[O_SRH + (size_t)bb * 512 + c] = h; } } }
        LDS_WAIT(); asm volatile("" ::: "memory");
    }
    { const int gt = F.vcu * NTHREADS + F.tid, NT = F.G * NTHREADS;
        for (int e = gt; e < NSEQ * 3 * 512; e += NT) { const int c = e & 511, j = (e >> 9) % 3, s = e / 1536;
            if (s < NPB) F.out[O_PRC + ((size_t)s * 3 + j) * 512 + c] = bf2f(Z[((size_t)s * PSEQ + PSEQ - 3 + j) * ZW + ZXR + c]);
            else { const int b = s - NPB; F.out[O_SRC + ((size_t)b * 3 + j) * 512 + c] = bf2f(Z[((size_t)MP + (size_t)b * SSEQ + SSEQ - 3 + j) * ZW + ZXR + c]); } } }
}

DI void ml2_scan(Frame& F, const Args& AR) {
    float* CST = (float*)(F.ws + WS_CST); float* NST = (float*)(F.ws + WS_NST); float* MST = (float*)(F.ws + WS_MST);
    for (int vb = F.vcu; vb < 256; vb += F.G) {
        const int bh = vb >> 3, e0 = ((vb & 7) * NTHREADS + F.tid) * 4;
        float m = 0.f; f32x4 C = (f32x4){0.f, 0.f, 0.f, 0.f};
        const bool nthr = (vb & 7) == 0 && F.tid < 128; float n = 0.f;
        f32x4 cl[16]; float ml[16], bl[16], nl[16];
#pragma unroll
        for (int c = 0; c < 16; ++c) { const int item = bh * 16 + c; cl[c] = *(const f32x4*)(CST + (size_t)item * 16384 + e0); ml[c] = MST[item * 4 + 0]; bl[c] = MST[item * 4 + 1];
            nl[c] = nthr ? NST[item * 128 + F.tid] : 0.f; }
#pragma unroll
        for (int c = 0; c < 16; ++c) { const int item = bh * 16 + c;
            *(f32x4*)(CST + (size_t)item * 16384 + e0) = C;
            const float mn = fmaxf(bl[c] + m, ml[c]), w0 = fexp(bl[c] + m - mn), w1 = fexp(ml[c] - mn);
            C = C * w0 + cl[c] * w1;
            if (nthr) { NST[item * 128 + F.tid] = n; n = n * w0 + nl[c] * w1; if (F.tid == 0) MST[item * 4 + 2] = m; }
            m = mn; }
        *(f32x4*)(F.out + O_PMC + (size_t)bh * 16384 + e0) = C;
        if (nthr) { F.out[O_PMN + bh * 128 + F.tid] = n; if (F.tid == 0) F.out[O_PMM + bh] = m; }
    }
}
DI void rg2_carry(Frame& F, const Args& AR) {
    const float* RGH = (const float*)(F.ws + WS_RGH); const float* RGP = (const float*)(F.ws + WS_RGP); float* CARRY = (float*)(F.ws + WS_CARRY);
    const int gt = F.vcu * NTHREADS + F.tid, NT = F.G * NTHREADS;
    for (int e = gt; e < NPB * 512; e += NT) { const int b = e >> 9, c = e & 511; float H = 0.f;
        for (int k0 = 0; k0 < 64; k0 += 16) { float pe[16], he[16];
#pragma unroll
            for (int k = 0; k < 16; ++k) { const size_t row = (size_t)b * PSEQ + 32 * (k0 + k) + 31; pe[k] = RGP[row * 512 + c]; he[k] = RGH[row * 512 + c]; }
#pragma unroll
            for (int k = 0; k < 16; ++k) { CARRY[((size_t)b * 64 + k0 + k) * 512 + c] = H; H = pe[k] * H + he[k]; } }
        F.out[O_PRH + (size_t)b * 512 + c] = H; }
}
DI void rg2_apply(Frame& F, const Args& AR) {
    const bf16* Z = (const bf16*)(F.ws + WS_Z); bf16* G = (bf16*)(F.ws + WS_H);
    const float* RGH = (const float*)(F.ws + WS_RGH); const float* RGP = (const float*)(F.ws + WS_RGP); const float* CARRY = (const float*)(F.ws + WS_CARRY);
    const int gt = F.vcu * NTHREADS + F.tid, NT = F.G * NTHREADS;
    for (int e = gt; e < MP * 64; e += NT) { const int row = e >> 6, c0 = (e & 63) * 8, b = row >> 11, tile = (row & (PSEQ - 1)) >> 5;
        const v4u gq = *(const v4u*)(Z + (size_t)row * ZW + ZGR + c0);
        const float gr[8] = {bflo(gq.x), bfhi(gq.x), bflo(gq.y), bfhi(gq.y), bflo(gq.z), bfhi(gq.z), bflo(gq.w), bfhi(gq.w)};
        const float* hp = RGH + (size_t)row * 512 + c0; const float* pp = RGP + (size_t)row * 512 + c0; const float* cp = CARRY + ((size_t)b * 64 + tile) * 512 + c0;
        float o[8];
#pragma unroll
        for (int q = 0; q < 2; ++q) { const f32x4 h4 = *(const f32x4*)(hp + 4 * q), p4 = *(const f32x4*)(pp + 4 * q), c4 = *(const f32x4*)(cp + 4 * q);
            const f32x4 hv = h4 + p4 * c4; o[4 * q] = hv.x * gelu_tanh(gr[4 * q]); o[4 * q + 1] = hv.y * gelu_tanh(gr[4 * q + 1]); o[4 * q + 2] = hv.z * gelu_tanh(gr[4 * q + 2]); o[4 * q + 3] = hv.w * gelu_tanh(gr[4 * q + 3]); }
        v4u w; w.x = pk2(o[0], o[1]); w.y = pk2(o[2], o[3]); w.z = pk2(o[4], o[5]); w.w = pk2(o[6], o[7]);
        *(v4u*)(G + (size_t)row * D + 512 + c0) = w; }
}

DI void ml3_prompt(Frame& F, const Args& AR) {
    const bf16* Z = (const bf16*)(F.ws + WS_Z); bf16* G = (bf16*)(F.ws + WS_H);
    const float* CST = (const float*)(F.ws + WS_CST); const float* NST = (const float*)(F.ws + WS_NST); const float* MST = (const float*)(F.ws + WS_MST);
    LAS bf16* Qs = (LAS bf16*)F.lds;
    LAS bf16* Ks = (LAS bf16*)(F.lds + 34816);
    LAS bf16* Vs = (LAS bf16*)(F.lds + 69632);
    LAS float* LF = (LAS float*)(F.lds + 102400);
    LAS float* BC = LF + 128;
    LAS float* GS = BC + 128;
    LAS float* MX = GS + 128;
    LAS float* N0 = MX + 128;
    LAS float* RA = N0 + 128;
    LAS float* RB = RA + 256;
    LAS float* OT = (LAS float*)F.lds;
    const int tid = F.tid, lane = F.lane, wave = F.wave, r = lane & 31, hh = lane >> 5;
    const int tb = wave >> 1, vh = wave & 1, t = tb * 32 + r;
    for (int item = F.vcu; item < 512; item += F.G) {
        const int b = item >> 6, h = (item >> 4) & 3, c = item & 15; const size_t row0 = (size_t)b * PSEQ + c * 128;
        const float m0 = MST[item * 4 + 2]; const float* C0 = CST + (size_t)item * 16384;
#pragma unroll
        for (int i = 0; i < 4; ++i) { const int e = tid + i * NTHREADS, s = e >> 4, c8 = (e & 15) * 8; const bf16* zr = Z + (row0 + s) * ZW + h * 128 + c8;
            *(LAS v4u*)(Qs + s * 136 + c8) = *(const v4u*)(zr + ZQ); *(LAS v4u*)(Ks + s * 136 + c8) = *(const v4u*)(zr + ZK); *(LAS v4u*)(Vs + s * 128 + c8) = *(const v4u*)(zr + ZV); }
        if (tid < 128) { LF[tid] = log_sigmoid(bf2f(Z[(row0 + tid) * ZW + ZFG + h]) + AR.in[I_BG][4 + h]); N0[tid] = NST[item * 128 + tid]; }
        __syncthreads();
        if (tid < 128) { float bs = 0.f; for (int s = 0; s <= tid; ++s) bs += LF[s];
            BC[tid] = bs; GS[tid] = bf2f(Z[(row0 + tid) * ZW + ZIG + h]) + AR.in[I_BG][h] - bs; }
        __syncthreads();
        if (tid < 128) { float mx = m0; for (int s = 0; s <= tid; ++s) mx = fmaxf(mx, GS[s]); MX[tid] = mx; }
        __syncthreads();
        const float mxt = MX[t], winter = fexp(m0 - mxt);
        bf16x8 bq[8];
#pragma unroll
        for (int ks = 0; ks < 8; ++ks) bq[ks] = *(const LAS bf16x8*)(Qs + t * 136 + 16 * ks + 8 * hh);
        bf16x8 pp[4][2]; float den = 0.f;
#pragma unroll
        for (int sb = 0; sb < 4; ++sb) {
            if (sb <= tb) { f32x16 sa;
#pragma unroll
                for (int i = 0; i < 16; ++i) sa[i] = 0.f;
#pragma unroll
                for (int ks = 0; ks < 8; ++ks) sa = MFMA32(*(const LAS bf16x8*)(Ks + (sb * 32 + r) * 136 + 16 * ks + 8 * hh), bq[ks], sa);
                float pv[16];
#pragma unroll
                for (int i = 0; i < 16; ++i) { const int s = sb * 32 + crow(i, hh); float v = sa[i] * MSCALE * fexp(GS[s] - mxt); if (s > t) v = 0.f; pv[i] = v; den += v; }
                pp[sb][0] = mk_frag(pk2(pv[0], pv[1]), pk2(pv[2], pv[3]), pk2(pv[4], pv[5]), pk2(pv[6], pv[7]));
                pp[sb][1] = mk_frag(pk2(pv[8], pv[9]), pk2(pv[10], pv[11]), pk2(pv[12], pv[13]), pk2(pv[14], pv[15]));
            } else { pp[sb][0] = mk_frag(0u, 0u, 0u, 0u); pp[sb][1] = mk_frag(0u, 0u, 0u, 0u); } }
        den += __shfl_xor(den, 32);
        float qn = 0.f;
#pragma unroll 8
        for (int k = 0; k < 64; ++k) qn += N0[hh * 64 + k] * bf2f(Qs[t * 136 + hh * 64 + k]);
        qn += __shfl_xor(qn, 32);
        const float dtot = den + winter * qn, denom = fmaxf(fabsf(dtot), fexp(-(BC[t] + mxt))), rden = 1.0f / denom;
        float hv[2][16];
#pragma unroll
        for (int q = 0; q < 2; ++q) { const int vb = vh * 2 + q; f32x16 an, ai;
#pragma unroll
            for (int i = 0; i < 16; ++i) { an[i] = 0.f; ai[i] = 0.f; }
#pragma unroll
            for (int sb = 0; sb < 4; ++sb) if (sb <= tb) {
#pragma unroll
                for (int s2 = 0; s2 < 2; ++s2) { unsigned vw[8];
#pragma unroll
                    for (int j = 0; j < 8; ++j) vw[j] = Vs[(sb * 32 + 16 * s2 + 8 * (j >> 2) + 4 * hh + (j & 3)) * 128 + vb * 32 + r];
                    an = MFMA32(mk_frag(vw[0] | (vw[1] << 16), vw[2] | (vw[3] << 16), vw[4] | (vw[5] << 16), vw[6] | (vw[7] << 16)), pp[sb][s2], an); } }
#pragma unroll
            for (int ks = 0; ks < 8; ++ks) { const float* cp = C0 + (size_t)(vb * 32 + r) * 128 + 16 * ks + 8 * hh; const f32x4 c0 = *(const f32x4*)cp, c1 = *(const f32x4*)(cp + 4);
                ai = MFMA32(mk_frag(pk2(c0.x, c0.y), pk2(c0.z, c0.w), pk2(c1.x, c1.y), pk2(c1.z, c1.w)), bq[ks], ai); }
#pragma unroll
            for (int i = 0; i < 16; ++i) hv[q][i] = (an[i] + winter * ai[i]) * rden; }
        float s1 = 0.f;
#pragma unroll
        for (int q = 0; q < 2; ++q)
#pragma unroll
            for (int i = 0; i < 16; ++i) s1 += hv[q][i];
        s1 += __shfl_xor(s1, 32);
        if (hh == 0) RA[vh * 128 + t] = s1;
        __syncthreads();
        const float mean = (RA[t] + RA[128 + t]) * (1.f / 128.f); float s2 = 0.f;
#pragma unroll
        for (int q = 0; q < 2; ++q)
#pragma unroll
            for (int i = 0; i < 16; ++i) { hv[q][i] -= mean; s2 += hv[q][i] * hv[q][i]; }
        s2 += __shfl_xor(s2, 32);
        if (hh == 0) RB[vh * 128 + t] = s2;
        __syncthreads();
        const float rstd = 1.f / sqrtf((RB[t] + RB[128 + t]) * (1.f / 128.f) + HEAD_EPS);
#pragma unroll
        for (int q = 0; q < 2; ++q)
#pragma unroll
            for (int i = 0; i < 16; ++i) OT[t * 132 + (vh * 2 + q) * 32 + crow(i, hh)] = hv[q][i] * rstd;
        __syncthreads();
        { const int tt = tid >> 2, v0 = (tid & 3) * 32; const size_t row = row0 + tt;
#pragma unroll
            for (int q = 0; q < 4; ++q) { const int v = v0 + 8 * q; const v4u oq = *(const v4u*)(Z + row * ZW + ZO + h * 128 + v);
                const float og[8] = {bflo(oq.x), bfhi(oq.x), bflo(oq.y), bfhi(oq.y), bflo(oq.z), bfhi(oq.z), bflo(oq.w), bfhi(oq.w)};
                const f32x4 g0 = *(const f32x4*)(AR.in[I_MNG] + h * 128 + v), g1 = *(const f32x4*)(AR.in[I_MNG] + h * 128 + v + 4);
                const f32x4 x0 = *(const LAS f32x4*)(OT + tt * 132 + v), x1 = *(const LAS f32x4*)(OT + tt * 132 + v + 4);
                v4u w; w.x = pk2(x0.x * g0.x * fsig(og[0]), x0.y * g0.y * fsig(og[1])); w.y = pk2(x0.z * g0.z * fsig(og[2]), x0.w * g0.w * fsig(og[3]));
                w.z = pk2(x1.x * g1.x * fsig(og[4]), x1.y * g1.y * fsig(og[5])); w.w = pk2(x1.z * g1.z * fsig(og[6]), x1.w * g1.w * fsig(og[7]));
                *(v4u*)(G + row * D + h * 128 + v) = w; } }
        __syncthreads();
    }
}

constexpr int TC = 32;
constexpr int RW_ARR = TC * 64;
constexpr int RW_BUF_FLOATS = 6 * RW_ARR + 2 * TC;
struct RwRaw { v2u r, k, v, w, a, g; };
DI void rw_load(RwRaw& x, const bf16* RK, const bf16* WAG, size_t row, size_t row_safe, int h, int k4, bool valid) {
    const size_t rr = valid ? row : row_safe;
    const bf16* p = RK + rr * RKW + h * 64 + k4; const bf16* q = WAG + rr * WAGW + h * 64 + k4;
    x.r = *(const v2u*)p; x.k = *(const v2u*)(p + 1024); x.v = *(const v2u*)(p + 2048); x.w = *(const v2u*)q; x.a = *(const v2u*)(q + 1024); x.g = *(const v2u*)(q + 2048);
}
DI void un4(const v2u u, float (&f)[4]) { f[0] = bflo(u.x); f[1] = bfhi(u.x); f[2] = bflo(u.y); f[3] = bfhi(u.y); }
DI float rw_prep(const RwRaw& x, LAS float* buf, int tok, int k4, const float (&kkw)[4], const float (&kaw)[4], const float (&rkw)[4]) {
    float r[4], k[4], v[4], w[4], a[4]; un4(x.r, r); un4(x.k, k); un4(x.v, v); un4(x.w, w); un4(x.a, a);
    float kk[4], ss = 0.f, bs = 0.f, km[4];
#pragma unroll
    for (int j = 0; j < 4; ++j) { kk[j] = k[j] * kkw[j]; ss += kk[j] * kk[j]; km[j] = k[j] * (1.0f + (a[j] - 1.0f) * kaw[j]); bs += r[j] * km[j] * rkw[j]; }
    ss = sum16(ss); bs = sum16(bs);
    const float inv = 1.0f / fmaxf(sqrtf(ss), 1e-12f);
    f32x4 o0, o1, o2, o3, o4, o5; float br = 0.f, kr = 0.f;
#pragma unroll
    for (int j = 0; j < 4; ++j) { const float kn = kk[j] * inv, dc = __builtin_amdgcn_exp2f(w[j]); o0[j] = kn; o1[j] = kn * a[j]; o2[j] = km[j]; o3[j] = dc; o4[j] = dc * r[j]; o5[j] = v[j];
        br += kn * a[j] * r[j]; kr += km[j] * r[j]; }
    br = sum16(br); kr = sum16(kr);
    LAS float* p = buf + tok * 64 + k4;
    *(LAS f32x4*)p = o0; *(LAS f32x4*)(p + RW_ARR) = o1; *(LAS f32x4*)(p + 2 * RW_ARR) = o2; *(LAS f32x4*)(p + 3 * RW_ARR) = o3;
    *(LAS f32x4*)(p + 4 * RW_ARR) = o4; *(LAS f32x4*)(p + 5 * RW_ARR) = o5;
    if (k4 == 0) *(LAS f32x2*)(buf + 6 * RW_ARR + 2 * tok) = (f32x2){br, kr};
    return bs;
}
#define BAR_LDS() do { asm volatile("s_waitcnt lgkmcnt(0)" ::: "memory"); __builtin_amdgcn_s_barrier(); asm volatile("" ::: "memory"); } while (0)
#define NOPK(x) asm volatile("" : "+v"(x))
DI void sum8x2(float& a, float& b) {
    asm volatile("s_nop 1\n\t"
                 "v_add_f32_dpp %0, %0, %0 quad_perm:[1,0,3,2] row_mask:0xf bank_mask:0xf\n\tv_add_f32_dpp %1, %1, %1 quad_perm:[1,0,3,2] row_mask:0xf bank_mask:0xf\n\ts_nop 0\n\t"
                 "v_add_f32_dpp %0, %0, %0 quad_perm:[2,3,0,1] row_mask:0xf bank_mask:0xf\n\tv_add_f32_dpp %1, %1, %1 quad_perm:[2,3,0,1] row_mask:0xf bank_mask:0xf\n\ts_nop 0\n\t"
                 "v_add_f32_dpp %0, %0, %0 row_half_mirror row_mask:0xf bank_mask:0xf\n\tv_add_f32_dpp %1, %1, %1 row_half_mirror row_mask:0xf bank_mask:0xf\n\ts_nop 0"
                 : "+v"(a), "+v"(b));
}
struct StepV { f32x4 ka, kb, ba, bb, ma, mb, da, db, ea, eb; float vv; f32x2 sc; };
DI void ld_step(StepV& s, const LAS float* cur, int tk, int p, int row) {
    const LAS float* q = cur + tk * 64 + 8 * p;
    s.ka = *(const LAS f32x4*)q; s.kb = *(const LAS f32x4*)(q + 4); s.ba = *(const LAS f32x4*)(q + RW_ARR); s.bb = *(const LAS f32x4*)(q + RW_ARR + 4);
    s.ma = *(const LAS f32x4*)(q + 2 * RW_ARR); s.mb = *(const LAS f32x4*)(q + 2 * RW_ARR + 4); s.da = *(const LAS f32x4*)(q + 3 * RW_ARR); s.db = *(const LAS f32x4*)(q + 3 * RW_ARR + 4);
    s.ea = *(const LAS f32x4*)(q + 4 * RW_ARR); s.eb = *(const LAS f32x4*)(q + 4 * RW_ARR + 4);
    s.vv = cur[5 * RW_ARR + tk * 64 + row]; s.sc = *(const LAS f32x2*)(cur + 6 * RW_ARR + 2 * tk);
}
DI void ld_step_asm(StepV& s, unsigned aq, unsigned av, unsigned asc) {
    asm volatile("ds_read_b128 %0, %12\n\tds_read_b128 %1, %12 offset:16\n\tds_read_b128 %2, %12 offset:8192\n\tds_read_b128 %3, %12 offset:8208\n\t"
                 "ds_read_b128 %4, %12 offset:16384\n\tds_read_b128 %5, %12 offset:16400\n\tds_read_b128 %6, %12 offset:24576\n\tds_read_b128 %7, %12 offset:24592\n\t"
                 "ds_read_b128 %8, %12 offset:32768\n\tds_read_b128 %9, %12 offset:32784\n\tds_read_b32 %10, %13\n\tds_read_b64 %11, %14"
                 : "=&v"(s.ka), "=&v"(s.kb), "=&v"(s.ba), "=&v"(s.bb), "=&v"(s.ma), "=&v"(s.mb), "=&v"(s.da), "=&v"(s.db), "=&v"(s.ea), "=&v"(s.eb), "=&v"(s.vv), "=&v"(s.sc)
                 : "v"(aq), "v"(av), "v"(asc) : "memory");
}
DI void wait_step(StepV& s) {
    asm volatile("s_waitcnt lgkmcnt(0)" : "+v"(s.ka), "+v"(s.kb), "+v"(s.ba), "+v"(s.bb), "+v"(s.ma), "+v"(s.mb), "+v"(s.da), "+v"(s.db), "+v"(s.ea), "+v"(s.eb), "+v"(s.vv), "+v"(s.sc) :: "memory");
}
template <int N> DI void wait_stepn(StepV& s) {
    asm volatile("s_waitcnt lgkmcnt(%12)" : "+v"(s.ka), "+v"(s.kb), "+v"(s.ba), "+v"(s.bb), "+v"(s.ma), "+v"(s.mb), "+v"(s.da), "+v"(s.db), "+v"(s.ea), "+v"(s.eb), "+v"(s.vv), "+v"(s.sc) : "n"(N) : "memory");
}
DI void rw_step(float (&S)[8], const StepV& c, LAS float* ydst, bool wr) {
    const float kk[8] = {c.ka.x, c.ka.y, c.ka.z, c.ka.w, c.kb.x, c.kb.y, c.kb.z, c.kb.w}, ee[8] = {c.ea.x, c.ea.y, c.ea.z, c.ea.w, c.eb.x, c.eb.y, c.eb.z, c.eb.w};
    const float dd[8] = {c.da.x, c.da.y, c.da.z, c.da.w, c.db.x, c.db.y, c.db.z, c.db.w}, bb[8] = {c.ba.x, c.ba.y, c.ba.z, c.ba.w, c.bb.x, c.bb.y, c.bb.z, c.bb.w};
    const float mm[8] = {c.ma.x, c.ma.y, c.ma.z, c.ma.w, c.mb.x, c.mb.y, c.mb.z, c.mb.w};
    float a0 = S[0] * kk[0], a1 = S[4] * kk[4], y0 = S[0] * ee[0], y1 = S[4] * ee[4];
#pragma unroll
    for (int j = 1; j < 4; ++j) { a0 = fmaf(S[j], kk[j], a0); a1 = fmaf(S[4 + j], kk[4 + j], a1); y0 = fmaf(S[j], ee[j], y0); y1 = fmaf(S[4 + j], ee[4 + j], y1); }
    float a = a0 + a1, y = y0 + y1; NOPK(a); NOPK(y);
    sum8x2(a, y);
    const float sa = -a, v = c.vv;
#pragma unroll
    for (int j = 0; j < 8; ++j) { float t = S[j] * dd[j]; t = fmaf(mm[j], v, t); t = fmaf(bb[j], sa, t); NOPK(t); S[j] = t; }
    if (wr) *ydst = fmaf(v, c.sc.y, fmaf(sa, c.sc.x, y));
    asm volatile("" ::: "memory");
}
DI void rw_prompt_half(Frame& F, const Args& AR, int b, int h, int half, float* Sout) {
    const bf16* RK = (const bf16*)(F.ws + WS_RK); const bf16* WAG = (const bf16*)(F.ws + WS_WAG); bf16* G = (bf16*)(F.ws + WS_H); float* BN = (float*)(F.ws + WS_BN);
    LAS float* BUF = (LAS float*)F.lds;
    LAS float* YB = BUF + 2 * RW_BUF_FLOATS;
    const int tid = F.tid; const size_t row0 = (size_t)b * PSEQ;
    constexpr int nch = PSEQ / TC;
    if (tid < 256) {
        const int rl = tid >> 3, row = 32 * half + rl, p = tid & 7;
        float S[8];
#pragma unroll
        for (int j = 0; j < 8; ++j) S[j] = 0.f;
#ifdef PROBE_SHADOW
        float S2[8];
#pragma unroll
        for (int j = 0; j < 8; ++j) S2[j] = 1.f;
#endif
        BAR_LDS();
        for (int ch = 0; ch < nch; ++ch) {
            const LAS float* cur = BUF + (ch & 1) * RW_BUF_FLOATS; LAS float* yb = YB + (ch & 1) * (TC * 32);
            const unsigned cb = (unsigned)(size_t)cur, aq = cb + 32u * p, av = cb + 40960u + 4u * row, asc = cb + 49152u;
            StepV st[3];
            ld_step_asm(st[0], aq, av, asc); ld_step_asm(st[1], aq + 256u, av + 256u, asc + 8u); wait_stepn<12>(st[0]);
#pragma unroll
            for (int tk = 0; tk < TC; ++tk) {
                if (tk + 2 < TC) ld_step_asm(st[(tk + 2) % 3], aq + 256u * (tk + 2), av + 256u * (tk + 2), asc + 8u * (tk + 2));
                rw_step(S, st[tk % 3], yb + tk * 32 + rl, p == 0);
                if (tk + 2 < TC) wait_stepn<13>(st[(tk + 1) % 3]); else if (tk + 1 < TC) wait_stepn<1>(st[(tk + 1) % 3]);
            }
            BAR_LDS();
        }
#ifdef PROBE_SHADOW
#pragma unroll
        for (int j = 0; j < 8; ++j) asm volatile("" :: "v"(S2[j]));
#endif
        *(f32x4*)(Sout + row * 64 + 8 * p) = (f32x4){S[0], S[1], S[2], S[3]}; *(f32x4*)(Sout + row * 64 + 8 * p + 4) = (f32x4){S[4], S[5], S[6], S[7]};
        BAR_LDS();
    } else {
        const int ht = tid - 256, tk0 = ht >> 4, k4 = (ht & 15) * 4;
        const int yt = ht >> 3, yv4 = (ht & 7) * 4;
        float kkw[4], kaw[4], rkw[4];
#pragma unroll
        for (int j = 0; j < 4; ++j) { const int c = h * 64 + k4 + j; kkw[j] = AR.in[I_KK][c]; kaw[j] = AR.in[I_KA][c]; rkw[j] = AR.in[I_RK][c]; }
        RwRaw raw[2];
#pragma unroll
        for (int i = 0; i < 2; ++i) { rw_load(raw[i], RK, WAG, row0 + tk0 + 16 * i, row0, h, k4, true);
            const float bn = rw_prep(raw[i], BUF, tk0 + 16 * i, k4, kkw, kaw, rkw); if (half == 0 && k4 == 0) BN[(row0 + tk0 + 16 * i) * 16 + h] = bn; }
#pragma unroll
        for (int i = 0; i < 2; ++i) rw_load(raw[i], RK, WAG, row0 + TC + tk0 + 16 * i, row0, h, k4, true);
        BAR_LDS();
        for (int ch = 0; ch < nch; ++ch) {
            const int base = ch * TC;
            if (ch > 0) { const f32x4 y4 = *(const LAS f32x4*)(YB + ((ch - 1) & 1) * (TC * 32) + yt * 32 + yv4);
                v2u w; w.x = pk2(y4.x, y4.y); w.y = pk2(y4.z, y4.w); *(v2u*)(G + (row0 + base - TC + yt) * D + h * 64 + 32 * half + yv4) = w; }
            if (ch + 1 < nch) {
#pragma unroll
                for (int i = 0; i < 2; ++i) { const float bn = rw_prep(raw[i], BUF + ((ch + 1) & 1) * RW_BUF_FLOATS, tk0 + 16 * i, k4, kkw, kaw, rkw);
                    if (half == 0 && k4 == 0) BN[(row0 + base + TC + tk0 + 16 * i) * 16 + h] = bn; }
#pragma unroll
                for (int i = 0; i < 2; ++i) rw_load(raw[i], RK, WAG, row0 + base + 2 * TC + tk0 + 16 * i, row0, h, k4, base + 2 * TC < PSEQ);
            }
            BAR_LDS();
        }
        { const f32x4 y4 = *(const LAS f32x4*)(YB + ((nch - 1) & 1) * (TC * 32) + yt * 32 + yv4);
            v2u w; w.x = pk2(y4.x, y4.y); w.y = pk2(y4.z, y4.w); *(v2u*)(G + (row0 + PSEQ - TC + yt) * D + h * 64 + 32 * half + yv4) = w; }
        BAR_LDS();
    }
}
DI void rw_gn_pass(Frame& F, const Args& AR) {
    const bf16* RK = (const bf16*)(F.ws + WS_RK); const bf16* WAG = (const bf16*)(F.ws + WS_WAG); bf16* G = (bf16*)(F.ws + WS_H); const float* BN = (const float*)(F.ws + WS_BN);
    const int gt = F.vcu * NTHREADS + F.tid, NT = F.G * NTHREADS;
    for (int e = gt; e < MP * 256; e += NT) { const int row = e >> 8, h = (e >> 4) & 15, k4 = (e & 15) * 4, c = h * 64 + k4;
        bf16* gp = G + (size_t)row * D + c; float y[4], v[4], g[4]; un4(*(const v2u*)gp, y); un4(*(const v2u*)(RK + (size_t)row * RKW + 2048 + c), v); un4(*(const v2u*)(WAG + (size_t)row * WAGW + 2048 + c), g);
        const f32x4 lg = *(const f32x4*)(AR.in[I_LXG] + c), lb = *(const f32x4*)(AR.in[I_LXB] + c); const float bn = BN[row * 16 + h];
        const float mean = sum16((y[0] + y[1]) + (y[2] + y[3])) * (1.f / 64.f);
        const float d0 = y[0] - mean, d1 = y[1] - mean, d2 = y[2] - mean, d3 = y[3] - mean;
        const float rstd = __builtin_amdgcn_rsqf(sum16((d0 * d0 + d1 * d1) + (d2 * d2 + d3 * d3)) * (1.f / 64.f) + RW_EPS);
        v2u w; w.x = pk2((d0 * rstd * lg.x + lb.x + bn * v[0]) * g[0], (d1 * rstd * lg.y + lb.y + bn * v[1]) * g[1]);
        w.y = pk2((d2 * rstd * lg.z + lb.z + bn * v[2]) * g[2], (d3 * rstd * lg.w + lb.w + bn * v[3]) * g[3]);
        *(v2u*)gp = w; }
}
constexpr int RS_WAVE_BYTES = 16640;
DI void ld8b(float (&f)[8], const bf16* p) { const v4u q = *(const v4u*)p; f[0] = bflo(q.x); f[1] = bfhi(q.x); f[2] = bflo(q.y); f[3] = bfhi(q.y); f[4] = bflo(q.z); f[5] = bfhi(q.z); f[6] = bflo(q.w); f[7] = bfhi(q.w); }
DI void st8(LAS float* p, const float (&f)[8]) { *(LAS f32x4*)p = (f32x4){f[0], f[1], f[2], f[3]}; *(LAS f32x4*)(p + 4) = (f32x4){f[4], f[5], f[6], f[7]}; }
DI void rw_sample_wave(Frame& F, const Args& AR, int item) {
    const bf16* RK = (const bf16*)(F.ws + WS_RK); const bf16* WAG = (const bf16*)(F.ws + WS_WAG); bf16* G = (bf16*)(F.ws + WS_H);
    const int lane = F.lane, b = item >> 4, h = item & 15; const size_t row0 = (size_t)MP + (size_t)b * SSEQ;
    LAS float* L = (LAS float*)(F.lds + F.wave * RS_WAVE_BYTES);
    { const int tok = lane >> 3, k8 = (lane & 7) * 8, c = h * 64 + k8;
        float r[8], k[8], v[8], w[8], a[8], g[8];
        { const bf16* p = RK + (row0 + tok) * RKW + c; const bf16* q = WAG + (row0 + tok) * WAGW + c; ld8b(r, p); ld8b(k, p + 1024); ld8b(v, p + 2048); ld8b(w, q); ld8b(a, q + 1024); ld8b(g, q + 2048); }
        float kkw[8], kaw[8], rkw[8]; ld8(kkw, AR.in[I_KK] + c); ld8(kaw, AR.in[I_KA] + c); ld8(rkw, AR.in[I_RK] + c);
        float kk[8], km[8], ss = 0.f, bs = 0.f;
#pragma unroll
        for (int j = 0; j < 8; ++j) { kk[j] = k[j] * kkw[j]; ss += kk[j] * kk[j]; km[j] = k[j] * (1.0f + (a[j] - 1.0f) * kaw[j]); bs += r[j] * km[j] * rkw[j]; }
        ss = sum8(ss); bs = sum8(bs);
        const float inv = 1.0f / fmaxf(sqrtf(ss), 1e-12f);
        float o1[8], o3[8], o4[8], br = 0.f, kr = 0.f;
#pragma unroll
        for (int j = 0; j < 8; ++j) { kk[j] *= inv; o1[j] = kk[j] * a[j]; o3[j] = __builtin_amdgcn_exp2f(w[j]); o4[j] = o3[j] * r[j]; br += o1[j] * r[j]; kr += km[j] * r[j]; }
        br = sum8(br); kr = sum8(kr);
        LAS float* p = L + tok * 64 + k8;
        st8(p, kk); st8(p + 512, o1); st8(p + 1024, km); st8(p + 1536, o3); st8(p + 2048, o4); st8(p + 2560, v); st8(p + 3072, g);
        if (k8 == 0) { L[3584 + 2 * tok] = br; L[3584 + 2 * tok + 1] = kr; L[3600 + tok] = bs; } }
    float S[64];
    { const float* sp = AR.in[I_SWKV] + (size_t)item * 4096 + lane * 64;
#pragma unroll
        for (int j = 0; j < 16; ++j) { const f32x4 q = *(const f32x4*)(sp + 4 * j); S[4 * j] = q.x; S[4 * j + 1] = q.y; S[4 * j + 2] = q.z; S[4 * j + 3] = q.w; } }
    LDS_WAIT(); asm volatile("" ::: "memory");
    LAS float* YS = L + 3616;
#pragma unroll 1
    for (int tk = 0; tk < SSEQ; ++tk) { const LAS float* q = L + tk * 64;
        float a0 = 0.f, a1 = 0.f, y0 = 0.f, y1 = 0.f;
#pragma unroll
        for (int c4 = 0; c4 < 16; ++c4) { const f32x4 kq = *(const LAS f32x4*)(q + 4 * c4), eq = *(const LAS f32x4*)(q + 2048 + 4 * c4);
            a0 = fmaf(S[4 * c4], kq.x, a0); a1 = fmaf(S[4 * c4 + 1], kq.y, a1); a0 = fmaf(S[4 * c4 + 2], kq.z, a0); a1 = fmaf(S[4 * c4 + 3], kq.w, a1);
            y0 = fmaf(S[4 * c4], eq.x, y0); y1 = fmaf(S[4 * c4 + 1], eq.y, y1); y0 = fmaf(S[4 * c4 + 2], eq.z, y0); y1 = fmaf(S[4 * c4 + 3], eq.w, y1); }
        const float sa = -(a0 + a1), v = q[2560 + lane]; const f32x2 sc = *(const LAS f32x2*)(L + 3584 + 2 * tk);
#pragma unroll
        for (int c4 = 0; c4 < 16; ++c4) { const f32x4 dq = *(const LAS f32x4*)(q + 1536 + 4 * c4), bq = *(const LAS f32x4*)(q + 512 + 4 * c4), mq = *(const LAS f32x4*)(q + 1024 + 4 * c4);
            S[4 * c4] = fmaf(bq.x, sa, fmaf(mq.x, v, S[4 * c4] * dq.x)); S[4 * c4 + 1] = fmaf(bq.y, sa, fmaf(mq.y, v, S[4 * c4 + 1] * dq.y));
            S[4 * c4 + 2] = fmaf(bq.z, sa, fmaf(mq.z, v, S[4 * c4 + 2] * dq.z)); S[4 * c4 + 3] = fmaf(bq.w, sa, fmaf(mq.w, v, S[4 * c4 + 3] * dq.w)); }
        YS[tk * 64 + lane] = fmaf(v, sc.y, fmaf(sa, sc.x, y0 + y1)); }
    { float* sp = F.out + O_SWKV + (size_t)item * 4096 + lane * 64;
#pragma unroll
        for (int j = 0; j < 16; ++j) *(f32x4*)(sp + 4 * j) = (f32x4){S[4 * j], S[4 * j + 1], S[4 * j + 2], S[4 * j + 3]}; }
    LDS_WAIT(); asm volatile("" ::: "memory");
    { const float lg = AR.in[I_LXG][h * 64 + lane], lb = AR.in[I_LXB][h * 64 + lane];
#pragma unroll 1
        for (int tk = 0; tk < SSEQ; ++tk) { const float y = YS[tk * 64 + lane];
            const float mean = wave_sum(y) * (1.f / 64.f), d = y - mean, rstd = __builtin_amdgcn_rsqf(wave_sum(d * d) * (1.f / 64.f) + RW_EPS);
            const float o = (d * rstd * lg + lb + L[3600 + tk] * L[2560 + tk * 64 + lane]) * L[3072 + tk * 64 + lane];
            G[(row0 + tk) * D + h * 64 + lane] = (bf16)f2bf(o); } }
    LDS_WAIT(); asm volatile("" ::: "memory");
}
#ifndef PROBE_RW
#define PROBE_RW 0
#endif
DI void rwkv_scan(Frame& F, const Args& AR) {
    for (int rep = 0; rep < (PROBE_RW == 1 ? 2 : 1); ++rep)
    for (int it = F.vcu; it < NPB * 16 * 2; it += F.G) { const int bh = it >> 1, b = bh >> 4, h = bh & 15;
        rw_prompt_half(F, AR, b, h, it & 1, F.out + O_PWKV + (size_t)bh * 4096); }
    __syncthreads();
    for (int rep = 0; rep < (PROBE_RW == 2 ? 2 : 1); ++rep)
    for (int item = F.vcu * NWAVES + F.wave; item < NSB * 16; item += F.G * NWAVES) rw_sample_wave(F, AR, item);
}

#ifndef MK_N_LAUNCHES
#define MK_N_LAUNCHES 1
#endif
#ifdef PROBE_DUP_PH
constexpr int NPHASES = 28;
#else
constexpr int NPHASES = 27;
#endif
enum { K_P0 = 0, K_MODX, K_UP, K_RESID, K_LN, K_WIN, K_MIXA, K_MIXB, K_MIXC, K_R1, K_R2, K_R3, K_MOD, K_R3B };

__global__ void __launch_bounds__(NTHREADS, 2) mega_fwd(Args AR) {
    extern __shared__ __attribute__((aligned(16))) unsigned char lds[];
    Frame F;
    F.lds = (LAS unsigned char*)lds;
    F.MISC = (volatile LAS unsigned*)(F.lds + MISC_OFF);
    F.tid = threadIdx.x; F.lane = F.tid & 63; F.wave = __builtin_amdgcn_readfirstlane(F.tid >> 6);
    F.G = gridDim.x; { const int bx = blockIdx.x; F.vcu = (F.G % 8 == 0) ? (bx % 8) * (F.G / 8) + bx / 8 : bx; }
    F.ws = AR.ws; F.out = AR.out; F.ctl = (gu32*)(AR.ws + WS_CTL);
    for (int u = F.tid; u < (LDS_BYTES - LDSCTL_OFF) / 4; u += NTHREADS) ((LAS unsigned*)(F.lds + LDSCTL_OFF))[u] = 0u;
    __syncthreads();
    const int lo = AR.ph_lo, hi = AR.ph_hi;
    XcdBarrier bar; bar.bar = (unsigned*)(F.ctl + CW_BAR); bar.x = 0; bar.st = nullptr;
    if (hi - lo > 1) bar = xcd_barrier_post((unsigned*)(F.ctl + CW_BAR), F.MISC + 8);

#ifndef PROBE_DUP_PH
#define PROBE_DUP_PH 1000
#endif
    for (int phs = lo; phs < hi; ++phs) {
        const int ph = phs > PROBE_DUP_PH ? phs - 1 : phs; const bool dupfirst = (phs == PROBE_DUP_PH);
        float* X = F.out + O_Y; const float* mod = (const float*)(F.ws + WS_MOD); bf16* H = (bf16*)(F.ws + WS_H);
        int kind = K_LN, f = 0, l = 0, sub = 0, js = 0, first = 0, mode = 0, lm = 0, which = 0, fin = 0;
        switch (ph == 0 ? 0 : (ph == 1 ? 100 : (ph <= 20 ? ph - 1 : (ph == 21 ? 101 : ph - 2)))) {
            case 0: kind = K_P0; break;
            case 100: kind = K_MOD; break;
            case 101: kind = K_R3B; break;
            case 1: kind = K_MODX; break;
            case 2: kind = K_UP; f = 0; break;
            case 3: kind = K_RESID; which = 0; f = 0; l = 0; js = 0; first = 1; break;
            case 4: kind = K_LN; l = 0; sub = 0; lm = 0; js = 3; mode = 0; break;
            case 5: kind = K_WIN; break;
            case 6: kind = K_MIXA; break;
            case 7: kind = K_MIXB; break;
            case 8: kind = K_MIXC; break;
            case 9: kind = K_RESID; which = 1; l = 0; js = 3; break;
            case 10: kind = K_LN; l = 0; sub = 1; lm = 0; js = 6; mode = 0; break;
            case 11: kind = K_UP; f = 1; break;
            case 12: kind = K_RESID; which = 0; f = 1; l = 0; js = 6; break;
            case 13: kind = K_LN; l = 0; sub = 2; lm = 1; js = 0; mode = 0; break;
            case 14: kind = K_UP; f = 2; break;
            case 15: kind = K_RESID; which = 0; f = 2; l = 1; js = 0; break;
            case 16: kind = K_LN; l = 1; sub = 0; lm = 1; js = 3; mode = 1; break;
            case 17: kind = K_R1; break;
            case 18: kind = K_R2; break;
            case 19: kind = K_R3; break;
            case 20: kind = K_RESID; which = 2; l = 1; js = 3; break;
            case 21: kind = K_LN; l = 1; sub = 1; lm = 1; js = 6; mode = 0; break;
            case 22: kind = K_UP; f = 3; break;
            case 23: kind = K_RESID; which = 0; f = 3; l = 1; js = 6; fin = 1; break;
            default: kind = K_LN; l = 1; sub = 2; lm = 1; js = 0; mode = 2; fin = 1; break;
        }
#ifndef PHMASK
#define PHMASK 0xFFFFF
#endif
        { int t_ = F.tid; asm volatile("" : "+v"(t_)); F.tid = t_; F.lane = t_ & 63; F.wave = __builtin_amdgcn_readfirstlane(t_ >> 6);

          int v_ = F.vcu; asm volatile("" : "+s"(v_)); F.vcu = v_; int g_ = F.G; asm volatile("" : "+s"(g_)); F.G = g_;
          unsigned l_ = (unsigned)(size_t)F.lds; asm volatile("" : "+s"(l_)); F.lds = (LAS unsigned char*)(size_t)l_; }
        switch (kind) {
            case K_P0: p0_sctab(F, AR); p0_weights(F, AR); break;
            case K_MOD: p0_mod(F, AR); break;
            case K_MODX: if ((PHMASK >> K_MODX) & 1) ln_pass(F, AR, 1, 0, 0, 0, 0, 0, 0, 0, 0, 0); break;
            case K_UP: if ((PHMASK >> K_UP) & 1) {
                pg8::Gemm g{H, (const bf16*)(F.ws + WS_W13) + (size_t)f * 5632 * 1024, M, 5632, 1024}; pg8::StaticOrder S; S.init(M, 5632, F.G, (int)blockIdx.x); S.ntk = 16;
                pg8::EpiSwiglu E{(bf16*)(F.ws + WS_HID), FF};
                pg8::gemm_phase<pg8::EpiSwiglu, pg8::StaticOrder, true, true>(F.lds, g, S, E, F.tid);
            } break;
            case K_RESID: if ((PHMASK >> K_RESID) & 1) {
                const bf16* A = which == 0 ? (const bf16*)(F.ws + WS_HID) : H; const int K = which == 0 ? FF : 1024;
                const bf16* Bt = which == 0 ? (const bf16*)(F.ws + WS_W2) + (size_t)f * 1024 * FF : (which == 1 ? (const bf16*)(F.ws + WS_WOUT) : (const bf16*)(F.ws + WS_WO));
                const int nsp = (F.G == 256) ? (which == 0 ? 11 : 4) : 0;
                pg8::Gemm g{A, Bt, M, 1024, K}; SplitOrder S; S.base.init(nsp ? MP : M, 1024, F.G, (int)blockIdx.x); S.base.ntk = K / 64; S.S = nsp;
                EpiResid E{AR, F.out, F.ws, (first ? 1 : 0) | (l << 1) | ((js + 2) << 2) | (which == 0 ? 0 : 64) | (dupfirst ? 128 : 0) | (fin ? 256 : 0)};
                pg8::gemm_phase<EpiResid, SplitOrder, true, true>(F.lds, g, S, E, F.tid);
                if (fin && nsp) {
                    const v4u* src = (const v4u*)((unsigned char*)F.out + XB_OFF + (size_t)MP * 2048); v4u* dst = (v4u*)(F.ws + WS_ZF + (size_t)MP * 2048);
                    for (int e = F.vcu * NTHREADS + F.tid; e < MS * 128; e += F.G * NTHREADS) dst[e] = src[e]; }
            } break;
            case K_LN: if ((PHMASK >> K_LN) & 1) ln_pass(F, AR, 0, 1, l, sub, lm, js, mode, (F.G == 256) ? (sub == 1 ? 4 : 11) : 0, ph == 5, fin); break;
            case K_WIN: if ((PHMASK >> K_WIN) & 1) {
                pg8::Gemm g{H, (const bf16*)(F.ws + WS_WIN), M, ZW, 1024}; pg8::StaticOrder S; S.init(M, ZW, F.G, (int)blockIdx.x); S.ntk = 16;
                pg8::EpiStore E{(bf16*)(F.ws + WS_Z), ZW, 1000, nullptr, 0};
                pg8::gemm_phase<pg8::EpiStore, pg8::StaticOrder, true, true>(F.lds, g, S, E, F.tid);
            } break;
            case K_R1: if ((PHMASK >> K_R1) & 1) {
                pg8::Gemm g{(const bf16*)(F.ws + WS_A2), (const bf16*)(F.ws + WS_WRK), M, 3328, 2048}; pg8::StaticOrder S; S.init(M, 3328, F.G, (int)blockIdx.x); S.ntk = 32;
                pg8::EpiStore E{(bf16*)(F.ws + WS_RK), RKW, 12, (bf16*)(F.ws + WS_A3), 256};
                pg8::gemm_phase<pg8::EpiStore, pg8::StaticOrder, true, true>(F.lds, g, S, E, F.tid);
            } break;
            case K_R2: if ((PHMASK >> K_R2) & 1) {
                pg8::Gemm g{(const bf16*)(F.ws + WS_A3), (const bf16*)(F.ws + WS_WL2), M, 3072, 256}; pg8::StaticOrder S; S.init(M, 3072, F.G, (int)blockIdx.x); S.ntk = 4;
                pg8::EpiLora2 E{(bf16*)(F.ws + WS_WAG), WAGW, AR.in[I_W0], AR.in[I_A0]};
                pg8::gemm_phase<pg8::EpiLora2, pg8::StaticOrder, true, true>(F.lds, g, S, E, F.tid);
            } break;
            case K_MIXA: if ((PHMASK >> K_MIXA) & 1) ml1_prompt(F, AR); __syncthreads(); if ((PHMASK >> 13) & 1) ml_sample(F, AR); __syncthreads(); if ((PHMASK >> 14) & 1) rg1(F, AR); break;
            case K_MIXB: if ((PHMASK >> K_MIXB) & 1) ml2_scan(F, AR); if ((PHMASK >> 15) & 1) rg2_carry(F, AR); break;
            case K_MIXC: if ((PHMASK >> K_MIXC) & 1) ml3_prompt(F, AR); __syncthreads(); if ((PHMASK >> 16) & 1) rg2_apply(F, AR); break;
            case K_R3: if ((PHMASK >> K_R3) & 1) rwkv_scan(F, AR); break;
            case K_R3B: rw_gn_pass(F, AR); break;
        }
        if (phs + 1 < hi) xcd_barrier(bar);
    }
}

extern "C" void kernel_launch(void* const* d_in, const int* in_sizes, int n_in, void* d_out, int out_size, void* d_ws, size_t ws_size, hipStream_t stream) {
    static int grid = 0;
    if (grid == 0) {
        if (n_in != 47 || out_size != (int)O_END || ws_size < WS_END) { fprintf(stderr, "kernel_launch: unexpected sizes n_in %d out %d ws %zu\n", n_in, out_size, ws_size); grid = -1; return; }
        int dev = 0, cus = 0, per_cu = 0;
        if (hipGetDevice(&dev) != hipSuccess || hipDeviceGetAttribute(&cus, hipDeviceAttributeMultiprocessorCount, dev) != hipSuccess) { grid = -1; return; }
        if (hipFuncSetAttribute((const void*)mega_fwd, hipFuncAttributeMaxDynamicSharedMemorySize, LDS_BYTES) != hipSuccess) { fprintf(stderr, "kernel_launch: hipFuncSetAttribute failed\n"); grid = -1; return; }
        if (hipOccupancyMaxActiveBlocksPerMultiprocessor(&per_cu, (const void*)mega_fwd, NTHREADS, LDS_BYTES) != hipSuccess || per_cu < 1) { fprintf(stderr, "kernel_launch: occupancy query says %d blocks per CU\n", per_cu); (void)hipGetLastError(); grid = -1; return; }
        grid = cus;
    }
    if (grid < 0) return;
    (void)hipMemsetAsync((char*)d_ws + WS_CTL, 0, CTL_ZERO_BYTES, stream);
    Args a{};
    for (int i = 0; i < 47; ++i) a.in[i] = (const float*)d_in[i];
    a.out = (float*)d_out; a.ws = (unsigned char*)d_ws;
#if MK_N_LAUNCHES == 1
    a.ph_lo = 0; a.ph_hi = NPHASES;
    hipLaunchKernelGGL(mega_fwd, dim3(grid), dim3(NTHREADS), LDS_BYTES, stream, a);
#else
    for (int p = 0; p < NPHASES; ++p) { a.ph_lo = p; a.ph_hi = p + 1; hipLaunchKernelGGL(mega_fwd, dim3(grid), dim3(NTHREADS), LDS_BYTES, stream, a); }
#endif
}
```

```cpp
#include <hip/hip_runtime.h>
#include <cstdio>
#include <cstdint>
#include <cmath>
namespace pg8 {
#define PG8_LAS __attribute__((address_space(3)))
typedef unsigned short bf16_t;
typedef short bf16x8 __attribute__((ext_vector_type(8)));
typedef float f32x4 __attribute__((ext_vector_type(4)));
typedef unsigned u32x4 __attribute__((ext_vector_type(4)));
constexpr int BM = 256, BK = 64, HALF = 128, HTB = HALF * BK * 2  , STAGE_BYTES = 8 * HTB, NXCD = 8, WGM = 8;

__host__ __device__ __forceinline__ int lds_byte(int r, int c) { const int st = (r >> 4) * 2 + (c >> 5), rr = r & 15, cc = c & 31, ob = rr * 64 + cc * 2; return st * 1024 + (ob ^ (((ob >> 9) & 1) << 5)); }
__host__ __device__ __forceinline__ void stage_rc(int b, int& R, int& C) { const int st = b / 1024, sb = b % 1024, swz = sb ^ (((sb >> 9) & 1) << 5); R = (st >> 1) * 16 + swz / 64; C = (st & 1) * 32 + (swz % 64) / 2; }
__host__ __device__ __forceinline__ int perm32(int rho) { const int n = rho >> 4, i = rho & 15; return 8 * (i >> 2) + 4 * n + (i & 3); }

struct Unit { int pm, pn, k0, nt, sub; };
struct Gemm { const bf16_t* A; const bf16_t* Bt; int M, N, K; };

struct StaticOrder {
    int nM, nN, nwg, G, c, ntk;
    __host__ __device__ void init(int M, int N, int G_, int c_) { nM = M / BM; nN = N / BM; nwg = nM * nN; G = G_; c = c_; }
    __host__ __device__ bool next(int i, Unit& u) const {
        const long L = (long)i * G + c; if (L >= nwg) return false;
        int wgid = (int)L; { const int q = nwg / NXCD, r = nwg % NXCD, xcd = wgid % NXCD, off = wgid / NXCD; wgid = (xcd < r ? xcd * (q + 1) : r * (q + 1) + (xcd - r) * q) + off; }
        const int nig = WGM * nN, gid = wgid / nig, fm = gid * WGM, gsz = (nM - fm) < WGM ? (nM - fm) : WGM;
        u.pm = fm + ((wgid % nig) % gsz); u.pn = (wgid % nig) / gsz; u.k0 = 0; u.nt = ntk; u.sub = 0; return true;
    }
    __device__ __forceinline__ void a_ready(const Unit&) const {}
    __device__ __forceinline__ void done(const Unit&) const {}
    __device__ __forceinline__ const bf16_t* a_base(const Gemm& g, const Unit&) const { return g.A; }
};

__device__ __forceinline__ unsigned cvt_pk_bf16(float lo, float hi) { unsigned r; asm volatile("v_cvt_pk_bf16_f32 %0, %1, %2" : "=v"(r) : "v"(lo), "v"(hi)); return r; }
typedef float f32x2 __attribute__((ext_vector_type(2)));
constexpr int MPROWS = 16384;
__device__ __forceinline__ int mod_row(int r) { return r < MPROWS ? (r >> 11) : 8 + ((r - MPROWS) >> 3); }
__device__ __forceinline__ float fsig(float x) { return __builtin_amdgcn_rcpf(1.0f + __builtin_amdgcn_exp2f(-1.44269504f * x)); }
__device__ __forceinline__ float ftanh(float x) { return 1.0f - 2.0f * __builtin_amdgcn_rcpf(1.0f + __builtin_amdgcn_exp2f(2.88539008f * x)); }

struct EpiSwiglu {
    static constexpr bool PERM = true, AFTER_DRAIN = false;
    bf16_t* O; int ldc;
    __device__ __forceinline__ void operator()(const f32x4 (&acc)[2][2][4][2], const Unit& u, int wr, int wc, int fr, int fq) const {
        const int row0 = u.pm * BM + wr * 64 + fr, col0 = u.pn * HALF + wc * 32 + 8 * fq;
#pragma unroll
        for (int ai = 0; ai < 2; ++ai)
#pragma unroll
            for (int m = 0; m < 4; ++m) { bf16_t* rowp = O + (size_t)(row0 + ai * HALF + m * 16) * ldc + col0;
                const f32x4 a0 = acc[ai][0][m][0], a1 = acc[ai][0][m][1], b0 = acc[ai][1][m][0], b1 = acc[ai][1][m][1];
                f32x4 v0, v1;
#pragma unroll
                for (int j = 0; j < 4; ++j) { v0[j] = a0[j] * fsig(a0[j]) * b0[j]; v1[j] = a1[j] * fsig(a1[j]) * b1[j]; }
                u32x4 w; w.x = cvt_pk_bf16(v0[0], v0[1]); w.y = cvt_pk_bf16(v0[2], v0[3]); w.z = cvt_pk_bf16(v1[0], v1[1]); w.w = cvt_pk_bf16(v1[2], v1[3]);
                *(u32x4*)rowp = w; asm volatile("" ::: "memory"); }
    }
};
struct EpiStore {
    static constexpr bool PERM = true, AFTER_DRAIN = false;
    bf16_t* O; int ldc; int ntile_main; bf16_t* O2; int ldc2;
    __device__ __forceinline__ void operator()(const f32x4 (&acc)[2][2][4][2], const Unit& u, int wr, int wc, int fr, int fq) const {
        const int row0 = u.pm * BM + wr * 64 + fr;
        const bool main = u.pn < ntile_main;
        bf16_t* base = main ? O + (size_t)u.pn * BM : O2; const int ld = main ? ldc : ldc2;
        const int col0 = wc * 32 + 8 * fq;
#pragma unroll
        for (int ai = 0; ai < 2; ++ai)
#pragma unroll
            for (int m = 0; m < 4; ++m) { bf16_t* rowp = base + (size_t)(row0 + ai * HALF + m * 16) * ld + col0;
#pragma unroll
                for (int bj = 0; bj < 2; ++bj) { f32x4 v0 = acc[ai][bj][m][0], v1 = acc[ai][bj][m][1];
                    if (!main) {
                        if (bj == 1) {
#pragma unroll
                            for (int j = 0; j < 4; ++j) { v0[j] = fsig(v0[j]); v1[j] = fsig(v1[j]); }
                        } else if (wc < 2) {
#pragma unroll
                            for (int j = 0; j < 4; ++j) { v0[j] = ftanh(v0[j]); v1[j] = ftanh(v1[j]); }
                        }
                    }
                    u32x4 w; w.x = cvt_pk_bf16(v0[0], v0[1]); w.y = cvt_pk_bf16(v0[2], v0[3]); w.z = cvt_pk_bf16(v1[0], v1[1]); w.w = cvt_pk_bf16(v1[2], v1[3]);
                    *(u32x4*)(rowp + bj * HALF) = w; asm volatile("" ::: "memory"); } }
    }
};
struct EpiLora2 {
    static constexpr bool PERM = true, AFTER_DRAIN = false;
    bf16_t* O; int ldc; const float* w0; const float* a0;
    __device__ __forceinline__ void operator()(const f32x4 (&acc)[2][2][4][2], const Unit& u, int wr, int wc, int fr, int fq) const {
        const int row0 = u.pm * BM + wr * 64 + fr, col0 = u.pn * BM + wc * 32 + 8 * fq, kind = u.pn >> 2;
        const float* bp = (kind == 0 ? w0 : a0) + (col0 & 1023); const float bsc = kind == 2 ? 0.f : 1.f, mul = kind == 0 ? -0.87504229f : 1.0f;
        f32x4 bb0[2], bb1[2];
#pragma unroll
        for (int bj = 0; bj < 2; ++bj) { bb0[bj] = *(const f32x4*)(bp + bj * HALF) * bsc; bb1[bj] = *(const f32x4*)(bp + bj * HALF + 4) * bsc; }
#pragma unroll
        for (int bj = 0; bj < 2; ++bj)
#pragma unroll
            for (int ai = 0; ai < 2; ++ai)
#pragma unroll
                for (int m = 0; m < 4; ++m) { bf16_t* rowp = O + (size_t)(row0 + ai * HALF + m * 16) * ldc + col0;
                    f32x4 v0 = acc[ai][bj][m][0] + bb0[bj], v1 = acc[ai][bj][m][1] + bb1[bj];
                    if (kind != 2) {
#pragma unroll
                        for (int j = 0; j < 4; ++j) { v0[j] = mul * fsig(v0[j]); v1[j] = mul * fsig(v1[j]); }
                    }
                    u32x4 w; w.x = cvt_pk_bf16(v0[0], v0[1]); w.y = cvt_pk_bf16(v0[2], v0[3]); w.z = cvt_pk_bf16(v1[0], v1[1]); w.w = cvt_pk_bf16(v1[2], v1[3]);
                    *(u32x4*)(rowp + bj * HALF) = w; asm volatile("" ::: "memory"); }
    }
};

template <class Epi, class Sched, bool ALIGN_EPI = false, bool SP2 = false>
__device__ __forceinline__ void gemm_phase(PG8_LAS unsigned char* lds, const Gemm g, const Sched& S, const Epi& E, int tid_in) {
    int tid_ = tid_in; asm volatile("" : "+v"(tid_));
    const int tid = tid_, wid = __builtin_amdgcn_readfirstlane(tid >> 6), lane = tid & 63, wr = wid >> 2, wc = wid & 3, fr = lane & 15, fq = lane >> 4;
    int K_ = g.K; asm volatile("" : "+s"(K_));
    const int K = K_;
    unsigned voffA[2], voffB[2];
#pragma unroll
    for (int i = 0; i < 2; ++i) { int R, C; stage_rc(tid * 16 + i * 8192, R, C); const int Rb = Epi::PERM ? ((R & ~31) + perm32(R & 31)) : R;
        voffA[i] = (unsigned)(R * K + C) * 2u; voffB[i] = (unsigned)(Rb * K + C) * 2u; }
    const size_t kstep = (size_t)(BK * 2);
    const size_t hstep = (size_t)HALF * K * 2;
    const size_t tstep = 2 * hstep;
    const unsigned ldsw = (unsigned)wid * 1024u;
    const int aoff = lds_byte(wr * 64 + fr, fq * 8), boff = lds_byte(wc * 32 + fr, fq * 8);
#define PG8_SA(b, h) (((b) * 2 + (h)) * HTB)
#define PG8_SB(b, h) ((4 + (b) * 2 + (h)) * HTB)
#define PG8_STAGE(bufoff, gbase, voff) do { _Pragma("unroll") for (int _i = 0; _i < 2; ++_i) \
        __builtin_amdgcn_global_load_lds((const unsigned*)((const char*)(gbase) + (voff)[_i]), (PG8_LAS unsigned*)(lds + (bufoff) + ldsw + _i * 8192), 16, 0, 0); } while (0)
#define PG8_LDA(dst, b, h) do { _Pragma("unroll") for (int m = 0; m < 4; ++m) _Pragma("unroll") for (int k = 0; k < 2; ++k) dst[m][k] = *(const PG8_LAS bf16x8*)(lds + PG8_SA(b, h) + aoff + m * 2048 + k * 1024); } while (0)
#define PG8_LDB(dst, b, h) do { _Pragma("unroll") for (int n = 0; n < 2; ++n) _Pragma("unroll") for (int k = 0; k < 2; ++k) dst[n][k] = *(const PG8_LAS bf16x8*)(lds + PG8_SB(b, h) + boff + n * 2048 + k * 1024); } while (0)
#define PG8_MMA(ai, bj, At, Bt) do { __builtin_amdgcn_s_setprio(1); _Pragma("unroll") for (int m = 0; m < 4; ++m) _Pragma("unroll") for (int n = 0; n < 2; ++n) _Pragma("unroll") for (int k = 0; k < 2; ++k) \
        acc[ai][bj][m][n] = __builtin_amdgcn_mfma_f32_16x16x32_bf16(Bt[n][k], At[m][k], acc[ai][bj][m][n], 0, 0, 0); __builtin_amdgcn_s_setprio(0); } while (0)
#define PG8_WAIT_V(n) asm volatile("s_waitcnt vmcnt(" #n ")" ::: "memory")
#define PG8_WAIT_L(n) asm volatile("s_waitcnt lgkmcnt(" #n ")" ::: "memory")
#define PG8_BAR __builtin_amdgcn_s_barrier()
#define PG8_SCHED __builtin_amdgcn_sched_barrier(0)
    Unit cur, nxt; int ui = 0;
    if (!S.next(0, cur)) return;
    f32x4 acc[2][2][4][2];
#pragma unroll
    for (int a = 0; a < 2; ++a)
#pragma unroll
        for (int b = 0; b < 2; ++b)
#pragma unroll
            for (int m = 0; m < 4; ++m)
#pragma unroll
                for (int n = 0; n < 2; ++n) acc[a][b][m][n] = (f32x4){0.f, 0.f, 0.f, 0.f};
    bf16x8 At[4][2], B0[2][2], B1[2][2];
    const char* cA = (const char*)S.a_base(g, cur) + (size_t)cur.pm * tstep + (size_t)cur.k0 * 2; const char* cB = (const char*)g.Bt + (size_t)cur.pn * tstep + (size_t)cur.k0 * 2;
    S.a_ready(cur);
    if constexpr (SP2) {
        PG8_STAGE(PG8_SB(0, 0), cB, voffB); PG8_STAGE(PG8_SB(0, 1), cB + hstep, voffB); PG8_STAGE(PG8_SA(0, 0), cA, voffA); PG8_STAGE(PG8_SA(0, 1), cA + hstep, voffA);
        if (wr == 1) PG8_BAR;
        PG8_WAIT_V(2); PG8_BAR;
        PG8_STAGE(PG8_SB(1, 0), cB + kstep, voffB); PG8_STAGE(PG8_SA(1, 0), cA + kstep, voffA); PG8_STAGE(PG8_SB(1, 1), cB + hstep + kstep, voffB);
        PG8_WAIT_V(6); PG8_BAR;
    } else {
        PG8_STAGE(PG8_SB(0, 0), cB, voffB); PG8_STAGE(PG8_SA(0, 0), cA, voffA); PG8_STAGE(PG8_SB(0, 1), cB + hstep, voffB); PG8_STAGE(PG8_SA(0, 1), cA + hstep, voffA);
        if (wr == 1) PG8_BAR;
        PG8_WAIT_V(4); PG8_BAR;
        PG8_STAGE(PG8_SB(1, 0), cB + kstep, voffB); PG8_STAGE(PG8_SA(1, 0), cA + kstep, voffA); PG8_STAGE(PG8_SB(1, 1), cB + hstep + kstep, voffB);
        PG8_WAIT_V(6); PG8_BAR;
    }
    for (;;) {
        const bool has_next = S.next(ui + 1, nxt);
        const char* nA = has_next ? (const char*)S.a_base(g, nxt) + (size_t)nxt.pm * tstep + (size_t)nxt.k0 * 2 : cA; const char* nB = has_next ? (const char*)g.Bt + (size_t)nxt.pn * tstep + (size_t)nxt.k0 * 2 : cB;
        const int nt = cur.nt;
        for (int t = 0; t < nt; t += 2) {
            const bool last = (t == nt - 2);
            const char* a1 = cA + (size_t)(t + 1) * kstep;
            const char* a2 = last ? nA : cA + (size_t)(t + 2) * kstep; const char* b2 = last ? nB : cB + (size_t)(t + 2) * kstep;
            const char* a3 = a2 + kstep; const char* b3 = b2 + kstep;
            if (last && has_next) S.a_ready(nxt);
            if constexpr (SP2) {
            PG8_LDB(B0, 0, 0); PG8_LDB(B1, 0, 1); PG8_SCHED; PG8_LDA(At, 0, 0); PG8_STAGE(PG8_SA(1, 1), a1 + hstep, voffA);
            PG8_WAIT_V(8); PG8_WAIT_L(0); PG8_BAR; PG8_MMA(0, 0, At, B0); PG8_MMA(0, 1, At, B1); PG8_BAR; PG8_SCHED;
            PG8_LDA(At, 0, 1); PG8_STAGE(PG8_SB(0, 0), b2, voffB); PG8_STAGE(PG8_SB(0, 1), b2 + hstep, voffB); PG8_STAGE(PG8_SA(0, 0), a2, voffA);
            PG8_WAIT_V(8); PG8_WAIT_L(0); PG8_BAR; PG8_MMA(1, 0, At, B0); PG8_MMA(1, 1, At, B1); PG8_BAR; PG8_SCHED;
            PG8_LDB(B0, 1, 0); PG8_LDB(B1, 1, 1); PG8_SCHED; PG8_LDA(At, 1, 0); PG8_STAGE(PG8_SA(0, 1), a2 + hstep, voffA);
            PG8_WAIT_V(8); PG8_WAIT_L(0); PG8_BAR; PG8_MMA(0, 0, At, B0); PG8_MMA(0, 1, At, B1); PG8_BAR; PG8_SCHED;
            PG8_LDA(At, 1, 1); PG8_STAGE(PG8_SB(1, 0), b3, voffB); PG8_STAGE(PG8_SB(1, 1), b3 + hstep, voffB); PG8_STAGE(PG8_SA(1, 0), a3, voffA);
            PG8_WAIT_V(8); PG8_WAIT_L(0); PG8_BAR; PG8_MMA(1, 0, At, B0); PG8_MMA(1, 1, At, B1); PG8_BAR; PG8_SCHED;
            } else {
            PG8_LDB(B0, 0, 0); PG8_SCHED; PG8_LDA(At, 0, 0); PG8_STAGE(PG8_SA(1, 1), a1 + hstep, voffA);
            PG8_WAIT_L(8); PG8_BAR; PG8_WAIT_L(0); PG8_MMA(0, 0, At, B0); PG8_BAR; PG8_SCHED;
            PG8_LDB(B1, 0, 1); PG8_STAGE(PG8_SB(0, 0), b2, voffB);
            PG8_BAR; PG8_WAIT_L(0); PG8_MMA(0, 1, At, B1); PG8_BAR;
            PG8_LDA(At, 0, 1); PG8_STAGE(PG8_SA(0, 0), a2, voffA);
            PG8_BAR; PG8_WAIT_L(0); PG8_MMA(1, 0, At, B0); PG8_BAR; PG8_SCHED;
            PG8_STAGE(PG8_SB(0, 1), b2 + hstep, voffB);
            PG8_WAIT_V(6); PG8_BAR; PG8_MMA(1, 1, At, B1); PG8_BAR;
            PG8_LDB(B0, 1, 0); PG8_SCHED; PG8_LDA(At, 1, 0); PG8_STAGE(PG8_SA(0, 1), a2 + hstep, voffA);
            PG8_WAIT_L(8); PG8_BAR; PG8_WAIT_L(0); PG8_MMA(0, 0, At, B0); PG8_BAR; PG8_SCHED;
            PG8_LDB(B1, 1, 1); PG8_STAGE(PG8_SB(1, 0), b3, voffB);
            PG8_BAR; PG8_WAIT_L(0); PG8_MMA(0, 1, At, B1); PG8_BAR;
            PG8_LDA(At, 1, 1); PG8_STAGE(PG8_SA(1, 0), a3, voffA);
            PG8_BAR; PG8_WAIT_L(0); PG8_MMA(1, 0, At, B0); PG8_BAR; PG8_SCHED;
            PG8_STAGE(PG8_SB(1, 1), b3 + hstep, voffB);
            PG8_WAIT_V(6); PG8_BAR; PG8_MMA(1, 1, At, B1); PG8_BAR;
            }
        }
        if constexpr (ALIGN_EPI) { if (wr == 0) PG8_BAR; }
        const bool chain = cur.sub == 2;
        if constexpr (!Epi::AFTER_DRAIN) { if (!chain) { E(acc, cur, wr, wc, fr, fq); S.done(cur); } }
        if (!has_next) break;
        if (!chain) {
#pragma unroll
        for (int a = 0; a < 2; ++a)
#pragma unroll
            for (int b = 0; b < 2; ++b)
#pragma unroll
                for (int m = 0; m < 4; ++m)
#pragma unroll
                    for (int n = 0; n < 2; ++n) acc[a][b][m][n] = (f32x4){0.f, 0.f, 0.f, 0.f};
        }
        cur = nxt; cA = nA; cB = nB; ++ui;
        if constexpr (ALIGN_EPI) { if (wr == 1) PG8_BAR; }
    }
    PG8_WAIT_V(0);
    if constexpr (!ALIGN_EPI) { if (wr == 0) PG8_BAR; }
    PG8_BAR;
    if constexpr (Epi::AFTER_DRAIN) { E.fused(acc, cur, wr, wc, fr, fq, lds, wid, lane); S.done(cur); }
#undef PG8_SA
#undef PG8_SB
#undef PG8_STAGE
#undef PG8_LDA
#undef PG8_LDB
#undef PG8_MMA
#undef PG8_WAIT_V
#undef PG8_WAIT_L
#undef PG8_BAR
#undef PG8_SCHED
}
}
constexpr int NWAVES = 8, NTHREADS = 512;
constexpr int D = 1024, MP = 16384, MS = 1024, M = MP + MS, NSEQ = 136, FF = 2816;
constexpr int PSEQ = 2048, SSEQ = 8, NPB = 8, NSB = 128;
constexpr int ZW = 3328;
constexpr int ZQ = 0, ZK = 512, ZV = 1024, ZO = 1536, ZXR = 2048, ZGR = 2560, ZIG = 3072, ZFG = 3076;
constexpr int RKW = 3072, WAGW = 3072;
constexpr float ALPHA = 1.41421356237f;
constexpr float LN_EPS = 1e-5f, HEAD_EPS = 1e-6f, RW_EPS = 64e-5f;
constexpr float MSCALE = 0.08838834764831845f;

constexpr size_t O_Y = 0, O_PMC = 17825792, O_PMN = 18350080, O_PMM = 18354176, O_PRH = 18354208, O_PRC = 18358304, O_PWKV = 18370592, O_PSH = 18894880,
                 O_SMC = 18903072, O_SMN = 27291680, O_SMM = 27357216, O_SRH = 27357728, O_SRC = 27423264, O_SWKV = 27619872, O_SSH = 36008480, O_END = 36139552;

constexpr size_t MiB = 1u << 20;
constexpr size_t WS_CTL = 0, CTL_ZERO_BYTES = 64 * 1024;
constexpr size_t WS_WRG = 512 * 1024;
constexpr size_t WS_W13 = 1 * MiB;
constexpr size_t WS_W2 = 45 * MiB;
constexpr size_t WS_WIN = 67 * MiB;
constexpr size_t WS_WOUT = WS_WIN + 6815744;
constexpr size_t WS_WRK = WS_WOUT + 2 * MiB;
constexpr size_t WS_WL2 = WS_WRK + 13 * MiB;
constexpr size_t WS_WO = WS_WL2 + 1572864;
constexpr size_t WS_MOD = 92 * MiB;
constexpr size_t WS_SC = 101 * MiB + 640 * 1024;
constexpr size_t WS_H = 102 * MiB;
constexpr size_t WS_BIG = 136 * MiB;
constexpr size_t WS_HID = WS_BIG;
constexpr size_t WS_Z = WS_BIG;
constexpr size_t WS_CST = WS_BIG + 111 * MiB;
constexpr size_t WS_SLAB = WS_BIG + 180 * MiB;
constexpr size_t WS_RGH = WS_BIG + 143 * MiB;
constexpr size_t WS_RGP = WS_BIG + 175 * MiB;
constexpr size_t WS_NST = WS_BIG + 207 * MiB;
constexpr size_t WS_MST = WS_NST + 262144;
constexpr size_t WS_CARRY = WS_MST + 8192;
constexpr size_t WS_GATE = WS_CARRY + 1048576;
constexpr size_t WS_RK = WS_BIG;
constexpr size_t WS_A3 = WS_BIG + 102 * MiB;
constexpr size_t WS_A2 = WS_BIG + 111 * MiB;
constexpr size_t WS_WAG = WS_BIG + 111 * MiB;
constexpr size_t WS_END = WS_BIG + 224 * MiB;
static_assert(WS_WO + 2 * MiB <= WS_MOD && WS_MOD + (size_t)2 * 136 * 9216 * 4 <= WS_SC && WS_SC + 160 * 1024 * 2 <= WS_H && WS_H + (size_t)M * D * 2 <= WS_BIG, "ws map");
static_assert(WS_SLAB + (size_t)11 * 4 * MiB <= WS_END && WS_A2 + (size_t)M * 2048 * 2 <= WS_SLAB && WS_CARRY + 8 * 64 * 512 * 4 <= WS_END && WS_WAG + (size_t)M * WAGW * 2 <= WS_END && WS_A3 + (size_t)M * 256 * 2 <= WS_A2, "ws map 2");
constexpr size_t WS_BN = WS_BIG + 213 * MiB;
constexpr size_t XB_OFF = (size_t)M * 1024 * 2;
constexpr size_t WS_ZF = WS_BIG + 111 * MiB;
constexpr int CW_BAR = 4096;

constexpr int LDS_BYTES = 147456;
constexpr int LDSCTL_OFF = LDS_BYTES - 512;
constexpr int MISC_OFF = LDSCTL_OFF;

#define GAS __attribute__((address_space(1)))
#define LAS __attribute__((address_space(3)))
typedef unsigned short bf16;
typedef unsigned v4u __attribute__((ext_vector_type(4)));
typedef unsigned v2u __attribute__((ext_vector_type(2)));
typedef float f32x4 __attribute__((ext_vector_type(4)));
typedef float f32x2 __attribute__((ext_vector_type(2)));
typedef float f32x16 __attribute__((ext_vector_type(16)));
typedef short bf16x8 __attribute__((ext_vector_type(8)));
typedef GAS unsigned gu32;
#define RLX_AGENT __ATOMIC_RELAXED, __HIP_MEMORY_SCOPE_AGENT
#define LDS_WAIT() asm volatile("s_waitcnt lgkmcnt(0)" ::: "memory")
#define DI __device__ __forceinline__
#define MFMA32(a, b, c) __builtin_amdgcn_mfma_f32_32x32x16_bf16((a), (b), (c), 0, 0, 0)
DI unsigned f2bf(float f) { unsigned u = __builtin_bit_cast(unsigned, f); return (u + 0x7fffu + ((u >> 16) & 1u)) >> 16; }
DI unsigned pk2(float lo, float hi) { return pg8::cvt_pk_bf16(lo, hi); }
DI float bf2f(unsigned b) { return __builtin_bit_cast(float, b << 16); }
DI float bflo(unsigned w) { return __builtin_bit_cast(float, w << 16); }
DI float bfhi(unsigned w) { return __builtin_bit_cast(float, w & 0xffff0000u); }
DI int crow(int reg, int h) { return (reg & 3) + 8 * (reg >> 2) + 4 * h; }
DI float fexp(float x) { return __builtin_amdgcn_exp2f(1.44269504f * x); }
DI float fsig(float x) { return pg8::fsig(x); }
DI bf16x8 mk_frag(unsigned a, unsigned b, unsigned c, unsigned d) { v4u p; p.x = a; p.y = b; p.z = c; p.w = d; return __builtin_bit_cast(bf16x8, p); }
DI bf16x8 pack8(const float (&v)[8]) { return mk_frag(pk2(v[0], v[1]), pk2(v[2], v[3]), pk2(v[4], v[5]), pk2(v[6], v[7])); }
template <int CTRL> DI float dpp_add(float x) {
    const int xi = __builtin_bit_cast(int, x);
    const int yi = __builtin_amdgcn_update_dpp(xi, xi, CTRL, 0xF, 0xF, false);
    return x + __builtin_bit_cast(float, yi);
}
DI float sum8(float x) { x = dpp_add<0xB1>(x); x = dpp_add<0x4E>(x); x = dpp_add<0x141>(x); return x; }
DI float sum16(float x) { x = sum8(x); x = dpp_add<0x140>(x); return x; }
DI float wave_sum(float v) { v = sum16(v); v += __shfl_xor(v, 16); v += __shfl_xor(v, 32); return v; }

#define XB_TMO      128
#define XB_XCNT(j)  (256  + 64 * (j))
#define XB_XSUB(j)  (1280 + 64 * (j))
#define XB_XGEN(j)  (2304 + 64 * (j))
#define XB_TOP      3328
#define XB_TOPGEN   3392
#define XCD_BAR_WORDS 3456
#define XB_SPIN_CAP (1u << 18)

__device__ __forceinline__ unsigned xb_ld(unsigned* p)              { return __hip_atomic_load(p, __ATOMIC_RELAXED, __HIP_MEMORY_SCOPE_AGENT); }
__device__ __forceinline__ unsigned xb_add(unsigned* p, unsigned v) { return __hip_atomic_fetch_add(p, v, __ATOMIC_RELAXED, __HIP_MEMORY_SCOPE_AGENT); }
__device__ __forceinline__ unsigned xb_xcc_id() { return (unsigned)__builtin_amdgcn_s_getreg((3 << 11) | 20) & 0xFu; }
#define XB_SPIN(cond, bar) do { unsigned _sp = 0; while (cond) { __builtin_amdgcn_s_sleep(1); \
    if ((++_sp & 255u) == 0u) { if (xb_ld(&(bar)[XB_TMO])) break; if (_sp > XB_SPIN_CAP) { atomicAdd(&(bar)[XB_TMO], 1u); break; } } } } while (0)

struct XcdBarrier {
    unsigned* bar; unsigned x;
    volatile LAS unsigned* st;
};

__device__ __forceinline__ XcdBarrier xcd_barrier_post(unsigned* bar, volatile LAS unsigned* st) {
    XcdBarrier b; b.bar = bar; b.x = xb_xcc_id(); b.st = st;
    if (threadIdx.x == 0) (void)xb_add(&bar[XB_XCNT(b.x)], 1u);
    return b;
}
__device__ __forceinline__ void xcd_barrier_complete(unsigned* bar, unsigned x, unsigned& nloc, unsigned& nx) {
    const unsigned G = gridDim.x * gridDim.y * gridDim.z;
    unsigned sum, cnt, mine, sp = 0u;
    for (;;) {
        sum = 0u; cnt = 0u; mine = 0u;
        unsigned cv[16];
        { const unsigned* p0 = &bar[XB_XCNT(0)];
            asm volatile("global_load_dword %0, %16, off sc1\n\tglobal_load_dword %1, %16, off offset:256 sc1\n\tglobal_load_dword %2, %16, off offset:512 sc1\n\tglobal_load_dword %3, %16, off offset:768 sc1\n\t"
                         "global_load_dword %4, %16, off offset:1024 sc1\n\tglobal_load_dword %5, %16, off offset:1280 sc1\n\tglobal_load_dword %6, %16, off offset:1536 sc1\n\tglobal_load_dword %7, %16, off offset:1792 sc1\n\t"
                         "global_load_dword %8, %16, off offset:2048 sc1\n\tglobal_load_dword %9, %16, off offset:2304 sc1\n\tglobal_load_dword %10, %16, off offset:2560 sc1\n\tglobal_load_dword %11, %16, off offset:2816 sc1\n\t"
                         "global_load_dword %12, %16, off offset:3072 sc1\n\tglobal_load_dword %13, %16, off offset:3328 sc1\n\tglobal_load_dword %14, %16, off offset:3584 sc1\n\tglobal_load_dword %15, %16, off offset:3840 sc1\n\t"
                         "s_waitcnt vmcnt(0)"
                         : "=&v"(cv[0]), "=&v"(cv[1]), "=&v"(cv[2]), "=&v"(cv[3]), "=&v"(cv[4]), "=&v"(cv[5]), "=&v"(cv[6]), "=&v"(cv[7]),
                           "=&v"(cv[8]), "=&v"(cv[9]), "=&v"(cv[10]), "=&v"(cv[11]), "=&v"(cv[12]), "=&v"(cv[13]), "=&v"(cv[14]), "=&v"(cv[15])
                         : "v"(p0) : "memory"); }
#pragma unroll
        for (unsigned j = 0; j < 16; ++j) { const unsigned c = cv[j]; sum += c; cnt += (c > 0u) ? 1u : 0u; mine = (j == x) ? c : mine; }
        if (sum == G) break;
        __builtin_amdgcn_s_sleep(1);
        if ((++sp & 255u) == 0u) { if (xb_ld(&bar[XB_TMO])) break; if (sp > XB_SPIN_CAP) { atomicAdd(&bar[XB_TMO], 1u); break; } }
    }
    nloc = mine > 0u ? mine : 1u; nx = cnt > 0u ? cnt : 1u;
}

__device__ __forceinline__ void xcd_barrier(const XcdBarrier& b) {
    asm volatile("s_waitcnt vmcnt(0)" ::: "memory");
    __syncthreads();
    if (threadIdx.x == 0) {
        unsigned* bar = b.bar;
        __builtin_amdgcn_s_waitcnt(0);
        unsigned nloc = b.st[0], nx = b.st[1];
        if (nloc == 0u) { xcd_barrier_complete(bar, b.x, nloc, nx); b.st[0] = nloc; b.st[1] = nx; }
        const unsigned old = xb_add(&bar[XB_XSUB(b.x)], 1u);
        const unsigned gen = old / nloc;
        if (old + 1u == (gen + 1u) * nloc) {
            __builtin_amdgcn_fence(__ATOMIC_RELEASE, "agent");
            asm volatile("s_waitcnt vmcnt(0)" ::: "memory");
            const unsigned og = xb_add(&bar[XB_TOP], 1u);
            const unsigned tg = og / nx;
            if (og + 1u == (tg + 1u) * nx) xb_add(&bar[XB_TOPGEN], 1u);
            else XB_SPIN(xb_ld(&bar[XB_TOPGEN]) == tg, bar);
            __builtin_amdgcn_fence(__ATOMIC_ACQUIRE, "agent");
            asm volatile("s_waitcnt vmcnt(0)" ::: "memory");
        } else {
            XB_SPIN(xb_ld(&bar[XB_TOPGEN]) == gen, bar);
            __builtin_amdgcn_fence(__ATOMIC_ACQUIRE, "agent");
            asm volatile("s_waitcnt vmcnt(0)" ::: "memory");
        }
    }
    __syncthreads();
}
struct Args { const float* in[47]; float* out; unsigned char* ws; int ph_lo, ph_hi; };
struct Frame {
    LAS unsigned char* lds;
    volatile LAS unsigned* MISC;
    gu32* ctl;
    int tid, lane, wave;
    int vcu, G;
    float* out;
    unsigned char* ws;
};
enum { I_XP = 0, I_XS, I_CP, I_CS, I_SMC, I_SMN, I_SMM, I_SRH, I_SRC, I_SWKV, I_SSH, I_ADAW, I_ADAB, I_LNG, I_LNB, I_W1, I_W3, I_W2, I_WIN, I_BG, I_MNG,
       I_CW, I_CB, I_WA, I_BA, I_WX, I_BX, I_LAM, I_WOUT, I_MU, I_WR, I_WK, I_WV, I_W0, I_LW1, I_LW2, I_A0, I_A1, I_A2, I_G1, I_G2, I_KK, I_KA, I_RK, I_LXG, I_LXB, I_WO };

struct EpiResid {
    static constexpr bool PERM = true, AFTER_DRAIN = false;
    const Args& ar; float* out; unsigned char* ws; int cfg;
    __device__ __forceinline__ void operator()(const pg8::f32x4 (&acc)[2][2][4][2], const pg8::Unit& u, int wr, int wc, int fr, int fq) const {
        using pg8::BM; using pg8::HALF;
        if (u.sub) {
            const int row0 = u.pm * BM + wr * 64 + fr - MP, col0 = u.pn * BM + wc * 32 + 8 * fq;
            bf16* sb = (bf16*)(ws + WS_SLAB) + (size_t)(u.k0 / (64 * u.nt)) * (1024 * 1024) + col0;
#pragma unroll
            for (int ai = 0; ai < 2; ++ai)
#pragma unroll
                for (int m = 0; m < 4; ++m) { bf16* o = sb + (size_t)(row0 + ai * HALF + m * 16) * 1024;
#pragma unroll
                    for (int bj = 0; bj < 2; ++bj) { const f32x4 p0 = acc[ai][bj][m][0], p1 = acc[ai][bj][m][1];
                        v4u w; w.x = pk2(p0.x, p0.y); w.y = pk2(p0.z, p0.w); w.z = pk2(p1.x, p1.y); w.w = pk2(p1.z, p1.w); *(v4u*)(o + bj * HALF) = w; } }
            return;
        }
        const int row0 = u.pm * BM + wr * 64 + fr, col0 = u.pn * BM + wc * 32 + 8 * fq;
        const bool first = cfg & 1; const int l = (cfg >> 1) & 1, jg = (cfg >> 2) & 15; const float rw = (cfg & 64) ? 1.0f : 0.5f;
        bf16* XB = (bf16*)((unsigned char*)out + XB_OFF);
        bf16* Zo = (cfg & 128) ? (bf16*)(ws + WS_BIG + 145 * MiB) : ((cfg & 256) ? (bf16*)(ws + WS_ZF) : ((cfg & 512) ? (bf16*)(out + O_SWKV) : XB));
        const float* gate = (const float*)(ws + WS_MOD) + ((size_t)l * NSEQ * 9 + jg) * 1024;
        if (first && u.pm < 64) {
            const float* gr = gate + (size_t)(u.pm >> 3) * 9216 + col0;
            f32x4 g0[2], g1[2];
#pragma unroll
            for (int bj = 0; bj < 2; ++bj) { g0[bj] = (*(const f32x4*)(gr + bj * HALF) + 1.0f) * rw; g1[bj] = (*(const f32x4*)(gr + bj * HALF + 4) + 1.0f) * rw; }
#pragma unroll
            for (int am = 0; am < 4; ++am) { const int ai = am >> 1, mh = am & 1; f32x4 xa[2][2], xb[2][2];
#pragma unroll
                for (int m2 = 0; m2 < 2; ++m2)
#pragma unroll
                    for (int bj = 0; bj < 2; ++bj) { const float* xr = ar.in[I_XP] + (size_t)(row0 + ai * HALF + (2 * mh + m2) * 16) * 1024 + col0 + bj * HALF; xa[m2][bj] = *(const f32x4*)xr; xb[m2][bj] = *(const f32x4*)(xr + 4); }
#pragma unroll
                for (int m2 = 0; m2 < 2; ++m2)
#pragma unroll
                    for (int bj = 0; bj < 2; ++bj) { const int m = 2 * mh + m2;
                        const f32x4 z0 = xa[m2][bj] * ALPHA + g0[bj] * acc[ai][bj][m][0], z1 = xb[m2][bj] * ALPHA + g1[bj] * acc[ai][bj][m][1];
                        v4u w; w.x = pk2(z0.x, z0.y); w.y = pk2(z0.z, z0.w); w.z = pk2(z1.x, z1.y); w.w = pk2(z1.z, z1.w);
                        *(v4u*)(Zo + (size_t)(row0 + ai * HALF + m * 16) * 1024 + col0 + bj * HALF) = w; }
                asm volatile("" ::: "memory"); }
            return;
        }
        if (!first && u.pm < 64) {
            const float* gr = gate + (size_t)(u.pm >> 3) * 9216 + col0;
            f32x4 g0[2], g1[2];
#pragma unroll
            for (int bj = 0; bj < 2; ++bj) { g0[bj] = (*(const f32x4*)(gr + bj * HALF) + 1.0f) * rw; g1[bj] = (*(const f32x4*)(gr + bj * HALF + 4) + 1.0f) * rw; }
#pragma unroll
            for (int ai = 0; ai < 2; ++ai) { v4u xq[4][2];
#pragma unroll
                for (int m = 0; m < 4; ++m)
#pragma unroll
                    for (int bj = 0; bj < 2; ++bj) xq[m][bj] = *(const v4u*)(XB + (size_t)(row0 + ai * HALF + m * 16) * 1024 + col0 + bj * HALF);
#pragma unroll
                for (int m = 0; m < 4; ++m)
#pragma unroll
                    for (int bj = 0; bj < 2; ++bj) { const v4u q = xq[m][bj];
                        const f32x4 x0 = (f32x4){bflo(q.x), bfhi(q.x), bflo(q.y), bfhi(q.y)}, x1 = (f32x4){bflo(q.z), bfhi(q.z), bflo(q.w), bfhi(q.w)};
                        const f32x4 z0 = x0 * ALPHA + g0[bj] * acc[ai][bj][m][0], z1 = x1 * ALPHA + g1[bj] * acc[ai][bj][m][1];
                        v4u w; w.x = pk2(z0.x, z0.y); w.y = pk2(z0.z, z0.w); w.z = pk2(z1.x, z1.y); w.w = pk2(z1.z, z1.w);
                        *(v4u*)(Zo + (size_t)(row0 + ai * HALF + m * 16) * 1024 + col0 + bj * HALF) = w; }
                asm volatile("" ::: "memory"); }
            return;
        }
#pragma unroll
        for (int ai = 0; ai < 2; ++ai)
#pragma unroll
            for (int m = 0; m < 4; ++m) { const int row = row0 + ai * HALF + m * 16;
                const float* gr = gate + (size_t)pg8::mod_row(row) * 9216 + col0;
#pragma unroll
                for (int bj = 0; bj < 2; ++bj) { const int c = bj * HALF; f32x4 x0, x1;
                    if (first) { const float* xr = (row < MP ? ar.in[I_XP] + (size_t)row * 1024 : ar.in[I_XS] + (size_t)(row - MP) * 1024) + col0 + c; x0 = *(const f32x4*)xr; x1 = *(const f32x4*)(xr + 4); }
                    else { const v4u q = *(const v4u*)(XB + (size_t)row * 1024 + col0 + c); x0 = (f32x4){bflo(q.x), bfhi(q.x), bflo(q.y), bfhi(q.y)}; x1 = (f32x4){bflo(q.z), bfhi(q.z), bflo(q.w), bfhi(q.w)}; }
                    const f32x4 g0 = *(const f32x4*)(gr + c), g1 = *(const f32x4*)(gr + c + 4);
                    const f32x4 z0 = x0 * ALPHA + (g0 + 1.0f) * rw * acc[ai][bj][m][0], z1 = x1 * ALPHA + (g1 + 1.0f) * rw * acc[ai][bj][m][1];
                    v4u w; w.x = pk2(z0.x, z0.y); w.y = pk2(z0.z, z0.w); w.z = pk2(z1.x, z1.y); w.w = pk2(z1.z, z1.w);
                    *(v4u*)(((cfg & 512) && row >= MP ? XB : Zo) + (size_t)row * 1024 + col0 + c) = w; }
                asm volatile("" ::: "memory"); }
    }
};
struct SplitOrder {
    pg8::StaticOrder base; int S;
    __device__ __forceinline__ bool next(int i, pg8::Unit& u) const {
        if (S == 0) return base.next(i, u);
        const bool hs = base.c < 16 * S;
        if (i == 0 && hs) { const int su = base.c / S, ks = base.c - su * S; u.pm = 64 + (su >> 2); u.pn = su & 3; u.k0 = ks * 256; u.nt = 4; u.sub = 1; return true; }
        if (i == (hs ? 1 : 0)) return base.next(0, u);
        return false;
    }
    __device__ __forceinline__ void a_ready(const pg8::Unit&) const {}
    __device__ __forceinline__ void done(const pg8::Unit&) const {}
    __device__ __forceinline__ const pg8::bf16_t* a_base(const pg8::Gemm& g, const pg8::Unit&) const { return g.A; }
};

struct R1Order {
    int c; unsigned char* ws; float* out;
    __device__ __forceinline__ bool next(int i, pg8::Unit& u) const {
        int L; u.k0 = 0; u.nt = 16; u.sub = 0;
        if (c < 68) { if (i >= 4) return false; if (i < 2) { u.pm = c; u.pn = 12 + i; u.sub = i == 0 ? 2 : 0; return true; } L = 2 * c + i - 2; }
        else { const int cc = c - 68; if (cc < 116) { if (i >= 4) return false; L = 136 + 4 * cc + i; } else { if (i >= 3) return false; L = 600 + 3 * (cc - 116) + i; } }
        if (L >= 816) return false;
        constexpr int nM = 68, nN = 12, nwg = 816, NX = 8, WG = 8;
        int wgid = L; { const int q = nwg / NX, r = nwg % NX, xcd = wgid % NX, off = wgid / NX; wgid = (xcd < r ? xcd * (q + 1) : r * (q + 1) + (xcd - r) * q) + off; }
        const int nig = WG * nN, gid = wgid / nig, fm = gid * WG, gsz = (nM - fm) < WG ? (nM - fm) : WG;
        u.pm = fm + ((wgid % nig) % gsz); u.pn = (wgid % nig) / gsz; return true;
    }
    __device__ __forceinline__ void a_ready(const pg8::Unit&) const {}
    __device__ __forceinline__ void done(const pg8::Unit&) const {}
    __device__ __forceinline__ const pg8::bf16_t* a_base(const pg8::Gemm&, const pg8::Unit& u) const { const int s = u.pn >> 2;
        return s == 0 ? (const pg8::bf16_t*)(ws + WS_H) : (s == 1 ? (const pg8::bf16_t*)out : (s == 2 ? (u.pm < 66 ? (const pg8::bf16_t*)(ws + 1 * MiB) : (const pg8::bf16_t*)(ws + 45 * MiB) - (size_t)16896 * 1024)
                                                                                                        : (const pg8::bf16_t*)(ws + WS_A2) + (size_t)(u.pn - 12) * M * 1024)); }
};
DI void p0_sctab(Frame& F, const Args& AR) {
    bf16* sc = (bf16*)(F.ws + WS_SC);
    const int gt = F.vcu * NTHREADS + F.tid, NT = F.G * NTHREADS;
    for (int e = gt; e < 160 * 256; e += NT) { const int m = e >> 8, k4 = (e & 255) * 4; v2u w; w.x = 0u; w.y = 0u;
        if (m < NSEQ) { const f32x4 c = *(const f32x4*)((m < NPB ? AR.in[I_CP] + (size_t)m * D : AR.in[I_CS] + (size_t)(m - NPB) * D) + k4);
            w.x = pk2(c.x * fsig(c.x), c.y * fsig(c.y)); w.y = pk2(c.z * fsig(c.z), c.w * fsig(c.w)); }
        *(v2u*)(sc + (size_t)m * 1024 + k4) = w; }
    bf16* wrg = (bf16*)(F.ws + WS_WRG);
    for (int e = gt; e < 2 * 8 * 4 * 2 * 2 * 32; e += NT) { const int r = e & 31, hh = (e >> 5) & 1, cb = (e >> 6) & 1, ks = (e >> 7) & 3, g = (e >> 9) & 7, w = e >> 12;
        const float* src = (w == 0 ? AR.in[I_WA] : AR.in[I_WX]) + (size_t)g * 4096 + (size_t)(16 * ks + 8 * hh) * 64 + 32 * cb + r; float a[8];
#pragma unroll
        for (int j = 0; j < 8; ++j) a[j] = src[j * 64];
        v4u o; o.x = pk2(a[0], a[1]); o.y = pk2(a[2], a[3]); o.z = pk2(a[4], a[5]); o.w = pk2(a[6], a[7]); *(v4u*)(wrg + (size_t)e * 8) = o; }
}
DI void p0_mod(Frame& F, const Args& AR) {
    LAS float* SL = (LAS float*)F.lds;
    LAS float* T = (LAS float*)(F.lds + 81920);
    const int lane = F.lane, wave = F.wave, r = lane & 31, hh = lane >> 5;
    const float* adaw = AR.in[I_ADAW]; const float* adab = AR.in[I_ADAB];
    const bf16* sc = (const bf16*)(F.ws + WS_SC);
    float* mod = (float*)(F.ws + WS_MOD);
#define MOD_BAR() do { asm volatile("s_waitcnt lgkmcnt(0)" ::: "memory"); __builtin_amdgcn_s_barrier(); asm volatile("" ::: "memory"); } while (0)
    float a[8][8];
    { const int nb = F.vcu < 576 ? F.vcu : 0, n0 = nb * 32, l = n0 / 9216, nc0 = n0 - l * 9216;
        const float* W = adaw + (size_t)l * 1024 * 9216 + nc0 + r + (size_t)(wave * 128 + 8 * hh) * 9216;
#pragma unroll
        for (int ks = 0; ks < 8; ++ks)
#pragma unroll
            for (int j = 0; j < 8; ++j) a[ks][j] = W[(size_t)(ks * 16 + j) * 9216]; }
    for (int nb = F.vcu; nb < 576; nb += F.G) {
        const int n0 = nb * 32, l = n0 / 9216, nc0 = n0 - l * 9216;
        f32x16 acc[5];
#pragma unroll
        for (int mb = 0; mb < 5; ++mb)
#pragma unroll
            for (int i = 0; i < 16; ++i) acc[mb][i] = 0.f;
        { bf16x8 Af[8], Bv[2][5];
#pragma unroll
            for (int mb = 0; mb < 5; ++mb) Bv[0][mb] = *(const bf16x8*)(sc + (size_t)(mb * 32 + r) * 1024 + wave * 128 + 8 * hh);
#pragma unroll
            for (int ks = 0; ks < 8; ++ks) Af[ks] = pack8(a[ks]);
#pragma unroll
            for (int ks = 0; ks < 8; ++ks) {
                if (ks < 7) {
#pragma unroll
                    for (int mb = 0; mb < 5; ++mb) Bv[(ks + 1) & 1][mb] = *(const bf16x8*)(sc + (size_t)(mb * 32 + r) * 1024 + wave * 128 + (ks + 1) * 16 + 8 * hh); }
#pragma unroll
                for (int mb = 0; mb < 5; ++mb) acc[mb] = MFMA32(Af[ks], Bv[ks & 1][mb], acc[mb]); } }
        { const int nn = nb + F.G < 576 ? nb + F.G : nb, n1 = nn * 32, l1 = n1 / 9216, nc1 = n1 - l1 * 9216;
            const float* W = adaw + (size_t)l1 * 1024 * 9216 + nc1 + r + (size_t)(wave * 128 + 8 * hh) * 9216;
#pragma unroll
            for (int ks = 0; ks < 8; ++ks)
#pragma unroll
                for (int j = 0; j < 8; ++j) a[ks][j] = W[(size_t)(ks * 16 + j) * 9216]; }
#pragma unroll
        for (int half = 4; half >= 1; half >>= 1) {
            if (wave >= half && wave < 2 * half) { LAS float* p = SL + (wave - half) * 5120 + lane;
#pragma unroll
                for (int mb = 0; mb < 5; ++mb)
#pragma unroll
                    for (int i = 0; i < 16; ++i) p[(mb * 16 + i) * 64] = acc[mb][i]; }
            MOD_BAR();
            if (wave < half) { const LAS float* p = SL + wave * 5120 + lane;
#pragma unroll
                for (int mb = 0; mb < 5; ++mb)
#pragma unroll
                    for (int i = 0; i < 16; ++i) acc[mb][i] += p[(mb * 16 + i) * 64]; }
            MOD_BAR();
        }
        if (wave == 0) {
#pragma unroll
            for (int mb = 0; mb < 5; ++mb)
#pragma unroll
                for (int i = 0; i < 16; ++i) T[(mb * 32 + r) * 33 + crow(i, hh)] = acc[mb][i]; }
        MOD_BAR();
        for (int m = F.tid >> 5; m < NSEQ; m += 16) { const int n = F.tid & 31; mod[(size_t)(l * NSEQ + m) * 9216 + nc0 + n] = T[m * 33 + n] + adab[l * 9216 + nc0 + n]; }
        MOD_BAR();
    }
}

struct TrP { const float* src; const float* sc; bf16* dst; int ld, nv, dld; float keep, sa, sb; };
DI void tr_load(const TrP& p, f32x4 (&v)[8], float (&m)[8], int lane) {
    const int n4 = (lane & 7) * 4, kr = lane >> 3;
#pragma unroll
    for (int i = 0; i < 8; ++i) { v[i] = *(const f32x4*)(p.src + (size_t)(kr + 8 * i) * p.ld + n4); m[i] = p.sc[kr + 8 * i]; }
}
DI void tr_finish(const TrP& p, const f32x4 (&v)[8], const float (&m)[8], LAS float* scr, int lane) {
    const int n4 = (lane & 7) * 4, kr = lane >> 3; const float kz = (n4 < p.nv) ? p.keep : 0.f;
#pragma unroll
    for (int i = 0; i < 8; ++i) { const float f = (p.sa + p.sb * m[i]) * kz; LAS float* q = scr + (kr + 8 * i) * 33 + n4;
        q[0] = kz == 0.f ? 0.f : v[i].x * f; q[1] = kz == 0.f ? 0.f : v[i].y * f; q[2] = kz == 0.f ? 0.f : v[i].z * f; q[3] = kz == 0.f ? 0.f : v[i].w * f; }
    LDS_WAIT(); asm volatile("" ::: "memory");
    const int c = lane & 7;
    float tv[4][8];
#pragma unroll
    for (int j = 0; j < 4; ++j) { const LAS float* t = scr + (8 * c) * 33 + (lane >> 3) + 8 * j;
#pragma unroll
        for (int k = 0; k < 8; ++k) tv[j][k] = t[k * 33]; }
#pragma unroll
    for (int j = 0; j < 4; ++j) { const int n = (lane >> 3) + 8 * j;
        v4u o; o.x = pk2(tv[j][0], tv[j][1]); o.y = pk2(tv[j][2], tv[j][3]); o.z = pk2(tv[j][4], tv[j][5]); o.w = pk2(tv[j][6], tv[j][7]);
        *(GAS v4u*)(p.dst + (size_t)n * p.dld + 8 * c) = o; }
    LDS_WAIT(); asm volatile("" ::: "memory");
}
DI void p0_decode(const Args& AR, unsigned char* ws, int it, TrP& p) {
    constexpr int I_13 = 16 * 176, I_2 = 44 * 32, I_IN = 16 * 104, I_SQ = 16 * 32, I_RKI = 16 * 96 + 32 * 8;
    bf16* W13 = (bf16*)(ws + WS_W13); bf16* W2 = (bf16*)(ws + WS_W2); bf16* WIN = (bf16*)(ws + WS_WIN); bf16* WOUT = (bf16*)(ws + WS_WOUT);
    bf16* WRK = (bf16*)(ws + WS_WRK); bf16* WL2 = (bf16*)(ws + WS_WL2); bf16* WO = (bf16*)(ws + WS_WO);
    int r = it; p.nv = 32; p.keep = 1.f; p.sa = 1.f; p.sb = 0.f; p.sc = nullptr;
    if (r < 4 * I_13) { const int f = r / I_13; r -= f * I_13; const int kt = r / 176, tn = r % 176, j = tn >> 3, i = tn & 7;
        p.src = (i < 4 ? AR.in[I_W1] : AR.in[I_W3]) + (size_t)f * 1024 * FF + (size_t)(64 * kt) * FF + 128 * j + 32 * (i & 3); p.ld = FF;
        p.dst = W13 + (size_t)f * 5632 * 1024 + (size_t)(32 * tn) * 1024 + 64 * kt; p.dld = 1024; }
    else if ((r -= 4 * I_13) < 4 * I_2) { const int f = r / I_2; r -= f * I_2; const int kt = r / 32, tn = r % 32;
        p.src = AR.in[I_W2] + (size_t)f * FF * 1024 + (size_t)(64 * kt) * 1024 + 32 * tn; p.ld = 1024;
        p.dst = W2 + (size_t)f * 1024 * FF + (size_t)(32 * tn) * FF + 64 * kt; p.dld = FF; }
    else if ((r -= 4 * I_2) < I_IN) { const int kt = r / 104, tn = r % 104, nd = 32 * tn; int sc0 = 0;
        if (nd < 2048) sc0 = nd; else if (nd < 3072) sc0 = nd + 8; else if (nd == 3072) { sc0 = 2048; p.nv = 8; } else p.keep = 0.f;
        p.src = AR.in[I_WIN] + (size_t)(64 * kt) * 3080 + sc0; p.ld = 3080; p.dst = WIN + (size_t)nd * 1024 + 64 * kt; p.dld = 1024; }
    else if ((r -= I_IN) < 2 * I_SQ) { const int w = r / I_SQ; r -= w * I_SQ; const int kt = r / 32, tn = r % 32;
        p.src = (w == 0 ? AR.in[I_WOUT] : AR.in[I_WO]) + (size_t)(64 * kt) * 1024 + 32 * tn; p.ld = 1024; p.dst = (w == 0 ? WOUT : WO) + (size_t)(32 * tn) * 1024 + 64 * kt; p.dld = 1024; }
    else if ((r -= 2 * I_SQ) < 16 * 96) { const int kt = r / 96, tn = r % 96, nd = 32 * tn;
        p.src = (nd < 1024 ? AR.in[I_WR] + nd : (nd < 2048 ? AR.in[I_WK] + (nd - 1024) : AR.in[I_WV] + (nd - 2048))) + (size_t)(64 * kt) * 1024; p.ld = 1024; p.dst = WRK + (size_t)nd * 1024 + 64 * kt; p.dld = 1024; }
    else if (r < I_RKI) { const int q = r - 16 * 96, kt = q / 8, tn = q % 8, nd = 32 * tn, kd = 64 * kt, half = kd >= 1024, ks = kd & 1023;
        const float* base; int ld, col, mi;
        if (nd < 64) { base = AR.in[I_LW1]; ld = 64; col = nd; mi = 1; }
        else if (nd < 128) { base = AR.in[I_A1]; ld = 64; col = nd - 64; mi = 4; }
        else { base = AR.in[I_G1]; ld = 128; col = nd - 128; mi = 5; }
        p.src = base + (size_t)ks * ld + col; p.ld = ld; p.sc = AR.in[I_MU] + mi * 1024 + ks; p.sa = half ? 0.f : 1.f; p.sb = half ? 1.f : -1.f; p.dst = WRK + (size_t)(3072 + 256 * half + nd) * 1024 + ks; p.dld = 1024; }
    else { r -= I_RKI; const int kt = r / 96, tn = r % 96, nd = 32 * tn; p.src = AR.in[I_LW2]; p.keep = 0.f; p.ld = 1024;
        if (nd < 1024) { if (kt == 0) { p.src = AR.in[I_LW2] + nd; p.keep = 1.f; } }
        else if (nd < 2048) { if (kt == 1) { p.src = AR.in[I_A2] + (nd - 1024); p.keep = 1.f; } }
        else { if (kt >= 2) { p.src = AR.in[I_G2] + (size_t)(64 * (kt - 2)) * 1024 + (nd - 2048); p.keep = 1.f; } }
        p.dst = WL2 + (size_t)nd * 256 + 64 * kt; p.dld = 256; }
    if (p.sc == nullptr) p.sc = p.src;
}
constexpr int P0_NITEMS = 4 * 16 * 176 + 4 * 44 * 32 + 16 * 104 + 2 * 16 * 32 + (16 * 96 + 32 * 8) + 4 * 96, P0_NPAIR = P0_NITEMS / 2;
constexpr int P0_MOD_LO = (4 * 16 * 176 + 44 * 32) / 2, P0_MOD_HI = (4 * 16 * 176 + 4 * 44 * 32) / 2;
constexpr int P0_MIXB_LO = (4 * 16 * 176 + 4 * 44 * 32 + 16 * 104 + 16 * 32) / 2, P0_MIXB_HI = P0_NPAIR;
static_assert(P0_NITEMS % 2 == 0, "pairs");
DI void p0_weights(Frame& F, const Args& AR, int lo1, int hi1, int lo2, int hi2, int widx, int wcnt) {
    LAS float* scr = (LAS float*)(F.lds + 32768 + F.wave * 8704);
    const int n1 = hi1 - lo1, n = n1 + (hi2 - lo2);
    if (widx < 0) return;
    for (int q = widx; q < n; q += wcnt) { const int g = q < n1 ? lo1 + q : lo2 + (q - n1);
        TrP pa, pb; f32x4 va[8], vb[8]; float ma[8], mb[8];
        p0_decode(AR, F.ws, 2 * g, pa); p0_decode(AR, F.ws, 2 * g + 1, pb);
        tr_load(pa, va, ma, F.lane); tr_load(pb, vb, mb, F.lane);
        tr_finish(pa, va, ma, scr, F.lane); tr_finish(pb, vb, mb, scr, F.lane);
    }
}

DI void ld8(float (&v)[8], const bf16* p) { const v4u q = *(const v4u*)p; v[0] = bflo(q.x); v[1] = bfhi(q.x); v[2] = bflo(q.y); v[3] = bfhi(q.y); v[4] = bflo(q.z); v[5] = bfhi(q.z); v[6] = bflo(q.w); v[7] = bfhi(q.w); }
DI void ld8(float (&v)[8], const float* p) { const f32x4 a = *(const f32x4*)p, b = *(const f32x4*)(p + 4); v[0] = a.x; v[1] = a.y; v[2] = a.z; v[3] = a.w; v[4] = b.x; v[5] = b.y; v[6] = b.z; v[7] = b.w; }
DI v4u pk8(const float (&v)[8]) { v4u w; w.x = pk2(v[0], v[1]); w.y = pk2(v[2], v[3]); w.z = pk2(v[4], v[5]); w.w = pk2(v[6], v[7]); return w; }
template <int NS> DI void slab_sum_n(const bf16* sl, float (&a)[8]) {
#pragma unroll
    for (int s0 = 1; s0 < NS; s0 += 5) { float u[5][8];
#pragma unroll
        for (int s2 = 0; s2 < 5; ++s2) if (s0 + s2 < NS) ld8(u[s2], sl + (size_t)(s0 + s2) * 1024 * 1024);
#pragma unroll
        for (int s2 = 0; s2 < 5; ++s2) if (s0 + s2 < NS) {
#pragma unroll
            for (int e = 0; e < 8; ++e) a[e] += u[s2][e]; } } }
DI void slab_sum(const bf16* sl, int nsplit, float (&a)[8]) {
    if (nsplit == 11) slab_sum_n<11>(sl, a); else if (nsplit == 4) slab_sum_n<4>(sl, a);
    else for (int s2 = 1; s2 < nsplit; ++s2) { float u[8]; ld8(u, sl + (size_t)s2 * 1024 * 1024);
#pragma unroll
        for (int e = 0; e < 8; ++e) a[e] += u[e]; } }
DI void ln_pass(Frame& F, const Args& AR, int first, int do_ln, int l, int sub, int lm, int js, int mode, int nsplit, int xfirst, int fin) {
    const int gw = F.vcu * NWAVES + F.wave, NGW = F.G * NWAVES, lane = F.lane;
    bf16* XB = (bf16*)((unsigned char*)F.out + XB_OFF); const bf16* ZS = fin ? (const bf16*)(F.ws + WS_ZF) : XB;
    const float* lg = AR.in[I_LNG] + (l * 3 + sub) * 1024; const float* lb = AR.in[I_LNB] + (l * 3 + sub) * 1024;
    const float* mod = (const float*)(F.ws + WS_MOD);
    bf16* H = (bf16*)(F.ws + WS_H); bf16* A2 = (bf16*)(F.ws + WS_A2);
    const int nprow = (MP - gw + NGW - 1) / NGW, hass = (MP + gw < M && NGW >= MS) ? 1 : 0;
    const bool oneseq = F.G == 256;
    auto rowof = [&](int k) -> int { const int kp = hass ? k - 1 : k; if (hass && k == 0) return MP + gw;
        return oneseq ? (F.vcu >> 5) * PSEQ + ((F.vcu & 31) * 8 + F.wave) + 256 * kp : gw + kp * NGW; };
    const int nrow = hass ? nprow + 1 : (M - gw + NGW - 1) / NGW;
    float nv[2][8];
    { const int r = nrow > 0 ? rowof(0) : 0;
#pragma unroll
        for (int j = 0; j < 2; ++j) { const int c0 = 8 * (lane + 64 * j);
            if (first || (xfirst && r >= MP)) ld8(nv[j], (r < MP ? AR.in[I_XP] + (size_t)r * D : AR.in[I_XS] + (size_t)(r - MP) * D) + c0);
            else ld8(nv[j], ZS + (size_t)r * D + c0); } }
    float lgv[2][8], lbv[2][8];
#pragma unroll
    for (int j = 0; j < 2; ++j) { ld8(lgv[j], lg + 8 * (lane + 64 * j)); ld8(lbv[j], lb + 8 * (lane + 64 * j)); }
    float s8v[2][8], h8v[2][8]; bool mod_have = false;
    for (int k = 0; k < nrow; ++k) { const int r = rowof(k);
        float v[2][8];
#pragma unroll
        for (int j = 0; j < 2; ++j)
#pragma unroll
            for (int e = 0; e < 8; ++e) v[j][e] = nv[j][e];
        { const int rn = k + 1 < nrow ? rowof(k + 1) : r;
#pragma unroll
            for (int j = 0; j < 2; ++j) { const int c0 = 8 * (lane + 64 * j);
                if (first || (xfirst && rn >= MP)) ld8(nv[j], (rn < MP ? AR.in[I_XP] + (size_t)rn * D : AR.in[I_XS] + (size_t)(rn - MP) * D) + c0);
                else ld8(nv[j], ZS + (size_t)rn * D + c0); } }
        if (nsplit > 0 && r >= MP) {
            const float* gp = mod + ((size_t)(l * NSEQ + pg8::mod_row(r)) * 9 + 3 * sub + 2) * 1024; const float rw = sub == 1 ? 1.0f : 0.5f;
            const bf16* sl = (const bf16*)(F.ws + WS_SLAB) + (size_t)(r - MP) * 1024;
#pragma unroll
            for (int j = 0; j < 2; ++j) { const int c0 = 8 * (lane + 64 * j); float a[8], g[8]; ld8(a, sl + c0); ld8(g, gp + c0);
                slab_sum(sl + c0, nsplit, a);
#pragma unroll
                for (int e = 0; e < 8; ++e) v[j][e] = v[j][e] * ALPHA + (g[e] + 1.0f) * rw * a[e]; }
        }
        if (!(oneseq && r < MP && mod_have)) {
            const float* sh = mod + ((size_t)(lm * NSEQ + pg8::mod_row(r)) * 9 + js) * 1024;
#pragma unroll
            for (int j = 0; j < 2; ++j) { ld8(h8v[j], sh + 8 * (lane + 64 * j)); ld8(s8v[j], sh + 1024 + 8 * (lane + 64 * j)); }
            mod_have = r < MP; }
        if (do_ln) {
            float s = 0.f;
#pragma unroll
            for (int j = 0; j < 2; ++j)
#pragma unroll
                for (int e = 0; e < 8; ++e) s += v[j][e];
            const float mean = wave_sum(s) * (1.f / D); float s2 = 0.f;
#pragma unroll
            for (int j = 0; j < 2; ++j)
#pragma unroll
                for (int e = 0; e < 8; ++e) { v[j][e] -= mean; s2 += v[j][e] * v[j][e]; }
            const float rstd = __builtin_amdgcn_rsqf(wave_sum(s2) * (1.f / D) + LN_EPS);
#pragma unroll
            for (int j = 0; j < 2; ++j) { const int c0 = 8 * (lane + 64 * j);
#pragma unroll
                for (int e = 0; e < 8; ++e) v[j][e] = v[j][e] * rstd * lgv[j][e] + lbv[j][e];
                if (fin) { float* o = F.out + O_Y + (size_t)r * D + c0; *(f32x4*)o = (f32x4){v[j][0], v[j][1], v[j][2], v[j][3]}; *(f32x4*)(o + 4) = (f32x4){v[j][4], v[j][5], v[j][6], v[j][7]}; }
                else *(v4u*)(XB + (size_t)r * D + c0) = pk8(v[j]); }
        }
        if (mode != 2) {
#pragma unroll
            for (int j = 0; j < 2; ++j) { const int c0 = 8 * (lane + 64 * j); float h[8];
#pragma unroll
                for (int e = 0; e < 8; ++e) h[e] = v[j][e] * (s8v[j][e] + 1.0f) + h8v[j][e];
                const v4u w = pk8(h);
                *(v4u*)(H + (size_t)r * D + c0) = w; }
        }
    }
}

struct LnPar { float lg[2][8], lb[2][8]; };
struct ModPar { float sc[2][8], sh[2][8]; };
DI void ld_lnpar(const Args& AR, int lane, LnPar& p) {
#pragma unroll
    for (int j = 0; j < 2; ++j) { ld8(p.lg[j], AR.in[I_LNG] + 3 * 1024 + 8 * (lane + 64 * j)); ld8(p.lb[j], AR.in[I_LNB] + 3 * 1024 + 8 * (lane + 64 * j)); } }
DI void ld_modpar(const float* mod, int mr, int lane, ModPar& p) { const float* sh = mod + ((size_t)(NSEQ + mr) * 9 + 3) * 1024;
#pragma unroll
    for (int j = 0; j < 2; ++j) { ld8(p.sh[j], sh + 8 * (lane + 64 * j)); ld8(p.sc[j], sh + 1024 + 8 * (lane + 64 * j)); } }
DI void rwkv_lnh(const LnPar& lp, const ModPar& mp, float (&x)[2][8], float (&h)[2][8]) {
    float s = 0.f;
#pragma unroll
    for (int j = 0; j < 2; ++j)
#pragma unroll
        for (int e = 0; e < 8; ++e) s += x[j][e];
    const float mean = wave_sum(s) * (1.f / D); float s2 = 0.f;
#pragma unroll
    for (int j = 0; j < 2; ++j)
#pragma unroll
        for (int e = 0; e < 8; ++e) { x[j][e] -= mean; s2 += x[j][e] * x[j][e]; }
    const float rstd = __builtin_amdgcn_rsqf(wave_sum(s2) * (1.f / D) + LN_EPS);
#pragma unroll
    for (int j = 0; j < 2; ++j)
#pragma unroll
        for (int e = 0; e < 8; ++e) { x[j][e] = x[j][e] * rstd * lp.lg[j][e] + lp.lb[j][e]; h[j][e] = x[j][e] * (mp.sc[j][e] + 1.0f) + mp.sh[j][e]; }
}
DI void rwkv_emit(Frame& F, const Args& AR, int r, const float (&x)[2][8], const float (&h)[2][8], const float (&hp)[2][8], float* so) {
    const int lane = F.lane; const float* mu = AR.in[I_MU];
    bf16* XB = (bf16*)((unsigned char*)F.out + XB_OFF); bf16* A2 = (bf16*)(F.ws + WS_A2); bf16* XR = (bf16*)(F.ws + WS_H); bf16* XK = (bf16*)F.out;
    bf16* xv = (r < 16896 ? (bf16*)(F.ws + 1 * MiB) + (size_t)r * D : (bf16*)(F.ws + 45 * MiB) + (size_t)(r - 16896) * D);
#pragma unroll
    for (int j = 0; j < 2; ++j) { const int c0 = 8 * (lane + 64 * j);
        *(v4u*)(XB + (size_t)r * D + c0) = pk8(x[j]);
        *(v4u*)(A2 + (size_t)r * D + c0) = pk8(h[j]); *(v4u*)(A2 + (size_t)(M + r) * D + c0) = pk8(hp[j]);
        float m0[8], m2[8], m3[8], o[8]; ld8(m0, mu + c0); ld8(m2, mu + 2 * 1024 + c0); ld8(m3, mu + 3 * 1024 + c0);
#pragma unroll
        for (int e = 0; e < 8; ++e) o[e] = h[j][e] + (hp[j][e] - h[j][e]) * m0[e];
        *(v4u*)(XR + (size_t)r * D + c0) = pk8(o);
#pragma unroll
        for (int e = 0; e < 8; ++e) o[e] = h[j][e] + (hp[j][e] - h[j][e]) * m2[e];
        *(v4u*)(XK + (size_t)r * D + c0) = pk8(o);
#pragma unroll
        for (int e = 0; e < 8; ++e) o[e] = h[j][e] + (hp[j][e] - h[j][e]) * m3[e];
        *(v4u*)(xv + c0) = pk8(o);
        if (so) { *(f32x4*)(so + c0) = (f32x4){h[j][0], h[j][1], h[j][2], h[j][3]}; *(f32x4*)(so + c0 + 4) = (f32x4){h[j][4], h[j][5], h[j][6], h[j][7]}; } }
}
DI void ln_rwkv(Frame& F, const Args& AR, int nsplit) {
    const int gw = F.vcu * NWAVES + F.wave, NGW = F.G * NWAVES, lane = F.lane;
    const bf16* XB = (const bf16*)((unsigned char*)F.out + XB_OFF); const bf16* ZP = (const bf16*)(F.out + O_SWKV);
    const float* mod = (const float*)(F.ws + WS_MOD);
    LnPar lp; ld_lnpar(AR, lane, lp);
    for (int q = F.vcu; q < NSB; q += F.G) {
        const int t = F.wave, r = MP + SSEQ * q + t; float x[2][8], h[2][8], hp[2][8];
        ModPar mpq; ld_modpar(mod, NPB + q, lane, mpq);
        LAS float* HL = (LAS float*)F.lds;
#pragma unroll
        for (int j = 0; j < 2; ++j) ld8(x[j], XB + (size_t)r * D + 8 * (lane + 64 * j));
        if (nsplit > 0) {
            const float* gp = mod + ((size_t)(NSEQ + NPB + q) * 9 + 2) * 1024; const bf16* sl = (const bf16*)(F.ws + WS_SLAB) + (size_t)(r - MP) * 1024;
#pragma unroll
            for (int j = 0; j < 2; ++j) { const int c0 = 8 * (lane + 64 * j); float a[8], g[8]; ld8(a, sl + c0); ld8(g, gp + c0);
                slab_sum(sl + c0, nsplit, a);
#pragma unroll
                for (int e = 0; e < 8; ++e) x[j][e] = x[j][e] * ALPHA + (g[e] + 1.0f) * 0.5f * a[e]; }
        }
        rwkv_lnh(lp, mpq, x, h);
#pragma unroll
        for (int j = 0; j < 2; ++j) { LAS float* o = HL + t * 1024 + 8 * (lane + 64 * j); *(LAS f32x4*)o = (f32x4){h[j][0], h[j][1], h[j][2], h[j][3]}; *(LAS f32x4*)(o + 4) = (f32x4){h[j][4], h[j][5], h[j][6], h[j][7]}; }
        __syncthreads();
#pragma unroll
        for (int j = 0; j < 2; ++j) { const int c0 = 8 * (lane + 64 * j);
            if (t == 0) ld8(hp[j], AR.in[I_SSH] + (size_t)q * D + c0);
            else { const LAS float* o = HL + (t - 1) * 1024 + c0; const f32x4 a = *(const LAS f32x4*)o, b = *(const LAS f32x4*)(o + 4);
                hp[j][0] = a.x; hp[j][1] = a.y; hp[j][2] = a.z; hp[j][3] = a.w; hp[j][4] = b.x; hp[j][5] = b.y; hp[j][6] = b.z; hp[j][7] = b.w; } }
        rwkv_emit(F, AR, r, x, h, hp, t == SSEQ - 1 ? F.out + O_SSH + (size_t)q * D : nullptr);
        __syncthreads();
    }
    const int nsw = 0;
    const int pw0 = gw - nsw, pst = NGW - nsw;
    if (pw0 >= 0) {
        v4u zc[2], zq[2];
        const bool oneseq = F.G == 256;
        auto prow = [&](int k) -> int { return oneseq ? (k < 8 ? (F.vcu >> 5) * PSEQ + ((F.vcu & 31) * 8 + F.wave) + 256 * k : MP) : pw0 + k * pst; };
        ModPar mpr; if (oneseq) ld_modpar(mod, F.vcu >> 5, lane, mpr);
        { const int rr = prow(0) < MP ? prow(0) : MP - 1, rp = (rr & (PSEQ - 1)) ? rr - 1 : rr;
#pragma unroll
            for (int j = 0; j < 2; ++j) { zc[j] = *(const v4u*)(ZP + (size_t)rr * D + 8 * (lane + 64 * j)); zq[j] = *(const v4u*)(ZP + (size_t)rp * D + 8 * (lane + 64 * j)); } }
        for (int k = 0; prow(k) < MP; ++k) { const int r = prow(k);
            float x[2][8], h[2][8], hp[2][8];
            const int t = r & (PSEQ - 1), b = r >> 11;
            if (!oneseq) ld_modpar(mod, b, lane, mpr);
            v4u cq[2];
#pragma unroll
            for (int j = 0; j < 2; ++j) { const v4u a = zc[j]; cq[j] = zq[j];
                x[j][0] = bflo(a.x); x[j][1] = bfhi(a.x); x[j][2] = bflo(a.y); x[j][3] = bfhi(a.y); x[j][4] = bflo(a.z); x[j][5] = bfhi(a.z); x[j][6] = bflo(a.w); x[j][7] = bfhi(a.w); }
            { const int rn = prow(k + 1), rr = rn < MP ? rn : MP - 1, rp = (rr & (PSEQ - 1)) ? rr - 1 : rr;
#pragma unroll
                for (int j = 0; j < 2; ++j) { zc[j] = *(const v4u*)(ZP + (size_t)rr * D + 8 * (lane + 64 * j)); zq[j] = *(const v4u*)(ZP + (size_t)rp * D + 8 * (lane + 64 * j)); } }
            rwkv_lnh(lp, mpr, x, h);
            { float xp[2][8];
#pragma unroll
                for (int j = 0; j < 2; ++j) { const v4u q = cq[j];
                    xp[j][0] = bflo(q.x); xp[j][1] = bfhi(q.x); xp[j][2] = bflo(q.y); xp[j][3] = bfhi(q.y); xp[j][4] = bflo(q.z); xp[j][5] = bfhi(q.z); xp[j][6] = bflo(q.w); xp[j][7] = bfhi(q.w); }
                rwkv_lnh(lp, mpr, xp, hp); }
            if (t == 0) {
#pragma unroll
                for (int j = 0; j < 2; ++j)
#pragma unroll
                    for (int e = 0; e < 8; ++e) hp[j][e] = 0.f; }
            rwkv_emit(F, AR, r, x, h, hp, t == PSEQ - 1 ? F.out + O_PSH + (size_t)b * D : nullptr);
        }
    }
}

DI float flog1p(float e) { return e < 0.015625f ? e * (1.0f - e * (0.5f - e * 0.33333333f)) : 0.69314718f * __builtin_amdgcn_logf(1.0f + e); }
DI float log_sigmoid(float x) { return -(fmaxf(-x, 0.f) + flog1p(__expf(-fabsf(x)))); }
DI float gelu_tanh(float x) { const float u = 0.7978845608f * (x + 0.044715f * x * x * x); return 0.5f * x * (1.0f + pg8::ftanh(u)); }

typedef short trv4 __attribute__((ext_vector_type(4)));
DI void ml1_prompt(Frame& F, const Args& AR) {
    const bf16* Z = (const bf16*)(F.ws + WS_Z);
    float* CST = (float*)(F.ws + WS_CST); float* NST = (float*)(F.ws + WS_NST); float* MST = (float*)(F.ws + WS_MST); float* GATE = (float*)(F.ws + WS_GATE);
    LAS bf16* Ks = (LAS bf16*)F.lds;
    LAS bf16* Vs = (LAS bf16*)(F.lds + 40960);
    LAS float* LF = (LAS float*)(F.lds + 81920);
    LAS float* GS = (LAS float*)(F.lds + 81920 + 512);
    LAS float* RED = (LAS float*)(F.lds + 81920 + 1024);
    const int tid = F.tid, lane = F.lane, wave = F.wave, r = lane & 31, hh = lane >> 5;
    for (int item = F.vcu; item < 512; item += F.G) {
        const int b = item >> 6, h = (item >> 4) & 3, c = item & 15; const size_t row0 = (size_t)b * PSEQ + c * 128;
        const bf16 fgq = Z[(row0 + (tid & 127)) * ZW + ZFG + h], igq = Z[(row0 + (tid & 127)) * ZW + ZIG + h];
        { v4u kq[4], vq[4];
#pragma unroll
            for (int i = 0; i < 4; ++i) { const int e = tid + i * NTHREADS, s = e >> 4, c8 = (e & 15) * 8;
                kq[i] = *(const v4u*)(Z + (row0 + s) * ZW + ZK + h * 128 + c8); vq[i] = *(const v4u*)(Z + (row0 + s) * ZW + ZV + h * 128 + c8); }
#pragma unroll
            for (int i = 0; i < 4; ++i) { const int e = tid + i * NTHREADS, s = e >> 4, c8 = (e & 15) * 8;
                *(LAS v4u*)(Ks + s * 160 + c8) = kq[i]; *(LAS v4u*)(Vs + s * 160 + c8) = vq[i]; } }
        if (tid < 128) { const float fg = bf2f(fgq); LF[tid] = log_sigmoid(fg + AR.in[I_BG][4 + h]); }
        __syncthreads();
        if (tid < 8) { float sb = 0.f, lv[16];
#pragma unroll
            for (int j = 0; j < 16; ++j) lv[j] = LF[tid * 16 + j];
#pragma unroll
            for (int j = 0; j < 16; ++j) sb += lv[j];
            RED[8 + tid] = sb; }
        __syncthreads();
        float ig_bs_hold = 0.f;
        if (tid < 128) { const int blk = tid >> 4; float bs = 0.f, rv[8], lv[16];
#pragma unroll
            for (int q = 0; q < 8; ++q) rv[q] = RED[8 + q];
#pragma unroll
            for (int j = 0; j < 16; ++j) lv[j] = LF[blk * 16 + j];
#pragma unroll
            for (int q = 0; q < 8; ++q) bs += (q < blk) ? rv[q] : 0.f;
#pragma unroll
            for (int j = 0; j < 16; ++j) bs += (blk * 16 + j <= tid) ? lv[j] : 0.f;
            const float ig = bf2f(igq) + AR.in[I_BG][h];
            GS[tid] = ig - bs; ig_bs_hold = bs; if (tid == 127) RED[0] = bs; }
        __syncthreads();
        if (tid < 8) { float mb = -INFINITY, gv[16];
#pragma unroll
            for (int j = 0; j < 16; ++j) gv[j] = GS[tid * 16 + j];
#pragma unroll
            for (int j = 0; j < 16; ++j) mb = fmaxf(mb, gv[j]);
            RED[16 + tid] = mb; }
        __syncthreads();
        float rm[8];
#pragma unroll
        for (int q = 0; q < 8; ++q) rm[q] = RED[16 + q];
        float gmax = rm[0];
#pragma unroll
        for (int q = 1; q < 8; ++q) gmax = fmaxf(gmax, rm[q]);
        const float bL = RED[0];
        float wv = 0.f;
        if (tid < 128) { const int blk = tid >> 4; float pm = -INFINITY; const float gme = GS[tid];
            float gv[16];
#pragma unroll
            for (int j = 0; j < 16; ++j) gv[j] = GS[blk * 16 + j];
#pragma unroll
            for (int q = 0; q < 8; ++q) pm = (q < blk) ? fmaxf(pm, rm[q]) : pm;
#pragma unroll
            for (int j = 0; j < 16; ++j) pm = (blk * 16 + j <= tid) ? fmaxf(pm, gv[j]) : pm;
            float* gp = GATE + (size_t)item * 384; gp[tid] = ig_bs_hold; gp[128 + tid] = gme; gp[256 + tid] = pm;
            wv = fexp(gme - gmax); }
        __syncthreads();
        if (tid < 128) GS[tid] = wv;
        __syncthreads();
        const int vb = wave >> 1, kb0 = 2 * (wave & 1);
        f32x16 acc[2];
#pragma unroll
        for (int i = 0; i < 16; ++i) { acc[0][i] = 0.f; acc[1][i] = 0.f; }
#pragma unroll 2
        for (int ks = 0; ks < 8; ++ks) { const int s0 = 16 * ks + 8 * hh;
            float a[8]; unsigned vq[8];
            const int trow = (s0 + ((lane >> 2) & 3)) * 160 + (lane & 16) + 4 * (lane & 3);
            { const v2u u0 = __builtin_bit_cast(v2u, __builtin_amdgcn_ds_read_tr16_b64_v4i16((LAS trv4*)(Vs + trow + vb * 32))), u1 = __builtin_bit_cast(v2u, __builtin_amdgcn_ds_read_tr16_b64_v4i16((LAS trv4*)(Vs + trow + vb * 32 + 4 * 160)));
                vq[0] = u0.x & 0xffffu; vq[1] = u0.x >> 16; vq[2] = u0.y & 0xffffu; vq[3] = u0.y >> 16; vq[4] = u1.x & 0xffffu; vq[5] = u1.x >> 16; vq[6] = u1.y & 0xffffu; vq[7] = u1.y >> 16; }
            const f32x4 gq0 = *(const LAS f32x4*)(GS + s0), gq1 = *(const LAS f32x4*)(GS + s0 + 4); const float gq[8] = {gq0.x, gq0.y, gq0.z, gq0.w, gq1.x, gq1.y, gq1.z, gq1.w};
#pragma unroll
            for (int j = 0; j < 8; ++j) a[j] = bf2f(vq[j]) * gq[j];
            const bf16x8 A = pack8(a);
#pragma unroll
            for (int q = 0; q < 2; ++q) {
                const v2u u0 = __builtin_bit_cast(v2u, __builtin_amdgcn_ds_read_tr16_b64_v4i16((LAS trv4*)(Ks + trow + (kb0 + q) * 32))), u1 = __builtin_bit_cast(v2u, __builtin_amdgcn_ds_read_tr16_b64_v4i16((LAS trv4*)(Ks + trow + (kb0 + q) * 32 + 4 * 160)));
                const bf16x8 B = mk_frag(u0.x, u0.y, u1.x, u1.y);
                acc[q] = MFMA32(A, B, acc[q]); } }
        bf16* Co = (bf16*)CST + (size_t)item * 16384;
#pragma unroll
        for (int q = 0; q < 2; ++q)
#pragma unroll
            for (int i = 0; i < 16; ++i) Co[(vb * 32 + crow(i, hh)) * 128 + (kb0 + q) * 32 + r] = (bf16)f2bf(acc[q][i] * MSCALE);
        { const int kq = tid & 127, sq = tid >> 7; float n = 0.f;
#pragma unroll
            for (int s8 = 0; s8 < 4; ++s8) { unsigned kq8[8];
#pragma unroll
                for (int j = 0; j < 8; ++j) kq8[j] = Ks[(sq * 32 + 8 * s8 + j) * 160 + kq];
                const f32x4 g0 = *(const LAS f32x4*)(GS + sq * 32 + 8 * s8), g1 = *(const LAS f32x4*)(GS + sq * 32 + 8 * s8 + 4);
                n += g0.x * bf2f(kq8[0]); n += g0.y * bf2f(kq8[1]); n += g0.z * bf2f(kq8[2]); n += g0.w * bf2f(kq8[3]);
                n += g1.x * bf2f(kq8[4]); n += g1.y * bf2f(kq8[5]); n += g1.z * bf2f(kq8[6]); n += g1.w * bf2f(kq8[7]); }
            RED[32 + sq * 128 + kq] = n; }
        __syncthreads();
        if (tid < 128) NST[item * 128 + tid] = ((RED[32 + tid] + RED[32 + 128 + tid]) + (RED[32 + 256 + tid] + RED[32 + 384 + tid])) * MSCALE;
        if (tid == 0) { MST[item * 4 + 0] = bL + gmax; MST[item * 4 + 1] = bL; }
        __syncthreads();
    }
}

DI void ml_sample(Frame& F, const Args& AR) {
    const bf16* Z = (const bf16*)(F.ws + WS_Z); bf16* G = (bf16*)(F.ws + WS_H);
    const int tid = F.tid, lane = F.lane, sub = tid >> 8, t2 = tid & 255, w4 = F.wave & 3;
    LAS float* Qs = (LAS float*)F.lds + sub * 5632;
    LAS float* Ks = Qs + 1024; LAS float* Vs = Ks + 1024;
    LAS float* HT = Vs + 1024;
    LAS float* P = HT + 1024;
    LAS float* GT = P + 64;
    LAS float* SC = GT + 64;
    LAS float* N0 = SC + 4;
    const float* C0g = AR.in[I_SMC]; const float* n0g = AR.in[I_SMN]; const float* m0g = AR.in[I_SMM];
    for (int pr = F.vcu; pr < 256; pr += F.G) {
        const int item = 2 * pr + sub, b = item >> 2, h = item & 3; const size_t row0 = (size_t)MP + (size_t)b * SSEQ;
        const int v = t2 >> 1, seg = t2 & 1;
        const float* C0p = C0g + ((size_t)(b * 4 + h) * 128 + v) * 128 + seg * 4;
        f32x4 c0q[16];
#pragma unroll
        for (int i = 0; i < 16; ++i) c0q[i] = *(const f32x4*)(C0p + 8 * i);
        bf16 og[2][2];
#pragma unroll
        for (int k = 0; k < 2; ++k) { og[k][0] = Z[(row0 + 2 * w4 + k) * ZW + ZO + h * 128 + lane]; og[k][1] = Z[(row0 + 2 * w4 + k) * ZW + ZO + h * 128 + 64 + lane]; }
        const float m0 = m0g[b * 4 + h], n0v = n0g[(size_t)(b * 4 + h) * 128 + (t2 & 127)];
        const bf16 zgv = Z[(row0 + (t2 & 7)) * ZW + ((t2 & 15) < 8 ? ZIG : ZFG) + h];
        { unsigned uq[6];
#pragma unroll
            for (int i = 0; i < 6; ++i) { const int e = t2 + 256 * i, w = e >> 9, t = (e >> 6) & 7, c2 = (e & 63) * 2; uq[i] = *(const unsigned*)(Z + (row0 + t) * ZW + (w == 0 ? ZQ : (w == 1 ? ZK : ZV)) + h * 128 + c2); }
#pragma unroll
            for (int i = 0; i < 6; ++i) { const int e = t2 + 256 * i, w = e >> 9, t = (e >> 6) & 7, c2 = (e & 63) * 2;
                LAS float* dst = (w == 0 ? Qs : (w == 1 ? Ks : Vs)) + t * 128 + c2; dst[0] = bflo(uq[i]); dst[1] = bfhi(uq[i]); } }
        if (t2 >= 128) N0[t2 - 128] = n0v;
        if (t2 < 16) { const int t = t2 & 7; const float zv = bf2f(zgv);
            if (t2 < 8) P[t] = zv + AR.in[I_BG][h]; else GT[7 * 8 + t] = log_sigmoid(zv + AR.in[I_BG][4 + h]); }
        __syncthreads();
        if (t2 < 8) { float bs = 0.f, mx = m0, bsl = 0.f, gme = 0.f;
            const f32x4 f0 = *(const LAS f32x4*)(GT + 7 * 8), f1 = *(const LAS f32x4*)(GT + 7 * 8 + 4), i0 = *(const LAS f32x4*)P, i1 = *(const LAS f32x4*)(P + 4);
            const float fl[8] = {f0.x, f0.y, f0.z, f0.w, f1.x, f1.y, f1.z, f1.w}, ig[8] = {i0.x, i0.y, i0.z, i0.w, i1.x, i1.y, i1.z, i1.w};
#pragma unroll
            for (int s = 0; s < 8; ++s) { bs += fl[s]; const float g = ig[s] - bs; if (s <= t2) { mx = fmaxf(mx, g); bsl = bs; } if (s == t2) gme = g; }
            GT[0 * 8 + t2] = bsl; GT[1 * 8 + t2] = gme; GT[2 * 8 + t2] = mx; GT[3 * 8 + t2] = fexp(m0 - mx);
            if (t2 == 7) { const float mend = bsl + mx; SC[0] = mend; SC[1] = fexp(bsl + m0 - mend); } }
        __syncthreads();
        if (t2 < 8) { const float mend = SC[0]; GT[5 * 8 + t2] = fexp(GT[0 * 8 + 7] + GT[1 * 8 + t2] - mend); }
#pragma unroll
        for (int rep = 0; rep < 2; ++rep) { const int g = (t2 >> 3) + 32 * rep, l8 = t2 & 7, t = g >> 3, sq = g & 7; float d;
            { f32x4 qa[4], ka[4];
#pragma unroll
                for (int k4 = 0; k4 < 4; ++k4) { qa[k4] = *(const LAS f32x4*)(Qs + t * 128 + l8 * 16 + 4 * k4); ka[k4] = *(const LAS f32x4*)(Ks + sq * 128 + l8 * 16 + 4 * k4); }
                f32x4 dv = qa[0] * ka[0];
#pragma unroll
                for (int k4 = 1; k4 < 4; ++k4) dv += qa[k4] * ka[k4];
                d = (dv.x + dv.y) + (dv.z + dv.w); }
            d = sum8(d);
            if (l8 == 0) P[t * 8 + sq] = (sq <= t) ? d * MSCALE * fexp(GT[1 * 8 + sq] - GT[2 * 8 + t]) : 0.f;
            if (g < 8) { f32x4 qa[4], na[4];
#pragma unroll
                for (int k4 = 0; k4 < 4; ++k4) { qa[k4] = *(const LAS f32x4*)(Qs + g * 128 + l8 * 16 + 4 * k4); na[k4] = *(const LAS f32x4*)(N0 + l8 * 16 + 4 * k4); }
                f32x4 dv = qa[0] * na[0];
#pragma unroll
                for (int k4 = 1; k4 < 4; ++k4) dv += qa[k4] * na[k4];
                float q = (dv.x + dv.y) + (dv.z + dv.w);
                q = sum8(q); if (l8 == 0) GT[6 * 8 + g] = q; } }
        __syncthreads();
        if (t2 < 8) { const f32x4 p0 = *(const LAS f32x4*)(P + t2 * 8), p1 = *(const LAS f32x4*)(P + t2 * 8 + 4); const float g3 = GT[3 * 8 + t2], g6 = GT[6 * 8 + t2], g0 = GT[0 * 8 + t2], g2 = GT[2 * 8 + t2];
            float d = ((p0.x + p0.y) + (p0.z + p0.w)) + ((p1.x + p1.y) + (p1.z + p1.w)); d += g3 * g6;
            const float mt = g0 + g2; GT[4 * 8 + t2] = fmaxf(fabsf(d), fexp(-mt)); }
        __syncthreads();
        float inter[8];
#pragma unroll
        for (int t = 0; t < 8; ++t) { f32x4 dv = (f32x4){0.f, 0.f, 0.f, 0.f};
#pragma unroll
            for (int hq = 0; hq < 2; ++hq) { f32x4 qv[8];
#pragma unroll
                for (int i4 = 0; i4 < 8; ++i4) qv[i4] = *(const LAS f32x4*)(Qs + t * 128 + 8 * (8 * hq + i4) + 4 * seg);
#pragma unroll
                for (int i4 = 0; i4 < 8; ++i4) dv += c0q[8 * hq + i4] * qv[i4]; }
            float d = (dv.x + dv.y) + (dv.z + dv.w);
            d += __shfl_xor(d, 1); inter[t] = d; }
        if (seg == 0) { float vv[8], wi[8], dn[8];
#pragma unroll
            for (int s2 = 0; s2 < 8; ++s2) { vv[s2] = Vs[s2 * 128 + v]; wi[s2] = GT[3 * 8 + s2]; dn[s2] = GT[4 * 8 + s2]; }
#pragma unroll
            for (int t = 0; t < 8; ++t) { const f32x4 p0 = *(const LAS f32x4*)(P + t * 8), p1 = *(const LAS f32x4*)(P + t * 8 + 4);
                float num = wi[t] * inter[t];
                num += p0.x * vv[0]; num += p0.y * vv[1]; num += p0.z * vv[2]; num += p0.w * vv[3]; num += p1.x * vv[4]; num += p1.y * vv[5]; num += p1.z * vv[6]; num += p1.w * vv[7];
                HT[t * 128 + v] = num * __builtin_amdgcn_rcpf(dn[t]); } }
        { const float wst = SC[1]; float* Cout = F.out + O_SMC + ((size_t)(b * 4 + h) * 128 + v) * 128 + seg * 4;
#pragma unroll
            for (int i = 0; i < 16; ++i) c0q[i] *= wst;
#pragma unroll
            for (int s = 0; s < 8; ++s) { const float wv = GT[5 * 8 + s] * Vs[s * 128 + v] * MSCALE;
#pragma unroll
                for (int hq = 0; hq < 2; ++hq) { f32x4 kv[8];
#pragma unroll
                    for (int i4 = 0; i4 < 8; ++i4) kv[i4] = *(const LAS f32x4*)(Ks + s * 128 + 8 * (8 * hq + i4) + 4 * seg);
#pragma unroll
                    for (int i4 = 0; i4 < 8; ++i4) c0q[8 * hq + i4] += kv[i4] * wv; } }
#pragma unroll
            for (int i = 0; i < 16; ++i) *(f32x4*)(Cout + 8 * i) = c0q[i]; }
        if (t2 < 128) { float n = SC[1] * N0[t2];
            for (int s = 0; s < 8; ++s) n += GT[5 * 8 + s] * Ks[s * 128 + t2] * MSCALE;
            F.out[O_SMN + (size_t)(b * 4 + h) * 128 + t2] = n; }
        if (t2 == 0) F.out[O_SMM + b * 4 + h] = SC[0];
        __syncthreads();
#pragma unroll
        for (int k = 0; k < 2; ++k) { const int t = 2 * w4 + k; const float x0 = HT[t * 128 + lane], x1 = HT[t * 128 + 64 + lane];
            const float mean = wave_sum(x0 + x1) * (1.f / 128.f); const float d0 = x0 - mean, d1 = x1 - mean;
            const float rstd = __builtin_amdgcn_rsqf(wave_sum(d0 * d0 + d1 * d1) * (1.f / 128.f) + HEAD_EPS);
            const size_t row = row0 + t;
            const float o0 = bf2f(og[k][0]), o1 = bf2f(og[k][1]);
            const float g0 = AR.in[I_MNG][h * 128 + lane], g1 = AR.in[I_MNG][h * 128 + 64 + lane];
            G[row * D + h * 128 + lane] = (bf16)f2bf(d0 * rstd * g0 * fsig(o0)); G[row * D + h * 128 + 64 + lane] = (bf16)f2bf(d1 * rstd * g1 * fsig(o1)); }
        __syncthreads();
    }
}

template <bool SAMP>
DI void rg_conv(const Args& AR, const bf16* Z, const float* cw, const float* cbias, LAS float* XT, bf16x8 (&Af)[4], int row, int t, int b, int g, int r, int hh) {
#pragma unroll
    for (int kp = 0; kp < 2; ++kp) {
        v4u zq[2][4];
#pragma unroll
        for (int k2 = 0; k2 < 2; ++k2)
#pragma unroll
            for (int tap = 0; tap < 4; ++tap) { const bool ok = t + tap - 3 >= 0; zq[k2][tap] = *(const v4u*)(Z + (size_t)(ok ? row + tap - 3 : row) * ZW + ZXR + 64 * g + 16 * (2 * kp + k2) + 8 * hh); }
#pragma unroll
        for (int k2 = 0; k2 < 2; ++k2) { const int ks = 2 * kp + k2, c0 = 64 * g + 16 * ks + 8 * hh; float xc[8];
            f32x4 s0[3], s1[3], cw0[4], cw1[4];
            const f32x4 bq0 = *(const f32x4*)(cbias + c0), bq1 = *(const f32x4*)(cbias + c0 + 4);
#pragma unroll
            for (int tap = 0; tap < 4; ++tap) { cw0[tap] = *(const f32x4*)(cw + tap * 512 + c0); cw1[tap] = *(const f32x4*)(cw + tap * 512 + c0 + 4); }
            if constexpr (SAMP) {
#pragma unroll
                for (int tap = 0; tap < 3; ++tap) { const bool ok = t + tap - 3 >= 0; const float* sp = AR.in[I_SRC] + ((size_t)b * 3 + (ok ? 0 : t + tap)) * 512 + c0; s0[tap] = *(const f32x4*)sp; s1[tap] = *(const f32x4*)(sp + 4); } }
            xc[0] = bq0.x; xc[1] = bq0.y; xc[2] = bq0.z; xc[3] = bq0.w; xc[4] = bq1.x; xc[5] = bq1.y; xc[6] = bq1.z; xc[7] = bq1.w;
#pragma unroll
            for (int tap = 0; tap < 4; ++tap) { const bool ok = t + tap - 3 >= 0; const v4u q = zq[k2][tap]; float xv[8];
                xv[0] = bflo(q.x); xv[1] = bfhi(q.x); xv[2] = bflo(q.y); xv[3] = bfhi(q.y); xv[4] = bflo(q.z); xv[5] = bfhi(q.z); xv[6] = bflo(q.w); xv[7] = bfhi(q.w);
                if (tap < 3) {
                    if constexpr (SAMP) { const f32x4 q0 = s0[tap], q1 = s1[tap]; const float st[8] = {q0.x, q0.y, q0.z, q0.w, q1.x, q1.y, q1.z, q1.w};
#pragma unroll
                        for (int j = 0; j < 8; ++j) xv[j] = ok ? xv[j] : st[j]; }
                    else {
#pragma unroll
                        for (int j = 0; j < 8; ++j) xv[j] = ok ? xv[j] : 0.f; } }
                const f32x4 w0 = cw0[tap], w1 = cw1[tap];
                xc[0] += w0.x * xv[0]; xc[1] += w0.y * xv[1]; xc[2] += w0.z * xv[2]; xc[3] += w0.w * xv[3]; xc[4] += w1.x * xv[4]; xc[5] += w1.y * xv[5]; xc[6] += w1.z * xv[6]; xc[7] += w1.w * xv[7]; }
            Af[ks] = pack8(xc);
            LAS float* xp = XT + r * 68 + 16 * ks + 8 * hh;
            *(LAS f32x4*)xp = (f32x4){xc[0], xc[1], xc[2], xc[3]}; *(LAS f32x4*)(xp + 4) = (f32x4){xc[4], xc[5], xc[6], xc[7]};
            asm volatile("" ::: "memory"); }
    }
}
DI void rg1(Frame& F, const Args& AR) {
    const bf16* Z = (const bf16*)(F.ws + WS_Z); bf16* G = (bf16*)(F.ws + WS_H);
    unsigned* RGHP = (unsigned*)(F.ws + WS_RGH);
    float* TEH = (float*)(F.ws + WS_RGP); float* TEP = TEH + 512 * 512;
    const int lane = F.lane, g = F.wave, r = lane & 31, hh = lane >> 5;
    LAS float* XT = (LAS float*)(F.lds + g * 17408);
    LAS float* AT = XT + 32 * 68;
    bf16x8 Ba[4][2], Bx[4][2];
    { const GAS bf16* wf = (const GAS bf16*)(F.ws + WS_WRG);
#pragma unroll
        for (int ks = 0; ks < 4; ++ks)
#pragma unroll
            for (int cb = 0; cb < 2; ++cb) { const int e = ((((g * 4 + ks) * 2 + cb) * 2 + hh) * 32 + r) * 8;
                Ba[ks][cb] = *(const GAS bf16x8*)(wf + e); Bx[ks][cb] = *(const GAS bf16x8*)(wf + 4096 * 8 + e); } }
    float spl[2], ba[2], bx[2];
#pragma unroll
    for (int cb = 0; cb < 2; ++cb) { const int c = 64 * g + cb * 32 + r; spl[cb] = -8.0f * flog1p(__expf(-AR.in[I_LAM][c])); ba[cb] = AR.in[I_BA][c]; bx[cb] = AR.in[I_BX][c]; }
    const float* cw = AR.in[I_CW]; const float* cbias = AR.in[I_CB];
    for (int tt = F.vcu; tt < M / 32; tt += F.G) {
        const int R0 = tt * 32, row = R0 + r; const bool samp = R0 >= MP;
        int t, b; if (!samp) { t = row & (PSEQ - 1); b = row >> 11; } else { t = (row - MP) & 7; b = (row - MP) >> 3; }
        bf16x8 Af[4];
        if (samp) rg_conv<true>(AR, Z, cw, cbias, XT, Af, row, t, b, g, r, hh); else rg_conv<false>(AR, Z, cw, cbias, XT, Af, row, t, b, g, r, hh);
        LDS_WAIT(); asm volatile("" ::: "memory");
#pragma unroll
        for (int cb = 0; cb < 2; ++cb) { f32x16 da, dx;
#pragma unroll
            for (int i = 0; i < 16; ++i) { da[i] = 0.f; dx[i] = 0.f; }
#pragma unroll
            for (int ks = 0; ks < 4; ++ks) { da = MFMA32(Af[ks], Ba[ks][cb], da); dx = MFMA32(Af[ks], Bx[ks][cb], dx); }
#pragma unroll
            for (int i = 0; i < 16; ++i) { const int tr = crow(i, hh), j = cb * 32 + r;
                const float rg = fsig(da[i] + ba[cb]), ig = fsig(dx[i] + bx[cb]);
                const float la = spl[cb] * rg, a = fexp(la), xcv = XT[tr * 68 + j];
                const float u = __builtin_amdgcn_sqrtf(fmaxf(1.0f - a * a, 0.f)) * ig * xcv;
                AT[tr * 68 + j] = a; XT[tr * 68 + j] = u; } }
        LDS_WAIT(); asm volatile("" ::: "memory");
        { const int c = 64 * g + lane;
            if (!samp) { float h = 0.f, P = 1.f;
#pragma unroll
                for (int t8 = 0; t8 < 4; ++t8) { float av[8], uv[8];
#pragma unroll
                    for (int j = 0; j < 8; ++j) { av[j] = AT[(8 * t8 + j) * 68 + lane]; uv[j] = XT[(8 * t8 + j) * 68 + lane]; }
#pragma unroll
                    for (int j = 0; j < 8; ++j) { const int tr = 8 * t8 + j; h = av[j] * h + uv[j]; P *= av[j];
                        RGHP[(size_t)(R0 + tr) * 512 + c] = pk2(h, P); } }
                TEH[(size_t)tt * 512 + c] = h; TEP[(size_t)tt * 512 + c] = P; }
            else { float h = 0.f; const int b0 = (R0 - MP) >> 3;
                bf16 grq[32]; float h0q[4];
#pragma unroll
                for (int tr = 0; tr < 32; ++tr) grq[tr] = Z[(size_t)(R0 + tr) * ZW + ZGR + c];
#pragma unroll
                for (int q = 0; q < 4; ++q) h0q[q] = AR.in[I_SRH][(size_t)(b0 + q) * 512 + c];
#pragma unroll
                for (int tr = 0; tr < 32; ++tr) { const int bb = b0 + (tr >> 3);
                    if ((tr & 7) == 0) h = h0q[tr >> 3];
                    const float a = AT[tr * 68 + lane], u = XT[tr * 68 + lane]; h = a * h + u;
                    const float gr = bf2f(grq[tr]);
                    G[(size_t)(R0 + tr) * D + 512 + c] = (bf16)f2bf(h * gelu_tanh(gr));
                    if ((tr & 7) == 7) F.out[O_SRH + (size_t)bb * 512 + c] = h; } } }
        LDS_WAIT(); asm volatile("" ::: "memory");
    }
    { const int gt = F.vcu * NTHREADS + F.tid, NT = F.G * NTHREADS;
        for (int e = gt; e < NSEQ * 3 * 512; e += NT) { const int c = e & 511, j = (e >> 9) % 3, s = e / 1536;
            if (s < NPB) F.out[O_PRC + ((size_t)s * 3 + j) * 512 + c] = bf2f(Z[((size_t)s * PSEQ + PSEQ - 3 + j) * ZW + ZXR + c]);
            else { const int b = s - NPB; F.out[O_SRC + ((size_t)b * 3 + j) * 512 + c] = bf2f(Z[((size_t)MP + (size_t)b * SSEQ + SSEQ - 3 + j) * ZW + ZXR + c]); } } }
}

DI void ml2_scan(Frame& F, const Args& AR) {
    const float* CST = (const float*)(F.ws + WS_CST); float* NST = (float*)(F.ws + WS_NST); float* MST = (float*)(F.ws + WS_MST); bf16* CB = (bf16*)F.out;
    for (int vb = F.vcu; vb < 256; vb += F.G) {
        const int bh = vb >> 3, e0 = ((vb & 7) * NTHREADS + F.tid) * 4;
        float m = 0.f; float z0 = 0.f; asm volatile("" : "+v"(z0));
        f32x4 C = (f32x4){z0, z0, z0, z0};
        const bool nthr = (vb & 7) == 0 && F.tid < 128; float n = 0.f;
        v2u cl[16]; float ml[16], bl[16], nl[16];
#pragma unroll
        for (int c = 0; c < 16; ++c) { const int item = bh * 16 + c; cl[c] = *(const v2u*)((const bf16*)CST + (size_t)item * 16384 + e0); ml[c] = MST[item * 4 + 0]; bl[c] = MST[item * 4 + 1];
            nl[c] = nthr ? NST[item * 128 + F.tid] : 0.f; }
#pragma unroll
        for (int c = 0; c < 16; ++c) { const int item = bh * 16 + c;
            { v2u cw; cw.x = pk2(C.x, C.y); cw.y = pk2(C.z, C.w); *(v2u*)(CB + (size_t)item * 16384 + e0) = cw; }
            const float mn = fmaxf(bl[c] + m, ml[c]), w0 = fexp(bl[c] + m - mn), w1 = fexp(ml[c] - mn);
            C = C * w0 + (f32x4){bflo(cl[c].x), bfhi(cl[c].x), bflo(cl[c].y), bfhi(cl[c].y)} * w1;
            if (nthr) { NST[item * 128 + F.tid] = n; n = n * w0 + nl[c] * w1; if (F.tid == 0) MST[item * 4 + 2] = m; }
            m = mn; }
        *(f32x4*)(F.out + O_PMC + (size_t)bh * 16384 + e0) = C;
        if (nthr) { F.out[O_PMN + bh * 128 + F.tid] = n; if (F.tid == 0) F.out[O_PMM + bh] = m; }
    }
}
DI void rg2_carry(Frame& F, const Args& AR) {
    const float* TEH = (const float*)(F.ws + WS_RGP); const float* TEP = TEH + 512 * 512; float* CARRY = (float*)(F.ws + WS_CARRY);
    const int gt = F.vcu * NTHREADS + F.tid, NT = F.G * NTHREADS;
    for (int e = gt; e < NPB * 512; e += NT) { const int b = e >> 9, c = e & 511; float H = 0.f;
        for (int k0 = 0; k0 < 64; k0 += 16) { float pe[16], he[16];
#pragma unroll
            for (int k = 0; k < 16; ++k) { const size_t tl = (size_t)b * 64 + k0 + k; pe[k] = TEP[tl * 512 + c]; he[k] = TEH[tl * 512 + c]; }
#pragma unroll
            for (int k = 0; k < 16; ++k) { CARRY[((size_t)b * 64 + k0 + k) * 512 + c] = H; H = pe[k] * H + he[k]; } }
        F.out[O_PRH + (size_t)b * 512 + c] = H; }
}
DI void rg2_apply(Frame& F, const Args& AR) {
    const bf16* Z = (const bf16*)(F.ws + WS_Z); bf16* G = (bf16*)(F.ws + WS_H);
    const unsigned* RGHP = (const unsigned*)(F.ws + WS_RGH); const float* CARRY = (const float*)(F.ws + WS_CARRY);
    const int gt = F.vcu * NTHREADS + F.tid, NT = F.G * NTHREADS;
    for (int e0 = gt; e0 < MP * 64; e0 += 2 * NT) {
        v4u gqa[2], hpa[2][2]; f32x4 ca[2][2];
#pragma unroll
        for (int u = 0; u < 2; ++u) { const int e = e0 + u * NT < MP * 64 ? e0 + u * NT : e0, row = e >> 6, c0 = (e & 63) * 8, b = row >> 11, tile = (row & (PSEQ - 1)) >> 5;
            gqa[u] = *(const v4u*)(Z + (size_t)row * ZW + ZGR + c0);
            const unsigned* hp = RGHP + (size_t)row * 512 + c0; const float* cp = CARRY + ((size_t)b * 64 + tile) * 512 + c0;
#pragma unroll
            for (int q = 0; q < 2; ++q) { hpa[u][q] = *(const v4u*)(hp + 4 * q); ca[u][q] = *(const f32x4*)(cp + 4 * q); } }
#pragma unroll
        for (int u = 0; u < 2; ++u) { const int e = e0 + u * NT, row = e >> 6, c0 = (e & 63) * 8; const v4u gq = gqa[u];
            const float gr[8] = {bflo(gq.x), bfhi(gq.x), bflo(gq.y), bfhi(gq.y), bflo(gq.z), bfhi(gq.z), bflo(gq.w), bfhi(gq.w)};
            float o[8];
#pragma unroll
            for (int q = 0; q < 2; ++q) { const v4u hq = hpa[u][q]; const f32x4 hl = (f32x4){bflo(hq.x), bflo(hq.y), bflo(hq.z), bflo(hq.w)}, pl = (f32x4){bfhi(hq.x), bfhi(hq.y), bfhi(hq.z), bfhi(hq.w)};
                const f32x4 hv = hl + pl * ca[u][q];
                o[4 * q] = hv.x * gelu_tanh(gr[4 * q]); o[4 * q + 1] = hv.y * gelu_tanh(gr[4 * q + 1]); o[4 * q + 2] = hv.z * gelu_tanh(gr[4 * q + 2]); o[4 * q + 3] = hv.w * gelu_tanh(gr[4 * q + 3]); }
            v4u w; w.x = pk2(o[0], o[1]); w.y = pk2(o[2], o[3]); w.z = pk2(o[4], o[5]); w.w = pk2(o[6], o[7]);
            if (e < MP * 64) *(v4u*)(G + (size_t)row * D + 512 + c0) = w; } }
}

DI void ml3_prompt(Frame& F, const Args& AR) {
    const bf16* Z = (const bf16*)(F.ws + WS_Z); bf16* G = (bf16*)(F.ws + WS_H);
    const float* NST = (const float*)(F.ws + WS_NST); const float* MST = (const float*)(F.ws + WS_MST); const float* GATE = (const float*)(F.ws + WS_GATE);
    LAS bf16* Qs = (LAS bf16*)F.lds;
    LAS bf16* Ks = (LAS bf16*)(F.lds + 34816);
    LAS bf16* Vs = (LAS bf16*)(F.lds + 69632);
    LAS float* LF = (LAS float*)(F.lds + 110592);
    LAS float* BC = LF + 128;
    LAS float* GS = BC + 128;
    LAS float* MX = GS + 128;
    LAS float* N0 = MX + 128;
    LAS float* RA = N0 + 128;
    LAS float* RB = RA + 256;
    LAS float* OT = (LAS float*)F.lds;
    const int tid = F.tid, lane = F.lane, wave = F.wave, r = lane & 31, hh = lane >> 5;
    const int tb = wave >> 1, vh = wave & 1, t = tb * 32 + r;
    for (int item = F.vcu; item < 512; item += F.G) {
        const int b = item >> 6, h = (item >> 4) & 3, c = item & 15; const size_t row0 = (size_t)b * PSEQ + c * 128;
        const float m0 = MST[item * 4 + 2]; const bf16* C0 = (const bf16*)F.out + (size_t)item * 16384;
        const float* gp = GATE + (size_t)item * 384; const int tq = tid & 127;
        const float g0 = gp[tq], g1 = gp[128 + tq], g2 = gp[256 + tq], g3 = NST[item * 128 + tq];
        { v4u qq[4], kq[4], vq[4];
#pragma unroll
            for (int i = 0; i < 4; ++i) { const int e = tid + i * NTHREADS, s = e >> 4, c8 = (e & 15) * 8; const bf16* zr = Z + (row0 + s) * ZW + h * 128 + c8;
                qq[i] = *(const v4u*)(zr + ZQ); kq[i] = *(const v4u*)(zr + ZK); vq[i] = *(const v4u*)(zr + ZV); }
#pragma unroll
            for (int i = 0; i < 4; ++i) { const int e = tid + i * NTHREADS, s = e >> 4, c8 = (e & 15) * 8;
                *(LAS v4u*)(Qs + s * 136 + c8) = qq[i]; *(LAS v4u*)(Ks + s * 136 + c8) = kq[i]; *(LAS v4u*)(Vs + s * 160 + c8) = vq[i]; } }
        if (tid < 128) { BC[tid] = g0; GS[tid] = g1; MX[tid] = fmaxf(m0, g2); N0[tid] = g3; }
        __syncthreads();
        const float mxt = MX[t], winter = fexp(m0 - mxt);
        bf16x8 bq[8];
#pragma unroll
        for (int ks = 0; ks < 8; ++ks) bq[ks] = *(const LAS bf16x8*)(Qs + t * 136 + 16 * ks + 8 * hh);
        bf16x8 pp[4][2]; float den = 0.f;
#pragma unroll
        for (int sb = 0; sb < 4; ++sb) {
            if (sb <= tb) { f32x16 sa;
#pragma unroll
                for (int i = 0; i < 16; ++i) sa[i] = 0.f;
#pragma unroll
                for (int ks = 0; ks < 8; ++ks) sa = MFMA32(*(const LAS bf16x8*)(Ks + (sb * 32 + r) * 136 + 16 * ks + 8 * hh), bq[ks], sa);
                float pv[16], gsv[16];
#pragma unroll
                for (int i = 0; i < 16; ++i) gsv[i] = GS[sb * 32 + crow(i, hh)];
#pragma unroll
                for (int i = 0; i < 16; ++i) { const int s = sb * 32 + crow(i, hh); float v = sa[i] * MSCALE * fexp(gsv[i] - mxt); if (s > t) v = 0.f; pv[i] = v; den += v; }
                pp[sb][0] = mk_frag(pk2(pv[0], pv[1]), pk2(pv[2], pv[3]), pk2(pv[4], pv[5]), pk2(pv[6], pv[7]));
                pp[sb][1] = mk_frag(pk2(pv[8], pv[9]), pk2(pv[10], pv[11]), pk2(pv[12], pv[13]), pk2(pv[14], pv[15]));
            } else { pp[sb][0] = mk_frag(0u, 0u, 0u, 0u); pp[sb][1] = mk_frag(0u, 0u, 0u, 0u); } }
        den += __shfl_xor(den, 32);
        float qn = 0.f;
#pragma unroll 8
        for (int k = 0; k < 64; ++k) qn += N0[hh * 64 + k] * bf2f(Qs[t * 136 + hh * 64 + k]);
        qn += __shfl_xor(qn, 32);
        const float dtot = den + winter * qn, denom = fmaxf(fabsf(dtot), fexp(-(BC[t] + mxt))), rden = 1.0f / denom;
        float hv[2][16];
#pragma unroll
        for (int q = 0; q < 2; ++q) { const int vb = vh * 2 + q; f32x16 an, ai;
#pragma unroll
            for (int i = 0; i < 16; ++i) { an[i] = 0.f; ai[i] = 0.f; }
#pragma unroll
            for (int sb = 0; sb < 4; ++sb) if (sb <= tb) {
#pragma unroll
                for (int s2 = 0; s2 < 2; ++s2) {
                    const LAS bf16* vp = Vs + (sb * 32 + 16 * s2 + 4 * hh + ((lane >> 2) & 3)) * 160 + vb * 32 + (lane & 16) + 4 * (lane & 3);
                    const trv4 t0 = __builtin_amdgcn_ds_read_tr16_b64_v4i16((LAS trv4*)vp), t1 = __builtin_amdgcn_ds_read_tr16_b64_v4i16((LAS trv4*)(vp + 8 * 160));
                    const v2u u0 = __builtin_bit_cast(v2u, t0), u1 = __builtin_bit_cast(v2u, t1);
                    an = MFMA32(mk_frag(u0.x, u0.y, u1.x, u1.y), pp[sb][s2], an); } }
            { bf16x8 cb[8];
#pragma unroll
                for (int ks = 0; ks < 8; ++ks) cb[ks] = *(const bf16x8*)(C0 + (size_t)(vb * 32 + r) * 128 + 16 * ks + 8 * hh);
#pragma unroll
                for (int ks = 0; ks < 8; ++ks) ai = MFMA32(cb[ks], bq[ks], ai); }
#pragma unroll
            for (int i = 0; i < 16; ++i) hv[q][i] = (an[i] + winter * ai[i]) * rden; }
        float s1 = 0.f;
#pragma unroll
        for (int q = 0; q < 2; ++q)
#pragma unroll
            for (int i = 0; i < 16; ++i) s1 += hv[q][i];
        s1 += __shfl_xor(s1, 32);
        if (hh == 0) RA[vh * 128 + t] = s1;
        __syncthreads();
        const float mean = (RA[t] + RA[128 + t]) * (1.f / 128.f); float s2 = 0.f;
#pragma unroll
        for (int q = 0; q < 2; ++q)
#pragma unroll
            for (int i = 0; i < 16; ++i) { hv[q][i] -= mean; s2 += hv[q][i] * hv[q][i]; }
        s2 += __shfl_xor(s2, 32);
        if (hh == 0) RB[vh * 128 + t] = s2;
        __syncthreads();
        const float rstd = 1.f / sqrtf((RB[t] + RB[128 + t]) * (1.f / 128.f) + HEAD_EPS);
#pragma unroll
        for (int q = 0; q < 2; ++q)
#pragma unroll
            for (int i = 0; i < 16; ++i) OT[t * 132 + (vh * 2 + q) * 32 + crow(i, hh)] = hv[q][i] * rstd;
        __syncthreads();
        { const int tt = tid >> 2, v0 = (tid & 3) * 32; const size_t row = row0 + tt;
            v4u oqa[4]; f32x4 ga[4][2];
#pragma unroll
            for (int q = 0; q < 4; ++q) { const int v = v0 + 8 * q; oqa[q] = *(const v4u*)(Z + row * ZW + ZO + h * 128 + v);
                ga[q][0] = *(const f32x4*)(AR.in[I_MNG] + h * 128 + v); ga[q][1] = *(const f32x4*)(AR.in[I_MNG] + h * 128 + v + 4); }
#pragma unroll
            for (int q = 0; q < 4; ++q) { const int v = v0 + 8 * q; const v4u oq = oqa[q];
                const float og[8] = {bflo(oq.x), bfhi(oq.x), bflo(oq.y), bfhi(oq.y), bflo(oq.z), bfhi(oq.z), bflo(oq.w), bfhi(oq.w)};
                const f32x4 g0 = ga[q][0], g1 = ga[q][1];
                const f32x4 x0 = *(const LAS f32x4*)(OT + tt * 132 + v), x1 = *(const LAS f32x4*)(OT + tt * 132 + v + 4);
                v4u w; w.x = pk2(x0.x * g0.x * fsig(og[0]), x0.y * g0.y * fsig(og[1])); w.y = pk2(x0.z * g0.z * fsig(og[2]), x0.w * g0.w * fsig(og[3]));
                w.z = pk2(x1.x * g1.x * fsig(og[4]), x1.y * g1.y * fsig(og[5])); w.w = pk2(x1.z * g1.z * fsig(og[6]), x1.w * g1.w * fsig(og[7]));
                *(v4u*)(G + row * D + h * 128 + v) = w; } }
        __syncthreads();
    }
}

constexpr int TC = 32;
constexpr int RW_ARR = TC * 64;
constexpr int RW_BUF_FLOATS = 6 * RW_ARR + 2 * TC;
struct RwRaw { v2u r, k, v, w, a, g; };
DI void rw_load(RwRaw& x, const bf16* RK, const bf16* WAG, size_t row, size_t row_safe, int h, int k4, bool valid) {
    const size_t rr = valid ? row : row_safe;
    const bf16* p = RK + rr * RKW + h * 64 + k4; const bf16* q = WAG + rr * WAGW + h * 64 + k4;
    x.r = *(const v2u*)p; x.k = *(const v2u*)(p + 1024); x.v = *(const v2u*)(p + 2048); x.w = *(const v2u*)q; x.a = *(const v2u*)(q + 1024); x.g = *(const v2u*)(q + 2048);
}
DI void un4(const v2u u, float (&f)[4]) { f[0] = bflo(u.x); f[1] = bfhi(u.x); f[2] = bflo(u.y); f[3] = bfhi(u.y); }
DI float rw_prep(const RwRaw& x, LAS float* buf, int tok, int k4, const float (&kkw)[4], const float (&kaw)[4], const float (&rkw)[4]) {
    float r[4], k[4], v[4], w[4], a[4]; un4(x.r, r); un4(x.k, k); un4(x.v, v); un4(x.w, w); un4(x.a, a);
    float kk[4], ss = 0.f, bs = 0.f, km[4];
#pragma unroll
    for (int j = 0; j < 4; ++j) { kk[j] = k[j] * kkw[j]; ss += kk[j] * kk[j]; km[j] = k[j] * (1.0f + (a[j] - 1.0f) * kaw[j]); bs += r[j] * km[j] * rkw[j]; }
    ss = sum16(ss); bs = sum16(bs);
    const float inv = 1.0f / fmaxf(sqrtf(ss), 1e-12f);
    f32x4 o0, o1, o2, o3, o4, o5; float br = 0.f, kr = 0.f;
#pragma unroll
    for (int j = 0; j < 4; ++j) { const float kn = kk[j] * inv, dc = __builtin_amdgcn_exp2f(w[j]); o0[j] = kn; o1[j] = kn * a[j]; o2[j] = km[j]; o3[j] = dc; o4[j] = dc * r[j]; o5[j] = v[j];
        br += kn * a[j] * r[j]; kr += km[j] * r[j]; }
    br = sum16(br); kr = sum16(kr);
    LAS float* p = buf + tok * 64 + k4;
    *(LAS f32x4*)p = o0; *(LAS f32x4*)(p + RW_ARR) = o1; *(LAS f32x4*)(p + 2 * RW_ARR) = o2; *(LAS f32x4*)(p + 3 * RW_ARR) = o3;
    *(LAS f32x4*)(p + 4 * RW_ARR) = o4; *(LAS f32x4*)(p + 5 * RW_ARR) = o5;
    if (k4 == 0) *(LAS f32x2*)(buf + 6 * RW_ARR + 2 * tok) = (f32x2){br, kr};
    return bs;
}
#define BAR_LDS() do { asm volatile("s_waitcnt lgkmcnt(0)" ::: "memory"); __builtin_amdgcn_s_barrier(); asm volatile("" ::: "memory"); } while (0)
#define NOPK(x) asm volatile("" : "+v"(x))
DI void sum8x2(float& a, float& b) {
    asm volatile("s_nop 1\n\t"
                 "v_add_f32_dpp %0, %0, %0 quad_perm:[1,0,3,2] row_mask:0xf bank_mask:0xf\n\tv_add_f32_dpp %1, %1, %1 quad_perm:[1,0,3,2] row_mask:0xf bank_mask:0xf\n\ts_nop 0\n\t"
                 "v_add_f32_dpp %0, %0, %0 quad_perm:[2,3,0,1] row_mask:0xf bank_mask:0xf\n\tv_add_f32_dpp %1, %1, %1 quad_perm:[2,3,0,1] row_mask:0xf bank_mask:0xf\n\ts_nop 0\n\t"
                 "v_add_f32_dpp %0, %0, %0 row_half_mirror row_mask:0xf bank_mask:0xf\n\tv_add_f32_dpp %1, %1, %1 row_half_mirror row_mask:0xf bank_mask:0xf\n\ts_nop 0"
                 : "+v"(a), "+v"(b));
}
struct StepV { f32x4 ka, kb, ba, bb, ma, mb, da, db, ea, eb; float vv; f32x2 sc; };
DI void ld_step(StepV& s, const LAS float* cur, int tk, int p, int row) {
    const LAS float* q = cur + tk * 64 + 8 * p;
    s.ka = *(const LAS f32x4*)q; s.kb = *(const LAS f32x4*)(q + 4); s.ba = *(const LAS f32x4*)(q + RW_ARR); s.bb = *(const LAS f32x4*)(q + RW_ARR + 4);
    s.ma = *(const LAS f32x4*)(q + 2 * RW_ARR); s.mb = *(const LAS f32x4*)(q + 2 * RW_ARR + 4); s.da = *(const LAS f32x4*)(q + 3 * RW_ARR); s.db = *(const LAS f32x4*)(q + 3 * RW_ARR + 4);
    s.ea = *(const LAS f32x4*)(q + 4 * RW_ARR); s.eb = *(const LAS f32x4*)(q + 4 * RW_ARR + 4);
    s.vv = cur[5 * RW_ARR + tk * 64 + row]; s.sc = *(const LAS f32x2*)(cur + 6 * RW_ARR + 2 * tk);
}
DI void sum16x4(float& a, float& b, float& c, float& d) {
#define DPP4(ctrl) "v_add_f32_dpp %0, %0, %0 " ctrl " row_mask:0xf bank_mask:0xf\n\tv_add_f32_dpp %1, %1, %1 " ctrl " row_mask:0xf bank_mask:0xf\n\tv_add_f32_dpp %2, %2, %2 " ctrl " row_mask:0xf bank_mask:0xf\n\tv_add_f32_dpp %3, %3, %3 " ctrl " row_mask:0xf bank_mask:0xf\n\t"
    asm volatile("s_nop 1\n\t" DPP4("quad_perm:[1,0,3,2]") DPP4("quad_perm:[2,3,0,1]") DPP4("row_half_mirror") DPP4("row_mirror") "s_nop 0" : "+v"(a), "+v"(b), "+v"(c), "+v"(d));
#undef DPP4
}
constexpr int RQ_KK = 0, RQ_BB = 8192, RQ_KM = 16384, RQ_DC = 24576, RQ_EE = 32768, RQ_VV = 40960, RQ_BUF_BYTES = 57344;
DI float rw_prep_q(const RwRaw& x, LAS unsigned char* buf, int tok, int k4, const float (&kkw)[4], const float (&kaw)[4], const float (&rkw)[4]) {
    float r[4], k[4], v[4], w[4], a[4]; un4(x.r, r); un4(x.k, k); un4(x.v, v); un4(x.w, w); un4(x.a, a);
    float kk[4], ka[4], km[4], ss = 0.f, bs = 0.f, t1 = 0.f, kr = 0.f;
#pragma unroll
    for (int j = 0; j < 4; ++j) { kk[j] = k[j] * kkw[j]; ss = fmaf(kk[j], kk[j], ss); km[j] = k[j] * fmaf(a[j], kaw[j], 1.0f - kaw[j]); bs = fmaf(r[j] * km[j], rkw[j], bs);
        ka[j] = kk[j] * a[j]; t1 = fmaf(ka[j], r[j], t1); kr = fmaf(km[j], r[j], kr); }
    sum16x4(ss, bs, t1, kr);
    const float inv = __builtin_amdgcn_rsqf(fmaxf(ss, 1e-24f)), br = inv * t1;
    f32x4 okk, obb, okm, odc, oee;
#pragma unroll
    for (int j = 0; j < 4; ++j) { okk[j] = kk[j] * inv; obb[j] = ka[j] * inv; okm[j] = km[j]; odc[j] = __builtin_amdgcn_exp2f(w[j]); oee[j] = odc[j] * r[j] - br * okk[j]; }
    LAS unsigned char* p = buf + tok * 256 + k4 * 4;
    *(LAS f32x4*)(p + RQ_KK) = okk; *(LAS f32x4*)(p + RQ_BB) = obb; *(LAS f32x4*)(p + RQ_KM) = okm; *(LAS f32x4*)(p + RQ_DC) = odc; *(LAS f32x4*)(p + RQ_EE) = oee;
    LAS float* vp = (LAS float*)(buf + RQ_VV + (tok * 64 + k4) * 8);
    *(LAS f32x4*)vp = (f32x4){v[0], v[0] * kr, v[1], v[1] * kr}; *(LAS f32x4*)(vp + 4) = (f32x4){v[2], v[2] * kr, v[3], v[3] * kr};
    return bs;
}
struct StepQ { f32x4 k, b, m, d, e, vv; };
template <int TK> DI void ld_stepq(StepQ& s, unsigned aq, unsigned av) {
    asm volatile("ds_read_b128 %0, %6 offset:%8\n\tds_read_b128 %4, %6 offset:%12\n\tds_read_b128 %3, %6 offset:%11\n\tds_read_b128 %2, %6 offset:%10\n\t"
                 "ds_read_b128 %1, %6 offset:%9\n\tds_read_b128 %5, %7 offset:%13"
                 : "=&v"(s.k), "=&v"(s.b), "=&v"(s.m), "=&v"(s.d), "=&v"(s.e), "=&v"(s.vv) : "v"(aq), "v"(av),
                   "n"(RQ_KK + 256 * TK), "n"(RQ_BB + 256 * TK), "n"(RQ_KM + 256 * TK), "n"(RQ_DC + 256 * TK), "n"(RQ_EE + 256 * TK), "n"(512 * TK) : "memory");
}
template <int N> DI void wait_stepqn(StepQ& s) { asm volatile("s_waitcnt lgkmcnt(%6)" : "+v"(s.k), "+v"(s.b), "+v"(s.m), "+v"(s.d), "+v"(s.e), "+v"(s.vv) : "n"(N) : "memory"); }
DI void rw_stepq(float (&S)[2][4], const StepQ& c, LAS float* ydst, bool wr) {
    float r[4];
#pragma unroll
    for (int i = 0; i < 2; ++i) {
        float a = S[i][0] * c.k.x; a = fmaf(S[i][1], c.k.y, a); a = fmaf(S[i][2], c.k.z, a); a = fmaf(S[i][3], c.k.w, a); NOPK(a); r[i] = a;
        float y = S[i][0] * c.e.x; y = fmaf(S[i][1], c.e.y, y); y = fmaf(S[i][2], c.e.z, y); y = fmaf(S[i][3], c.e.w, y); NOPK(y); r[2 + i] = y; }
    sum16x4(r[0], r[1], r[2], r[3]);
#pragma unroll
    for (int i = 0; i < 2; ++i) { const float sa = -r[i], v = i == 0 ? c.vv.x : c.vv.z; float t;
        t = S[i][0] * c.d.x; t = fmaf(c.m.x, v, t); t = fmaf(c.b.x, sa, t); NOPK(t); S[i][0] = t;
        t = S[i][1] * c.d.y; t = fmaf(c.m.y, v, t); t = fmaf(c.b.y, sa, t); NOPK(t); S[i][1] = t;
        t = S[i][2] * c.d.z; t = fmaf(c.m.z, v, t); t = fmaf(c.b.z, sa, t); NOPK(t); S[i][2] = t;
        t = S[i][3] * c.d.w; t = fmaf(c.m.w, v, t); t = fmaf(c.b.w, sa, t); NOPK(t); S[i][3] = t; }
    if (wr) *(LAS f32x2*)ydst = (f32x2){r[2] + c.vv.y, r[3] + c.vv.w};
    asm volatile("" ::: "memory");
}
template <int TK> DI void rw_chunk_steps(float (&S)[2][4], StepQ (&st)[4], unsigned aq, unsigned av, LAS float* yb, bool wr) {
    if constexpr (TK < TC) {
        if constexpr (TK + 3 < TC) ld_stepq<TK + 3>(st[(TK + 3) & 3], aq, av);
        rw_stepq(S, st[TK & 3], yb + TK * 32, wr);
        if constexpr (TK + 3 < TC) wait_stepqn<15>(st[(TK + 1) & 3]); else if constexpr (TK + 2 < TC) wait_stepqn<8>(st[(TK + 1) & 3]); else if constexpr (TK + 1 < TC) wait_stepqn<1>(st[(TK + 1) & 3]);
        rw_chunk_steps<TK + 1>(S, st, aq, av, yb, wr);
    }
}
DI void rw_prompt_half(Frame& F, const Args& AR, int b, int h, int half, float* Sout) {
    const bf16* RK = (const bf16*)(F.ws + WS_RK); const bf16* WAG = (const bf16*)(F.ws + WS_WAG); bf16* G = (bf16*)(F.ws + WS_H); float* BN = (float*)(F.ws + WS_BN);
    LAS unsigned char* BUF = F.lds;
    LAS float* YB = (LAS float*)(F.lds + 2 * RQ_BUF_BYTES);
    const int tid = F.tid; const size_t row0 = (size_t)b * PSEQ;
    constexpr int nch = PSEQ / TC;
    if (tid < 256) {
        const int rp = tid >> 4, cg = tid & 15, rowp = 32 * half + 2 * rp;
        float S[2][4];
#pragma unroll
        for (int i = 0; i < 2; ++i)
#pragma unroll
            for (int j = 0; j < 4; ++j) S[i][j] = 0.f;
        BAR_LDS();
        for (int ch = 0; ch < nch; ++ch) {
            const unsigned cb = (unsigned)(size_t)(BUF + (ch & 1) * RQ_BUF_BYTES); LAS float* yb = YB + (ch & 1) * (TC * 32);
            const unsigned aq = cb + 16u * cg, av = cb + RQ_VV + 8u * rowp;
            StepQ st[4];
            ld_stepq<0>(st[0], aq, av); ld_stepq<1>(st[1], aq, av); ld_stepq<2>(st[2], aq, av); wait_stepqn<12>(st[0]);
            rw_chunk_steps<0>(S, st, aq, av, yb + 2 * rp, cg == 0);
            BAR_LDS();
        }
#pragma unroll
        for (int i = 0; i < 2; ++i) *(f32x4*)(Sout + (rowp + i) * 64 + 4 * cg) = (f32x4){S[i][0], S[i][1], S[i][2], S[i][3]};
        BAR_LDS();
    } else {
        const int ht = tid - 256, tk0 = ht >> 4, k4 = (ht & 15) * 4;
        const int yt = ht >> 3, yv4 = (ht & 7) * 4;
        float kkw[4], kaw[4], rkw[4];
#pragma unroll
        for (int j = 0; j < 4; ++j) { const int c = h * 64 + k4 + j; kkw[j] = AR.in[I_KK][c]; kaw[j] = AR.in[I_KA][c]; rkw[j] = AR.in[I_RK][c]; }
        RwRaw raw[2];
#pragma unroll
        for (int i = 0; i < 2; ++i) { rw_load(raw[i], RK, WAG, row0 + tk0 + 16 * i, row0, h, k4, true);
            const float bn = rw_prep_q(raw[i], BUF, tk0 + 16 * i, k4, kkw, kaw, rkw); if (half == 0 && k4 == 0) BN[(row0 + tk0 + 16 * i) * 16 + h] = bn; }
#pragma unroll
        for (int i = 0; i < 2; ++i) rw_load(raw[i], RK, WAG, row0 + TC + tk0 + 16 * i, row0, h, k4, true);
        BAR_LDS();
        for (int ch = 0; ch < nch; ++ch) {
            const int base = ch * TC;
            if (ch > 0) { const f32x4 y4 = *(const LAS f32x4*)(YB + ((ch - 1) & 1) * (TC * 32) + yt * 32 + yv4);
                v2u w; w.x = pk2(y4.x, y4.y); w.y = pk2(y4.z, y4.w); *(v2u*)(G + (row0 + base - TC + yt) * D + h * 64 + 32 * half + yv4) = w; }
            if (ch + 1 < nch) {
#pragma unroll
                for (int i = 0; i < 2; ++i) { const float bn = rw_prep_q(raw[i], BUF + ((ch + 1) & 1) * RQ_BUF_BYTES, tk0 + 16 * i, k4, kkw, kaw, rkw);
                    if (half == 0 && k4 == 0) BN[(row0 + base + TC + tk0 + 16 * i) * 16 + h] = bn; }
#pragma unroll
                for (int i = 0; i < 2; ++i) rw_load(raw[i], RK, WAG, row0 + base + 2 * TC + tk0 + 16 * i, row0, h, k4, base + 2 * TC < PSEQ);
            }
            BAR_LDS();
        }
        { const f32x4 y4 = *(const LAS f32x4*)(YB + ((nch - 1) & 1) * (TC * 32) + yt * 32 + yv4);
            v2u w; w.x = pk2(y4.x, y4.y); w.y = pk2(y4.z, y4.w); *(v2u*)(G + (row0 + PSEQ - TC + yt) * D + h * 64 + 32 * half + yv4) = w; }
        BAR_LDS();
    }
}
DI void rw_gn_pass(Frame& F, const Args& AR) {
    const bf16* RK = (const bf16*)(F.ws + WS_RK); const bf16* WAG = (const bf16*)(F.ws + WS_WAG); bf16* G = (bf16*)(F.ws + WS_H); const float* BN = (const float*)(F.ws + WS_BN);
    const int gt = F.vcu * NTHREADS + F.tid, NT = F.G * NTHREADS;
    const int h = (gt >> 3) & 15, k8 = (gt & 7) * 8, c = h * 64 + k8;
    float lg[8], lb[8]; ld8(lg, AR.in[I_LXG] + c); ld8(lb, AR.in[I_LXB] + c);
    for (int e0 = gt; e0 < MP * 128; e0 += 4 * NT) {
        v4u yq[4], vq[4], gq[4]; float bnq[4];
#pragma unroll
        for (int u = 0; u < 4; ++u) { const int e = e0 + u * NT < MP * 128 ? e0 + u * NT : e0, row = e >> 7;
            yq[u] = *(const v4u*)(G + (size_t)row * D + c); vq[u] = *(const v4u*)(RK + (size_t)row * RKW + 2048 + c); gq[u] = *(const v4u*)(WAG + (size_t)row * WAGW + 2048 + c); bnq[u] = BN[row * 16 + h]; }
#pragma unroll
        for (int u = 0; u < 4; ++u) { const int e = e0 + u * NT, row = e >> 7; const float bn = bnq[u];
            const float y[8] = {bflo(yq[u].x), bfhi(yq[u].x), bflo(yq[u].y), bfhi(yq[u].y), bflo(yq[u].z), bfhi(yq[u].z), bflo(yq[u].w), bfhi(yq[u].w)};
            const float v[8] = {bflo(vq[u].x), bfhi(vq[u].x), bflo(vq[u].y), bfhi(vq[u].y), bflo(vq[u].z), bfhi(vq[u].z), bflo(vq[u].w), bfhi(vq[u].w)};
            const float g[8] = {bflo(gq[u].x), bfhi(gq[u].x), bflo(gq[u].y), bfhi(gq[u].y), bflo(gq[u].z), bfhi(gq[u].z), bflo(gq[u].w), bfhi(gq[u].w)};
            const float mean = sum8(((y[0] + y[1]) + (y[2] + y[3])) + ((y[4] + y[5]) + (y[6] + y[7]))) * (1.f / 64.f);
            float d[8], s2 = 0.f;
#pragma unroll
            for (int j = 0; j < 8; ++j) { d[j] = y[j] - mean; s2 += d[j] * d[j]; }
            const float rstd = __builtin_amdgcn_rsqf(sum8(s2) * (1.f / 64.f) + RW_EPS);
            float o[8];
#pragma unroll
            for (int j = 0; j < 8; ++j) o[j] = (d[j] * rstd * lg[j] + lb[j] + bn * v[j]) * g[j];
            v4u w; w.x = pk2(o[0], o[1]); w.y = pk2(o[2], o[3]); w.z = pk2(o[4], o[5]); w.w = pk2(o[6], o[7]);
            if (e < MP * 128) *(v4u*)(G + (size_t)row * D + c) = w; }
    }
}
constexpr int RS_WAVE_BYTES = 16640;
DI void ld8b(float (&f)[8], const bf16* p) { const v4u q = *(const v4u*)p; f[0] = bflo(q.x); f[1] = bfhi(q.x); f[2] = bflo(q.y); f[3] = bfhi(q.y); f[4] = bflo(q.z); f[5] = bfhi(q.z); f[6] = bflo(q.w); f[7] = bfhi(q.w); }
DI void st8(LAS float* p, const float (&f)[8]) { *(LAS f32x4*)p = (f32x4){f[0], f[1], f[2], f[3]}; *(LAS f32x4*)(p + 4) = (f32x4){f[4], f[5], f[6], f[7]}; }
DI void rw_sample_wave(Frame& F, const Args& AR, int item) {
    const bf16* RK = (const bf16*)(F.ws + WS_RK); const bf16* WAG = (const bf16*)(F.ws + WS_WAG); bf16* G = (bf16*)(F.ws + WS_H);
    const int lane = F.lane, b = item >> 4, h = item & 15; const size_t row0 = (size_t)MP + (size_t)b * SSEQ;
    LAS float* L = (LAS float*)(F.lds + F.wave * RS_WAVE_BYTES);
    f32x4 Sq[16];
    { const float* sp = AR.in[I_SWKV] + (size_t)item * 4096 + lane * 64;
#pragma unroll
        for (int j = 0; j < 16; ++j) Sq[j] = *(const f32x4*)(sp + 4 * j); }
    { const int tok = lane >> 3, k8 = (lane & 7) * 8, c = h * 64 + k8;
        float r[8], k[8], v[8], w[8], a[8], g[8];
        { const bf16* p = RK + (row0 + tok) * RKW + c; const bf16* q = WAG + (row0 + tok) * WAGW + c; ld8b(r, p); ld8b(k, p + 1024); ld8b(v, p + 2048); ld8b(w, q); ld8b(a, q + 1024); ld8b(g, q + 2048); }
        float kkw[8], kaw[8], rkw[8]; ld8(kkw, AR.in[I_KK] + c); ld8(kaw, AR.in[I_KA] + c); ld8(rkw, AR.in[I_RK] + c);
        float kk[8], km[8], ss = 0.f, bs = 0.f;
#pragma unroll
        for (int j = 0; j < 8; ++j) { kk[j] = k[j] * kkw[j]; ss += kk[j] * kk[j]; km[j] = k[j] * (1.0f + (a[j] - 1.0f) * kaw[j]); bs += r[j] * km[j] * rkw[j]; }
        ss = sum8(ss); bs = sum8(bs);
        const float inv = __builtin_amdgcn_rsqf(fmaxf(ss, 1e-24f));
        float o1[8], o3[8], o4[8], br = 0.f, kr = 0.f;
#pragma unroll
        for (int j = 0; j < 8; ++j) { kk[j] *= inv; o1[j] = kk[j] * a[j]; o3[j] = __builtin_amdgcn_exp2f(w[j]); o4[j] = o3[j] * r[j]; br += o1[j] * r[j]; kr += km[j] * r[j]; }
        br = sum8(br); kr = sum8(kr);
        LAS float* p = L + tok * 64 + k8;
        st8(p, kk); st8(p + 512, o1); st8(p + 1024, km); st8(p + 1536, o3); st8(p + 2048, o4); st8(p + 2560, v); st8(p + 3072, g);
        if (k8 == 0) { L[3584 + 2 * tok] = br; L[3584 + 2 * tok + 1] = kr; L[3600 + tok] = bs; } }
    float S[64];
#pragma unroll
    for (int j = 0; j < 16; ++j) { const f32x4 q = Sq[j]; S[4 * j] = q.x; S[4 * j + 1] = q.y; S[4 * j + 2] = q.z; S[4 * j + 3] = q.w; }
    LDS_WAIT(); asm volatile("" ::: "memory");
    LAS float* YS = L + 3616;
#pragma unroll 1
    for (int tk = 0; tk < SSEQ; ++tk) { const LAS float* q = L + tk * 64;
        float a0 = 0.f, a1 = 0.f, y0 = 0.f, y1 = 0.f;
#pragma unroll
        for (int c4 = 0; c4 < 16; ++c4) { const f32x4 kq = *(const LAS f32x4*)(q + 4 * c4), eq = *(const LAS f32x4*)(q + 2048 + 4 * c4);
            a0 = fmaf(S[4 * c4], kq.x, a0); a1 = fmaf(S[4 * c4 + 1], kq.y, a1); a0 = fmaf(S[4 * c4 + 2], kq.z, a0); a1 = fmaf(S[4 * c4 + 3], kq.w, a1);
            y0 = fmaf(S[4 * c4], eq.x, y0); y1 = fmaf(S[4 * c4 + 1], eq.y, y1); y0 = fmaf(S[4 * c4 + 2], eq.z, y0); y1 = fmaf(S[4 * c4 + 3], eq.w, y1); }
        const float sa = -(a0 + a1), v = q[2560 + lane]; const f32x2 sc = *(const LAS f32x2*)(L + 3584 + 2 * tk);
#pragma unroll
        for (int c4 = 0; c4 < 16; ++c4) { const f32x4 dq = *(const LAS f32x4*)(q + 1536 + 4 * c4), bq = *(const LAS f32x4*)(q + 512 + 4 * c4), mq = *(const LAS f32x4*)(q + 1024 + 4 * c4);
            S[4 * c4] = fmaf(bq.x, sa, fmaf(mq.x, v, S[4 * c4] * dq.x)); S[4 * c4 + 1] = fmaf(bq.y, sa, fmaf(mq.y, v, S[4 * c4 + 1] * dq.y));
            S[4 * c4 + 2] = fmaf(bq.z, sa, fmaf(mq.z, v, S[4 * c4 + 2] * dq.z)); S[4 * c4 + 3] = fmaf(bq.w, sa, fmaf(mq.w, v, S[4 * c4 + 3] * dq.w)); }
        YS[tk * 64 + lane] = fmaf(v, sc.y, fmaf(sa, sc.x, y0 + y1)); }
    { float* sp = F.out + O_SWKV + (size_t)item * 4096 + lane * 64;
#pragma unroll
        for (int j = 0; j < 16; ++j) *(f32x4*)(sp + 4 * j) = (f32x4){S[4 * j], S[4 * j + 1], S[4 * j + 2], S[4 * j + 3]}; }
    LDS_WAIT(); asm volatile("" ::: "memory");
    { const float lg = AR.in[I_LXG][h * 64 + lane], lb = AR.in[I_LXB][h * 64 + lane];
#pragma unroll 1
        for (int tk = 0; tk < SSEQ; ++tk) { const float y = YS[tk * 64 + lane];
            const float mean = wave_sum(y) * (1.f / 64.f), d = y - mean, rstd = __builtin_amdgcn_rsqf(wave_sum(d * d) * (1.f / 64.f) + RW_EPS);
            const float o = (d * rstd * lg + lb + L[3600 + tk] * L[2560 + tk * 64 + lane]) * L[3072 + tk * 64 + lane];
            G[(row0 + tk) * D + h * 64 + lane] = (bf16)f2bf(o); } }
    LDS_WAIT(); asm volatile("" ::: "memory");
}
#ifndef PROBE_RW
#define PROBE_RW 0
#endif
DI void rwkv_scan(Frame& F, const Args& AR) {
    for (int rep = 0; rep < (PROBE_RW == 1 ? 2 : 1); ++rep)
    for (int it = F.vcu; it < NPB * 16 * 2; it += F.G) { const int bh = it >> 1, b = bh >> 4, h = bh & 15;
        rw_prompt_half(F, AR, b, h, it & 1, F.out + O_PWKV + (size_t)bh * 4096); }
}
DI void rwkv_samples(Frame& F, const Args& AR) { for (int item = F.vcu * NWAVES + F.wave; item < NSB * 16; item += F.G * NWAVES) rw_sample_wave(F, AR, item); }

#ifndef MK_N_LAUNCHES
#define MK_N_LAUNCHES 1
#endif
#ifdef PROBE_DUP_PH
constexpr int NPHASES = 28;
#else
constexpr int NPHASES = 27;
#endif
enum { K_P0 = 0, K_MODX, K_UP, K_RESID, K_LN, K_WIN, K_MIXA, K_MIXB, K_MIXC, K_R1, K_R2, K_R3, K_MOD, K_R3B };

__global__ void __launch_bounds__(NTHREADS, 2) mega_fwd(Args AR) {
    extern __shared__ __attribute__((aligned(16))) unsigned char lds[];
    Frame F;
    F.lds = (LAS unsigned char*)lds;
    F.MISC = (volatile LAS unsigned*)(F.lds + MISC_OFF);
    F.tid = threadIdx.x; F.lane = F.tid & 63; F.wave = __builtin_amdgcn_readfirstlane(F.tid >> 6);
    F.G = gridDim.x; { const int bx = blockIdx.x; F.vcu = (F.G % 8 == 0) ? (bx % 8) * (F.G / 8) + bx / 8 : bx; }
    F.ws = AR.ws; F.out = AR.out; F.ctl = (gu32*)(AR.ws + WS_CTL);
    for (int u = F.tid; u < (LDS_BYTES - LDSCTL_OFF) / 4; u += NTHREADS) ((LAS unsigned*)(F.lds + LDSCTL_OFF))[u] = 0u;
    __syncthreads();
    const int lo = AR.ph_lo, hi = AR.ph_hi;
    XcdBarrier bar; bar.bar = (unsigned*)(F.ctl + CW_BAR); bar.x = 0; bar.st = nullptr;
    if (hi - lo > 1) bar = xcd_barrier_post((unsigned*)(F.ctl + CW_BAR), F.MISC + 8);

#ifndef PROBE_DUP_PH
#define PROBE_DUP_PH 1000
#endif
    for (int phs = lo; phs < hi; ++phs) {
        const int ph = phs > PROBE_DUP_PH ? phs - 1 : phs; const bool dupfirst = (phs == PROBE_DUP_PH);
        float* X = F.out + O_Y; const float* mod = (const float*)(F.ws + WS_MOD); bf16* H = (bf16*)(F.ws + WS_H);
        int kind = K_LN, f = 0, l = 0, sub = 0, js = 0, first = 0, mode = 0, lm = 0, which = 0, fin = 0, zsep = 0;
        switch (ph == 0 ? 0 : (ph == 1 ? 100 : (ph <= 20 ? ph - 1 : (ph == 21 ? 101 : ph - 2)))) {
            case 0: kind = K_P0; break;
            case 100: kind = K_MOD; break;
            case 101: kind = K_R3B; break;
            case 1: kind = K_MODX; break;
            case 2: kind = K_UP; f = 0; break;
            case 3: kind = K_RESID; which = 0; f = 0; l = 0; js = 0; first = 1; break;
            case 4: kind = K_LN; l = 0; sub = 0; lm = 0; js = 3; mode = 0; break;
            case 5: kind = K_WIN; break;
            case 6: kind = K_MIXA; break;
            case 7: kind = K_MIXB; break;
            case 8: kind = K_MIXC; break;
            case 9: kind = K_RESID; which = 1; l = 0; js = 3; break;
            case 10: kind = K_LN; l = 0; sub = 1; lm = 0; js = 6; mode = 0; break;
            case 11: kind = K_UP; f = 1; break;
            case 12: kind = K_RESID; which = 0; f = 1; l = 0; js = 6; break;
            case 13: kind = K_LN; l = 0; sub = 2; lm = 1; js = 0; mode = 0; break;
            case 14: kind = K_UP; f = 2; break;
            case 15: kind = K_RESID; which = 0; f = 2; l = 1; js = 0; zsep = 1; break;
            case 16: kind = K_LN; l = 1; sub = 0; lm = 1; js = 3; mode = 1; break;
            case 17: kind = K_R1; break;
            case 18: kind = K_R2; break;
            case 19: kind = K_R3; break;
            case 20: kind = K_RESID; which = 2; l = 1; js = 3; break;
            case 21: kind = K_LN; l = 1; sub = 1; lm = 1; js = 6; mode = 0; break;
            case 22: kind = K_UP; f = 3; break;
            case 23: kind = K_RESID; which = 0; f = 3; l = 1; js = 6; fin = 1; break;
            default: kind = K_LN; l = 1; sub = 2; lm = 1; js = 0; mode = 2; fin = 1; break;
        }
#ifndef PHMASK
#define PHMASK 0xFFFFF
#endif
        { int t_ = F.tid; asm volatile("" : "+v"(t_)); F.tid = t_; F.lane = t_ & 63; F.wave = __builtin_amdgcn_readfirstlane(t_ >> 6);

          int v_ = F.vcu; asm volatile("" : "+s"(v_)); F.vcu = v_; int g_ = F.G; asm volatile("" : "+s"(g_)); F.G = g_;
          unsigned l_ = (unsigned)(size_t)F.lds; asm volatile("" : "+s"(l_)); F.lds = (LAS unsigned char*)(size_t)l_; }
        switch (kind) {
            case K_P0: p0_sctab(F, AR); break;
            case K_MOD: p0_mod(F, AR); break;
            case K_MODX: if ((PHMASK >> K_MODX) & 1) ln_pass(F, AR, 1, 0, 0, 0, 0, 0, 0, 0, 0, 0); break;
            case K_UP: if ((PHMASK >> K_UP) & 1) {
                pg8::Gemm g{H, (const bf16*)(F.ws + WS_W13) + (size_t)f * 5632 * 1024, M, 5632, 1024}; pg8::StaticOrder S; S.init(M, 5632, F.G, (int)blockIdx.x); S.ntk = 16;
                pg8::EpiSwiglu E{(bf16*)(F.ws + WS_HID), FF};
                pg8::gemm_phase<pg8::EpiSwiglu, pg8::StaticOrder, true, true>(F.lds, g, S, E, F.tid);
            } break;
            case K_RESID: if ((PHMASK >> K_RESID) & 1) {
                const bf16* A = which == 0 ? (const bf16*)(F.ws + WS_HID) : H; const int K = which == 0 ? FF : 1024;
                const bf16* Bt = which == 0 ? (const bf16*)(F.ws + WS_W2) + (size_t)f * 1024 * FF : (which == 1 ? (const bf16*)(F.ws + WS_WOUT) : (const bf16*)(F.ws + WS_WO));
                const int nsp = (F.G == 256) ? (which == 0 ? 11 : 4) : 0;
                pg8::Gemm g{A, Bt, M, 1024, K}; SplitOrder S; S.base.init(nsp ? MP : M, 1024, F.G, (int)blockIdx.x); S.base.ntk = K / 64; S.S = nsp;
                EpiResid E{AR, F.out, F.ws, (first ? 1 : 0) | (l << 1) | ((js + 2) << 2) | (which == 0 ? 0 : 64) | (dupfirst ? 128 : 0) | (fin ? 256 : 0) | (zsep ? 512 : 0)};
                pg8::gemm_phase<EpiResid, SplitOrder, true, true>(F.lds, g, S, E, F.tid);
                if (fin && nsp) {
                    const v4u* src = (const v4u*)((unsigned char*)F.out + XB_OFF + (size_t)MP * 2048); v4u* dst = (v4u*)(F.ws + WS_ZF + (size_t)MP * 2048);
                    for (int e = F.vcu * NTHREADS + F.tid; e < MS * 128; e += F.G * NTHREADS) dst[e] = src[e]; }
            } break;
            case K_LN: if (mode == 1) ln_rwkv(F, AR, (F.G == 256) ? 11 : 0);
                       else ln_pass(F, AR, 0, 1, l, sub, lm, js, mode, (F.G == 256) ? (sub == 1 ? 4 : 11) : 0, ph == 5, fin); break;
            case K_WIN: if ((PHMASK >> K_WIN) & 1) {
                pg8::Gemm g{H, (const bf16*)(F.ws + WS_WIN), M, ZW, 1024}; pg8::StaticOrder S; S.init(M, ZW, F.G, (int)blockIdx.x); S.ntk = 16;
                pg8::EpiStore E{(bf16*)(F.ws + WS_Z), ZW, 1000, nullptr, 0};
                pg8::gemm_phase<pg8::EpiStore, pg8::StaticOrder, true, true>(F.lds, g, S, E, F.tid);
            } break;
            case K_R1: {
                pg8::Gemm g{(const bf16*)(F.ws + WS_H), (const bf16*)(F.ws + WS_WRK), M, 3584, 1024};
                R1Order S; S.c = (int)blockIdx.x; S.ws = F.ws; S.out = F.out;
                pg8::EpiStore E{(bf16*)(F.ws + WS_RK), RKW, 12, (bf16*)(F.ws + WS_A3), 256};
                pg8::gemm_phase<pg8::EpiStore, R1Order, true, true>(F.lds, g, S, E, F.tid);
            } break;
            case K_R2: if ((PHMASK >> K_R2) & 1) {
                pg8::Gemm g{(const bf16*)(F.ws + WS_A3), (const bf16*)(F.ws + WS_WL2), M, 3072, 256}; pg8::StaticOrder S; S.init(M, 3072, F.G, (int)blockIdx.x); S.ntk = 4;
                pg8::EpiLora2 E{(bf16*)(F.ws + WS_WAG), WAGW, AR.in[I_W0], AR.in[I_A0]};
                pg8::gemm_phase<pg8::EpiLora2, pg8::StaticOrder, true, true>(F.lds, g, S, E, F.tid);
            } break;
            case K_MIXA: ml1_prompt(F, AR); __syncthreads(); ml_sample(F, AR); __syncthreads(); rg1(F, AR);
#if defined(PROBE_MIX) && PROBE_MIX == 1
                __syncthreads(); ml1_prompt(F, AR);
#elif defined(PROBE_MIX) && PROBE_MIX == 2
                __syncthreads(); ml_sample(F, AR);
#elif defined(PROBE_MIX) && PROBE_MIX == 3
                __syncthreads(); rg1(F, AR);
#endif
                break;
            case K_MIXB: ml2_scan(F, AR); rg2_carry(F, AR);
#if defined(PROBE_MIX) && PROBE_MIX == 6
                rg2_carry(F, AR);
#endif
                break;
            case K_MIXC: ml3_prompt(F, AR); __syncthreads(); rg2_apply(F, AR);
#if defined(PROBE_MIX) && PROBE_MIX == 4
                __syncthreads(); ml3_prompt(F, AR);
#elif defined(PROBE_MIX) && PROBE_MIX == 5
                __syncthreads(); rg2_apply(F, AR);
#endif
                break;
            case K_R3: if ((PHMASK >> K_R3) & 1) rwkv_scan(F, AR); break;
            case K_R3B:
                for (int st = 0; st < 2; ++st) { if ((st == 0) == (F.wave < 4)) rw_gn_pass(F, AR); else rwkv_samples(F, AR); }
                break;
        }
        if (kind == K_P0 || kind == K_MOD || kind == K_MIXB || kind == K_WIN || kind == K_R1 || (kind == K_UP && f < 3)) {
            const bool split = F.G == 256 && hi - lo > 1;
            int lo1 = 0, hi1 = 0, lo2 = 0, hi2 = 0, widx = F.vcu * NWAVES + F.wave, wcnt = F.G * NWAVES; const int bx = (int)blockIdx.x;
            if (kind == K_P0) { lo1 = 0; hi1 = split ? 0 : P0_NPAIR; }
            else if (!split) { }
            else if (kind == K_MOD) { lo1 = 0; hi1 = F.vcu >= 64 ? 1408 : 0; lo2 = 8448; hi2 = F.vcu >= 64 ? 9536 : 8448; widx -= 64 * NWAVES; wcnt -= 64 * NWAVES; }
            else if (kind == K_UP) { lo1 = 5632 + (f == 0 ? 0 : (f + 1) * 704); hi1 = bx >= 216 ? lo1 + 704 : lo1; widx = (bx - 216) * NWAVES + F.wave; wcnt = 40 * NWAVES; }
            else if (kind == K_WIN) { lo1 = 1408; hi1 = bx >= 116 ? 3 * 1408 : lo1; lo2 = 5632 + 704; hi2 = bx >= 116 ? 5632 + 2 * 704 : lo2; widx = (bx - 116) * NWAVES + F.wave; wcnt = 140 * NWAVES; }
            else if (kind == K_MIXB) { lo1 = P0_MIXB_LO; hi1 = F.vcu >= 8 ? P0_MIXB_HI : P0_MIXB_LO; widx -= 8 * NWAVES; wcnt -= 8 * NWAVES; }
            else { lo1 = 3 * 1408; hi1 = bx >= 184 ? 4 * 1408 : lo1; widx = (bx - 184) * NWAVES + F.wave; wcnt = 72 * NWAVES; }
            p0_weights(F, AR, lo1, hi1, lo2, hi2, widx, wcnt);
        }
        if (phs + 1 < hi) xcd_barrier(bar);
#ifdef PROBE_BAR
        if (phs == 2 && hi - lo > 1) { for (int q = 0; q < 20; ++q) xcd_barrier(bar); }
#endif
    }
}

extern "C" void kernel_launch(void* const* d_in, const int* in_sizes, int n_in, void* d_out, int out_size, void* d_ws, size_t ws_size, hipStream_t stream) {
    static int grid = 0;
    if (grid == 0) {
        if (n_in != 47 || out_size != (int)O_END || ws_size < WS_END) { fprintf(stderr, "kernel_launch: unexpected sizes n_in %d out %d ws %zu\n", n_in, out_size, ws_size); grid = -1; return; }
        int dev = 0, cus = 0, per_cu = 0;
        if (hipGetDevice(&dev) != hipSuccess || hipDeviceGetAttribute(&cus, hipDeviceAttributeMultiprocessorCount, dev) != hipSuccess) { grid = -1; return; }
        if (hipFuncSetAttribute((const void*)mega_fwd, hipFuncAttributeMaxDynamicSharedMemorySize, LDS_BYTES) != hipSuccess) { fprintf(stderr, "kernel_launch: hipFuncSetAttribute failed\n"); grid = -1; return; }
        if (hipOccupancyMaxActiveBlocksPerMultiprocessor(&per_cu, (const void*)mega_fwd, NTHREADS, LDS_BYTES) != hipSuccess || per_cu < 1) { fprintf(stderr, "kernel_launch: occupancy query says %d blocks per CU\n", per_cu); (void)hipGetLastError(); grid = -1; return; }
        grid = cus;
    }
    if (grid < 0) return;
    (void)hipMemsetAsync((char*)d_ws + WS_CTL, 0, CTL_ZERO_BYTES, stream);
    Args a{};
    for (int i = 0; i < 47; ++i) a.in[i] = (const float*)d_in[i];
    a.out = (float*)d_out; a.ws = (unsigned char*)d_ws;
#if MK_N_LAUNCHES == 1
    a.ph_lo = 0; a.ph_hi = NPHASES;
    hipLaunchKernelGGL(mega_fwd, dim3(grid), dim3(NTHREADS), LDS_BYTES, stream, a);
#else
    for (int p = 0; p < NPHASES; ++p) { a.ph_lo = p; a.ph_hi = p + 1; hipLaunchKernelGGL(mega_fwd, dim3(grid), dim3(NTHREADS), LDS_BYTES, stream, a); }
#endif
}
```

```cpp
#include <hip/hip_runtime.h>
#include <cstdio>
#include <cstdint>
#include <cmath>
namespace pg8 {
#define PG8_LAS __attribute__((address_space(3)))
typedef unsigned short bf16_t;
typedef short bf16x8 __attribute__((ext_vector_type(8)));
typedef float f32x4 __attribute__((ext_vector_type(4)));
typedef unsigned u32x4 __attribute__((ext_vector_type(4)));
constexpr int BM = 256, BK = 64, HALF = 128, HTB = HALF * BK * 2  , STAGE_BYTES = 8 * HTB, NXCD = 8, WGM = 8;

__host__ __device__ __forceinline__ int lds_byte(int r, int c) { const int st = (r >> 4) * 2 + (c >> 5), rr = r & 15, cc = c & 31, ob = rr * 64 + cc * 2; return st * 1024 + (ob ^ (((ob >> 9) & 1) << 5)); }
__host__ __device__ __forceinline__ void stage_rc(int b, int& R, int& C) { const int st = b / 1024, sb = b % 1024, swz = sb ^ (((sb >> 9) & 1) << 5); R = (st >> 1) * 16 + swz / 64; C = (st & 1) * 32 + (swz % 64) / 2; }
__host__ __device__ __forceinline__ int perm32(int rho) { const int n = rho >> 4, i = rho & 15; return 8 * (i >> 2) + 4 * n + (i & 3); }

struct Unit { int pm, pn, k0, nt, sub; };
struct Gemm { const bf16_t* A; const bf16_t* Bt; int M, N, K; };

struct StaticOrder {
    int nM, nN, nwg, G, c, ntk;
    __host__ __device__ void init(int M, int N, int G_, int c_) { nM = M / BM; nN = N / BM; nwg = nM * nN; G = G_; c = c_; }
    __host__ __device__ bool next(int i, Unit& u) const {
        const long L = (long)i * G + c; if (L >= nwg) return false;
        int wgid = (int)L; { const int q = nwg / NXCD, r = nwg % NXCD, xcd = wgid % NXCD, off = wgid / NXCD; wgid = (xcd < r ? xcd * (q + 1) : r * (q + 1) + (xcd - r) * q) + off; }
        const int nig = WGM * nN, gid = wgid / nig, fm = gid * WGM, gsz = (nM - fm) < WGM ? (nM - fm) : WGM;
        u.pm = fm + ((wgid % nig) % gsz); u.pn = (wgid % nig) / gsz; u.k0 = 0; u.nt = ntk; u.sub = 0; return true;
    }
    __device__ __forceinline__ void a_ready(const Unit&) const {}
    __device__ __forceinline__ void done(const Unit&) const {}
    __device__ __forceinline__ const bf16_t* a_base(const Gemm& g, const Unit&) const { return g.A; }
};

__device__ __forceinline__ unsigned cvt_pk_bf16(float lo, float hi) { unsigned r; asm volatile("v_cvt_pk_bf16_f32 %0, %1, %2" : "=v"(r) : "v"(lo), "v"(hi)); return r; }
typedef float f32x2 __attribute__((ext_vector_type(2)));
constexpr int MPROWS = 16384;
__device__ __forceinline__ int mod_row(int r) { return r < MPROWS ? (r >> 11) : 8 + ((r - MPROWS) >> 3); }
__device__ __forceinline__ float fsig(float x) { return __builtin_amdgcn_rcpf(1.0f + __builtin_amdgcn_exp2f(-1.44269504f * x)); }
__device__ __forceinline__ float ftanh(float x) { return 1.0f - 2.0f * __builtin_amdgcn_rcpf(1.0f + __builtin_amdgcn_exp2f(2.88539008f * x)); }

struct EpiSwiglu {
    static constexpr bool PERM = true, AFTER_DRAIN = false;
    bf16_t* O; int ldc;
    __device__ __forceinline__ void operator()(const f32x4 (&acc)[2][2][4][2], const Unit& u, int wr, int wc, int fr, int fq) const {
        const int row0 = u.pm * BM + wr * 64 + fr, col0 = u.pn * HALF + wc * 32 + 8 * fq;
#pragma unroll
        for (int ai = 0; ai < 2; ++ai)
#pragma unroll
            for (int m = 0; m < 4; ++m) { bf16_t* rowp = O + (size_t)(row0 + ai * HALF + m * 16) * ldc + col0;
                const f32x4 a0 = acc[ai][0][m][0], a1 = acc[ai][0][m][1], b0 = acc[ai][1][m][0], b1 = acc[ai][1][m][1];
                f32x4 v0, v1;
#pragma unroll
                for (int j = 0; j < 4; ++j) { v0[j] = a0[j] * fsig(a0[j]) * b0[j]; v1[j] = a1[j] * fsig(a1[j]) * b1[j]; }
                u32x4 w; w.x = cvt_pk_bf16(v0[0], v0[1]); w.y = cvt_pk_bf16(v0[2], v0[3]); w.z = cvt_pk_bf16(v1[0], v1[1]); w.w = cvt_pk_bf16(v1[2], v1[3]);
                *(u32x4*)rowp = w; asm volatile("" ::: "memory"); }
    }
};
struct EpiStore {
    static constexpr bool PERM = true, AFTER_DRAIN = false;
    bf16_t* O; int ldc; int ntile_main; bf16_t* O2; int ldc2;
    __device__ __forceinline__ void operator()(const f32x4 (&acc)[2][2][4][2], const Unit& u, int wr, int wc, int fr, int fq) const {
        const int row0 = u.pm * BM + wr * 64 + fr;
        const bool main = u.pn < ntile_main;
        bf16_t* base = main ? O + (size_t)u.pn * BM : O2; const int ld = main ? ldc : ldc2;
        const int col0 = wc * 32 + 8 * fq;
#pragma unroll
        for (int ai = 0; ai < 2; ++ai)
#pragma unroll
            for (int m = 0; m < 4; ++m) { bf16_t* rowp = base + (size_t)(row0 + ai * HALF + m * 16) * ld + col0;
#pragma unroll
                for (int bj = 0; bj < 2; ++bj) { f32x4 v0 = acc[ai][bj][m][0], v1 = acc[ai][bj][m][1];
                    if (!main) {
                        if (bj == 1) {
#pragma unroll
                            for (int j = 0; j < 4; ++j) { v0[j] = fsig(v0[j]); v1[j] = fsig(v1[j]); }
                        } else if (wc < 2) {
#pragma unroll
                            for (int j = 0; j < 4; ++j) { v0[j] = ftanh(v0[j]); v1[j] = ftanh(v1[j]); }
                        }
                    }
                    u32x4 w; w.x = cvt_pk_bf16(v0[0], v0[1]); w.y = cvt_pk_bf16(v0[2], v0[3]); w.z = cvt_pk_bf16(v1[0], v1[1]); w.w = cvt_pk_bf16(v1[2], v1[3]);
                    *(u32x4*)(rowp + bj * HALF) = w; asm volatile("" ::: "memory"); } }
    }
};
struct EpiLora2 {
    static constexpr bool PERM = true, AFTER_DRAIN = false;
    bf16_t* O; int ldc; const float* w0; const float* a0;
    __device__ __forceinline__ void operator()(const f32x4 (&acc)[2][2][4][2], const Unit& u, int wr, int wc, int fr, int fq) const {
        const int row0 = u.pm * BM + wr * 64 + fr, col0 = u.pn * BM + wc * 32 + 8 * fq, kind = u.pn >> 2;
        const float* bp = (kind == 0 ? w0 : a0) + (col0 & 1023); const float bsc = kind == 2 ? 0.f : 1.f, mul = kind == 0 ? -0.87504229f : 1.0f;
        f32x4 bb0[2], bb1[2];
#pragma unroll
        for (int bj = 0; bj < 2; ++bj) { bb0[bj] = *(const f32x4*)(bp + bj * HALF) * bsc; bb1[bj] = *(const f32x4*)(bp + bj * HALF + 4) * bsc; }
#pragma unroll
        for (int bj = 0; bj < 2; ++bj)
#pragma unroll
            for (int ai = 0; ai < 2; ++ai)
#pragma unroll
                for (int m = 0; m < 4; ++m) { bf16_t* rowp = O + (size_t)(row0 + ai * HALF + m * 16) * ldc + col0;
                    f32x4 v0 = acc[ai][bj][m][0] + bb0[bj], v1 = acc[ai][bj][m][1] + bb1[bj];
                    if (kind != 2) {
#pragma unroll
                        for (int j = 0; j < 4; ++j) { v0[j] = mul * fsig(v0[j]); v1[j] = mul * fsig(v1[j]); }
                    }
                    u32x4 w; w.x = cvt_pk_bf16(v0[0], v0[1]); w.y = cvt_pk_bf16(v0[2], v0[3]); w.z = cvt_pk_bf16(v1[0], v1[1]); w.w = cvt_pk_bf16(v1[2], v1[3]);
                    *(u32x4*)(rowp + bj * HALF) = w; asm volatile("" ::: "memory"); }
    }
};

template <class Epi, class Sched, bool ALIGN_EPI = false, bool SP2 = false>
__device__ __forceinline__ void gemm_phase(PG8_LAS unsigned char* lds, const Gemm g, const Sched& S, const Epi& E, int tid_in) {
    int tid_ = tid_in; asm volatile("" : "+v"(tid_));
    const int tid = tid_, wid = __builtin_amdgcn_readfirstlane(tid >> 6), lane = tid & 63, wr = wid >> 2, wc = wid & 3, fr = lane & 15, fq = lane >> 4;
    int K_ = g.K; asm volatile("" : "+s"(K_));
    const int K = K_;
    unsigned voffA[2], voffB[2];
#pragma unroll
    for (int i = 0; i < 2; ++i) { int R, C; stage_rc(tid * 16 + i * 8192, R, C); const int Rb = Epi::PERM ? ((R & ~31) + perm32(R & 31)) : R;
        voffA[i] = (unsigned)(R * K + C) * 2u; voffB[i] = (unsigned)(Rb * K + C) * 2u; }
    const size_t kstep = (size_t)(BK * 2);
    const size_t hstep = (size_t)HALF * K * 2;
    const size_t tstep = 2 * hstep;
    const unsigned ldsw = (unsigned)wid * 1024u;
    const int aoff = lds_byte(wr * 64 + fr, fq * 8), boff = lds_byte(wc * 32 + fr, fq * 8);
#define PG8_SA(b, h) (((b) * 2 + (h)) * HTB)
#define PG8_SB(b, h) ((4 + (b) * 2 + (h)) * HTB)
#define PG8_STAGE(bufoff, gbase, voff) do { _Pragma("unroll") for (int _i = 0; _i < 2; ++_i) \
        __builtin_amdgcn_global_load_lds((const unsigned*)((const char*)(gbase) + (voff)[_i]), (PG8_LAS unsigned*)(lds + (bufoff) + ldsw + _i * 8192), 16, 0, 0); } while (0)
#define PG8_LDA(dst, b, h) do { _Pragma("unroll") for (int m = 0; m < 4; ++m) _Pragma("unroll") for (int k = 0; k < 2; ++k) dst[m][k] = *(const PG8_LAS bf16x8*)(lds + PG8_SA(b, h) + aoff + m * 2048 + k * 1024); } while (0)
#define PG8_LDB(dst, b, h) do { _Pragma("unroll") for (int n = 0; n < 2; ++n) _Pragma("unroll") for (int k = 0; k < 2; ++k) dst[n][k] = *(const PG8_LAS bf16x8*)(lds + PG8_SB(b, h) + boff + n * 2048 + k * 1024); } while (0)
#define PG8_MMA(ai, bj, At, Bt) do { __builtin_amdgcn_s_setprio(1); _Pragma("unroll") for (int m = 0; m < 4; ++m) _Pragma("unroll") for (int n = 0; n < 2; ++n) _Pragma("unroll") for (int k = 0; k < 2; ++k) \
        acc[ai][bj][m][n] = __builtin_amdgcn_mfma_f32_16x16x32_bf16(Bt[n][k], At[m][k], acc[ai][bj][m][n], 0, 0, 0); __builtin_amdgcn_s_setprio(0); } while (0)
#define PG8_WAIT_V(n) asm volatile("s_waitcnt vmcnt(" #n ")" ::: "memory")
#define PG8_WAIT_L(n) asm volatile("s_waitcnt lgkmcnt(" #n ")" ::: "memory")
#define PG8_BAR __builtin_amdgcn_s_barrier()
#define PG8_SCHED __builtin_amdgcn_sched_barrier(0)
    Unit cur, nxt; int ui = 0;
    if (!S.next(0, cur)) return;
    f32x4 acc[2][2][4][2];
#pragma unroll
    for (int a = 0; a < 2; ++a)
#pragma unroll
        for (int b = 0; b < 2; ++b)
#pragma unroll
            for (int m = 0; m < 4; ++m)
#pragma unroll
                for (int n = 0; n < 2; ++n) acc[a][b][m][n] = (f32x4){0.f, 0.f, 0.f, 0.f};
    bf16x8 At[4][2], B0[2][2], B1[2][2];
    const char* cA = (const char*)S.a_base(g, cur) + (size_t)cur.pm * tstep + (size_t)cur.k0 * 2; const char* cB = (const char*)g.Bt + (size_t)cur.pn * tstep + (size_t)cur.k0 * 2;
    S.a_ready(cur);
    if constexpr (SP2) {
        PG8_STAGE(PG8_SB(0, 0), cB, voffB); PG8_STAGE(PG8_SB(0, 1), cB + hstep, voffB); PG8_STAGE(PG8_SA(0, 0), cA, voffA); PG8_STAGE(PG8_SA(0, 1), cA + hstep, voffA);
        if (wr == 1) PG8_BAR;
        PG8_WAIT_V(2); PG8_BAR;
        PG8_STAGE(PG8_SB(1, 0), cB + kstep, voffB); PG8_STAGE(PG8_SA(1, 0), cA + kstep, voffA); PG8_STAGE(PG8_SB(1, 1), cB + hstep + kstep, voffB);
        PG8_WAIT_V(6); PG8_BAR;
    } else {
        PG8_STAGE(PG8_SB(0, 0), cB, voffB); PG8_STAGE(PG8_SA(0, 0), cA, voffA); PG8_STAGE(PG8_SB(0, 1), cB + hstep, voffB); PG8_STAGE(PG8_SA(0, 1), cA + hstep, voffA);
        if (wr == 1) PG8_BAR;
        PG8_WAIT_V(4); PG8_BAR;
        PG8_STAGE(PG8_SB(1, 0), cB + kstep, voffB); PG8_STAGE(PG8_SA(1, 0), cA + kstep, voffA); PG8_STAGE(PG8_SB(1, 1), cB + hstep + kstep, voffB);
        PG8_WAIT_V(6); PG8_BAR;
    }
    for (;;) {
        const bool has_next = S.next(ui + 1, nxt);
        const char* nA = has_next ? (const char*)S.a_base(g, nxt) + (size_t)nxt.pm * tstep + (size_t)nxt.k0 * 2 : cA; const char* nB = has_next ? (const char*)g.Bt + (size_t)nxt.pn * tstep + (size_t)nxt.k0 * 2 : cB;
        const int nt = cur.nt;
        for (int t = 0; t < nt; t += 2) {
            const bool last = (t == nt - 2);
            const char* a1 = cA + (size_t)(t + 1) * kstep;
            const char* a2 = last ? nA : cA + (size_t)(t + 2) * kstep; const char* b2 = last ? nB : cB + (size_t)(t + 2) * kstep;
            const char* a3 = a2 + kstep; const char* b3 = b2 + kstep;
            if (last && has_next) S.a_ready(nxt);
            if constexpr (SP2) {
            PG8_LDB(B0, 0, 0); PG8_LDB(B1, 0, 1); PG8_SCHED; PG8_LDA(At, 0, 0); PG8_STAGE(PG8_SA(1, 1), a1 + hstep, voffA);
            PG8_WAIT_V(8); PG8_WAIT_L(0); PG8_BAR; PG8_MMA(0, 0, At, B0); PG8_MMA(0, 1, At, B1); PG8_BAR; PG8_SCHED;
            PG8_LDA(At, 0, 1); PG8_STAGE(PG8_SB(0, 0), b2, voffB); PG8_STAGE(PG8_SB(0, 1), b2 + hstep, voffB); PG8_STAGE(PG8_SA(0, 0), a2, voffA);
            PG8_WAIT_V(8); PG8_WAIT_L(0); PG8_BAR; PG8_MMA(1, 0, At, B0); PG8_MMA(1, 1, At, B1); PG8_BAR; PG8_SCHED;
            PG8_LDB(B0, 1, 0); PG8_LDB(B1, 1, 1); PG8_SCHED; PG8_LDA(At, 1, 0); PG8_STAGE(PG8_SA(0, 1), a2 + hstep, voffA);
            PG8_WAIT_V(8); PG8_WAIT_L(0); PG8_BAR; PG8_MMA(0, 0, At, B0); PG8_MMA(0, 1, At, B1); PG8_BAR; PG8_SCHED;
            PG8_LDA(At, 1, 1); PG8_STAGE(PG8_SB(1, 0), b3, voffB); PG8_STAGE(PG8_SB(1, 1), b3 + hstep, voffB); PG8_STAGE(PG8_SA(1, 0), a3, voffA);
            PG8_WAIT_V(8); PG8_WAIT_L(0); PG8_BAR; PG8_MMA(1, 0, At, B0); PG8_MMA(1, 1, At, B1); PG8_BAR; PG8_SCHED;
            } else {
            PG8_LDB(B0, 0, 0); PG8_SCHED; PG8_LDA(At, 0, 0); PG8_STAGE(PG8_SA(1, 1), a1 + hstep, voffA);
            PG8_WAIT_L(8); PG8_BAR; PG8_WAIT_L(0); PG8_MMA(0, 0, At, B0); PG8_BAR; PG8_SCHED;
            PG8_LDB(B1, 0, 1); PG8_STAGE(PG8_SB(0, 0), b2, voffB);
            PG8_BAR; PG8_WAIT_L(0); PG8_MMA(0, 1, At, B1); PG8_BAR;
            PG8_LDA(At, 0, 1); PG8_STAGE(PG8_SA(0, 0), a2, voffA);
            PG8_BAR; PG8_WAIT_L(0); PG8_MMA(1, 0, At, B0); PG8_BAR; PG8_SCHED;
            PG8_STAGE(PG8_SB(0, 1), b2 + hstep, voffB);
            PG8_WAIT_V(6); PG8_BAR; PG8_MMA(1, 1, At, B1); PG8_BAR;
            PG8_LDB(B0, 1, 0); PG8_SCHED; PG8_LDA(At, 1, 0); PG8_STAGE(PG8_SA(0, 1), a2 + hstep, voffA);
            PG8_WAIT_L(8); PG8_BAR; PG8_WAIT_L(0); PG8_MMA(0, 0, At, B0); PG8_BAR; PG8_SCHED;
            PG8_LDB(B1, 1, 1); PG8_STAGE(PG8_SB(1, 0), b3, voffB);
            PG8_BAR; PG8_WAIT_L(0); PG8_MMA(0, 1, At, B1); PG8_BAR;
            PG8_LDA(At, 1, 1); PG8_STAGE(PG8_SA(1, 0), a3, voffA);
            PG8_BAR; PG8_WAIT_L(0); PG8_MMA(1, 0, At, B0); PG8_BAR; PG8_SCHED;
            PG8_STAGE(PG8_SB(1, 1), b3 + hstep, voffB);
            PG8_WAIT_V(6); PG8_BAR; PG8_MMA(1, 1, At, B1); PG8_BAR;
            }
        }
        if constexpr (ALIGN_EPI) { if (wr == 0) PG8_BAR; }
        const bool chain = cur.sub == 2;
        if constexpr (!Epi::AFTER_DRAIN) { if (!chain) { E(acc, cur, wr, wc, fr, fq); S.done(cur); } }
        if (!has_next) break;
        if (!chain) {
#pragma unroll
        for (int a = 0; a < 2; ++a)
#pragma unroll
            for (int b = 0; b < 2; ++b)
#pragma unroll
                for (int m = 0; m < 4; ++m)
#pragma unroll
                    for (int n = 0; n < 2; ++n) acc[a][b][m][n] = (f32x4){0.f, 0.f, 0.f, 0.f};
        }
        cur = nxt; cA = nA; cB = nB; ++ui;
        if constexpr (ALIGN_EPI) { if (wr == 1) PG8_BAR; }
    }
    PG8_WAIT_V(0);
    if constexpr (!ALIGN_EPI) { if (wr == 0) PG8_BAR; }
    PG8_BAR;
    if constexpr (Epi::AFTER_DRAIN) { E.fused(acc, cur, wr, wc, fr, fq, lds, wid, lane); S.done(cur); }
#undef PG8_SA
#undef PG8_SB
#undef PG8_STAGE
#undef PG8_LDA
#undef PG8_LDB
#undef PG8_MMA
#undef PG8_WAIT_V
#undef PG8_WAIT_L
#undef PG8_BAR
#undef PG8_SCHED
}
}
constexpr int NWAVES = 8, NTHREADS = 512;
constexpr int D = 1024, MP = 16384, MS = 1024, M = MP + MS, NSEQ = 136, FF = 2816;
constexpr int PSEQ = 2048, SSEQ = 8, NPB = 8, NSB = 128;
constexpr int ZW = 3328;
constexpr int ZQ = 0, ZK = 512, ZV = 1024, ZO = 1536, ZXR = 2048, ZGR = 2560, ZIG = 3072, ZFG = 3076;
constexpr int RKW = 3072, WAGW = 3072;
constexpr float ALPHA = 1.41421356237f;
constexpr float LN_EPS = 1e-5f, HEAD_EPS = 1e-6f, RW_EPS = 64e-5f;
constexpr float MSCALE = 0.08838834764831845f;

constexpr size_t O_Y = 0, O_PMC = 17825792, O_PMN = 18350080, O_PMM = 18354176, O_PRH = 18354208, O_PRC = 18358304, O_PWKV = 18370592, O_PSH = 18894880,
                 O_SMC = 18903072, O_SMN = 27291680, O_SMM = 27357216, O_SRH = 27357728, O_SRC = 27423264, O_SWKV = 27619872, O_SSH = 36008480, O_END = 36139552;

constexpr size_t MiB = 1u << 20;
constexpr size_t WS_CTL = 0, CTL_ZERO_BYTES = 64 * 1024;
constexpr size_t WS_WRG = 512 * 1024;
constexpr size_t WS_W13 = 1 * MiB;
constexpr size_t WS_W2 = 45 * MiB;
constexpr size_t WS_WIN = 67 * MiB;
constexpr size_t WS_WOUT = WS_WIN + 6815744;
constexpr size_t WS_WRK = WS_WOUT + 2 * MiB;
constexpr size_t WS_WL2 = WS_WRK + 13 * MiB;
constexpr size_t WS_WO = WS_WL2 + 1572864;
constexpr size_t WS_MOD = 92 * MiB;
constexpr size_t WS_SC = 101 * MiB + 640 * 1024;
constexpr size_t WS_H = 102 * MiB;
constexpr size_t WS_BIG = 136 * MiB;
constexpr size_t WS_HID = WS_BIG;
constexpr size_t WS_Z = WS_BIG;
constexpr size_t WS_CST = WS_BIG + 111 * MiB;
constexpr size_t WS_SLAB = WS_BIG + 180 * MiB;
constexpr size_t WS_RGH = WS_BIG + 143 * MiB;
constexpr size_t WS_RGP = WS_BIG + 175 * MiB;
constexpr size_t WS_NST = WS_BIG + 207 * MiB;
constexpr size_t WS_MST = WS_NST + 262144;
constexpr size_t WS_CARRY = WS_MST + 8192;
constexpr size_t WS_GATE = WS_CARRY + 1048576;
constexpr size_t WS_RK = WS_BIG;
constexpr size_t WS_A3 = WS_BIG + 102 * MiB;
constexpr size_t WS_A2 = WS_BIG + 111 * MiB;
constexpr size_t WS_WAG = WS_BIG + 111 * MiB;
constexpr size_t WS_END = WS_BIG + 224 * MiB;
static_assert(WS_WO + 2 * MiB <= WS_MOD && WS_MOD + (size_t)2 * 136 * 9216 * 4 <= WS_SC && WS_SC + 160 * 1024 * 2 <= WS_H && WS_H + (size_t)M * D * 2 <= WS_BIG, "ws map");
static_assert(WS_SLAB + (size_t)11 * 4 * MiB <= WS_END && WS_A2 + (size_t)M * 2048 * 2 <= WS_SLAB && WS_CARRY + 8 * 64 * 512 * 4 <= WS_END && WS_WAG + (size_t)M * WAGW * 2 <= WS_END && WS_A3 + (size_t)M * 256 * 2 <= WS_A2, "ws map 2");
constexpr size_t WS_BN = WS_BIG + 213 * MiB;
constexpr size_t XB_OFF = (size_t)M * 1024 * 2;
constexpr size_t WS_ZF = WS_BIG + 111 * MiB;
constexpr int CW_BAR = 4096;

constexpr int LDS_BYTES = 147456;
constexpr int LDSCTL_OFF = LDS_BYTES - 512;
constexpr int MISC_OFF = LDSCTL_OFF;

#define GAS __attribute__((address_space(1)))
#define LAS __attribute__((address_space(3)))
typedef unsigned short bf16;
typedef unsigned v4u __attribute__((ext_vector_type(4)));
typedef unsigned v2u __attribute__((ext_vector_type(2)));
typedef float f32x4 __attribute__((ext_vector_type(4)));
typedef float f32x2 __attribute__((ext_vector_type(2)));
typedef float f32x16 __attribute__((ext_vector_type(16)));
typedef short bf16x8 __attribute__((ext_vector_type(8)));
typedef GAS unsigned gu32;
#define RLX_AGENT __ATOMIC_RELAXED, __HIP_MEMORY_SCOPE_AGENT
#define LDS_WAIT() asm volatile("s_waitcnt lgkmcnt(0)" ::: "memory")
#define DI __device__ __forceinline__
#define MFMA32(a, b, c) __builtin_amdgcn_mfma_f32_32x32x16_bf16((a), (b), (c), 0, 0, 0)
DI unsigned f2bf(float f) { unsigned u = __builtin_bit_cast(unsigned, f); return (u + 0x7fffu + ((u >> 16) & 1u)) >> 16; }
DI unsigned pk2(float lo, float hi) { return pg8::cvt_pk_bf16(lo, hi); }
DI float bf2f(unsigned b) { return __builtin_bit_cast(float, b << 16); }
DI float bflo(unsigned w) { return __builtin_bit_cast(float, w << 16); }
DI float bfhi(unsigned w) { return __builtin_bit_cast(float, w & 0xffff0000u); }
DI int crow(int reg, int h) { return (reg & 3) + 8 * (reg >> 2) + 4 * h; }
DI float fexp(float x) { return __builtin_amdgcn_exp2f(1.44269504f * x); }
DI float fsig(float x) { return pg8::fsig(x); }
DI bf16x8 mk_frag(unsigned a, unsigned b, unsigned c, unsigned d) { v4u p; p.x = a; p.y = b; p.z = c; p.w = d; return __builtin_bit_cast(bf16x8, p); }
DI bf16x8 pack8(const float (&v)[8]) { return mk_frag(pk2(v[0], v[1]), pk2(v[2], v[3]), pk2(v[4], v[5]), pk2(v[6], v[7])); }
template <int CTRL> DI float dpp_add(float x) {
    const int xi = __builtin_bit_cast(int, x);
    const int yi = __builtin_amdgcn_update_dpp(xi, xi, CTRL, 0xF, 0xF, false);
    return x + __builtin_bit_cast(float, yi);
}
DI float sum8(float x) { x = dpp_add<0xB1>(x); x = dpp_add<0x4E>(x); x = dpp_add<0x141>(x); return x; }
DI float sum16(float x) { x = sum8(x); x = dpp_add<0x140>(x); return x; }
DI float wave_sum(float v) { v = sum16(v); v += __shfl_xor(v, 16); v += __shfl_xor(v, 32); return v; }

#define XB_TMO      128
#define XB_XCNT(j)  (256  + 64 * (j))
#define XB_XSUB(j)  (1280 + 64 * (j))
#define XB_XGEN(j)  (2304 + 64 * (j))
#define XB_TOP      3328
#define XB_TOPGEN   3392
#define XCD_BAR_WORDS 3456
#define XB_SPIN_CAP (1u << 18)

__device__ __forceinline__ unsigned xb_ld(unsigned* p)              { return __hip_atomic_load(p, __ATOMIC_RELAXED, __HIP_MEMORY_SCOPE_AGENT); }
__device__ __forceinline__ unsigned xb_add(unsigned* p, unsigned v) { return __hip_atomic_fetch_add(p, v, __ATOMIC_RELAXED, __HIP_MEMORY_SCOPE_AGENT); }
__device__ __forceinline__ unsigned xb_xcc_id() { return (unsigned)__builtin_amdgcn_s_getreg((3 << 11) | 20) & 0xFu; }
#define XB_SPIN(cond, bar) do { unsigned _sp = 0; while (cond) { __builtin_amdgcn_s_sleep(1); \
    if ((++_sp & 255u) == 0u) { if (xb_ld(&(bar)[XB_TMO])) break; if (_sp > XB_SPIN_CAP) { atomicAdd(&(bar)[XB_TMO], 1u); break; } } } } while (0)

struct XcdBarrier {
    unsigned* bar; unsigned x;
    volatile LAS unsigned* st;
};

__device__ __forceinline__ XcdBarrier xcd_barrier_post(unsigned* bar, volatile LAS unsigned* st) {
    XcdBarrier b; b.bar = bar; b.x = xb_xcc_id(); b.st = st;
    if (threadIdx.x == 0) (void)xb_add(&bar[XB_XCNT(b.x)], 1u);
    return b;
}
__device__ __forceinline__ void xcd_barrier_complete(unsigned* bar, unsigned x, unsigned& nloc, unsigned& nx) {
    const unsigned G = gridDim.x * gridDim.y * gridDim.z;
    unsigned sum, cnt, mine, sp = 0u;
    for (;;) {
        sum = 0u; cnt = 0u; mine = 0u;
        unsigned cv[16];
        { const unsigned* p0 = &bar[XB_XCNT(0)];
            asm volatile("global_load_dword %0, %16, off sc1\n\tglobal_load_dword %1, %16, off offset:256 sc1\n\tglobal_load_dword %2, %16, off offset:512 sc1\n\tglobal_load_dword %3, %16, off offset:768 sc1\n\t"
                         "global_load_dword %4, %16, off offset:1024 sc1\n\tglobal_load_dword %5, %16, off offset:1280 sc1\n\tglobal_load_dword %6, %16, off offset:1536 sc1\n\tglobal_load_dword %7, %16, off offset:1792 sc1\n\t"
                         "global_load_dword %8, %16, off offset:2048 sc1\n\tglobal_load_dword %9, %16, off offset:2304 sc1\n\tglobal_load_dword %10, %16, off offset:2560 sc1\n\tglobal_load_dword %11, %16, off offset:2816 sc1\n\t"
                         "global_load_dword %12, %16, off offset:3072 sc1\n\tglobal_load_dword %13, %16, off offset:3328 sc1\n\tglobal_load_dword %14, %16, off offset:3584 sc1\n\tglobal_load_dword %15, %16, off offset:3840 sc1\n\t"
                         "s_waitcnt vmcnt(0)"
                         : "=&v"(cv[0]), "=&v"(cv[1]), "=&v"(cv[2]), "=&v"(cv[3]), "=&v"(cv[4]), "=&v"(cv[5]), "=&v"(cv[6]), "=&v"(cv[7]),
                           "=&v"(cv[8]), "=&v"(cv[9]), "=&v"(cv[10]), "=&v"(cv[11]), "=&v"(cv[12]), "=&v"(cv[13]), "=&v"(cv[14]), "=&v"(cv[15])
                         : "v"(p0) : "memory"); }
#pragma unroll
        for (unsigned j = 0; j < 16; ++j) { const unsigned c = cv[j]; sum += c; cnt += (c > 0u) ? 1u : 0u; mine = (j == x) ? c : mine; }
        if (sum == G) break;
        __builtin_amdgcn_s_sleep(1);
        if ((++sp & 255u) == 0u) { if (xb_ld(&bar[XB_TMO])) break; if (sp > XB_SPIN_CAP) { atomicAdd(&bar[XB_TMO], 1u); break; } }
    }
    nloc = mine > 0u ? mine : 1u; nx = cnt > 0u ? cnt : 1u;
}

__device__ __forceinline__ void xcd_barrier(const XcdBarrier& b) {
    asm volatile("s_waitcnt vmcnt(0)" ::: "memory");
    __syncthreads();
    if (threadIdx.x == 0) {
        unsigned* bar = b.bar;
        __builtin_amdgcn_s_waitcnt(0);
        unsigned nloc = b.st[0], nx = b.st[1];
        if (nloc == 0u) { xcd_barrier_complete(bar, b.x, nloc, nx); b.st[0] = nloc; b.st[1] = nx; }
        const unsigned old = xb_add(&bar[XB_XSUB(b.x)], 1u);
        const unsigned gen = old / nloc;
        if (old + 1u == (gen + 1u) * nloc) {
            __builtin_amdgcn_fence(__ATOMIC_RELEASE, "agent");
            asm volatile("s_waitcnt vmcnt(0)" ::: "memory");
            const unsigned og = xb_add(&bar[XB_TOP], 1u);
            const unsigned tg = og / nx;
            if (og + 1u == (tg + 1u) * nx) xb_add(&bar[XB_TOPGEN], 1u);
            else XB_SPIN(xb_ld(&bar[XB_TOPGEN]) == tg, bar);
            __builtin_amdgcn_fence(__ATOMIC_ACQUIRE, "agent");
            asm volatile("s_waitcnt vmcnt(0)" ::: "memory");
        } else {
            XB_SPIN(xb_ld(&bar[XB_TOPGEN]) == gen, bar);
            __builtin_amdgcn_fence(__ATOMIC_ACQUIRE, "agent");
            asm volatile("s_waitcnt vmcnt(0)" ::: "memory");
        }
    }
    __syncthreads();
}
struct Args { const float* in[47]; float* out; unsigned char* ws; int ph_lo, ph_hi; };
struct Frame {
    LAS unsigned char* lds;
    volatile LAS unsigned* MISC;
    gu32* ctl;
    int tid, lane, wave;
    int vcu, G;
    float* out;
    unsigned char* ws;
};
enum { I_XP = 0, I_XS, I_CP, I_CS, I_SMC, I_SMN, I_SMM, I_SRH, I_SRC, I_SWKV, I_SSH, I_ADAW, I_ADAB, I_LNG, I_LNB, I_W1, I_W3, I_W2, I_WIN, I_BG, I_MNG,
       I_CW, I_CB, I_WA, I_BA, I_WX, I_BX, I_LAM, I_WOUT, I_MU, I_WR, I_WK, I_WV, I_W0, I_LW1, I_LW2, I_A0, I_A1, I_A2, I_G1, I_G2, I_KK, I_KA, I_RK, I_LXG, I_LXB, I_WO };

struct EpiResid {
    static constexpr bool PERM = true, AFTER_DRAIN = false;
    const Args& ar; float* out; unsigned char* ws; int cfg;
    __device__ __forceinline__ void operator()(const pg8::f32x4 (&acc)[2][2][4][2], const pg8::Unit& u, int wr, int wc, int fr, int fq) const {
        using pg8::BM; using pg8::HALF;
        if (u.sub) {
            const int row0 = u.pm * BM + wr * 64 + fr - MP, col0 = u.pn * BM + wc * 32 + 8 * fq;
            bf16* sb = (bf16*)(ws + WS_SLAB) + (size_t)(u.k0 / (64 * u.nt)) * (1024 * 1024) + col0;
#pragma unroll
            for (int ai = 0; ai < 2; ++ai)
#pragma unroll
                for (int m = 0; m < 4; ++m) { bf16* o = sb + (size_t)(row0 + ai * HALF + m * 16) * 1024;
#pragma unroll
                    for (int bj = 0; bj < 2; ++bj) { const f32x4 p0 = acc[ai][bj][m][0], p1 = acc[ai][bj][m][1];
                        v4u w; w.x = pk2(p0.x, p0.y); w.y = pk2(p0.z, p0.w); w.z = pk2(p1.x, p1.y); w.w = pk2(p1.z, p1.w); *(v4u*)(o + bj * HALF) = w; } }
            return;
        }
        const int row0 = u.pm * BM + wr * 64 + fr, col0 = u.pn * BM + wc * 32 + 8 * fq;
        const bool first = cfg & 1; const int l = (cfg >> 1) & 1, jg = (cfg >> 2) & 15; const float rw = (cfg & 64) ? 1.0f : 0.5f;
        bf16* XB = (bf16*)((unsigned char*)out + XB_OFF);
        bf16* Zo = (cfg & 128) ? (bf16*)(ws + WS_BIG + 145 * MiB) : ((cfg & 256) ? (bf16*)(ws + WS_ZF) : ((cfg & 512) ? (bf16*)(out + O_SWKV) : XB));
        const float* gate = (const float*)(ws + WS_MOD) + ((size_t)l * NSEQ * 9 + jg) * 1024;
        if (first && u.pm < 64) {
            const float* gr = gate + (size_t)(u.pm >> 3) * 9216 + col0;
            f32x4 g0[2], g1[2];
#pragma unroll
            for (int bj = 0; bj < 2; ++bj) { g0[bj] = (*(const f32x4*)(gr + bj * HALF) + 1.0f) * rw; g1[bj] = (*(const f32x4*)(gr + bj * HALF + 4) + 1.0f) * rw; }
#pragma unroll
            for (int am = 0; am < 4; ++am) { const int ai = am >> 1, mh = am & 1; f32x4 xa[2][2], xb[2][2];
#pragma unroll
                for (int m2 = 0; m2 < 2; ++m2)
#pragma unroll
                    for (int bj = 0; bj < 2; ++bj) { const float* xr = ar.in[I_XP] + (size_t)(row0 + ai * HALF + (2 * mh + m2) * 16) * 1024 + col0 + bj * HALF; xa[m2][bj] = *(const f32x4*)xr; xb[m2][bj] = *(const f32x4*)(xr + 4); }
#pragma unroll
                for (int m2 = 0; m2 < 2; ++m2)
#pragma unroll
                    for (int bj = 0; bj < 2; ++bj) { const int m = 2 * mh + m2;
                        const f32x4 z0 = xa[m2][bj] * ALPHA + g0[bj] * acc[ai][bj][m][0], z1 = xb[m2][bj] * ALPHA + g1[bj] * acc[ai][bj][m][1];
                        v4u w; w.x = pk2(z0.x, z0.y); w.y = pk2(z0.z, z0.w); w.z = pk2(z1.x, z1.y); w.w = pk2(z1.z, z1.w);
                        *(v4u*)(Zo + (size_t)(row0 + ai * HALF + m * 16) * 1024 + col0 + bj * HALF) = w; }
                asm volatile("" ::: "memory"); }
            return;
        }
        if (!first && u.pm < 64) {
            const float* gr = gate + (size_t)(u.pm >> 3) * 9216 + col0;
            f32x4 g0[2], g1[2];
#pragma unroll
            for (int bj = 0; bj < 2; ++bj) { g0[bj] = (*(const f32x4*)(gr + bj * HALF) + 1.0f) * rw; g1[bj] = (*(const f32x4*)(gr + bj * HALF + 4) + 1.0f) * rw; }
#pragma unroll
            for (int ai = 0; ai < 2; ++ai) { v4u xq[4][2];
#pragma unroll
                for (int m = 0; m < 4; ++m)
#pragma unroll
                    for (int bj = 0; bj < 2; ++bj) xq[m][bj] = *(const v4u*)(XB + (size_t)(row0 + ai * HALF + m * 16) * 1024 + col0 + bj * HALF);
#pragma unroll
                for (int m = 0; m < 4; ++m)
#pragma unroll
                    for (int bj = 0; bj < 2; ++bj) { const v4u q = xq[m][bj];
                        const f32x4 x0 = (f32x4){bflo(q.x), bfhi(q.x), bflo(q.y), bfhi(q.y)}, x1 = (f32x4){bflo(q.z), bfhi(q.z), bflo(q.w), bfhi(q.w)};
                        const f32x4 z0 = x0 * ALPHA + g0[bj] * acc[ai][bj][m][0], z1 = x1 * ALPHA + g1[bj] * acc[ai][bj][m][1];
                        v4u w; w.x = pk2(z0.x, z0.y); w.y = pk2(z0.z, z0.w); w.z = pk2(z1.x, z1.y); w.w = pk2(z1.z, z1.w);
                        *(v4u*)(Zo + (size_t)(row0 + ai * HALF + m * 16) * 1024 + col0 + bj * HALF) = w; }
                asm volatile("" ::: "memory"); }
            return;
        }
#pragma unroll
        for (int ai = 0; ai < 2; ++ai)
#pragma unroll
            for (int m = 0; m < 4; ++m) { const int row = row0 + ai * HALF + m * 16;
                const float* gr = gate + (size_t)pg8::mod_row(row) * 9216 + col0;
#pragma unroll
                for (int bj = 0; bj < 2; ++bj) { const int c = bj * HALF; f32x4 x0, x1;
                    if (first) { const float* xr = (row < MP ? ar.in[I_XP] + (size_t)row * 1024 : ar.in[I_XS] + (size_t)(row - MP) * 1024) + col0 + c; x0 = *(const f32x4*)xr; x1 = *(const f32x4*)(xr + 4); }
                    else { const v4u q = *(const v4u*)(XB + (size_t)row * 1024 + col0 + c); x0 = (f32x4){bflo(q.x), bfhi(q.x), bflo(q.y), bfhi(q.y)}; x1 = (f32x4){bflo(q.z), bfhi(q.z), bflo(q.w), bfhi(q.w)}; }
                    const f32x4 g0 = *(const f32x4*)(gr + c), g1 = *(const f32x4*)(gr + c + 4);
                    const f32x4 z0 = x0 * ALPHA + (g0 + 1.0f) * rw * acc[ai][bj][m][0], z1 = x1 * ALPHA + (g1 + 1.0f) * rw * acc[ai][bj][m][1];
                    v4u w; w.x = pk2(z0.x, z0.y); w.y = pk2(z0.z, z0.w); w.z = pk2(z1.x, z1.y); w.w = pk2(z1.z, z1.w);
                    *(v4u*)(((cfg & 512) && row >= MP ? XB : Zo) + (size_t)row * 1024 + col0 + c) = w; }
                asm volatile("" ::: "memory"); }
    }
};
struct SplitOrder {
    pg8::StaticOrder base; int S;
    __device__ __forceinline__ bool next(int i, pg8::Unit& u) const {
        if (S == 0) return base.next(i, u);
        const bool hs = base.c < 16 * S;
        if (i == 0 && hs) { const int su = base.c / S, ks = base.c - su * S; u.pm = 64 + (su >> 2); u.pn = su & 3; u.k0 = ks * 256; u.nt = 4; u.sub = 1; return true; }
        if (i == (hs ? 1 : 0)) return base.next(0, u);
        return false;
    }
    __device__ __forceinline__ void a_ready(const pg8::Unit&) const {}
    __device__ __forceinline__ void done(const pg8::Unit&) const {}
    __device__ __forceinline__ const pg8::bf16_t* a_base(const pg8::Gemm& g, const pg8::Unit&) const { return g.A; }
};

struct R1Order {
    int c; unsigned char* ws; float* out;
    __device__ __forceinline__ bool next(int i, pg8::Unit& u) const {
        int L; u.k0 = 0; u.nt = 16; u.sub = 0;
        if (c < 68) { if (i >= 4) return false; if (i < 2) { u.pm = c; u.pn = 12 + i; u.sub = i == 0 ? 2 : 0; return true; } L = 2 * c + i - 2; }
        else { const int cc = c - 68; if (cc < 116) { if (i >= 4) return false; L = 136 + 4 * cc + i; } else { if (i >= 3) return false; L = 600 + 3 * (cc - 116) + i; } }
        if (L >= 816) return false;
        constexpr int nM = 68, nN = 12, nwg = 816, NX = 8, WG = 8;
        int wgid = L; { const int q = nwg / NX, r = nwg % NX, xcd = wgid % NX, off = wgid / NX; wgid = (xcd < r ? xcd * (q + 1) : r * (q + 1) + (xcd - r) * q) + off; }
        const int nig = WG * nN, gid = wgid / nig, fm = gid * WG, gsz = (nM - fm) < WG ? (nM - fm) : WG;
        u.pm = fm + ((wgid % nig) % gsz); u.pn = (wgid % nig) / gsz; return true;
    }
    __device__ __forceinline__ void a_ready(const pg8::Unit&) const {}
    __device__ __forceinline__ void done(const pg8::Unit&) const {}
    __device__ __forceinline__ const pg8::bf16_t* a_base(const pg8::Gemm&, const pg8::Unit& u) const { const int s = u.pn >> 2;
        return s == 0 ? (const pg8::bf16_t*)(ws + WS_H) : (s == 1 ? (const pg8::bf16_t*)out : (s == 2 ? (u.pm < 66 ? (const pg8::bf16_t*)(ws + 1 * MiB) : (const pg8::bf16_t*)(ws + 45 * MiB) - (size_t)16896 * 1024)
                                                                                                        : (const pg8::bf16_t*)(ws + WS_A2) + (size_t)(u.pm < 64 ? (u.pm >> 3) + 13 - u.pn : (u.pn == 12 ? 8 : 1032)) * 1024)); }
};
DI void p0_sctab(Frame& F, const Args& AR) {
    bf16* sc = (bf16*)(F.ws + WS_SC);
    const int gt = F.vcu * NTHREADS + F.tid, NT = F.G * NTHREADS;
    for (int e = gt; e < 160 * 256; e += NT) { const int m = e >> 8, k4 = (e & 255) * 4; v2u w; w.x = 0u; w.y = 0u;
        if (m < NSEQ) { const f32x4 c = *(const f32x4*)((m < NPB ? AR.in[I_CP] + (size_t)m * D : AR.in[I_CS] + (size_t)(m - NPB) * D) + k4);
            w.x = pk2(c.x * fsig(c.x), c.y * fsig(c.y)); w.y = pk2(c.z * fsig(c.z), c.w * fsig(c.w)); }
        *(v2u*)(sc + (size_t)m * 1024 + k4) = w; }
    bf16* wrg = (bf16*)(F.ws + WS_WRG);
    for (int e = gt; e < 2 * 8 * 4 * 2 * 2 * 32; e += NT) { const int r = e & 31, hh = (e >> 5) & 1, cb = (e >> 6) & 1, ks = (e >> 7) & 3, g = (e >> 9) & 7, w = e >> 12;
        const float* src = (w == 0 ? AR.in[I_WA] : AR.in[I_WX]) + (size_t)g * 4096 + (size_t)(16 * ks + 8 * hh) * 64 + 32 * cb + r; float a[8];
#pragma unroll
        for (int j = 0; j < 8; ++j) a[j] = src[j * 64];
        v4u o; o.x = pk2(a[0], a[1]); o.y = pk2(a[2], a[3]); o.z = pk2(a[4], a[5]); o.w = pk2(a[6], a[7]); *(v4u*)(wrg + (size_t)e * 8) = o; }
}
DI void p0_mod(Frame& F, const Args& AR) {
    LAS float* SL = (LAS float*)F.lds;
    LAS float* T = (LAS float*)(F.lds + 81920);
    const int lane = F.lane, wave = F.wave, r = lane & 31, hh = lane >> 5;
    const float* adaw = AR.in[I_ADAW]; const float* adab = AR.in[I_ADAB];
    const bf16* sc = (const bf16*)(F.ws + WS_SC);
    float* mod = (float*)(F.ws + WS_MOD);
#define MOD_BAR() do { asm volatile("s_waitcnt lgkmcnt(0)" ::: "memory"); __builtin_amdgcn_s_barrier(); asm volatile("" ::: "memory"); } while (0)
    float a[8][8];
    { const int nb = F.vcu < 576 ? F.vcu : 0, n0 = nb * 32, l = n0 / 9216, nc0 = n0 - l * 9216;
        const float* W = adaw + (size_t)l * 1024 * 9216 + nc0 + r + (size_t)(wave * 128 + 8 * hh) * 9216;
#pragma unroll
        for (int ks = 0; ks < 8; ++ks)
#pragma unroll
            for (int j = 0; j < 8; ++j) a[ks][j] = W[(size_t)(ks * 16 + j) * 9216]; }
    for (int nb = F.vcu; nb < 576; nb += F.G) {
        const int n0 = nb * 32, l = n0 / 9216, nc0 = n0 - l * 9216;
        f32x16 acc[5];
#pragma unroll
        for (int mb = 0; mb < 5; ++mb)
#pragma unroll
            for (int i = 0; i < 16; ++i) acc[mb][i] = 0.f;
        { bf16x8 Af[8], Bv[2][5];
#pragma unroll
            for (int mb = 0; mb < 5; ++mb) Bv[0][mb] = *(const bf16x8*)(sc + (size_t)(mb * 32 + r) * 1024 + wave * 128 + 8 * hh);
#pragma unroll
            for (int ks = 0; ks < 8; ++ks) Af[ks] = pack8(a[ks]);
#pragma unroll
            for (int ks = 0; ks < 8; ++ks) {
                if (ks < 7) {
#pragma unroll
                    for (int mb = 0; mb < 5; ++mb) Bv[(ks + 1) & 1][mb] = *(const bf16x8*)(sc + (size_t)(mb * 32 + r) * 1024 + wave * 128 + (ks + 1) * 16 + 8 * hh); }
#pragma unroll
                for (int mb = 0; mb < 5; ++mb) acc[mb] = MFMA32(Af[ks], Bv[ks & 1][mb], acc[mb]); } }
        { const int nn = nb + F.G < 576 ? nb + F.G : nb, n1 = nn * 32, l1 = n1 / 9216, nc1 = n1 - l1 * 9216;
            const float* W = adaw + (size_t)l1 * 1024 * 9216 + nc1 + r + (size_t)(wave * 128 + 8 * hh) * 9216;
#pragma unroll
            for (int ks = 0; ks < 8; ++ks)
#pragma unroll
                for (int j = 0; j < 8; ++j) a[ks][j] = W[(size_t)(ks * 16 + j) * 9216]; }
#pragma unroll
        for (int half = 4; half >= 1; half >>= 1) {
            if (wave >= half && wave < 2 * half) { LAS float* p = SL + (wave - half) * 5120 + lane;
#pragma unroll
                for (int mb = 0; mb < 5; ++mb)
#pragma unroll
                    for (int i = 0; i < 16; ++i) p[(mb * 16 + i) * 64] = acc[mb][i]; }
            MOD_BAR();
            if (wave < half) { const LAS float* p = SL + wave * 5120 + lane;
#pragma unroll
                for (int mb = 0; mb < 5; ++mb)
#pragma unroll
                    for (int i = 0; i < 16; ++i) acc[mb][i] += p[(mb * 16 + i) * 64]; }
            MOD_BAR();
        }
        if (wave == 0) {
#pragma unroll
            for (int mb = 0; mb < 5; ++mb)
#pragma unroll
                for (int i = 0; i < 16; ++i) T[(mb * 32 + r) * 33 + crow(i, hh)] = acc[mb][i]; }
        MOD_BAR();
        for (int m = F.tid >> 5; m < NSEQ; m += 16) { const int n = F.tid & 31; mod[(size_t)(l * NSEQ + m) * 9216 + nc0 + n] = T[m * 33 + n] + adab[l * 9216 + nc0 + n]; }
        MOD_BAR();
    }
}

struct TrP { const float* src; const float* sc; bf16* dst; int ld, nv, dld; float keep, sa, sb; };
DI void tr_load(const TrP& p, f32x4 (&v)[8], float (&m)[8], int lane) {
    const int n4 = (lane & 7) * 4, kr = lane >> 3;
#pragma unroll
    for (int i = 0; i < 8; ++i) { v[i] = *(const f32x4*)(p.src + (size_t)(kr + 8 * i) * p.ld + n4); m[i] = p.sc[kr + 8 * i]; }
}
DI void tr_finish(const TrP& p, const f32x4 (&v)[8], const float (&m)[8], LAS float* scr, int lane) {
    const int n4 = (lane & 7) * 4, kr = lane >> 3; const float kz = (n4 < p.nv) ? p.keep : 0.f;
#pragma unroll
    for (int i = 0; i < 8; ++i) { const float f = (p.sa + p.sb * m[i]) * kz; LAS float* q = scr + (kr + 8 * i) * 33 + n4;
        q[0] = kz == 0.f ? 0.f : v[i].x * f; q[1] = kz == 0.f ? 0.f : v[i].y * f; q[2] = kz == 0.f ? 0.f : v[i].z * f; q[3] = kz == 0.f ? 0.f : v[i].w * f; }
    LDS_WAIT(); asm volatile("" ::: "memory");
    const int c = lane & 7;
    float tv[4][8];
#pragma unroll
    for (int j = 0; j < 4; ++j) { const LAS float* t = scr + (8 * c) * 33 + (lane >> 3) + 8 * j;
#pragma unroll
        for (int k = 0; k < 8; ++k) tv[j][k] = t[k * 33]; }
#pragma unroll
    for (int j = 0; j < 4; ++j) { const int n = (lane >> 3) + 8 * j;
        v4u o; o.x = pk2(tv[j][0], tv[j][1]); o.y = pk2(tv[j][2], tv[j][3]); o.z = pk2(tv[j][4], tv[j][5]); o.w = pk2(tv[j][6], tv[j][7]);
        *(GAS v4u*)(p.dst + (size_t)n * p.dld + 8 * c) = o; }
    LDS_WAIT(); asm volatile("" ::: "memory");
}
DI void p0_decode(const Args& AR, unsigned char* ws, int it, TrP& p) {
    constexpr int I_13 = 16 * 176, I_2 = 44 * 32, I_IN = 16 * 104, I_SQ = 16 * 32, I_RKI = 16 * 96 + 32 * 8;
    bf16* W13 = (bf16*)(ws + WS_W13); bf16* W2 = (bf16*)(ws + WS_W2); bf16* WIN = (bf16*)(ws + WS_WIN); bf16* WOUT = (bf16*)(ws + WS_WOUT);
    bf16* WRK = (bf16*)(ws + WS_WRK); bf16* WL2 = (bf16*)(ws + WS_WL2); bf16* WO = (bf16*)(ws + WS_WO);
    int r = it; p.nv = 32; p.keep = 1.f; p.sa = 1.f; p.sb = 0.f; p.sc = nullptr;
    if (r < 4 * I_13) { const int f = r / I_13; r -= f * I_13; const int kt = r / 176, tn = r % 176, j = tn >> 3, i = tn & 7;
        p.src = (i < 4 ? AR.in[I_W1] : AR.in[I_W3]) + (size_t)f * 1024 * FF + (size_t)(64 * kt) * FF + 128 * j + 32 * (i & 3); p.ld = FF;
        p.dst = W13 + (size_t)f * 5632 * 1024 + (size_t)(32 * tn) * 1024 + 64 * kt; p.dld = 1024; }
    else if ((r -= 4 * I_13) < 4 * I_2) { const int f = r / I_2; r -= f * I_2; const int kt = r / 32, tn = r % 32;
        p.src = AR.in[I_W2] + (size_t)f * FF * 1024 + (size_t)(64 * kt) * 1024 + 32 * tn; p.ld = 1024;
        p.dst = W2 + (size_t)f * 1024 * FF + (size_t)(32 * tn) * FF + 64 * kt; p.dld = FF; }
    else if ((r -= 4 * I_2) < I_IN) { const int kt = r / 104, tn = r % 104, nd = 32 * tn; int sc0 = 0;
        if (nd < 2048) sc0 = nd; else if (nd < 3072) sc0 = nd + 8; else if (nd == 3072) { sc0 = 2048; p.nv = 8; } else p.keep = 0.f;
        p.src = AR.in[I_WIN] + (size_t)(64 * kt) * 3080 + sc0; p.ld = 3080; p.dst = WIN + (size_t)nd * 1024 + 64 * kt; p.dld = 1024; }
    else if ((r -= I_IN) < 2 * I_SQ) { const int w = r / I_SQ; r -= w * I_SQ; const int kt = r / 32, tn = r % 32;
        p.src = (w == 0 ? AR.in[I_WOUT] : AR.in[I_WO]) + (size_t)(64 * kt) * 1024 + 32 * tn; p.ld = 1024; p.dst = (w == 0 ? WOUT : WO) + (size_t)(32 * tn) * 1024 + 64 * kt; p.dld = 1024; }
    else if ((r -= 2 * I_SQ) < 16 * 96) { const int kt = r / 96, tn = r % 96, nd = 32 * tn;
        p.src = (nd < 1024 ? AR.in[I_WR] + nd : (nd < 2048 ? AR.in[I_WK] + (nd - 1024) : AR.in[I_WV] + (nd - 2048))) + (size_t)(64 * kt) * 1024; p.ld = 1024; p.dst = WRK + (size_t)nd * 1024 + 64 * kt; p.dld = 1024; }
    else if (r < I_RKI) { const int q = r - 16 * 96, kt = q / 8, tn = q % 8, nd = 32 * tn, kd = 64 * kt, half = kd >= 1024, ks = kd & 1023;
        const float* base; int ld, col, mi;
        if (nd < 64) { base = AR.in[I_LW1]; ld = 64; col = nd; mi = 1; }
        else if (nd < 128) { base = AR.in[I_A1]; ld = 64; col = nd - 64; mi = 4; }
        else { base = AR.in[I_G1]; ld = 128; col = nd - 128; mi = 5; }
        p.src = base + (size_t)ks * ld + col; p.ld = ld; p.sc = AR.in[I_MU] + mi * 1024 + ks; p.sa = half ? 0.f : 1.f; p.sb = half ? 1.f : -1.f; p.dst = WRK + (size_t)(3072 + 256 * half + nd) * 1024 + ks; p.dld = 1024; }
    else { r -= I_RKI; const int kt = r / 96, tn = r % 96, nd = 32 * tn; p.src = AR.in[I_LW2]; p.keep = 0.f; p.ld = 1024;
        if (nd < 1024) { if (kt == 0) { p.src = AR.in[I_LW2] + nd; p.keep = 1.f; } }
        else if (nd < 2048) { if (kt == 1) { p.src = AR.in[I_A2] + (nd - 1024); p.keep = 1.f; } }
        else { if (kt >= 2) { p.src = AR.in[I_G2] + (size_t)(64 * (kt - 2)) * 1024 + (nd - 2048); p.keep = 1.f; } }
        p.dst = WL2 + (size_t)nd * 256 + 64 * kt; p.dld = 256; }
    if (p.sc == nullptr) p.sc = p.src;
}
constexpr int P0_NITEMS = 4 * 16 * 176 + 4 * 44 * 32 + 16 * 104 + 2 * 16 * 32 + (16 * 96 + 32 * 8) + 4 * 96, P0_NPAIR = P0_NITEMS / 2;
constexpr int P0_MOD_LO = (4 * 16 * 176 + 44 * 32) / 2, P0_MOD_HI = (4 * 16 * 176 + 4 * 44 * 32) / 2;
constexpr int P0_MIXB_LO = (4 * 16 * 176 + 4 * 44 * 32 + 16 * 104 + 16 * 32) / 2, P0_MIXB_HI = P0_NPAIR;
static_assert(P0_NITEMS % 2 == 0, "pairs");
DI void p0_weights(Frame& F, const Args& AR, int lo1, int hi1, int lo2, int hi2, int widx, int wcnt) {
    LAS float* scr = (LAS float*)(F.lds + 32768 + F.wave * 8704);
    const int n1 = hi1 - lo1, n = n1 + (hi2 - lo2);
    if (widx < 0) return;
    for (int q = widx; q < n; q += wcnt) { const int g = q < n1 ? lo1 + q : lo2 + (q - n1);
        TrP pa, pb; f32x4 va[8], vb[8]; float ma[8], mb[8];
        p0_decode(AR, F.ws, 2 * g, pa); p0_decode(AR, F.ws, 2 * g + 1, pb);
        tr_load(pa, va, ma, F.lane); tr_load(pb, vb, mb, F.lane);
        tr_finish(pa, va, ma, scr, F.lane); tr_finish(pb, vb, mb, scr, F.lane);
    }
}

DI void ld8(float (&v)[8], const bf16* p) { const v4u q = *(const v4u*)p; v[0] = bflo(q.x); v[1] = bfhi(q.x); v[2] = bflo(q.y); v[3] = bfhi(q.y); v[4] = bflo(q.z); v[5] = bfhi(q.z); v[6] = bflo(q.w); v[7] = bfhi(q.w); }
DI void ld8(float (&v)[8], const float* p) { const f32x4 a = *(const f32x4*)p, b = *(const f32x4*)(p + 4); v[0] = a.x; v[1] = a.y; v[2] = a.z; v[3] = a.w; v[4] = b.x; v[5] = b.y; v[6] = b.z; v[7] = b.w; }
DI v4u pk8(const float (&v)[8]) { v4u w; w.x = pk2(v[0], v[1]); w.y = pk2(v[2], v[3]); w.z = pk2(v[4], v[5]); w.w = pk2(v[6], v[7]); return w; }
template <int NS> DI void slab_sum_n(const bf16* sl, float (&a)[8]) {
#pragma unroll
    for (int s0 = 1; s0 < NS; s0 += 5) { float u[5][8];
#pragma unroll
        for (int s2 = 0; s2 < 5; ++s2) if (s0 + s2 < NS) ld8(u[s2], sl + (size_t)(s0 + s2) * 1024 * 1024);
#pragma unroll
        for (int s2 = 0; s2 < 5; ++s2) if (s0 + s2 < NS) {
#pragma unroll
            for (int e = 0; e < 8; ++e) a[e] += u[s2][e]; } } }
template <int NS> DI void slab_all_n(const bf16* sl, float (&a)[8]) {
    v4u u[NS];
#pragma unroll
    for (int s2 = 0; s2 < NS; ++s2) u[s2] = *(const v4u*)(sl + (size_t)s2 * 1024 * 1024);
#pragma unroll
    for (int s2 = 0; s2 < NS; ++s2) { const v4u q = u[s2]; const float f[8] = {bflo(q.x), bfhi(q.x), bflo(q.y), bfhi(q.y), bflo(q.z), bfhi(q.z), bflo(q.w), bfhi(q.w)};
#pragma unroll
        for (int e = 0; e < 8; ++e) a[e] = s2 == 0 ? f[e] : a[e] + f[e]; } }
DI void slab_all(const bf16* sl, int nsplit, float (&a)[8]) {
    if (nsplit == 11) slab_all_n<11>(sl, a); else if (nsplit == 4) slab_all_n<4>(sl, a);
    else { ld8(a, sl); for (int s2 = 1; s2 < nsplit; ++s2) { float u[8]; ld8(u, sl + (size_t)s2 * 1024 * 1024);
#pragma unroll
        for (int e = 0; e < 8; ++e) a[e] += u[e]; } } }
DI void slab_sum(const bf16* sl, int nsplit, float (&a)[8]) {
    if (nsplit == 11) slab_sum_n<11>(sl, a); else if (nsplit == 4) slab_sum_n<4>(sl, a);
    else for (int s2 = 1; s2 < nsplit; ++s2) { float u[8]; ld8(u, sl + (size_t)s2 * 1024 * 1024);
#pragma unroll
        for (int e = 0; e < 8; ++e) a[e] += u[e]; } }
DI void ln_pass(Frame& F, const Args& AR, int first, int do_ln, int l, int sub, int lm, int js, int mode, int nsplit, int xfirst, int fin) {
    const int gw = F.vcu * NWAVES + F.wave, NGW = F.G * NWAVES, lane = F.lane;
    bf16* XB = (bf16*)((unsigned char*)F.out + XB_OFF); const bf16* ZS = fin ? (const bf16*)(F.ws + WS_ZF) : XB;
    const float* lg = AR.in[I_LNG] + (l * 3 + sub) * 1024; const float* lb = AR.in[I_LNB] + (l * 3 + sub) * 1024;
    const float* mod = (const float*)(F.ws + WS_MOD);
    bf16* H = (bf16*)(F.ws + WS_H); bf16* A2 = (bf16*)(F.ws + WS_A2);
    const int nprow = (MP - gw + NGW - 1) / NGW, hass = (MP + gw < M && NGW >= MS) ? 1 : 0;
    const bool oneseq = F.G == 256;
    auto rowof = [&](int k) -> int { const int kp = hass ? k - 1 : k; if (hass && k == 0) return MP + gw;
        return oneseq ? (F.vcu >> 5) * PSEQ + ((F.vcu & 31) * 8 + F.wave) + 256 * kp : gw + kp * NGW; };
    const int nrow = hass ? nprow + 1 : (M - gw + NGW - 1) / NGW;
    float nf[2][8]; v4u nb[2];
    auto issue = [&](int r) {
#pragma unroll
        for (int j = 0; j < 2; ++j) { const int c0 = 8 * (lane + 64 * j);
            if (first || (xfirst && r >= MP)) ld8(nf[j], (r < MP ? AR.in[I_XP] + (size_t)r * D : AR.in[I_XS] + (size_t)(r - MP) * D) + c0);
            else nb[j] = *(const v4u*)(ZS + (size_t)r * D + c0); } };
#pragma unroll
    for (int j = 0; j < 2; ++j) { nb[j] = (v4u){0u, 0u, 0u, 0u};
#pragma unroll
        for (int e = 0; e < 8; ++e) nf[j][e] = 0.f; }
    issue(nrow > 0 ? rowof(0) : 0);
    float lgv[2][8], lbv[2][8];
#pragma unroll
    for (int j = 0; j < 2; ++j) { ld8(lgv[j], lg + 8 * (lane + 64 * j)); ld8(lbv[j], lb + 8 * (lane + 64 * j)); }
    float s8v[2][8], h8v[2][8]; bool mod_have = false;
    for (int k = 0; k < nrow; ++k) { const int r = rowof(k);
        float v[2][8];
        if (first || (xfirst && r >= MP)) {
#pragma unroll
            for (int j = 0; j < 2; ++j)
#pragma unroll
                for (int e = 0; e < 8; ++e) v[j][e] = nf[j][e]; }
        else {
#pragma unroll
            for (int j = 0; j < 2; ++j) { const v4u a = nb[j];
                v[j][0] = bflo(a.x); v[j][1] = bfhi(a.x); v[j][2] = bflo(a.y); v[j][3] = bfhi(a.y); v[j][4] = bflo(a.z); v[j][5] = bfhi(a.z); v[j][6] = bflo(a.w); v[j][7] = bfhi(a.w); } }
        issue(k + 1 < nrow ? rowof(k + 1) : r);
        if (!(oneseq && r < MP && mod_have)) {
            const float* sh = mod + ((size_t)(lm * NSEQ + pg8::mod_row(r)) * 9 + js) * 1024;
#pragma unroll
            for (int j = 0; j < 2; ++j) { ld8(h8v[j], sh + 8 * (lane + 64 * j)); ld8(s8v[j], sh + 1024 + 8 * (lane + 64 * j)); }
            mod_have = r < MP; }
        if (nsplit > 0 && r >= MP) {
            const float* gp = mod + ((size_t)(l * NSEQ + pg8::mod_row(r)) * 9 + 3 * sub + 2) * 1024; const float rw = sub == 1 ? 1.0f : 0.5f;
            const bf16* sl = (const bf16*)(F.ws + WS_SLAB) + (size_t)(r - MP) * 1024;
#pragma unroll
            for (int j = 0; j < 2; ++j) { const int c0 = 8 * (lane + 64 * j); float a[8], g[8]; ld8(g, gp + c0);
                slab_all(sl + c0, nsplit, a);
#pragma unroll
                for (int e = 0; e < 8; ++e) v[j][e] = v[j][e] * ALPHA + (g[e] + 1.0f) * rw * a[e]; }
        }
        if (do_ln) {
            float s = 0.f;
#pragma unroll
            for (int j = 0; j < 2; ++j)
#pragma unroll
                for (int e = 0; e < 8; ++e) s += v[j][e];
            const float mean = wave_sum(s) * (1.f / D); float s2 = 0.f;
#pragma unroll
            for (int j = 0; j < 2; ++j)
#pragma unroll
                for (int e = 0; e < 8; ++e) { v[j][e] -= mean; s2 += v[j][e] * v[j][e]; }
            const float rstd = __builtin_amdgcn_rsqf(wave_sum(s2) * (1.f / D) + LN_EPS);
#pragma unroll
            for (int j = 0; j < 2; ++j) { const int c0 = 8 * (lane + 64 * j);
#pragma unroll
                for (int e = 0; e < 8; ++e) v[j][e] = v[j][e] * rstd * lgv[j][e] + lbv[j][e];
                if (fin) { float* o = F.out + O_Y + (size_t)r * D + c0; *(f32x4*)o = (f32x4){v[j][0], v[j][1], v[j][2], v[j][3]}; *(f32x4*)(o + 4) = (f32x4){v[j][4], v[j][5], v[j][6], v[j][7]}; }
                else *(v4u*)(XB + (size_t)r * D + c0) = pk8(v[j]); }
        }
        if (mode != 2) {
#pragma unroll
            for (int j = 0; j < 2; ++j) { const int c0 = 8 * (lane + 64 * j); float h[8];
#pragma unroll
                for (int e = 0; e < 8; ++e) h[e] = v[j][e] * (s8v[j][e] + 1.0f) + h8v[j][e];
                const v4u w = pk8(h);
                *(v4u*)(H + (size_t)r * D + c0) = w; }
        }
    }
}

struct LnPar { float lg[2][8], lb[2][8]; };
struct ModPar { float sc[2][8], sh[2][8]; };
DI void ld_lnpar(const Args& AR, int lane, LnPar& p) {
#pragma unroll
    for (int j = 0; j < 2; ++j) { ld8(p.lg[j], AR.in[I_LNG] + 3 * 1024 + 8 * (lane + 64 * j)); ld8(p.lb[j], AR.in[I_LNB] + 3 * 1024 + 8 * (lane + 64 * j)); } }
DI void ld_modpar(const float* mod, int mr, int lane, ModPar& p) { const float* sh = mod + ((size_t)(NSEQ + mr) * 9 + 3) * 1024;
#pragma unroll
    for (int j = 0; j < 2; ++j) { ld8(p.sh[j], sh + 8 * (lane + 64 * j)); ld8(p.sc[j], sh + 1024 + 8 * (lane + 64 * j)); } }
DI void rwkv_lnh(const LnPar& lp, const ModPar& mp, float (&x)[2][8], float (&h)[2][8]) {
    float s = 0.f;
#pragma unroll
    for (int j = 0; j < 2; ++j)
#pragma unroll
        for (int e = 0; e < 8; ++e) s += x[j][e];
    const float mean = wave_sum(s) * (1.f / D); float s2 = 0.f;
#pragma unroll
    for (int j = 0; j < 2; ++j)
#pragma unroll
        for (int e = 0; e < 8; ++e) { x[j][e] -= mean; s2 += x[j][e] * x[j][e]; }
    const float rstd = __builtin_amdgcn_rsqf(wave_sum(s2) * (1.f / D) + LN_EPS);
#pragma unroll
    for (int j = 0; j < 2; ++j)
#pragma unroll
        for (int e = 0; e < 8; ++e) { x[j][e] = x[j][e] * rstd * lp.lg[j][e] + lp.lb[j][e]; h[j][e] = x[j][e] * (mp.sc[j][e] + 1.0f) + mp.sh[j][e]; }
}
template <bool SAMP> DI void rwkv_emit(Frame& F, const Args& AR, int r, const float (&x)[2][8], const float (&h)[2][8], const float (&hp)[2][8], float* so) {
    const int lane = F.lane; const float* mu = AR.in[I_MU];
    bf16* XB = (bf16*)((unsigned char*)F.out + XB_OFF); bf16* A2 = (bf16*)(F.ws + WS_A2); bf16* XR = (bf16*)(F.ws + WS_H); bf16* XK = (bf16*)F.out;
    bf16* xv = (r < 16896 ? (bf16*)(F.ws + 1 * MiB) + (size_t)r * D : (bf16*)(F.ws + 45 * MiB) + (size_t)(r - 16896) * D);
#pragma unroll
    for (int j = 0; j < 2; ++j) { const int c0 = 8 * (lane + 64 * j);
        *(v4u*)(XB + (size_t)r * D + c0) = pk8(x[j]);
        if (SAMP) { *(v4u*)(A2 + (size_t)(r + 8) * D + c0) = pk8(h[j]); *(v4u*)(A2 + (size_t)(r + 1032) * D + c0) = pk8(hp[j]); }
        else { const size_t xr = (size_t)(r + 1 + (r >> 11)); *(v4u*)(A2 + xr * D + c0) = pk8(h[j]); if ((r & (PSEQ - 1)) == 0) *(v4u*)(A2 + (xr - 1) * D + c0) = pk8(hp[j]); }
        float m0[8], m2[8], m3[8], o[8]; ld8(m0, mu + c0); ld8(m2, mu + 2 * 1024 + c0); ld8(m3, mu + 3 * 1024 + c0);
#pragma unroll
        for (int e = 0; e < 8; ++e) o[e] = h[j][e] + (hp[j][e] - h[j][e]) * m0[e];
        *(v4u*)(XR + (size_t)r * D + c0) = pk8(o);
#pragma unroll
        for (int e = 0; e < 8; ++e) o[e] = h[j][e] + (hp[j][e] - h[j][e]) * m2[e];
        *(v4u*)(XK + (size_t)r * D + c0) = pk8(o);
#pragma unroll
        for (int e = 0; e < 8; ++e) o[e] = h[j][e] + (hp[j][e] - h[j][e]) * m3[e];
        *(v4u*)(xv + c0) = pk8(o);
        if (so) { *(f32x4*)(so + c0) = (f32x4){h[j][0], h[j][1], h[j][2], h[j][3]}; *(f32x4*)(so + c0 + 4) = (f32x4){h[j][4], h[j][5], h[j][6], h[j][7]}; } }
}
DI void ln_rwkv(Frame& F, const Args& AR, int nsplit) {
    const int gw = F.vcu * NWAVES + F.wave, NGW = F.G * NWAVES, lane = F.lane;
    const bf16* XB = (const bf16*)((unsigned char*)F.out + XB_OFF); const bf16* ZP = (const bf16*)(F.out + O_SWKV);
    const float* mod = (const float*)(F.ws + WS_MOD);
    LnPar lp; ld_lnpar(AR, lane, lp);
    for (int q = F.vcu; q < NSB; q += F.G) {
        const int t = F.wave, r = MP + SSEQ * q + t; float x[2][8], h[2][8], hp[2][8];
        ModPar mpq; ld_modpar(mod, NPB + q, lane, mpq);
        LAS float* HL = (LAS float*)F.lds;
        { v4u xq[2];
#pragma unroll
            for (int j = 0; j < 2; ++j) xq[j] = *(const v4u*)(XB + (size_t)r * D + 8 * (lane + 64 * j));
#pragma unroll
            for (int j = 0; j < 2; ++j) { const v4u a = xq[j];
                x[j][0] = bflo(a.x); x[j][1] = bfhi(a.x); x[j][2] = bflo(a.y); x[j][3] = bfhi(a.y); x[j][4] = bflo(a.z); x[j][5] = bfhi(a.z); x[j][6] = bflo(a.w); x[j][7] = bfhi(a.w); } }
        if (nsplit > 0) {
            const float* gp = mod + ((size_t)(NSEQ + NPB + q) * 9 + 2) * 1024; const bf16* sl = (const bf16*)(F.ws + WS_SLAB) + (size_t)(r - MP) * 1024;
#pragma unroll
            for (int j = 0; j < 2; ++j) { const int c0 = 8 * (lane + 64 * j); float a[8], g[8]; ld8(g, gp + c0);
                slab_all(sl + c0, nsplit, a);
#pragma unroll
                for (int e = 0; e < 8; ++e) x[j][e] = x[j][e] * ALPHA + (g[e] + 1.0f) * 0.5f * a[e]; }
        }
        rwkv_lnh(lp, mpq, x, h);
#pragma unroll
        for (int j = 0; j < 2; ++j) { LAS float* o = HL + t * 1024 + 8 * (lane + 64 * j); *(LAS f32x4*)o = (f32x4){h[j][0], h[j][1], h[j][2], h[j][3]}; *(LAS f32x4*)(o + 4) = (f32x4){h[j][4], h[j][5], h[j][6], h[j][7]}; }
        __syncthreads();
#pragma unroll
        for (int j = 0; j < 2; ++j) { const int c0 = 8 * (lane + 64 * j);
            if (t == 0) ld8(hp[j], AR.in[I_SSH] + (size_t)q * D + c0);
            else { const LAS float* o = HL + (t - 1) * 1024 + c0; const f32x4 a = *(const LAS f32x4*)o, b = *(const LAS f32x4*)(o + 4);
                hp[j][0] = a.x; hp[j][1] = a.y; hp[j][2] = a.z; hp[j][3] = a.w; hp[j][4] = b.x; hp[j][5] = b.y; hp[j][6] = b.z; hp[j][7] = b.w; } }
        rwkv_emit<true>(F, AR, r, x, h, hp, t == SSEQ - 1 ? F.out + O_SSH + (size_t)q * D : nullptr);
        __syncthreads();
    }
    for (int run = gw; run < MP / 8; run += NGW) { const int r0 = run * 8, b = r0 >> 11;
        ModPar mpr; ld_modpar(mod, b, lane, mpr);
        v4u zc[2]; float hc[2][8];
        { v4u zq[2]; const int rp = (r0 & (PSEQ - 1)) ? r0 - 1 : r0;
#pragma unroll
            for (int j = 0; j < 2; ++j) { zc[j] = *(const v4u*)(ZP + (size_t)r0 * D + 8 * (lane + 64 * j)); zq[j] = *(const v4u*)(ZP + (size_t)rp * D + 8 * (lane + 64 * j)); }
            float xp[2][8];
#pragma unroll
            for (int j = 0; j < 2; ++j) { const v4u q = zq[j];
                xp[j][0] = bflo(q.x); xp[j][1] = bfhi(q.x); xp[j][2] = bflo(q.y); xp[j][3] = bfhi(q.y); xp[j][4] = bflo(q.z); xp[j][5] = bfhi(q.z); xp[j][6] = bflo(q.w); xp[j][7] = bfhi(q.w); }
            rwkv_lnh(lp, mpr, xp, hc);
            if ((r0 & (PSEQ - 1)) == 0) {
#pragma unroll
                for (int j = 0; j < 2; ++j)
#pragma unroll
                    for (int e = 0; e < 8; ++e) hc[j][e] = 0.f; } }
#pragma unroll 1
        for (int k = 0; k < 8; ++k) { const int r = r0 + k, t = r & (PSEQ - 1);
            float x[2][8], h[2][8];
#pragma unroll
            for (int j = 0; j < 2; ++j) { const v4u a = zc[j];
                x[j][0] = bflo(a.x); x[j][1] = bfhi(a.x); x[j][2] = bflo(a.y); x[j][3] = bfhi(a.y); x[j][4] = bflo(a.z); x[j][5] = bfhi(a.z); x[j][6] = bflo(a.w); x[j][7] = bfhi(a.w); }
            { const int rn = k < 7 ? r + 1 : r;
#pragma unroll
                for (int j = 0; j < 2; ++j) zc[j] = *(const v4u*)(ZP + (size_t)rn * D + 8 * (lane + 64 * j)); }
            rwkv_lnh(lp, mpr, x, h);
            rwkv_emit<false>(F, AR, r, x, h, hc, t == PSEQ - 1 ? F.out + O_PSH + (size_t)b * D : nullptr);
#pragma unroll
            for (int j = 0; j < 2; ++j)
#pragma unroll
                for (int e = 0; e < 8; ++e) hc[j][e] = h[j][e]; }
    }
}

DI float flog1p(float e) { return e < 0.015625f ? e * (1.0f - e * (0.5f - e * 0.33333333f)) : 0.69314718f * __builtin_amdgcn_logf(1.0f + e); }
DI float log_sigmoid(float x) { return -(fmaxf(-x, 0.f) + flog1p(__expf(-fabsf(x)))); }
DI float gelu_tanh(float x) { const float u = 0.7978845608f * (x + 0.044715f * x * x * x); return 0.5f * x * (1.0f + pg8::ftanh(u)); }

typedef short trv4 __attribute__((ext_vector_type(4)));
DI void ml1_prompt(Frame& F, const Args& AR) {
    const bf16* Z = (const bf16*)(F.ws + WS_Z);
    float* CST = (float*)(F.ws + WS_CST); float* NST = (float*)(F.ws + WS_NST); float* MST = (float*)(F.ws + WS_MST); float* GATE = (float*)(F.ws + WS_GATE);
    LAS bf16* Ks = (LAS bf16*)F.lds;
    LAS bf16* Vs = (LAS bf16*)(F.lds + 40960);
    LAS float* LF = (LAS float*)(F.lds + 81920);
    LAS float* GS = (LAS float*)(F.lds + 81920 + 512);
    LAS float* RED = (LAS float*)(F.lds + 81920 + 1024);
    const int tid = F.tid, lane = F.lane, wave = F.wave, r = lane & 31, hh = lane >> 5;
    for (int item = F.vcu; item < 512; item += F.G) {
        const int b = item >> 6, h = (item >> 4) & 3, c = item & 15; const size_t row0 = (size_t)b * PSEQ + c * 128;
        const bf16 fgq = Z[(row0 + (tid & 127)) * ZW + ZFG + h], igq = Z[(row0 + (tid & 127)) * ZW + ZIG + h];
        { v4u kq[4], vq[4];
#pragma unroll
            for (int i = 0; i < 4; ++i) { const int e = tid + i * NTHREADS, s = e >> 4, c8 = (e & 15) * 8;
                kq[i] = *(const v4u*)(Z + (row0 + s) * ZW + ZK + h * 128 + c8); vq[i] = *(const v4u*)(Z + (row0 + s) * ZW + ZV + h * 128 + c8); }
#pragma unroll
            for (int i = 0; i < 4; ++i) { const int e = tid + i * NTHREADS, s = e >> 4, c8 = (e & 15) * 8;
                *(LAS v4u*)(Ks + s * 160 + c8) = kq[i]; *(LAS v4u*)(Vs + s * 160 + c8) = vq[i]; } }
        if (tid < 128) { const float fg = bf2f(fgq); LF[tid] = log_sigmoid(fg + AR.in[I_BG][4 + h]); }
        __syncthreads();
        if (tid < 8) { float sb = 0.f, lv[16];
#pragma unroll
            for (int j = 0; j < 16; ++j) lv[j] = LF[tid * 16 + j];
#pragma unroll
            for (int j = 0; j < 16; ++j) sb += lv[j];
            RED[8 + tid] = sb; }
        __syncthreads();
        float ig_bs_hold = 0.f;
        if (tid < 128) { const int blk = tid >> 4; float bs = 0.f, rv[8], lv[16];
#pragma unroll
            for (int q = 0; q < 8; ++q) rv[q] = RED[8 + q];
#pragma unroll
            for (int j = 0; j < 16; ++j) lv[j] = LF[blk * 16 + j];
#pragma unroll
            for (int q = 0; q < 8; ++q) bs += (q < blk) ? rv[q] : 0.f;
#pragma unroll
            for (int j = 0; j < 16; ++j) bs += (blk * 16 + j <= tid) ? lv[j] : 0.f;
            const float ig = bf2f(igq) + AR.in[I_BG][h];
            GS[tid] = ig - bs; ig_bs_hold = bs; if (tid == 127) RED[0] = bs; }
        __syncthreads();
        if (tid < 8) { float mb = -INFINITY, gv[16];
#pragma unroll
            for (int j = 0; j < 16; ++j) gv[j] = GS[tid * 16 + j];
#pragma unroll
            for (int j = 0; j < 16; ++j) mb = fmaxf(mb, gv[j]);
            RED[16 + tid] = mb; }
        __syncthreads();
        float rm[8];
#pragma unroll
        for (int q = 0; q < 8; ++q) rm[q] = RED[16 + q];
        float gmax = rm[0];
#pragma unroll
        for (int q = 1; q < 8; ++q) gmax = fmaxf(gmax, rm[q]);
        const float bL = RED[0];
        float wv = 0.f;
        if (tid < 128) { const int blk = tid >> 4; float pm = -INFINITY; const float gme = GS[tid];
            float gv[16];
#pragma unroll
            for (int j = 0; j < 16; ++j) gv[j] = GS[blk * 16 + j];
#pragma unroll
            for (int q = 0; q < 8; ++q) pm = (q < blk) ? fmaxf(pm, rm[q]) : pm;
#pragma unroll
            for (int j = 0; j < 16; ++j) pm = (blk * 16 + j <= tid) ? fmaxf(pm, gv[j]) : pm;
            float* gp = GATE + (size_t)item * 384; gp[tid] = ig_bs_hold; gp[128 + tid] = gme; gp[256 + tid] = pm;
            wv = fexp(gme - gmax); }
        __syncthreads();
        if (tid < 128) GS[tid] = wv;
        __syncthreads();
        const int vb = wave >> 1, kb0 = 2 * (wave & 1);
        f32x16 acc[2];
#pragma unroll
        for (int i = 0; i < 16; ++i) { acc[0][i] = 0.f; acc[1][i] = 0.f; }
#pragma unroll 2
        for (int ks = 0; ks < 8; ++ks) { const int s0 = 16 * ks + 8 * hh;
            float a[8]; unsigned vq[8];
            const int trow = (s0 + ((lane >> 2) & 3)) * 160 + (lane & 16) + 4 * (lane & 3);
            { const v2u u0 = __builtin_bit_cast(v2u, __builtin_amdgcn_ds_read_tr16_b64_v4i16((LAS trv4*)(Vs + trow + vb * 32))), u1 = __builtin_bit_cast(v2u, __builtin_amdgcn_ds_read_tr16_b64_v4i16((LAS trv4*)(Vs + trow + vb * 32 + 4 * 160)));
                vq[0] = u0.x & 0xffffu; vq[1] = u0.x >> 16; vq[2] = u0.y & 0xffffu; vq[3] = u0.y >> 16; vq[4] = u1.x & 0xffffu; vq[5] = u1.x >> 16; vq[6] = u1.y & 0xffffu; vq[7] = u1.y >> 16; }
            const f32x4 gq0 = *(const LAS f32x4*)(GS + s0), gq1 = *(const LAS f32x4*)(GS + s0 + 4); const float gq[8] = {gq0.x, gq0.y, gq0.z, gq0.w, gq1.x, gq1.y, gq1.z, gq1.w};
#pragma unroll
            for (int j = 0; j < 8; ++j) a[j] = bf2f(vq[j]) * gq[j];
            const bf16x8 A = pack8(a);
#pragma unroll
            for (int q = 0; q < 2; ++q) {
                const v2u u0 = __builtin_bit_cast(v2u, __builtin_amdgcn_ds_read_tr16_b64_v4i16((LAS trv4*)(Ks + trow + (kb0 + q) * 32))), u1 = __builtin_bit_cast(v2u, __builtin_amdgcn_ds_read_tr16_b64_v4i16((LAS trv4*)(Ks + trow + (kb0 + q) * 32 + 4 * 160)));
                const bf16x8 B = mk_frag(u0.x, u0.y, u1.x, u1.y);
                acc[q] = MFMA32(A, B, acc[q]); } }
        bf16* Co = (bf16*)CST + (size_t)item * 16384;
#pragma unroll
        for (int q = 0; q < 2; ++q)
#pragma unroll
            for (int i = 0; i < 16; ++i) Co[(vb * 32 + crow(i, hh)) * 128 + (kb0 + q) * 32 + r] = (bf16)f2bf(acc[q][i] * MSCALE);
        { const int kq = tid & 127, sq = tid >> 7; float n = 0.f;
#pragma unroll
            for (int s8 = 0; s8 < 4; ++s8) { unsigned kq8[8];
#pragma unroll
                for (int j = 0; j < 8; ++j) kq8[j] = Ks[(sq * 32 + 8 * s8 + j) * 160 + kq];
                const f32x4 g0 = *(const LAS f32x4*)(GS + sq * 32 + 8 * s8), g1 = *(const LAS f32x4*)(GS + sq * 32 + 8 * s8 + 4);
                n += g0.x * bf2f(kq8[0]); n += g0.y * bf2f(kq8[1]); n += g0.z * bf2f(kq8[2]); n += g0.w * bf2f(kq8[3]);
                n += g1.x * bf2f(kq8[4]); n += g1.y * bf2f(kq8[5]); n += g1.z * bf2f(kq8[6]); n += g1.w * bf2f(kq8[7]); }
            RED[32 + sq * 128 + kq] = n; }
        __syncthreads();
        if (tid < 128) NST[item * 128 + tid] = ((RED[32 + tid] + RED[32 + 128 + tid]) + (RED[32 + 256 + tid] + RED[32 + 384 + tid])) * MSCALE;
        if (tid == 0) { MST[item * 4 + 0] = bL + gmax; MST[item * 4 + 1] = bL; }
        __syncthreads();
    }
}

DI void ml_sample(Frame& F, const Args& AR) {
    const bf16* Z = (const bf16*)(F.ws + WS_Z); bf16* G = (bf16*)(F.ws + WS_H);
    const int tid = F.tid, lane = F.lane, sub = tid >> 8, t2 = tid & 255, w4 = F.wave & 3;
    LAS float* Qs = (LAS float*)F.lds + sub * 5632;
    LAS float* Ks = Qs + 1024; LAS float* Vs = Ks + 1024;
    LAS float* HT = Vs + 1024;
    LAS float* P = HT + 1024;
    LAS float* GT = P + 64;
    LAS float* SC = GT + 64;
    LAS float* N0 = SC + 4;
    const float* C0g = AR.in[I_SMC]; const float* n0g = AR.in[I_SMN]; const float* m0g = AR.in[I_SMM];
    for (int pr = F.vcu; pr < 256; pr += F.G) {
        const int item = 2 * pr + sub, b = item >> 2, h = item & 3; const size_t row0 = (size_t)MP + (size_t)b * SSEQ;
        const int v = t2 >> 1, seg = t2 & 1;
        const float* C0p = C0g + ((size_t)(b * 4 + h) * 128 + v) * 128 + seg * 4;
        f32x4 c0q[16];
#pragma unroll
        for (int i = 0; i < 16; ++i) c0q[i] = *(const f32x4*)(C0p + 8 * i);
        bf16 og[2][2];
#pragma unroll
        for (int k = 0; k < 2; ++k) { og[k][0] = Z[(row0 + 2 * w4 + k) * ZW + ZO + h * 128 + lane]; og[k][1] = Z[(row0 + 2 * w4 + k) * ZW + ZO + h * 128 + 64 + lane]; }
        const float m0 = m0g[b * 4 + h], n0v = n0g[(size_t)(b * 4 + h) * 128 + (t2 & 127)];
        const bf16 zgv = Z[(row0 + (t2 & 7)) * ZW + ((t2 & 15) < 8 ? ZIG : ZFG) + h];
        { unsigned uq[6];
#pragma unroll
            for (int i = 0; i < 6; ++i) { const int e = t2 + 256 * i, w = e >> 9, t = (e >> 6) & 7, c2 = (e & 63) * 2; uq[i] = *(const unsigned*)(Z + (row0 + t) * ZW + (w == 0 ? ZQ : (w == 1 ? ZK : ZV)) + h * 128 + c2); }
#pragma unroll
            for (int i = 0; i < 6; ++i) { const int e = t2 + 256 * i, w = e >> 9, t = (e >> 6) & 7, c2 = (e & 63) * 2;
                LAS float* dst = (w == 0 ? Qs : (w == 1 ? Ks : Vs)) + t * 128 + c2; dst[0] = bflo(uq[i]); dst[1] = bfhi(uq[i]); } }
        if (t2 >= 128) N0[t2 - 128] = n0v;
        if (t2 < 16) { const int t = t2 & 7; const float zv = bf2f(zgv);
            if (t2 < 8) P[t] = zv + AR.in[I_BG][h]; else GT[7 * 8 + t] = log_sigmoid(zv + AR.in[I_BG][4 + h]); }
        __syncthreads();
        if (t2 < 8) { float bs = 0.f, mx = m0, bsl = 0.f, gme = 0.f;
            const f32x4 f0 = *(const LAS f32x4*)(GT + 7 * 8), f1 = *(const LAS f32x4*)(GT + 7 * 8 + 4), i0 = *(const LAS f32x4*)P, i1 = *(const LAS f32x4*)(P + 4);
            const float fl[8] = {f0.x, f0.y, f0.z, f0.w, f1.x, f1.y, f1.z, f1.w}, ig[8] = {i0.x, i0.y, i0.z, i0.w, i1.x, i1.y, i1.z, i1.w};
#pragma unroll
            for (int s = 0; s < 8; ++s) { bs += fl[s]; const float g = ig[s] - bs; if (s <= t2) { mx = fmaxf(mx, g); bsl = bs; } if (s == t2) gme = g; }
            GT[0 * 8 + t2] = bsl; GT[1 * 8 + t2] = gme; GT[2 * 8 + t2] = mx; GT[3 * 8 + t2] = fexp(m0 - mx);
            if (t2 == 7) { const float mend = bsl + mx; SC[0] = mend; SC[1] = fexp(bsl + m0 - mend); } }
        __syncthreads();
        if (t2 < 8) { const float mend = SC[0]; GT[5 * 8 + t2] = fexp(GT[0 * 8 + 7] + GT[1 * 8 + t2] - mend); }
#pragma unroll
        for (int rep = 0; rep < 2; ++rep) { const int g = (t2 >> 3) + 32 * rep, l8 = t2 & 7, t = g >> 3, sq = g & 7; float d;
            { f32x4 qa[4], ka[4];
#pragma unroll
                for (int k4 = 0; k4 < 4; ++k4) { qa[k4] = *(const LAS f32x4*)(Qs + t * 128 + l8 * 16 + 4 * k4); ka[k4] = *(const LAS f32x4*)(Ks + sq * 128 + l8 * 16 + 4 * k4); }
                f32x4 dv = qa[0] * ka[0];
#pragma unroll
                for (int k4 = 1; k4 < 4; ++k4) dv += qa[k4] * ka[k4];
                d = (dv.x + dv.y) + (dv.z + dv.w); }
            d = sum8(d);
            if (l8 == 0) P[t * 8 + sq] = (sq <= t) ? d * MSCALE * fexp(GT[1 * 8 + sq] - GT[2 * 8 + t]) : 0.f;
            if (g < 8) { f32x4 qa[4], na[4];
#pragma unroll
                for (int k4 = 0; k4 < 4; ++k4) { qa[k4] = *(const LAS f32x4*)(Qs + g * 128 + l8 * 16 + 4 * k4); na[k4] = *(const LAS f32x4*)(N0 + l8 * 16 + 4 * k4); }
                f32x4 dv = qa[0] * na[0];
#pragma unroll
                for (int k4 = 1; k4 < 4; ++k4) dv += qa[k4] * na[k4];
                float q = (dv.x + dv.y) + (dv.z + dv.w);
                q = sum8(q); if (l8 == 0) GT[6 * 8 + g] = q; } }
        __syncthreads();
        if (t2 < 8) { const f32x4 p0 = *(const LAS f32x4*)(P + t2 * 8), p1 = *(const LAS f32x4*)(P + t2 * 8 + 4); const float g3 = GT[3 * 8 + t2], g6 = GT[6 * 8 + t2], g0 = GT[0 * 8 + t2], g2 = GT[2 * 8 + t2];
            float d = ((p0.x + p0.y) + (p0.z + p0.w)) + ((p1.x + p1.y) + (p1.z + p1.w)); d += g3 * g6;
            const float mt = g0 + g2; GT[4 * 8 + t2] = fmaxf(fabsf(d), fexp(-mt)); }
        __syncthreads();
        float inter[8];
#pragma unroll
        for (int t = 0; t < 8; ++t) { f32x4 dv = (f32x4){0.f, 0.f, 0.f, 0.f};
#pragma unroll
            for (int hq = 0; hq < 2; ++hq) { f32x4 qv[8];
#pragma unroll
                for (int i4 = 0; i4 < 8; ++i4) qv[i4] = *(const LAS f32x4*)(Qs + t * 128 + 8 * (8 * hq + i4) + 4 * seg);
#pragma unroll
                for (int i4 = 0; i4 < 8; ++i4) dv += c0q[8 * hq + i4] * qv[i4]; }
            float d = (dv.x + dv.y) + (dv.z + dv.w);
            d += __shfl_xor(d, 1); inter[t] = d; }
        if (seg == 0) { float vv[8], wi[8], dn[8];
#pragma unroll
            for (int s2 = 0; s2 < 8; ++s2) { vv[s2] = Vs[s2 * 128 + v]; wi[s2] = GT[3 * 8 + s2]; dn[s2] = GT[4 * 8 + s2]; }
#pragma unroll
            for (int t = 0; t < 8; ++t) { const f32x4 p0 = *(const LAS f32x4*)(P + t * 8), p1 = *(const LAS f32x4*)(P + t * 8 + 4);
                float num = wi[t] * inter[t];
                num += p0.x * vv[0]; num += p0.y * vv[1]; num += p0.z * vv[2]; num += p0.w * vv[3]; num += p1.x * vv[4]; num += p1.y * vv[5]; num += p1.z * vv[6]; num += p1.w * vv[7];
                HT[t * 128 + v] = num * __builtin_amdgcn_rcpf(dn[t]); } }
        { const float wst = SC[1]; float* Cout = F.out + O_SMC + ((size_t)(b * 4 + h) * 128 + v) * 128 + seg * 4;
#pragma unroll
            for (int i = 0; i < 16; ++i) c0q[i] *= wst;
#pragma unroll
            for (int s = 0; s < 8; ++s) { const float wv = GT[5 * 8 + s] * Vs[s * 128 + v] * MSCALE;
#pragma unroll
                for (int hq = 0; hq < 2; ++hq) { f32x4 kv[8];
#pragma unroll
                    for (int i4 = 0; i4 < 8; ++i4) kv[i4] = *(const LAS f32x4*)(Ks + s * 128 + 8 * (8 * hq + i4) + 4 * seg);
#pragma unroll
                    for (int i4 = 0; i4 < 8; ++i4) c0q[8 * hq + i4] += kv[i4] * wv; } }
#pragma unroll
            for (int i = 0; i < 16; ++i) *(f32x4*)(Cout + 8 * i) = c0q[i]; }
        if (t2 < 128) { float n = SC[1] * N0[t2];
            for (int s = 0; s < 8; ++s) n += GT[5 * 8 + s] * Ks[s * 128 + t2] * MSCALE;
            F.out[O_SMN + (size_t)(b * 4 + h) * 128 + t2] = n; }
        if (t2 == 0) F.out[O_SMM + b * 4 + h] = SC[0];
        __syncthreads();
#pragma unroll
        for (int k = 0; k < 2; ++k) { const int t = 2 * w4 + k; const float x0 = HT[t * 128 + lane], x1 = HT[t * 128 + 64 + lane];
            const float mean = wave_sum(x0 + x1) * (1.f / 128.f); const float d0 = x0 - mean, d1 = x1 - mean;
            const float rstd = __builtin_amdgcn_rsqf(wave_sum(d0 * d0 + d1 * d1) * (1.f / 128.f) + HEAD_EPS);
            const size_t row = row0 + t;
            const float o0 = bf2f(og[k][0]), o1 = bf2f(og[k][1]);
            const float g0 = AR.in[I_MNG][h * 128 + lane], g1 = AR.in[I_MNG][h * 128 + 64 + lane];
            G[row * D + h * 128 + lane] = (bf16)f2bf(d0 * rstd * g0 * fsig(o0)); G[row * D + h * 128 + 64 + lane] = (bf16)f2bf(d1 * rstd * g1 * fsig(o1)); }
        __syncthreads();
    }
}

template <bool SAMP>
DI void rg_conv(const Args& AR, const bf16* Z, const float* cw, const float* cbias, LAS float* XT, bf16x8 (&Af)[4], int row, int t, int b, int g, int r, int hh) {
#pragma unroll
    for (int kp = 0; kp < 2; ++kp) {
        v4u zq[2][4];
#pragma unroll
        for (int k2 = 0; k2 < 2; ++k2)
#pragma unroll
            for (int tap = 0; tap < 4; ++tap) { const bool ok = t + tap - 3 >= 0; zq[k2][tap] = *(const v4u*)(Z + (size_t)(ok ? row + tap - 3 : row) * ZW + ZXR + 64 * g + 16 * (2 * kp + k2) + 8 * hh); }
#pragma unroll
        for (int k2 = 0; k2 < 2; ++k2) { const int ks = 2 * kp + k2, c0 = 64 * g + 16 * ks + 8 * hh; float xc[8];
            f32x4 s0[3], s1[3], cw0[4], cw1[4];
            const f32x4 bq0 = *(const f32x4*)(cbias + c0), bq1 = *(const f32x4*)(cbias + c0 + 4);
#pragma unroll
            for (int tap = 0; tap < 4; ++tap) { cw0[tap] = *(const f32x4*)(cw + tap * 512 + c0); cw1[tap] = *(const f32x4*)(cw + tap * 512 + c0 + 4); }
            if constexpr (SAMP) {
#pragma unroll
                for (int tap = 0; tap < 3; ++tap) { const bool ok = t + tap - 3 >= 0; const float* sp = AR.in[I_SRC] + ((size_t)b * 3 + (ok ? 0 : t + tap)) * 512 + c0; s0[tap] = *(const f32x4*)sp; s1[tap] = *(const f32x4*)(sp + 4); } }
            xc[0] = bq0.x; xc[1] = bq0.y; xc[2] = bq0.z; xc[3] = bq0.w; xc[4] = bq1.x; xc[5] = bq1.y; xc[6] = bq1.z; xc[7] = bq1.w;
#pragma unroll
            for (int tap = 0; tap < 4; ++tap) { const bool ok = t + tap - 3 >= 0; const v4u q = zq[k2][tap]; float xv[8];
                xv[0] = bflo(q.x); xv[1] = bfhi(q.x); xv[2] = bflo(q.y); xv[3] = bfhi(q.y); xv[4] = bflo(q.z); xv[5] = bfhi(q.z); xv[6] = bflo(q.w); xv[7] = bfhi(q.w);
                if (tap < 3) {
                    if constexpr (SAMP) { const f32x4 q0 = s0[tap], q1 = s1[tap]; const float st[8] = {q0.x, q0.y, q0.z, q0.w, q1.x, q1.y, q1.z, q1.w};
#pragma unroll
                        for (int j = 0; j < 8; ++j) xv[j] = ok ? xv[j] : st[j]; }
                    else {
#pragma unroll
                        for (int j = 0; j < 8; ++j) xv[j] = ok ? xv[j] : 0.f; } }
                const f32x4 w0 = cw0[tap], w1 = cw1[tap];
                xc[0] += w0.x * xv[0]; xc[1] += w0.y * xv[1]; xc[2] += w0.z * xv[2]; xc[3] += w0.w * xv[3]; xc[4] += w1.x * xv[4]; xc[5] += w1.y * xv[5]; xc[6] += w1.z * xv[6]; xc[7] += w1.w * xv[7]; }
            Af[ks] = pack8(xc);
            LAS float* xp = XT + r * 68 + 16 * ks + 8 * hh;
            *(LAS f32x4*)xp = (f32x4){xc[0], xc[1], xc[2], xc[3]}; *(LAS f32x4*)(xp + 4) = (f32x4){xc[4], xc[5], xc[6], xc[7]};
            asm volatile("" ::: "memory"); }
    }
}
DI void rg1(Frame& F, const Args& AR) {
    const bf16* Z = (const bf16*)(F.ws + WS_Z); bf16* G = (bf16*)(F.ws + WS_H);
    unsigned* RGHP = (unsigned*)(F.ws + WS_RGH);
    float* TEH = (float*)(F.ws + WS_RGP); float* TEP = TEH + 512 * 512;
    const int lane = F.lane, g = F.wave, r = lane & 31, hh = lane >> 5;
    LAS float* XT = (LAS float*)(F.lds + g * 17408);
    LAS float* AT = XT + 32 * 68;
    bf16x8 Ba[4][2], Bx[4][2];
    { const GAS bf16* wf = (const GAS bf16*)(F.ws + WS_WRG);
#pragma unroll
        for (int ks = 0; ks < 4; ++ks)
#pragma unroll
            for (int cb = 0; cb < 2; ++cb) { const int e = ((((g * 4 + ks) * 2 + cb) * 2 + hh) * 32 + r) * 8;
                Ba[ks][cb] = *(const GAS bf16x8*)(wf + e); Bx[ks][cb] = *(const GAS bf16x8*)(wf + 4096 * 8 + e); } }
    float spl[2], ba[2], bx[2];
#pragma unroll
    for (int cb = 0; cb < 2; ++cb) { const int c = 64 * g + cb * 32 + r; spl[cb] = -8.0f * flog1p(__expf(-AR.in[I_LAM][c])); ba[cb] = AR.in[I_BA][c]; bx[cb] = AR.in[I_BX][c]; }
    const float* cw = AR.in[I_CW]; const float* cbias = AR.in[I_CB];
    for (int tt = F.vcu; tt < M / 32; tt += F.G) {
        const int R0 = tt * 32, row = R0 + r; const bool samp = R0 >= MP;
        int t, b; if (!samp) { t = row & (PSEQ - 1); b = row >> 11; } else { t = (row - MP) & 7; b = (row - MP) >> 3; }
        bf16x8 Af[4];
        if (samp) rg_conv<true>(AR, Z, cw, cbias, XT, Af, row, t, b, g, r, hh); else rg_conv<false>(AR, Z, cw, cbias, XT, Af, row, t, b, g, r, hh);
        LDS_WAIT(); asm volatile("" ::: "memory");
#pragma unroll
        for (int cb = 0; cb < 2; ++cb) { f32x16 da, dx;
#pragma unroll
            for (int i = 0; i < 16; ++i) { da[i] = 0.f; dx[i] = 0.f; }
#pragma unroll
            for (int ks = 0; ks < 4; ++ks) { da = MFMA32(Af[ks], Ba[ks][cb], da); dx = MFMA32(Af[ks], Bx[ks][cb], dx); }
#pragma unroll
            for (int i = 0; i < 16; ++i) { const int tr = crow(i, hh), j = cb * 32 + r;
                const float rg = fsig(da[i] + ba[cb]), ig = fsig(dx[i] + bx[cb]);
                const float la = spl[cb] * rg, a = fexp(la), xcv = XT[tr * 68 + j];
                const float u = __builtin_amdgcn_sqrtf(fmaxf(1.0f - a * a, 0.f)) * ig * xcv;
                AT[tr * 68 + j] = a; XT[tr * 68 + j] = u; } }
        LDS_WAIT(); asm volatile("" ::: "memory");
        { const int c = 64 * g + lane;
            if (!samp) { float h = 0.f, P = 1.f;
#pragma unroll
                for (int t8 = 0; t8 < 4; ++t8) { float av[8], uv[8];
#pragma unroll
                    for (int j = 0; j < 8; ++j) { av[j] = AT[(8 * t8 + j) * 68 + lane]; uv[j] = XT[(8 * t8 + j) * 68 + lane]; }
#pragma unroll
                    for (int j = 0; j < 8; ++j) { const int tr = 8 * t8 + j; h = av[j] * h + uv[j]; P *= av[j];
                        RGHP[(size_t)(R0 + tr) * 512 + c] = pk2(h, P); } }
                TEH[(size_t)tt * 512 + c] = h; TEP[(size_t)tt * 512 + c] = P; }
            else { float h = 0.f; const int b0 = (R0 - MP) >> 3;
                bf16 grq[32]; float h0q[4];
#pragma unroll
                for (int tr = 0; tr < 32; ++tr) grq[tr] = Z[(size_t)(R0 + tr) * ZW + ZGR + c];
#pragma unroll
                for (int q = 0; q < 4; ++q) h0q[q] = AR.in[I_SRH][(size_t)(b0 + q) * 512 + c];
#pragma unroll
                for (int tr = 0; tr < 32; ++tr) { const int bb = b0 + (tr >> 3);
                    if ((tr & 7) == 0) h = h0q[tr >> 3];
                    const float a = AT[tr * 68 + lane], u = XT[tr * 68 + lane]; h = a * h + u;
                    const float gr = bf2f(grq[tr]);
                    G[(size_t)(R0 + tr) * D + 512 + c] = (bf16)f2bf(h * gelu_tanh(gr));
                    if ((tr & 7) == 7) F.out[O_SRH + (size_t)bb * 512 + c] = h; } } }
        LDS_WAIT(); asm volatile("" ::: "memory");
    }
    { const int gt = F.vcu * NTHREADS + F.tid, NT = F.G * NTHREADS;
        for (int e = gt; e < NSEQ * 3 * 512; e += NT) { const int c = e & 511, j = (e >> 9) % 3, s = e / 1536;
            if (s < NPB) F.out[O_PRC + ((size_t)s * 3 + j) * 512 + c] = bf2f(Z[((size_t)s * PSEQ + PSEQ - 3 + j) * ZW + ZXR + c]);
            else { const int b = s - NPB; F.out[O_SRC + ((size_t)b * 3 + j) * 512 + c] = bf2f(Z[((size_t)MP + (size_t)b * SSEQ + SSEQ - 3 + j) * ZW + ZXR + c]); } } }
}

DI void ml2_scan(Frame& F, const Args& AR) {
    const float* CST = (const float*)(F.ws + WS_CST); float* NST = (float*)(F.ws + WS_NST); float* MST = (float*)(F.ws + WS_MST); bf16* CB = (bf16*)F.out;
    for (int vb = F.vcu; vb < 256; vb += F.G) {
        const int bh = vb >> 3, e0 = ((vb & 7) * NTHREADS + F.tid) * 4;
        float m = 0.f; float z0 = 0.f; asm volatile("" : "+v"(z0));
        f32x4 C = (f32x4){z0, z0, z0, z0};
        const bool nthr = (vb & 7) == 0 && F.tid < 128; float n = 0.f;
        v2u cl[16]; float ml[16], bl[16], nl[16];
#pragma unroll
        for (int c = 0; c < 16; ++c) { const int item = bh * 16 + c; cl[c] = *(const v2u*)((const bf16*)CST + (size_t)item * 16384 + e0); ml[c] = MST[item * 4 + 0]; bl[c] = MST[item * 4 + 1];
            nl[c] = NST[item * 128 + (F.tid & 127)]; }
#pragma unroll
        for (int c = 0; c < 16; ++c) { const int item = bh * 16 + c;
            { v2u cw; cw.x = pk2(C.x, C.y); cw.y = pk2(C.z, C.w); *(v2u*)(CB + (size_t)item * 16384 + e0) = cw; }
            const float mn = fmaxf(bl[c] + m, ml[c]), w0 = fexp(bl[c] + m - mn), w1 = fexp(ml[c] - mn);
            C = C * w0 + (f32x4){bflo(cl[c].x), bfhi(cl[c].x), bflo(cl[c].y), bfhi(cl[c].y)} * w1;
            if (nthr) { NST[item * 128 + F.tid] = n; n = n * w0 + nl[c] * w1; if (F.tid == 0) MST[item * 4 + 2] = m; }
            m = mn; }
        *(f32x4*)(F.out + O_PMC + (size_t)bh * 16384 + e0) = C;
        if (nthr) { F.out[O_PMN + bh * 128 + F.tid] = n; if (F.tid == 0) F.out[O_PMM + bh] = m; }
    }
}
DI void rg2_carry(Frame& F, const Args& AR) {
    const float* TEH = (const float*)(F.ws + WS_RGP); const float* TEP = TEH + 512 * 512; float* CARRY = (float*)(F.ws + WS_CARRY);
    const int gt = F.vcu * NTHREADS + F.tid, NT = F.G * NTHREADS;
    for (int e = gt; e < NPB * 512; e += NT) { const int b = e >> 9, c = e & 511; float H = 0.f;
        for (int k0 = 0; k0 < 64; k0 += 16) { float pe[16], he[16];
#pragma unroll
            for (int k = 0; k < 16; ++k) { const size_t tl = (size_t)b * 64 + k0 + k; pe[k] = TEP[tl * 512 + c]; he[k] = TEH[tl * 512 + c]; }
#pragma unroll
            for (int k = 0; k < 16; ++k) { CARRY[((size_t)b * 64 + k0 + k) * 512 + c] = H; H = pe[k] * H + he[k]; } }
        F.out[O_PRH + (size_t)b * 512 + c] = H; }
}
DI void rg2_apply(Frame& F, const Args& AR) {
    const bf16* Z = (const bf16*)(F.ws + WS_Z); bf16* G = (bf16*)(F.ws + WS_H);
    const unsigned* RGHP = (const unsigned*)(F.ws + WS_RGH); const float* CARRY = (const float*)(F.ws + WS_CARRY);
    const int gt = F.vcu * NTHREADS + F.tid, NT = F.G * NTHREADS;
    for (int e0 = gt; e0 < MP * 64; e0 += 2 * NT) {
        v4u gqa[2], hpa[2][2]; f32x4 ca[2][2];
#pragma unroll
        for (int u = 0; u < 2; ++u) { const int e = e0 + u * NT < MP * 64 ? e0 + u * NT : e0, row = e >> 6, c0 = (e & 63) * 8, b = row >> 11, tile = (row & (PSEQ - 1)) >> 5;
            gqa[u] = *(const v4u*)(Z + (size_t)row * ZW + ZGR + c0);
            const unsigned* hp = RGHP + (size_t)row * 512 + c0; const float* cp = CARRY + ((size_t)b * 64 + tile) * 512 + c0;
#pragma unroll
            for (int q = 0; q < 2; ++q) { hpa[u][q] = *(const v4u*)(hp + 4 * q); ca[u][q] = *(const f32x4*)(cp + 4 * q); } }
#pragma unroll
        for (int u = 0; u < 2; ++u) { const int e = e0 + u * NT, row = e >> 6, c0 = (e & 63) * 8; const v4u gq = gqa[u];
            const float gr[8] = {bflo(gq.x), bfhi(gq.x), bflo(gq.y), bfhi(gq.y), bflo(gq.z), bfhi(gq.z), bflo(gq.w), bfhi(gq.w)};
            float o[8];
#pragma unroll
            for (int q = 0; q < 2; ++q) { const v4u hq = hpa[u][q]; const f32x4 hl = (f32x4){bflo(hq.x), bflo(hq.y), bflo(hq.z), bflo(hq.w)}, pl = (f32x4){bfhi(hq.x), bfhi(hq.y), bfhi(hq.z), bfhi(hq.w)};
                const f32x4 hv = hl + pl * ca[u][q];
                o[4 * q] = hv.x * gelu_tanh(gr[4 * q]); o[4 * q + 1] = hv.y * gelu_tanh(gr[4 * q + 1]); o[4 * q + 2] = hv.z * gelu_tanh(gr[4 * q + 2]); o[4 * q + 3] = hv.w * gelu_tanh(gr[4 * q + 3]); }
            v4u w; w.x = pk2(o[0], o[1]); w.y = pk2(o[2], o[3]); w.z = pk2(o[4], o[5]); w.w = pk2(o[6], o[7]);
            if (e < MP * 64) *(v4u*)(G + (size_t)row * D + 512 + c0) = w; } }
}

DI void ml3_prompt(Frame& F, const Args& AR) {
    const bf16* Z = (const bf16*)(F.ws + WS_Z); bf16* G = (bf16*)(F.ws + WS_H);
    const float* NST = (const float*)(F.ws + WS_NST); const float* MST = (const float*)(F.ws + WS_MST); const float* GATE = (const float*)(F.ws + WS_GATE);
    LAS bf16* Qs = (LAS bf16*)F.lds;
    LAS bf16* Ks = (LAS bf16*)(F.lds + 34816);
    LAS bf16* Vs = (LAS bf16*)(F.lds + 69632);
    LAS float* LF = (LAS float*)(F.lds + 110592);
    LAS float* BC = LF + 128;
    LAS float* GS = BC + 128;
    LAS float* MX = GS + 128;
    LAS float* N0 = MX + 128;
    LAS float* RA = N0 + 128;
    LAS float* RB = RA + 256;
    LAS float* OT = (LAS float*)F.lds;
    const int tid = F.tid, lane = F.lane, wave = F.wave, r = lane & 31, hh = lane >> 5;
    const int tb = wave >> 1, vh = wave & 1, t = tb * 32 + r;
    for (int item = F.vcu; item < 512; item += F.G) {
        const int b = item >> 6, h = (item >> 4) & 3, c = item & 15; const size_t row0 = (size_t)b * PSEQ + c * 128;
        const float m0 = MST[item * 4 + 2]; const bf16* C0 = (const bf16*)F.out + (size_t)item * 16384;
        const float* gp = GATE + (size_t)item * 384; const int tq = tid & 127;
        const float g0 = gp[tq], g1 = gp[128 + tq], g2 = gp[256 + tq], g3 = NST[item * 128 + tq];
        { v4u qq[4], kq[4], vq[4];
#pragma unroll
            for (int i = 0; i < 4; ++i) { const int e = tid + i * NTHREADS, s = e >> 4, c8 = (e & 15) * 8; const bf16* zr = Z + (row0 + s) * ZW + h * 128 + c8;
                qq[i] = *(const v4u*)(zr + ZQ); kq[i] = *(const v4u*)(zr + ZK); vq[i] = *(const v4u*)(zr + ZV); }
#pragma unroll
            for (int i = 0; i < 4; ++i) { const int e = tid + i * NTHREADS, s = e >> 4, c8 = (e & 15) * 8;
                *(LAS v4u*)(Qs + s * 136 + c8) = qq[i]; *(LAS v4u*)(Ks + s * 136 + c8) = kq[i]; *(LAS v4u*)(Vs + s * 160 + c8) = vq[i]; } }
        if (tid < 128) { BC[tid] = g0; GS[tid] = g1; MX[tid] = fmaxf(m0, g2); N0[tid] = g3; }
        __syncthreads();
        const float mxt = MX[t], winter = fexp(m0 - mxt);
        bf16x8 bq[8];
#pragma unroll
        for (int ks = 0; ks < 8; ++ks) bq[ks] = *(const LAS bf16x8*)(Qs + t * 136 + 16 * ks + 8 * hh);
        bf16x8 cbn[8];
#pragma unroll
        for (int ks = 0; ks < 8; ++ks) cbn[ks] = *(const bf16x8*)(C0 + (size_t)((vh * 2) * 32 + r) * 128 + 16 * ks + 8 * hh);
        bf16x8 pp[4][2]; float den = 0.f;
#pragma unroll
        for (int sb = 0; sb < 4; ++sb) {
            if (sb <= tb) { f32x16 sa;
#pragma unroll
                for (int i = 0; i < 16; ++i) sa[i] = 0.f;
#pragma unroll
                for (int ks = 0; ks < 8; ++ks) sa = MFMA32(*(const LAS bf16x8*)(Ks + (sb * 32 + r) * 136 + 16 * ks + 8 * hh), bq[ks], sa);
                float pv[16], gsv[16];
#pragma unroll
                for (int i = 0; i < 16; ++i) gsv[i] = GS[sb * 32 + crow(i, hh)];
#pragma unroll
                for (int i = 0; i < 16; ++i) { const int s = sb * 32 + crow(i, hh); float v = sa[i] * MSCALE * fexp(gsv[i] - mxt); if (s > t) v = 0.f; pv[i] = v; den += v; }
                pp[sb][0] = mk_frag(pk2(pv[0], pv[1]), pk2(pv[2], pv[3]), pk2(pv[4], pv[5]), pk2(pv[6], pv[7]));
                pp[sb][1] = mk_frag(pk2(pv[8], pv[9]), pk2(pv[10], pv[11]), pk2(pv[12], pv[13]), pk2(pv[14], pv[15]));
            } else { pp[sb][0] = mk_frag(0u, 0u, 0u, 0u); pp[sb][1] = mk_frag(0u, 0u, 0u, 0u); } }
        den += __shfl_xor(den, 32);
        float qn = 0.f;
        { float qa = 0.f, qb = 0.f;
#pragma unroll
            for (int ks = 0; ks < 8; ++ks) { const f32x4 n0 = *(const LAS f32x4*)(N0 + 16 * ks + 8 * hh), n1 = *(const LAS f32x4*)(N0 + 16 * ks + 8 * hh + 4); const v4u qv = __builtin_bit_cast(v4u, bq[ks]);
                qa = fmaf(n0.x, bflo(qv.x), qa); qb = fmaf(n0.y, bfhi(qv.x), qb); qa = fmaf(n0.z, bflo(qv.y), qa); qb = fmaf(n0.w, bfhi(qv.y), qb);
                qa = fmaf(n1.x, bflo(qv.z), qa); qb = fmaf(n1.y, bfhi(qv.z), qb); qa = fmaf(n1.z, bflo(qv.w), qa); qb = fmaf(n1.w, bfhi(qv.w), qb); }
            qn = qa + qb; }
        qn += __shfl_xor(qn, 32);
        const float dtot = den + winter * qn, denom = fmaxf(fabsf(dtot), fexp(-(BC[t] + mxt))), rden = 1.0f / denom;
        float hv[2][16];
#pragma unroll
        for (int q = 0; q < 2; ++q) { const int vb = vh * 2 + q; f32x16 an, ai;
            bf16x8 cb[8];
#pragma unroll
            for (int ks = 0; ks < 8; ++ks) cb[ks] = cbn[ks];
            if (q == 0) {
#pragma unroll
                for (int ks = 0; ks < 8; ++ks) cbn[ks] = *(const bf16x8*)(C0 + (size_t)((vh * 2 + 1) * 32 + r) * 128 + 16 * ks + 8 * hh); }
#pragma unroll
            for (int i = 0; i < 16; ++i) { an[i] = 0.f; ai[i] = 0.f; }
#pragma unroll
            for (int sb = 0; sb < 4; ++sb) if (sb <= tb) {
#pragma unroll
                for (int s2 = 0; s2 < 2; ++s2) {
                    const LAS bf16* vp = Vs + (sb * 32 + 16 * s2 + 4 * hh + ((lane >> 2) & 3)) * 160 + vb * 32 + (lane & 16) + 4 * (lane & 3);
                    const trv4 t0 = __builtin_amdgcn_ds_read_tr16_b64_v4i16((LAS trv4*)vp), t1 = __builtin_amdgcn_ds_read_tr16_b64_v4i16((LAS trv4*)(vp + 8 * 160));
                    const v2u u0 = __builtin_bit_cast(v2u, t0), u1 = __builtin_bit_cast(v2u, t1);
                    an = MFMA32(mk_frag(u0.x, u0.y, u1.x, u1.y), pp[sb][s2], an); } }
#pragma unroll
            for (int ks = 0; ks < 8; ++ks) ai = MFMA32(cb[ks], bq[ks], ai);
#pragma unroll
            for (int i = 0; i < 16; ++i) hv[q][i] = (an[i] + winter * ai[i]) * rden; }
        v4u oqa[4];
        { const int tt = tid >> 2, v0 = (tid & 3) * 32; const size_t row = row0 + tt;
#pragma unroll
            for (int q = 0; q < 4; ++q) oqa[q] = *(const v4u*)(Z + row * ZW + ZO + h * 128 + v0 + 8 * q); }
        float s1 = 0.f;
#pragma unroll
        for (int q = 0; q < 2; ++q)
#pragma unroll
            for (int i = 0; i < 16; ++i) s1 += hv[q][i];
        s1 += __shfl_xor(s1, 32);
        if (hh == 0) RA[vh * 128 + t] = s1;
        __syncthreads();
        const float mean = (RA[t] + RA[128 + t]) * (1.f / 128.f); float s2 = 0.f;
#pragma unroll
        for (int q = 0; q < 2; ++q)
#pragma unroll
            for (int i = 0; i < 16; ++i) { hv[q][i] -= mean; s2 += hv[q][i] * hv[q][i]; }
        s2 += __shfl_xor(s2, 32);
        if (hh == 0) RB[vh * 128 + t] = s2;
        __syncthreads();
        const float rstd = 1.f / sqrtf((RB[t] + RB[128 + t]) * (1.f / 128.f) + HEAD_EPS);
#pragma unroll
        for (int q = 0; q < 2; ++q)
#pragma unroll
            for (int i = 0; i < 16; ++i) OT[t * 132 + (vh * 2 + q) * 32 + crow(i, hh)] = hv[q][i] * rstd;
        __syncthreads();
        { const int tt = tid >> 2, v0 = (tid & 3) * 32; const size_t row = row0 + tt;
            f32x4 ga[4][2];
#pragma unroll
            for (int q = 0; q < 4; ++q) { const int v = v0 + 8 * q; ga[q][0] = *(const f32x4*)(AR.in[I_MNG] + h * 128 + v); ga[q][1] = *(const f32x4*)(AR.in[I_MNG] + h * 128 + v + 4); }
#pragma unroll
            for (int q = 0; q < 4; ++q) { const int v = v0 + 8 * q; const v4u oq = oqa[q];
                const float og[8] = {bflo(oq.x), bfhi(oq.x), bflo(oq.y), bfhi(oq.y), bflo(oq.z), bfhi(oq.z), bflo(oq.w), bfhi(oq.w)};
                const f32x4 g0 = ga[q][0], g1 = ga[q][1];
                const f32x4 x0 = *(const LAS f32x4*)(OT + tt * 132 + v), x1 = *(const LAS f32x4*)(OT + tt * 132 + v + 4);
                v4u w; w.x = pk2(x0.x * g0.x * fsig(og[0]), x0.y * g0.y * fsig(og[1])); w.y = pk2(x0.z * g0.z * fsig(og[2]), x0.w * g0.w * fsig(og[3]));
                w.z = pk2(x1.x * g1.x * fsig(og[4]), x1.y * g1.y * fsig(og[5])); w.w = pk2(x1.z * g1.z * fsig(og[6]), x1.w * g1.w * fsig(og[7]));
                *(v4u*)(G + row * D + h * 128 + v) = w; } }
        __syncthreads();
    }
}

constexpr int TC = 32;
constexpr int RW_ARR = TC * 64;
constexpr int RW_BUF_FLOATS = 6 * RW_ARR + 2 * TC;
struct RwRaw { v2u r, k, v, w, a, g; };
DI void rw_load(RwRaw& x, const bf16* RK, const bf16* WAG, size_t row, size_t row_safe, int h, int k4, bool valid) {
    const size_t rr = valid ? row : row_safe;
    const bf16* p = RK + rr * RKW + h * 64 + k4; const bf16* q = WAG + rr * WAGW + h * 64 + k4;
    x.r = *(const v2u*)p; x.k = *(const v2u*)(p + 1024); x.v = *(const v2u*)(p + 2048); x.w = *(const v2u*)q; x.a = *(const v2u*)(q + 1024); x.g = *(const v2u*)(q + 2048);
}
DI void un4(const v2u u, float (&f)[4]) { f[0] = bflo(u.x); f[1] = bfhi(u.x); f[2] = bflo(u.y); f[3] = bfhi(u.y); }
DI float rw_prep(const RwRaw& x, LAS float* buf, int tok, int k4, const float (&kkw)[4], const float (&kaw)[4], const float (&rkw)[4]) {
    float r[4], k[4], v[4], w[4], a[4]; un4(x.r, r); un4(x.k, k); un4(x.v, v); un4(x.w, w); un4(x.a, a);
    float kk[4], ss = 0.f, bs = 0.f, km[4];
#pragma unroll
    for (int j = 0; j < 4; ++j) { kk[j] = k[j] * kkw[j]; ss += kk[j] * kk[j]; km[j] = k[j] * (1.0f + (a[j] - 1.0f) * kaw[j]); bs += r[j] * km[j] * rkw[j]; }
    ss = sum16(ss); bs = sum16(bs);
    const float inv = 1.0f / fmaxf(sqrtf(ss), 1e-12f);
    f32x4 o0, o1, o2, o3, o4, o5; float br = 0.f, kr = 0.f;
#pragma unroll
    for (int j = 0; j < 4; ++j) { const float kn = kk[j] * inv, dc = __builtin_amdgcn_exp2f(w[j]); o0[j] = kn; o1[j] = kn * a[j]; o2[j] = km[j]; o3[j] = dc; o4[j] = dc * r[j]; o5[j] = v[j];
        br += kn * a[j] * r[j]; kr += km[j] * r[j]; }
    br = sum16(br); kr = sum16(kr);
    LAS float* p = buf + tok * 64 + k4;
    *(LAS f32x4*)p = o0; *(LAS f32x4*)(p + RW_ARR) = o1; *(LAS f32x4*)(p + 2 * RW_ARR) = o2; *(LAS f32x4*)(p + 3 * RW_ARR) = o3;
    *(LAS f32x4*)(p + 4 * RW_ARR) = o4; *(LAS f32x4*)(p + 5 * RW_ARR) = o5;
    if (k4 == 0) *(LAS f32x2*)(buf + 6 * RW_ARR + 2 * tok) = (f32x2){br, kr};
    return bs;
}
#define BAR_LDS() do { asm volatile("s_waitcnt lgkmcnt(0)" ::: "memory"); __builtin_amdgcn_s_barrier(); asm volatile("" ::: "memory"); } while (0)
#define NOPK(x) asm volatile("" : "+v"(x))
DI void sum8x2(float& a, float& b) {
    asm volatile("s_nop 1\n\t"
                 "v_add_f32_dpp %0, %0, %0 quad_perm:[1,0,3,2] row_mask:0xf bank_mask:0xf\n\tv_add_f32_dpp %1, %1, %1 quad_perm:[1,0,3,2] row_mask:0xf bank_mask:0xf\n\ts_nop 0\n\t"
                 "v_add_f32_dpp %0, %0, %0 quad_perm:[2,3,0,1] row_mask:0xf bank_mask:0xf\n\tv_add_f32_dpp %1, %1, %1 quad_perm:[2,3,0,1] row_mask:0xf bank_mask:0xf\n\ts_nop 0\n\t"
                 "v_add_f32_dpp %0, %0, %0 row_half_mirror row_mask:0xf bank_mask:0xf\n\tv_add_f32_dpp %1, %1, %1 row_half_mirror row_mask:0xf bank_mask:0xf\n\ts_nop 0"
                 : "+v"(a), "+v"(b));
}
struct StepV { f32x4 ka, kb, ba, bb, ma, mb, da, db, ea, eb; float vv; f32x2 sc; };
DI void ld_step(StepV& s, const LAS float* cur, int tk, int p, int row) {
    const LAS float* q = cur + tk * 64 + 8 * p;
    s.ka = *(const LAS f32x4*)q; s.kb = *(const LAS f32x4*)(q + 4); s.ba = *(const LAS f32x4*)(q + RW_ARR); s.bb = *(const LAS f32x4*)(q + RW_ARR + 4);
    s.ma = *(const LAS f32x4*)(q + 2 * RW_ARR); s.mb = *(const LAS f32x4*)(q + 2 * RW_ARR + 4); s.da = *(const LAS f32x4*)(q + 3 * RW_ARR); s.db = *(const LAS f32x4*)(q + 3 * RW_ARR + 4);
    s.ea = *(const LAS f32x4*)(q + 4 * RW_ARR); s.eb = *(const LAS f32x4*)(q + 4 * RW_ARR + 4);
    s.vv = cur[5 * RW_ARR + tk * 64 + row]; s.sc = *(const LAS f32x2*)(cur + 6 * RW_ARR + 2 * tk);
}
DI void sum16x4(float& a, float& b, float& c, float& d) {
#define DPP4(ctrl) "v_add_f32_dpp %0, %0, %0 " ctrl " row_mask:0xf bank_mask:0xf\n\tv_add_f32_dpp %1, %1, %1 " ctrl " row_mask:0xf bank_mask:0xf\n\tv_add_f32_dpp %2, %2, %2 " ctrl " row_mask:0xf bank_mask:0xf\n\tv_add_f32_dpp %3, %3, %3 " ctrl " row_mask:0xf bank_mask:0xf\n\t"
    asm volatile("s_nop 1\n\t" DPP4("quad_perm:[1,0,3,2]") DPP4("quad_perm:[2,3,0,1]") DPP4("row_half_mirror") DPP4("row_mirror") "s_nop 0" : "+v"(a), "+v"(b), "+v"(c), "+v"(d));
#undef DPP4
}
constexpr int RQ_KK = 0, RQ_BB = 8192, RQ_KM = 16384, RQ_DC = 24576, RQ_EE = 32768, RQ_VV = 40960, RQ_BUF_BYTES = 57344;
DI float rw_prep_q(const RwRaw& x, LAS unsigned char* buf, int tok, int k4, const float (&kkw)[4], const float (&kaw)[4], const float (&rkw)[4]) {
    float r[4], k[4], v[4], w[4], a[4]; un4(x.r, r); un4(x.k, k); un4(x.v, v); un4(x.w, w); un4(x.a, a);
    float kk[4], ka[4], km[4], ss = 0.f, bs = 0.f, t1 = 0.f, kr = 0.f;
#pragma unroll
    for (int j = 0; j < 4; ++j) { kk[j] = k[j] * kkw[j]; ss = fmaf(kk[j], kk[j], ss); km[j] = k[j] * fmaf(a[j], kaw[j], 1.0f - kaw[j]); bs = fmaf(r[j] * km[j], rkw[j], bs);
        ka[j] = kk[j] * a[j]; t1 = fmaf(ka[j], r[j], t1); kr = fmaf(km[j], r[j], kr); }
    sum16x4(ss, bs, t1, kr);
    const float inv = __builtin_amdgcn_rsqf(fmaxf(ss, 1e-24f)), br = inv * t1;
    f32x4 okk, obb, okm, odc, oee;
#pragma unroll
    for (int j = 0; j < 4; ++j) { okk[j] = kk[j] * inv; obb[j] = ka[j] * inv; okm[j] = km[j]; odc[j] = __builtin_amdgcn_exp2f(w[j]); oee[j] = odc[j] * r[j] - br * okk[j]; }
    LAS unsigned char* p = buf + tok * 256 + k4 * 4;
    *(LAS f32x4*)(p + RQ_KK) = okk; *(LAS f32x4*)(p + RQ_BB) = obb; *(LAS f32x4*)(p + RQ_KM) = okm; *(LAS f32x4*)(p + RQ_DC) = odc; *(LAS f32x4*)(p + RQ_EE) = oee;
    LAS float* vp = (LAS float*)(buf + RQ_VV + (tok * 64 + k4) * 8);
    *(LAS f32x4*)vp = (f32x4){v[0], v[0] * kr, v[1], v[1] * kr}; *(LAS f32x4*)(vp + 4) = (f32x4){v[2], v[2] * kr, v[3], v[3] * kr};
    return bs;
}
struct StepQ { f32x4 k, b, m, d, e, vv; };
template <int TK> DI void ld_stepq(StepQ& s, unsigned aq, unsigned av) {
    asm volatile("ds_read_b128 %0, %6 offset:%8\n\tds_read_b128 %4, %6 offset:%12\n\tds_read_b128 %3, %6 offset:%11\n\tds_read_b128 %2, %6 offset:%10\n\t"
                 "ds_read_b128 %1, %6 offset:%9\n\tds_read_b128 %5, %7 offset:%13"
                 : "=&v"(s.k), "=&v"(s.b), "=&v"(s.m), "=&v"(s.d), "=&v"(s.e), "=&v"(s.vv) : "v"(aq), "v"(av),
                   "n"(RQ_KK + 256 * TK), "n"(RQ_BB + 256 * TK), "n"(RQ_KM + 256 * TK), "n"(RQ_DC + 256 * TK), "n"(RQ_EE + 256 * TK), "n"(512 * TK) : "memory");
}
template <int N> DI void wait_stepqn(StepQ& s) { asm volatile("s_waitcnt lgkmcnt(%6)" : "+v"(s.k), "+v"(s.b), "+v"(s.m), "+v"(s.d), "+v"(s.e), "+v"(s.vv) : "n"(N) : "memory"); }
DI void rw_stepq(float (&S)[2][4], const StepQ& c, LAS float* ydst, bool wr) {
    float r[4];
#pragma unroll
    for (int i = 0; i < 2; ++i) {
        float a = S[i][0] * c.k.x; a = fmaf(S[i][1], c.k.y, a); a = fmaf(S[i][2], c.k.z, a); a = fmaf(S[i][3], c.k.w, a); NOPK(a); r[i] = a;
        float y = S[i][0] * c.e.x; y = fmaf(S[i][1], c.e.y, y); y = fmaf(S[i][2], c.e.z, y); y = fmaf(S[i][3], c.e.w, y); NOPK(y); r[2 + i] = y; }
    sum16x4(r[0], r[1], r[2], r[3]);
#pragma unroll
    for (int i = 0; i < 2; ++i) { const float sa = -r[i], v = i == 0 ? c.vv.x : c.vv.z; float t;
        t = S[i][0] * c.d.x; t = fmaf(c.m.x, v, t); t = fmaf(c.b.x, sa, t); NOPK(t); S[i][0] = t;
        t = S[i][1] * c.d.y; t = fmaf(c.m.y, v, t); t = fmaf(c.b.y, sa, t); NOPK(t); S[i][1] = t;
        t = S[i][2] * c.d.z; t = fmaf(c.m.z, v, t); t = fmaf(c.b.z, sa, t); NOPK(t); S[i][2] = t;
        t = S[i][3] * c.d.w; t = fmaf(c.m.w, v, t); t = fmaf(c.b.w, sa, t); NOPK(t); S[i][3] = t; }
    if (wr) *(LAS f32x2*)ydst = (f32x2){r[2] + c.vv.y, r[3] + c.vv.w};
    asm volatile("" ::: "memory");
}
template <int TK> DI void rw_chunk_steps(float (&S)[2][4], StepQ (&st)[4], unsigned aq, unsigned av, LAS float* yb, bool wr) {
    if constexpr (TK < TC) {
        if constexpr (TK + 3 < TC) ld_stepq<TK + 3>(st[(TK + 3) & 3], aq, av);
        rw_stepq(S, st[TK & 3], yb + TK * 32, wr);
        if constexpr (TK + 3 < TC) wait_stepqn<15>(st[(TK + 1) & 3]); else if constexpr (TK + 2 < TC) wait_stepqn<8>(st[(TK + 1) & 3]); else if constexpr (TK + 1 < TC) wait_stepqn<1>(st[(TK + 1) & 3]);
        rw_chunk_steps<TK + 1>(S, st, aq, av, yb, wr);
    }
}
DI void rw_prompt_half(Frame& F, const Args& AR, int b, int h, int half, float* Sout) {
    const bf16* RK = (const bf16*)(F.ws + WS_RK); const bf16* WAG = (const bf16*)(F.ws + WS_WAG); bf16* G = (bf16*)(F.ws + WS_H); float* BN = (float*)(F.ws + WS_BN);
    LAS unsigned char* BUF = F.lds;
    LAS float* YB = (LAS float*)(F.lds + 2 * RQ_BUF_BYTES);
    const int tid = F.tid; const size_t row0 = (size_t)b * PSEQ;
    constexpr int nch = PSEQ / TC;
    if (tid < 256) {
        const int rp = tid >> 4, cg = tid & 15, rowp = 32 * half + 2 * rp;
        float S[2][4];
#pragma unroll
        for (int i = 0; i < 2; ++i)
#pragma unroll
            for (int j = 0; j < 4; ++j) S[i][j] = 0.f;
        BAR_LDS();
        for (int ch = 0; ch < nch; ++ch) {
            const unsigned cb = (unsigned)(size_t)(BUF + (ch & 1) * RQ_BUF_BYTES); LAS float* yb = YB + (ch & 1) * (TC * 32);
            const unsigned aq = cb + 16u * cg, av = cb + RQ_VV + 8u * rowp;
            StepQ st[4];
            ld_stepq<0>(st[0], aq, av); ld_stepq<1>(st[1], aq, av); ld_stepq<2>(st[2], aq, av); wait_stepqn<12>(st[0]);
            rw_chunk_steps<0>(S, st, aq, av, yb + 2 * rp, cg == 0);
            BAR_LDS();
        }
#pragma unroll
        for (int i = 0; i < 2; ++i) *(f32x4*)(Sout + (rowp + i) * 64 + 4 * cg) = (f32x4){S[i][0], S[i][1], S[i][2], S[i][3]};
        BAR_LDS();
    } else {
        const int ht = tid - 256, tk0 = ht >> 4, k4 = (ht & 15) * 4;
        const int yt = ht >> 3, yv4 = (ht & 7) * 4;
        float kkw[4], kaw[4], rkw[4];
#pragma unroll
        for (int j = 0; j < 4; ++j) { const int c = h * 64 + k4 + j; kkw[j] = AR.in[I_KK][c]; kaw[j] = AR.in[I_KA][c]; rkw[j] = AR.in[I_RK][c]; }
        RwRaw raw[2];
#pragma unroll
        for (int i = 0; i < 2; ++i) { rw_load(raw[i], RK, WAG, row0 + tk0 + 16 * i, row0, h, k4, true);
            const float bn = rw_prep_q(raw[i], BUF, tk0 + 16 * i, k4, kkw, kaw, rkw); if (half == 0 && k4 == 0) BN[(row0 + tk0 + 16 * i) * 16 + h] = bn; }
#pragma unroll
        for (int i = 0; i < 2; ++i) rw_load(raw[i], RK, WAG, row0 + TC + tk0 + 16 * i, row0, h, k4, true);
        BAR_LDS();
        for (int ch = 0; ch < nch; ++ch) {
            const int base = ch * TC;
            if (ch > 0) { const f32x4 y4 = *(const LAS f32x4*)(YB + ((ch - 1) & 1) * (TC * 32) + yt * 32 + yv4);
                v2u w; w.x = pk2(y4.x, y4.y); w.y = pk2(y4.z, y4.w); *(v2u*)(G + (row0 + base - TC + yt) * D + h * 64 + 32 * half + yv4) = w; }
            if (ch + 1 < nch) {
#pragma unroll
                for (int i = 0; i < 2; ++i) { const float bn = rw_prep_q(raw[i], BUF + ((ch + 1) & 1) * RQ_BUF_BYTES, tk0 + 16 * i, k4, kkw, kaw, rkw);
                    if (half == 0 && k4 == 0) BN[(row0 + base + TC + tk0 + 16 * i) * 16 + h] = bn; }
#pragma unroll
                for (int i = 0; i < 2; ++i) rw_load(raw[i], RK, WAG, row0 + base + 2 * TC + tk0 + 16 * i, row0, h, k4, base + 2 * TC < PSEQ);
            }
            BAR_LDS();
        }
        { const f32x4 y4 = *(const LAS f32x4*)(YB + ((nch - 1) & 1) * (TC * 32) + yt * 32 + yv4);
            v2u w; w.x = pk2(y4.x, y4.y); w.y = pk2(y4.z, y4.w); *(v2u*)(G + (row0 + PSEQ - TC + yt) * D + h * 64 + 32 * half + yv4) = w; }
        BAR_LDS();
    }
}
DI void rw_gn_pass(Frame& F, const Args& AR) {
    const bf16* RK = (const bf16*)(F.ws + WS_RK); const bf16* WAG = (const bf16*)(F.ws + WS_WAG); bf16* G = (bf16*)(F.ws + WS_H); const float* BN = (const float*)(F.ws + WS_BN);
    const int gt = F.vcu * NTHREADS + F.tid, NT = F.G * NTHREADS;
    const int h = (gt >> 3) & 15, k8 = (gt & 7) * 8, c = h * 64 + k8;
    float lg[8], lb[8]; ld8(lg, AR.in[I_LXG] + c); ld8(lb, AR.in[I_LXB] + c);
    for (int e0 = gt; e0 < MP * 128; e0 += 4 * NT) {
        v4u yq[4], vq[4], gq[4]; float bnq[4];
#pragma unroll
        for (int u = 0; u < 4; ++u) { const int e = e0 + u * NT < MP * 128 ? e0 + u * NT : e0, row = e >> 7;
            yq[u] = *(const v4u*)(G + (size_t)row * D + c); vq[u] = *(const v4u*)(RK + (size_t)row * RKW + 2048 + c); gq[u] = *(const v4u*)(WAG + (size_t)row * WAGW + 2048 + c); bnq[u] = BN[row * 16 + h]; }
#pragma unroll
        for (int u = 0; u < 4; ++u) { const int e = e0 + u * NT, row = e >> 7; const float bn = bnq[u];
            const float y[8] = {bflo(yq[u].x), bfhi(yq[u].x), bflo(yq[u].y), bfhi(yq[u].y), bflo(yq[u].z), bfhi(yq[u].z), bflo(yq[u].w), bfhi(yq[u].w)};
            const float v[8] = {bflo(vq[u].x), bfhi(vq[u].x), bflo(vq[u].y), bfhi(vq[u].y), bflo(vq[u].z), bfhi(vq[u].z), bflo(vq[u].w), bfhi(vq[u].w)};
            const float g[8] = {bflo(gq[u].x), bfhi(gq[u].x), bflo(gq[u].y), bfhi(gq[u].y), bflo(gq[u].z), bfhi(gq[u].z), bflo(gq[u].w), bfhi(gq[u].w)};
            const float mean = sum8(((y[0] + y[1]) + (y[2] + y[3])) + ((y[4] + y[5]) + (y[6] + y[7]))) * (1.f / 64.f);
            float d[8], s2 = 0.f;
#pragma unroll
            for (int j = 0; j < 8; ++j) { d[j] = y[j] - mean; s2 += d[j] * d[j]; }
            const float rstd = __builtin_amdgcn_rsqf(sum8(s2) * (1.f / 64.f) + RW_EPS);
            float o[8];
#pragma unroll
            for (int j = 0; j < 8; ++j) o[j] = (d[j] * rstd * lg[j] + lb[j] + bn * v[j]) * g[j];
            v4u w; w.x = pk2(o[0], o[1]); w.y = pk2(o[2], o[3]); w.z = pk2(o[4], o[5]); w.w = pk2(o[6], o[7]);
            if (e < MP * 128) *(v4u*)(G + (size_t)row * D + c) = w; }
    }
}
constexpr int RS_WAVE_BYTES = 16640;
DI void ld8b(float (&f)[8], const bf16* p) { const v4u q = *(const v4u*)p; f[0] = bflo(q.x); f[1] = bfhi(q.x); f[2] = bflo(q.y); f[3] = bfhi(q.y); f[4] = bflo(q.z); f[5] = bfhi(q.z); f[6] = bflo(q.w); f[7] = bfhi(q.w); }
DI void st8(LAS float* p, const float (&f)[8]) { *(LAS f32x4*)p = (f32x4){f[0], f[1], f[2], f[3]}; *(LAS f32x4*)(p + 4) = (f32x4){f[4], f[5], f[6], f[7]}; }
DI void rw_sample_wave(Frame& F, const Args& AR, int item) {
    const bf16* RK = (const bf16*)(F.ws + WS_RK); const bf16* WAG = (const bf16*)(F.ws + WS_WAG); bf16* G = (bf16*)(F.ws + WS_H);
    const int lane = F.lane, b = item >> 4, h = item & 15; const size_t row0 = (size_t)MP + (size_t)b * SSEQ;
    LAS float* L = (LAS float*)(F.lds + F.wave * RS_WAVE_BYTES);
    f32x4 Sq[16];
    { const float* sp = AR.in[I_SWKV] + (size_t)item * 4096 + lane * 64;
#pragma unroll
        for (int j = 0; j < 16; ++j) Sq[j] = *(const f32x4*)(sp + 4 * j); }
    { const int tok = lane >> 3, k8 = (lane & 7) * 8, c = h * 64 + k8;
        float r[8], k[8], v[8], w[8], a[8], g[8];
        { const bf16* p = RK + (row0 + tok) * RKW + c; const bf16* q = WAG + (row0 + tok) * WAGW + c; ld8b(r, p); ld8b(k, p + 1024); ld8b(v, p + 2048); ld8b(w, q); ld8b(a, q + 1024); ld8b(g, q + 2048); }
        float kkw[8], kaw[8], rkw[8]; ld8(kkw, AR.in[I_KK] + c); ld8(kaw, AR.in[I_KA] + c); ld8(rkw, AR.in[I_RK] + c);
        float kk[8], km[8], ss = 0.f, bs = 0.f;
#pragma unroll
        for (int j = 0; j < 8; ++j) { kk[j] = k[j] * kkw[j]; ss += kk[j] * kk[j]; km[j] = k[j] * (1.0f + (a[j] - 1.0f) * kaw[j]); bs += r[j] * km[j] * rkw[j]; }
        ss = sum8(ss); bs = sum8(bs);
        const float inv = __builtin_amdgcn_rsqf(fmaxf(ss, 1e-24f));
        float o1[8], o3[8], o4[8], br = 0.f, kr = 0.f;
#pragma unroll
        for (int j = 0; j < 8; ++j) { kk[j] *= inv; o1[j] = kk[j] * a[j]; o3[j] = __builtin_amdgcn_exp2f(w[j]); o4[j] = o3[j] * r[j]; br += o1[j] * r[j]; kr += km[j] * r[j]; }
        br = sum8(br); kr = sum8(kr);
        LAS float* p = L + tok * 64 + k8;
        st8(p, kk); st8(p + 512, o1); st8(p + 1024, km); st8(p + 1536, o3); st8(p + 2048, o4); st8(p + 2560, v); st8(p + 3072, g);
        if (k8 == 0) { L[3584 + 2 * tok] = br; L[3584 + 2 * tok + 1] = kr; L[3600 + tok] = bs; } }
    float S[64];
#pragma unroll
    for (int j = 0; j < 16; ++j) { const f32x4 q = Sq[j]; S[4 * j] = q.x; S[4 * j + 1] = q.y; S[4 * j + 2] = q.z; S[4 * j + 3] = q.w; }
    LDS_WAIT(); asm volatile("" ::: "memory");
    LAS float* YS = L + 3616;
#pragma unroll 1
    for (int tk = 0; tk < SSEQ; ++tk) { const LAS float* q = L + tk * 64;
        float a0 = 0.f, a1 = 0.f, y0 = 0.f, y1 = 0.f;
#pragma unroll
        for (int c4 = 0; c4 < 16; ++c4) { const f32x4 kq = *(const LAS f32x4*)(q + 4 * c4), eq = *(const LAS f32x4*)(q + 2048 + 4 * c4);
            a0 = fmaf(S[4 * c4], kq.x, a0); a1 = fmaf(S[4 * c4 + 1], kq.y, a1); a0 = fmaf(S[4 * c4 + 2], kq.z, a0); a1 = fmaf(S[4 * c4 + 3], kq.w, a1);
            y0 = fmaf(S[4 * c4], eq.x, y0); y1 = fmaf(S[4 * c4 + 1], eq.y, y1); y0 = fmaf(S[4 * c4 + 2], eq.z, y0); y1 = fmaf(S[4 * c4 + 3], eq.w, y1); }
        const float sa = -(a0 + a1), v = q[2560 + lane]; const f32x2 sc = *(const LAS f32x2*)(L + 3584 + 2 * tk);
#pragma unroll
        for (int c4 = 0; c4 < 16; ++c4) { const f32x4 dq = *(const LAS f32x4*)(q + 1536 + 4 * c4), bq = *(const LAS f32x4*)(q + 512 + 4 * c4), mq = *(const LAS f32x4*)(q + 1024 + 4 * c4);
            S[4 * c4] = fmaf(bq.x, sa, fmaf(mq.x, v, S[4 * c4] * dq.x)); S[4 * c4 + 1] = fmaf(bq.y, sa, fmaf(mq.y, v, S[4 * c4 + 1] * dq.y));
            S[4 * c4 + 2] = fmaf(bq.z, sa, fmaf(mq.z, v, S[4 * c4 + 2] * dq.z)); S[4 * c4 + 3] = fmaf(bq.w, sa, fmaf(mq.w, v, S[4 * c4 + 3] * dq.w)); }
        YS[tk * 64 + lane] = fmaf(v, sc.y, fmaf(sa, sc.x, y0 + y1)); }
    { float* sp = F.out + O_SWKV + (size_t)item * 4096 + lane * 64;
#pragma unroll
        for (int j = 0; j < 16; ++j) *(f32x4*)(sp + 4 * j) = (f32x4){S[4 * j], S[4 * j + 1], S[4 * j + 2], S[4 * j + 3]}; }
    LDS_WAIT(); asm volatile("" ::: "memory");
    { const float lg = AR.in[I_LXG][h * 64 + lane], lb = AR.in[I_LXB][h * 64 + lane];
#pragma unroll 1
        for (int tk = 0; tk < SSEQ; ++tk) { const float y = YS[tk * 64 + lane];
            const float mean = wave_sum(y) * (1.f / 64.f), d = y - mean, rstd = __builtin_amdgcn_rsqf(wave_sum(d * d) * (1.f / 64.f) + RW_EPS);
            const float o = (d * rstd * lg + lb + L[3600 + tk] * L[2560 + tk * 64 + lane]) * L[3072 + tk * 64 + lane];
            G[(row0 + tk) * D + h * 64 + lane] = (bf16)f2bf(o); } }
    LDS_WAIT(); asm volatile("" ::: "memory");
}
#ifndef PROBE_RW
#define PROBE_RW 0
#endif
DI void rwkv_scan(Frame& F, const Args& AR) {
    for (int rep = 0; rep < (PROBE_RW == 1 ? 2 : 1); ++rep)
    for (int it = F.vcu; it < NPB * 16 * 2; it += F.G) { const int bh = it >> 1, b = bh >> 4, h = bh & 15;
        rw_prompt_half(F, AR, b, h, it & 1, F.out + O_PWKV + (size_t)bh * 4096); }
}
DI void rwkv_samples(Frame& F, const Args& AR) { for (int item = F.vcu * NWAVES + F.wave; item < NSB * 16; item += F.G * NWAVES) rw_sample_wave(F, AR, item); }

#ifndef MK_N_LAUNCHES
#define MK_N_LAUNCHES 1
#endif
#ifdef PROBE_DUP_PH
constexpr int NPHASES = 28;
#else
constexpr int NPHASES = 27;
#endif
enum { K_P0 = 0, K_MODX, K_UP, K_RESID, K_LN, K_WIN, K_MIXA, K_MIXB, K_MIXC, K_R1, K_R2, K_R3, K_MOD, K_R3B };

__global__ void __launch_bounds__(NTHREADS, 2) mega_fwd(Args AR) {
    extern __shared__ __attribute__((aligned(16))) unsigned char lds[];
    Frame F;
    F.lds = (LAS unsigned char*)lds;
    F.MISC = (volatile LAS unsigned*)(F.lds + MISC_OFF);
    F.tid = threadIdx.x; F.lane = F.tid & 63; F.wave = __builtin_amdgcn_readfirstlane(F.tid >> 6);
    F.G = gridDim.x; { const int bx = blockIdx.x; F.vcu = (F.G % 8 == 0) ? (bx % 8) * (F.G / 8) + bx / 8 : bx; }
    F.ws = AR.ws; F.out = AR.out; F.ctl = (gu32*)(AR.ws + WS_CTL);
    for (int u = F.tid; u < (LDS_BYTES - LDSCTL_OFF) / 4; u += NTHREADS) ((LAS unsigned*)(F.lds + LDSCTL_OFF))[u] = 0u;
    __syncthreads();
    const int lo = AR.ph_lo, hi = AR.ph_hi;
    XcdBarrier bar; bar.bar = (unsigned*)(F.ctl + CW_BAR); bar.x = 0; bar.st = nullptr;
    if (hi - lo > 1) bar = xcd_barrier_post((unsigned*)(F.ctl + CW_BAR), F.MISC + 8);

#ifndef PROBE_DUP_PH
#define PROBE_DUP_PH 1000
#endif
    for (int phs = lo; phs < hi; ++phs) {
        const int ph = phs > PROBE_DUP_PH ? phs - 1 : phs; const bool dupfirst = (phs == PROBE_DUP_PH);
        float* X = F.out + O_Y; const float* mod = (const float*)(F.ws + WS_MOD); bf16* H = (bf16*)(F.ws + WS_H);
        int kind = K_LN, f = 0, l = 0, sub = 0, js = 0, first = 0, mode = 0, lm = 0, which = 0, fin = 0, zsep = 0;
        switch (ph == 0 ? 0 : (ph == 1 ? 100 : (ph <= 20 ? ph - 1 : (ph == 21 ? 101 : ph - 2)))) {
            case 0: kind = K_P0; break;
            case 100: kind = K_MOD; break;
            case 101: kind = K_R3B; break;
            case 1: kind = K_MODX; break;
            case 2: kind = K_UP; f = 0; break;
            case 3: kind = K_RESID; which = 0; f = 0; l = 0; js = 0; first = 1; break;
            case 4: kind = K_LN; l = 0; sub = 0; lm = 0; js = 3; mode = 0; break;
            case 5: kind = K_WIN; break;
            case 6: kind = K_MIXA; break;
            case 7: kind = K_MIXB; break;
            case 8: kind = K_MIXC; break;
            case 9: kind = K_RESID; which = 1; l = 0; js = 3; break;
            case 10: kind = K_LN; l = 0; sub = 1; lm = 0; js = 6; mode = 0; break;
            case 11: kind = K_UP; f = 1; break;
            case 12: kind = K_RESID; which = 0; f = 1; l = 0; js = 6; break;
            case 13: kind = K_LN; l = 0; sub = 2; lm = 1; js = 0; mode = 0; break;
            case 14: kind = K_UP; f = 2; break;
            case 15: kind = K_RESID; which = 0; f = 2; l = 1; js = 0; zsep = 1; break;
            case 16: kind = K_LN; l = 1; sub = 0; lm = 1; js = 3; mode = 1; break;
            case 17: kind = K_R1; break;
            case 18: kind = K_R2; break;
            case 19: kind = K_R3; break;
            case 20: kind = K_RESID; which = 2; l = 1; js = 3; break;
            case 21: kind = K_LN; l = 1; sub = 1; lm = 1; js = 6; mode = 0; break;
            case 22: kind = K_UP; f = 3; break;
            case 23: kind = K_RESID; which = 0; f = 3; l = 1; js = 6; fin = 1; break;
            default: kind = K_LN; l = 1; sub = 2; lm = 1; js = 0; mode = 2; fin = 1; break;
        }
#ifndef PHMASK
#define PHMASK 0xFFFFF
#endif
        { int t_ = F.tid; asm volatile("" : "+v"(t_)); F.tid = t_; F.lane = t_ & 63; F.wave = __builtin_amdgcn_readfirstlane(t_ >> 6);

          int v_ = F.vcu; asm volatile("" : "+s"(v_)); F.vcu = v_; int g_ = F.G; asm volatile("" : "+s"(g_)); F.G = g_;
          unsigned l_ = (unsigned)(size_t)F.lds; asm volatile("" : "+s"(l_)); F.lds = (LAS unsigned char*)(size_t)l_; }
        switch (kind) {
            case K_P0: p0_sctab(F, AR); break;
            case K_MOD: p0_mod(F, AR); break;
            case K_MODX: if ((PHMASK >> K_MODX) & 1) ln_pass(F, AR, 1, 0, 0, 0, 0, 0, 0, 0, 0, 0); break;
            case K_UP: if ((PHMASK >> K_UP) & 1) {
                pg8::Gemm g{H, (const bf16*)(F.ws + WS_W13) + (size_t)f * 5632 * 1024, M, 5632, 1024}; pg8::StaticOrder S; S.init(M, 5632, F.G, (int)blockIdx.x); S.ntk = 16;
                pg8::EpiSwiglu E{(bf16*)(F.ws + WS_HID), FF};
                pg8::gemm_phase<pg8::EpiSwiglu, pg8::StaticOrder, true, true>(F.lds, g, S, E, F.tid);
            } break;
            case K_RESID: if ((PHMASK >> K_RESID) & 1) {
                const bf16* A = which == 0 ? (const bf16*)(F.ws + WS_HID) : H; const int K = which == 0 ? FF : 1024;
                const bf16* Bt = which == 0 ? (const bf16*)(F.ws + WS_W2) + (size_t)f * 1024 * FF : (which == 1 ? (const bf16*)(F.ws + WS_WOUT) : (const bf16*)(F.ws + WS_WO));
                const int nsp = (F.G == 256) ? (which == 0 ? 11 : 4) : 0;
                pg8::Gemm g{A, Bt, M, 1024, K}; SplitOrder S; S.base.init(nsp ? MP : M, 1024, F.G, (int)blockIdx.x); S.base.ntk = K / 64; S.S = nsp;
                EpiResid E{AR, F.out, F.ws, (first ? 1 : 0) | (l << 1) | ((js + 2) << 2) | (which == 0 ? 0 : 64) | (dupfirst ? 128 : 0) | (fin ? 256 : 0) | (zsep ? 512 : 0)};
                pg8::gemm_phase<EpiResid, SplitOrder, true, true>(F.lds, g, S, E, F.tid);
                if (fin && nsp) {
                    const v4u* src = (const v4u*)((unsigned char*)F.out + XB_OFF + (size_t)MP * 2048); v4u* dst = (v4u*)(F.ws + WS_ZF + (size_t)MP * 2048);
                    for (int e = F.vcu * NTHREADS + F.tid; e < MS * 128; e += F.G * NTHREADS) dst[e] = src[e]; }
            } break;
            case K_LN: if (mode == 1) ln_rwkv(F, AR, (F.G == 256) ? 11 : 0);
                       else ln_pass(F, AR, 0, 1, l, sub, lm, js, mode, (F.G == 256) ? (sub == 1 ? 4 : 11) : 0, ph == 5, fin); break;
            case K_WIN: if ((PHMASK >> K_WIN) & 1) {
                pg8::Gemm g{H, (const bf16*)(F.ws + WS_WIN), M, ZW, 1024}; pg8::StaticOrder S; S.init(M, ZW, F.G, (int)blockIdx.x); S.ntk = 16;
                pg8::EpiStore E{(bf16*)(F.ws + WS_Z), ZW, 1000, nullptr, 0};
                pg8::gemm_phase<pg8::EpiStore, pg8::StaticOrder, true, true>(F.lds, g, S, E, F.tid);
            } break;
            case K_R1: {
                pg8::Gemm g{(const bf16*)(F.ws + WS_H), (const bf16*)(F.ws + WS_WRK), M, 3584, 1024};
                R1Order S; S.c = (int)blockIdx.x; S.ws = F.ws; S.out = F.out;
                pg8::EpiStore E{(bf16*)(F.ws + WS_RK), RKW, 12, (bf16*)(F.ws + WS_A3), 256};
                pg8::gemm_phase<pg8::EpiStore, R1Order, true, true>(F.lds, g, S, E, F.tid);
            } break;
            case K_R2: if ((PHMASK >> K_R2) & 1) {
                pg8::Gemm g{(const bf16*)(F.ws + WS_A3), (const bf16*)(F.ws + WS_WL2), M, 3072, 256}; pg8::StaticOrder S; S.init(M, 3072, F.G, (int)blockIdx.x); S.ntk = 4;
                pg8::EpiLora2 E{(bf16*)(F.ws + WS_WAG), WAGW, AR.in[I_W0], AR.in[I_A0]};
                pg8::gemm_phase<pg8::EpiLora2, pg8::StaticOrder, true, true>(F.lds, g, S, E, F.tid);
            } break;
            case K_MIXA: ml1_prompt(F, AR); __syncthreads(); ml_sample(F, AR); __syncthreads(); rg1(F, AR);
#if defined(PROBE_MIX) && PROBE_MIX == 1
                __syncthreads(); ml1_prompt(F, AR);
#elif defined(PROBE_MIX) && PROBE_MIX == 2
                __syncthreads(); ml_sample(F, AR);
#elif defined(PROBE_MIX) && PROBE_MIX == 3
                __syncthreads(); rg1(F, AR);
#endif
                break;
            case K_MIXB: ml2_scan(F, AR); rg2_carry(F, AR);
#if defined(PROBE_MIX) && PROBE_MIX == 6
                rg2_carry(F, AR);
#endif
                break;
            case K_MIXC: ml3_prompt(F, AR); __syncthreads(); rg2_apply(F, AR);
#if defined(PROBE_MIX) && PROBE_MIX == 4
                __syncthreads(); ml3_prompt(F, AR);
#elif defined(PROBE_MIX) && PROBE_MIX == 5
                __syncthreads(); rg2_apply(F, AR);
#endif
                break;
            case K_R3: if ((PHMASK >> K_R3) & 1) rwkv_scan(F, AR); break;
            case K_R3B:
                for (int st = 0; st < 2; ++st) { if ((st == 0) == (F.wave < 4)) rw_gn_pass(F, AR); else rwkv_samples(F, AR); }
                break;
        }
        if (kind == K_P0 || kind == K_MOD || kind == K_MIXB || kind == K_WIN || kind == K_R1 || (kind == K_UP && f < 3)) {
            const bool split = F.G == 256 && hi - lo > 1;
            int lo1 = 0, hi1 = 0, lo2 = 0, hi2 = 0, widx = F.vcu * NWAVES + F.wave, wcnt = F.G * NWAVES; const int bx = (int)blockIdx.x;
            if (kind == K_P0) { lo1 = 0; hi1 = split ? 0 : P0_NPAIR; }
            else if (!split) { }
            else if (kind == K_MOD) { lo1 = 0; hi1 = F.vcu >= 64 ? 1408 : 0; lo2 = 8448; hi2 = F.vcu >= 64 ? 9536 : 8448; widx -= 64 * NWAVES; wcnt -= 64 * NWAVES; }
            else if (kind == K_UP) { lo1 = 5632 + (f == 0 ? 0 : (f + 1) * 704); hi1 = bx >= 216 ? lo1 + 704 : lo1; widx = (bx - 216) * NWAVES + F.wave; wcnt = 40 * NWAVES; }
            else if (kind == K_WIN) { lo1 = 1408; hi1 = bx >= 116 ? 3 * 1408 : lo1; lo2 = 5632 + 704; hi2 = bx >= 116 ? 5632 + 2 * 704 : lo2; widx = (bx - 116) * NWAVES + F.wave; wcnt = 140 * NWAVES; }
            else if (kind == K_MIXB) { lo1 = P0_MIXB_LO; hi1 = F.vcu >= 8 ? P0_MIXB_HI : P0_MIXB_LO; widx -= 8 * NWAVES; wcnt -= 8 * NWAVES; }
            else { lo1 = 3 * 1408; hi1 = bx >= 184 ? 4 * 1408 : lo1; widx = (bx - 184) * NWAVES + F.wave; wcnt = 72 * NWAVES; }
            p0_weights(F, AR, lo1, hi1, lo2, hi2, widx, wcnt);
        }
        if (phs + 1 < hi) xcd_barrier(bar);
#ifdef PROBE_BAR
        if (phs == 2 && hi - lo > 1) { for (int q = 0; q < 20; ++q) xcd_barrier(bar); }
#endif
    }
}

extern "C" void kernel_launch(void* const* d_in, const int* in_sizes, int n_in, void* d_out, int out_size, void* d_ws, size_t ws_size, hipStream_t stream) {
    static int grid = 0;
    if (grid == 0) {
        if (n_in != 47 || out_size != (int)O_END || ws_size < WS_END) { fprintf(stderr, "kernel_launch: unexpected sizes n_in %d out %d ws %zu\n", n_in, out_size, ws_size); grid = -1; return; }
        int dev = 0, cus = 0, per_cu = 0;
        if (hipGetDevice(&dev) != hipSuccess || hipDeviceGetAttribute(&cus, hipDeviceAttributeMultiprocessorCount, dev) != hipSuccess) { grid = -1; return; }
        if (hipFuncSetAttribute((const void*)mega_fwd, hipFuncAttributeMaxDynamicSharedMemorySize, LDS_BYTES) != hipSuccess) { fprintf(stderr, "kernel_launch: hipFuncSetAttribute failed\n"); grid = -1; return; }
        if (hipOccupancyMaxActiveBlocksPerMultiprocessor(&per_cu, (const void*)mega_fwd, NTHREADS, LDS_BYTES) != hipSuccess || per_cu < 1) { fprintf(stderr, "kernel_launch: occupancy query says %d blocks per CU\n", per_cu); (void)hipGetLastError(); grid = -1; return; }
        grid = cus;
    }
    if (grid < 0) return;
    (void)hipMemsetAsync((char*)d_ws + WS_CTL, 0, CTL_ZERO_BYTES, stream);
    Args a{};
    for (int i = 0; i < 47; ++i) a.in[i] = (const float*)d_in[i];
    a.out = (float*)d_out; a.ws = (unsigned char*)d_ws;
#if MK_N_LAUNCHES == 1
    a.ph_lo = 0; a.ph_hi = NPHASES;
    hipLaunchKernelGGL(mega_fwd, dim3(grid), dim3(NTHREADS), LDS_BYTES, stream, a);
#else
    for (int p = 0; p < NPHASES; ++p) { a.ph_lo = p; a.ph_hi = p + 1; hipLaunchKernelGGL(mega_fwd, dim3(grid), dim3(NTHREADS), LDS_BYTES, stream, a); }
#endif
}
```
